# Optimizing an MI355X kernel written in HIP

```python
import jax
import jax.numpy as jnp
from jax import lax
import numpy as np

D_MODEL = 2048
BATCH = 2
SEQ = 4096
DEPTH = 1

GRID_W = 64
CTX_LEN = 256
HEAD_DIM = 64
MIX_DIM = D_MODEL
RWKV_DIM = MIX_DIM // 2
RWKV_HEADS = RWKV_DIM // HEAD_DIM
ATTN_DIM = MIX_DIM - RWKV_DIM
ATTN_HEADS = ATTN_DIM // HEAD_DIM
ATTN_KV_HEADS = 4
ATTN_GROUP = ATTN_HEADS // ATTN_KV_HEADS
KV_DIM = ATTN_KV_HEADS * HEAD_DIM
W_LORA = 96
A_LORA = 96
G_LORA = 256
RWKV_SPLITS = (RWKV_DIM, 2 * RWKV_DIM, 3 * RWKV_DIM, 3 * RWKV_DIM + W_LORA, 3 * RWKV_DIM + W_LORA + A_LORA)
RWKV_COLS = 3 * RWKV_DIM + W_LORA + A_LORA + G_LORA
IN_SPLITS = (RWKV_COLS, RWKV_COLS + ATTN_DIM, RWKV_COLS + ATTN_DIM + KV_DIM)
IN_COLS = RWKV_COLS + ATTN_DIM + 2 * KV_DIM
WINDOW = 128
BLOCK = 128
ROPE_BASE = 10000.0
N_EXPERTS = 64
N_GROUPS = 8
TOPK_GROUPS = 4
TOP_K = 8
EXPERT_FF = 512
SHARED_FF = 512
ROUTED_SCALE = 2.5
EXPERT_BLOCK = 128
NORM_EPS = 1e-6
LNX_EPS = 64e-5

kernel_name = 'hybrid_rwkv7_swa_moe_dit_block'


def rmsnorm(x, g):
    x32 = x.astype(jnp.float32)
    y = x32 * lax.rsqrt(jnp.mean(x32 * x32, axis=-1, keepdims=True) + NORM_EPS)
    return (y * g.astype(jnp.float32)).astype(x.dtype)


def modulate(h, shift, scale):
    return h * (1.0 + scale) + shift


def heads(t, n):
    return t.reshape(t.shape[:-1] + (n, t.shape[-1] // n))


def centred_shift(p, mu):
    prev = jnp.pad(p[:, :-1], ((0, 0), (1, 0), (0, 0)))
    nxt = jnp.pad(p[:, 1:], ((0, 0), (0, 1), (0, 0)))
    return p + mu * (0.5 * (prev + nxt) - p)


def rope_pairs(x, ang):
    x1, x2 = jnp.split(x, 2, axis=-1)
    cos = jnp.cos(ang)[None, :, None, :].astype(x.dtype)
    sin = jnp.sin(ang)[None, :, None, :].astype(x.dtype)
    return jnp.concatenate([x1 * cos - x2 * sin, x2 * cos + x1 * sin], axis=-1)


def axial_rope(x, row, col):
    n_freq = HEAD_DIM // 4
    freqs = ROPE_BASE ** (-jnp.arange(n_freq, dtype=jnp.float32) / n_freq)
    xr, xc = jnp.split(x, 2, axis=-1)
    return jnp.concatenate([rope_pairs(xr, row[:, None] * freqs), rope_pairs(xc, col[:, None] * freqs)], axis=-1)


def wkv7_scan(s0, r, w, k, v, a_, b_, reverse, emit):
    def step(s, inp):
        r_t, w_t, k_t, v_t, a_t, b_t = inp
        sa = jnp.einsum('bhvk,bhk->bhv', s, a_t)
        s = s * w_t[:, :, None, :] + sa[..., None] * b_t[:, :, None, :] + v_t[..., None] * k_t[:, :, None, :]
        y = jnp.einsum('bhvk,bhk->bhv', s, r_t) if emit else None
        return s, y
    xs = tuple(jnp.swapaxes(t, 0, 1) for t in (r, w, k, v, a_, b_))
    s, ys = lax.scan(step, s0, xs, reverse=reverse)
    return s, (jnp.swapaxes(ys, 0, 1) if emit else None)


def rwkv_streams(p, shift_mu, decay_bias, decay_up, iclr_bias, iclr_up, k_k, k_a):
    p = centred_shift(p, shift_mu)
    r, k, v, xw, xa, xg = jnp.split(p, RWKV_SPLITS, axis=-1)
    kk = heads((k * k_k).astype(jnp.float32), RWKV_HEADS)
    kk = kk * lax.rsqrt(jnp.sum(kk * kk, axis=-1, keepdims=True) + 1e-12)
    tw = jnp.tanh(xw)
    dirs = []
    for d in range(2):
        logw = -jax.nn.softplus(-(decay_bias[d] + tw @ decay_up[d])) - 0.5
        decay = jnp.exp(-jnp.exp(logw.astype(jnp.float32)))
        a = jax.nn.sigmoid((iclr_bias[d] + xa @ iclr_up[d]).astype(jnp.float32))
        k_d = k.astype(jnp.float32) * (1.0 + (a - 1.0) * k_a.astype(jnp.float32))
        dirs.append((heads(decay, RWKV_HEADS), heads(k_d, RWKV_HEADS), kk * heads(a, RWKV_HEADS)))
    r = heads(r.astype(jnp.float32), RWKV_HEADS)
    v = heads(v.astype(jnp.float32), RWKV_HEADS)
    return r, v, xg, -kk, dirs


def rwkv_output(y, r, v, k_sum, xg, gate_up, r_k, lnx_g, lnx_b):
    b, t = y.shape[:2]
    mean = jnp.mean(y, axis=-1, keepdims=True)
    var = jnp.mean((y - mean) ** 2, axis=-1, keepdims=True)
    yn = ((y - mean) * lax.rsqrt(var + LNX_EPS)).reshape(b, t, RWKV_DIM)
    bonus = jnp.sum(r * k_sum * r_k.astype(jnp.float32), axis=-1, keepdims=True) * v
    out = yn * lnx_g.astype(jnp.float32) + lnx_b.astype(jnp.float32) + bonus.reshape(b, t, RWKV_DIM)
    g = jax.nn.sigmoid(xg) @ gate_up
    return out.astype(xg.dtype) * g


def window_ctx_attention(q, k, v, k_ctx, v_ctx, sink):
    b, t = q.shape[:2]
    nb = t // BLOCK
    qb = q.reshape(b, nb, BLOCK, ATTN_KV_HEADS, ATTN_GROUP, HEAD_DIM)

    def band(z):
        zp = jnp.pad(z, ((0, 0), (BLOCK, BLOCK), (0, 0), (0, 0))).reshape(b, nb + 2, BLOCK, ATTN_KV_HEADS, HEAD_DIM)
        return jnp.concatenate([zp[:, :-2], zp[:, 1:-1], zp[:, 2:]], axis=2)

    kw, vw = band(k), band(v)
    qpos = jnp.arange(t).reshape(nb, BLOCK)
    kpos = (jnp.arange(nb)[:, None] - 1) * BLOCK + jnp.arange(3 * BLOCK)[None, :]
    valid = (jnp.abs(qpos[:, :, None] - kpos[:, None, :]) <= WINDOW) & (kpos[:, None, :] >= 0) & (kpos[:, None, :] < t)
    scale = HEAD_DIM ** -0.5
    s_w = jnp.einsum('bnqkgd,bnskd->bnkgqs', qb, kw).astype(jnp.float32) * scale
    s_w = jnp.where(valid[None, :, None, None], s_w, -jnp.inf)
    s_c = jnp.einsum('bnqkgd,bckd->bnkgqc', qb, k_ctx).astype(jnp.float32) * scale
    sk = sink.reshape(ATTN_KV_HEADS, ATTN_GROUP)[None, None, :, :, None, None].astype(jnp.float32)
    m = jnp.maximum(jnp.maximum(jnp.max(s_w, -1, keepdims=True), jnp.max(s_c, -1, keepdims=True)), sk)
    e_w = jnp.exp(s_w - m)
    e_c = jnp.exp(s_c - m)
    denom = jnp.sum(e_w, -1, keepdims=True) + jnp.sum(e_c, -1, keepdims=True) + jnp.exp(sk - m)
    o = (jnp.einsum('bnkgqs,bnskd->bnqkgd', (e_w / denom).astype(v.dtype), vw)
         + jnp.einsum('bnkgqc,bckd->bnqkgd', (e_c / denom).astype(v.dtype), v_ctx))
    return o.reshape(b, t, ATTN_DIM)


def ctx_attention(q, k, v, sink):
    b, c = q.shape[:2]
    qg = q.reshape(b, c, ATTN_KV_HEADS, ATTN_GROUP, HEAD_DIM)
    s = jnp.einsum('bqkgd,bckd->bkgqc', qg, k).astype(jnp.float32) * HEAD_DIM ** -0.5
    sk = sink.reshape(ATTN_KV_HEADS, ATTN_GROUP)[None, :, :, None, None].astype(jnp.float32)
    m = jnp.maximum(jnp.max(s, -1, keepdims=True), sk)
    e = jnp.exp(s - m)
    p = e / (jnp.sum(e, -1, keepdims=True) + jnp.exp(sk - m))
    return jnp.einsum('bkgqc,bckd->bqkgd', p.astype(v.dtype), v).reshape(b, c, ATTN_DIM)


def token_mixers(px, pc, row, col, update_ctx, shift_mu, k_k, k_a, r_k, decay_bias, decay_up,
                 iclr_bias, iclr_up, gate_up, lnx_g, lnx_b, attn_sink):
    rx, qx, kx, vx = jnp.split(px, IN_SPLITS, axis=-1)
    rc, qc, kc, vc = jnp.split(pc, IN_SPLITS, axis=-1)
    lora = (shift_mu, decay_bias, decay_up, iclr_bias, iclr_up, k_k, k_a)
    r_x, v_x, xg_x, na_x, dirs_x = rwkv_streams(rx, *lora)
    r_c, v_c, xg_c, na_c, dirs_c = rwkv_streams(rc, *lora)
    s0 = jnp.zeros((px.shape[0], RWKV_HEADS, HEAD_DIM, HEAD_DIM), jnp.float32)
    ys_x, ys_c = [], []
    for d, reverse in enumerate((False, True)):
        dec_c, k_c, b_c = dirs_c[d]
        s_ctx, y_c = wkv7_scan(s0, r_c, dec_c, k_c, v_c, na_c, b_c, reverse, update_ctx)
        dec_x, k_x, b_x = dirs_x[d]
        _, y_x = wkv7_scan(s_ctx, r_x, dec_x, k_x, v_x, na_x, b_x, reverse, True)
        ys_x.append(y_x)
        ys_c.append(y_c)
    rwkv_x = rwkv_output(ys_x[0] + ys_x[1], r_x, v_x, dirs_x[0][1] + dirs_x[1][1], xg_x, gate_up, r_k, lnx_g, lnx_b)
    q = axial_rope(heads(qx, ATTN_HEADS), row, col)
    k = axial_rope(heads(kx, ATTN_KV_HEADS), row, col)
    k_ctx = heads(kc, ATTN_KV_HEADS)
    v_ctx = heads(vc, ATTN_KV_HEADS)
    attn_x = window_ctx_attention(q, k, heads(vx, ATTN_KV_HEADS), k_ctx, v_ctx, attn_sink)
    mix_x = jnp.concatenate([rwkv_x, attn_x], axis=-1)
    if not update_ctx:
        return mix_x, None
    rwkv_c = rwkv_output(ys_c[0] + ys_c[1], r_c, v_c, dirs_c[0][1] + dirs_c[1][1], xg_c, gate_up, r_k, lnx_g, lnx_b)
    attn_c = ctx_attention(heads(qc, ATTN_HEADS), k_ctx, v_ctx, attn_sink)
    return mix_x, jnp.concatenate([rwkv_c, attn_c], axis=-1)


def swiglu(h, wg, wu, wd):
    return (jax.nn.silu(h @ wg) * (h @ wu)) @ wd


def grouped_experts(h, idx, gate, e_gate, e_up, e_down):
    n_tok, d = h.shape
    m = n_tok * TOP_K
    n_blk = -(-m // EXPERT_BLOCK) + N_EXPERTS
    e = idx.reshape(m)
    tok = jnp.repeat(jnp.arange(n_tok, dtype=jnp.int32), TOP_K)
    wt = gate.reshape(m)
    order = jnp.argsort(e)
    e_s, tok_s, wt_s = e[order], tok[order], wt[order]
    counts = jnp.bincount(e, length=N_EXPERTS)
    padded = (counts + EXPERT_BLOCK - 1) // EXPERT_BLOCK * EXPERT_BLOCK
    start = jnp.cumsum(counts) - counts
    pend = jnp.cumsum(padded)
    pstart = pend - padded
    dest = pstart[e_s] + (jnp.arange(m) - start[e_s])
    pad_tok = jnp.full((n_blk * EXPERT_BLOCK,), n_tok, jnp.int32).at[dest].set(tok_s)
    pad_wt = jnp.zeros((n_blk * EXPERT_BLOCK,), h.dtype).at[dest].set(wt_s)
    blk_expert = jnp.minimum(jnp.searchsorted(pend, jnp.arange(n_blk) * EXPERT_BLOCK, side='right'), N_EXPERTS - 1)
    h_pad = jnp.concatenate([h, jnp.zeros((1, d), h.dtype)], axis=0)

    def body(y, blk):
        tok_b, wt_b, e_b = blk
        xb = h_pad[tok_b]
        out = swiglu(xb, e_gate[e_b], e_up[e_b], e_down[e_b])
        return y.at[tok_b].add(out * wt_b[:, None]), None

    y, _ = lax.scan(body, jnp.zeros((n_tok + 1, d), h.dtype),
                    (pad_tok.reshape(n_blk, EXPERT_BLOCK), pad_wt.reshape(n_blk, EXPERT_BLOCK), blk_expert))
    return y[:n_tok]


def moe_ffn(h, w_router, expert_bias, e_gate, e_up, e_down, s_gate, s_up, s_down):
    n_tok = h.shape[0]
    scores = jax.nn.sigmoid((h @ w_router).astype(jnp.float32))
    biased = scores + expert_bias.astype(jnp.float32)
    grp = biased.reshape(n_tok, N_GROUPS, N_EXPERTS // N_GROUPS)
    grp_score = jnp.sum(lax.top_k(grp, 2)[0], axis=-1)
    _, top_grp = lax.top_k(grp_score, TOPK_GROUPS)
    grp_mask = jnp.any(top_grp[..., None] == jnp.arange(N_GROUPS), axis=1)
    masked = jnp.where(jnp.repeat(grp_mask, N_EXPERTS // N_GROUPS, axis=1), biased, -jnp.inf)
    _, idx = lax.top_k(masked, TOP_K)
    gate = jnp.take_along_axis(scores, idx, axis=1)
    gate = gate / jnp.sum(gate, axis=-1, keepdims=True) * ROUTED_SCALE
    routed = grouped_experts(h, idx, gate.astype(h.dtype), e_gate, e_up, e_down)
    return routed + swiglu(h, s_gate, s_up, s_down)


def setup_inputs(seed: int = 0) -> dict:
    key = jax.random.key(seed)
    ks = jax.random.split(key, 32)
    f32 = jnp.float32

    def nrm(k, shape, scale):
        return jax.random.normal(k, shape, f32) * scale

    d = D_MODEL
    return {
        'x': nrm(ks[0], (BATCH, SEQ, d), 1.0),
        'c': nrm(ks[1], (BATCH, d), 1.0),
        'ctx': nrm(ks[2], (BATCH, CTX_LEN, d), 1.0),
        'c_ctx': nrm(ks[3], (d,), 1.0),
        'w_mod': nrm(ks[4], (DEPTH, d, 6 * d), 0.5 * d ** -0.5),
        'b_mod': nrm(ks[5], (DEPTH, 6 * d), 0.02),
        'norm1_g': 1.0 + nrm(ks[6], (DEPTH, d), 0.02),
        'norm2_g': 1.0 + nrm(ks[7], (DEPTH, d), 0.02),
        'w_in': nrm(ks[8], (DEPTH, d, IN_COLS), d ** -0.5),
        'shift_mu': jax.random.uniform(ks[9], (DEPTH, RWKV_COLS), f32),
        'k_k': 0.85 + nrm(ks[10], (DEPTH, RWKV_DIM), 0.02),
        'k_a': 1.0 + nrm(ks[11], (DEPTH, RWKV_DIM), 0.02),
        'r_k': nrm(ks[12], (DEPTH, RWKV_HEADS, HEAD_DIM), 0.1),
        'decay_bias': -3.0 + nrm(ks[13], (DEPTH, 2, RWKV_DIM), 1.0),
        'decay_up': nrm(ks[14], (DEPTH, 2, W_LORA, RWKV_DIM), W_LORA ** -0.5),
        'iclr_bias': nrm(ks[15], (DEPTH, 2, RWKV_DIM), 0.5),
        'iclr_up': nrm(ks[16], (DEPTH, 2, A_LORA, RWKV_DIM), A_LORA ** -0.5),
        'gate_up': nrm(ks[17], (DEPTH, G_LORA, RWKV_DIM), G_LORA ** -0.5),
        'lnx_g': 1.0 + nrm(ks[18], (DEPTH, RWKV_DIM), 0.02),
        'lnx_b': nrm(ks[19], (DEPTH, RWKV_DIM), 0.02),
        'attn_sink': nrm(ks[20], (DEPTH, ATTN_HEADS), 1.0),
        'w_out': nrm(ks[21], (DEPTH, MIX_DIM, d), MIX_DIM ** -0.5),
        'w_router': nrm(ks[22], (DEPTH, d, N_EXPERTS), d ** -0.5),
        'expert_bias': nrm(ks[23], (DEPTH, N_EXPERTS), 0.01),
        'e_gate': nrm(ks[24], (DEPTH, N_EXPERTS, d, EXPERT_FF), d ** -0.5),
        'e_up': nrm(ks[25], (DEPTH, N_EXPERTS, d, EXPERT_FF), d ** -0.5),
        'e_down': nrm(ks[26], (DEPTH, N_EXPERTS, EXPERT_FF, d), EXPERT_FF ** -0.5),
        's_gate': nrm(ks[27], (DEPTH, d, SHARED_FF), d ** -0.5),
        's_up': nrm(ks[28], (DEPTH, d, SHARED_FF), d ** -0.5),
        's_down': nrm(ks[29], (DEPTH, SHARED_FF, d), SHARED_FF ** -0.5),
        'final_g': 1.0 + nrm(ks[30], (d,), 0.02),
    }


def reference(x, c, ctx, c_ctx, w_mod, b_mod, norm1_g, norm2_g, w_in, shift_mu, k_k, k_a, r_k,
              decay_bias, decay_up, iclr_bias, iclr_up, gate_up, lnx_g, lnx_b, attn_sink, w_out,
              w_router, expert_bias, e_gate, e_up, e_down, s_gate, s_up, s_down, final_g):
    b, t, d = x.shape
    rows = t // GRID_W
    row = jnp.repeat(jnp.arange(rows, dtype=jnp.float32), GRID_W)
    col = jnp.tile(jnp.arange(GRID_W, dtype=jnp.float32), rows)
    for layer in range(DEPTH):
        update_ctx = layer < DEPTH - 1
        mod_x = (jax.nn.silu(c) @ w_mod[layer] + b_mod[layer])[:, None, :]
        mod_c = jax.nn.silu(c_ctx) @ w_mod[layer] + b_mod[layer]
        sh1, sc1, gt1, sh2, sc2, gt2 = jnp.split(mod_x, 6, axis=-1)
        csh1, csc1, cgt1, csh2, csc2, cgt2 = jnp.split(mod_c, 6, axis=-1)
        hx = modulate(rmsnorm(x, norm1_g[layer]), sh1, sc1)
        hc = modulate(rmsnorm(ctx, norm1_g[layer]), csh1, csc1)
        mix_x, mix_c = token_mixers(hx @ w_in[layer], hc @ w_in[layer], row, col, update_ctx,
                                    shift_mu[layer], k_k[layer], k_a[layer], r_k[layer],
                                    decay_bias[layer], decay_up[layer], iclr_bias[layer], iclr_up[layer],
                                    gate_up[layer], lnx_g[layer], lnx_b[layer], attn_sink[layer])
        x = x + gt1 * (mix_x @ w_out[layer])
        h2 = modulate(rmsnorm(x, norm2_g[layer]), sh2, sc2)
        moe_w = (w_router[layer], expert_bias[layer], e_gate[layer], e_up[layer], e_down[layer],
                 s_gate[layer], s_up[layer], s_down[layer])
        if update_ctx:
            ctx = ctx + cgt1 * (mix_c @ w_out[layer])
            hc2 = modulate(rmsnorm(ctx, norm2_g[layer]), csh2, csc2)
            f = moe_ffn(jnp.concatenate([h2.reshape(-1, d), hc2.reshape(-1, d)], axis=0), *moe_w)
            x = x + gt2 * f[:b * t].reshape(x.shape)
            ctx = ctx + cgt2 * f[b * t:].reshape(ctx.shape)
        else:
            x = x + gt2 * moe_ffn(h2.reshape(-1, d), *moe_w).reshape(x.shape)
    return rmsnorm(x, final_g)
```

```cpp
#include <hip/hip_runtime.h>
#include <hip/hip_cooperative_groups.h>
#include <cstdio>
#include <cstdint>
namespace cg = cooperative_groups;

#define LDSP __attribute__((address_space(3)))
typedef unsigned short bf16_t;
typedef short bf16x8 __attribute__((ext_vector_type(8)));
typedef float f32x4 __attribute__((ext_vector_type(4)));
typedef float f32x16 __attribute__((ext_vector_type(16)));
typedef unsigned u32x4 __attribute__((ext_vector_type(4)));
typedef unsigned u32x2 __attribute__((ext_vector_type(2)));
__device__ __forceinline__ u32x4 mk4u(unsigned a, unsigned b, unsigned c, unsigned d) { u32x4 r; r.x = a; r.y = b; r.z = c; r.w = d; return r; }
__device__ __forceinline__ u32x2 mk2u(unsigned a, unsigned b) { u32x2 r; r.x = a; r.y = b; return r; }
__device__ __forceinline__ f32x4 mk4f(float a, float b, float c, float d) { f32x4 r; r.x = a; r.y = b; r.z = c; r.w = d; return r; }

constexpr int D = 2048, NB = 2, T = 4096, CL = 256, NX = NB * T, NCX = NB * CL, NR = NX + NCX;
constexpr int INC = 5056, INP = 5120;
constexpr int C_R = 0, C_K = 1024, C_V = 2048, C_XW = 3072, C_XA = 3168, C_XG = 3264, C_Q = 3520, C_AK = 4544, C_AV = 4800;
constexpr int NE = 64, NEX = 65, EFF = 512;
constexpr int NCHUNK = 68;
constexpr int NINST = NB * 16 * 2 * NCHUNK;
constexpr int EROWS = NX * 8 + NX;

constexpr size_t al4k(size_t x) { return (x + 4095) & ~(size_t)4095; }
constexpr size_t OFF_CTL = 0;
constexpr size_t OFF_ROPE = 65536;
constexpr size_t OFF_MODP = OFF_ROPE + 8192;
constexpr size_t OFF_MOD = al4k(OFF_MODP + (size_t)16 * 3 * 12288 * 4);
constexpr size_t OFF_WTDU = al4k(OFF_MOD + (size_t)3 * 12288 * 4);
constexpr size_t OFF_WTIU = OFF_WTDU + (size_t)2 * 1024 * 128 * 2;
constexpr size_t OFF_WTGU = OFF_WTIU + (size_t)2 * 1024 * 128 * 2;
constexpr size_t OFF_WTE2 = OFF_WTGU + (size_t)1024 * 256 * 2;
constexpr size_t OFF_X1 = OFF_WTE2 + (size_t)NEX * 2048 * 512 * 2;
constexpr size_t OFF_H2 = OFF_X1 + (size_t)NX * D * 4;
constexpr size_t OFF_TOKL = OFF_H2 + (size_t)NX * D * 2;
constexpr size_t OFF_EIDX = OFF_TOKL + (size_t)NE * NX * 4;
constexpr size_t OFF_ESLOT = OFF_EIDX + (size_t)NX * 8 * 4;
constexpr size_t OFF_GATE = OFF_ESLOT + (size_t)NX * 8 * 4;
constexpr size_t OFF_H1 = OFF_GATE + (size_t)NX * 8 * 4;
constexpr size_t OFF_WTE1 = al4k(OFF_H1 + (size_t)(EROWS + 256) * EFF * 2);
constexpr size_t OFF_EO = OFF_WTE1;
constexpr size_t OFF_WTIN = OFF_WTE1 + (size_t)NEX * 1024 * 2048 * 2;
constexpr size_t OFF_WTOUT = OFF_WTIN + (size_t)INP * D * 2;
constexpr size_t OFF_HX = OFF_WTOUT + (size_t)D * D * 2;
constexpr size_t OFF_PX = OFF_HX + (size_t)NR * D * 2;
constexpr size_t OFF_CM = OFF_PX + (size_t)NR * INP * 2;
constexpr size_t OFF_CN = OFF_CM + (size_t)NINST * 4096 * 2;
constexpr size_t OFF_CP = OFF_CN + (size_t)NINST * 4096 * 2;
constexpr size_t OFF_CQ = OFF_CP + (size_t)NINST * 4096 * 2;
constexpr size_t OFF_YD = OFF_CQ + (size_t)NINST * 4096 * 2;
constexpr size_t OFF_VSH = OFF_YD + (size_t)2 * NX * 1024 * 4;
constexpr size_t OFF_BON = OFF_VSH + (size_t)NX * 1024 * 2;
constexpr size_t OFF_MIX = OFF_BON + (size_t)NX * 16 * 4;
constexpr size_t WS_END = OFF_MIX + (size_t)NX * D * 2;
static_assert(OFF_EO + (size_t)EROWS * D * 2 <= OFF_HX, "EO overlays only WT_E1/WT_IN/WT_OUT");
static_assert(WS_END <= (size_t)1073741824, "workspace map must fit 1 GiB");

constexpr int SMEM_BYTES = 157 * 1024;

struct Params {
    const float *x, *c, *ctx, *c_ctx, *w_mod, *b_mod, *norm1_g, *norm2_g, *w_in, *shift_mu, *k_k, *k_a, *r_k, *decay_bias, *decay_up, *iclr_bias, *iclr_up,
        *gate_up, *lnx_g, *lnx_b, *attn_sink, *w_out, *w_router, *expert_bias, *e_gate, *e_up, *e_down, *s_gate, *s_up, *s_down, *final_g;
    float* out;
    unsigned char* ws;
};

__device__ __forceinline__ unsigned f2bf(float f) { unsigned u = __float_as_uint(f); return (u + 0x7fffu + ((u >> 16) & 1u)) >> 16; }
__device__ __forceinline__ float bf2f(unsigned h) { return __uint_as_float(h << 16); }
__device__ __forceinline__ unsigned pk2(float lo, float hi) { return f2bf(lo) | (f2bf(hi) << 16); }
__device__ __forceinline__ float wave_sum(float v) {
#pragma unroll
    for (int o = 32; o > 0; o >>= 1) v += __shfl_xor(v, o);
    return v;
}
__device__ __forceinline__ int opaque(int x) { asm volatile("" : "+v"(x)); return x; }
__device__ __forceinline__ unsigned char* opq(unsigned char* x) { asm volatile("" : "+s"(x)); return x; }
__device__ __forceinline__ float sigmoidf_(float x) { return 1.f / (1.f + __expf(-x)); }
__device__ __forceinline__ float softplusf_(float x) { return x > 20.f ? x : log1pf(__expf(x)); }
__device__ __forceinline__ int lds_byte(int r, int c) { const int st = (r >> 4) * 2 + (c >> 5), rr = r & 15, cc = c & 31, ob = rr * 64 + cc * 2; return st * 1024 + (ob ^ (((ob >> 9) & 1) << 5)); }
__device__ __forceinline__ int sw64(int r, int k) { return r * 128 + ((((k >> 3) ^ (r >> 1)) & 7) << 4) + (k & 7) * 2; }
__device__ __forceinline__ int sw128(int r, int k) { return r * 256 + ((((k >> 3) ^ r) & 15) << 4) + (k & 7) * 2; }
__device__ __forceinline__ int sw256(int r, int k) { const int ch = k >> 3; return r * 512 + (((ch & 16) | ((ch ^ r) & 15)) << 4) + (k & 7) * 2; }

__device__ __forceinline__ f32x16 zero16() { f32x16 z;
#pragma unroll
    for (int i = 0; i < 16; ++i) z[i] = 0.f; return z; }
__device__ __forceinline__ int crow(int reg, int hi) { return (reg & 3) + 8 * (reg >> 2) + 4 * hi; }

__device__ __forceinline__ f32x16 mm32_k64(const LDSP unsigned char* A, int arow0, const LDSP unsigned char* B, int brow0, f32x16 acc, int lane) {
    const int r = lane & 31, h = lane >> 5;
#pragma unroll
    for (int s = 0; s < 4; ++s) {
        const bf16x8 a = *(const LDSP bf16x8*)(A + sw64(arow0 + r, 16 * s + 8 * h));
        const bf16x8 b = *(const LDSP bf16x8*)(B + sw64(brow0 + r, 16 * s + 8 * h));
        acc = __builtin_amdgcn_mfma_f32_32x32x16_bf16(a, b, acc, 0, 0, 0);
    }
    return acc;
}

template <class Epi>
__device__ __forceinline__ void gemm256(LDSP unsigned char* lds, const bf16_t* A, int lda, const int* rowmap, int nvalid, const bf16_t* Bt, int ldb, int K, int m0, int n0,
                                        const Epi& epi) {
    const int tid = opaque(threadIdx.x), wid = tid >> 6, lane = tid & 63, wr = wid >> 2, wc = wid & 3, fr = lane & 15, fq = lane >> 4;
    const int lr = tid >> 3, lc = (tid & 7) * 8;
    unsigned aoff[4], boff[4];
#pragma unroll
    for (int i = 0; i < 4; ++i) {
        const int r = lr + 64 * i;
        int gr = m0 + r;
        if (rowmap) gr = (gr < nvalid) ? rowmap[gr] : 0;
        aoff[i] = (unsigned)gr * (unsigned)lda + lc;
        boff[i] = (unsigned)(n0 + r) * (unsigned)ldb + lc;
    }
    const int wo = lds_byte(lr, lc);
    const int swz = lds_byte(fr, fq * 8);
    u32x4 rg[4];
    f32x4 acc[8][4];
#pragma unroll
    for (int m = 0; m < 8; ++m)
#pragma unroll
        for (int n = 0; n < 4; ++n) acc[m][n] = (f32x4){0.f, 0.f, 0.f, 0.f};
    const int nt = K >> 6;
#pragma unroll
    for (int i = 0; i < 4; ++i) rg[i] = *(const u32x4*)(A + aoff[i]);
#pragma unroll
    for (int i = 0; i < 4; ++i) *(LDSP u32x4*)(lds + wo + 8192 * i) = rg[i];
#pragma unroll
    for (int i = 0; i < 4; ++i) rg[i] = *(const u32x4*)(Bt + boff[i]);
#pragma unroll
    for (int i = 0; i < 4; ++i) *(LDSP u32x4*)(lds + 32768 + wo + 8192 * i) = rg[i];
    __syncthreads();
#pragma unroll 1
    for (int t = 0; t < nt; ++t) {
        const int s = t & 1;
        const bool more = (t + 1 < nt);
        const LDSP unsigned char* bA = lds + s * 65536 + swz;
        const LDSP unsigned char* bB = lds + s * 65536 + 32768 + swz;
        LDSP unsigned char* w = lds + (s ^ 1) * 65536 + wo;
#pragma unroll
        for (int ks = 0; ks < 2; ++ks) {
            if (more) {
                if (ks == 0) {
#pragma unroll
                    for (int i = 0; i < 4; ++i) rg[i] = *(const u32x4*)(A + aoff[i] + (t + 1) * 64);
                } else {
#pragma unroll
                    for (int i = 0; i < 4; ++i) rg[i] = *(const u32x4*)(Bt + boff[i] + (t + 1) * 64);
                }
            }
            bf16x8 a[4], b[4];
#pragma unroll
            for (int n = 0; n < 4; ++n) b[n] = *(const LDSP bf16x8*)(bB + ((wc * 4 + n) * 2 + ks) * 1024);
#pragma unroll
            for (int mh = 0; mh < 2; ++mh) {
#pragma unroll
                for (int m = 0; m < 4; ++m) a[m] = *(const LDSP bf16x8*)(bA + ((wr * 8 + mh * 4 + m) * 2 + ks) * 1024);
#pragma unroll
                for (int m = 0; m < 4; ++m)
#pragma unroll
                    for (int n = 0; n < 4; ++n) acc[mh * 4 + m][n] = __builtin_amdgcn_mfma_f32_16x16x32_bf16(b[n], a[m], acc[mh * 4 + m][n], 0, 0, 0);
            }
            if (more) {
#pragma unroll
                for (int i = 0; i < 4; ++i) *(LDSP u32x4*)(w + (ks ? 32768 : 0) + 8192 * i) = rg[i];
            }
        }
        __syncthreads();
    }
#pragma unroll
    for (int m = 0; m < 8; ++m)
#pragma unroll
        for (int n = 0; n < 4; ++n) epi(m0 + wr * 128 + m * 16 + fr, n0 + wc * 64 + n * 16 + fq * 4, acc[m][n]);
}

struct EpiPX { bf16_t* PX; __device__ __forceinline__ void operator()(int row, int col, f32x4 v) const {
    u32x2 w; w.x = pk2(v[0], v[1]); w.y = pk2(v[2], v[3]); *(u32x2*)(PX + (size_t)row * INP + col) = w; } };
struct EpiX1 { const float* x; const float* mod; float* X1; __device__ __forceinline__ void operator()(int row, int col, f32x4 v) const {
    const f32x4 xv = *(const f32x4*)(x + (size_t)row * D + col); const f32x4 g = *(const f32x4*)(mod + (size_t)(row >> 12) * 12288 + 2 * D + col);
    *(f32x4*)(X1 + (size_t)row * D + col) = xv + g * v; } };
struct EpiH1 { bf16_t* H1; int pos0, m0, cnt; __device__ __forceinline__ void operator()(int row, int col, f32x4 v) const {
    if (row < cnt) { const float a = v[0] * sigmoidf_(v[0]) * v[2], b = v[1] * sigmoidf_(v[1]) * v[3];
        *(unsigned*)(H1 + (size_t)(pos0 + row) * EFF + (col >> 1)) = pk2(a, b); } } };
struct EpiEO { bf16_t* EO; int pos0, cnt; __device__ __forceinline__ void operator()(int row, int col, f32x4 v) const {
    if (row < cnt) { u32x2 w; w.x = pk2(v[0], v[1]); w.y = pk2(v[2], v[3]); *(u32x2*)(EO + (size_t)(pos0 + row) * D + col) = w; } } };

struct ConvJob { const float* src; bf16_t* dst; int K, N, ld, mode, ntk, ntn; size_t sbs, dbs; };
__device__ __forceinline__ int conv_row(int n, int mode) { return mode == 0 ? n : (4 * (n >> 1) + (n & 1) + (mode == 2 ? 2 : 0)); }

__device__ __forceinline__ void conv_tile(LDSP unsigned char* lds, const ConvJob& J, int tile) {
    const int per = J.ntk * J.ntn, bi = tile / per, rem = tile - bi * per, kt = rem / J.ntn, ntile = rem - kt * J.ntn;
    const float* src = J.src + (size_t)bi * J.sbs; bf16_t* dst = J.dst + (size_t)bi * J.dbs;
    const int k0 = kt * 256, n0 = ntile * 64, tid = threadIdx.x;
    LDSP float* Tm = (LDSP float*)lds;
    {
        const int kr = tid >> 3, nc = (tid & 7) * 8;
        f32x4 v[4][2];
#pragma unroll
        for (int s = 0; s < 4; ++s) { const float* p = src + (size_t)(k0 + s * 64 + kr) * J.N + n0 + nc; v[s][0] = *(const f32x4*)p; v[s][1] = *(const f32x4*)(p + 4); }
#pragma unroll
        for (int s = 0; s < 4; ++s) { LDSP float* q = Tm + (s * 64 + kr) * 65 + nc;
            q[0] = v[s][0].x; q[1] = v[s][0].y; q[2] = v[s][0].z; q[3] = v[s][0].w; q[4] = v[s][1].x; q[5] = v[s][1].y; q[6] = v[s][1].z; q[7] = v[s][1].w; }
    }
    __syncthreads();
    {
        const int n = tid >> 3; bf16_t* drow = dst + (size_t)conv_row(n0 + n, J.mode) * J.ld + k0;
#pragma unroll
        for (int s = 0; s < 4; ++s) { const int kc = ((tid & 7) + 8 * s) * 8; float f[8];
#pragma unroll
            for (int j = 0; j < 8; ++j) f[j] = Tm[(kc + j) * 65 + n];
            u32x4 w; w.x = pk2(f[0], f[1]); w.y = pk2(f[2], f[3]); w.z = pk2(f[4], f[5]); w.w = pk2(f[6], f[7]); *(u32x4*)(drow + kc) = w; }
    }
    __syncthreads();
}

__device__ __forceinline__ void mod_item(LDSP unsigned char* lds, const Params& p, int item) {
    const int kb = item >> 4, nb = item & 15, tid = threadIdx.x, wid = tid >> 6, lane = tid & 63;
    f32x4 acc[3][3];
#pragma unroll
    for (int v = 0; v < 3; ++v)
#pragma unroll
        for (int j = 0; j < 3; ++j) acc[v][j] = mk4f(0.f, 0.f, 0.f, 0.f);
    for (int i = 0; i < 16; ++i) {
        const int k = kb * 128 + wid * 16 + i;
        float s[3]; { const float c0 = p.c[k], c1 = p.c[D + k], c2 = p.c_ctx[k]; s[0] = c0 * sigmoidf_(c0); s[1] = c1 * sigmoidf_(c1); s[2] = c2 * sigmoidf_(c2); }
        const f32x4* wrow = (const f32x4*)(p.w_mod + (size_t)k * 12288 + nb * 768);
#pragma unroll
        for (int j = 0; j < 3; ++j) { const f32x4 w = wrow[lane + 64 * j];
#pragma unroll
            for (int v = 0; v < 3; ++v) { acc[v][j].x += s[v] * w.x; acc[v][j].y += s[v] * w.y; acc[v][j].z += s[v] * w.z; acc[v][j].w += s[v] * w.w; } }
    }
    LDSP float* R = (LDSP float*)lds;
#pragma unroll
    for (int v = 0; v < 3; ++v)
#pragma unroll
        for (int j = 0; j < 3; ++j) *(LDSP f32x4*)(R + (wid * 3 + v) * 768 + 4 * (lane + 64 * j)) = acc[v][j];
    __syncthreads();
    float* MODP = (float*)(p.ws + OFF_MODP);
    for (int o = tid; o < 3 * 768; o += 512) { const int v = o / 768, cidx = o - v * 768; float s = 0.f;
#pragma unroll
        for (int w = 0; w < 8; ++w) s += R[(w * 3 + v) * 768 + cidx];
        MODP[((size_t)kb * 3 + v) * 12288 + nb * 768 + cidx] = s; }
    __syncthreads();
}

__device__ void phase0(LDSP unsigned char* lds, const Params& p) {
    const int tid = threadIdx.x;
    bf16_t* WTE1 = (bf16_t*)(p.ws + OFF_WTE1); bf16_t* WTE2 = (bf16_t*)(p.ws + OFF_WTE2);
    for (int it = blockIdx.x; it < 256; it += gridDim.x) mod_item(lds, p, it);
    for (int j = 0; j < 9; ++j) {
        ConvJob J;
        switch (j) {
            case 0: J = ConvJob{p.w_in, (bf16_t*)(p.ws + OFF_WTIN), 2048, INC, 2048, 0, 8, INC / 64, 0, 0}; break;
            case 1: J = ConvJob{p.w_out, (bf16_t*)(p.ws + OFF_WTOUT), 2048, 2048, 2048, 0, 8, 32, 0, 0}; break;
            case 2: J = ConvJob{p.e_gate, WTE1, 2048, 512, 2048, 1, 8, 8, (size_t)2048 * 512, (size_t)1024 * 2048}; break;
            case 3: J = ConvJob{p.e_up, WTE1, 2048, 512, 2048, 2, 8, 8, (size_t)2048 * 512, (size_t)1024 * 2048}; break;
            case 4: J = ConvJob{p.e_down, WTE2, 512, 2048, 512, 0, 2, 32, (size_t)512 * 2048, (size_t)2048 * 512}; break;
            case 5: J = ConvJob{p.s_gate, WTE1 + (size_t)64 * 1024 * 2048, 2048, 512, 2048, 1, 8, 8, 0, 0}; break;
            case 6: J = ConvJob{p.s_up, WTE1 + (size_t)64 * 1024 * 2048, 2048, 512, 2048, 2, 8, 8, 0, 0}; break;
            case 7: J = ConvJob{p.s_down, WTE2 + (size_t)64 * 2048 * 512, 512, 2048, 512, 0, 2, 32, 0, 0}; break;
            default: J = ConvJob{p.gate_up, (bf16_t*)(p.ws + OFF_WTGU), 256, 1024, 256, 0, 1, 16, 0, 0}; break;
        }
        const int nbatch = (j >= 2 && j <= 4) ? 64 : 1;
        const int ntiles = nbatch * J.ntk * J.ntn;
        for (int t = blockIdx.x; t < ntiles; t += gridDim.x) conv_tile(lds, J, t);
    }
    {
        const int total = 4 * 1024 * 128;
        for (int idx = blockIdx.x * 512 + tid; idx < total; idx += gridDim.x * 512) {
            const int mtx = idx >> 17, rem = idx & 131071, n = rem >> 7, k = rem & 127;
            const float* src = (mtx < 2 ? p.decay_up : p.iclr_up) + (size_t)(mtx & 1) * 96 * 1024;
            bf16_t* dst = (bf16_t*)(p.ws + (mtx < 2 ? OFF_WTDU : OFF_WTIU)) + (size_t)(mtx & 1) * 1024 * 128;
            dst[n * 128 + k] = (bf16_t)f2bf(k < 96 ? src[(size_t)k * 1024 + n] : 0.f);
        }
    }
    {
        u32x4* z = (u32x4*)((bf16_t*)(p.ws + OFF_WTIN) + (size_t)INC * D);
        const int total = (INP - INC) * D * 2 / 16;
        for (int idx = blockIdx.x * 512 + tid; idx < total; idx += gridDim.x * 512) z[idx] = mk4u(0, 0, 0, 0);
    }
    if (blockIdx.x == gridDim.x - 1) {
        float2* R = (float2*)(p.ws + OFF_ROPE);
        for (int idx = tid; idx < 1024; idx += 512) { const int pos = idx >> 4, f = idx & 15;
            const float freq = powf(10000.f, -(float)f / 16.f); const float ang = (float)pos * freq; R[idx] = make_float2(cosf(ang), sinf(ang)); }
    }
}

__device__ void phase1(LDSP unsigned char* lds, const Params& p) {
    const int tid = threadIdx.x, wid = tid >> 6, lane = tid & 63;
    const float* MODP = (const float*)(p.ws + OFF_MODP);
    float* MOD = (float*)(p.ws + OFF_MOD);
    LDSP float* MV = (LDSP float*)lds;
    for (int idx = tid; idx < 3 * 4096; idx += 512) { const int v = idx >> 12, col = idx & 4095; float s = p.b_mod[col];
#pragma unroll
        for (int kb = 0; kb < 16; ++kb) s += MODP[((size_t)kb * 3 + v) * 12288 + col];
        MV[idx] = s; }
    for (int idx = blockIdx.x * 512 + tid; idx < 3 * 12288; idx += gridDim.x * 512) { const int v = idx / 12288, col = idx - v * 12288; float s = p.b_mod[col];
#pragma unroll
        for (int kb = 0; kb < 16; ++kb) s += MODP[((size_t)kb * 3 + v) * 12288 + col];
        MOD[idx] = s; }
    __syncthreads();
    bf16_t* HX = (bf16_t*)(p.ws + OFF_HX);
    for (int row = blockIdx.x * 8 + wid; row < NR; row += gridDim.x * 8) {
        const float* src = row < NX ? p.x + (size_t)row * D : p.ctx + (size_t)(row - NX) * D;
        const int v = row < NX ? (row >> 12) : 2;
        f32x4 xv[8]; float ss = 0.f;
#pragma unroll
        for (int i = 0; i < 8; ++i) { xv[i] = ((const f32x4*)src)[lane + 64 * i]; ss += xv[i].x * xv[i].x + xv[i].y * xv[i].y + xv[i].z * xv[i].z + xv[i].w * xv[i].w; }
        ss = wave_sum(ss);
        const float rs = rsqrtf(ss * (1.f / D) + 1e-6f);
#pragma unroll
        for (int i = 0; i < 8; ++i) { const int col = 4 * (lane + 64 * i);
            const f32x4 g = *(const f32x4*)(p.norm1_g + col); const LDSP float* sh = MV + v * 4096 + col; const LDSP float* sc = sh + 2048;
            const float h0 = xv[i].x * rs * g.x * (1.f + sc[0]) + sh[0], h1 = xv[i].y * rs * g.y * (1.f + sc[1]) + sh[1];
            const float h2 = xv[i].z * rs * g.z * (1.f + sc[2]) + sh[2], h3 = xv[i].w * rs * g.w * (1.f + sc[3]) + sh[3];
            u32x2 w; w.x = pk2(h0, h1); w.y = pk2(h2, h3); *(u32x2*)(HX + (size_t)row * D + col) = w; }
    }
}

__device__ void phase2(LDSP unsigned char* lds, const Params& p) {
    EpiPX epi{(bf16_t*)(p.ws + OFF_PX)};
    const int ntn = INP / 256, ntm = NR / 256;
    for (int u = blockIdx.x; u < ntm * ntn; u += gridDim.x) { const int pm = u / ntn, pn = u - pm * ntn;
        gemm256(lds, (const bf16_t*)(p.ws + OFF_HX), D, nullptr, 0, (const bf16_t*)(p.ws + OFF_WTIN), D, D, pm * 256, pn * 256, epi); }
}

__device__ __forceinline__ float px_shift(const bf16_t* PX, const float* mu, int row, int s0, int len, int col) {
    const float c = bf2f(PX[(size_t)row * INP + col]);
    const float pv = (row > s0) ? bf2f(PX[(size_t)(row - 1) * INP + col]) : 0.f;
    const float nx = (row + 1 < s0 + len) ? bf2f(PX[(size_t)(row + 1) * INP + col]) : 0.f;
    return c + mu[col] * (0.5f * (pv + nx) - c);
}

constexpr int L3_TW = 0, L3_XA = 16384, L3_XL = 0  , L3_AAB = 32768  , L3_PRE = 32768  , L3_RHS = 32768 + 17408  ,
              L3_AT = 67072, L3_RT = L3_AT + 8192, L3_BT = L3_RT + 8192, L3_KT = L3_BT + 8192, L3_XT = L3_BT  ,
              L3_BHT = L3_KT + 8192, L3_KHT = L3_BHT + 8192, L3_VT = L3_KHT + 8192, L3_AAK = L3_VT + 8192, L3_ARB = L3_AAK + 8192, L3_ARK = L3_ARB + 8192,
              L3_SEG = L3_ARK + 8192  , L3_GL = L3_SEG + 2048  , L3_BONS = L3_GL + 256  , L3_END = L3_BONS + 256;
static_assert(L3_RHS + 16640 <= L3_AT && L3_PRE + 2 * 64 * 65 * 4 <= L3_AT && L3_END <= SMEM_BYTES, "P3 LDS map");

__device__ __forceinline__ int inst_index(int b, int h, int d, int chunk) { return ((b * 16 + h) * 2 + d) * NCHUNK + chunk; }

__device__ void rwkv_prep_unit(LDSP unsigned char* lds, const Params& p, int unit) {
    int seq, c, h;
    if (unit < 2 * 64 * 16) { seq = unit >> 10; c = (unit >> 4) & 63; h = unit & 15; } else { const int u = unit - 2048; seq = 2 + (u >> 6); c = (u >> 4) & 3; h = u & 15; }
    const bool isx = seq < 2;
    const int b = seq & 1;
    const int s0 = isx ? b * T : NX + b * CL, len = isx ? T : CL, t0 = c * 64;
    const int chunk_id = isx ? 4 + c : c;
    const bf16_t* PX = (const bf16_t*)(p.ws + OFF_PX);
    for (int d = 0; d < 2; ++d) {
        { const int tid = opaque(threadIdx.x), wid = tid >> 6, lane = tid & 63; (void)wid; (void)lane;
        for (int idx = tid; idx < 64 * 128; idx += 512) {
            const int i = idx >> 7, k = idx & 127;
            float tw = 0.f, xa = 0.f;
            if (k < 96) { tw = tanhf(px_shift(PX, p.shift_mu, s0 + t0 + i, s0, len, C_XW + k)); xa = px_shift(PX, p.shift_mu, s0 + t0 + i, s0, len, C_XA + k); }
            *(LDSP bf16_t*)(lds + L3_TW + sw128(i, k)) = (bf16_t)f2bf(tw);
            *(LDSP bf16_t*)(lds + L3_XA + sw128(i, k)) = (bf16_t)f2bf(xa);
        }
        }
        __syncthreads();
        { const int tid = opaque(threadIdx.x), wid = tid >> 6, lane = tid & 63; (void)wid; (void)lane;
        if (wid < 4) {
            const int mi = wid >> 1, rh = wid & 1, r = lane & 31, hh = lane >> 5;
            const LDSP unsigned char* Asrc = lds + (mi == 0 ? L3_TW : L3_XA);
            const bf16_t* W = (const bf16_t*)(p.ws + (mi == 0 ? OFF_WTDU : OFF_WTIU)) + (size_t)d * 1024 * 128 + (size_t)(h * 64) * 128;
            f32x16 acc0 = zero16(), acc1 = zero16();
#pragma unroll
            for (int s = 0; s < 8; ++s) {
                const bf16x8 a = *(const LDSP bf16x8*)(Asrc + sw128(32 * rh + r, 16 * s + 8 * hh));
                const bf16x8 b0 = *(const bf16x8*)(W + (size_t)r * 128 + 16 * s + 8 * hh);
                const bf16x8 b1 = *(const bf16x8*)(W + (size_t)(32 + r) * 128 + 16 * s + 8 * hh);
                acc0 = __builtin_amdgcn_mfma_f32_32x32x16_bf16(a, b0, acc0, 0, 0, 0);
                acc1 = __builtin_amdgcn_mfma_f32_32x32x16_bf16(a, b1, acc1, 0, 0, 0);
            }
            LDSP float* PRE = (LDSP float*)(lds + L3_PRE) + mi * 64 * 65;
#pragma unroll
            for (int g = 0; g < 16; ++g) { const int row = 32 * rh + crow(g, hh); PRE[row * 65 + r] = acc0[g]; PRE[row * 65 + 32 + r] = acc1[g]; }
        }
        }
        __syncthreads();
        { const int tid = opaque(threadIdx.x), wid = tid >> 6, lane = tid & 63; (void)wid; (void)lane;
        {
            const int k = lane, seg = wid, hk = h * 64 + k;
            const float kkc = p.k_k[hk], kac = p.k_a[hk], rkc = p.r_k[hk], dbias = p.decay_bias[d * 1024 + hk], ibias = p.iclr_bias[d * 1024 + hk];
            const LDSP float* PRE = (const LDSP float*)(lds + L3_PRE);
            float rr[8], kd[8], vv[8], aa[8], bb[8], lw[8];
            float run = 0.f;
#pragma unroll
            for (int tt = 0; tt < 8; ++tt) {
                const int i = seg * 8 + tt, tau = d ? 63 - i : i, row = s0 + t0 + tau;
                const float r_ = px_shift(PX, p.shift_mu, row, s0, len, C_R + hk);
                const float kraw = px_shift(PX, p.shift_mu, row, s0, len, C_K + hk);
                const float v_ = px_shift(PX, p.shift_mu, row, s0, len, C_V + hk);
                const float kkv = kraw * kkc;
                const float ss = wave_sum(kkv * kkv);
                const float kk = kkv * rsqrtf(ss + 1e-12f);
                const float logw = -softplusf_(-(dbias + PRE[tau * 65 + k])) - 0.5f;
                lw[tt] = -__expf(logw);
                const float a = sigmoidf_(ibias + PRE[64 * 65 + tau * 65 + k]);
                kd[tt] = kraw * (1.f + (a - 1.f) * kac);
                bb[tt] = kk * a; aa[tt] = -kk; rr[tt] = r_; vv[tt] = v_;
                run += lw[tt]; lw[tt] = run;
                if (isx) {
                    const float bs = wave_sum(r_ * kd[tt] * rkc);
                    if (lane == 0) { LDSP float* BS = (LDSP float*)(lds + L3_BONS); if (d == 0) BS[tau] = bs; else BS[tau] += bs; }
                    if (d == 0) ((bf16_t*)(p.ws + OFF_VSH))[(size_t)(row) * 1024 + hk] = (bf16_t)f2bf(v_);
                }
                __builtin_amdgcn_sched_barrier(0);
            }
            LDSP float* SEG = (LDSP float*)(lds + L3_SEG);
            SEG[seg * 64 + k] = run;
            __syncthreads();
            float off = 0.f, gL = 0.f;
#pragma unroll
            for (int s = 0; s < 8; ++s) { const float sv = SEG[s * 64 + k]; if (s < seg) off += sv; gL += sv; }
            if (seg == 0) ((LDSP float*)(lds + L3_GL))[k] = gL;
#pragma unroll
            for (int tt = 0; tt < 8; ++tt) {
                const int i = seg * 8 + tt;
                const float g = off + lw[tt];
                const float ge = (tt == 0) ? off : off + lw[tt - 1];
                const float eg = __expf(g), eng = __expf(-g), ege = __expf(ge), egl = __expf(gL - g);
                *(LDSP bf16_t*)(lds + L3_AT + sw64(i, k)) = (bf16_t)f2bf(aa[tt] * ege);
                *(LDSP bf16_t*)(lds + L3_RT + sw64(i, k)) = (bf16_t)f2bf(rr[tt] * eg);
                *(LDSP bf16_t*)(lds + L3_BT + sw64(i, k)) = (bf16_t)f2bf(bb[tt] * eng);
                *(LDSP bf16_t*)(lds + L3_KT + sw64(i, k)) = (bf16_t)f2bf(kd[tt] * eng);
                *(LDSP bf16_t*)(lds + L3_BHT + sw64(k, i)) = (bf16_t)f2bf(bb[tt] * egl);
                *(LDSP bf16_t*)(lds + L3_KHT + sw64(k, i)) = (bf16_t)f2bf(kd[tt] * egl);
                *(LDSP bf16_t*)(lds + L3_VT + sw64(k, i)) = (bf16_t)f2bf(vv[tt]);
            }
        }
        }
        __syncthreads();
        { const int tid = opaque(threadIdx.x), wid = tid >> 6, lane = tid & 63; (void)wid; (void)lane;
        {
            const int tr = wid >> 1, r = lane & 31, hh = lane >> 5;
            const LDSP unsigned char* Asrc = lds + (tr < 2 ? L3_AT : L3_RT);
#pragma unroll
            for (int q = 0; q < 2; ++q) {
                const int tc = (wid & 1) * 2 + q;
                const LDSP unsigned char* Bsrc = lds + (tc < 2 ? L3_BT : L3_KT);
                const f32x16 acc = mm32_k64(Asrc, 32 * (tr & 1), Bsrc, 32 * (tc & 1), zero16(), lane);
                const int j = 32 * (tc & 1) + r;
#pragma unroll
                for (int g = 0; g < 16; ++g) {
                    const int i = 32 * (tr & 1) + crow(g, hh);
                    if (tr < 2) { const float v = (j < i) ? acc[g] : 0.f;
                        if (tc < 2) ((LDSP float*)(lds + L3_AAB))[i * 68 + j] = v; else *(LDSP bf16_t*)(lds + L3_AAK + sw64(i, j)) = (bf16_t)f2bf(v); }
                    else { const float v = (j <= i) ? acc[g] : 0.f;
                        *(LDSP bf16_t*)(lds + (tc < 2 ? L3_ARB : L3_ARK) + sw64(i, j)) = (bf16_t)f2bf(v); }
                }
            }
        }
        }
        __syncthreads();
        { const int tid = opaque(threadIdx.x), wid = tid >> 6, lane = tid & 63; (void)wid; (void)lane;
        if (wid < 4) {
            const int rt = wid >> 1, ct = wid & 1, r = lane & 31, hh = lane >> 5;
            const f32x16 acc = mm32_k64(lds + L3_AAK, 32 * rt, lds + L3_VT, 32 * ct, zero16(), lane);
            LDSP float* RHS = (LDSP float*)(lds + L3_RHS);
#pragma unroll
            for (int g = 0; g < 16; ++g) RHS[(32 * rt + crow(g, hh)) * 65 + 32 * ct + r] = acc[g];
        }
        }
        __syncthreads();
        { const int tid = opaque(threadIdx.x), wid = tid >> 6, lane = tid & 63; (void)wid; (void)lane;
        if (wid < 2) {
            const int col = tid, cc = col & 63;
            LDSP float* Xc = (col < 64) ? (LDSP float*)(lds + L3_XL) + cc : (LDSP float*)(lds + L3_RHS) + cc;
            const LDSP float* Aab = (const LDSP float*)(lds + L3_AAB);
            for (int i = 0; i < 64; ++i) {
                float acc = (col < 64) ? bf2f(*(const LDSP bf16_t*)(lds + L3_AT + sw64(i, cc))) : Xc[i * 65];
                const int n4 = (i + 3) >> 2;
                for (int j4 = 0; j4 < n4; ++j4) {
                    const f32x4 a = *(const LDSP f32x4*)(Aab + i * 68 + 4 * j4);
                    float x0 = Xc[(4 * j4) * 65], x1 = Xc[(4 * j4 + 1) * 65], x2 = Xc[(4 * j4 + 2) * 65], x3 = Xc[(4 * j4 + 3) * 65];
                    if (4 * j4 + 0 >= i) x0 = 0.f;
                    if (4 * j4 + 1 >= i) x1 = 0.f;
                    if (4 * j4 + 2 >= i) x2 = 0.f;
                    if (4 * j4 + 3 >= i) x3 = 0.f;
                    acc += a.x * x0; acc += a.y * x1; acc += a.z * x2; acc += a.w * x3;
                }
                Xc[i * 65] = acc;
            }
#pragma unroll 1
            for (int ch = 0; ch < 8; ++ch) { float X[8];
#pragma unroll
                for (int j = 0; j < 8; ++j) X[j] = Xc[(8 * ch + j) * 65];
                u32x4 w; w.x = pk2(X[0], X[1]); w.y = pk2(X[2], X[3]); w.z = pk2(X[4], X[5]); w.w = pk2(X[6], X[7]);
                *(LDSP u32x4*)(lds + L3_XT + sw64(tid, 8 * ch)) = w; }
        }
        }
        __syncthreads();
        { const int tid = opaque(threadIdx.x), wid = tid >> 6, lane = tid & 63; (void)wid; (void)lane;
        {
            const int mi = wid >> 1, rh = wid & 1, r = lane & 31, hh = lane >> 5;
            const size_t inst = (size_t)inst_index(b, h, d, chunk_id) * 4096;
            bf16_t* dst = (bf16_t*)(p.ws + (mi == 0 ? OFF_CM : mi == 1 ? OFF_CN : mi == 2 ? OFF_CP : OFF_CQ)) + inst;
            if (isx || mi < 2) {
#pragma unroll
                for (int ct = 0; ct < 2; ++ct) {
                    f32x16 acc = zero16();
                    const LDSP unsigned char* A1 = lds + (mi < 2 ? L3_BHT : L3_ARB);
                    const int brow = ((mi & 1) ? 64 : 0) + 32 * ct;
                    acc = mm32_k64(A1, 32 * rh, lds + L3_XT, brow, acc, lane);
                    if (mi & 1) acc = mm32_k64(lds + (mi == 1 ? L3_KHT : L3_ARK), 32 * rh, lds + L3_VT, 32 * ct, acc, lane);
                    const int col = 32 * ct + r;
#pragma unroll
                    for (int g = 0; g < 16; ++g) {
                        const int row = 32 * rh + crow(g, hh);
                        float v = acc[g];
                        if (mi == 0 && row == col) v += __expf(((const LDSP float*)(lds + L3_GL))[row]);
                        if (mi == 2) v += bf2f(*(const LDSP bf16_t*)(lds + L3_RT + sw64(row, col)));
                        dst[row * 64 + col] = (bf16_t)f2bf(v);
                    }
                }
            }
        }
        }
        __syncthreads();
    }
    const int tid = opaque(threadIdx.x);
    if (isx && tid < 64) ((float*)(p.ws + OFF_BON))[(size_t)(s0 + t0 + tid) * 16 + h] = ((const LDSP float*)(lds + L3_BONS))[tid];
    __syncthreads();
}

constexpr int LA_K = 0  , LA_VT = 73728  , LA_END = LA_VT + 18 * 4608;
static_assert(LA_END <= SMEM_BYTES, "attention LDS map");

__device__ void attn_unit(LDSP unsigned char* lds, const Params& p, int unit) {
    const int tid = threadIdx.x, wid = tid >> 6, lane = tid & 63;
    const int b = unit >> 8, kvh = (unit >> 6) & 3, qb = unit & 63, q0 = qb * 64;
    const bf16_t* PX = (const bf16_t*)(p.ws + OFF_PX);
    const float2* ROPE = (const float2*)(p.ws + OFF_ROPE);
    for (int task = tid; task < 576 * 4; task += 512) {
        const int key = task >> 2, pr = task & 3, c0 = (pr & 1) + 4 * (pr >> 1);
        u32x4 w0 = mk4u(0, 0, 0, 0), w1 = mk4u(0, 0, 0, 0);
        if (key < 320) {
            const int pos = q0 - 128 + key;
            if (pos >= 0 && pos < T) {
                const bf16_t* src = PX + (size_t)(b * T + pos) * INP + C_AK + kvh * 64 + c0 * 8;
                const u32x4 x1 = *(const u32x4*)src, x2 = *(const u32x4*)(src + 16);
                const int ppos = (pr < 2) ? (pos >> 6) : (pos & 63);
                const float2* tb = ROPE + ppos * 16 + (pr & 1) * 8;
                const unsigned a1[4] = {x1.x, x1.y, x1.z, x1.w}, a2[4] = {x2.x, x2.y, x2.z, x2.w};
                unsigned o1[4], o2[4];
#pragma unroll
                for (int j = 0; j < 4; ++j) {
                    const float2 cs0 = tb[2 * j], cs1 = tb[2 * j + 1];
                    const float u0 = bf2f(a1[j] & 0xffff), u1 = bf2f(a1[j] >> 16), v0 = bf2f(a2[j] & 0xffff), v1 = bf2f(a2[j] >> 16);
                    o1[j] = pk2(u0 * cs0.x - v0 * cs0.y, u1 * cs1.x - v1 * cs1.y);
                    o2[j] = pk2(v0 * cs0.x + u0 * cs0.y, v1 * cs1.x + u1 * cs1.y);
                }
                w0 = mk4u(o1[0], o1[1], o1[2], o1[3]); w1 = mk4u(o2[0], o2[1], o2[2], o2[3]);
            }
        } else {
            const bf16_t* src = PX + (size_t)(NX + b * CL + (key - 320)) * INP + C_AK + kvh * 64 + c0 * 8;
            w0 = *(const u32x4*)src; w1 = *(const u32x4*)(src + 16);
        }
        *(LDSP u32x4*)(lds + LA_K + sw64(key, c0 * 8)) = w0;
        *(LDSP u32x4*)(lds + LA_K + sw64(key, c0 * 8 + 16)) = w1;
    }
    for (int task = tid; task < 144 * 8; task += 512) {
        const int kg = task >> 3, dc = task & 7;
        unsigned short e[4][8];
#pragma unroll
        for (int q = 0; q < 4; ++q) {
            const int key = kg * 4 + q;
            u32x4 w = mk4u(0, 0, 0, 0);
            if (key < 320) { const int pos = q0 - 128 + key; if (pos >= 0 && pos < T) w = *(const u32x4*)(PX + (size_t)(b * T + pos) * INP + C_AV + kvh * 64 + dc * 8); }
            else w = *(const u32x4*)(PX + (size_t)(NX + b * CL + (key - 320)) * INP + C_AV + kvh * 64 + dc * 8);
            e[q][0] = w.x & 0xffff; e[q][1] = w.x >> 16; e[q][2] = w.y & 0xffff; e[q][3] = w.y >> 16; e[q][4] = w.z & 0xffff; e[q][5] = w.z >> 16; e[q][6] = w.w & 0xffff; e[q][7] = w.w >> 16;
        }
        const int tile = kg >> 3, kin = (kg & 7) * 4;
#pragma unroll
        for (int j = 0; j < 8; ++j) { u32x2 w; w.x = (unsigned)e[0][j] | ((unsigned)e[1][j] << 16); w.y = (unsigned)e[2][j] | ((unsigned)e[3][j] << 16);
            *(LDSP u32x2*)(lds + LA_VT + tile * 4608 + (dc * 8 + j) * 72 + kin * 2) = w; }
    }
    const int hq = kvh * 4 + (wid >> 1), qs = (wid & 1) * 32, r = lane & 31, hh = lane >> 5;
    const int qpos = q0 + qs + r;
    bf16x8 qf[4];
    {
        const bf16_t* src = PX + (size_t)(b * T + qpos) * INP + C_Q + hq * 64 + 8 * hh;
        u32x4 raw[4];
#pragma unroll
        for (int s = 0; s < 4; ++s) raw[s] = *(const u32x4*)(src + 16 * s);
#pragma unroll
        for (int pr = 0; pr < 2; ++pr) {
            const int ppos = pr == 0 ? (qpos >> 6) : (qpos & 63);
            const float2* tb = ROPE + ppos * 16 + 8 * hh;
            const unsigned a1[4] = {raw[2 * pr].x, raw[2 * pr].y, raw[2 * pr].z, raw[2 * pr].w}, a2[4] = {raw[2 * pr + 1].x, raw[2 * pr + 1].y, raw[2 * pr + 1].z, raw[2 * pr + 1].w};
            unsigned o1[4], o2[4];
#pragma unroll
            for (int j = 0; j < 4; ++j) {
                const float2 cs0 = tb[2 * j], cs1 = tb[2 * j + 1];
                const float u0 = bf2f(a1[j] & 0xffff), u1 = bf2f(a1[j] >> 16), v0 = bf2f(a2[j] & 0xffff), v1 = bf2f(a2[j] >> 16);
                o1[j] = pk2(0.125f * (u0 * cs0.x - v0 * cs0.y), 0.125f * (u1 * cs1.x - v1 * cs1.y));
                o2[j] = pk2(0.125f * (v0 * cs0.x + u0 * cs0.y), 0.125f * (v1 * cs1.x + u1 * cs1.y));
            }
            const u32x4 w1 = mk4u(o1[0], o1[1], o1[2], o1[3]), w2 = mk4u(o2[0], o2[1], o2[2], o2[3]);
            qf[2 * pr] = __builtin_bit_cast(bf16x8, w1); qf[2 * pr + 1] = __builtin_bit_cast(bf16x8, w2);
        }
    }
    __syncthreads();
    float m = p.attn_sink[hq], l = 1.f;
    f32x16 o0 = zero16(), o1 = zero16();
    for (int tl = 0; tl < 18; ++tl) {
        f32x16 st = zero16();
#pragma unroll
        for (int s = 0; s < 4; ++s) {
            const bf16x8 kf = *(const LDSP bf16x8*)(lds + LA_K + sw64(32 * tl + r, 16 * s + 8 * hh));
            st = __builtin_amdgcn_mfma_f32_32x32x16_bf16(kf, qf[s], st, 0, 0, 0);
        }
        if (tl < 10) {
#pragma unroll
            for (int g = 0; g < 16; ++g) { const int kp = q0 - 128 + 32 * tl + crow(g, hh); const int dlt = qpos - kp;
                const bool ok = (dlt <= 128) && (dlt >= -128) && (kp >= 0) && (kp < T); st[g] = ok ? st[g] : -1e30f; }
        }
        float mt = st[0];
#pragma unroll
        for (int g = 1; g < 16; ++g) mt = fmaxf(mt, st[g]);
        mt = fmaxf(mt, __shfl_xor(mt, 32));
        const float mn = fmaxf(m, mt), alpha = __expf(m - mn);
        float ps = 0.f;
#pragma unroll
        for (int g = 0; g < 16; ++g) { st[g] = __expf(st[g] - mn); ps += st[g]; }
        ps += __shfl_xor(ps, 32);
        l = l * alpha + ps; m = mn;
#pragma unroll
        for (int g = 0; g < 16; ++g) { o0[g] *= alpha; o1[g] *= alpha; }
#pragma unroll
        for (int s2 = 0; s2 < 2; ++s2) {
            const u32x4 pw = mk4u(pk2(st[8 * s2], st[8 * s2 + 1]), pk2(st[8 * s2 + 2], st[8 * s2 + 3]), pk2(st[8 * s2 + 4], st[8 * s2 + 5]), pk2(st[8 * s2 + 6], st[8 * s2 + 7]));
            const bf16x8 pf = __builtin_bit_cast(bf16x8, pw);
#pragma unroll
            for (int dm = 0; dm < 2; ++dm) {
                const LDSP unsigned char* vp = lds + LA_VT + tl * 4608 + (32 * dm + r) * 72 + (16 * s2 + 4 * hh) * 2;
                const u32x2 v0 = *(const LDSP u32x2*)vp, v1 = *(const LDSP u32x2*)(vp + 16);
                const bf16x8 vf = __builtin_bit_cast(bf16x8, mk4u(v0.x, v0.y, v1.x, v1.y));
                if (dm == 0) o0 = __builtin_amdgcn_mfma_f32_32x32x16_bf16(vf, pf, o0, 0, 0, 0); else o1 = __builtin_amdgcn_mfma_f32_32x32x16_bf16(vf, pf, o1, 0, 0, 0);
            }
        }
    }
    {
        const float inv = 1.f / l;
        bf16_t* dst = (bf16_t*)(p.ws + OFF_MIX) + (size_t)(b * T + qpos) * D + 1024 + hq * 64;
#pragma unroll
        for (int gq = 0; gq < 4; ++gq) {
            u32x2 w; w.x = pk2(o0[4 * gq] * inv, o0[4 * gq + 1] * inv); w.y = pk2(o0[4 * gq + 2] * inv, o0[4 * gq + 3] * inv); *(u32x2*)(dst + 8 * gq + 4 * hh) = w;
            u32x2 w2; w2.x = pk2(o1[4 * gq] * inv, o1[4 * gq + 1] * inv); w2.y = pk2(o1[4 * gq + 2] * inv, o1[4 * gq + 3] * inv); *(u32x2*)(dst + 32 + 8 * gq + 4 * hh) = w2;
        }
    }
    __syncthreads();
}

__device__ void phase3(LDSP unsigned char* lds, const Params& p) {
    const int n_rw = 2 * 64 * 16 + 2 * 4 * 16, n_at = 512;
    for (int u = blockIdx.x; u < n_rw + n_at; u += gridDim.x) {
#ifndef NO_RW
        if (u < n_rw) rwkv_prep_unit(lds, p, u);
#endif
#ifndef NO_ATTN
        if (u >= n_rw) attn_unit(lds, p, u - n_rw);
#endif
    }
}

__device__ void scan_chain(LDSP unsigned char* lds, const Params& p, int chain) {
    const int tid = threadIdx.x, wid = tid >> 6, lane = tid & 63, r = lane & 31, hh = lane >> 5;
    const int b = chain >> 5, h = (chain >> 1) & 15, d = chain & 1;
    const int rb = wid >> 1, cb = wid & 1;
    for (int i = tid; i < 2 * 8192 / 16; i += 512) ((LDSP u32x4*)lds)[i] = mk4u(0, 0, 0, 0);
    __syncthreads();
    float* YD = (float*)(p.ws + OFF_YD);
    for (int step = 0; step < NCHUNK; ++step) {
        int chunk_id;
        if (step < 4) chunk_id = d ? 3 - step : step; else chunk_id = d ? 4 + (67 - step) : step;
        const bool isx = chunk_id >= 4;
        const size_t inst = (size_t)inst_index(b, h, d, chunk_id) * 4096;
        const int cur = step & 1;
        if (rb < 2 || isx) {
            const bf16_t* Am = (const bf16_t*)(p.ws + (rb < 2 ? OFF_CM : OFF_CP)) + inst;
            const bf16_t* Cm = (const bf16_t*)(p.ws + (rb < 2 ? OFF_CN : OFF_CQ)) + inst;
            const int row0 = 32 * (rb & 1), col = 32 * cb + r;
            f32x16 acc;
#pragma unroll
            for (int g = 0; g < 16; ++g) acc[g] = bf2f(Cm[(row0 + crow(g, hh)) * 64 + col]);
#pragma unroll
            for (int s = 0; s < 4; ++s) {
                const bf16x8 a = *(const bf16x8*)(Am + (row0 + r) * 64 + 16 * s + 8 * hh);
                const bf16x8 bfr = *(const LDSP bf16x8*)(lds + cur * 8192 + sw64(32 * cb + r, 16 * s + 8 * hh));
                acc = __builtin_amdgcn_mfma_f32_32x32x16_bf16(a, bfr, acc, 0, 0, 0);
            }
            if (rb < 2) {
#pragma unroll
                for (int gq = 0; gq < 4; ++gq) { u32x2 w; w.x = pk2(acc[4 * gq], acc[4 * gq + 1]); w.y = pk2(acc[4 * gq + 2], acc[4 * gq + 3]);
                    *(LDSP u32x2*)(lds + (cur ^ 1) * 8192 + sw64(col, row0 + 8 * gq + 4 * hh)) = w; }
            } else {
                const int t0 = (chunk_id - 4) * 64;
#pragma unroll
                for (int g = 0; g < 16; ++g) { const int i = row0 + crow(g, hh), tau = d ? 63 - i : i;
                    YD[((size_t)d * NX + (size_t)b * T + t0 + tau) * 1024 + h * 64 + col] = acc[g]; }
            }
        }
        __syncthreads();
    }
}

__device__ void phase4(LDSP unsigned char* lds, const Params& p) {
    for (int u = blockIdx.x; u < 64; u += gridDim.x) scan_chain(lds, p, u);
}

constexpr int L5_SG = 0  , L5_OUT = 32768  ;
__device__ void rwkv_out_unit(LDSP unsigned char* lds, const Params& p, int unit) {
    const int tid = threadIdx.x, wid = tid >> 6, lane = tid & 63;
    const int b = unit >> 10, c = (unit >> 4) & 63, h = unit & 15, s0 = b * T, t0 = c * 64;
    const bf16_t* PX = (const bf16_t*)(p.ws + OFF_PX);
    for (int idx = tid; idx < 64 * 256; idx += 512) { const int i = idx >> 8, k = idx & 255;
        *(LDSP bf16_t*)(lds + L5_SG + sw256(i, k)) = (bf16_t)f2bf(sigmoidf_(px_shift(PX, p.shift_mu, s0 + t0 + i, s0, T, C_XG + k))); }
    {
        const float* YD = (const float*)(p.ws + OFF_YD);
        const int hk = h * 64 + lane; const float lg = p.lnx_g[hk], lb = p.lnx_b[hk];
#pragma unroll
        for (int tt = 0; tt < 8; ++tt) {
            const int i = wid * 8 + tt; const size_t row = (size_t)s0 + t0 + i;
            const float y = YD[row * 1024 + hk] + YD[((size_t)NX + row) * 1024 + hk];
            const float mean = wave_sum(y) * (1.f / 64.f); const float dv = y - mean; const float var = wave_sum(dv * dv) * (1.f / 64.f);
            const float yn = dv * rsqrtf(var + 64e-5f);
            const float bon = ((const float*)(p.ws + OFF_BON))[row * 16 + h] * bf2f(((const bf16_t*)(p.ws + OFF_VSH))[row * 1024 + hk]);
            ((LDSP float*)(lds + L5_OUT))[i * 65 + lane] = yn * lg + lb + bon;
        }
    }
    __syncthreads();
    if (wid < 4) {
        const int rt = wid >> 1, ct = wid & 1, r = lane & 31, hh = lane >> 5;
        const bf16_t* W = (const bf16_t*)(p.ws + OFF_WTGU) + (size_t)(h * 64 + 32 * ct + r) * 256;
        f32x16 acc = zero16();
#pragma unroll
        for (int s = 0; s < 16; ++s) {
            const bf16x8 a = *(const LDSP bf16x8*)(lds + L5_SG + sw256(32 * rt + r, 16 * s + 8 * hh));
            const bf16x8 bfr = *(const bf16x8*)(W + 16 * s + 8 * hh);
            acc = __builtin_amdgcn_mfma_f32_32x32x16_bf16(a, bfr, acc, 0, 0, 0);
        }
        bf16_t* MIX = (bf16_t*)(p.ws + OFF_MIX);
#pragma unroll
        for (int g = 0; g < 16; ++g) { const int i = 32 * rt + crow(g, hh), n = 32 * ct + r;
            MIX[(size_t)(s0 + t0 + i) * D + h * 64 + n] = (bf16_t)f2bf(((const LDSP float*)(lds + L5_OUT))[i * 65 + n] * acc[g]); }
    }
    __syncthreads();
}
__device__ void phase5(LDSP unsigned char* lds, const Params& p) { for (int u = blockIdx.x; u < 2048; u += gridDim.x) rwkv_out_unit(lds, p, u); }

__device__ void phase6(LDSP unsigned char* lds, const Params& p) {
    EpiX1 epi{p.x, (const float*)(p.ws + OFF_MOD), (float*)(p.ws + OFF_X1)};
    for (int u = blockIdx.x; u < 32 * 8; u += gridDim.x) { const int pm = u >> 3, pn = u & 7;
        gemm256(lds, (const bf16_t*)(p.ws + OFF_MIX), D, nullptr, 0, (const bf16_t*)(p.ws + OFF_WTOUT), D, D, pm * 256, pn * 256, epi); }
}

__device__ void phase7(LDSP unsigned char* lds, const Params& p) {
    const int tid = threadIdx.x, wid = tid >> 6, lane = tid & 63;
    LDSP float* HR = (LDSP float*)lds;
    LDSP float* PART = (LDSP float*)(lds + 65536);
    const float* MOD = (const float*)(p.ws + OFF_MOD);
    const float* X1 = (const float*)(p.ws + OFF_X1);
    bf16_t* H2 = (bf16_t*)(p.ws + OFF_H2);
    int* CNT = (int*)(p.ws + OFF_CTL + 16384);
    for (int u = blockIdx.x; u < NX / 8; u += gridDim.x) {
        {
            const int row = u * 8 + wid; const float* src = X1 + (size_t)row * D; const float* md = MOD + (size_t)(row >> 12) * 12288;
            f32x4 xv[8]; float ss = 0.f;
#pragma unroll
            for (int i = 0; i < 8; ++i) { xv[i] = ((const f32x4*)src)[lane + 64 * i]; ss += xv[i].x * xv[i].x + xv[i].y * xv[i].y + xv[i].z * xv[i].z + xv[i].w * xv[i].w; }
            ss = wave_sum(ss); const float rs = rsqrtf(ss * (1.f / D) + 1e-6f);
#pragma unroll
            for (int i = 0; i < 8; ++i) { const int col = 4 * (lane + 64 * i);
                const f32x4 g = *(const f32x4*)(p.norm2_g + col), sh = *(const f32x4*)(md + 3 * D + col), sc = *(const f32x4*)(md + 4 * D + col);
                f32x4 hv; hv.x = xv[i].x * rs * g.x * (1.f + sc.x) + sh.x; hv.y = xv[i].y * rs * g.y * (1.f + sc.y) + sh.y; hv.z = xv[i].z * rs * g.z * (1.f + sc.z) + sh.z; hv.w = xv[i].w * rs * g.w * (1.f + sc.w) + sh.w;
                *(LDSP f32x4*)(HR + wid * 2048 + col) = hv;
                u32x2 w; w.x = pk2(hv.x, hv.y); w.y = pk2(hv.z, hv.w); *(u32x2*)(H2 + (size_t)row * D + col) = w; }
        }
        __syncthreads();
        {
            float acc[8];
#pragma unroll
            for (int t = 0; t < 8; ++t) acc[t] = 0.f;
            const float* wr = p.w_router + (size_t)(wid * 256) * 64 + lane;
            for (int k4 = 0; k4 < 64; ++k4) {
                const float w0 = wr[(4 * k4) * 64], w1 = wr[(4 * k4 + 1) * 64], w2 = wr[(4 * k4 + 2) * 64], w3 = wr[(4 * k4 + 3) * 64];
#pragma unroll
                for (int t = 0; t < 8; ++t) { const f32x4 hv = *(const LDSP f32x4*)(HR + t * 2048 + wid * 256 + 4 * k4); acc[t] += hv.x * w0 + hv.y * w1 + hv.z * w2 + hv.w * w3; }
            }
#pragma unroll
            for (int t = 0; t < 8; ++t) PART[(wid * 8 + t) * 64 + lane] = acc[t];
        }
        __syncthreads();
        {
            const int token = u * 8 + wid;
            float logit = 0.f;
#pragma unroll
            for (int w = 0; w < 8; ++w) logit += PART[(w * 8 + wid) * 64 + lane];
            const float score = 1.f / (1.f + expf(-logit));
            const float v = score + p.expert_bias[lane];
            const int gi = lane >> 3;
            float m1 = v;
            m1 = fmaxf(m1, __shfl_xor(m1, 1)); m1 = fmaxf(m1, __shfl_xor(m1, 2)); m1 = fmaxf(m1, __shfl_xor(m1, 4));
            const unsigned long long eq = __ballot(v == m1);
            const unsigned gbits = (unsigned)((eq >> (gi * 8)) & 0xffull);
            const bool first = (lane & 7) == (__ffs((int)gbits) - 1);
            float v2 = first ? -INFINITY : v;
            v2 = fmaxf(v2, __shfl_xor(v2, 1)); v2 = fmaxf(v2, __shfl_xor(v2, 2)); v2 = fmaxf(v2, __shfl_xor(v2, 4));
            const float gs = m1 + v2;
            int gr = 0;
#pragma unroll
            for (int j = 0; j < 8; ++j) { const float gj = __shfl(gs, j * 8); gr += (gj > gs || (gj == gs && j < gi)) ? 1 : 0; }
            const float mv = (gr < 4) ? v : -INFINITY;
            int rk = 0;
#pragma unroll
            for (int j = 0; j < 64; ++j) { const float vj = __shfl(mv, j); rk += (vj > mv || (vj == mv && j < lane)) ? 1 : 0; }
            const bool sel = (rk < 8) && (gr < 4);
            const float gsum = wave_sum(sel ? score : 0.f);
            if (sel) {
                const int slot = atomicAdd(&CNT[lane], 1);
                ((int*)(p.ws + OFF_EIDX))[token * 8 + rk] = lane;
                ((int*)(p.ws + OFF_ESLOT))[token * 8 + rk] = slot;
                ((float*)(p.ws + OFF_GATE))[token * 8 + rk] = score / gsum * 2.5f;
                ((int*)(p.ws + OFF_TOKL))[(size_t)lane * NX + slot] = token;
            }
        }
        __syncthreads();
    }
}

constexpr int LE_TAB = 131072;
__device__ __forceinline__ void build_expert_tables(LDSP unsigned char* lds, const Params& p) {
    LDSP int* TP = (LDSP int*)(lds + LE_TAB); LDSP int* ST = TP + 72; LDSP int* CN = ST + 72;
    if (threadIdx.x == 0) {
        const int* CNT = (const int*)(p.ws + OFF_CTL + 16384);
        int tp = 0, st = 0;
        for (int e = 0; e < NEX; ++e) { const int cn = (e < NE) ? CNT[e] : NX; TP[e] = tp; ST[e] = st; CN[e] = cn; tp += (cn + 255) >> 8; st += cn; }
        TP[NEX] = tp; ST[NEX] = st;
    }
    __syncthreads();
}

__device__ void phase8(LDSP unsigned char* lds, const Params& p) {
    build_expert_tables(lds, p);
    const LDSP int* TP = (const LDSP int*)(lds + LE_TAB); const LDSP int* ST = TP + 72; const LDSP int* CN = ST + 72;
    const int total = TP[NEX] * 4;
    for (int u = blockIdx.x; u < total; u += gridDim.x) {
        const int nt = u & 3, mtg = u >> 2;
        int e = 0;
        while (TP[e + 1] <= mtg) ++e;
        const int mt = mtg - TP[e], cn = CN[e];
        EpiH1 epi{(bf16_t*)(p.ws + OFF_H1), ST[e], mt * 256, cn};
        const int* rowmap = (e < NE) ? (const int*)(p.ws + OFF_TOKL) + (size_t)e * NX : nullptr;
        gemm256(lds, (const bf16_t*)(p.ws + OFF_H2), D, rowmap, cn, (const bf16_t*)(p.ws + OFF_WTE1) + (size_t)e * 1024 * 2048, D, D, mt * 256, nt * 256, epi);
    }
}
__device__ void phase9(LDSP unsigned char* lds, const Params& p) {
    build_expert_tables(lds, p);
    const LDSP int* TP = (const LDSP int*)(lds + LE_TAB); const LDSP int* ST = TP + 72; const LDSP int* CN = ST + 72;
    const int total = TP[NEX] * 8;
    for (int u = blockIdx.x; u < total; u += gridDim.x) {
        const int nt = u & 7, mtg = u >> 3;
        int e = 0;
        while (TP[e + 1] <= mtg) ++e;
        const int mt = mtg - TP[e], cn = CN[e];
        EpiEO epi{(bf16_t*)(p.ws + OFF_EO) + (size_t)ST[e] * D, 0, cn};
        gemm256(lds, (const bf16_t*)(p.ws + OFF_H1) + (size_t)ST[e] * EFF, EFF, nullptr, 0, (const bf16_t*)(p.ws + OFF_WTE2) + (size_t)e * 2048 * 512, EFF, EFF, mt * 256, nt * 256, epi);
    }
}
__device__ void phase10(LDSP unsigned char* lds, const Params& p) {
    build_expert_tables(lds, p);
    const LDSP int* ST = (const LDSP int*)(lds + LE_TAB) + 72;
    const int tid = threadIdx.x, wid = tid >> 6, lane = tid & 63;
    const float* MOD = (const float*)(p.ws + OFF_MOD);
    const float* X1 = (const float*)(p.ws + OFF_X1);
    const bf16_t* EO = (const bf16_t*)(p.ws + OFF_EO);
    for (int row = blockIdx.x * 8 + wid; row < NX; row += gridDim.x * 8) {
        unsigned er[9]; float gw[9];
#pragma unroll
        for (int k = 0; k < 8; ++k) { const int e = ((const int*)(p.ws + OFF_EIDX))[row * 8 + k], sl = ((const int*)(p.ws + OFF_ESLOT))[row * 8 + k];
            er[k] = (unsigned)(ST[e] + sl) * (unsigned)D; gw[k] = ((const float*)(p.ws + OFF_GATE))[row * 8 + k]; }
        er[8] = (unsigned)(ST[NE] + row) * (unsigned)D; gw[8] = 1.f;
        const float* md = MOD + (size_t)(row >> 12) * 12288 + 5 * D;
        LDSP float* RB = (LDSP float*)lds + wid * 2048;
        float ss = 0.f;
#pragma unroll 1
        for (int i = 0; i < 8; ++i) { const int col = 4 * (lane + 64 * i);
            f32x4 a = mk4f(0.f, 0.f, 0.f, 0.f);
#pragma unroll
            for (int k = 0; k < 9; ++k) { const u32x2 w = *(const u32x2*)(EO + er[k] + col);
                a.x += gw[k] * bf2f(w.x & 0xffff); a.y += gw[k] * bf2f(w.x >> 16); a.z += gw[k] * bf2f(w.y & 0xffff); a.w += gw[k] * bf2f(w.y >> 16); }
            const f32x4 x1 = *(const f32x4*)(X1 + (size_t)row * D + col), g2 = *(const f32x4*)(md + col);
            f32x4 xv; xv.x = x1.x + g2.x * a.x; xv.y = x1.y + g2.y * a.y; xv.z = x1.z + g2.z * a.z; xv.w = x1.w + g2.w * a.w;
            ss += xv.x * xv.x + xv.y * xv.y + xv.z * xv.z + xv.w * xv.w;
            *(LDSP f32x4*)(RB + col) = xv; }
        ss = wave_sum(ss); const float rs = rsqrtf(ss * (1.f / D) + 1e-6f);
#pragma unroll 1
        for (int i = 0; i < 8; ++i) { const int col = 4 * (lane + 64 * i); const f32x4 g = *(const f32x4*)(p.final_g + col);
            const f32x4 xv = *(const LDSP f32x4*)(RB + col);
            f32x4 o; o.x = xv.x * rs * g.x; o.y = xv.y * rs * g.y; o.z = xv.z * rs * g.z; o.w = xv.w * rs * g.w;
            *(f32x4*)(p.out + (size_t)row * D + col) = o; }
    }
}

__global__ void __launch_bounds__(512, 2) fwd_megakernel(Params p) {
    __shared__ __attribute__((aligned(16))) unsigned char smem_raw[SMEM_BYTES];
    LDSP unsigned char* lds = (LDSP unsigned char*)smem_raw;
    cg::grid_group grid = cg::this_grid();
#ifndef PH_MASK
#define PH_MASK 0x7ff
#endif
    if (PH_MASK & 1) { Params q = p; q.ws = opq(p.ws); phase0(lds, q); }
    grid.sync();
    if (PH_MASK & 2) { Params q = p; q.ws = opq(p.ws); phase1(lds, q); }
    grid.sync();
    if (PH_MASK & 4) { Params q = p; q.ws = opq(p.ws); phase2(lds, q); }
    grid.sync();
    if (PH_MASK & 8) { Params q = p; q.ws = opq(p.ws); phase3(lds, q); }
    grid.sync();
    if (PH_MASK & 16) { Params q = p; q.ws = opq(p.ws); phase4(lds, q); }
    grid.sync();
    if (PH_MASK & 32) { Params q = p; q.ws = opq(p.ws); phase5(lds, q); }
    grid.sync();
    if (PH_MASK & 64) { Params q = p; q.ws = opq(p.ws); phase6(lds, q); }
    grid.sync();
    if (PH_MASK & 128) { Params q = p; q.ws = opq(p.ws); phase7(lds, q); }
    grid.sync();
    if (PH_MASK & 256) { Params q = p; q.ws = opq(p.ws); phase8(lds, q); }
    grid.sync();
    if (PH_MASK & 512) { Params q = p; q.ws = opq(p.ws); phase9(lds, q); }
    grid.sync();
    if (PH_MASK & 1024) { Params q = p; q.ws = opq(p.ws); phase10(lds, q); }
}

extern "C" void kernel_launch(void* const* d_in, const int* in_sizes, int n_in, void* d_out, int out_size, void* d_ws, size_t ws_size, hipStream_t stream) {
    static int grid_blocks = 0;
    if (!grid_blocks) {
        int dev = 0, cus = 0, per_cu = 0;
        (void)hipGetDevice(&dev);
        (void)hipDeviceGetAttribute(&cus, hipDeviceAttributeMultiprocessorCount, dev);
        (void)hipOccupancyMaxActiveBlocksPerMultiprocessor(&per_cu, fwd_megakernel, 512, 0);
        if (per_cu > 1) per_cu = 1;
        grid_blocks = cus * per_cu;
        if (ws_size < WS_END) fprintf(stderr, "workspace too small: %zu < %zu\n", ws_size, (size_t)WS_END);
    }
    Params p{};
    const float** f = (const float**)&p;
    for (int i = 0; i < 31; ++i) f[i] = (const float*)d_in[i];
    p.out = (float*)d_out; p.ws = (unsigned char*)d_ws;
    (void)hipMemsetAsync(d_ws, 0, 32768, stream);
    void* args[] = {&p};
    hipError_t e = hipLaunchCooperativeKernel((void*)fwd_megakernel, dim3(grid_blocks), dim3(512), args, 0, stream);
    if (e != hipSuccess) fprintf(stderr, "cooperative launch failed: %s (grid %d)\n", hipGetErrorString(e), grid_blocks);
}
```

```cpp
#include <hip/hip_runtime.h>
#include <hip/hip_cooperative_groups.h>
#include <cstdio>
#include <cstdint>
namespace cg = cooperative_groups;

#define LDSP __attribute__((address_space(3)))
typedef unsigned short bf16_t;
typedef short bf16x8 __attribute__((ext_vector_type(8)));
typedef float f32x4 __attribute__((ext_vector_type(4)));
typedef float f32x16 __attribute__((ext_vector_type(16)));
typedef unsigned u32x4 __attribute__((ext_vector_type(4)));
typedef unsigned u32x2 __attribute__((ext_vector_type(2)));
__device__ __forceinline__ u32x4 mk4u(unsigned a, unsigned b, unsigned c, unsigned d) { u32x4 r; r.x = a; r.y = b; r.z = c; r.w = d; return r; }
__device__ __forceinline__ u32x2 mk2u(unsigned a, unsigned b) { u32x2 r; r.x = a; r.y = b; return r; }
__device__ __forceinline__ f32x4 mk4f(float a, float b, float c, float d) { f32x4 r; r.x = a; r.y = b; r.z = c; r.w = d; return r; }

constexpr int D = 2048, NB = 2, T = 4096, CL = 256, NX = NB * T, NCX = NB * CL, NR = NX + NCX;
constexpr int INC = 5056, INP = 5120;
constexpr int C_R = 0, C_K = 1024, C_V = 2048, C_XW = 3072, C_XA = 3168, C_XG = 3264, C_Q = 3520, C_AK = 4544, C_AV = 4800;
constexpr int NE = 64, NEX = 65, EFF = 512;
constexpr int NCHUNK = 68;
constexpr int NINST = NB * 16 * 2 * NCHUNK;
constexpr int EROWS = NX * 8 + NX;

constexpr size_t al4k(size_t x) { return (x + 4095) & ~(size_t)4095; }
constexpr size_t OFF_CTL = 0;
constexpr size_t OFF_ROPE = 65536;
constexpr size_t OFF_MODP = OFF_ROPE + 8192;
constexpr size_t OFF_MOD = al4k(OFF_MODP + (size_t)16 * 3 * 12288 * 4);
constexpr size_t OFF_WTDU = al4k(OFF_MOD + (size_t)3 * 12288 * 4);
constexpr size_t OFF_WTIU = OFF_WTDU + (size_t)2 * 1024 * 128 * 2;
constexpr size_t OFF_WTGU = OFF_WTIU + (size_t)2 * 1024 * 128 * 2;
constexpr size_t OFF_WTE2 = OFF_WTGU + (size_t)1024 * 256 * 2;
constexpr size_t OFF_X1 = OFF_WTE2 + (size_t)NEX * 2048 * 512 * 2;
constexpr size_t OFF_H2 = OFF_X1 + (size_t)NX * D * 4;
constexpr size_t OFF_TOKL = OFF_H2 + (size_t)NX * D * 2;
constexpr size_t OFF_EIDX = OFF_TOKL + (size_t)NE * NX * 4;
constexpr size_t OFF_ESLOT = OFF_EIDX + (size_t)NX * 8 * 4;
constexpr size_t OFF_GATE = OFF_ESLOT + (size_t)NX * 8 * 4;
constexpr size_t OFF_H1 = OFF_GATE + (size_t)NX * 8 * 4;
constexpr size_t OFF_WTE1 = al4k(OFF_H1 + (size_t)(EROWS + 256) * EFF * 2);
constexpr size_t OFF_EO = OFF_WTE1;
constexpr size_t OFF_WTIN = OFF_WTE1 + (size_t)NEX * 1024 * 2048 * 2;
constexpr size_t OFF_WTOUT = OFF_WTIN + (size_t)INP * D * 2;
constexpr size_t OFF_HX = OFF_WTOUT + (size_t)D * D * 2;
constexpr size_t OFF_PX = OFF_HX + (size_t)NR * D * 2;
constexpr size_t OFF_CM = OFF_PX + (size_t)NR * INP * 2;
constexpr size_t OFF_CN = OFF_CM + (size_t)NINST * 4096 * 2;
constexpr size_t OFF_CP = OFF_CN + (size_t)NINST * 4096 * 2;
constexpr size_t OFF_CQ = OFF_CP + (size_t)NINST * 4096 * 2;
constexpr size_t OFF_YD = OFF_CQ + (size_t)NINST * 4096 * 2;
constexpr size_t OFF_BON = OFF_YD + (size_t)2 * NX * 1024 * 4;
constexpr size_t OFF_MIX = OFF_BON + (size_t)2 * NX * 16 * 4;
constexpr size_t WS_END = OFF_MIX + (size_t)NX * D * 2;
constexpr size_t OFF_RS = OFF_X1;
constexpr size_t OFF_KS = OFF_RS + (size_t)NR * 1024 * 2;
constexpr size_t OFF_KK = OFF_KS + (size_t)NR * 1024 * 2;
constexpr size_t OFF_VS = OFF_KK + (size_t)NR * 1024 * 2;
constexpr size_t OFF_TW = OFF_VS + (size_t)NR * 1024 * 2;
constexpr size_t OFF_XA = OFF_TW + (size_t)NR * 128 * 2;
constexpr size_t OFF_SG = OFF_XA + (size_t)NR * 128 * 2;
constexpr size_t OFF_LWG = OFF_SG + (size_t)NX * 256 * 2;
constexpr size_t OFF_AIG = OFF_LWG + (size_t)NR * 2048 * 2;
constexpr size_t OFF_GG = OFF_AIG + (size_t)NR * 2048 * 2;
static_assert(OFF_GG + (size_t)NX * 1024 * 2 <= OFF_WTE1, "RWKV token buffers fit the overlay region");
static_assert(OFF_EO + (size_t)EROWS * D * 2 <= OFF_HX, "EO overlays only WT_E1/WT_IN/WT_OUT");
static_assert(WS_END <= (size_t)1073741824, "workspace map must fit 1 GiB");

constexpr int SMEM_BYTES = 157 * 1024;

struct Params {
    const float *x, *c, *ctx, *c_ctx, *w_mod, *b_mod, *norm1_g, *norm2_g, *w_in, *shift_mu, *k_k, *k_a, *r_k, *decay_bias, *decay_up, *iclr_bias, *iclr_up,
        *gate_up, *lnx_g, *lnx_b, *attn_sink, *w_out, *w_router, *expert_bias, *e_gate, *e_up, *e_down, *s_gate, *s_up, *s_down, *final_g;
    float* out;
    unsigned char* ws;
};

__device__ __forceinline__ unsigned f2bf(float f) { unsigned u = __float_as_uint(f); return (u + 0x7fffu + ((u >> 16) & 1u)) >> 16; }
__device__ __forceinline__ float bf2f(unsigned h) { return __uint_as_float(h << 16); }
__device__ __forceinline__ unsigned pk2(float lo, float hi) { return f2bf(lo) | (f2bf(hi) << 16); }
__device__ __forceinline__ float wave_sum(float v) {
#pragma unroll
    for (int o = 32; o > 0; o >>= 1) v += __shfl_xor(v, o);
    return v;
}
__device__ __forceinline__ int opaque(int x) { asm volatile("" : "+v"(x)); return x; }
__device__ __forceinline__ int opaque_s(int x) { asm volatile("" : "+s"(x)); return x; }
__device__ __forceinline__ unsigned char* opq(unsigned char* x) { asm volatile("" : "+s"(x)); return x; }
__device__ __forceinline__ float sigmoidf_(float x) { return 1.f / (1.f + __expf(-x)); }
__device__ __forceinline__ float softplusf_(float x) { return x > 20.f ? x : log1pf(__expf(x)); }
__device__ __forceinline__ int lds_byte(int r, int c) { const int st = (r >> 4) * 2 + (c >> 5), rr = r & 15, cc = c & 31, ob = rr * 64 + cc * 2; return st * 1024 + (ob ^ (((ob >> 9) & 1) << 5)); }
__device__ __forceinline__ int sw64(int r, int k) { return r * 128 + ((((k >> 3) ^ (r >> 1)) & 7) << 4) + (k & 7) * 2; }
__device__ __forceinline__ int sw128(int r, int k) { return r * 256 + ((((k >> 3) ^ r) & 15) << 4) + (k & 7) * 2; }
__device__ __forceinline__ int sw256(int r, int k) { const int ch = k >> 3; return r * 512 + (((ch & 16) | ((ch ^ r) & 15)) << 4) + (k & 7) * 2; }

__device__ __forceinline__ f32x16 zero16() { f32x16 z;
#pragma unroll
    for (int i = 0; i < 16; ++i) z[i] = 0.f; return z; }
__device__ __forceinline__ int crow(int reg, int hi) { return (reg & 3) + 8 * (reg >> 2) + 4 * hi; }

__device__ __forceinline__ f32x16 mm32_k64(const LDSP unsigned char* A, int arow0, const LDSP unsigned char* B, int brow0, f32x16 acc, int lane) {
    const int r = lane & 31, h = lane >> 5;
#pragma unroll
    for (int s = 0; s < 4; ++s) {
        const bf16x8 a = *(const LDSP bf16x8*)(A + sw64(arow0 + r, 16 * s + 8 * h));
        const bf16x8 b = *(const LDSP bf16x8*)(B + sw64(brow0 + r, 16 * s + 8 * h));
        acc = __builtin_amdgcn_mfma_f32_32x32x16_bf16(a, b, acc, 0, 0, 0);
    }
    return acc;
}

template <class Epi>
__device__ __forceinline__ void gemm256(LDSP unsigned char* lds, const bf16_t* A, int lda, const int* rowmap, int nvalid, const bf16_t* Bt, int ldb, int K, int m0, int n0,
                                        const Epi& epi) {
    const int tid = opaque(threadIdx.x), wid = tid >> 6, lane = tid & 63, wr = wid >> 2, wc = wid & 3, fr = lane & 15, fq = lane >> 4;
    const int lr = tid >> 3, lc = (tid & 7) * 8;
    unsigned aoff[4], boff[4];
#pragma unroll
    for (int i = 0; i < 4; ++i) {
        const int r = lr + 64 * i;
        int gr = m0 + r;
        if (rowmap) gr = (gr < nvalid) ? rowmap[gr] : 0;
        aoff[i] = (unsigned)gr * (unsigned)lda + lc;
        boff[i] = (unsigned)(n0 + r) * (unsigned)ldb + lc;
    }
    const int wo = lds_byte(lr, lc);
    const int swz = lds_byte(fr, fq * 8);
    u32x4 rg[4];
    f32x4 acc[8][4];
#pragma unroll
    for (int m = 0; m < 8; ++m)
#pragma unroll
        for (int n = 0; n < 4; ++n) acc[m][n] = (f32x4){0.f, 0.f, 0.f, 0.f};
    const int nt = K >> 6;
#pragma unroll
    for (int i = 0; i < 4; ++i) rg[i] = *(const u32x4*)(A + aoff[i]);
#pragma unroll
    for (int i = 0; i < 4; ++i) *(LDSP u32x4*)(lds + wo + 8192 * i) = rg[i];
#pragma unroll
    for (int i = 0; i < 4; ++i) rg[i] = *(const u32x4*)(Bt + boff[i]);
#pragma unroll
    for (int i = 0; i < 4; ++i) *(LDSP u32x4*)(lds + 32768 + wo + 8192 * i) = rg[i];
    __syncthreads();
#pragma unroll 1
    for (int t = 0; t < nt; ++t) {
        const int s = t & 1;
        const bool more = (t + 1 < nt);
        const LDSP unsigned char* bA = lds + s * 65536 + swz;
        const LDSP unsigned char* bB = lds + s * 65536 + 32768 + swz;
        LDSP unsigned char* w = lds + (s ^ 1) * 65536 + wo;
#pragma unroll
        for (int ks = 0; ks < 2; ++ks) {
            if (more) {
                if (ks == 0) {
#pragma unroll
                    for (int i = 0; i < 4; ++i) rg[i] = *(const u32x4*)(A + aoff[i] + (t + 1) * 64);
                } else {
#pragma unroll
                    for (int i = 0; i < 4; ++i) rg[i] = *(const u32x4*)(Bt + boff[i] + (t + 1) * 64);
                }
            }
            bf16x8 a[4], b[4];
#pragma unroll
            for (int n = 0; n < 4; ++n) b[n] = *(const LDSP bf16x8*)(bB + ((wc * 4 + n) * 2 + ks) * 1024);
#pragma unroll
            for (int mh = 0; mh < 2; ++mh) {
#pragma unroll
                for (int m = 0; m < 4; ++m) a[m] = *(const LDSP bf16x8*)(bA + ((wr * 8 + mh * 4 + m) * 2 + ks) * 1024);
#pragma unroll
                for (int m = 0; m < 4; ++m)
#pragma unroll
                    for (int n = 0; n < 4; ++n) acc[mh * 4 + m][n] = __builtin_amdgcn_mfma_f32_16x16x32_bf16(b[n], a[m], acc[mh * 4 + m][n], 0, 0, 0);
            }
            if (more) {
#pragma unroll
                for (int i = 0; i < 4; ++i) *(LDSP u32x4*)(w + (ks ? 32768 : 0) + 8192 * i) = rg[i];
            }
        }
        __syncthreads();
    }
#pragma unroll
    for (int m = 0; m < 8; ++m)
#pragma unroll
        for (int n = 0; n < 4; ++n) epi(m0 + wr * 128 + m * 16 + fr, n0 + wc * 64 + n * 16 + fq * 4, acc[m][n]);
}


namespace pg8 {
constexpr int BM = 256, BK = 64, HALF = 128, HTB = HALF * BK * 2, NXCD = 8;
__device__ __forceinline__ void stage_rc(int b, int& R, int& C) { const int st = b / 1024, sb = b % 1024, swz = sb ^ (((sb >> 9) & 1) << 5); R = (st >> 1) * 16 + swz / 64; C = (st & 1) * 32 + (swz % 64) / 2; }
struct Unit { const char* A; const char* B; const int* rowmap; int nvalid, m0, row0, col0, pos0; };
__device__ __forceinline__ int xcd_remap(int L, int nwg) { const int q = nwg / NXCD, r = nwg % NXCD, xcd = L % NXCD, off = L / NXCD; return (xcd < r ? xcd * (q + 1) : r * (q + 1) + (xcd - r) * q) + off; }

template <class F> struct Epi {
    F f;
    __device__ __forceinline__ void operator()(const f32x4 (&acc)[2][2][4][2], const Unit& u, int wr, int wc, int fr, int fq) const {
#pragma unroll
        for (int ai = 0; ai < 2; ++ai)
#pragma unroll
            for (int m = 0; m < 4; ++m)
#pragma unroll
                for (int bj = 0; bj < 2; ++bj)
#pragma unroll
                    for (int n = 0; n < 2; ++n) f(u, 128 * ai + 64 * wr + 16 * m + fr, 128 * bj + 32 * wc + 16 * n + 4 * fq, acc[ai][bj][m][n]);
    }
};

template <bool GATHER, class EpiT, class Sched>
__device__ __forceinline__ void gemm_phase(LDSP unsigned char* lds, const int K, const Sched& S, const EpiT& E) {
    const int tid = opaque(threadIdx.x), wid = __builtin_amdgcn_readfirstlane(tid >> 6), lane = tid & 63, wr = wid >> 2, wc = wid & 3, fr = lane & 15, fq = lane >> 4;
    const int nt = K / BK;
    unsigned voffA[2], voffB[2];
#pragma unroll
    for (int i = 0; i < 2; ++i) { int R, C; stage_rc(tid * 16 + i * 8192, R, C); voffA[i] = (unsigned)(R * K + C) * 2u; voffB[i] = voffA[i]; }
    const size_t kstep = (size_t)(BK * 2);
    const size_t hstep = (size_t)HALF * K * 2;
    const unsigned ldsw = (unsigned)wid * 1024u;
    const int aoff = lds_byte(wr * 64 + fr, fq * 8), boff = lds_byte(wc * 32 + fr, fq * 8);
#define PG8_SA(b, h) (((b) * 2 + (h)) * HTB)
#define PG8_SB(b, h) ((4 + (b) * 2 + (h)) * HTB)
#define PG8_STAGE(bufoff, gbase, voff) do { _Pragma("unroll") for (int _i = 0; _i < 2; ++_i) \
        __builtin_amdgcn_global_load_lds((const unsigned*)((const char*)(gbase) + (voff)[_i]), (LDSP unsigned*)(lds + (bufoff) + ldsw + _i * 8192), 16, 0, 0); } while (0)
#define PG8_STAGE_A(bufoff, nx, h, ubase, koff) do { if constexpr (GATHER) { unsigned _v[2]; const LDSP unsigned* _ro = rowoff + ((((nx) ? (ui + 1) : ui) & 1) * 4 + (h) * 2) * 512; _v[0] = _ro[0]; _v[1] = _ro[512]; PG8_STAGE(bufoff, (ubase) + (koff), _v); } \
        else { PG8_STAGE(bufoff, (ubase) + (h) * hstep + (koff), voffA); } } while (0)
#define PG8_LDA(dst, b, h) do { _Pragma("unroll") for (int m = 0; m < 4; ++m) _Pragma("unroll") for (int k = 0; k < 2; ++k) dst[m][k] = *(const LDSP bf16x8*)(lds + PG8_SA(b, h) + aoff + m * 2048 + k * 1024); } while (0)
#define PG8_LDB(dst, b, h) do { _Pragma("unroll") for (int n = 0; n < 2; ++n) _Pragma("unroll") for (int k = 0; k < 2; ++k) dst[n][k] = *(const LDSP bf16x8*)(lds + PG8_SB(b, h) + boff + n * 2048 + k * 1024); } while (0)
#define PG8_MMA(ai, bj, At, Bt) do { __builtin_amdgcn_s_setprio(1); _Pragma("unroll") for (int m = 0; m < 4; ++m) _Pragma("unroll") for (int n = 0; n < 2; ++n) _Pragma("unroll") for (int k = 0; k < 2; ++k) \
        acc[ai][bj][m][n] = __builtin_amdgcn_mfma_f32_16x16x32_bf16(Bt[n][k], At[m][k], acc[ai][bj][m][n], 0, 0, 0); __builtin_amdgcn_s_setprio(0); } while (0)
#define PG8_WAIT_V(n) asm volatile("s_waitcnt vmcnt(" #n ")" ::: "memory")
#define PG8_WAIT_L(n) asm volatile("s_waitcnt lgkmcnt(" #n ")" ::: "memory")
#define PG8_BAR __builtin_amdgcn_s_barrier()
#define PG8_SCHED __builtin_amdgcn_sched_barrier(0)
    Unit cur, nxt; int ui = 0;
    if (!S.next(0, cur)) return;
    LDSP unsigned* rowoff = (LDSP unsigned*)(lds + 132096) + tid;
    auto rows_of = [&](const Unit& u, int slot) {
        if constexpr (GATHER) {
#pragma unroll
            for (int h = 0; h < 2; ++h)
#pragma unroll
                for (int i = 0; i < 2; ++i) { int R, C; stage_rc(tid * 16 + i * 8192, R, C); const int idx = u.m0 + h * HALF + R; int gr = idx; if (u.rowmap) gr = (idx < u.nvalid) ? u.rowmap[idx] : 0;
                    rowoff[((slot & 1) * 4 + h * 2 + i) * 512] = (unsigned)(gr * K + C) * 2u; }
        }
    };
    rows_of(cur, 0);
    f32x4 acc[2][2][4][2];
#pragma unroll
    for (int a = 0; a < 2; ++a)
#pragma unroll
        for (int b = 0; b < 2; ++b)
#pragma unroll
            for (int m = 0; m < 4; ++m)
#pragma unroll
                for (int n = 0; n < 2; ++n) acc[a][b][m][n] = (f32x4){0.f, 0.f, 0.f, 0.f};
    bf16x8 At[4][2], B0[2][2], B1[2][2];
    const char* cA = cur.A; const char* cB = cur.B;
    PG8_STAGE(PG8_SB(0, 0), cB, voffB); PG8_STAGE(PG8_SB(0, 1), cB + hstep, voffB); PG8_STAGE_A(PG8_SA(0, 0), false, 0, cA, 0); PG8_STAGE_A(PG8_SA(0, 1), false, 1, cA, 0);
    if (wr == 1) PG8_BAR;
    PG8_WAIT_V(2); PG8_BAR;
    PG8_STAGE(PG8_SB(1, 0), cB + kstep, voffB); PG8_STAGE_A(PG8_SA(1, 0), false, 0, cA, kstep); PG8_STAGE(PG8_SB(1, 1), cB + hstep + kstep, voffB);
    PG8_WAIT_V(6); PG8_BAR;
    for (;;) {
        const bool has_next = S.next(ui + 1, nxt);
        rows_of(has_next ? nxt : cur, ui + 1);
        const char* nA = has_next ? nxt.A : cA; const char* nB = has_next ? nxt.B : cB;
#pragma unroll 1
        for (int t = 0; t < nt; t += 2) {
            const bool last = (t == nt - 2);
            const size_t k1 = (size_t)(t + 1) * kstep;
            const char* a2 = last ? nA : cA; const size_t k2 = last ? 0 : (size_t)(t + 2) * kstep;
            const char* b2 = last ? nB : cB + (size_t)(t + 2) * kstep;
            const char* b3 = b2 + kstep;
            PG8_LDB(B0, 0, 0); PG8_LDB(B1, 0, 1); PG8_SCHED; PG8_LDA(At, 0, 0); PG8_STAGE_A(PG8_SA(1, 1), false, 1, cA, k1);
            PG8_WAIT_V(8); PG8_WAIT_L(0); PG8_BAR; PG8_MMA(0, 0, At, B0); PG8_MMA(0, 1, At, B1); PG8_BAR; PG8_SCHED;
            PG8_LDA(At, 0, 1); PG8_STAGE(PG8_SB(0, 0), b2, voffB); PG8_STAGE(PG8_SB(0, 1), b2 + hstep, voffB); PG8_STAGE_A(PG8_SA(0, 0), last, 0, a2, k2);
            PG8_WAIT_V(8); PG8_WAIT_L(0); PG8_BAR; PG8_MMA(1, 0, At, B0); PG8_MMA(1, 1, At, B1); PG8_BAR; PG8_SCHED;
            PG8_LDB(B0, 1, 0); PG8_LDB(B1, 1, 1); PG8_SCHED; PG8_LDA(At, 1, 0); PG8_STAGE_A(PG8_SA(0, 1), last, 1, a2, k2);
            PG8_WAIT_V(8); PG8_WAIT_L(0); PG8_BAR; PG8_MMA(0, 0, At, B0); PG8_MMA(0, 1, At, B1); PG8_BAR; PG8_SCHED;
            PG8_LDA(At, 1, 1); PG8_STAGE(PG8_SB(1, 0), b3, voffB); PG8_STAGE(PG8_SB(1, 1), b3 + hstep, voffB); PG8_STAGE_A(PG8_SA(1, 0), last, 0, a2, k2 + kstep);
            PG8_WAIT_V(8); PG8_WAIT_L(0); PG8_BAR; PG8_MMA(1, 0, At, B0); PG8_MMA(1, 1, At, B1); PG8_BAR; PG8_SCHED;
        }
        if (wr == 0) PG8_BAR;
        E(acc, cur, wr, wc, fr, fq);
        if (!has_next) break;
#pragma unroll
        for (int a = 0; a < 2; ++a)
#pragma unroll
            for (int b = 0; b < 2; ++b)
#pragma unroll
                for (int m = 0; m < 4; ++m)
#pragma unroll
                    for (int n = 0; n < 2; ++n) acc[a][b][m][n] = (f32x4){0.f, 0.f, 0.f, 0.f};
        cur = nxt; cA = nA; cB = nB; ++ui;
        if (wr == 1) PG8_BAR;
    }
    PG8_WAIT_V(0);
    PG8_BAR;
#undef PG8_SA
#undef PG8_SB
#undef PG8_STAGE
#undef PG8_STAGE_A
#undef PG8_LDA
#undef PG8_LDB
#undef PG8_MMA
#undef PG8_WAIT_V
#undef PG8_WAIT_L
#undef PG8_BAR
#undef PG8_SCHED
}

struct DenseSched {
    const char* A; const char* B; int nM, nN, K, G, c;
    __device__ __forceinline__ bool next(int i, Unit& u) const {
        const int nwg = nM * nN; const long L = (long)i * G + c; if (L >= nwg) return false;
        const int wgid = xcd_remap((int)L, nwg);
        const int nig = 8 * nN, gid = wgid / nig, fm = gid * 8, gsz = (nM - fm) < 8 ? (nM - fm) : 8;
        const int pm = fm + ((wgid % nig) % gsz), pn = (wgid % nig) / gsz;
        u.A = A + (size_t)pm * 256 * K * 2; u.B = B + (size_t)pn * 256 * K * 2; u.rowmap = nullptr; u.nvalid = 0; u.m0 = 0; u.row0 = pm * 256; u.col0 = pn * 256; u.pos0 = 0;
        return true;
    }
};
}

struct EpiPX { bf16_t* PX; __device__ __forceinline__ void operator()(int row, int col, f32x4 v) const {
    u32x2 w; w.x = pk2(v[0], v[1]); w.y = pk2(v[2], v[3]); *(u32x2*)(PX + (size_t)row * INP + col) = w; } };
struct EpiX1 { const float* x; const float* mod; float* X1; __device__ __forceinline__ void operator()(int row, int col, f32x4 v) const {
    const f32x4 xv = *(const f32x4*)(x + (size_t)row * D + col); const f32x4 g = *(const f32x4*)(mod + (size_t)(row >> 12) * 12288 + 2 * D + col);
    *(f32x4*)(X1 + (size_t)row * D + col) = xv + g * v; } };
struct EpiH1 { bf16_t* H1; int pos0, m0, cnt; __device__ __forceinline__ void operator()(int row, int col, f32x4 v) const {
    if (row < cnt) { const float a = v[0] * sigmoidf_(v[0]) * v[2], b = v[1] * sigmoidf_(v[1]) * v[3];
        *(unsigned*)(H1 + (size_t)(pos0 + row) * EFF + (col >> 1)) = pk2(a, b); } } };
struct EpiEO { bf16_t* EO; int pos0, cnt; __device__ __forceinline__ void operator()(int row, int col, f32x4 v) const {
    if (row < cnt) { u32x2 w; w.x = pk2(v[0], v[1]); w.y = pk2(v[2], v[3]); *(u32x2*)(EO + (size_t)(pos0 + row) * D + col) = w; } } };


struct FPX { bf16_t* PX; __device__ __forceinline__ void operator()(const pg8::Unit& u, int lr, int lc, f32x4 v) const {
    u32x2 w; w.x = pk2(v[0], v[1]); w.y = pk2(v[2], v[3]); *(u32x2*)(PX + (size_t)(u.row0 + lr) * INP + u.col0 + lc) = w; } };
struct FX1 { const float* x; const float* mod; float* X1; __device__ __forceinline__ void operator()(const pg8::Unit& u, int lr, int lc, f32x4 v) const {
    const int row = u.row0 + lr, col = u.col0 + lc;
    const f32x4 xv = *(const f32x4*)(x + (size_t)row * D + col); const f32x4 g = *(const f32x4*)(mod + (size_t)(row >> 12) * 12288 + 2 * D + col);
    *(f32x4*)(X1 + (size_t)row * D + col) = xv + g * v; } };
struct FH1 { bf16_t* H1; __device__ __forceinline__ void operator()(const pg8::Unit& u, int lr, int lc, f32x4 v) const {
    if (u.m0 + lr < u.nvalid) { const float a = v[0] * sigmoidf_(v[0]) * v[2], b = v[1] * sigmoidf_(v[1]) * v[3];
        *(unsigned*)(H1 + (size_t)(u.pos0 + u.m0 + lr) * EFF + ((u.col0 + lc) >> 1)) = pk2(a, b); } } };
struct FEO { bf16_t* EO; __device__ __forceinline__ void operator()(const pg8::Unit& u, int lr, int lc, f32x4 v) const {
    if (u.m0 + lr < u.nvalid) { u32x2 w; w.x = pk2(v[0], v[1]); w.y = pk2(v[2], v[3]); *(u32x2*)(EO + (size_t)(u.pos0 + u.m0 + lr) * D + u.col0 + lc) = w; } } };

struct ConvJob { const float* src; bf16_t* dst; int K, N, ld, mode, ntk, ntn; size_t sbs, dbs; };
__device__ __forceinline__ int conv_row(int n, int mode) { return mode == 0 ? n : (4 * (n >> 1) + (n & 1) + (mode == 2 ? 2 : 0)); }

__device__ __forceinline__ void conv_tile(LDSP unsigned char* lds, const ConvJob& J, int tile) {
    const int per = J.ntk * J.ntn, bi = tile / per, rem = tile - bi * per, kt = rem / J.ntn, ntile = rem - kt * J.ntn;
    const float* src = J.src + (size_t)bi * J.sbs; bf16_t* dst = J.dst + (size_t)bi * J.dbs;
    const int k0 = kt * 256, n0 = ntile * 64, tid = opaque(threadIdx.x);
    LDSP float* Tm = (LDSP float*)lds;
    {
        const int kr = tid >> 3, nc = (tid & 7) * 8;
        f32x4 v[4][2];
#pragma unroll
        for (int s = 0; s < 4; ++s) { const float* p = src + (size_t)(k0 + s * 64 + kr) * J.N + n0 + nc; v[s][0] = *(const f32x4*)p; v[s][1] = *(const f32x4*)(p + 4); }
#pragma unroll
        for (int s = 0; s < 4; ++s) { LDSP float* q = Tm + (s * 64 + kr) * 65 + nc;
            q[0] = v[s][0].x; q[1] = v[s][0].y; q[2] = v[s][0].z; q[3] = v[s][0].w; q[4] = v[s][1].x; q[5] = v[s][1].y; q[6] = v[s][1].z; q[7] = v[s][1].w; }
    }
    __syncthreads();
    {
        const int n = tid >> 3; bf16_t* drow = dst + (size_t)conv_row(n0 + n, J.mode) * J.ld + k0;
#pragma unroll
        for (int s = 0; s < 4; ++s) { const int kc = ((tid & 7) + 8 * s) * 8; float f[8];
#pragma unroll
            for (int j = 0; j < 8; ++j) f[j] = Tm[(kc + j) * 65 + n];
            u32x4 w; w.x = pk2(f[0], f[1]); w.y = pk2(f[2], f[3]); w.z = pk2(f[4], f[5]); w.w = pk2(f[6], f[7]); *(u32x4*)(drow + kc) = w; }
    }
    __syncthreads();
}

__device__ __forceinline__ void mod_item(LDSP unsigned char* lds, const Params& p, int item) {
    const int kb = item >> 4, nb = item & 15, tid = opaque(threadIdx.x), wid = tid >> 6, lane = tid & 63;
    f32x4 acc[3][3];
#pragma unroll
    for (int v = 0; v < 3; ++v)
#pragma unroll
        for (int j = 0; j < 3; ++j) acc[v][j] = mk4f(0.f, 0.f, 0.f, 0.f);
#pragma unroll 4
    for (int i = 0; i < 16; ++i) {
        const int k = kb * 128 + wid * 16 + i;
        float s[3]; { const float c0 = p.c[k], c1 = p.c[D + k], c2 = p.c_ctx[k]; s[0] = c0 * sigmoidf_(c0); s[1] = c1 * sigmoidf_(c1); s[2] = c2 * sigmoidf_(c2); }
        const f32x4* wrow = (const f32x4*)(p.w_mod + (size_t)k * 12288 + nb * 768);
#pragma unroll
        for (int j = 0; j < 3; ++j) { const f32x4 w = wrow[lane + 64 * j];
#pragma unroll
            for (int v = 0; v < 3; ++v) { acc[v][j].x += s[v] * w.x; acc[v][j].y += s[v] * w.y; acc[v][j].z += s[v] * w.z; acc[v][j].w += s[v] * w.w; } }
    }
    LDSP float* R = (LDSP float*)lds;
#pragma unroll
    for (int v = 0; v < 3; ++v)
#pragma unroll
        for (int j = 0; j < 3; ++j) *(LDSP f32x4*)(R + (wid * 3 + v) * 768 + 4 * (lane + 64 * j)) = acc[v][j];
    __syncthreads();
    float* MODP = (float*)(p.ws + OFF_MODP);
    for (int o = tid; o < 3 * 768; o += 512) { const int v = o / 768, cidx = o - v * 768; float s = 0.f;
#pragma unroll
        for (int w = 0; w < 8; ++w) s += R[(w * 3 + v) * 768 + cidx];
        MODP[((size_t)kb * 3 + v) * 12288 + nb * 768 + cidx] = s; }
    __syncthreads();
}

__device__ void phase0(LDSP unsigned char* lds, const Params& p) {
    const int tid = opaque(threadIdx.x);
    bf16_t* WTE1 = (bf16_t*)(p.ws + OFF_WTE1); bf16_t* WTE2 = (bf16_t*)(p.ws + OFF_WTE2);
    for (int it = blockIdx.x; it < 256; it += gridDim.x) mod_item(lds, p, it);
    for (int j = 0; j < 9; ++j) {
        ConvJob J;
        switch (j) {
            case 0: J = ConvJob{p.w_in, (bf16_t*)(p.ws + OFF_WTIN), 2048, INC, 2048, 0, 8, INC / 64, 0, 0}; break;
            case 1: J = ConvJob{p.w_out, (bf16_t*)(p.ws + OFF_WTOUT), 2048, 2048, 2048, 0, 8, 32, 0, 0}; break;
            case 2: J = ConvJob{p.e_gate, WTE1, 2048, 512, 2048, 1, 8, 8, (size_t)2048 * 512, (size_t)1024 * 2048}; break;
            case 3: J = ConvJob{p.e_up, WTE1, 2048, 512, 2048, 2, 8, 8, (size_t)2048 * 512, (size_t)1024 * 2048}; break;
            case 4: J = ConvJob{p.e_down, WTE2, 512, 2048, 512, 0, 2, 32, (size_t)512 * 2048, (size_t)2048 * 512}; break;
            case 5: J = ConvJob{p.s_gate, WTE1 + (size_t)64 * 1024 * 2048, 2048, 512, 2048, 1, 8, 8, 0, 0}; break;
            case 6: J = ConvJob{p.s_up, WTE1 + (size_t)64 * 1024 * 2048, 2048, 512, 2048, 2, 8, 8, 0, 0}; break;
            case 7: J = ConvJob{p.s_down, WTE2 + (size_t)64 * 2048 * 512, 512, 2048, 512, 0, 2, 32, 0, 0}; break;
            default: J = ConvJob{p.gate_up, (bf16_t*)(p.ws + OFF_WTGU), 256, 1024, 256, 0, 1, 16, 0, 0}; break;
        }
        const int nbatch = (j >= 2 && j <= 4) ? 64 : 1;
        const int ntiles = nbatch * J.ntk * J.ntn;
        for (int t = blockIdx.x; t < ntiles; t += gridDim.x) conv_tile(lds, J, t);
    }
    {
        const int total = 4 * 1024 * 128;
        for (int idx = blockIdx.x * 512 + tid; idx < total; idx += gridDim.x * 512) {
            const int mtx = idx >> 17, rem = idx & 131071, n = rem >> 7, k = rem & 127;
            const float* src = (mtx < 2 ? p.decay_up : p.iclr_up) + (size_t)(mtx & 1) * 96 * 1024;
            bf16_t* dst = (bf16_t*)(p.ws + (mtx < 2 ? OFF_WTDU : OFF_WTIU)) + (size_t)(mtx & 1) * 1024 * 128;
            dst[n * 128 + k] = (bf16_t)f2bf(k < 96 ? src[(size_t)k * 1024 + n] : 0.f);
        }
    }
    {
        u32x4* z = (u32x4*)((bf16_t*)(p.ws + OFF_WTIN) + (size_t)INC * D);
        const int total = (INP - INC) * D * 2 / 16;
        for (int idx = blockIdx.x * 512 + tid; idx < total; idx += gridDim.x * 512) z[idx] = mk4u(0, 0, 0, 0);
    }
    if (blockIdx.x == gridDim.x - 1) {
        float2* R = (float2*)(p.ws + OFF_ROPE);
        for (int idx = tid; idx < 1024; idx += 512) { const int pos = idx >> 4, f = idx & 15;
            const float freq = powf(10000.f, -(float)f / 16.f); const float ang = (float)pos * freq; R[idx] = make_float2(cosf(ang), sinf(ang)); }
    }
}

__device__ void phase1(LDSP unsigned char* lds, const Params& p) {
    const int tid = opaque(threadIdx.x), wid = tid >> 6, lane = tid & 63;
    const float* MODP = (const float*)(p.ws + OFF_MODP);
    float* MOD = (float*)(p.ws + OFF_MOD);
    LDSP float* MV = (LDSP float*)lds;
    for (int idx = tid; idx < 3 * 4096; idx += 512) { const int v = idx >> 12, col = idx & 4095; float s = p.b_mod[col];
#pragma unroll
        for (int kb = 0; kb < 16; ++kb) s += MODP[((size_t)kb * 3 + v) * 12288 + col];
        MV[idx] = s; }
    for (int idx = blockIdx.x * 512 + tid; idx < 3 * 12288; idx += gridDim.x * 512) { const int v = idx / 12288, col = idx - v * 12288; float s = p.b_mod[col];
#pragma unroll
        for (int kb = 0; kb < 16; ++kb) s += MODP[((size_t)kb * 3 + v) * 12288 + col];
        MOD[idx] = s; }
    __syncthreads();
    bf16_t* HX = (bf16_t*)(p.ws + OFF_HX);
    for (int row = blockIdx.x * 8 + wid; row < NR; row += gridDim.x * 8) {
        const float* src = row < NX ? p.x + (size_t)row * D : p.ctx + (size_t)(row - NX) * D;
        const int v = row < NX ? (row >> 12) : 2;
        f32x4 xv[8]; float ss = 0.f;
#pragma unroll
        for (int i = 0; i < 8; ++i) { xv[i] = ((const f32x4*)src)[lane + 64 * i]; ss += xv[i].x * xv[i].x + xv[i].y * xv[i].y + xv[i].z * xv[i].z + xv[i].w * xv[i].w; }
        ss = wave_sum(ss);
        const float rs = rsqrtf(ss * (1.f / D) + 1e-6f);
#pragma unroll
        for (int i = 0; i < 8; ++i) { const int col = 4 * (lane + 64 * i);
            const f32x4 g = *(const f32x4*)(p.norm1_g + col); const LDSP float* sh = MV + v * 4096 + col; const LDSP float* sc = sh + 2048;
            const float h0 = xv[i].x * rs * g.x * (1.f + sc[0]) + sh[0], h1 = xv[i].y * rs * g.y * (1.f + sc[1]) + sh[1];
            const float h2 = xv[i].z * rs * g.z * (1.f + sc[2]) + sh[2], h3 = xv[i].w * rs * g.w * (1.f + sc[3]) + sh[3];
            u32x2 w; w.x = pk2(h0, h1); w.y = pk2(h2, h3); *(u32x2*)(HX + (size_t)row * D + col) = w; }
    }
}

__device__ void phase2(LDSP unsigned char* lds, const Params& p) {
    pg8::Epi<FPX> epi{FPX{(bf16_t*)(p.ws + OFF_PX)}};
    pg8::DenseSched S{(const char*)(p.ws + OFF_HX), (const char*)(p.ws + OFF_WTIN), NR / 256, INP / 256, D, (int)gridDim.x, (int)blockIdx.x};
    pg8::gemm_phase<false>(lds, D, S, epi);
}

__device__ __forceinline__ float px_shift(const bf16_t* PX, const float* mu, int row, int s0, int len, int col) {
    const float c = bf2f(PX[(size_t)row * INP + col]);
    const float pv = (row > s0) ? bf2f(PX[(size_t)(row - 1) * INP + col]) : 0.f;
    const float nx = (row + 1 < s0 + len) ? bf2f(PX[(size_t)(row + 1) * INP + col]) : 0.f;
    return c + mu[col] * (0.5f * (pv + nx) - c);
}

__device__ void phaseR1(LDSP unsigned char* lds, const Params& p) {
    const int tid = opaque(threadIdx.x), wid = tid >> 6, lane = tid & 63;
    const bf16_t* PX = (const bf16_t*)(p.ws + OFF_PX);
    for (int row = blockIdx.x * 8 + wid; row < NR; row += gridDim.x * 8) {
        const bool isx = row < NX;
        const int s0 = isx ? (row & ~(T - 1)) : NX + ((row - NX) & ~(CL - 1)), len = isx ? T : CL;
        const bool hp = row > s0, hn = row + 1 < s0 + len;
        const bf16_t* pc = PX + (size_t)row * INP;
#pragma unroll 1
        for (int it = 0; it < 7; ++it) {
            const int ch = lane + 64 * it;
            if (ch < 440) {
                const int col = ch * 8;
                const u32x4 c4 = *(const u32x4*)(pc + col);
                u32x4 p4 = mk4u(0, 0, 0, 0), n4 = mk4u(0, 0, 0, 0);
                if (hp) p4 = *(const u32x4*)(pc - INP + col);
                if (hn) n4 = *(const u32x4*)(pc + INP + col);
                const f32x4 m0 = *(const f32x4*)(p.shift_mu + col), m1 = *(const f32x4*)(p.shift_mu + col + 4);
                const float mu[8] = {m0.x, m0.y, m0.z, m0.w, m1.x, m1.y, m1.z, m1.w};
                const unsigned cw[4] = {c4.x, c4.y, c4.z, c4.w}, pw[4] = {p4.x, p4.y, p4.z, p4.w}, nw[4] = {n4.x, n4.y, n4.z, n4.w};
                float v[8];
#pragma unroll
                for (int j = 0; j < 4; ++j) {
                    const float c0 = bf2f(cw[j] & 0xffff), c1 = bf2f(cw[j] >> 16);
                    v[2 * j] = c0 + mu[2 * j] * (0.5f * (bf2f(pw[j] & 0xffff) + bf2f(nw[j] & 0xffff)) - c0);
                    v[2 * j + 1] = c1 + mu[2 * j + 1] * (0.5f * (bf2f(pw[j] >> 16) + bf2f(nw[j] >> 16)) - c1);
                }
                if (it < 2) {
                    *(u32x4*)((bf16_t*)(p.ws + OFF_RS) + (size_t)row * 1024 + col) = mk4u(pk2(v[0], v[1]), pk2(v[2], v[3]), pk2(v[4], v[5]), pk2(v[6], v[7]));
                } else if (it < 4) {
                    const int kc = col - C_K;
                    *(u32x4*)((bf16_t*)(p.ws + OFF_KS) + (size_t)row * 1024 + kc) = mk4u(pk2(v[0], v[1]), pk2(v[2], v[3]), pk2(v[4], v[5]), pk2(v[6], v[7]));
                    const f32x4 k0 = *(const f32x4*)(p.k_k + kc), k1 = *(const f32x4*)(p.k_k + kc + 4);
                    const float kq[8] = {k0.x, k0.y, k0.z, k0.w, k1.x, k1.y, k1.z, k1.w};
                    float ss = 0.f;
#pragma unroll
                    for (int j = 0; j < 8; ++j) { v[j] *= kq[j]; ss += v[j] * v[j]; }
                    ss += __shfl_xor(ss, 1); ss += __shfl_xor(ss, 2); ss += __shfl_xor(ss, 4);
                    const float sc = rsqrtf(ss + 1e-12f);
                    *(u32x4*)((bf16_t*)(p.ws + OFF_KK) + (size_t)row * 1024 + kc) = mk4u(pk2(v[0] * sc, v[1] * sc), pk2(v[2] * sc, v[3] * sc), pk2(v[4] * sc, v[5] * sc), pk2(v[6] * sc, v[7] * sc));
                } else if (it < 6) {
                    *(u32x4*)((bf16_t*)(p.ws + OFF_VS) + (size_t)row * 1024 + col - C_V) = mk4u(pk2(v[0], v[1]), pk2(v[2], v[3]), pk2(v[4], v[5]), pk2(v[6], v[7]));
                } else if (ch < 396) {
#pragma unroll
                    for (int j = 0; j < 8; ++j) v[j] = tanhf(v[j]);
                    *(u32x4*)((bf16_t*)(p.ws + OFF_TW) + (size_t)row * 128 + col - C_XW) = mk4u(pk2(v[0], v[1]), pk2(v[2], v[3]), pk2(v[4], v[5]), pk2(v[6], v[7]));
                } else if (ch < 408) {
                    *(u32x4*)((bf16_t*)(p.ws + OFF_XA) + (size_t)row * 128 + col - C_XA) = mk4u(pk2(v[0], v[1]), pk2(v[2], v[3]), pk2(v[4], v[5]), pk2(v[6], v[7]));
                } else if (isx) {
#pragma unroll
                    for (int j = 0; j < 8; ++j) v[j] = sigmoidf_(v[j]);
                    *(u32x4*)((bf16_t*)(p.ws + OFF_SG) + (size_t)row * 256 + col - C_XG) = mk4u(pk2(v[0], v[1]), pk2(v[2], v[3]), pk2(v[4], v[5]), pk2(v[6], v[7]));
                }
            }
        }
        if (lane < 4) { *(u32x4*)((bf16_t*)(p.ws + OFF_TW) + (size_t)row * 128 + 96 + lane * 8) = mk4u(0, 0, 0, 0); *(u32x4*)((bf16_t*)(p.ws + OFF_XA) + (size_t)row * 128 + 96 + lane * 8) = mk4u(0, 0, 0, 0); }
    }
}

struct LoraSched {
    const char *A0, *B0, *A1, *B1; int G, c;
    __device__ __forceinline__ bool next(int i, pg8::Unit& u) const {
        const int per = (NR / 256) * 8; const long L = (long)i * G + c; if (L >= 2 * per) return false;
        const int job = (int)L / per, w = (int)L % per, pm = w >> 3, pn = w & 7;
        u.A = (job ? A1 : A0) + (size_t)pm * 256 * 128 * 2; u.B = (job ? B1 : B0) + (size_t)pn * 256 * 128 * 2; u.rowmap = nullptr; u.nvalid = 0; u.m0 = 0; u.row0 = pm * 256; u.col0 = pn * 256; u.pos0 = job;
        return true;
    }
};
struct FLORA { const float* dbias; const float* ibias; bf16_t* LWG; bf16_t* AIG; __device__ __forceinline__ void operator()(const pg8::Unit& u, int lr, int lc, f32x4 v) const {
    const int row = u.row0 + lr, col = u.col0 + lc;
    float o[4];
    if (u.pos0 == 0) { const f32x4 b = *(const f32x4*)(dbias + col);
#pragma unroll
        for (int e = 0; e < 4; ++e) o[e] = -__expf(-softplusf_(-(b[e] + v[e])) - 0.5f);
        u32x2 w; w.x = pk2(o[0], o[1]); w.y = pk2(o[2], o[3]); *(u32x2*)(LWG + (size_t)row * 2048 + col) = w;
    } else { const f32x4 b = *(const f32x4*)(ibias + col);
#pragma unroll
        for (int e = 0; e < 4; ++e) o[e] = sigmoidf_(b[e] + v[e]);
        u32x2 w; w.x = pk2(o[0], o[1]); w.y = pk2(o[2], o[3]); *(u32x2*)(AIG + (size_t)row * 2048 + col) = w; }
} };
struct FGG { bf16_t* GG; __device__ __forceinline__ void operator()(const pg8::Unit& u, int lr, int lc, f32x4 v) const {
    u32x2 w; w.x = pk2(v[0], v[1]); w.y = pk2(v[2], v[3]); *(u32x2*)(GG + (size_t)(u.row0 + lr) * 1024 + u.col0 + lc) = w; } };

constexpr int L_AT = 0, L_RT = 8192, L_BT = 16384, L_KT = 24576, L_BHT = 32768, L_KHT = 40960, L_VT = 49152, L_AAK = 57344, L_ARB = 65536, L_ARK = 73728,
              L_P0 = 81920, L_PT0 = 90112, L_P1 = 98304, L_PT1 = 106496, L_X0 = 114688, L_X1 = 131072, L_SEG = 147456, L_GL = 149504, L_END = 149760;
static_assert(L_END <= SMEM_BYTES, "R3 LDS map");

__device__ __forceinline__ int inst_index(int b, int h, int d, int chunk) { return ((b * 16 + h) * 2 + d) * NCHUNK + chunk; }

__device__ __forceinline__ void store_t(LDSP unsigned char* dst, int yrow, int x0, const f32x16& acc, int lane) {
    const int hh = lane >> 5;
#pragma unroll
    for (int gq = 0; gq < 4; ++gq) *(LDSP u32x2*)(dst + sw64(yrow, x0 + 8 * gq + 4 * hh)) = mk2u(pk2(acc[4 * gq], acc[4 * gq + 1]), pk2(acc[4 * gq + 2], acc[4 * gq + 3]));
}

__device__ void rwkv_prep_unit(LDSP unsigned char* lds, const Params& p, int unit) {
    int seq, c, h, d;
    if (unit < 4096) { seq = unit >> 11; c = (unit >> 5) & 63; h = (unit >> 1) & 15; d = unit & 1; } else { const int u = unit - 4096; seq = 2 + (u >> 7); c = (u >> 5) & 3; h = (u >> 1) & 15; d = u & 1; }
    const bool isx = seq < 2;
    const int b = seq & 1;
    const int s0 = isx ? b * T : NX + b * CL, t0 = c * 64;
    const int chunk_id = isx ? 4 + c : c;
    {
        const int tid = opaque(threadIdx.x), seg = tid >> 6, lane = tid & 63, k = lane, hk = h * 64 + k;
        const float kac = p.k_a[hk], rkc = p.r_k[hk];
        const bf16_t* RS = (const bf16_t*)(p.ws + OFF_RS); const bf16_t* KS = (const bf16_t*)(p.ws + OFF_KS); const bf16_t* KKp = (const bf16_t*)(p.ws + OFF_KK); const bf16_t* VS = (const bf16_t*)(p.ws + OFF_VS);
        const bf16_t* LWG = (const bf16_t*)(p.ws + OFF_LWG); const bf16_t* AIG = (const bf16_t*)(p.ws + OFF_AIG);
        float rr[8], kd[8], vv[8], aa[8], bb[8], lw[8];
        float run = 0.f;
#pragma unroll
        for (int tt = 0; tt < 8; ++tt) {
            const int i = seg * 8 + tt, tau = d ? 63 - i : i; const size_t row = (size_t)(s0 + t0 + tau);
            rr[tt] = bf2f(RS[row * 1024 + hk]); const float kraw = bf2f(KS[row * 1024 + hk]), kk = bf2f(KKp[row * 1024 + hk]); vv[tt] = bf2f(VS[row * 1024 + hk]);
            const float lwv = bf2f(LWG[row * 2048 + d * 1024 + hk]), a = bf2f(AIG[row * 2048 + d * 1024 + hk]);
            kd[tt] = kraw * (1.f + (a - 1.f) * kac); bb[tt] = kk * a; aa[tt] = -kk;
            run += lwv; lw[tt] = run;
        }
        if (isx) {
#pragma unroll
            for (int tt = 0; tt < 8; ++tt) { const int i = seg * 8 + tt, tau = d ? 63 - i : i; const float bs = wave_sum(rr[tt] * kd[tt] * rkc);
                if (lane == 0) ((float*)(p.ws + OFF_BON))[((size_t)d * NX + (size_t)(s0 + t0 + tau)) * 16 + h] = bs; }
        }
        LDSP float* SEG = (LDSP float*)(lds + L_SEG);
        SEG[seg * 64 + k] = run;
        __syncthreads();
        float off = 0.f, gL = 0.f;
#pragma unroll
        for (int s = 0; s < 8; ++s) { const float sv = SEG[s * 64 + k]; if (s < seg) off += sv; gL += sv; }
        if (seg == 0) ((LDSP float*)(lds + L_GL))[k] = gL;
#pragma unroll
        for (int tt = 0; tt < 8; ++tt) {
            const int i = seg * 8 + tt;
            const float g = off + lw[tt];
            const float ge = (tt == 0) ? off : off + lw[tt - 1];
            const float eg = __expf(g), eng = __expf(-g), ege = __expf(ge), egl = __expf(gL - g);
            const bf16_t at = (bf16_t)f2bf(aa[tt] * ege);
            *(LDSP bf16_t*)(lds + L_AT + sw64(i, k)) = at;
            *(LDSP bf16_t*)(lds + L_X0 + sw64(k, i)) = at;
            *(LDSP bf16_t*)(lds + L_RT + sw64(i, k)) = (bf16_t)f2bf(rr[tt] * eg);
            *(LDSP bf16_t*)(lds + L_BT + sw64(i, k)) = (bf16_t)f2bf(bb[tt] * eng);
            *(LDSP bf16_t*)(lds + L_KT + sw64(i, k)) = (bf16_t)f2bf(kd[tt] * eng);
            *(LDSP bf16_t*)(lds + L_BHT + sw64(k, i)) = (bf16_t)f2bf(bb[tt] * egl);
            *(LDSP bf16_t*)(lds + L_KHT + sw64(k, i)) = (bf16_t)f2bf(kd[tt] * egl);
            *(LDSP bf16_t*)(lds + L_VT + sw64(k, i)) = (bf16_t)f2bf(vv[tt]);
        }
    }
    __syncthreads();
    {
        const int tid = opaque(threadIdx.x), wid = tid >> 6, lane = tid & 63, r = lane & 31, hh = lane >> 5;
        for (int q = wid; q < 20; q += 8) {
            const int kind = q >> 2, xb = (q >> 1) & 1, yb = q & 1;
            const int Aoff = (kind == 0) ? L_BT : (kind == 1) ? L_AT : (kind == 2) ? L_KT : (kind == 3) ? L_BT : L_KT;
            const int Boff = (kind == 0) ? L_AT : (kind == 1) ? L_BT : (kind == 2) ? L_AT : L_RT;
            const int Doff = (kind == 0) ? L_P0 : (kind == 1) ? L_PT0 : (kind == 2) ? L_AAK : (kind == 3) ? L_ARB : L_ARK;
            f32x16 acc = mm32_k64(lds + Aoff, 32 * xb, lds + Boff, 32 * yb, zero16(), lane);
            const int y = 32 * yb + r;
#pragma unroll
            for (int g = 0; g < 16; ++g) { const int x = 32 * xb + crow(g, hh);
                const bool keep = (kind == 1) ? (y < x) : (kind >= 3) ? (x <= y) : (x < y);
                acc[g] = keep ? acc[g] : 0.f; }
            store_t(lds + Doff, y, 32 * xb, acc, lane);
        }
    }
    __syncthreads();
    {
        const int tid = opaque(threadIdx.x), wid = tid >> 6, lane = tid & 63, r = lane & 31;
        if (wid < 4) { const int ib = wid >> 1, vb = wid & 1;
            const f32x16 acc = mm32_k64(lds + L_AAK, 32 * ib, lds + L_VT, 32 * vb, zero16(), lane);
            store_t(lds + L_X0, 64 + 32 * vb + r, 32 * ib, acc, lane); }
    }
    __syncthreads();
#pragma unroll 1
    for (int s = 0; s < 6; ++s) {
        const int tid = opaque(threadIdx.x), wid = tid >> 6, lane = tid & 63, r = lane & 31, hh = lane >> 5;
        const LDSP unsigned char* Pc = lds + ((s & 1) ? L_P1 : L_P0); const LDSP unsigned char* PTc = lds + ((s & 1) ? L_PT1 : L_PT0); const LDSP unsigned char* Xc = lds + ((s & 1) ? L_X1 : L_X0);
        LDSP unsigned char* Pn = lds + ((s & 1) ? L_P0 : L_P1); LDSP unsigned char* PTn = lds + ((s & 1) ? L_PT0 : L_PT1); LDSP unsigned char* Xn = lds + ((s & 1) ? L_X0 : L_X1);
        {
            const int ib = wid & 1, cb = wid >> 1, col = 32 * cb + r;
            f32x16 acc;
#pragma unroll
            for (int gq = 0; gq < 4; ++gq) { const u32x2 w = *(const LDSP u32x2*)(Xc + sw64(col, 32 * ib + 8 * gq + 4 * hh));
                acc[4 * gq] = bf2f(w.x & 0xffff); acc[4 * gq + 1] = bf2f(w.x >> 16); acc[4 * gq + 2] = bf2f(w.y & 0xffff); acc[4 * gq + 3] = bf2f(w.y >> 16); }
            acc = mm32_k64(Pc, 32 * ib, Xc, 32 * cb, acc, lane);
            store_t(Xn, col, 32 * ib, acc, lane);
        }
        if (s < 5) {
            const int w4 = wid & 3, xb = w4 >> 1, yb = w4 & 1;
            if (wid < 4) { const f32x16 acc = mm32_k64(PTc, 32 * xb, Pc, 32 * yb, zero16(), lane); store_t(Pn, 32 * yb + r, 32 * xb, acc, lane); }
            else { const f32x16 acc = mm32_k64(Pc, 32 * xb, PTc, 32 * yb, zero16(), lane); store_t(PTn, 32 * yb + r, 32 * xb, acc, lane); }
        }
        __syncthreads();
    }
    {
        const int tid = opaque(threadIdx.x), wid = tid >> 6, lane = tid & 63, r = lane & 31, hh = lane >> 5;
        const int mi = wid >> 1, half = wid & 1;
        const size_t inst = (size_t)inst_index(b, h, d, chunk_id) * 4096;
        bf16_t* dst = (bf16_t*)(p.ws + (mi == 0 ? OFF_CM : mi == 1 ? OFF_CN : mi == 2 ? OFF_CP : OFF_CQ)) + inst;
        const LDSP unsigned char* XT = lds + L_X0;
        if (isx || mi < 2) {
#pragma unroll
            for (int xb = 0; xb < 2; ++xb) {
                f32x16 acc = zero16();
                if (mi == 0) acc = mm32_k64(XT, 32 * xb, lds + L_BHT, 32 * half, acc, lane);
                else if (mi == 1) { acc = mm32_k64(lds + L_BHT, 32 * xb, XT, 64 + 32 * half, acc, lane); acc = mm32_k64(lds + L_KHT, 32 * xb, lds + L_VT, 32 * half, acc, lane); }
                else if (mi == 2) acc = mm32_k64(XT, 32 * xb, lds + L_ARB, 32 * half, acc, lane);
                else { acc = mm32_k64(lds + L_ARB, 32 * xb, XT, 64 + 32 * half, acc, lane); acc = mm32_k64(lds + L_ARK, 32 * xb, lds + L_VT, 32 * half, acc, lane); }
                const int y = 32 * half + r;
#pragma unroll
                for (int gq = 0; gq < 4; ++gq) {
                    const int x0 = 32 * xb + 8 * gq + 4 * hh;
                    float v0 = acc[4 * gq], v1 = acc[4 * gq + 1], v2 = acc[4 * gq + 2], v3 = acc[4 * gq + 3];
                    if (mi == 0) { const float dg = __expf(((const LDSP float*)(lds + L_GL))[y]); if (x0 == y) v0 += dg; if (x0 + 1 == y) v1 += dg; if (x0 + 2 == y) v2 += dg; if (x0 + 3 == y) v3 += dg; }
                    if (mi == 2) { const u32x2 w = *(const LDSP u32x2*)(lds + L_RT + sw64(y, x0)); v0 += bf2f(w.x & 0xffff); v1 += bf2f(w.x >> 16); v2 += bf2f(w.y & 0xffff); v3 += bf2f(w.y >> 16); }
                    *(u32x2*)(dst + y * 64 + x0) = mk2u(pk2(v0, v1), pk2(v2, v3));
                }
            }
        }
    }
    __syncthreads();
}

constexpr int LA_K = 0  , LA_VT = 73728  , LA_END = LA_VT + 18 * 4608;
static_assert(LA_END <= SMEM_BYTES, "attention LDS map");

__device__ void attn_unit(LDSP unsigned char* lds, const Params& p, int unit) {
    const int tid = opaque(threadIdx.x), wid = tid >> 6, lane = tid & 63;
    const int b = unit >> 8, kvh = (unit >> 6) & 3, qb = unit & 63, q0 = qb * 64;
    const bf16_t* PX = (const bf16_t*)(p.ws + OFF_PX);
    const float2* ROPE = (const float2*)(p.ws + OFF_ROPE);
    for (int task = tid; task < 576 * 4; task += 512) {
        const int key = task >> 2, pr = task & 3, c0 = (pr & 1) + 4 * (pr >> 1);
        u32x4 w0 = mk4u(0, 0, 0, 0), w1 = mk4u(0, 0, 0, 0);
        if (key < 320) {
            const int pos = q0 - 128 + key;
            if (pos >= 0 && pos < T) {
                const bf16_t* src = PX + (size_t)(b * T + pos) * INP + C_AK + kvh * 64 + c0 * 8;
                const u32x4 x1 = *(const u32x4*)src, x2 = *(const u32x4*)(src + 16);
                const int ppos = (pr < 2) ? (pos >> 6) : (pos & 63);
                const float2* tb = ROPE + ppos * 16 + (pr & 1) * 8;
                const unsigned a1[4] = {x1.x, x1.y, x1.z, x1.w}, a2[4] = {x2.x, x2.y, x2.z, x2.w};
                unsigned o1[4], o2[4];
#pragma unroll
                for (int j = 0; j < 4; ++j) {
                    const float2 cs0 = tb[2 * j], cs1 = tb[2 * j + 1];
                    const float u0 = bf2f(a1[j] & 0xffff), u1 = bf2f(a1[j] >> 16), v0 = bf2f(a2[j] & 0xffff), v1 = bf2f(a2[j] >> 16);
                    o1[j] = pk2(u0 * cs0.x - v0 * cs0.y, u1 * cs1.x - v1 * cs1.y);
                    o2[j] = pk2(v0 * cs0.x + u0 * cs0.y, v1 * cs1.x + u1 * cs1.y);
                }
                w0 = mk4u(o1[0], o1[1], o1[2], o1[3]); w1 = mk4u(o2[0], o2[1], o2[2], o2[3]);
            }
        } else {
            const bf16_t* src = PX + (size_t)(NX + b * CL + (key - 320)) * INP + C_AK + kvh * 64 + c0 * 8;
            w0 = *(const u32x4*)src; w1 = *(const u32x4*)(src + 16);
        }
        *(LDSP u32x4*)(lds + LA_K + sw64(key, c0 * 8)) = w0;
        *(LDSP u32x4*)(lds + LA_K + sw64(key, c0 * 8 + 16)) = w1;
    }
    for (int task = tid; task < 144 * 8; task += 512) {
        const int kg = task >> 3, dc = task & 7;
        unsigned short e[4][8];
#pragma unroll
        for (int q = 0; q < 4; ++q) {
            const int key = kg * 4 + q;
            u32x4 w = mk4u(0, 0, 0, 0);
            if (key < 320) { const int pos = q0 - 128 + key; if (pos >= 0 && pos < T) w = *(const u32x4*)(PX + (size_t)(b * T + pos) * INP + C_AV + kvh * 64 + dc * 8); }
            else w = *(const u32x4*)(PX + (size_t)(NX + b * CL + (key - 320)) * INP + C_AV + kvh * 64 + dc * 8);
            e[q][0] = w.x & 0xffff; e[q][1] = w.x >> 16; e[q][2] = w.y & 0xffff; e[q][3] = w.y >> 16; e[q][4] = w.z & 0xffff; e[q][5] = w.z >> 16; e[q][6] = w.w & 0xffff; e[q][7] = w.w >> 16;
        }
        const int tile = kg >> 3, kin = (kg & 7) * 4;
#pragma unroll
        for (int j = 0; j < 8; ++j) { u32x2 w; w.x = (unsigned)e[0][j] | ((unsigned)e[1][j] << 16); w.y = (unsigned)e[2][j] | ((unsigned)e[3][j] << 16);
            *(LDSP u32x2*)(lds + LA_VT + tile * 4608 + (dc * 8 + j) * 72 + kin * 2) = w; }
    }
    const int hq = kvh * 4 + (wid >> 1), qs = (wid & 1) * 32, r = lane & 31, hh = lane >> 5;
    const int qpos = q0 + qs + r;
    bf16x8 qf[4];
    {
        const bf16_t* src = PX + (size_t)(b * T + qpos) * INP + C_Q + hq * 64 + 8 * hh;
        u32x4 raw[4];
#pragma unroll
        for (int s = 0; s < 4; ++s) raw[s] = *(const u32x4*)(src + 16 * s);
#pragma unroll
        for (int pr = 0; pr < 2; ++pr) {
            const int ppos = pr == 0 ? (qpos >> 6) : (qpos & 63);
            const float2* tb = ROPE + ppos * 16 + 8 * hh;
            const unsigned a1[4] = {raw[2 * pr].x, raw[2 * pr].y, raw[2 * pr].z, raw[2 * pr].w}, a2[4] = {raw[2 * pr + 1].x, raw[2 * pr + 1].y, raw[2 * pr + 1].z, raw[2 * pr + 1].w};
            unsigned o1[4], o2[4];
#pragma unroll
            for (int j = 0; j < 4; ++j) {
                const float2 cs0 = tb[2 * j], cs1 = tb[2 * j + 1];
                const float u0 = bf2f(a1[j] & 0xffff), u1 = bf2f(a1[j] >> 16), v0 = bf2f(a2[j] & 0xffff), v1 = bf2f(a2[j] >> 16);
                o1[j] = pk2(0.125f * (u0 * cs0.x - v0 * cs0.y), 0.125f * (u1 * cs1.x - v1 * cs1.y));
                o2[j] = pk2(0.125f * (v0 * cs0.x + u0 * cs0.y), 0.125f * (v1 * cs1.x + u1 * cs1.y));
            }
            const u32x4 w1 = mk4u(o1[0], o1[1], o1[2], o1[3]), w2 = mk4u(o2[0], o2[1], o2[2], o2[3]);
            qf[2 * pr] = __builtin_bit_cast(bf16x8, w1); qf[2 * pr + 1] = __builtin_bit_cast(bf16x8, w2);
        }
    }
    __syncthreads();
    float m = p.attn_sink[hq], l = 1.f;
    f32x16 o0 = zero16(), o1 = zero16();
    for (int tl = 0; tl < 18; ++tl) {
        f32x16 st = zero16();
#pragma unroll
        for (int s = 0; s < 4; ++s) {
            const bf16x8 kf = *(const LDSP bf16x8*)(lds + LA_K + sw64(32 * tl + r, 16 * s + 8 * hh));
            st = __builtin_amdgcn_mfma_f32_32x32x16_bf16(kf, qf[s], st, 0, 0, 0);
        }
        if (tl < 10) {
#pragma unroll
            for (int g = 0; g < 16; ++g) { const int kp = q0 - 128 + 32 * tl + crow(g, hh); const int dlt = qpos - kp;
                const bool ok = (dlt <= 128) && (dlt >= -128) && (kp >= 0) && (kp < T); st[g] = ok ? st[g] : -1e30f; }
        }
        float mt = st[0];
#pragma unroll
        for (int g = 1; g < 16; ++g) mt = fmaxf(mt, st[g]);
        mt = fmaxf(mt, __shfl_xor(mt, 32));
        const float mn = fmaxf(m, mt), alpha = __expf(m - mn);
        float ps = 0.f;
#pragma unroll
        for (int g = 0; g < 16; ++g) { st[g] = __expf(st[g] - mn); ps += st[g]; }
        ps += __shfl_xor(ps, 32);
        l = l * alpha + ps; m = mn;
#pragma unroll
        for (int g = 0; g < 16; ++g) { o0[g] *= alpha; o1[g] *= alpha; }
#pragma unroll
        for (int s2 = 0; s2 < 2; ++s2) {
            const u32x4 pw = mk4u(pk2(st[8 * s2], st[8 * s2 + 1]), pk2(st[8 * s2 + 2], st[8 * s2 + 3]), pk2(st[8 * s2 + 4], st[8 * s2 + 5]), pk2(st[8 * s2 + 6], st[8 * s2 + 7]));
            const bf16x8 pf = __builtin_bit_cast(bf16x8, pw);
#pragma unroll
            for (int dm = 0; dm < 2; ++dm) {
                const LDSP unsigned char* vp = lds + LA_VT + tl * 4608 + (32 * dm + r) * 72 + (16 * s2 + 4 * hh) * 2;
                const u32x2 v0 = *(const LDSP u32x2*)vp, v1 = *(const LDSP u32x2*)(vp + 16);
                const bf16x8 vf = __builtin_bit_cast(bf16x8, mk4u(v0.x, v0.y, v1.x, v1.y));
                if (dm == 0) o0 = __builtin_amdgcn_mfma_f32_32x32x16_bf16(vf, pf, o0, 0, 0, 0); else o1 = __builtin_amdgcn_mfma_f32_32x32x16_bf16(vf, pf, o1, 0, 0, 0);
            }
        }
    }
    {
        const float inv = 1.f / l;
        bf16_t* dst = (bf16_t*)(p.ws + OFF_MIX) + (size_t)(b * T + qpos) * D + 1024 + hq * 64;
#pragma unroll
        for (int gq = 0; gq < 4; ++gq) {
            u32x2 w; w.x = pk2(o0[4 * gq] * inv, o0[4 * gq + 1] * inv); w.y = pk2(o0[4 * gq + 2] * inv, o0[4 * gq + 3] * inv); *(u32x2*)(dst + 8 * gq + 4 * hh) = w;
            u32x2 w2; w2.x = pk2(o1[4 * gq] * inv, o1[4 * gq + 1] * inv); w2.y = pk2(o1[4 * gq + 2] * inv, o1[4 * gq + 3] * inv); *(u32x2*)(dst + 32 + 8 * gq + 4 * hh) = w2;
        }
    }
    __syncthreads();
}

__device__ void phaseR2(LDSP unsigned char* lds, const Params& p) {
    {
        pg8::Epi<FLORA> epi{FLORA{p.decay_bias, p.iclr_bias, (bf16_t*)(p.ws + OFF_LWG), (bf16_t*)(p.ws + OFF_AIG)}};
        LoraSched S{(const char*)(p.ws + OFF_TW), (const char*)(p.ws + OFF_WTDU), (const char*)(p.ws + OFF_XA), (const char*)(p.ws + OFF_WTIU), (int)gridDim.x, (int)blockIdx.x};
        pg8::gemm_phase<false>(lds, opaque_s(128), S, epi);
    }
    {
        pg8::Epi<FGG> epi{FGG{(bf16_t*)(p.ws + OFF_GG)}};
        pg8::DenseSched S{(const char*)(p.ws + OFF_SG), (const char*)(p.ws + OFF_WTGU), NX / 256, 1024 / 256, 256, (int)gridDim.x, (int)(gridDim.x - 1 - blockIdx.x)};
        pg8::gemm_phase<false>(lds, opaque_s(256), S, epi);
    }
    __syncthreads();
    for (int u = blockIdx.x; u < 512; u += gridDim.x) attn_unit(lds, p, u);
}

__device__ void phaseR3(LDSP unsigned char* lds, const Params& p) {
    for (int u = blockIdx.x; u < 4096 + 256; u += gridDim.x) rwkv_prep_unit(lds, p, u);
}

__device__ void scan_chain(LDSP unsigned char* lds, const Params& p, int chain) {
    const int tid = opaque(threadIdx.x), wid = tid >> 6, lane = tid & 63, r = lane & 31, hh = lane >> 5;
    const int b = chain >> 5, h = (chain >> 1) & 15, d = chain & 1;
    const int rb = wid >> 1, cb = wid & 1, row0 = 32 * (rb & 1), col = 32 * cb + r;
    for (int i = tid; i < 2 * 8192 / 16; i += 512) ((LDSP u32x4*)lds)[i] = mk4u(0, 0, 0, 0);
    __syncthreads();
    float* YD = (float*)(p.ws + OFF_YD);
    const bf16_t* Abase = (const bf16_t*)(p.ws + (rb < 2 ? OFF_CM : OFF_CP));
    const bf16_t* Cbase = (const bf16_t*)(p.ws + (rb < 2 ? OFF_CN : OFF_CQ));
    bf16x8 na[4]; u32x2 nc[4];
    auto chunk_of = [&](int step) { return (step < 4) ? (d ? 3 - step : step) : (d ? 4 + (67 - step) : step); };
    auto prefetch = [&](int step) {
        const int chunk_id = chunk_of(step);
        if (rb < 2 || chunk_id >= 4) {
            const size_t inst = (size_t)inst_index(b, h, d, chunk_id) * 4096;
#pragma unroll
            for (int s = 0; s < 4; ++s) na[s] = *(const bf16x8*)(Abase + inst + (row0 + r) * 64 + 16 * s + 8 * hh);
#pragma unroll
            for (int gq = 0; gq < 4; ++gq) nc[gq] = *(const u32x2*)(Cbase + inst + col * 64 + row0 + 8 * gq + 4 * hh);
        }
    };
    prefetch(0);
#pragma unroll 1
    for (int step = 0; step < NCHUNK; ++step) {
        const int chunk_id = chunk_of(step);
        const bool active = (rb < 2) || (chunk_id >= 4);
        const int cur = step & 1;
        bf16x8 a[4]; u32x2 c[4];
#pragma unroll
        for (int s = 0; s < 4; ++s) { a[s] = na[s]; c[s] = nc[s]; }
        if (step + 1 < NCHUNK) prefetch(step + 1);
        if (active) {
            f32x16 acc;
#pragma unroll
            for (int gq = 0; gq < 4; ++gq) { acc[4 * gq] = bf2f(c[gq].x & 0xffff); acc[4 * gq + 1] = bf2f(c[gq].x >> 16); acc[4 * gq + 2] = bf2f(c[gq].y & 0xffff); acc[4 * gq + 3] = bf2f(c[gq].y >> 16); }
#pragma unroll
            for (int s = 0; s < 4; ++s) {
                const bf16x8 bfr = *(const LDSP bf16x8*)(lds + cur * 8192 + sw64(col, 16 * s + 8 * hh));
                acc = __builtin_amdgcn_mfma_f32_32x32x16_bf16(a[s], bfr, acc, 0, 0, 0);
            }
            if (rb < 2) {
#pragma unroll
                for (int gq = 0; gq < 4; ++gq) *(LDSP u32x2*)(lds + (cur ^ 1) * 8192 + sw64(col, row0 + 8 * gq + 4 * hh)) = mk2u(pk2(acc[4 * gq], acc[4 * gq + 1]), pk2(acc[4 * gq + 2], acc[4 * gq + 3]));
            } else {
                const int t0 = (chunk_id - 4) * 64;
#pragma unroll
                for (int g = 0; g < 16; ++g) { const int i = row0 + crow(g, hh), tau = d ? 63 - i : i;
                    YD[((size_t)d * NX + (size_t)b * T + t0 + tau) * 1024 + h * 64 + col] = acc[g]; }
            }
        }
        __syncthreads();
    }
}
__device__ void phaseR4(LDSP unsigned char* lds, const Params& p) { for (int u = blockIdx.x; u < 64; u += gridDim.x) scan_chain(lds, p, u); }

__device__ void phaseR5(LDSP unsigned char* lds, const Params& p) {
    const int tid = opaque(threadIdx.x), wid = tid >> 6, lane = tid & 63, ch = lane * 16, h = lane >> 2;
    const float* YD = (const float*)(p.ws + OFF_YD); const float* BON = (const float*)(p.ws + OFF_BON);
    for (int row = blockIdx.x * 8 + wid; row < NX; row += gridDim.x * 8) {
        float y[16];
#pragma unroll
        for (int q = 0; q < 4; ++q) { const f32x4 a = *(const f32x4*)(YD + (size_t)row * 1024 + ch + 4 * q), bq = *(const f32x4*)(YD + ((size_t)NX + row) * 1024 + ch + 4 * q);
            y[4 * q] = a.x + bq.x; y[4 * q + 1] = a.y + bq.y; y[4 * q + 2] = a.z + bq.z; y[4 * q + 3] = a.w + bq.w; }
        float sm = 0.f;
#pragma unroll
        for (int j = 0; j < 16; ++j) sm += y[j];
        sm += __shfl_xor(sm, 1); sm += __shfl_xor(sm, 2);
        const float mean = sm * (1.f / 64.f);
        float q2 = 0.f;
#pragma unroll
        for (int j = 0; j < 16; ++j) { y[j] -= mean; q2 += y[j] * y[j]; }
        q2 += __shfl_xor(q2, 1); q2 += __shfl_xor(q2, 2);
        const float rstd = rsqrtf(q2 * (1.f / 64.f) + 64e-5f);
        const float bon = BON[(size_t)row * 16 + h] + BON[((size_t)NX + row) * 16 + h];
        const bf16_t* vs = (const bf16_t*)(p.ws + OFF_VS) + (size_t)row * 1024 + ch; const bf16_t* gg = (const bf16_t*)(p.ws + OFF_GG) + (size_t)row * 1024 + ch;
        unsigned o[8];
#pragma unroll
        for (int q = 0; q < 2; ++q) {
            const u32x4 v4 = *(const u32x4*)(vs + 8 * q), g4 = *(const u32x4*)(gg + 8 * q);
            const unsigned vw[4] = {v4.x, v4.y, v4.z, v4.w}, gw[4] = {g4.x, g4.y, g4.z, g4.w};
#pragma unroll
            for (int j = 0; j < 4; ++j) { const int e = 8 * q + 2 * j;
                const float o0 = (y[e] * rstd * p.lnx_g[ch + e] + p.lnx_b[ch + e] + bon * bf2f(vw[j] & 0xffff)) * bf2f(gw[j] & 0xffff);
                const float o1 = (y[e + 1] * rstd * p.lnx_g[ch + e + 1] + p.lnx_b[ch + e + 1] + bon * bf2f(vw[j] >> 16)) * bf2f(gw[j] >> 16);
                o[4 * q + j] = pk2(o0, o1); }
        }
        bf16_t* dst = (bf16_t*)(p.ws + OFF_MIX) + (size_t)row * D + ch;
        *(u32x4*)dst = mk4u(o[0], o[1], o[2], o[3]); *(u32x4*)(dst + 8) = mk4u(o[4], o[5], o[6], o[7]);
    }
}

__device__ void phase6(LDSP unsigned char* lds, const Params& p) {
    pg8::Epi<FX1> epi{FX1{p.x, (const float*)(p.ws + OFF_MOD), (float*)(p.ws + OFF_X1)}};
    pg8::DenseSched S{(const char*)(p.ws + OFF_MIX), (const char*)(p.ws + OFF_WTOUT), NX / 256, D / 256, D, (int)gridDim.x, (int)blockIdx.x};
    pg8::gemm_phase<false>(lds, D, S, epi);
}

__device__ void phase7(LDSP unsigned char* lds, const Params& p) {
    const int tid = opaque(threadIdx.x), wid = tid >> 6, lane = tid & 63;
    LDSP float* HR = (LDSP float*)lds;
    LDSP float* PART = (LDSP float*)(lds + 65536);
    const float* MOD = (const float*)(p.ws + OFF_MOD);
    const float* X1 = (const float*)(p.ws + OFF_X1);
    bf16_t* H2 = (bf16_t*)(p.ws + OFF_H2);
    int* CNT = (int*)(p.ws + OFF_CTL + 16384);
    for (int u = blockIdx.x; u < NX / 8; u += gridDim.x) {
        {
            const int row = u * 8 + wid; const float* src = X1 + (size_t)row * D; const float* md = MOD + (size_t)(row >> 12) * 12288;
            f32x4 xv[8]; float ss = 0.f;
#pragma unroll
            for (int i = 0; i < 8; ++i) { xv[i] = ((const f32x4*)src)[lane + 64 * i]; ss += xv[i].x * xv[i].x + xv[i].y * xv[i].y + xv[i].z * xv[i].z + xv[i].w * xv[i].w; }
            ss = wave_sum(ss); const float rs = rsqrtf(ss * (1.f / D) + 1e-6f);
#pragma unroll
            for (int i = 0; i < 8; ++i) { const int col = 4 * (lane + 64 * i);
                const f32x4 g = *(const f32x4*)(p.norm2_g + col), sh = *(const f32x4*)(md + 3 * D + col), sc = *(const f32x4*)(md + 4 * D + col);
                f32x4 hv; hv.x = xv[i].x * rs * g.x * (1.f + sc.x) + sh.x; hv.y = xv[i].y * rs * g.y * (1.f + sc.y) + sh.y; hv.z = xv[i].z * rs * g.z * (1.f + sc.z) + sh.z; hv.w = xv[i].w * rs * g.w * (1.f + sc.w) + sh.w;
                *(LDSP f32x4*)(HR + wid * 2048 + col) = hv;
                u32x2 w; w.x = pk2(hv.x, hv.y); w.y = pk2(hv.z, hv.w); *(u32x2*)(H2 + (size_t)row * D + col) = w; }
        }
        __syncthreads();
        {
            float acc[8];
#pragma unroll
            for (int t = 0; t < 8; ++t) acc[t] = 0.f;
            const float* wr = p.w_router + (size_t)(wid * 256) * 64 + lane;
            for (int k4 = 0; k4 < 64; ++k4) {
                const float w0 = wr[(4 * k4) * 64], w1 = wr[(4 * k4 + 1) * 64], w2 = wr[(4 * k4 + 2) * 64], w3 = wr[(4 * k4 + 3) * 64];
#pragma unroll
                for (int t = 0; t < 8; ++t) { const f32x4 hv = *(const LDSP f32x4*)(HR + t * 2048 + wid * 256 + 4 * k4); acc[t] += hv.x * w0 + hv.y * w1 + hv.z * w2 + hv.w * w3; }
            }
#pragma unroll
            for (int t = 0; t < 8; ++t) PART[(wid * 8 + t) * 64 + lane] = acc[t];
        }
        __syncthreads();
        {
            const int token = u * 8 + wid;
            float logit = 0.f;
#pragma unroll
            for (int w = 0; w < 8; ++w) logit += PART[(w * 8 + wid) * 64 + lane];
            const float score = 1.f / (1.f + expf(-logit));
            const float v = score + p.expert_bias[lane];
            const int gi = lane >> 3;
            float m1 = v;
            m1 = fmaxf(m1, __shfl_xor(m1, 1)); m1 = fmaxf(m1, __shfl_xor(m1, 2)); m1 = fmaxf(m1, __shfl_xor(m1, 4));
            const unsigned long long eq = __ballot(v == m1);
            const unsigned gbits = (unsigned)((eq >> (gi * 8)) & 0xffull);
            const bool first = (lane & 7) == (__ffs((int)gbits) - 1);
            float v2 = first ? -INFINITY : v;
            v2 = fmaxf(v2, __shfl_xor(v2, 1)); v2 = fmaxf(v2, __shfl_xor(v2, 2)); v2 = fmaxf(v2, __shfl_xor(v2, 4));
            const float gs = m1 + v2;
            int gr = 0;
#pragma unroll
            for (int j = 0; j < 8; ++j) { const float gj = __shfl(gs, j * 8); gr += (gj > gs || (gj == gs && j < gi)) ? 1 : 0; }
            const float mv = (gr < 4) ? v : -INFINITY;
            int rk = 0;
#pragma unroll
            for (int j = 0; j < 64; ++j) { const float vj = __shfl(mv, j); rk += (vj > mv || (vj == mv && j < lane)) ? 1 : 0; }
            const bool sel = (rk < 8) && (gr < 4);
            const float gsum = wave_sum(sel ? score : 0.f);
            if (sel) {
                const int slot = atomicAdd(&CNT[lane], 1);
                ((int*)(p.ws + OFF_EIDX))[token * 8 + rk] = lane;
                ((int*)(p.ws + OFF_ESLOT))[token * 8 + rk] = slot;
                ((float*)(p.ws + OFF_GATE))[token * 8 + rk] = score / gsum * 2.5f;
                ((int*)(p.ws + OFF_TOKL))[(size_t)lane * NX + slot] = token;
            }
        }
        __syncthreads();
    }
}

constexpr int LE_TAB = 131072;
__device__ __forceinline__ void build_expert_tables(LDSP unsigned char* lds, const Params& p) {
    LDSP int* TP = (LDSP int*)(lds + LE_TAB); LDSP int* ST = TP + 72; LDSP int* CN = ST + 72;
    if (threadIdx.x < NEX) CN[threadIdx.x] = (threadIdx.x < NE) ? ((const int*)(p.ws + OFF_CTL + 16384))[threadIdx.x] : NX;
    __syncthreads();
    if (threadIdx.x == 0) {
        int tp = 0, st = 0;
        for (int e = 0; e < NEX; ++e) { const int cn = CN[e]; TP[e] = tp; ST[e] = st; tp += (cn + 255) >> 8; st += cn; }
        TP[NEX] = tp; ST[NEX] = st;
    }
    __syncthreads();
}

struct GroupSched {
    const LDSP int* TP; const LDSP int* ST; const LDSP int* CN;
    const char* A; const char* B; const int* tokl; int ntn, K, G, c; size_t bstride; bool gather;
    __device__ __forceinline__ bool next(int i, pg8::Unit& u) const {
        const int total = __builtin_amdgcn_readfirstlane(TP[NEX]) * ntn; const long L = (long)i * G + c; if (L >= total) return false;
        const int w = pg8::xcd_remap((int)L, total);
        const int nt = w % ntn, mtg = w / ntn;
        int e = 0, hi = NEX;
        while (hi - e > 1) { const int mid = (e + hi) >> 1; if (__builtin_amdgcn_readfirstlane(TP[mid]) <= mtg) e = mid; else hi = mid; }
        const int tpe = __builtin_amdgcn_readfirstlane(TP[e]), ste = __builtin_amdgcn_readfirstlane(ST[e]), cne = __builtin_amdgcn_readfirstlane(CN[e]);
        const int mt = mtg - tpe;
        u.B = B + (size_t)e * bstride + (size_t)nt * 256 * K * 2;
        u.nvalid = cne; u.m0 = mt * 256; u.pos0 = ste; u.row0 = 0; u.col0 = nt * 256;
        if (gather) { u.A = A; u.rowmap = (e < NE) ? tokl + (size_t)e * NX : nullptr; }
        else { u.A = A + (size_t)(ste + mt * 256) * K * 2; u.rowmap = nullptr; }
        return true;
    }
};
__device__ void phase8(LDSP unsigned char* lds, const Params& p) {
    build_expert_tables(lds, p);
    const LDSP int* TP = (const LDSP int*)(lds + LE_TAB);
    pg8::Epi<FH1> epi{FH1{(bf16_t*)(p.ws + OFF_H1)}};
    GroupSched S{TP, TP + 72, TP + 144, (const char*)(p.ws + OFF_H2), (const char*)(p.ws + OFF_WTE1), (const int*)(p.ws + OFF_TOKL), 4, D, (int)gridDim.x, (int)blockIdx.x,
                 (size_t)1024 * 2048 * 2, true};
    pg8::gemm_phase<true>(lds, D, S, epi);
}
__device__ void phase9(LDSP unsigned char* lds, const Params& p) {
    build_expert_tables(lds, p);
    const LDSP int* TP = (const LDSP int*)(lds + LE_TAB);
    pg8::Epi<FEO> epi{FEO{(bf16_t*)(p.ws + OFF_EO)}};
    GroupSched S{TP, TP + 72, TP + 144, (const char*)(p.ws + OFF_H1), (const char*)(p.ws + OFF_WTE2), nullptr, 8, EFF, (int)gridDim.x, (int)blockIdx.x,
                 (size_t)2048 * 512 * 2, false};
    pg8::gemm_phase<false>(lds, EFF, S, epi);
}
__device__ void phase10(LDSP unsigned char* lds, const Params& p) {
    build_expert_tables(lds, p);
    const LDSP int* ST = (const LDSP int*)(lds + LE_TAB) + 72;
    const int tid = opaque(threadIdx.x), wid = tid >> 6, lane = tid & 63;
    const float* MOD = (const float*)(p.ws + OFF_MOD);
    const float* X1 = (const float*)(p.ws + OFF_X1);
    const bf16_t* EO = (const bf16_t*)(p.ws + OFF_EO);
    for (int row = blockIdx.x * 8 + wid; row < NX; row += gridDim.x * 8) {
        unsigned er[9]; float gw[9];
#pragma unroll
        for (int k = 0; k < 8; ++k) { const int e = ((const int*)(p.ws + OFF_EIDX))[row * 8 + k], sl = ((const int*)(p.ws + OFF_ESLOT))[row * 8 + k];
            er[k] = (unsigned)(ST[e] + sl) * (unsigned)D; gw[k] = ((const float*)(p.ws + OFF_GATE))[row * 8 + k]; }
        er[8] = (unsigned)(ST[NE] + row) * (unsigned)D; gw[8] = 1.f;
        const float* md = MOD + (size_t)(row >> 12) * 12288 + 5 * D;
        LDSP float* RB = (LDSP float*)lds + wid * 2048;
        float ss = 0.f;
#pragma unroll 1
        for (int i = 0; i < 8; ++i) { const int col = 4 * (lane + 64 * i);
            f32x4 a = mk4f(0.f, 0.f, 0.f, 0.f);
#pragma unroll
            for (int k = 0; k < 9; ++k) { const u32x2 w = *(const u32x2*)(EO + er[k] + col);
                a.x += gw[k] * bf2f(w.x & 0xffff); a.y += gw[k] * bf2f(w.x >> 16); a.z += gw[k] * bf2f(w.y & 0xffff); a.w += gw[k] * bf2f(w.y >> 16); }
            const f32x4 x1 = *(const f32x4*)(X1 + (size_t)row * D + col), g2 = *(const f32x4*)(md + col);
            f32x4 xv; xv.x = x1.x + g2.x * a.x; xv.y = x1.y + g2.y * a.y; xv.z = x1.z + g2.z * a.z; xv.w = x1.w + g2.w * a.w;
            ss += xv.x * xv.x + xv.y * xv.y + xv.z * xv.z + xv.w * xv.w;
            *(LDSP f32x4*)(RB + col) = xv; }
        ss = wave_sum(ss); const float rs = rsqrtf(ss * (1.f / D) + 1e-6f);
#pragma unroll 1
        for (int i = 0; i < 8; ++i) { const int col = 4 * (lane + 64 * i); const f32x4 g = *(const f32x4*)(p.final_g + col);
            const f32x4 xv = *(const LDSP f32x4*)(RB + col);
            f32x4 o; o.x = xv.x * rs * g.x; o.y = xv.y * rs * g.y; o.z = xv.z * rs * g.z; o.w = xv.w * rs * g.w;
            *(f32x4*)(p.out + (size_t)row * D + col) = o; }
    }
}

__global__ void __launch_bounds__(512, 2) fwd_megakernel(Params p) {
    __shared__ __attribute__((aligned(16))) unsigned char smem_raw[SMEM_BYTES];
    LDSP unsigned char* lds = (LDSP unsigned char*)smem_raw;
    cg::grid_group grid = cg::this_grid();
#ifndef PH_TWICE
#define PH_TWICE 0
#endif
#ifndef PH_MASK
#define PH_MASK 0xffff
#endif
#define RUN_PHASE(bit, fn) _Pragma("unroll 1") for (int rep = 0; rep < ((PH_TWICE & (bit)) ? 2 : 1); ++rep) { if (rep) grid.sync(); if (PH_MASK & (bit)) { Params q = p; q.ws = opq(p.ws); fn(lds, q); } }
    RUN_PHASE(1, phase0)      grid.sync();
    RUN_PHASE(2, phase1)      grid.sync();
    RUN_PHASE(4, phase2)      grid.sync();
    RUN_PHASE(8, phaseR1)     grid.sync();
    RUN_PHASE(16, phaseR2)    grid.sync();
    RUN_PHASE(32, phaseR3)    grid.sync();
    RUN_PHASE(64, phaseR4)    grid.sync();
    RUN_PHASE(128, phaseR5)   grid.sync();
    RUN_PHASE(256, phase6)    grid.sync();
    RUN_PHASE(512, phase7)    grid.sync();
    RUN_PHASE(1024, phase8)   grid.sync();
    RUN_PHASE(2048, phase9)   grid.sync();
    RUN_PHASE(4096, phase10)
}

extern "C" void kernel_launch(void* const* d_in, const int* in_sizes, int n_in, void* d_out, int out_size, void* d_ws, size_t ws_size, hipStream_t stream) {
    static int grid_blocks = 0;
    if (!grid_blocks) {
        int dev = 0, cus = 0, per_cu = 0;
        (void)hipGetDevice(&dev);
        (void)hipDeviceGetAttribute(&cus, hipDeviceAttributeMultiprocessorCount, dev);
        (void)hipOccupancyMaxActiveBlocksPerMultiprocessor(&per_cu, fwd_megakernel, 512, 0);
        if (per_cu > 1) per_cu = 1;
        grid_blocks = cus * per_cu;
        if (ws_size < WS_END) fprintf(stderr, "workspace too small: %zu < %zu\n", ws_size, (size_t)WS_END);
    }
    Params p{};
    const float** f = (const float**)&p;
    for (int i = 0; i < 31; ++i) f[i] = (const float*)d_in[i];
    p.out = (float*)d_out; p.ws = (unsigned char*)d_ws;
    (void)hipMemsetAsync(d_ws, 0, 32768, stream);
    void* args[] = {&p};
    hipError_t e = hipLaunchCooperativeKernel((void*)fwd_megakernel, dim3(grid_blocks), dim3(512), args, 0, stream);
    if (e != hipSuccess) fprintf(stderr, "cooperative launch failed: %s (grid %d)\n", hipGetErrorString(e), grid_blocks);
}
```

```cpp
#include <hip/hip_runtime.h>
#include <hip/hip_cooperative_groups.h>
#include <cstdio>
#include <cstdint>
namespace cg = cooperative_groups;

#define LDSP __attribute__((address_space(3)))
typedef unsigned short bf16_t;
typedef short bf16x8 __attribute__((ext_vector_type(8)));
typedef float f32x4 __attribute__((ext_vector_type(4)));
typedef float f32x16 __attribute__((ext_vector_type(16)));
typedef unsigned u32x4 __attribute__((ext_vector_type(4)));
typedef unsigned u32x2 __attribute__((ext_vector_type(2)));
__device__ __forceinline__ u32x4 mk4u(unsigned a, unsigned b, unsigned c, unsigned d) { u32x4 r; r.x = a; r.y = b; r.z = c; r.w = d; return r; }
__device__ __forceinline__ u32x2 mk2u(unsigned a, unsigned b) { u32x2 r; r.x = a; r.y = b; return r; }
__device__ __forceinline__ f32x4 mk4f(float a, float b, float c, float d) { f32x4 r; r.x = a; r.y = b; r.z = c; r.w = d; return r; }

constexpr int D = 2048, NB = 2, T = 4096, CL = 256, NX = NB * T, NCX = NB * CL, NR = NX + NCX;
constexpr int INC = 5056, INP = 5120;
constexpr int C_R = 0, C_K = 1024, C_V = 2048, C_XW = 3072, C_XA = 3168, C_XG = 3264, C_Q = 3520, C_AK = 4544, C_AV = 4800;
constexpr int NE = 64, NEX = 65, EFF = 512;
constexpr int NCHUNK = 68;
constexpr int NINST = NB * 16 * 2 * NCHUNK;
constexpr int EROWS = NX * 8 + NX;

constexpr size_t al4k(size_t x) { return (x + 4095) & ~(size_t)4095; }
constexpr size_t OFF_CTL = 0;
constexpr size_t OFF_ROPE = 65536;
constexpr size_t OFF_MODP = OFF_ROPE + 8192;
constexpr size_t OFF_MOD = al4k(OFF_MODP + (size_t)16 * 3 * 12288 * 4);
constexpr size_t OFF_WTDU = al4k(OFF_MOD + (size_t)3 * 12288 * 4);
constexpr size_t OFF_WTIU = OFF_WTDU + (size_t)2 * 1024 * 128 * 2;
constexpr size_t OFF_WTGU = OFF_WTIU + (size_t)2 * 1024 * 128 * 2;
constexpr size_t OFF_WTE2 = OFF_WTGU + (size_t)1024 * 256 * 2;
constexpr size_t OFF_X1 = OFF_WTE2 + (size_t)NEX * 2048 * 512 * 2;
constexpr size_t OFF_H2 = OFF_X1 + (size_t)NX * D * 4;
constexpr size_t OFF_TOKL = OFF_H2 + (size_t)NX * D * 2;
constexpr size_t OFF_EIDX = OFF_TOKL + (size_t)NE * NX * 4;
constexpr size_t OFF_ESLOT = OFF_EIDX + (size_t)NX * 8 * 4;
constexpr size_t OFF_GATE = OFF_ESLOT + (size_t)NX * 8 * 4;
constexpr size_t OFF_H1 = OFF_GATE + (size_t)NX * 8 * 4;
constexpr size_t OFF_WTE1 = al4k(OFF_H1 + (size_t)(EROWS + 256) * EFF * 2);
constexpr size_t OFF_EO = OFF_WTE1;
constexpr size_t OFF_WTIN = OFF_WTE1 + (size_t)NEX * 1024 * 2048 * 2;
constexpr size_t OFF_WTOUT = OFF_WTIN + (size_t)INP * D * 2;
constexpr size_t OFF_HX = OFF_WTOUT + (size_t)D * D * 2;
constexpr size_t OFF_PX = OFF_HX + (size_t)NR * D * 2;
constexpr size_t OFF_CM = OFF_PX + (size_t)NR * INP * 2;
constexpr size_t OFF_CN = OFF_CM + (size_t)NINST * 4096 * 2;
constexpr size_t OFF_CP = OFF_CN + (size_t)NINST * 4096 * 2;
constexpr size_t OFF_CQ = OFF_CP + (size_t)NINST * 4096 * 2;
constexpr size_t OFF_YD = OFF_CQ + (size_t)NINST * 4096 * 2;
constexpr size_t OFF_BON = OFF_YD + (size_t)2 * NX * 1024 * 4;
constexpr size_t OFF_MIX = OFF_BON + (size_t)2 * NX * 16 * 4;
constexpr size_t WS_END = OFF_MIX + (size_t)NX * D * 2;
constexpr size_t OFF_RS = OFF_X1;
constexpr size_t OFF_KS = OFF_RS + (size_t)NR * 1024 * 2;
constexpr size_t OFF_KK = OFF_KS + (size_t)NR * 1024 * 2;
constexpr size_t OFF_VS = OFF_KK + (size_t)NR * 1024 * 2;
constexpr size_t OFF_TW = OFF_VS + (size_t)NR * 1024 * 2;
constexpr size_t OFF_XA = OFF_TW + (size_t)NR * 128 * 2;
constexpr size_t OFF_SG = OFF_XA + (size_t)NR * 128 * 2;
constexpr size_t OFF_LWG = OFF_SG + (size_t)NX * 256 * 2;
constexpr size_t OFF_AIG = OFF_LWG + (size_t)NR * 2048 * 2;
constexpr size_t OFF_GG = OFF_AIG + (size_t)NR * 2048 * 2;
static_assert(OFF_GG + (size_t)NX * 1024 * 2 <= OFF_WTE1, "RWKV token buffers fit the overlay region");
static_assert(OFF_EO + (size_t)EROWS * D * 2 <= OFF_HX, "EO overlays only WT_E1/WT_IN/WT_OUT");
static_assert(WS_END <= (size_t)1073741824, "workspace map must fit 1 GiB");

constexpr int SMEM_BYTES = 157 * 1024;

struct Params {
    const float *x, *c, *ctx, *c_ctx, *w_mod, *b_mod, *norm1_g, *norm2_g, *w_in, *shift_mu, *k_k, *k_a, *r_k, *decay_bias, *decay_up, *iclr_bias, *iclr_up,
        *gate_up, *lnx_g, *lnx_b, *attn_sink, *w_out, *w_router, *expert_bias, *e_gate, *e_up, *e_down, *s_gate, *s_up, *s_down, *final_g;
    float* out;
    unsigned char* ws;
};

__device__ __forceinline__ unsigned f2bf(float f) { unsigned u = __float_as_uint(f); return (u + 0x7fffu + ((u >> 16) & 1u)) >> 16; }
__device__ __forceinline__ float bf2f(unsigned h) { return __uint_as_float(h << 16); }
typedef float f32x2_t __attribute__((ext_vector_type(2)));
typedef __bf16 bf16x2_t __attribute__((ext_vector_type(2)));
__device__ __forceinline__ unsigned pk2(float lo, float hi) { f32x2_t v = {lo, hi}; bf16x2_t b = __builtin_convertvector(v, bf16x2_t); return __builtin_bit_cast(unsigned, b); }
__device__ __forceinline__ float wave_sum(float v) {
#pragma unroll
    for (int o = 32; o > 0; o >>= 1) v += __shfl_xor(v, o);
    return v;
}
__device__ __forceinline__ int opaque(int x) { asm volatile("" : "+v"(x)); return x; }
__device__ __forceinline__ int opaque_s(int x) { asm volatile("" : "+s"(x)); return x; }
__device__ __forceinline__ unsigned char* opq(unsigned char* x) {
    unsigned long long v = (unsigned long long)x; asm volatile("" : "+s"(v));
    return (unsigned char*)(__attribute__((address_space(1))) unsigned char*)v; }
__device__ __forceinline__ float sigmoidf_(float x) { return 1.f / (1.f + __expf(-x)); }
__device__ __forceinline__ float softplusf_(float x) { return x > 20.f ? x : log1pf(__expf(x)); }
__device__ __forceinline__ int lds_byte(int r, int c) { const int st = (r >> 4) * 2 + (c >> 5), rr = r & 15, cc = c & 31, ob = rr * 64 + cc * 2; return st * 1024 + (ob ^ (((ob >> 9) & 1) << 5)); }
__device__ __forceinline__ int sw64(int r, int k) { return r * 128 + ((((k >> 3) ^ (r >> 1)) & 7) << 4) + (k & 7) * 2; }
__device__ __forceinline__ int sw128(int r, int k) { return r * 256 + ((((k >> 3) ^ r) & 15) << 4) + (k & 7) * 2; }
__device__ __forceinline__ int sw256(int r, int k) { const int ch = k >> 3; return r * 512 + (((ch & 16) | ((ch ^ r) & 15)) << 4) + (k & 7) * 2; }

__device__ __forceinline__ f32x16 zero16() { f32x16 z;
#pragma unroll
    for (int i = 0; i < 16; ++i) z[i] = 0.f; return z; }
__device__ __forceinline__ int crow(int reg, int hi) { return (reg & 3) + 8 * (reg >> 2) + 4 * hi; }

__device__ __forceinline__ f32x16 mm32_k64(const LDSP unsigned char* A, int arow0, const LDSP unsigned char* B, int brow0, f32x16 acc, int lane) {
    const int r = lane & 31, h = lane >> 5;
#pragma unroll
    for (int s = 0; s < 4; ++s) {
        const bf16x8 a = *(const LDSP bf16x8*)(A + sw64(arow0 + r, 16 * s + 8 * h));
        const bf16x8 b = *(const LDSP bf16x8*)(B + sw64(brow0 + r, 16 * s + 8 * h));
        acc = __builtin_amdgcn_mfma_f32_32x32x16_bf16(a, b, acc, 0, 0, 0);
    }
    return acc;
}

template <class Epi>
__device__ __forceinline__ void gemm256(LDSP unsigned char* lds, const bf16_t* A, int lda, const int* rowmap, int nvalid, const bf16_t* Bt, int ldb, int K, int m0, int n0,
                                        const Epi& epi) {
    const int tid = opaque(threadIdx.x), wid = tid >> 6, lane = tid & 63, wr = wid >> 2, wc = wid & 3, fr = lane & 15, fq = lane >> 4;
    const int lr = tid >> 3, lc = (tid & 7) * 8;
    unsigned aoff[4], boff[4];
#pragma unroll
    for (int i = 0; i < 4; ++i) {
        const int r = lr + 64 * i;
        int gr = m0 + r;
        if (rowmap) gr = (gr < nvalid) ? rowmap[gr] : 0;
        aoff[i] = (unsigned)gr * (unsigned)lda + lc;
        boff[i] = (unsigned)(n0 + r) * (unsigned)ldb + lc;
    }
    const int wo = lds_byte(lr, lc);
    const int swz = lds_byte(fr, fq * 8);
    u32x4 rg[4];
    f32x4 acc[8][4];
#pragma unroll
    for (int m = 0; m < 8; ++m)
#pragma unroll
        for (int n = 0; n < 4; ++n) acc[m][n] = (f32x4){0.f, 0.f, 0.f, 0.f};
    const int nt = K >> 6;
#pragma unroll
    for (int i = 0; i < 4; ++i) rg[i] = *(const u32x4*)(A + aoff[i]);
#pragma unroll
    for (int i = 0; i < 4; ++i) *(LDSP u32x4*)(lds + wo + 8192 * i) = rg[i];
#pragma unroll
    for (int i = 0; i < 4; ++i) rg[i] = *(const u32x4*)(Bt + boff[i]);
#pragma unroll
    for (int i = 0; i < 4; ++i) *(LDSP u32x4*)(lds + 32768 + wo + 8192 * i) = rg[i];
    __syncthreads();
#pragma unroll 1
    for (int t = 0; t < nt; ++t) {
        const int s = t & 1;
        const bool more = (t + 1 < nt);
        const LDSP unsigned char* bA = lds + s * 65536 + swz;
        const LDSP unsigned char* bB = lds + s * 65536 + 32768 + swz;
        LDSP unsigned char* w = lds + (s ^ 1) * 65536 + wo;
#pragma unroll
        for (int ks = 0; ks < 2; ++ks) {
            if (more) {
                if (ks == 0) {
#pragma unroll
                    for (int i = 0; i < 4; ++i) rg[i] = *(const u32x4*)(A + aoff[i] + (t + 1) * 64);
                } else {
#pragma unroll
                    for (int i = 0; i < 4; ++i) rg[i] = *(const u32x4*)(Bt + boff[i] + (t + 1) * 64);
                }
            }
            bf16x8 a[4], b[4];
#pragma unroll
            for (int n = 0; n < 4; ++n) b[n] = *(const LDSP bf16x8*)(bB + ((wc * 4 + n) * 2 + ks) * 1024);
#pragma unroll
            for (int mh = 0; mh < 2; ++mh) {
#pragma unroll
                for (int m = 0; m < 4; ++m) a[m] = *(const LDSP bf16x8*)(bA + ((wr * 8 + mh * 4 + m) * 2 + ks) * 1024);
#pragma unroll
                for (int m = 0; m < 4; ++m)
#pragma unroll
                    for (int n = 0; n < 4; ++n) acc[mh * 4 + m][n] = __builtin_amdgcn_mfma_f32_16x16x32_bf16(b[n], a[m], acc[mh * 4 + m][n], 0, 0, 0);
            }
            if (more) {
#pragma unroll
                for (int i = 0; i < 4; ++i) *(LDSP u32x4*)(w + (ks ? 32768 : 0) + 8192 * i) = rg[i];
            }
        }
        __syncthreads();
    }
#pragma unroll
    for (int m = 0; m < 8; ++m)
#pragma unroll
        for (int n = 0; n < 4; ++n) epi(m0 + wr * 128 + m * 16 + fr, n0 + wc * 64 + n * 16 + fq * 4, acc[m][n]);
}


namespace pg8 {
constexpr int BM = 256, BK = 64, HALF = 128, HTB = HALF * BK * 2, NXCD = 8;
__device__ __forceinline__ void stage_rc(int b, int& R, int& C) { const int st = b / 1024, sb = b % 1024, swz = sb ^ (((sb >> 9) & 1) << 5); R = (st >> 1) * 16 + swz / 64; C = (st & 1) * 32 + (swz % 64) / 2; }
struct Unit { const char* A; const char* B; const int* rowmap; int nvalid, m0, row0, col0, pos0; };
__device__ __forceinline__ int xcd_remap(int L, int nwg) { const int q = nwg / NXCD, r = nwg % NXCD, xcd = L % NXCD, off = L / NXCD; return (xcd < r ? xcd * (q + 1) : r * (q + 1) + (xcd - r) * q) + off; }

template <class F> struct Epi {
    F f;
    __device__ __forceinline__ void operator()(const f32x4 (&acc)[2][2][4][2], const Unit& u, int wr, int wc, int fr, int fq) const {
#pragma unroll
        for (int ai = 0; ai < 2; ++ai)
#pragma unroll
            for (int m = 0; m < 4; ++m)
#pragma unroll
                for (int bj = 0; bj < 2; ++bj)
#pragma unroll
                    for (int n = 0; n < 2; ++n) f(u, 128 * ai + 64 * wr + 16 * m + fr, 128 * bj + 32 * wc + 16 * n + 4 * fq, acc[ai][bj][m][n]);
    }
};

template <bool GATHER, class EpiT, class Sched>
__device__ __forceinline__ void gemm_phase(LDSP unsigned char* lds, const int K, const Sched& S, const EpiT& E) {
    const int tid = opaque(threadIdx.x), wid = __builtin_amdgcn_readfirstlane(tid >> 6), lane = tid & 63, wr = wid >> 2, wc = wid & 3, fr = lane & 15, fq = lane >> 4;
    const int nt = K / BK;
    unsigned voffA[2], voffB[2];
#pragma unroll
    for (int i = 0; i < 2; ++i) { int R, C; stage_rc(tid * 16 + i * 8192, R, C); voffA[i] = (unsigned)(R * K + C) * 2u; voffB[i] = voffA[i]; }
    const size_t kstep = (size_t)(BK * 2);
    const size_t hstep = (size_t)HALF * K * 2;
    const unsigned ldsw = (unsigned)wid * 1024u;
    const int aoff = lds_byte(wr * 64 + fr, fq * 8), boff = lds_byte(wc * 32 + fr, fq * 8);
#define PG8_SA(b, h) (((b) * 2 + (h)) * HTB)
#define PG8_SB(b, h) ((4 + (b) * 2 + (h)) * HTB)
#define PG8_STAGE(bufoff, gbase, voff) do { _Pragma("unroll") for (int _i = 0; _i < 2; ++_i) \
        __builtin_amdgcn_global_load_lds((const unsigned*)((const char*)(gbase) + (voff)[_i]), (LDSP unsigned*)(lds + (bufoff) + ldsw + _i * 8192), 16, 0, 0); } while (0)
#define PG8_STAGE_A(bufoff, nx, h, ubase, koff) do { if constexpr (GATHER) { unsigned _v[2]; const LDSP unsigned* _ro = rowoff + ((((nx) ? (ui + 1) : ui) & 1) * 4 + (h) * 2) * 512; _v[0] = _ro[0]; _v[1] = _ro[512]; PG8_STAGE(bufoff, (ubase) + (koff), _v); } \
        else { PG8_STAGE(bufoff, (ubase) + (h) * hstep + (koff), voffA); } } while (0)
#define PG8_LDA(dst, b, h) do { _Pragma("unroll") for (int m = 0; m < 4; ++m) _Pragma("unroll") for (int k = 0; k < 2; ++k) dst[m][k] = *(const LDSP bf16x8*)(lds + PG8_SA(b, h) + aoff + m * 2048 + k * 1024); } while (0)
#define PG8_LDB(dst, b, h) do { _Pragma("unroll") for (int n = 0; n < 2; ++n) _Pragma("unroll") for (int k = 0; k < 2; ++k) dst[n][k] = *(const LDSP bf16x8*)(lds + PG8_SB(b, h) + boff + n * 2048 + k * 1024); } while (0)
#define PG8_MMA(ai, bj, At, Bt) do { __builtin_amdgcn_s_setprio(1); _Pragma("unroll") for (int m = 0; m < 4; ++m) _Pragma("unroll") for (int n = 0; n < 2; ++n) _Pragma("unroll") for (int k = 0; k < 2; ++k) \
        acc[ai][bj][m][n] = __builtin_amdgcn_mfma_f32_16x16x32_bf16(Bt[n][k], At[m][k], acc[ai][bj][m][n], 0, 0, 0); __builtin_amdgcn_s_setprio(0); } while (0)
#define PG8_WAIT_V(n) asm volatile("s_waitcnt vmcnt(" #n ")" ::: "memory")
#define PG8_WAIT_L(n) asm volatile("s_waitcnt lgkmcnt(" #n ")" ::: "memory")
#define PG8_BAR __builtin_amdgcn_s_barrier()
#define PG8_SCHED __builtin_amdgcn_sched_barrier(0)
    Unit cur, nxt; int ui = 0;
    if (!S.next(0, cur)) return;
    LDSP unsigned* rowoff = (LDSP unsigned*)(lds + 132096) + tid;
    auto rows_of = [&](const Unit& u, int slot) {
        if constexpr (GATHER) {
#pragma unroll
            for (int h = 0; h < 2; ++h)
#pragma unroll
                for (int i = 0; i < 2; ++i) { int R, C; stage_rc(tid * 16 + i * 8192, R, C); const int idx = u.m0 + h * HALF + R; int gr = idx; if (u.rowmap) gr = (idx < u.nvalid) ? u.rowmap[idx] : 0;
                    rowoff[((slot & 1) * 4 + h * 2 + i) * 512] = (unsigned)(gr * K + C) * 2u; }
        }
    };
    rows_of(cur, 0);
    f32x4 acc[2][2][4][2];
#pragma unroll
    for (int a = 0; a < 2; ++a)
#pragma unroll
        for (int b = 0; b < 2; ++b)
#pragma unroll
            for (int m = 0; m < 4; ++m)
#pragma unroll
                for (int n = 0; n < 2; ++n) acc[a][b][m][n] = (f32x4){0.f, 0.f, 0.f, 0.f};
    bf16x8 At[4][2], B0[2][2], B1[2][2];
    const char* cA = cur.A; const char* cB = cur.B;
    PG8_STAGE(PG8_SB(0, 0), cB, voffB); PG8_STAGE(PG8_SB(0, 1), cB + hstep, voffB); PG8_STAGE_A(PG8_SA(0, 0), false, 0, cA, 0); PG8_STAGE_A(PG8_SA(0, 1), false, 1, cA, 0);
    if (wr == 1) PG8_BAR;
    PG8_WAIT_V(2); PG8_BAR;
    PG8_STAGE(PG8_SB(1, 0), cB + kstep, voffB); PG8_STAGE_A(PG8_SA(1, 0), false, 0, cA, kstep); PG8_STAGE(PG8_SB(1, 1), cB + hstep + kstep, voffB);
    PG8_WAIT_V(6); PG8_BAR;
    for (;;) {
        const bool has_next = S.next(ui + 1, nxt);
        rows_of(has_next ? nxt : cur, ui + 1);
        const char* nA = has_next ? nxt.A : cA; const char* nB = has_next ? nxt.B : cB;
#pragma unroll 1
        for (int t = 0; t < nt; t += 2) {
            const bool last = (t == nt - 2);
            const size_t k1 = (size_t)(t + 1) * kstep;
            const char* a2 = last ? nA : cA; const size_t k2 = last ? 0 : (size_t)(t + 2) * kstep;
            const char* b2 = last ? nB : cB + (size_t)(t + 2) * kstep;
            const char* b3 = b2 + kstep;
            PG8_LDB(B0, 0, 0); PG8_LDB(B1, 0, 1); PG8_SCHED; PG8_LDA(At, 0, 0); PG8_STAGE_A(PG8_SA(1, 1), false, 1, cA, k1);
            PG8_WAIT_V(8); PG8_WAIT_L(0); PG8_BAR; PG8_MMA(0, 0, At, B0); PG8_MMA(0, 1, At, B1); PG8_BAR; PG8_SCHED;
            PG8_LDA(At, 0, 1); PG8_STAGE(PG8_SB(0, 0), b2, voffB); PG8_STAGE(PG8_SB(0, 1), b2 + hstep, voffB); PG8_STAGE_A(PG8_SA(0, 0), last, 0, a2, k2);
            PG8_WAIT_V(8); PG8_WAIT_L(0); PG8_BAR; PG8_MMA(1, 0, At, B0); PG8_MMA(1, 1, At, B1); PG8_BAR; PG8_SCHED;
            PG8_LDB(B0, 1, 0); PG8_LDB(B1, 1, 1); PG8_SCHED; PG8_LDA(At, 1, 0); PG8_STAGE_A(PG8_SA(0, 1), last, 1, a2, k2);
            PG8_WAIT_V(8); PG8_WAIT_L(0); PG8_BAR; PG8_MMA(0, 0, At, B0); PG8_MMA(0, 1, At, B1); PG8_BAR; PG8_SCHED;
            PG8_LDA(At, 1, 1); PG8_STAGE(PG8_SB(1, 0), b3, voffB); PG8_STAGE(PG8_SB(1, 1), b3 + hstep, voffB); PG8_STAGE_A(PG8_SA(1, 0), last, 0, a2, k2 + kstep);
            PG8_WAIT_V(8); PG8_WAIT_L(0); PG8_BAR; PG8_MMA(1, 0, At, B0); PG8_MMA(1, 1, At, B1); PG8_BAR; PG8_SCHED;
        }
        if (wr == 0) PG8_BAR;
        E(acc, cur, wr, wc, fr, fq);
        if (!has_next) break;
#pragma unroll
        for (int a = 0; a < 2; ++a)
#pragma unroll
            for (int b = 0; b < 2; ++b)
#pragma unroll
                for (int m = 0; m < 4; ++m)
#pragma unroll
                    for (int n = 0; n < 2; ++n) acc[a][b][m][n] = (f32x4){0.f, 0.f, 0.f, 0.f};
        cur = nxt; cA = nA; cB = nB; ++ui;
        if (wr == 1) PG8_BAR;
    }
    PG8_WAIT_V(0);
    PG8_BAR;
#undef PG8_SA
#undef PG8_SB
#undef PG8_STAGE
#undef PG8_STAGE_A
#undef PG8_LDA
#undef PG8_LDB
#undef PG8_MMA
#undef PG8_WAIT_V
#undef PG8_WAIT_L
#undef PG8_BAR
#undef PG8_SCHED
}

struct DenseSched {
    const char* A; const char* B; int nM, nN, K, G, c;
    __device__ __forceinline__ bool next(int i, Unit& u) const {
        const int nwg = nM * nN; const long L = (long)i * G + c; if (L >= nwg) return false;
        const int wgid = xcd_remap((int)L, nwg);
        const int nig = 8 * nN, gid = wgid / nig, fm = gid * 8, gsz = (nM - fm) < 8 ? (nM - fm) : 8;
        const int pm = fm + ((wgid % nig) % gsz), pn = (wgid % nig) / gsz;
        u.A = A + (size_t)pm * 256 * K * 2; u.B = B + (size_t)pn * 256 * K * 2; u.rowmap = nullptr; u.nvalid = 0; u.m0 = 0; u.row0 = pm * 256; u.col0 = pn * 256; u.pos0 = 0;
        return true;
    }
};
}

struct EpiPX { bf16_t* PX; __device__ __forceinline__ void operator()(int row, int col, f32x4 v) const {
    u32x2 w; w.x = pk2(v[0], v[1]); w.y = pk2(v[2], v[3]); *(u32x2*)(PX + (size_t)row * INP + col) = w; } };
struct EpiX1 { const float* x; const float* mod; float* X1; __device__ __forceinline__ void operator()(int row, int col, f32x4 v) const {
    const f32x4 xv = *(const f32x4*)(x + (size_t)row * D + col); const f32x4 g = *(const f32x4*)(mod + (size_t)(row >> 12) * 12288 + 2 * D + col);
    *(f32x4*)(X1 + (size_t)row * D + col) = xv + g * v; } };
struct EpiH1 { bf16_t* H1; int pos0, m0, cnt; __device__ __forceinline__ void operator()(int row, int col, f32x4 v) const {
    if (row < cnt) { const float a = v[0] * sigmoidf_(v[0]) * v[2], b = v[1] * sigmoidf_(v[1]) * v[3];
        *(unsigned*)(H1 + (size_t)(pos0 + row) * EFF + (col >> 1)) = pk2(a, b); } } };
struct EpiEO { bf16_t* EO; int pos0, cnt; __device__ __forceinline__ void operator()(int row, int col, f32x4 v) const {
    if (row < cnt) { u32x2 w; w.x = pk2(v[0], v[1]); w.y = pk2(v[2], v[3]); *(u32x2*)(EO + (size_t)(pos0 + row) * D + col) = w; } } };


struct FPX { bf16_t* PX; __device__ __forceinline__ void operator()(const pg8::Unit& u, int lr, int lc, f32x4 v) const {
    u32x2 w; w.x = pk2(v[0], v[1]); w.y = pk2(v[2], v[3]); *(u32x2*)(PX + (size_t)(u.row0 + lr) * INP + u.col0 + lc) = w; } };
struct FX1 { const float* x; const float* mod; float* X1; __device__ __forceinline__ void operator()(const pg8::Unit& u, int lr, int lc, f32x4 v) const {
    const int row = u.row0 + lr, col = u.col0 + lc;
    const f32x4 xv = *(const f32x4*)(x + (size_t)row * D + col); const f32x4 g = *(const f32x4*)(mod + (size_t)(row >> 12) * 12288 + 2 * D + col);
    *(f32x4*)(X1 + (size_t)row * D + col) = xv + g * v; } };
struct FH1 { bf16_t* H1; __device__ __forceinline__ void operator()(const pg8::Unit& u, int lr, int lc, f32x4 v) const {
    if (u.m0 + lr < u.nvalid) { const float a = v[0] * sigmoidf_(v[0]) * v[2], b = v[1] * sigmoidf_(v[1]) * v[3];
        *(unsigned*)(H1 + (size_t)(u.pos0 + u.m0 + lr) * EFF + ((u.col0 + lc) >> 1)) = pk2(a, b); } } };
struct FEO { bf16_t* EO; __device__ __forceinline__ void operator()(const pg8::Unit& u, int lr, int lc, f32x4 v) const {
    if (u.m0 + lr < u.nvalid) { u32x2 w; w.x = pk2(v[0], v[1]); w.y = pk2(v[2], v[3]); *(u32x2*)(EO + (size_t)(u.pos0 + u.m0 + lr) * D + u.col0 + lc) = w; } } };

struct ConvJob { const float* src; bf16_t* dst; int K, N, ld, mode, ntk, ntn; size_t sbs, dbs; };
__device__ __forceinline__ int conv_row(int n, int mode) { return mode == 0 ? n : (4 * (n >> 1) + (n & 1) + (mode == 2 ? 2 : 0)); }

struct TileCtx { const float* src; bf16_t* dst; int N, ld, mode, k0, n0; };
constexpr int CT0 = 0, CT1 = CT0 + 8 * (INC / 64), CT2 = CT1 + 8 * 32, CT3 = CT2 + 64 * 64, CT4 = CT3 + 64 * 64, CT5 = CT4 + 64 * 64, CT6 = CT5 + 64, CT7 = CT6 + 64, CT8 = CT7 + 64, CT_END = CT8 + 16;
__device__ __forceinline__ void conv_decode(const Params& p, int g, const float*& src, bf16_t*& dst, int& N, int& ld, int& mode, int& k0, int& n0) {
    bf16_t* WTE1 = (bf16_t*)(p.ws + OFF_WTE1); bf16_t* WTE2 = (bf16_t*)(p.ws + OFF_WTE2);
    int t, ntk, ntn; size_t sbs = 0, dbs = 0;
    if (g < CT1)      { t = g - CT0; src = p.w_in; dst = (bf16_t*)(p.ws + OFF_WTIN); N = INC; ld = 2048; mode = 0; ntk = 8; ntn = INC / 64; }
    else if (g < CT2) { t = g - CT1; src = p.w_out; dst = (bf16_t*)(p.ws + OFF_WTOUT); N = 2048; ld = 2048; mode = 0; ntk = 8; ntn = 32; }
    else if (g < CT3) { t = g - CT2; src = p.e_gate; dst = WTE1; N = 512; ld = 2048; mode = 1; ntk = 8; ntn = 8; sbs = (size_t)2048 * 512; dbs = (size_t)1024 * 2048; }
    else if (g < CT4) { t = g - CT3; src = p.e_up; dst = WTE1; N = 512; ld = 2048; mode = 2; ntk = 8; ntn = 8; sbs = (size_t)2048 * 512; dbs = (size_t)1024 * 2048; }
    else if (g < CT5) { t = g - CT4; src = p.e_down; dst = WTE2; N = 2048; ld = 512; mode = 0; ntk = 2; ntn = 32; sbs = (size_t)512 * 2048; dbs = (size_t)2048 * 512; }
    else if (g < CT6) { t = g - CT5; src = p.s_gate; dst = WTE1 + (size_t)64 * 1024 * 2048; N = 512; ld = 2048; mode = 1; ntk = 8; ntn = 8; }
    else if (g < CT7) { t = g - CT6; src = p.s_up; dst = WTE1 + (size_t)64 * 1024 * 2048; N = 512; ld = 2048; mode = 2; ntk = 8; ntn = 8; }
    else if (g < CT8) { t = g - CT7; src = p.s_down; dst = WTE2 + (size_t)64 * 2048 * 512; N = 2048; ld = 512; mode = 0; ntk = 2; ntn = 32; }
    else              { t = g - CT8; src = p.gate_up; dst = (bf16_t*)(p.ws + OFF_WTGU); N = 1024; ld = 256; mode = 0; ntk = 1; ntn = 16; }
    const int per = ntk * ntn, bi = t / per, rem = t - bi * per, kt = rem / ntn, ntile = rem - kt * ntn;
    src += (size_t)bi * sbs; dst += (size_t)bi * dbs; k0 = kt * 256; n0 = ntile * 64;
}
__device__ __forceinline__ void conv_load(const float* src, int N, int k0, int n0, f32x4 (&v)[4][2], int tid) {
    const int kr = tid >> 3, nc = (tid & 7) * 8;
#pragma unroll
    for (int s = 0; s < 4; ++s) { const float* q = src + (size_t)(k0 + s * 64 + kr) * N + n0 + nc; v[s][0] = *(const f32x4*)q; v[s][1] = *(const f32x4*)(q + 4); }
}
__device__ __forceinline__ void conv_finish(LDSP unsigned char* lds, bf16_t* dst, int ld, int mode, int k0, int n0, const f32x4 (&v)[4][2], int tid) {
    LDSP float* Tm = (LDSP float*)lds;
    {
        const int kr = tid >> 3, nc = (tid & 7) * 8;
#pragma unroll
        for (int s = 0; s < 4; ++s) { LDSP float* q = Tm + (s * 64 + kr) * 65 + nc;
            q[0] = v[s][0].x; q[1] = v[s][0].y; q[2] = v[s][0].z; q[3] = v[s][0].w; q[4] = v[s][1].x; q[5] = v[s][1].y; q[6] = v[s][1].z; q[7] = v[s][1].w; }
    }
    __syncthreads();
    {
        const int n = tid >> 3; bf16_t* drow = dst + (size_t)conv_row(n0 + n, mode) * ld + k0;
#pragma unroll
        for (int s = 0; s < 4; ++s) { const int kc = ((tid & 7) + 8 * s) * 8; float f[8];
#pragma unroll
            for (int j = 0; j < 8; ++j) f[j] = Tm[(kc + j) * 65 + n];
            u32x4 w; w.x = pk2(f[0], f[1]); w.y = pk2(f[2], f[3]); w.z = pk2(f[4], f[5]); w.w = pk2(f[6], f[7]); *(u32x4*)(drow + kc) = w; }
    }
    __syncthreads();
}

__device__ __forceinline__ void mod_item(LDSP unsigned char* lds, const Params& p, int item) {
    const int kb = item >> 6, nb = item & 63, tid = opaque(threadIdx.x), wid = tid >> 6, lane = tid & 63;
    f32x4 acc[3];
#pragma unroll
    for (int v = 0; v < 3; ++v) acc[v] = mk4f(0.f, 0.f, 0.f, 0.f);
    if (lane < 48) {
#pragma unroll 8
        for (int i = 0; i < 64; ++i) {
            const int k = kb * 512 + wid * 64 + i;
            const float c0 = p.c[k], c1 = p.c[D + k], c2 = p.c_ctx[k];
            const float s0 = c0 * sigmoidf_(c0), s1 = c1 * sigmoidf_(c1), s2 = c2 * sigmoidf_(c2);
            const f32x4 w = *(const f32x4*)(p.w_mod + (size_t)k * 12288 + nb * 192 + 4 * lane);
            acc[0] += s0 * w; acc[1] += s1 * w; acc[2] += s2 * w;
        }
    }
    LDSP float* R = (LDSP float*)lds;
    if (lane < 48) {
#pragma unroll
        for (int v = 0; v < 3; ++v) *(LDSP f32x4*)(R + (wid * 3 + v) * 192 + 4 * lane) = acc[v];
    }
    __syncthreads();
    float* MODP = (float*)(p.ws + OFF_MODP);
    for (int o = tid; o < 3 * 192; o += 512) { const int v = o / 192, cidx = o - v * 192; float sum = 0.f;
#pragma unroll
        for (int w = 0; w < 8; ++w) sum += R[(w * 3 + v) * 192 + cidx];
        MODP[((size_t)kb * 3 + v) * 12288 + nb * 192 + cidx] = sum; }
    __syncthreads();
}

__device__ __forceinline__ void phase0(LDSP unsigned char* lds, const Params& p) {
    const int tid = opaque(threadIdx.x);
    for (int it = blockIdx.x; it < 256; it += gridDim.x) mod_item(lds, p, it);
    {
        int g = blockIdx.x;
        const float* csrc = nullptr; bf16_t* cdst = nullptr; int cN = 0, cld = 0, cmode = 0, ck0 = 0, cn0 = 0;
        const float* nsrc = nullptr; bf16_t* ndst = nullptr; int nN = 0, nld = 0, nmode = 0, nk0 = 0, nn0 = 0;
        f32x4 va[4][2], vb[4][2];
        if (g < CT_END) { conv_decode(p, g, csrc, cdst, cN, cld, cmode, ck0, cn0); conv_load(csrc, cN, ck0, cn0, va, tid); }
#pragma unroll 1
        while (g < CT_END) {
            const int gn = g + gridDim.x;
            if (gn < CT_END) { conv_decode(p, gn, nsrc, ndst, nN, nld, nmode, nk0, nn0); conv_load(nsrc, nN, nk0, nn0, vb, tid); }
            conv_finish(lds, cdst, cld, cmode, ck0, cn0, va, tid);
            cdst = ndst; cld = nld; cmode = nmode; ck0 = nk0; cn0 = nn0; g = gn;
#pragma unroll
            for (int s = 0; s < 4; ++s) { va[s][0] = vb[s][0]; va[s][1] = vb[s][1]; }
        }
    }
    {
        const int total = 4 * 1024 * 128;
        for (int idx = blockIdx.x * 512 + tid; idx < total; idx += gridDim.x * 512) {
            const int mtx = idx >> 17, rem = idx & 131071, n = rem >> 7, k = rem & 127;
            const float* src = (mtx < 2 ? p.decay_up : p.iclr_up) + (size_t)(mtx & 1) * 96 * 1024;
            bf16_t* dst = (bf16_t*)(p.ws + (mtx < 2 ? OFF_WTDU : OFF_WTIU)) + (size_t)(mtx & 1) * 1024 * 128;
            dst[n * 128 + k] = (bf16_t)f2bf(k < 96 ? src[(size_t)k * 1024 + n] : 0.f);
        }
    }
    {
        u32x4* z = (u32x4*)((bf16_t*)(p.ws + OFF_WTIN) + (size_t)INC * D);
        const int total = (INP - INC) * D * 2 / 16;
        for (int idx = blockIdx.x * 512 + tid; idx < total; idx += gridDim.x * 512) z[idx] = mk4u(0, 0, 0, 0);
    }
    if (blockIdx.x == gridDim.x - 1) {
        float2* R = (float2*)(p.ws + OFF_ROPE);
        for (int idx = tid; idx < 1024; idx += 512) { const int pos = idx >> 4, f = idx & 15;
            const float freq = powf(10000.f, -(float)f / 16.f); const float ang = (float)pos * freq; R[idx] = make_float2(cosf(ang), sinf(ang)); }
    }
}

__device__ __forceinline__ void phase1(LDSP unsigned char* lds, const Params& p) {
    const int tid = opaque(threadIdx.x), wid = tid >> 6, lane = tid & 63;
    const float* MODP = (const float*)(p.ws + OFF_MODP);
    float* MOD = (float*)(p.ws + OFF_MOD);
    LDSP float* MV = (LDSP float*)lds;
    for (int idx = tid; idx < 3 * 4096; idx += 512) { const int v = idx >> 12, col = idx & 4095; float s = p.b_mod[col];
#pragma unroll
        for (int kb = 0; kb < 4; ++kb) s += MODP[((size_t)kb * 3 + v) * 12288 + col];
        MV[idx] = s; }
    for (int idx = blockIdx.x * 512 + tid; idx < 3 * 12288; idx += gridDim.x * 512) { const int v = idx / 12288, col = idx - v * 12288; float s = p.b_mod[col];
#pragma unroll
        for (int kb = 0; kb < 4; ++kb) s += MODP[((size_t)kb * 3 + v) * 12288 + col];
        MOD[idx] = s; }
    __syncthreads();
    bf16_t* HX = (bf16_t*)(p.ws + OFF_HX);
    for (int row = blockIdx.x * 8 + wid; row < NR; row += gridDim.x * 8) {
        const float* src = row < NX ? p.x + (size_t)row * D : p.ctx + (size_t)(row - NX) * D;
        const int v = row < NX ? (row >> 12) : 2;
        f32x4 xv[8]; float ss = 0.f;
#pragma unroll
        for (int i = 0; i < 8; ++i) { xv[i] = ((const f32x4*)src)[lane + 64 * i]; ss += xv[i].x * xv[i].x + xv[i].y * xv[i].y + xv[i].z * xv[i].z + xv[i].w * xv[i].w; }
        ss = wave_sum(ss);
        const float rs = rsqrtf(ss * (1.f / D) + 1e-6f);
#pragma unroll
        for (int i = 0; i < 8; ++i) { const int col = 4 * (lane + 64 * i);
            const f32x4 g = *(const f32x4*)(p.norm1_g + col); const LDSP float* sh = MV + v * 4096 + col; const LDSP float* sc = sh + 2048;
            const float h0 = xv[i].x * rs * g.x * (1.f + sc[0]) + sh[0], h1 = xv[i].y * rs * g.y * (1.f + sc[1]) + sh[1];
            const float h2 = xv[i].z * rs * g.z * (1.f + sc[2]) + sh[2], h3 = xv[i].w * rs * g.w * (1.f + sc[3]) + sh[3];
            u32x2 w; w.x = pk2(h0, h1); w.y = pk2(h2, h3); *(u32x2*)(HX + (size_t)row * D + col) = w; }
    }
}

__device__ __forceinline__ void phase2(LDSP unsigned char* lds, const Params& p) {
    pg8::Epi<FPX> epi{FPX{(bf16_t*)(p.ws + OFF_PX)}};
    pg8::DenseSched S{(const char*)(p.ws + OFF_HX), (const char*)(p.ws + OFF_WTIN), NR / 256, INP / 256, D, (int)gridDim.x, (int)blockIdx.x};
    pg8::gemm_phase<false>(lds, D, S, epi);
}

__device__ __forceinline__ float px_shift(const bf16_t* PX, const float* mu, int row, int s0, int len, int col) {
    const float c = bf2f(PX[(size_t)row * INP + col]);
    const float pv = (row > s0) ? bf2f(PX[(size_t)(row - 1) * INP + col]) : 0.f;
    const float nx = (row + 1 < s0 + len) ? bf2f(PX[(size_t)(row + 1) * INP + col]) : 0.f;
    return c + mu[col] * (0.5f * (pv + nx) - c);
}

__device__ __forceinline__ void phaseR1(LDSP unsigned char* lds, const Params& p) {
    const int tid = opaque(threadIdx.x), wid = tid >> 6, lane = tid & 63;
    const bf16_t* PX = (const bf16_t*)(p.ws + OFF_PX);
    for (int row = blockIdx.x * 8 + wid; row < NR; row += gridDim.x * 8) {
        const bool isx = row < NX;
        const int s0 = isx ? (row & ~(T - 1)) : NX + ((row - NX) & ~(CL - 1)), len = isx ? T : CL;
        const bool hp = row > s0, hn = row + 1 < s0 + len;
        const bf16_t* pc = PX + (size_t)row * INP;
#pragma unroll 1
        for (int it = 0; it < 7; ++it) {
            const int ch = lane + 64 * it;
            if (ch < 440) {
                const int col = ch * 8;
                const u32x4 c4 = *(const u32x4*)(pc + col);
                u32x4 p4 = mk4u(0, 0, 0, 0), n4 = mk4u(0, 0, 0, 0);
                if (hp) p4 = *(const u32x4*)(pc - INP + col);
                if (hn) n4 = *(const u32x4*)(pc + INP + col);
                const f32x4 m0 = *(const f32x4*)(p.shift_mu + col), m1 = *(const f32x4*)(p.shift_mu + col + 4);
                const float mu[8] = {m0.x, m0.y, m0.z, m0.w, m1.x, m1.y, m1.z, m1.w};
                const unsigned cw[4] = {c4.x, c4.y, c4.z, c4.w}, pw[4] = {p4.x, p4.y, p4.z, p4.w}, nw[4] = {n4.x, n4.y, n4.z, n4.w};
                float v[8];
#pragma unroll
                for (int j = 0; j < 4; ++j) {
                    const float c0 = bf2f(cw[j] & 0xffff), c1 = bf2f(cw[j] >> 16);
                    v[2 * j] = c0 + mu[2 * j] * (0.5f * (bf2f(pw[j] & 0xffff) + bf2f(nw[j] & 0xffff)) - c0);
                    v[2 * j + 1] = c1 + mu[2 * j + 1] * (0.5f * (bf2f(pw[j] >> 16) + bf2f(nw[j] >> 16)) - c1);
                }
                if (it < 2) {
                    *(u32x4*)((bf16_t*)(p.ws + OFF_RS) + (size_t)row * 1024 + col) = mk4u(pk2(v[0], v[1]), pk2(v[2], v[3]), pk2(v[4], v[5]), pk2(v[6], v[7]));
                } else if (it < 4) {
                    const int kc = col - C_K;
                    *(u32x4*)((bf16_t*)(p.ws + OFF_KS) + (size_t)row * 1024 + kc) = mk4u(pk2(v[0], v[1]), pk2(v[2], v[3]), pk2(v[4], v[5]), pk2(v[6], v[7]));
                    const f32x4 k0 = *(const f32x4*)(p.k_k + kc), k1 = *(const f32x4*)(p.k_k + kc + 4);
                    const float kq[8] = {k0.x, k0.y, k0.z, k0.w, k1.x, k1.y, k1.z, k1.w};
                    float ss = 0.f;
#pragma unroll
                    for (int j = 0; j < 8; ++j) { v[j] *= kq[j]; ss += v[j] * v[j]; }
                    ss += __shfl_xor(ss, 1); ss += __shfl_xor(ss, 2); ss += __shfl_xor(ss, 4);
                    const float sc = rsqrtf(ss + 1e-12f);
                    *(u32x4*)((bf16_t*)(p.ws + OFF_KK) + (size_t)row * 1024 + kc) = mk4u(pk2(v[0] * sc, v[1] * sc), pk2(v[2] * sc, v[3] * sc), pk2(v[4] * sc, v[5] * sc), pk2(v[6] * sc, v[7] * sc));
                } else if (it < 6) {
                    *(u32x4*)((bf16_t*)(p.ws + OFF_VS) + (size_t)row * 1024 + col - C_V) = mk4u(pk2(v[0], v[1]), pk2(v[2], v[3]), pk2(v[4], v[5]), pk2(v[6], v[7]));
                } else if (ch < 396) {
#pragma unroll
                    for (int j = 0; j < 8; ++j) v[j] = tanhf(v[j]);
                    *(u32x4*)((bf16_t*)(p.ws + OFF_TW) + (size_t)row * 128 + col - C_XW) = mk4u(pk2(v[0], v[1]), pk2(v[2], v[3]), pk2(v[4], v[5]), pk2(v[6], v[7]));
                } else if (ch < 408) {
                    *(u32x4*)((bf16_t*)(p.ws + OFF_XA) + (size_t)row * 128 + col - C_XA) = mk4u(pk2(v[0], v[1]), pk2(v[2], v[3]), pk2(v[4], v[5]), pk2(v[6], v[7]));
                } else if (isx) {
#pragma unroll
                    for (int j = 0; j < 8; ++j) v[j] = sigmoidf_(v[j]);
                    *(u32x4*)((bf16_t*)(p.ws + OFF_SG) + (size_t)row * 256 + col - C_XG) = mk4u(pk2(v[0], v[1]), pk2(v[2], v[3]), pk2(v[4], v[5]), pk2(v[6], v[7]));
                }
            }
        }
        if (lane < 4) { *(u32x4*)((bf16_t*)(p.ws + OFF_TW) + (size_t)row * 128 + 96 + lane * 8) = mk4u(0, 0, 0, 0); *(u32x4*)((bf16_t*)(p.ws + OFF_XA) + (size_t)row * 128 + 96 + lane * 8) = mk4u(0, 0, 0, 0); }
    }
}

struct LoraSched {
    const char *A0, *B0, *A1, *B1; int G, c;
    __device__ __forceinline__ bool next(int i, pg8::Unit& u) const {
        const int per = (NR / 256) * 8; const long L = (long)i * G + c; if (L >= 2 * per) return false;
        const int job = (int)L / per, w = (int)L % per, pm = w >> 3, pn = w & 7;
        u.A = (job ? A1 : A0) + (size_t)pm * 256 * 128 * 2; u.B = (job ? B1 : B0) + (size_t)pn * 256 * 128 * 2; u.rowmap = nullptr; u.nvalid = 0; u.m0 = 0; u.row0 = pm * 256; u.col0 = pn * 256; u.pos0 = job;
        return true;
    }
};
struct FLORA { const float* dbias; const float* ibias; bf16_t* LWG; bf16_t* AIG; __device__ __forceinline__ void operator()(const pg8::Unit& u, int lr, int lc, f32x4 v) const {
    const int row = u.row0 + lr, col = u.col0 + lc;
    float o[4];
    if (u.pos0 == 0) { const f32x4 b = *(const f32x4*)(dbias + col);
#pragma unroll
        for (int e = 0; e < 4; ++e) o[e] = -0.60653065971f * sigmoidf_(b[e] + v[e]);
        u32x2 w; w.x = pk2(o[0], o[1]); w.y = pk2(o[2], o[3]); *(u32x2*)(LWG + (size_t)row * 2048 + col) = w;
    } else { const f32x4 b = *(const f32x4*)(ibias + col);
#pragma unroll
        for (int e = 0; e < 4; ++e) o[e] = sigmoidf_(b[e] + v[e]);
        u32x2 w; w.x = pk2(o[0], o[1]); w.y = pk2(o[2], o[3]); *(u32x2*)(AIG + (size_t)row * 2048 + col) = w; }
} };
struct FGG { bf16_t* GG; __device__ __forceinline__ void operator()(const pg8::Unit& u, int lr, int lc, f32x4 v) const {
    u32x2 w; w.x = pk2(v[0], v[1]); w.y = pk2(v[2], v[3]); *(u32x2*)(GG + (size_t)(u.row0 + lr) * 1024 + u.col0 + lc) = w; } };

constexpr int L_AT = 0, L_RT = 8192, L_BT = 16384, L_KT = 24576, L_BHT = 32768, L_KHT = 40960, L_VT = 49152, L_AAK = 57344, L_ARB = 65536, L_ARK = 73728,
              L_P0 = 81920, L_PT0 = 90112, L_P1 = 98304, L_PT1 = 106496, L_X0 = 114688, L_X1 = 131072, L_SEG = 147456, L_GL = 149504, L_END = 149760;
static_assert(L_END <= SMEM_BYTES, "R3 LDS map");

__device__ __forceinline__ int inst_index(int b, int h, int d, int chunk) { return ((b * 16 + h) * 2 + d) * NCHUNK + chunk; }

__device__ __forceinline__ void store_t(LDSP unsigned char* dst, int yrow, int x0, const f32x16& acc, int lane) {
    const int hh = lane >> 5;
#pragma unroll
    for (int gq = 0; gq < 4; ++gq) *(LDSP u32x2*)(dst + sw64(yrow, x0 + 8 * gq + 4 * hh)) = mk2u(pk2(acc[4 * gq], acc[4 * gq + 1]), pk2(acc[4 * gq + 2], acc[4 * gq + 3]));
}

__device__ __forceinline__ void rwkv_prep_unit(LDSP unsigned char* lds, const Params& p, int unit) {
    int seq, c, h, d;
    if (unit < 4096) { seq = unit >> 11; c = (unit >> 5) & 63; h = (unit >> 1) & 15; d = unit & 1; } else { const int u = unit - 4096; seq = 2 + (u >> 7); c = (u >> 5) & 3; h = (u >> 1) & 15; d = u & 1; }
    const bool isx = seq < 2;
    const int b = seq & 1;
    const int s0 = isx ? b * T : NX + b * CL, t0 = c * 64;
    const int chunk_id = isx ? 4 + c : c;
    {
        const int tid = opaque(threadIdx.x), seg = tid >> 6, lane = tid & 63, k = lane, hk = h * 64 + k;
        const float kac = p.k_a[hk];
        const bf16_t* RS = (const bf16_t*)(p.ws + OFF_RS); const bf16_t* KS = (const bf16_t*)(p.ws + OFF_KS); const bf16_t* KKp = (const bf16_t*)(p.ws + OFF_KK); const bf16_t* VS = (const bf16_t*)(p.ws + OFF_VS);
        const bf16_t* LWG = (const bf16_t*)(p.ws + OFF_LWG); const bf16_t* AIG = (const bf16_t*)(p.ws + OFF_AIG);
        float rr[8], kd[8], vv[8], aa[8], bb[8], lw[8];
        float run = 0.f;
#pragma unroll
        for (int tt = 0; tt < 8; ++tt) {
            const int i = seg * 8 + tt, tau = d ? 63 - i : i; const size_t row = (size_t)(s0 + t0 + tau);
            rr[tt] = bf2f(RS[row * 1024 + hk]); const float kraw = bf2f(KS[row * 1024 + hk]), kk = bf2f(KKp[row * 1024 + hk]); vv[tt] = bf2f(VS[row * 1024 + hk]);
            const float lwv = bf2f(LWG[row * 2048 + d * 1024 + hk]), a = bf2f(AIG[row * 2048 + d * 1024 + hk]);
            kd[tt] = kraw * (1.f + (a - 1.f) * kac); bb[tt] = kk * a; aa[tt] = -kk;
            run += lwv; lw[tt] = run;
        }
        LDSP float* SEG = (LDSP float*)(lds + L_SEG);
        SEG[seg * 64 + k] = run;
        __syncthreads();
        float off = 0.f, gL = 0.f;
#pragma unroll
        for (int s = 0; s < 8; ++s) { const float sv = SEG[s * 64 + k]; if (s < seg) off += sv; gL += sv; }
        if (seg == 0) ((LDSP float*)(lds + L_GL))[k] = gL;
        unsigned xat[8], xbh[8], xkh[8], xv[8];
#pragma unroll
        for (int tt = 0; tt < 8; ++tt) {
            const int i = seg * 8 + tt;
            const float g = off + lw[tt];
            const float ge = (tt == 0) ? off : off + lw[tt - 1];
            const float eg = __expf(g), eng = __expf(-g), ege = __expf(ge), egl = __expf(gL - g);
            xat[tt] = f2bf(aa[tt] * ege); xbh[tt] = f2bf(bb[tt] * egl); xkh[tt] = f2bf(kd[tt] * egl); xv[tt] = f2bf(vv[tt]);
            *(LDSP bf16_t*)(lds + L_AT + sw64(i, k)) = (bf16_t)xat[tt];
            *(LDSP bf16_t*)(lds + L_RT + sw64(i, k)) = (bf16_t)f2bf(rr[tt] * eg);
            *(LDSP bf16_t*)(lds + L_BT + sw64(i, k)) = (bf16_t)f2bf(bb[tt] * eng);
            *(LDSP bf16_t*)(lds + L_KT + sw64(i, k)) = (bf16_t)f2bf(kd[tt] * eng);
        }
        *(LDSP u32x4*)(lds + L_X0 + sw64(k, seg * 8)) = mk4u(xat[0] | (xat[1] << 16), xat[2] | (xat[3] << 16), xat[4] | (xat[5] << 16), xat[6] | (xat[7] << 16));
        *(LDSP u32x4*)(lds + L_BHT + sw64(k, seg * 8)) = mk4u(xbh[0] | (xbh[1] << 16), xbh[2] | (xbh[3] << 16), xbh[4] | (xbh[5] << 16), xbh[6] | (xbh[7] << 16));
        *(LDSP u32x4*)(lds + L_KHT + sw64(k, seg * 8)) = mk4u(xkh[0] | (xkh[1] << 16), xkh[2] | (xkh[3] << 16), xkh[4] | (xkh[5] << 16), xkh[6] | (xkh[7] << 16));
        *(LDSP u32x4*)(lds + L_VT + sw64(k, seg * 8)) = mk4u(xv[0] | (xv[1] << 16), xv[2] | (xv[3] << 16), xv[4] | (xv[5] << 16), xv[6] | (xv[7] << 16));
    }
    __syncthreads();
    {
        const int tid = opaque(threadIdx.x), wid = tid >> 6, lane = tid & 63, r = lane & 31, hh = lane >> 5;
        for (int q = wid; q < 20; q += 8) {
            const int kind = q >> 2, xb = (q >> 1) & 1, yb = q & 1;
            const int Aoff = (kind == 0) ? L_BT : (kind == 1) ? L_AT : (kind == 2) ? L_KT : (kind == 3) ? L_BT : L_KT;
            const int Boff = (kind == 0) ? L_AT : (kind == 1) ? L_BT : (kind == 2) ? L_AT : L_RT;
            const int Doff = (kind == 0) ? L_P0 : (kind == 1) ? L_PT0 : (kind == 2) ? L_AAK : (kind == 3) ? L_ARB : L_ARK;
            f32x16 acc = mm32_k64(lds + Aoff, 32 * xb, lds + Boff, 32 * yb, zero16(), lane);
            const int y = 32 * yb + r;
#pragma unroll
            for (int g = 0; g < 16; ++g) { const int x = 32 * xb + crow(g, hh);
                const bool keep = (kind == 1) ? (y < x) : (kind >= 3) ? (x <= y) : (x < y);
                acc[g] = keep ? acc[g] : 0.f; }
            store_t(lds + Doff, y, 32 * xb, acc, lane);
        }
    }
    __syncthreads();
    {
        const int tid = opaque(threadIdx.x), wid = tid >> 6, lane = tid & 63, r = lane & 31;
        if (wid < 4) { const int ib = wid >> 1, vb = wid & 1;
            const f32x16 acc = mm32_k64(lds + L_AAK, 32 * ib, lds + L_VT, 32 * vb, zero16(), lane);
            store_t(lds + L_X0, 64 + 32 * vb + r, 32 * ib, acc, lane); }
    }
    __syncthreads();
#pragma unroll 1
    for (int s = 0; s < 6; ++s) {
        const int tid = opaque(threadIdx.x), wid = tid >> 6, lane = tid & 63, r = lane & 31, hh = lane >> 5;
        const LDSP unsigned char* Pc = lds + ((s & 1) ? L_P1 : L_P0); const LDSP unsigned char* PTc = lds + ((s & 1) ? L_PT1 : L_PT0); const LDSP unsigned char* Xc = lds + ((s & 1) ? L_X1 : L_X0);
        LDSP unsigned char* Pn = lds + ((s & 1) ? L_P0 : L_P1); LDSP unsigned char* PTn = lds + ((s & 1) ? L_PT0 : L_PT1); LDSP unsigned char* Xn = lds + ((s & 1) ? L_X0 : L_X1);
        {
            const int ib = wid & 1, cb = wid >> 1, col = 32 * cb + r;
            f32x16 acc;
#pragma unroll
            for (int gq = 0; gq < 4; ++gq) { const u32x2 w = *(const LDSP u32x2*)(Xc + sw64(col, 32 * ib + 8 * gq + 4 * hh));
                acc[4 * gq] = bf2f(w.x & 0xffff); acc[4 * gq + 1] = bf2f(w.x >> 16); acc[4 * gq + 2] = bf2f(w.y & 0xffff); acc[4 * gq + 3] = bf2f(w.y >> 16); }
            acc = mm32_k64(Pc, 32 * ib, Xc, 32 * cb, acc, lane);
            store_t(Xn, col, 32 * ib, acc, lane);
        }
        if (s < 5) {
            const int w4 = wid & 3, xb = w4 >> 1, yb = w4 & 1;
            if (wid < 4) { const f32x16 acc = mm32_k64(PTc, 32 * xb, Pc, 32 * yb, zero16(), lane); store_t(Pn, 32 * yb + r, 32 * xb, acc, lane); }
            else { const f32x16 acc = mm32_k64(Pc, 32 * xb, PTc, 32 * yb, zero16(), lane); store_t(PTn, 32 * yb + r, 32 * xb, acc, lane); }
        }
        __syncthreads();
    }
    {
        const int tid = opaque(threadIdx.x), wid = tid >> 6, lane = tid & 63, r = lane & 31, hh = lane >> 5;
        const int mi = wid >> 1, half = wid & 1;
        const size_t inst = (size_t)inst_index(b, h, d, chunk_id) * 4096;
        bf16_t* dst = (bf16_t*)(p.ws + (mi == 0 ? OFF_CM : mi == 1 ? OFF_CN : mi == 2 ? OFF_CP : OFF_CQ)) + inst;
        const LDSP unsigned char* XT = lds + L_X0;
        if (isx || mi < 2) {
#pragma unroll
            for (int xb = 0; xb < 2; ++xb) {
                f32x16 acc = zero16();
                if (mi == 0) acc = mm32_k64(XT, 32 * xb, lds + L_BHT, 32 * half, acc, lane);
                else if (mi == 1) { acc = mm32_k64(lds + L_BHT, 32 * xb, XT, 64 + 32 * half, acc, lane); acc = mm32_k64(lds + L_KHT, 32 * xb, lds + L_VT, 32 * half, acc, lane); }
                else if (mi == 2) acc = mm32_k64(XT, 32 * xb, lds + L_ARB, 32 * half, acc, lane);
                else { acc = mm32_k64(XT, 64 + 32 * xb, lds + L_ARB, 32 * half, acc, lane); acc = mm32_k64(lds + L_VT, 32 * xb, lds + L_ARK, 32 * half, acc, lane); }
                const int y = 32 * half + r;
#pragma unroll
                for (int gq = 0; gq < 4; ++gq) {
                    const int x0 = 32 * xb + 8 * gq + 4 * hh;
                    float v0 = acc[4 * gq], v1 = acc[4 * gq + 1], v2 = acc[4 * gq + 2], v3 = acc[4 * gq + 3];
                    if (mi == 0) { const float dg = __expf(((const LDSP float*)(lds + L_GL))[y]); if (x0 == y) v0 += dg; if (x0 + 1 == y) v1 += dg; if (x0 + 2 == y) v2 += dg; if (x0 + 3 == y) v3 += dg; }
                    if (mi == 2) { const u32x2 w = *(const LDSP u32x2*)(lds + L_RT + sw64(y, x0)); v0 += bf2f(w.x & 0xffff); v1 += bf2f(w.x >> 16); v2 += bf2f(w.y & 0xffff); v3 += bf2f(w.y >> 16); }
                    *(u32x2*)(dst + ((half * 4 + 2 * xb + (gq >> 1)) * 64 + hh * 32 + r) * 8 + 4 * (gq & 1)) = mk2u(pk2(v0, v1), pk2(v2, v3));
                }
            }
        }
    }
    __syncthreads();
}

constexpr int LA_K = 0  , LA_VT = 73728  , LA_END = LA_VT + 18 * 4608;
static_assert(LA_END <= SMEM_BYTES, "attention LDS map");

__device__ __forceinline__ void attn_unit(LDSP unsigned char* lds, const Params& p, int unit) {
    const int tid = opaque(threadIdx.x), wid = tid >> 6, lane = tid & 63;
    const int b = unit >> 8, kvh = (unit >> 6) & 3, qb = unit & 63, q0 = qb * 64;
    const bf16_t* PX = (const bf16_t*)(p.ws + OFF_PX);
    const float2* ROPE = (const float2*)(p.ws + OFF_ROPE);
    for (int task = tid; task < 576 * 4; task += 512) {
        const int key = task >> 2, pr = task & 3, c0 = (pr & 1) + 4 * (pr >> 1);
        u32x4 w0 = mk4u(0, 0, 0, 0), w1 = mk4u(0, 0, 0, 0);
        if (key < 320) {
            const int pos = q0 - 128 + key;
            if (pos >= 0 && pos < T) {
                const bf16_t* src = PX + (size_t)(b * T + pos) * INP + C_AK + kvh * 64 + c0 * 8;
                const u32x4 x1 = *(const u32x4*)src, x2 = *(const u32x4*)(src + 16);
                const int ppos = (pr < 2) ? (pos >> 6) : (pos & 63);
                const float2* tb = ROPE + ppos * 16 + (pr & 1) * 8;
                const unsigned a1[4] = {x1.x, x1.y, x1.z, x1.w}, a2[4] = {x2.x, x2.y, x2.z, x2.w};
                unsigned o1[4], o2[4];
#pragma unroll
                for (int j = 0; j < 4; ++j) {
                    const float2 cs0 = tb[2 * j], cs1 = tb[2 * j + 1];
                    const float u0 = bf2f(a1[j] & 0xffff), u1 = bf2f(a1[j] >> 16), v0 = bf2f(a2[j] & 0xffff), v1 = bf2f(a2[j] >> 16);
                    o1[j] = pk2(u0 * cs0.x - v0 * cs0.y, u1 * cs1.x - v1 * cs1.y);
                    o2[j] = pk2(v0 * cs0.x + u0 * cs0.y, v1 * cs1.x + u1 * cs1.y);
                }
                w0 = mk4u(o1[0], o1[1], o1[2], o1[3]); w1 = mk4u(o2[0], o2[1], o2[2], o2[3]);
            }
        } else {
            const bf16_t* src = PX + (size_t)(NX + b * CL + (key - 320)) * INP + C_AK + kvh * 64 + c0 * 8;
            w0 = *(const u32x4*)src; w1 = *(const u32x4*)(src + 16);
        }
        *(LDSP u32x4*)(lds + LA_K + sw64(key, c0 * 8)) = w0;
        *(LDSP u32x4*)(lds + LA_K + sw64(key, c0 * 8 + 16)) = w1;
    }
    for (int task = tid; task < 144 * 8; task += 512) {
        const int kg = task >> 3, dc = task & 7;
        unsigned short e[4][8];
#pragma unroll
        for (int q = 0; q < 4; ++q) {
            const int key = kg * 4 + q;
            u32x4 w = mk4u(0, 0, 0, 0);
            if (key < 320) { const int pos = q0 - 128 + key; if (pos >= 0 && pos < T) w = *(const u32x4*)(PX + (size_t)(b * T + pos) * INP + C_AV + kvh * 64 + dc * 8); }
            else w = *(const u32x4*)(PX + (size_t)(NX + b * CL + (key - 320)) * INP + C_AV + kvh * 64 + dc * 8);
            e[q][0] = w.x & 0xffff; e[q][1] = w.x >> 16; e[q][2] = w.y & 0xffff; e[q][3] = w.y >> 16; e[q][4] = w.z & 0xffff; e[q][5] = w.z >> 16; e[q][6] = w.w & 0xffff; e[q][7] = w.w >> 16;
        }
        const int tile = kg >> 3, kin = (kg & 7) * 4;
#pragma unroll
        for (int j = 0; j < 8; ++j) { u32x2 w; w.x = (unsigned)e[0][j] | ((unsigned)e[1][j] << 16); w.y = (unsigned)e[2][j] | ((unsigned)e[3][j] << 16);
            *(LDSP u32x2*)(lds + LA_VT + tile * 4608 + (dc * 8 + j) * 72 + kin * 2) = w; }
    }
    const int hq = kvh * 4 + (wid >> 1), qs = (wid & 1) * 32, r = lane & 31, hh = lane >> 5;
    const int qpos = q0 + qs + r;
    bf16x8 qf[4];
    {
        const bf16_t* src = PX + (size_t)(b * T + qpos) * INP + C_Q + hq * 64 + 8 * hh;
        u32x4 raw[4];
#pragma unroll
        for (int s = 0; s < 4; ++s) raw[s] = *(const u32x4*)(src + 16 * s);
#pragma unroll
        for (int pr = 0; pr < 2; ++pr) {
            const int ppos = pr == 0 ? (qpos >> 6) : (qpos & 63);
            const float2* tb = ROPE + ppos * 16 + 8 * hh;
            const unsigned a1[4] = {raw[2 * pr].x, raw[2 * pr].y, raw[2 * pr].z, raw[2 * pr].w}, a2[4] = {raw[2 * pr + 1].x, raw[2 * pr + 1].y, raw[2 * pr + 1].z, raw[2 * pr + 1].w};
            unsigned o1[4], o2[4];
#pragma unroll
            for (int j = 0; j < 4; ++j) {
                const float2 cs0 = tb[2 * j], cs1 = tb[2 * j + 1];
                const float u0 = bf2f(a1[j] & 0xffff), u1 = bf2f(a1[j] >> 16), v0 = bf2f(a2[j] & 0xffff), v1 = bf2f(a2[j] >> 16);
                o1[j] = pk2(0.125f * (u0 * cs0.x - v0 * cs0.y), 0.125f * (u1 * cs1.x - v1 * cs1.y));
                o2[j] = pk2(0.125f * (v0 * cs0.x + u0 * cs0.y), 0.125f * (v1 * cs1.x + u1 * cs1.y));
            }
            const u32x4 w1 = mk4u(o1[0], o1[1], o1[2], o1[3]), w2 = mk4u(o2[0], o2[1], o2[2], o2[3]);
            qf[2 * pr] = __builtin_bit_cast(bf16x8, w1); qf[2 * pr + 1] = __builtin_bit_cast(bf16x8, w2);
        }
    }
    __syncthreads();
    float m = p.attn_sink[hq], l = 1.f;
    f32x16 o0 = zero16(), o1 = zero16();
    for (int tl = 0; tl < 18; ++tl) {
        f32x16 st = zero16();
#pragma unroll
        for (int s = 0; s < 4; ++s) {
            const bf16x8 kf = *(const LDSP bf16x8*)(lds + LA_K + sw64(32 * tl + r, 16 * s + 8 * hh));
            st = __builtin_amdgcn_mfma_f32_32x32x16_bf16(kf, qf[s], st, 0, 0, 0);
        }
        if (tl < 10) {
#pragma unroll
            for (int g = 0; g < 16; ++g) { const int kp = q0 - 128 + 32 * tl + crow(g, hh); const int dlt = qpos - kp;
                const bool ok = (dlt <= 128) && (dlt >= -128) && (kp >= 0) && (kp < T); st[g] = ok ? st[g] : -1e30f; }
        }
        float mt = st[0];
#pragma unroll
        for (int g = 1; g < 16; ++g) mt = fmaxf(mt, st[g]);
        mt = fmaxf(mt, __shfl_xor(mt, 32));
        const float mn = fmaxf(m, mt), alpha = __expf(m - mn);
        float ps = 0.f;
#pragma unroll
        for (int g = 0; g < 16; ++g) { st[g] = __expf(st[g] - mn); ps += st[g]; }
        ps += __shfl_xor(ps, 32);
        l = l * alpha + ps; m = mn;
#pragma unroll
        for (int g = 0; g < 16; ++g) { o0[g] *= alpha; o1[g] *= alpha; }
#pragma unroll
        for (int s2 = 0; s2 < 2; ++s2) {
            const u32x4 pw = mk4u(pk2(st[8 * s2], st[8 * s2 + 1]), pk2(st[8 * s2 + 2], st[8 * s2 + 3]), pk2(st[8 * s2 + 4], st[8 * s2 + 5]), pk2(st[8 * s2 + 6], st[8 * s2 + 7]));
            const bf16x8 pf = __builtin_bit_cast(bf16x8, pw);
#pragma unroll
            for (int dm = 0; dm < 2; ++dm) {
                const LDSP unsigned char* vp = lds + LA_VT + tl * 4608 + (32 * dm + r) * 72 + (16 * s2 + 4 * hh) * 2;
                const u32x2 v0 = *(const LDSP u32x2*)vp, v1 = *(const LDSP u32x2*)(vp + 16);
                const bf16x8 vf = __builtin_bit_cast(bf16x8, mk4u(v0.x, v0.y, v1.x, v1.y));
                if (dm == 0) o0 = __builtin_amdgcn_mfma_f32_32x32x16_bf16(vf, pf, o0, 0, 0, 0); else o1 = __builtin_amdgcn_mfma_f32_32x32x16_bf16(vf, pf, o1, 0, 0, 0);
            }
        }
    }
    {
        const float inv = 1.f / l;
        bf16_t* dst = (bf16_t*)(p.ws + OFF_MIX) + (size_t)(b * T + qpos) * D + 1024 + hq * 64;
#pragma unroll
        for (int gq = 0; gq < 4; ++gq) {
            u32x2 w; w.x = pk2(o0[4 * gq] * inv, o0[4 * gq + 1] * inv); w.y = pk2(o0[4 * gq + 2] * inv, o0[4 * gq + 3] * inv); *(u32x2*)(dst + 8 * gq + 4 * hh) = w;
            u32x2 w2; w2.x = pk2(o1[4 * gq] * inv, o1[4 * gq + 1] * inv); w2.y = pk2(o1[4 * gq + 2] * inv, o1[4 * gq + 3] * inv); *(u32x2*)(dst + 32 + 8 * gq + 4 * hh) = w2;
        }
    }
    __syncthreads();
}

__device__ __forceinline__ void phaseR2(LDSP unsigned char* lds, const Params& p) {
    {
        pg8::Epi<FLORA> epi{FLORA{p.decay_bias, p.iclr_bias, (bf16_t*)(p.ws + OFF_LWG), (bf16_t*)(p.ws + OFF_AIG)}};
        LoraSched S{(const char*)(p.ws + OFF_TW), (const char*)(p.ws + OFF_WTDU), (const char*)(p.ws + OFF_XA), (const char*)(p.ws + OFF_WTIU), (int)gridDim.x, (int)blockIdx.x};
        pg8::gemm_phase<false>(lds, opaque_s(128), S, epi);
    }
    {
        pg8::Epi<FGG> epi{FGG{(bf16_t*)(p.ws + OFF_GG)}};
        pg8::DenseSched S{(const char*)(p.ws + OFF_SG), (const char*)(p.ws + OFF_WTGU), NX / 256, 1024 / 256, 256, (int)gridDim.x, (int)(gridDim.x - 1 - blockIdx.x)};
        pg8::gemm_phase<false>(lds, opaque_s(256), S, epi);
    }
    __syncthreads();
    for (int u = blockIdx.x; u < 512; u += gridDim.x) attn_unit(lds, p, u);
}

__device__ __forceinline__ void phaseR3(LDSP unsigned char* lds, const Params& p) {
    for (int u = blockIdx.x; u < 4096 + 256; u += gridDim.x) rwkv_prep_unit(lds, p, u);
}

constexpr size_t OFF_HT = OFF_YD;
__device__ __forceinline__ void scan_wave(const Params& p, int item, int lane) {
    const int chain = item >> 1, vb = item & 1, b = chain >> 5, h = (chain >> 1) & 15, d = chain & 1;
    const bf16_t* CM = (const bf16_t*)(p.ws + OFF_CM); const bf16_t* CN = (const bf16_t*)(p.ws + OFF_CN); bf16_t* HT = (bf16_t*)(p.ws + OFF_HT);
    u32x4 na[2][4], nn[2][2];
    auto chunk_of = [&](int step) { return (step < 4) ? (d ? 3 - step : step) : (d ? 4 + (67 - step) : step); };
    auto prefetch = [&](int step) {
        const size_t inst = (size_t)inst_index(b, h, d, chunk_of(step)) * 4096;
#pragma unroll
        for (int rt = 0; rt < 2; ++rt) {
#pragma unroll
            for (int s = 0; s < 4; ++s) na[rt][s] = *(const u32x4*)(CM + inst + ((rt * 4 + s) * 64 + lane) * 8);
#pragma unroll
            for (int g2 = 0; g2 < 2; ++g2) nn[rt][g2] = *(const u32x4*)(CN + inst + (((vb * 2 + rt) * 2 + g2) * 64 + lane) * 8);
        }
    };
    f32x16 hacc[2]; hacc[0] = zero16(); hacc[1] = zero16();
    prefetch(0);
#pragma unroll 1
    for (int step = 0; step < NCHUNK; ++step) {
        const int chunk_id = chunk_of(step);
        u32x4 a[2][4], n[2][2];
#pragma unroll
        for (int rt = 0; rt < 2; ++rt) {
#pragma unroll
            for (int s = 0; s < 4; ++s) a[rt][s] = na[rt][s];
            n[rt][0] = nn[rt][0]; n[rt][1] = nn[rt][1];
        }
        if (step + 1 < NCHUNK) prefetch(step + 1);
        bf16x8 bfr[4];
#pragma unroll
        for (int s = 0; s < 4; ++s) { const f32x16& t = hacc[s >> 1]; const int o = 8 * (s & 1);
            bfr[s] = __builtin_bit_cast(bf16x8, mk4u(pk2(t[o], t[o + 1]), pk2(t[o + 2], t[o + 3]), pk2(t[o + 4], t[o + 5]), pk2(t[o + 6], t[o + 7]))); }
        if (chunk_id >= 4) {
            bf16_t* hp = HT + (size_t)inst_index(b, h, d, chunk_id) * 4096 + (vb * 4 * 64 + lane) * 8;
#pragma unroll
            for (int s = 0; s < 4; ++s) *(bf16x8*)(hp + s * 512) = bfr[s];
        }
#pragma unroll
        for (int rt = 0; rt < 2; ++rt) {
            f32x16 acc;
#pragma unroll
            for (int g2 = 0; g2 < 2; ++g2) { const u32x4 w = n[rt][g2];
                acc[8 * g2] = bf2f(w.x & 0xffff); acc[8 * g2 + 1] = bf2f(w.x >> 16); acc[8 * g2 + 2] = bf2f(w.y & 0xffff); acc[8 * g2 + 3] = bf2f(w.y >> 16);
                acc[8 * g2 + 4] = bf2f(w.z & 0xffff); acc[8 * g2 + 5] = bf2f(w.z >> 16); acc[8 * g2 + 6] = bf2f(w.w & 0xffff); acc[8 * g2 + 7] = bf2f(w.w >> 16); }
#pragma unroll
            for (int s = 0; s < 4; ++s) acc = __builtin_amdgcn_mfma_f32_32x32x16_bf16(__builtin_bit_cast(bf16x8, a[rt][s]), bfr[s], acc, 0, 0, 0);
            hacc[rt] = acc;
        }
    }
}
__device__ __forceinline__ void phaseR4(LDSP unsigned char* lds, const Params& p) {
    const int tid = opaque(threadIdx.x), wid = tid >> 6, lane = tid & 63;
    if (wid == 0) for (int it = blockIdx.x; it < 128; it += gridDim.x) scan_wave(p, it, lane);
}

__device__ __forceinline__ void phaseR5(LDSP unsigned char* lds, const Params& p) {
    const int tid = opaque(threadIdx.x), wid = tid >> 6, lane = tid & 63, r = lane & 31, hh = lane >> 5;
    const bf16_t* CP = (const bf16_t*)(p.ws + OFF_CP); const bf16_t* CQ = (const bf16_t*)(p.ws + OFF_CQ); const bf16_t* HT = (const bf16_t*)(p.ws + OFF_HT);
    for (int wu = blockIdx.x * 8 + wid; wu < 2 * 64 * 16 * 2; wu += gridDim.x * 8) {
        const int half = wu & 1, u = wu >> 1, b = u >> 10, c = (u >> 4) & 63, h = u & 15;
        f32x16 y0 = zero16(), y1 = zero16();
#pragma unroll
        for (int d = 0; d < 2; ++d) {
            const size_t inst = (size_t)inst_index(b, h, d, 4 + c) * 4096;
            const int ii = d ? 63 - (32 * half + r) : (32 * half + r);
            const int it = ii >> 5, lp = hh * 32 + (ii & 31);
            f32x16 a0, a1;
#pragma unroll
            for (int g2 = 0; g2 < 2; ++g2) {
                const u32x4 w0 = *(const u32x4*)(CQ + inst + (((it * 2 + 0) * 2 + g2) * 64 + lp) * 8), w1 = *(const u32x4*)(CQ + inst + (((it * 2 + 1) * 2 + g2) * 64 + lp) * 8);
                a0[8 * g2] = bf2f(w0.x & 0xffff); a0[8 * g2 + 1] = bf2f(w0.x >> 16); a0[8 * g2 + 2] = bf2f(w0.y & 0xffff); a0[8 * g2 + 3] = bf2f(w0.y >> 16);
                a0[8 * g2 + 4] = bf2f(w0.z & 0xffff); a0[8 * g2 + 5] = bf2f(w0.z >> 16); a0[8 * g2 + 6] = bf2f(w0.w & 0xffff); a0[8 * g2 + 7] = bf2f(w0.w >> 16);
                a1[8 * g2] = bf2f(w1.x & 0xffff); a1[8 * g2 + 1] = bf2f(w1.x >> 16); a1[8 * g2 + 2] = bf2f(w1.y & 0xffff); a1[8 * g2 + 3] = bf2f(w1.y >> 16);
                a1[8 * g2 + 4] = bf2f(w1.z & 0xffff); a1[8 * g2 + 5] = bf2f(w1.z >> 16); a1[8 * g2 + 6] = bf2f(w1.w & 0xffff); a1[8 * g2 + 7] = bf2f(w1.w >> 16);
            }
#pragma unroll
            for (int s = 0; s < 4; ++s) {
                const bf16x8 pf = *(const bf16x8*)(CP + inst + ((it * 4 + s) * 64 + lp) * 8);
                const bf16x8 h0 = *(const bf16x8*)(HT + inst + ((0 * 4 + s) * 64 + lane) * 8), h1 = *(const bf16x8*)(HT + inst + ((1 * 4 + s) * 64 + lane) * 8);
                a0 = __builtin_amdgcn_mfma_f32_32x32x16_bf16(h0, pf, a0, 0, 0, 0);
                a1 = __builtin_amdgcn_mfma_f32_32x32x16_bf16(h1, pf, a1, 0, 0, 0);
            }
#pragma unroll
            for (int g = 0; g < 16; ++g) { y0[g] += a0[g]; y1[g] += a1[g]; }
        }
        const int tau = 32 * half + r; const size_t row = (size_t)b * T + c * 64 + tau;
        float sm = 0.f;
#pragma unroll
        for (int g = 0; g < 16; ++g) sm += y0[g] + y1[g];
        sm += __shfl_xor(sm, 32);
        const float mean = sm * (1.f / 64.f);
        float q2 = 0.f;
#pragma unroll
        for (int g = 0; g < 16; ++g) { y0[g] -= mean; y1[g] -= mean; q2 += y0[g] * y0[g] + y1[g] * y1[g]; }
        q2 += __shfl_xor(q2, 32);
        const float rstd = rsqrtf(q2 * (1.f / 64.f) + 64e-5f);
        const bf16_t* rs = (const bf16_t*)(p.ws + OFF_RS) + row * 1024 + h * 64; const bf16_t* ks = (const bf16_t*)(p.ws + OFF_KS) + row * 1024 + h * 64;
        const bf16_t* ai0 = (const bf16_t*)(p.ws + OFF_AIG) + row * 2048 + h * 64; const bf16_t* ai1 = ai0 + 1024;
        const bf16_t* vs = (const bf16_t*)(p.ws + OFF_VS) + row * 1024 + h * 64; const bf16_t* gg = (const bf16_t*)(p.ws + OFF_GG) + row * 1024 + h * 64;
        float bon = 0.f;
#pragma unroll
        for (int q = 0; q < 8; ++q) {
            const int ch = 32 * (q >> 2) + 8 * (q & 3) + 4 * hh;
            const u32x2 r2 = *(const u32x2*)(rs + ch), k2 = *(const u32x2*)(ks + ch), x2 = *(const u32x2*)(ai0 + ch), z2 = *(const u32x2*)(ai1 + ch);
            const f32x4 ka = *(const f32x4*)(p.k_a + h * 64 + ch), rk = *(const f32x4*)(p.r_k + h * 64 + ch);
            const float rr[4] = {bf2f(r2.x & 0xffff), bf2f(r2.x >> 16), bf2f(r2.y & 0xffff), bf2f(r2.y >> 16)}, kk[4] = {bf2f(k2.x & 0xffff), bf2f(k2.x >> 16), bf2f(k2.y & 0xffff), bf2f(k2.y >> 16)};
            const float xa[4] = {bf2f(x2.x & 0xffff), bf2f(x2.x >> 16), bf2f(x2.y & 0xffff), bf2f(x2.y >> 16)}, za[4] = {bf2f(z2.x & 0xffff), bf2f(z2.x >> 16), bf2f(z2.y & 0xffff), bf2f(z2.y >> 16)};
#pragma unroll
            for (int e = 0; e < 4; ++e) bon += rr[e] * (kk[e] * ((1.f + (xa[e] - 1.f) * ka[e]) + (1.f + (za[e] - 1.f) * ka[e]))) * rk[e];
        }
        bon += __shfl_xor(bon, 32);
        bf16_t* dst = (bf16_t*)(p.ws + OFF_MIX) + row * D + h * 64;
#pragma unroll
        for (int q = 0; q < 8; ++q) {
            const int ch = 32 * (q >> 2) + 8 * (q & 3) + 4 * hh, g0 = 4 * (q & 3);
            const f32x4 lg = *(const f32x4*)(p.lnx_g + h * 64 + ch), lb = *(const f32x4*)(p.lnx_b + h * 64 + ch);
            const u32x2 v2 = *(const u32x2*)(vs + ch), g2 = *(const u32x2*)(gg + ch);
            const float vv[4] = {bf2f(v2.x & 0xffff), bf2f(v2.x >> 16), bf2f(v2.y & 0xffff), bf2f(v2.y >> 16)}, gv[4] = {bf2f(g2.x & 0xffff), bf2f(g2.x >> 16), bf2f(g2.y & 0xffff), bf2f(g2.y >> 16)};
            float o[4];
#pragma unroll
            for (int e = 0; e < 4; ++e) { const float yv = (q < 4) ? y0[g0 + e] : y1[g0 + e]; o[e] = (yv * rstd * lg[e] + lb[e] + bon * vv[e]) * gv[e]; }
            *(u32x2*)(dst + ch) = mk2u(pk2(o[0], o[1]), pk2(o[2], o[3]));
        }
    }
}

__device__ __forceinline__ void phase6(LDSP unsigned char* lds, const Params& p) {
    pg8::Epi<FX1> epi{FX1{p.x, (const float*)(p.ws + OFF_MOD), (float*)(p.ws + OFF_X1)}};
    pg8::DenseSched S{(const char*)(p.ws + OFF_MIX), (const char*)(p.ws + OFF_WTOUT), NX / 256, D / 256, D, (int)gridDim.x, (int)blockIdx.x};
    pg8::gemm_phase<false>(lds, D, S, epi);
}

__device__ __forceinline__ void phase7(LDSP unsigned char* lds, const Params& p) {
    const int tid = opaque(threadIdx.x), wid = tid >> 6, lane = tid & 63;
    LDSP float* GS = (LDSP float*)lds;
    LDSP float* RSTD = (LDSP float*)(lds + 16384);
    LDSP float* PART = (LDSP float*)(lds + 16896);
    LDSP float* CB = (LDSP float*)(lds + 16896 + 65536);
    const float* MOD = (const float*)(p.ws + OFF_MOD);
    const float* X1 = (const float*)(p.ws + OFF_X1);
    bf16_t* H2 = (bf16_t*)(p.ws + OFF_H2);
    int* CNT = (int*)(p.ws + OFF_CTL + 16384);
    for (int u = blockIdx.x; u < NX / 32; u += gridDim.x) {
        const float* md = MOD + (size_t)((u * 32) >> 12) * 12288;
        for (int idx = tid; idx < D / 4; idx += 512) { const f32x4 g = *(const f32x4*)(p.norm2_g + 4 * idx), sh = *(const f32x4*)(md + 3 * D + 4 * idx), sc = *(const f32x4*)(md + 4 * D + 4 * idx);
            *(LDSP f32x4*)(GS + 4 * idx) = g * (sc + 1.f); *(LDSP f32x4*)(GS + D + 4 * idx) = sh; }
        __syncthreads();
#pragma unroll 1
        for (int rr = 0; rr < 4; ++rr) {
            const int t = 4 * wid + rr, row = u * 32 + t; const float* src = X1 + (size_t)row * D;
            f32x4 xv[8]; float ss = 0.f;
#pragma unroll
            for (int i = 0; i < 8; ++i) { xv[i] = ((const f32x4*)src)[lane + 64 * i]; ss += xv[i].x * xv[i].x + xv[i].y * xv[i].y + xv[i].z * xv[i].z + xv[i].w * xv[i].w; }
            ss = wave_sum(ss); const float rs = rsqrtf(ss * (1.f / D) + 1e-6f);
            if (lane == 0) RSTD[t] = rs;
#pragma unroll
            for (int i = 0; i < 8; ++i) { const int col = 4 * (lane + 64 * i);
                const f32x4 g = *(const LDSP f32x4*)(GS + col), sh = *(const LDSP f32x4*)(GS + D + col);
                const f32x4 hv = xv[i] * rs * g + sh;
                *(u32x2*)(H2 + (size_t)row * D + col) = mk2u(pk2(hv.x, hv.y), pk2(hv.z, hv.w)); }
        }
        {
            const int j = lane & 31, kk = lane >> 5, k0 = wid * 256;
            unsigned xoff = (unsigned)((u * 32 + j) * D + k0 + 4 * kk) * 4u;
            unsigned woff = (unsigned)((k0 + 4 * kk) * 64 + j) * 4u;
            unsigned goff = (unsigned)(k0 + 4 * kk) * 4u;
            f32x16 acc0 = zero16(), acc1 = zero16(); float c0 = 0.f, c1 = 0.f;
#pragma unroll 2
            for (int q = 0; q < 32; ++q) {
                const f32x4 xa = *(const f32x4*)((const char*)X1 + xoff);
                const f32x4 gv = *(const LDSP f32x4*)((const LDSP char*)GS + goff), sv = *(const LDSP f32x4*)((const LDSP char*)GS + D * 4 + goff);
                float b0[4], b1[4];
#pragma unroll
                for (int e = 0; e < 4; ++e) { b0[e] = *(const float*)((const char*)p.w_router + woff + e * 256); b1[e] = *(const float*)((const char*)p.w_router + woff + e * 256 + 128); }
#pragma unroll
                for (int e = 0; e < 4; ++e) {
                    acc0 = __builtin_amdgcn_mfma_f32_32x32x2f32(xa[e], b0[e] * gv[e], acc0, 0, 0, 0);
                    acc1 = __builtin_amdgcn_mfma_f32_32x32x2f32(xa[e], b1[e] * gv[e], acc1, 0, 0, 0);
                    c0 += sv[e] * b0[e]; c1 += sv[e] * b1[e];
                }
                xoff += 32u; woff += 2048u; goff += 32u;
            }
            c0 += __shfl_xor(c0, 32); c1 += __shfl_xor(c1, 32);
#pragma unroll
            for (int g = 0; g < 16; ++g) { const int t = crow(g, kk); PART[(wid * 32 + t) * 64 + j] = acc0[g]; PART[(wid * 32 + t) * 64 + 32 + j] = acc1[g]; }
            if (kk == 0) { CB[wid * 64 + j] = c0; CB[wid * 64 + 32 + j] = c1; }
        }
        __syncthreads();
        float cb = 0.f;
#pragma unroll
        for (int w = 0; w < 8; ++w) cb += CB[w * 64 + lane];
        const float eb = p.expert_bias[lane];
#pragma unroll 1
        for (int rr = 0; rr < 4; ++rr) {
            const int t = 4 * wid + rr, token = u * 32 + t;
            float sum = 0.f;
#pragma unroll
            for (int w = 0; w < 8; ++w) sum += PART[(w * 32 + t) * 64 + lane];
            const float logit = RSTD[t] * sum + cb;
            const float score = 1.f / (1.f + expf(-logit));
            const float v = score + eb;
            const int gi = lane >> 3;
            float m1 = v;
            m1 = fmaxf(m1, __shfl_xor(m1, 1)); m1 = fmaxf(m1, __shfl_xor(m1, 2)); m1 = fmaxf(m1, __shfl_xor(m1, 4));
            const unsigned long long eq = __ballot(v == m1);
            const unsigned gbits = (unsigned)((eq >> (gi * 8)) & 0xffull);
            const bool first = (lane & 7) == (__ffs((int)gbits) - 1);
            float v2 = first ? -INFINITY : v;
            v2 = fmaxf(v2, __shfl_xor(v2, 1)); v2 = fmaxf(v2, __shfl_xor(v2, 2)); v2 = fmaxf(v2, __shfl_xor(v2, 4));
            const float gs = m1 + v2;
            int gr = 0;
#pragma unroll
            for (int jj = 0; jj < 8; ++jj) { const float gj = __builtin_bit_cast(float, __builtin_amdgcn_readlane(__builtin_bit_cast(int, gs), jj * 8)); gr += (gj > gs || (gj == gs && jj < gi)) ? 1 : 0; }
            const float mv = (gr < 4) ? v : -INFINITY;
            int rk = 0;
#pragma unroll
            for (int jj = 0; jj < 64; ++jj) { const float vj = __builtin_bit_cast(float, __builtin_amdgcn_readlane(__builtin_bit_cast(int, mv), jj)); rk += (vj > mv || (vj == mv && jj < lane)) ? 1 : 0; }
            const bool sel = (rk < 8) && (gr < 4);
            const float gsum = wave_sum(sel ? score : 0.f);
            if (sel) {
                const int slot = atomicAdd(&CNT[lane], 1);
                ((int*)(p.ws + OFF_EIDX))[token * 8 + rk] = lane;
                ((int*)(p.ws + OFF_ESLOT))[token * 8 + rk] = slot;
                ((float*)(p.ws + OFF_GATE))[token * 8 + rk] = score / gsum * 2.5f;
                ((int*)(p.ws + OFF_TOKL))[(size_t)lane * NX + slot] = token;
            }
        }
        __syncthreads();
    }
}

constexpr int LE_TAB = 131072;
__device__ __forceinline__ void build_expert_tables(LDSP unsigned char* lds, const Params& p) {
    LDSP int* TP = (LDSP int*)(lds + LE_TAB); LDSP int* ST = TP + 72; LDSP int* CN = ST + 72;
    if (threadIdx.x < NEX) CN[threadIdx.x] = (threadIdx.x < NE) ? ((const int*)(p.ws + OFF_CTL + 16384))[threadIdx.x] : NX;
    __syncthreads();
    if (threadIdx.x == 0) {
        int tp = 0, st = 0;
        for (int e = 0; e < NEX; ++e) { const int cn = CN[e]; TP[e] = tp; ST[e] = st; tp += (cn + 255) >> 8; st += cn; }
        TP[NEX] = tp; ST[NEX] = st;
    }
    __syncthreads();
}

struct GroupSched {
    const LDSP int* TP; const LDSP int* ST; const LDSP int* CN;
    const char* A; const char* B; const int* tokl; int ntn, K, G, c; size_t bstride; bool gather;
    __device__ __forceinline__ bool next(int i, pg8::Unit& u) const {
        const int total = __builtin_amdgcn_readfirstlane(TP[NEX]) * ntn; const long L = (long)i * G + c; if (L >= total) return false;
        const int w = pg8::xcd_remap((int)L, total);
        const int nt = w % ntn, mtg = w / ntn;
        int e = 0, hi = NEX;
        while (hi - e > 1) { const int mid = (e + hi) >> 1; if (__builtin_amdgcn_readfirstlane(TP[mid]) <= mtg) e = mid; else hi = mid; }
        const int tpe = __builtin_amdgcn_readfirstlane(TP[e]), ste = __builtin_amdgcn_readfirstlane(ST[e]), cne = __builtin_amdgcn_readfirstlane(CN[e]);
        const int mt = mtg - tpe;
        u.B = B + (size_t)e * bstride + (size_t)nt * 256 * K * 2;
        u.nvalid = cne; u.m0 = mt * 256; u.pos0 = ste; u.row0 = 0; u.col0 = nt * 256;
        if (gather) { u.A = A; u.rowmap = (e < NE) ? tokl + (size_t)e * NX : nullptr; }
        else { u.A = A + (size_t)(ste + mt * 256) * K * 2; u.rowmap = nullptr; }
        return true;
    }
};
__device__ __forceinline__ void phase8(LDSP unsigned char* lds, const Params& p) {
    build_expert_tables(lds, p);
    const LDSP int* TP = (const LDSP int*)(lds + LE_TAB);
    pg8::Epi<FH1> epi{FH1{(bf16_t*)(p.ws + OFF_H1)}};
    GroupSched S{TP, TP + 72, TP + 144, (const char*)(p.ws + OFF_H2), (const char*)(p.ws + OFF_WTE1), (const int*)(p.ws + OFF_TOKL), 4, D, (int)gridDim.x, (int)blockIdx.x,
                 (size_t)1024 * 2048 * 2, true};
    pg8::gemm_phase<true>(lds, D, S, epi);
}
__device__ __forceinline__ void phase9(LDSP unsigned char* lds, const Params& p) {
    build_expert_tables(lds, p);
    const LDSP int* TP = (const LDSP int*)(lds + LE_TAB);
    pg8::Epi<FEO> epi{FEO{(bf16_t*)(p.ws + OFF_EO)}};
    GroupSched S{TP, TP + 72, TP + 144, (const char*)(p.ws + OFF_H1), (const char*)(p.ws + OFF_WTE2), nullptr, 8, EFF, (int)gridDim.x, (int)blockIdx.x,
                 (size_t)2048 * 512 * 2, false};
    pg8::gemm_phase<false>(lds, EFF, S, epi);
}
__device__ __forceinline__ void phase10(LDSP unsigned char* lds, const Params& p) {
    build_expert_tables(lds, p);
    const LDSP int* ST = (const LDSP int*)(lds + LE_TAB) + 72;
    const int tid = opaque(threadIdx.x), wid = tid >> 6, lane = tid & 63;
    const float* MOD = (const float*)(p.ws + OFF_MOD);
    const float* X1 = (const float*)(p.ws + OFF_X1);
    const bf16_t* EO = (const bf16_t*)(p.ws + OFF_EO);
    for (int row = blockIdx.x * 8 + wid; row < NX; row += gridDim.x * 8) {
        unsigned er[9]; float gw[9];
#pragma unroll
        for (int k = 0; k < 8; ++k) { const int e = ((const int*)(p.ws + OFF_EIDX))[row * 8 + k], sl = ((const int*)(p.ws + OFF_ESLOT))[row * 8 + k];
            er[k] = (unsigned)(ST[e] + sl) * (unsigned)D; gw[k] = ((const float*)(p.ws + OFF_GATE))[row * 8 + k]; }
        er[8] = (unsigned)(ST[NE] + row) * (unsigned)D; gw[8] = 1.f;
        const float* md = MOD + (size_t)(row >> 12) * 12288 + 5 * D;
        LDSP float* RB = (LDSP float*)lds + wid * 2048;
        float ss = 0.f;
#pragma unroll 2
        for (int i = 0; i < 8; ++i) { const int col = 4 * (lane + 64 * i);
            f32x4 a = mk4f(0.f, 0.f, 0.f, 0.f);
#pragma unroll
            for (int k = 0; k < 9; ++k) { const u32x2 w = *(const u32x2*)(EO + er[k] + col);
                a.x += gw[k] * bf2f(w.x & 0xffff); a.y += gw[k] * bf2f(w.x >> 16); a.z += gw[k] * bf2f(w.y & 0xffff); a.w += gw[k] * bf2f(w.y >> 16); }
            const f32x4 x1 = *(const f32x4*)(X1 + (size_t)row * D + col), g2 = *(const f32x4*)(md + col);
            f32x4 xv; xv.x = x1.x + g2.x * a.x; xv.y = x1.y + g2.y * a.y; xv.z = x1.z + g2.z * a.z; xv.w = x1.w + g2.w * a.w;
            ss += xv.x * xv.x + xv.y * xv.y + xv.z * xv.z + xv.w * xv.w;
            *(LDSP f32x4*)(RB + col) = xv; }
        ss = wave_sum(ss); const float rs = rsqrtf(ss * (1.f / D) + 1e-6f);
#pragma unroll 4
        for (int i = 0; i < 8; ++i) { const int col = 4 * (lane + 64 * i); const f32x4 g = *(const f32x4*)(p.final_g + col);
            const f32x4 xv = *(const LDSP f32x4*)(RB + col);
            f32x4 o; o.x = xv.x * rs * g.x; o.y = xv.y * rs * g.y; o.z = xv.z * rs * g.z; o.w = xv.w * rs * g.w;
            *(f32x4*)(p.out + (size_t)row * D + col) = o; }
    }
}


#define XB_TMO      128
#define XB_XCNT(j)  (256  + 64 * (j))
#define XB_XSUB(j)  (1280 + 64 * (j))
#define XB_XGEN(j)  (2304 + 64 * (j))
#define XB_TOP      3328
#define XB_TOPGEN   3392
#define XB_SPIN_CAP (1u << 20)
__device__ __forceinline__ unsigned xb_ld(unsigned* p)              { return __hip_atomic_load(p, __ATOMIC_RELAXED, __HIP_MEMORY_SCOPE_AGENT); }
__device__ __forceinline__ unsigned xb_add(unsigned* p, unsigned v) { return __hip_atomic_fetch_add(p, v, __ATOMIC_RELAXED, __HIP_MEMORY_SCOPE_AGENT); }
__device__ __forceinline__ unsigned xb_xcc_id() { return (unsigned)__builtin_amdgcn_s_getreg((3 << 11) | 20) & 0xFu; }
#define XB_SPIN(cond, bar) do { unsigned _sp = 0; while (cond) { __builtin_amdgcn_s_sleep(1); \
    if ((++_sp & 255u) == 0u) { if (xb_ld(&(bar)[XB_TMO])) break; if (_sp > XB_SPIN_CAP) { atomicAdd(&(bar)[XB_TMO], 1u); break; } } } } while (0)
__device__ __forceinline__ unsigned xcd_barrier_complete(unsigned* bar, unsigned x) {
    const unsigned G = gridDim.x * gridDim.y * gridDim.z;
    unsigned sum, cnt, mine, sp = 0u;
    for (;;) {
        sum = 0u; cnt = 0u; mine = 0u;
#pragma unroll
        for (unsigned j = 0; j < 16; ++j) { const unsigned c = xb_ld(&bar[XB_XCNT(j)]); sum += c; cnt += (c > 0u) ? 1u : 0u; mine = (j == x) ? c : mine; }
        if (sum == G) break;
        __builtin_amdgcn_s_sleep(1);
        if ((++sp & 255u) == 0u) { if (xb_ld(&bar[XB_TMO])) break; if (sp > XB_SPIN_CAP) { atomicAdd(&bar[XB_TMO], 1u); break; } }
    }
    return (mine > 0u ? mine : 1u) | ((cnt > 0u ? cnt : 1u) << 16);
}
__device__ __forceinline__ void xcd_barrier(unsigned* bar, unsigned x, volatile LDSP unsigned* st) {
    asm volatile("s_waitcnt vmcnt(0)" ::: "memory");
    __syncthreads();
    if (threadIdx.x == 0) {
        __builtin_amdgcn_s_waitcnt(0);
        unsigned pk = st[0];
        if (pk == 0u) { pk = xcd_barrier_complete(bar, x); st[0] = pk; }
        const unsigned nloc = pk & 0xffffu, nx = pk >> 16;
        const unsigned old = xb_add(&bar[XB_XSUB(x)], 1u);
        const unsigned gen = old / nloc;
        if (old + 1u == (gen + 1u) * nloc) {
            __builtin_amdgcn_fence(__ATOMIC_RELEASE, "agent");
            asm volatile("s_waitcnt vmcnt(0)" ::: "memory");
            const unsigned og = xb_add(&bar[XB_TOP], 1u);
            const unsigned tg = og / nx;
            if (og + 1u == (tg + 1u) * nx) xb_add(&bar[XB_TOPGEN], 1u);
            else XB_SPIN(xb_ld(&bar[XB_TOPGEN]) == tg, bar);
            __builtin_amdgcn_fence(__ATOMIC_ACQUIRE, "agent");
            xb_add(&bar[XB_XGEN(x)], 1u);
            asm volatile("s_waitcnt vmcnt(0)" ::: "memory");
        } else {
            XB_SPIN(xb_ld(&bar[XB_XGEN(x)]) == gen, bar);
            __builtin_amdgcn_fence(__ATOMIC_ACQUIRE, "agent");
            asm volatile("s_waitcnt vmcnt(0)" ::: "memory");
        }
    }
    __syncthreads();
}

__global__ void __launch_bounds__(512, 2) fwd_megakernel(Params p) {
    __shared__ __attribute__((aligned(16))) unsigned char smem_raw[SMEM_BYTES];
    LDSP unsigned char* lds = (LDSP unsigned char*)smem_raw;
    cg::grid_group grid = cg::this_grid();
    volatile LDSP unsigned* xst = (volatile LDSP unsigned*)(lds + SMEM_BYTES - 16);
    if (threadIdx.x == 0) { xst[0] = 0u; xst[1] = 0u; }
    __syncthreads();
    const unsigned xcc = xb_xcc_id();
    if (threadIdx.x == 0) (void)xb_add(&((unsigned*)p.ws)[XB_XCNT(xcc)], 1u);
#define GSYNC xcd_barrier((unsigned*)p.ws, xcc, xst)
#ifndef PH_TWICE
#define PH_TWICE 0
#endif
#ifndef PH_MASK
#define PH_MASK 0xffff
#endif
#define RUN_PHASE(bit, fn) _Pragma("unroll 1") for (int rep = 0; rep < ((PH_TWICE & (bit)) ? 2 : 1); ++rep) { if (rep) GSYNC; if (PH_MASK & (bit)) { Params q = p; q.ws = opq(p.ws); fn(lds, q); } }
    RUN_PHASE(1, phase0)      grid.sync();
    RUN_PHASE(2, phase1)      GSYNC;
    RUN_PHASE(4, phase2)      GSYNC;
    RUN_PHASE(8, phaseR1)     GSYNC;
    RUN_PHASE(16, phaseR2)    GSYNC;
    RUN_PHASE(32, phaseR3)    GSYNC;
    RUN_PHASE(64, phaseR4)    GSYNC;
    RUN_PHASE(128, phaseR5)   GSYNC;
    RUN_PHASE(256, phase6)    GSYNC;
    RUN_PHASE(512, phase7)    GSYNC;
    RUN_PHASE(1024, phase8)   GSYNC;
    RUN_PHASE(2048, phase9)   GSYNC;
    RUN_PHASE(4096, phase10)
}

extern "C" void kernel_launch(void* const* d_in, const int* in_sizes, int n_in, void* d_out, int out_size, void* d_ws, size_t ws_size, hipStream_t stream) {
    static int grid_blocks = 0;
    if (!grid_blocks) {
        int dev = 0, cus = 0, per_cu = 0;
        (void)hipGetDevice(&dev);
        (void)hipDeviceGetAttribute(&cus, hipDeviceAttributeMultiprocessorCount, dev);
        (void)hipOccupancyMaxActiveBlocksPerMultiprocessor(&per_cu, fwd_megakernel, 512, 0);
        if (per_cu > 1) per_cu = 1;
        grid_blocks = cus * per_cu;
        if (ws_size < WS_END) fprintf(stderr, "workspace too small: %zu < %zu\n", ws_size, (size_t)WS_END);
    }
    Params p{};
    const float** f = (const float**)&p;
    for (int i = 0; i < 31; ++i) f[i] = (const float*)d_in[i];
    p.out = (float*)d_out; p.ws = (unsigned char*)d_ws;
    (void)hipMemsetAsync(d_ws, 0, 32768, stream);
    void* args[] = {&p};
    hipError_t e = hipLaunchCooperativeKernel((void*)fwd_megakernel, dim3(grid_blocks), dim3(512), args, 0, stream);
    if (e != hipSuccess) fprintf(stderr, "cooperative launch failed: %s (grid %d)\n", hipGetErrorString(e), grid_blocks);
}
```

```cpp
#include <hip/hip_runtime.h>
#include <hip/hip_cooperative_groups.h>
#include <cstdio>
#include <cstdint>
namespace cg = cooperative_groups;

#define LDSP __attribute__((address_space(3)))
typedef unsigned short bf16_t;
typedef short bf16x8 __attribute__((ext_vector_type(8)));
typedef float f32x4 __attribute__((ext_vector_type(4)));
typedef float f32x16 __attribute__((ext_vector_type(16)));
typedef unsigned u32x4 __attribute__((ext_vector_type(4)));
typedef unsigned u32x2 __attribute__((ext_vector_type(2)));
__device__ __forceinline__ u32x4 mk4u(unsigned a, unsigned b, unsigned c, unsigned d) { u32x4 r; r.x = a; r.y = b; r.z = c; r.w = d; return r; }
__device__ __forceinline__ u32x2 mk2u(unsigned a, unsigned b) { u32x2 r; r.x = a; r.y = b; return r; }
__device__ __forceinline__ f32x4 mk4f(float a, float b, float c, float d) { f32x4 r; r.x = a; r.y = b; r.z = c; r.w = d; return r; }

constexpr int D = 2048, NB = 2, T = 4096, CL = 256, NX = NB * T, NCX = NB * CL, NR = NX + NCX;
constexpr int INC = 5056, INP = 5120;
constexpr int C_R = 0, C_K = 1024, C_V = 2048, C_XW = 3072, C_XA = 3168, C_XG = 3264, C_Q = 3520, C_AK = 4544, C_AV = 4800;
constexpr int NE = 64, NEX = 65, EFF = 512;
constexpr int NCHUNK = 68;
constexpr int NINST = NB * 16 * 2 * NCHUNK;
constexpr int EROWS = NX * 8 + NX;

constexpr size_t al4k(size_t x) { return (x + 4095) & ~(size_t)4095; }
constexpr size_t OFF_CTL = 0;
constexpr size_t OFF_ROPE = 65536;
constexpr size_t OFF_MODP = OFF_ROPE + 8192;
constexpr size_t OFF_MOD = al4k(OFF_MODP + (size_t)16 * 3 * 12288 * 4);
constexpr size_t OFF_WTDU = al4k(OFF_MOD + (size_t)3 * 12288 * 4);
constexpr size_t OFF_WTIU = OFF_WTDU + (size_t)2 * 1024 * 128 * 2;
constexpr size_t OFF_WTGU = OFF_WTIU + (size_t)2 * 1024 * 128 * 2;
constexpr size_t OFF_WTE2 = OFF_WTGU + (size_t)1024 * 256 * 2;
constexpr size_t OFF_X1 = OFF_WTE2 + (size_t)NEX * 2048 * 512 * 2;
constexpr size_t OFF_H2 = OFF_X1 + (size_t)NX * D * 4;
constexpr size_t OFF_TOKL = OFF_H2 + (size_t)NX * D * 2;
constexpr size_t OFF_EIDX = OFF_TOKL + (size_t)NE * NX * 4;
constexpr size_t OFF_ESLOT = OFF_EIDX + (size_t)NX * 8 * 4;
constexpr size_t OFF_GATE = OFF_ESLOT + (size_t)NX * 8 * 4;
constexpr size_t OFF_H1 = OFF_GATE + (size_t)NX * 8 * 4;
constexpr size_t OFF_WTE1 = al4k(OFF_H1 + (size_t)(EROWS + 256) * EFF * 2);
constexpr size_t OFF_EO = OFF_WTE1;
constexpr size_t OFF_WTIN = OFF_WTE1 + (size_t)NEX * 1024 * 2048 * 2;
constexpr size_t OFF_WTOUT = OFF_WTIN + (size_t)INP * D * 2;
constexpr size_t OFF_HX = OFF_WTOUT + (size_t)D * D * 2;
constexpr size_t OFF_PX = OFF_HX + (size_t)NR * D * 2;
constexpr size_t OFF_CM = OFF_PX + (size_t)NR * INP * 2;
constexpr size_t OFF_CN = OFF_CM + (size_t)NINST * 4096 * 2;
constexpr size_t OFF_CP = OFF_CN + (size_t)NINST * 4096 * 2;
constexpr size_t OFF_CQ = OFF_CP + (size_t)NINST * 4096 * 2;
constexpr size_t OFF_YD = OFF_CQ + (size_t)NINST * 4096 * 2;
constexpr size_t OFF_BON = OFF_YD + (size_t)2 * NX * 1024 * 4;
constexpr size_t OFF_MIX = OFF_BON + (size_t)2 * NX * 16 * 4;
constexpr size_t WS_END = OFF_MIX + (size_t)NX * D * 2;
constexpr size_t OFF_RS = OFF_X1;
constexpr size_t OFF_KS = OFF_RS + (size_t)NR * 1024 * 2;
constexpr size_t OFF_KK = OFF_KS + (size_t)NR * 1024 * 2;
constexpr size_t OFF_VS = OFF_KK + (size_t)NR * 1024 * 2;
constexpr size_t OFF_TW = OFF_VS + (size_t)NR * 1024 * 2;
constexpr size_t OFF_XA = OFF_TW + (size_t)NR * 128 * 2;
constexpr size_t OFF_SG = OFF_XA + (size_t)NR * 128 * 2;
constexpr size_t OFF_LWG = OFF_SG + (size_t)NX * 256 * 2;
constexpr size_t OFF_AIG = OFF_LWG + (size_t)NR * 2048 * 2;
constexpr size_t OFF_GG = OFF_AIG + (size_t)NR * 2048 * 2;
static_assert(OFF_GG + (size_t)NX * 1024 * 2 <= OFF_WTE1, "RWKV token buffers fit the overlay region");
static_assert(OFF_EO + (size_t)EROWS * D * 2 <= OFF_HX, "EO overlays only WT_E1/WT_IN/WT_OUT");
static_assert(WS_END <= (size_t)1073741824, "workspace map must fit 1 GiB");

constexpr int SMEM_BYTES = 157 * 1024;

struct Params {
    const float *x, *c, *ctx, *c_ctx, *w_mod, *b_mod, *norm1_g, *norm2_g, *w_in, *shift_mu, *k_k, *k_a, *r_k, *decay_bias, *decay_up, *iclr_bias, *iclr_up,
        *gate_up, *lnx_g, *lnx_b, *attn_sink, *w_out, *w_router, *expert_bias, *e_gate, *e_up, *e_down, *s_gate, *s_up, *s_down, *final_g;
    float* out;
    unsigned char* ws;
};

__device__ __forceinline__ unsigned f2bf(float f) { unsigned u = __float_as_uint(f); return (u + 0x7fffu + ((u >> 16) & 1u)) >> 16; }
__device__ __forceinline__ float bf2f(unsigned h) { return __uint_as_float(h << 16); }
typedef float f32x2_t __attribute__((ext_vector_type(2)));
typedef __bf16 bf16x2_t __attribute__((ext_vector_type(2)));
__device__ __forceinline__ unsigned pk2(float lo, float hi) { f32x2_t v = {lo, hi}; bf16x2_t b = __builtin_convertvector(v, bf16x2_t); return __builtin_bit_cast(unsigned, b); }
__device__ __forceinline__ float wave_sum(float v) {
#pragma unroll
    for (int o = 32; o > 0; o >>= 1) v += __shfl_xor(v, o);
    return v;
}
__device__ __forceinline__ int opaque(int x) { asm volatile("" : "+v"(x)); return x; }
__device__ __forceinline__ int opaque_s(int x) { asm volatile("" : "+s"(x)); return x; }
__device__ __forceinline__ unsigned char* opq(unsigned char* x) {
    unsigned long long v = (unsigned long long)x; asm volatile("" : "+s"(v));
    return (unsigned char*)(__attribute__((address_space(1))) unsigned char*)v; }
__device__ __forceinline__ float sigmoidf_(float x) { return __builtin_amdgcn_rcpf(1.f + __expf(-x)); }
__device__ __forceinline__ float softplusf_(float x) { return x > 20.f ? x : log1pf(__expf(x)); }
__device__ __forceinline__ int lds_byte(int r, int c) { const int st = (r >> 4) * 2 + (c >> 5), rr = r & 15, cc = c & 31, ob = rr * 64 + cc * 2; return st * 1024 + (ob ^ (((ob >> 9) & 1) << 5)); }
__device__ __forceinline__ int sw64(int r, int k) { return r * 128 + ((((k >> 3) ^ (r >> 1)) & 7) << 4) + (k & 7) * 2; }
__device__ __forceinline__ int sw128(int r, int k) { return r * 256 + ((((k >> 3) ^ r) & 15) << 4) + (k & 7) * 2; }
__device__ __forceinline__ int sw256(int r, int k) { const int ch = k >> 3; return r * 512 + (((ch & 16) | ((ch ^ r) & 15)) << 4) + (k & 7) * 2; }

__device__ __forceinline__ f32x16 zero16() { f32x16 z;
#pragma unroll
    for (int i = 0; i < 16; ++i) z[i] = 0.f; return z; }
__device__ __forceinline__ int crow(int reg, int hi) { return (reg & 3) + 8 * (reg >> 2) + 4 * hi; }

__device__ __forceinline__ f32x16 mm32_k64(const LDSP unsigned char* A, int arow0, const LDSP unsigned char* B, int brow0, f32x16 acc, int lane) {
    const int r = lane & 31, h = lane >> 5;
#pragma unroll
    for (int s = 0; s < 4; ++s) {
        const bf16x8 a = *(const LDSP bf16x8*)(A + sw64(arow0 + r, 16 * s + 8 * h));
        const bf16x8 b = *(const LDSP bf16x8*)(B + sw64(brow0 + r, 16 * s + 8 * h));
        acc = __builtin_amdgcn_mfma_f32_32x32x16_bf16(a, b, acc, 0, 0, 0);
    }
    return acc;
}

template <class Epi>
__device__ __forceinline__ void gemm256(LDSP unsigned char* lds, const bf16_t* A, int lda, const int* rowmap, int nvalid, const bf16_t* Bt, int ldb, int K, int m0, int n0,
                                        const Epi& epi) {
    const int tid = opaque(threadIdx.x), wid = tid >> 6, lane = tid & 63, wr = wid >> 2, wc = wid & 3, fr = lane & 15, fq = lane >> 4;
    const int lr = tid >> 3, lc = (tid & 7) * 8;
    unsigned aoff[4], boff[4];
#pragma unroll
    for (int i = 0; i < 4; ++i) {
        const int r = lr + 64 * i;
        int gr = m0 + r;
        if (rowmap) gr = (gr < nvalid) ? rowmap[gr] : 0;
        aoff[i] = (unsigned)gr * (unsigned)lda + lc;
        boff[i] = (unsigned)(n0 + r) * (unsigned)ldb + lc;
    }
    const int wo = lds_byte(lr, lc);
    const int swz = lds_byte(fr, fq * 8);
    u32x4 rg[4];
    f32x4 acc[8][4];
#pragma unroll
    for (int m = 0; m < 8; ++m)
#pragma unroll
        for (int n = 0; n < 4; ++n) acc[m][n] = (f32x4){0.f, 0.f, 0.f, 0.f};
    const int nt = K >> 6;
#pragma unroll
    for (int i = 0; i < 4; ++i) rg[i] = *(const u32x4*)(A + aoff[i]);
#pragma unroll
    for (int i = 0; i < 4; ++i) *(LDSP u32x4*)(lds + wo + 8192 * i) = rg[i];
#pragma unroll
    for (int i = 0; i < 4; ++i) rg[i] = *(const u32x4*)(Bt + boff[i]);
#pragma unroll
    for (int i = 0; i < 4; ++i) *(LDSP u32x4*)(lds + 32768 + wo + 8192 * i) = rg[i];
    __syncthreads();
#pragma unroll 1
    for (int t = 0; t < nt; ++t) {
        const int s = t & 1;
        const bool more = (t + 1 < nt);
        const LDSP unsigned char* bA = lds + s * 65536 + swz;
        const LDSP unsigned char* bB = lds + s * 65536 + 32768 + swz;
        LDSP unsigned char* w = lds + (s ^ 1) * 65536 + wo;
#pragma unroll
        for (int ks = 0; ks < 2; ++ks) {
            if (more) {
                if (ks == 0) {
#pragma unroll
                    for (int i = 0; i < 4; ++i) rg[i] = *(const u32x4*)(A + aoff[i] + (t + 1) * 64);
                } else {
#pragma unroll
                    for (int i = 0; i < 4; ++i) rg[i] = *(const u32x4*)(Bt + boff[i] + (t + 1) * 64);
                }
            }
            bf16x8 a[4], b[4];
#pragma unroll
            for (int n = 0; n < 4; ++n) b[n] = *(const LDSP bf16x8*)(bB + ((wc * 4 + n) * 2 + ks) * 1024);
#pragma unroll
            for (int mh = 0; mh < 2; ++mh) {
#pragma unroll
                for (int m = 0; m < 4; ++m) a[m] = *(const LDSP bf16x8*)(bA + ((wr * 8 + mh * 4 + m) * 2 + ks) * 1024);
#pragma unroll
                for (int m = 0; m < 4; ++m)
#pragma unroll
                    for (int n = 0; n < 4; ++n) acc[mh * 4 + m][n] = __builtin_amdgcn_mfma_f32_16x16x32_bf16(b[n], a[m], acc[mh * 4 + m][n], 0, 0, 0);
            }
            if (more) {
#pragma unroll
                for (int i = 0; i < 4; ++i) *(LDSP u32x4*)(w + (ks ? 32768 : 0) + 8192 * i) = rg[i];
            }
        }
        __syncthreads();
    }
#pragma unroll
    for (int m = 0; m < 8; ++m)
#pragma unroll
        for (int n = 0; n < 4; ++n) epi(m0 + wr * 128 + m * 16 + fr, n0 + wc * 64 + n * 16 + fq * 4, acc[m][n]);
}


namespace pg8 {
constexpr int BM = 256, BK = 64, HALF = 128, HTB = HALF * BK * 2, NXCD = 8;
__device__ __forceinline__ void stage_rc(int b, int& R, int& C) { const int st = b / 1024, sb = b % 1024, swz = sb ^ (((sb >> 9) & 1) << 5); R = (st >> 1) * 16 + swz / 64; C = (st & 1) * 32 + (swz % 64) / 2; }
struct Unit { const char* A; const char* B; const int* rowmap; int nvalid, m0, row0, col0, pos0; };
__device__ __forceinline__ int xcd_remap(int L, int nwg) { const int q = nwg / NXCD, r = nwg % NXCD, xcd = L % NXCD, off = L / NXCD; return (xcd < r ? xcd * (q + 1) : r * (q + 1) + (xcd - r) * q) + off; }

__device__ __forceinline__ int perm32(int rho) { const int n = rho >> 4, i = rho & 15; return 8 * (i >> 2) + 4 * n + (i & 3); }
template <class F> struct Epi {
    F f;
    __device__ __forceinline__ void operator()(const f32x4 (&acc)[2][2][4][2], const Unit& u, int wr, int wc, int fr, int fq) const {
#pragma unroll
        for (int ai = 0; ai < 2; ++ai)
#pragma unroll
            for (int m = 0; m < 4; ++m)
#pragma unroll
                for (int bj = 0; bj < 2; ++bj) { f(u, 128 * ai + 64 * wr + 16 * m + fr, 128 * bj + 32 * wc + 8 * fq, acc[ai][bj][m][0], acc[ai][bj][m][1]); __builtin_amdgcn_sched_barrier(0); }
    }
};

template <bool GATHER, bool ALIGN_EPI = true, class EpiT, class Sched>
__device__ __forceinline__ void gemm_phase(LDSP unsigned char* lds, const int K, const Sched& S, const EpiT& E) {
    const int tid = opaque(threadIdx.x), wid = __builtin_amdgcn_readfirstlane(tid >> 6), lane = tid & 63, wr = wid >> 2, wc = wid & 3, fr = lane & 15, fq = lane >> 4;
    const int nt = K / BK;
    unsigned voffA[2], voffB[2];
#pragma unroll
    for (int i = 0; i < 2; ++i) { int R, C; stage_rc(tid * 16 + i * 8192, R, C); const int Rb = (R & ~31) + perm32(R & 31); voffA[i] = (unsigned)(R * K + C) * 2u; voffB[i] = (unsigned)(Rb * K + C) * 2u; }
    const size_t kstep = (size_t)(BK * 2);
    const size_t hstep = (size_t)HALF * K * 2;
    const unsigned ldsw = (unsigned)wid * 1024u;
    const int aoff = lds_byte(wr * 64 + fr, fq * 8), boff = lds_byte(wc * 32 + fr, fq * 8);
#define PG8_SA(b, h) (((b) * 2 + (h)) * HTB)
#define PG8_SB(b, h) ((4 + (b) * 2 + (h)) * HTB)
#define PG8_STAGE(bufoff, gbase, voff) do { _Pragma("unroll") for (int _i = 0; _i < 2; ++_i) \
        __builtin_amdgcn_global_load_lds((const unsigned*)((const char*)(gbase) + (voff)[_i]), (LDSP unsigned*)(lds + (bufoff) + ldsw + _i * 8192), 16, 0, 0); } while (0)
#define PG8_STAGE_A(bufoff, nx, h, ubase, koff) do { if constexpr (GATHER) { unsigned _v[2]; const LDSP unsigned* _ro = rowoff + ((((nx) ? (ui + 1) : ui) & 1) * 4 + (h) * 2) * 512; _v[0] = _ro[0]; _v[1] = _ro[512]; PG8_STAGE(bufoff, (ubase) + (koff), _v); } \
        else { PG8_STAGE(bufoff, (ubase) + (h) * hstep + (koff), voffA); } } while (0)
#define PG8_LDA(dst, b, h) do { _Pragma("unroll") for (int m = 0; m < 4; ++m) _Pragma("unroll") for (int k = 0; k < 2; ++k) dst[m][k] = *(const LDSP bf16x8*)(lds + PG8_SA(b, h) + aoff + m * 2048 + k * 1024); } while (0)
#define PG8_LDB(dst, b, h) do { _Pragma("unroll") for (int n = 0; n < 2; ++n) _Pragma("unroll") for (int k = 0; k < 2; ++k) dst[n][k] = *(const LDSP bf16x8*)(lds + PG8_SB(b, h) + boff + n * 2048 + k * 1024); } while (0)
#define PG8_MMA(ai, bj, At, Bt) do { __builtin_amdgcn_s_setprio(1); _Pragma("unroll") for (int m = 0; m < 4; ++m) _Pragma("unroll") for (int n = 0; n < 2; ++n) _Pragma("unroll") for (int k = 0; k < 2; ++k) \
        acc[ai][bj][m][n] = __builtin_amdgcn_mfma_f32_16x16x32_bf16(Bt[n][k], At[m][k], acc[ai][bj][m][n], 0, 0, 0); __builtin_amdgcn_s_setprio(0); } while (0)
#define PG8_WAIT_V(n) asm volatile("s_waitcnt vmcnt(" #n ")" ::: "memory")
#define PG8_WAIT_L(n) asm volatile("s_waitcnt lgkmcnt(" #n ")" ::: "memory")
#define PG8_BAR __builtin_amdgcn_s_barrier()
#define PG8_SCHED __builtin_amdgcn_sched_barrier(0)
    Unit cur, nxt; int ui = 0;
    if (!S.next(0, cur)) return;
    LDSP unsigned* rowoff = (LDSP unsigned*)(lds + 132096) + tid;
    auto rows_of = [&](const Unit& u, int slot) {
        if constexpr (GATHER) {
#pragma unroll
            for (int h = 0; h < 2; ++h)
#pragma unroll
                for (int i = 0; i < 2; ++i) { int R, C; stage_rc(tid * 16 + i * 8192, R, C); const int idx = u.m0 + h * HALF + R; int gr = idx; if (u.rowmap) gr = (idx < u.nvalid) ? u.rowmap[idx] : 0;
                    rowoff[((slot & 1) * 4 + h * 2 + i) * 512] = (unsigned)(gr * K + C) * 2u; }
        }
    };
    rows_of(cur, 0);
    f32x4 acc[2][2][4][2];
#pragma unroll
    for (int a = 0; a < 2; ++a)
#pragma unroll
        for (int b = 0; b < 2; ++b)
#pragma unroll
            for (int m = 0; m < 4; ++m)
#pragma unroll
                for (int n = 0; n < 2; ++n) acc[a][b][m][n] = (f32x4){0.f, 0.f, 0.f, 0.f};
    bf16x8 At[4][2], B0[2][2], B1[2][2];
    const char* cA = cur.A; const char* cB = cur.B;
    PG8_STAGE(PG8_SB(0, 0), cB, voffB); PG8_STAGE(PG8_SB(0, 1), cB + hstep, voffB); PG8_STAGE_A(PG8_SA(0, 0), false, 0, cA, 0); PG8_STAGE_A(PG8_SA(0, 1), false, 1, cA, 0);
    if (wr == 1) PG8_BAR;
    PG8_WAIT_V(2); PG8_BAR;
    PG8_STAGE(PG8_SB(1, 0), cB + kstep, voffB); PG8_STAGE_A(PG8_SA(1, 0), false, 0, cA, kstep); PG8_STAGE(PG8_SB(1, 1), cB + hstep + kstep, voffB);
    PG8_WAIT_V(6); PG8_BAR;
    for (;;) {
        const bool has_next = S.next(ui + 1, nxt);
        rows_of(has_next ? nxt : cur, ui + 1);
        const char* nA = has_next ? nxt.A : cA; const char* nB = has_next ? nxt.B : cB;
#pragma unroll 1
        for (int t = 0; t < nt; t += 2) {
            const bool last = (t == nt - 2);
            const size_t k1 = (size_t)(t + 1) * kstep;
            const char* a2 = last ? nA : cA; const size_t k2 = last ? 0 : (size_t)(t + 2) * kstep;
            const char* b2 = last ? nB : cB + (size_t)(t + 2) * kstep;
            const char* b3 = b2 + kstep;
            PG8_LDB(B0, 0, 0); PG8_LDB(B1, 0, 1); PG8_SCHED; PG8_LDA(At, 0, 0); PG8_STAGE_A(PG8_SA(1, 1), false, 1, cA, k1);
            PG8_WAIT_V(8); PG8_WAIT_L(0); PG8_BAR; PG8_MMA(0, 0, At, B0); PG8_MMA(0, 1, At, B1); PG8_BAR; PG8_SCHED;
            PG8_LDA(At, 0, 1); PG8_STAGE(PG8_SB(0, 0), b2, voffB); PG8_STAGE(PG8_SB(0, 1), b2 + hstep, voffB); PG8_STAGE_A(PG8_SA(0, 0), last, 0, a2, k2);
            PG8_WAIT_V(8); PG8_WAIT_L(0); PG8_BAR; PG8_MMA(1, 0, At, B0); PG8_MMA(1, 1, At, B1); PG8_BAR; PG8_SCHED;
            PG8_LDB(B0, 1, 0); PG8_LDB(B1, 1, 1); PG8_SCHED; PG8_LDA(At, 1, 0); PG8_STAGE_A(PG8_SA(0, 1), last, 1, a2, k2);
            PG8_WAIT_V(8); PG8_WAIT_L(0); PG8_BAR; PG8_MMA(0, 0, At, B0); PG8_MMA(0, 1, At, B1); PG8_BAR; PG8_SCHED;
            PG8_LDA(At, 1, 1); PG8_STAGE(PG8_SB(1, 0), b3, voffB); PG8_STAGE(PG8_SB(1, 1), b3 + hstep, voffB); PG8_STAGE_A(PG8_SA(1, 0), last, 0, a2, k2 + kstep);
            PG8_WAIT_V(8); PG8_WAIT_L(0); PG8_BAR; PG8_MMA(1, 0, At, B0); PG8_MMA(1, 1, At, B1); PG8_BAR; PG8_SCHED;
        }
        if constexpr (ALIGN_EPI) { if (wr == 0) PG8_BAR; }
        E(acc, cur, wr, wc, fr, fq);
        if (!has_next) break;
#pragma unroll
        for (int a = 0; a < 2; ++a)
#pragma unroll
            for (int b = 0; b < 2; ++b)
#pragma unroll
                for (int m = 0; m < 4; ++m)
#pragma unroll
                    for (int n = 0; n < 2; ++n) acc[a][b][m][n] = (f32x4){0.f, 0.f, 0.f, 0.f};
        cur = nxt; cA = nA; cB = nB; ++ui;
        if constexpr (ALIGN_EPI) { if (wr == 1) PG8_BAR; }
    }
    PG8_WAIT_V(0);
    if constexpr (!ALIGN_EPI) { if (wr == 0) PG8_BAR; }
    PG8_BAR;
#undef PG8_SA
#undef PG8_SB
#undef PG8_STAGE
#undef PG8_STAGE_A
#undef PG8_LDA
#undef PG8_LDB
#undef PG8_MMA
#undef PG8_WAIT_V
#undef PG8_WAIT_L
#undef PG8_BAR
#undef PG8_SCHED
}

struct DenseSched {
    const char* A; const char* B; int nM, nN, K, G, c;
    __device__ __forceinline__ bool next(int i, Unit& u) const {
        const int nwg = nM * nN; const long L = (long)i * G + c; if (L >= nwg) return false;
        const int wgid = xcd_remap((int)L, nwg);
        const int nig = 8 * nN, gid = wgid / nig, fm = gid * 8, gsz = (nM - fm) < 8 ? (nM - fm) : 8;
        const int pm = fm + ((wgid % nig) % gsz), pn = (wgid % nig) / gsz;
        u.A = A + (size_t)pm * 256 * K * 2; u.B = B + (size_t)pn * 256 * K * 2; u.rowmap = nullptr; u.nvalid = 0; u.m0 = 0; u.row0 = pm * 256; u.col0 = pn * 256; u.pos0 = 0;
        return true;
    }
};
}

struct EpiPX { bf16_t* PX; __device__ __forceinline__ void operator()(int row, int col, f32x4 v) const {
    u32x2 w; w.x = pk2(v[0], v[1]); w.y = pk2(v[2], v[3]); *(u32x2*)(PX + (size_t)row * INP + col) = w; } };
struct EpiX1 { const float* x; const float* mod; float* X1; __device__ __forceinline__ void operator()(int row, int col, f32x4 v) const {
    const f32x4 xv = *(const f32x4*)(x + (size_t)row * D + col); const f32x4 g = *(const f32x4*)(mod + (size_t)(row >> 12) * 12288 + 2 * D + col);
    *(f32x4*)(X1 + (size_t)row * D + col) = xv + g * v; } };
struct EpiH1 { bf16_t* H1; int pos0, m0, cnt; __device__ __forceinline__ void operator()(int row, int col, f32x4 v) const {
    if (row < cnt) { const float a = v[0] * sigmoidf_(v[0]) * v[2], b = v[1] * sigmoidf_(v[1]) * v[3];
        *(unsigned*)(H1 + (size_t)(pos0 + row) * EFF + (col >> 1)) = pk2(a, b); } } };
struct EpiEO { bf16_t* EO; int pos0, cnt; __device__ __forceinline__ void operator()(int row, int col, f32x4 v) const {
    if (row < cnt) { u32x2 w; w.x = pk2(v[0], v[1]); w.y = pk2(v[2], v[3]); *(u32x2*)(EO + (size_t)(pos0 + row) * D + col) = w; } } };


struct FPX { bf16_t* PX; __device__ __forceinline__ void operator()(const pg8::Unit& u, int lr, int lc, f32x4 v0, f32x4 v1) const {
    *(u32x4*)(PX + (size_t)(u.row0 + lr) * INP + u.col0 + lc) = mk4u(pk2(v0[0], v0[1]), pk2(v0[2], v0[3]), pk2(v1[0], v1[1]), pk2(v1[2], v1[3])); } };
struct FX1 { const float* x; const float* mod; float* X1; __device__ __forceinline__ void operator()(const pg8::Unit& u, int lr, int lc, f32x4 v0, f32x4 v1) const {
    const int row = u.row0 + lr, col = u.col0 + lc; const float* xp = x + (size_t)row * D + col; const float* gp = mod + (size_t)(row >> 12) * 12288 + 2 * D + col; float* op = X1 + (size_t)row * D + col;
    *(f32x4*)op = *(const f32x4*)xp + *(const f32x4*)gp * v0; *(f32x4*)(op + 4) = *(const f32x4*)(xp + 4) + *(const f32x4*)(gp + 4) * v1; } };
struct FH1 { bf16_t* H1; __device__ __forceinline__ void operator()(const pg8::Unit& u, int lr, int lc, f32x4 v0, f32x4 v1) const {
    if (u.m0 + lr < u.nvalid) { float h[4];
#pragma unroll
        for (int e = 0; e < 4; ++e) h[e] = v0[e] * sigmoidf_(v0[e]) * v1[e];
        *(u32x2*)(H1 + (size_t)(u.pos0 + u.m0 + lr) * EFF + ((u.col0 + lc) >> 1)) = mk2u(pk2(h[0], h[1]), pk2(h[2], h[3])); } } };
struct FEO { bf16_t* EO; __device__ __forceinline__ void operator()(const pg8::Unit& u, int lr, int lc, f32x4 v0, f32x4 v1) const {
    if (u.m0 + lr < u.nvalid) *(u32x4*)(EO + (size_t)(u.pos0 + u.m0 + lr) * D + u.col0 + lc) = mk4u(pk2(v0[0], v0[1]), pk2(v0[2], v0[3]), pk2(v1[0], v1[1]), pk2(v1[2], v1[3])); } };

struct ConvJob { const float* src; bf16_t* dst; int K, N, ld, mode, ntk, ntn; size_t sbs, dbs; };
__device__ __forceinline__ int conv_row(int n, int mode) { return mode == 0 ? n : (8 * (n >> 2) + (n & 3) + (mode == 2 ? 4 : 0)); }

struct TileCtx { const float* src; bf16_t* dst; int N, ld, mode, k0, n0; };
constexpr int CT0 = 0, CT1 = CT0 + 8 * (INC / 64), CT2 = CT1 + 8 * 32, CT3 = CT2 + 64 * 64, CT4 = CT3 + 64 * 64, CT5 = CT4 + 64 * 64, CT6 = CT5 + 64, CT7 = CT6 + 64, CT8 = CT7 + 64, CT_END = CT8 + 16;
__device__ __forceinline__ void conv_decode(const Params& p, int g, const float*& src, bf16_t*& dst, int& N, int& ld, int& mode, int& k0, int& n0) {
    bf16_t* WTE1 = (bf16_t*)(p.ws + OFF_WTE1); bf16_t* WTE2 = (bf16_t*)(p.ws + OFF_WTE2);
    int t, ntk, ntn; size_t sbs = 0, dbs = 0;
    if (g < CT1)      { t = g - CT0; src = p.w_in; dst = (bf16_t*)(p.ws + OFF_WTIN); N = INC; ld = 2048; mode = 0; ntk = 8; ntn = INC / 64; }
    else if (g < CT2) { t = g - CT1; src = p.w_out; dst = (bf16_t*)(p.ws + OFF_WTOUT); N = 2048; ld = 2048; mode = 0; ntk = 8; ntn = 32; }
    else if (g < CT3) { t = g - CT2; src = p.e_gate; dst = WTE1; N = 512; ld = 2048; mode = 1; ntk = 8; ntn = 8; sbs = (size_t)2048 * 512; dbs = (size_t)1024 * 2048; }
    else if (g < CT4) { t = g - CT3; src = p.e_up; dst = WTE1; N = 512; ld = 2048; mode = 2; ntk = 8; ntn = 8; sbs = (size_t)2048 * 512; dbs = (size_t)1024 * 2048; }
    else if (g < CT5) { t = g - CT4; src = p.e_down; dst = WTE2; N = 2048; ld = 512; mode = 0; ntk = 2; ntn = 32; sbs = (size_t)512 * 2048; dbs = (size_t)2048 * 512; }
    else if (g < CT6) { t = g - CT5; src = p.s_gate; dst = WTE1 + (size_t)64 * 1024 * 2048; N = 512; ld = 2048; mode = 1; ntk = 8; ntn = 8; }
    else if (g < CT7) { t = g - CT6; src = p.s_up; dst = WTE1 + (size_t)64 * 1024 * 2048; N = 512; ld = 2048; mode = 2; ntk = 8; ntn = 8; }
    else if (g < CT8) { t = g - CT7; src = p.s_down; dst = WTE2 + (size_t)64 * 2048 * 512; N = 2048; ld = 512; mode = 0; ntk = 2; ntn = 32; }
    else              { t = g - CT8; src = p.gate_up; dst = (bf16_t*)(p.ws + OFF_WTGU); N = 1024; ld = 256; mode = 0; ntk = 1; ntn = 16; }
    const int per = ntk * ntn, bi = t / per, rem = t - bi * per, kt = rem / ntn, ntile = rem - kt * ntn;
    src += (size_t)bi * sbs; dst += (size_t)bi * dbs; k0 = kt * 256; n0 = ntile * 64;
}
__device__ __forceinline__ void conv_load(const float* src, int N, int k0, int n0, f32x4 (&v)[4][2], int tid) {
    const int kr = tid >> 3, nc = (tid & 7) * 8;
#pragma unroll
    for (int s = 0; s < 4; ++s) { const float* q = src + (size_t)(k0 + s * 64 + kr) * N + n0 + nc; v[s][0] = *(const f32x4*)q; v[s][1] = *(const f32x4*)(q + 4); }
}
__device__ __forceinline__ void conv_finish(LDSP unsigned char* lds, bf16_t* dst, int ld, int mode, int k0, int n0, const f32x4 (&v)[4][2], int tid) {
    LDSP float* Tm = (LDSP float*)lds;
    {
        const int kr = tid >> 3, nc = (tid & 7) * 8;
#pragma unroll
        for (int s = 0; s < 4; ++s) { LDSP float* q = Tm + (s * 64 + kr) * 65 + nc;
            q[0] = v[s][0].x; q[1] = v[s][0].y; q[2] = v[s][0].z; q[3] = v[s][0].w; q[4] = v[s][1].x; q[5] = v[s][1].y; q[6] = v[s][1].z; q[7] = v[s][1].w; }
    }
    __syncthreads();
    {
        const int n = tid >> 3; bf16_t* drow = dst + (size_t)conv_row(n0 + n, mode) * ld + k0;
#pragma unroll
        for (int s = 0; s < 4; ++s) { const int kc = ((tid & 7) + 8 * s) * 8; float f[8];
#pragma unroll
            for (int j = 0; j < 8; ++j) f[j] = Tm[(kc + j) * 65 + n];
            u32x4 w; w.x = pk2(f[0], f[1]); w.y = pk2(f[2], f[3]); w.z = pk2(f[4], f[5]); w.w = pk2(f[6], f[7]); *(u32x4*)(drow + kc) = w; }
    }
    __syncthreads();
}

__device__ __forceinline__ void mod_item(LDSP unsigned char* lds, const Params& p, int item) {
    const int kb = item >> 6, nb = item & 63, tid = opaque(threadIdx.x), wid = tid >> 6, lane = tid & 63;
    f32x4 acc[3];
#pragma unroll
    for (int v = 0; v < 3; ++v) acc[v] = mk4f(0.f, 0.f, 0.f, 0.f);
    if (lane < 48) {
#pragma unroll 8
        for (int i = 0; i < 64; ++i) {
            const int k = kb * 512 + wid * 64 + i;
            const float c0 = p.c[k], c1 = p.c[D + k], c2 = p.c_ctx[k];
            const float s0 = c0 * sigmoidf_(c0), s1 = c1 * sigmoidf_(c1), s2 = c2 * sigmoidf_(c2);
            const f32x4 w = *(const f32x4*)(p.w_mod + (size_t)k * 12288 + nb * 192 + 4 * lane);
            acc[0] += s0 * w; acc[1] += s1 * w; acc[2] += s2 * w;
        }
    }
    LDSP float* R = (LDSP float*)lds;
    if (lane < 48) {
#pragma unroll
        for (int v = 0; v < 3; ++v) *(LDSP f32x4*)(R + (wid * 3 + v) * 192 + 4 * lane) = acc[v];
    }
    __syncthreads();
    float* MODP = (float*)(p.ws + OFF_MODP);
    for (int o = tid; o < 3 * 192; o += 512) { const int v = o / 192, cidx = o - v * 192; float sum = 0.f;
#pragma unroll
        for (int w = 0; w < 8; ++w) sum += R[(w * 3 + v) * 192 + cidx];
        MODP[((size_t)kb * 3 + v) * 12288 + nb * 192 + cidx] = sum; }
    __syncthreads();
}

__device__ __forceinline__ void phase0(LDSP unsigned char* lds, const Params& p) {
    const int tid = opaque(threadIdx.x);
    for (int it = blockIdx.x; it < 256; it += gridDim.x) mod_item(lds, p, it);
    {
        int g = blockIdx.x;
        const float* csrc = nullptr; bf16_t* cdst = nullptr; int cN = 0, cld = 0, cmode = 0, ck0 = 0, cn0 = 0;
        const float* nsrc = nullptr; bf16_t* ndst = nullptr; int nN = 0, nld = 0, nmode = 0, nk0 = 0, nn0 = 0;
        f32x4 va[4][2], vb[4][2];
        if (g < CT_END) { conv_decode(p, g, csrc, cdst, cN, cld, cmode, ck0, cn0); conv_load(csrc, cN, ck0, cn0, va, tid); }
#pragma unroll 1
        while (g < CT_END) {
            const int gn = g + gridDim.x;
            if (gn < CT_END) { conv_decode(p, gn, nsrc, ndst, nN, nld, nmode, nk0, nn0); conv_load(nsrc, nN, nk0, nn0, vb, tid); }
            conv_finish(lds, cdst, cld, cmode, ck0, cn0, va, tid);
            cdst = ndst; cld = nld; cmode = nmode; ck0 = nk0; cn0 = nn0; g = gn;
#pragma unroll
            for (int s = 0; s < 4; ++s) { va[s][0] = vb[s][0]; va[s][1] = vb[s][1]; }
        }
    }
    {
        const int total = 4 * 1024 * 128;
        for (int idx = blockIdx.x * 512 + tid; idx < total; idx += gridDim.x * 512) {
            const int mtx = idx >> 17, rem = idx & 131071, n = rem >> 7, k = rem & 127;
            const float* src = (mtx < 2 ? p.decay_up : p.iclr_up) + (size_t)(mtx & 1) * 96 * 1024;
            bf16_t* dst = (bf16_t*)(p.ws + (mtx < 2 ? OFF_WTDU : OFF_WTIU)) + (size_t)(mtx & 1) * 1024 * 128;
            dst[n * 128 + k] = (bf16_t)f2bf(k < 96 ? src[(size_t)k * 1024 + n] : 0.f);
        }
    }
    {
        u32x4* z = (u32x4*)((bf16_t*)(p.ws + OFF_WTIN) + (size_t)INC * D);
        const int total = (INP - INC) * D * 2 / 16;
        for (int idx = blockIdx.x * 512 + tid; idx < total; idx += gridDim.x * 512) z[idx] = mk4u(0, 0, 0, 0);
    }
    if (blockIdx.x == gridDim.x - 1) {
        float2* R = (float2*)(p.ws + OFF_ROPE);
        for (int idx = tid; idx < 1024; idx += 512) { const int pos = idx >> 4, f = idx & 15;
            const float freq = powf(10000.f, -(float)f / 16.f); const float ang = (float)pos * freq; R[idx] = make_float2(cosf(ang), sinf(ang)); }
    }
}

__device__ __forceinline__ void phase1(LDSP unsigned char* lds, const Params& p) {
    const int tid = opaque(threadIdx.x), wid = tid >> 6, lane = tid & 63;
    const float* MODP = (const float*)(p.ws + OFF_MODP);
    float* MOD = (float*)(p.ws + OFF_MOD);
    LDSP float* MV = (LDSP float*)lds;
    for (int idx = tid; idx < 3 * 4096; idx += 512) { const int v = idx >> 12, col = idx & 4095; float s = p.b_mod[col];
#pragma unroll
        for (int kb = 0; kb < 4; ++kb) s += MODP[((size_t)kb * 3 + v) * 12288 + col];
        MV[idx] = s; }
    for (int idx = blockIdx.x * 512 + tid; idx < 3 * 12288; idx += gridDim.x * 512) { const int v = idx / 12288, col = idx - v * 12288; float s = p.b_mod[col];
#pragma unroll
        for (int kb = 0; kb < 4; ++kb) s += MODP[((size_t)kb * 3 + v) * 12288 + col];
        MOD[idx] = s; }
    __syncthreads();
    bf16_t* HX = (bf16_t*)(p.ws + OFF_HX);
    for (int row = blockIdx.x * 8 + wid; row < NR; row += gridDim.x * 8) {
        const float* src = row < NX ? p.x + (size_t)row * D : p.ctx + (size_t)(row - NX) * D;
        const int v = row < NX ? (row >> 12) : 2;
        f32x4 xv[8]; float ss = 0.f;
#pragma unroll
        for (int i = 0; i < 8; ++i) { xv[i] = ((const f32x4*)src)[lane + 64 * i]; ss += xv[i].x * xv[i].x + xv[i].y * xv[i].y + xv[i].z * xv[i].z + xv[i].w * xv[i].w; }
        ss = wave_sum(ss);
        const float rs = rsqrtf(ss * (1.f / D) + 1e-6f);
#pragma unroll
        for (int i = 0; i < 8; ++i) { const int col = 4 * (lane + 64 * i);
            const f32x4 g = *(const f32x4*)(p.norm1_g + col); const LDSP float* sh = MV + v * 4096 + col; const LDSP float* sc = sh + 2048;
            const float h0 = xv[i].x * rs * g.x * (1.f + sc[0]) + sh[0], h1 = xv[i].y * rs * g.y * (1.f + sc[1]) + sh[1];
            const float h2 = xv[i].z * rs * g.z * (1.f + sc[2]) + sh[2], h3 = xv[i].w * rs * g.w * (1.f + sc[3]) + sh[3];
            u32x2 w; w.x = pk2(h0, h1); w.y = pk2(h2, h3); *(u32x2*)(HX + (size_t)row * D + col) = w; }
    }
}

__device__ __forceinline__ void phase2(LDSP unsigned char* lds, const Params& p) {
    pg8::Epi<FPX> epi{FPX{(bf16_t*)(p.ws + OFF_PX)}};
    pg8::DenseSched S{(const char*)(p.ws + OFF_HX), (const char*)(p.ws + OFF_WTIN), NR / 256, INP / 256, D, (int)gridDim.x, (int)blockIdx.x};
    pg8::gemm_phase<false>(lds, D, S, epi);
}

__device__ __forceinline__ float px_shift(const bf16_t* PX, const float* mu, int row, int s0, int len, int col) {
    const float c = bf2f(PX[(size_t)row * INP + col]);
    const float pv = (row > s0) ? bf2f(PX[(size_t)(row - 1) * INP + col]) : 0.f;
    const float nx = (row + 1 < s0 + len) ? bf2f(PX[(size_t)(row + 1) * INP + col]) : 0.f;
    return c + mu[col] * (0.5f * (pv + nx) - c);
}

__device__ __forceinline__ void phaseR1(LDSP unsigned char* lds, const Params& p) {
    const int tid = opaque(threadIdx.x), wid = tid >> 6, lane = tid & 63;
    const bf16_t* PX = (const bf16_t*)(p.ws + OFF_PX);
    for (int row = blockIdx.x * 8 + wid; row < NR; row += gridDim.x * 8) {
        const bool isx = row < NX;
        const int s0 = isx ? (row & ~(T - 1)) : NX + ((row - NX) & ~(CL - 1)), len = isx ? T : CL;
        const bool hp = row > s0, hn = row + 1 < s0 + len;
        const bf16_t* pc = PX + (size_t)row * INP;
#pragma unroll 1
        for (int it = 0; it < 7; ++it) {
            const int ch = lane + 64 * it;
            if (ch < 440) {
                const int col = ch * 8;
                const u32x4 c4 = *(const u32x4*)(pc + col);
                u32x4 p4 = mk4u(0, 0, 0, 0), n4 = mk4u(0, 0, 0, 0);
                if (hp) p4 = *(const u32x4*)(pc - INP + col);
                if (hn) n4 = *(const u32x4*)(pc + INP + col);
                const f32x4 m0 = *(const f32x4*)(p.shift_mu + col), m1 = *(const f32x4*)(p.shift_mu + col + 4);
                const float mu[8] = {m0.x, m0.y, m0.z, m0.w, m1.x, m1.y, m1.z, m1.w};
                const unsigned cw[4] = {c4.x, c4.y, c4.z, c4.w}, pw[4] = {p4.x, p4.y, p4.z, p4.w}, nw[4] = {n4.x, n4.y, n4.z, n4.w};
                float v[8];
#pragma unroll
                for (int j = 0; j < 4; ++j) {
                    const float c0 = bf2f(cw[j] & 0xffff), c1 = bf2f(cw[j] >> 16);
                    v[2 * j] = c0 + mu[2 * j] * (0.5f * (bf2f(pw[j] & 0xffff) + bf2f(nw[j] & 0xffff)) - c0);
                    v[2 * j + 1] = c1 + mu[2 * j + 1] * (0.5f * (bf2f(pw[j] >> 16) + bf2f(nw[j] >> 16)) - c1);
                }
                if (it < 2) {
                    *(u32x4*)((bf16_t*)(p.ws + OFF_RS) + (size_t)row * 1024 + col) = mk4u(pk2(v[0], v[1]), pk2(v[2], v[3]), pk2(v[4], v[5]), pk2(v[6], v[7]));
                } else if (it < 4) {
                    const int kc = col - C_K;
                    *(u32x4*)((bf16_t*)(p.ws + OFF_KS) + (size_t)row * 1024 + kc) = mk4u(pk2(v[0], v[1]), pk2(v[2], v[3]), pk2(v[4], v[5]), pk2(v[6], v[7]));
                    const f32x4 k0 = *(const f32x4*)(p.k_k + kc), k1 = *(const f32x4*)(p.k_k + kc + 4);
                    const float kq[8] = {k0.x, k0.y, k0.z, k0.w, k1.x, k1.y, k1.z, k1.w};
                    float ss = 0.f;
#pragma unroll
                    for (int j = 0; j < 8; ++j) { v[j] *= kq[j]; ss += v[j] * v[j]; }
                    ss += __shfl_xor(ss, 1); ss += __shfl_xor(ss, 2); ss += __shfl_xor(ss, 4);
                    const float sc = rsqrtf(ss + 1e-12f);
                    *(u32x4*)((bf16_t*)(p.ws + OFF_KK) + (size_t)row * 1024 + kc) = mk4u(pk2(v[0] * sc, v[1] * sc), pk2(v[2] * sc, v[3] * sc), pk2(v[4] * sc, v[5] * sc), pk2(v[6] * sc, v[7] * sc));
                } else if (it < 6) {
                    *(u32x4*)((bf16_t*)(p.ws + OFF_VS) + (size_t)row * 1024 + col - C_V) = mk4u(pk2(v[0], v[1]), pk2(v[2], v[3]), pk2(v[4], v[5]), pk2(v[6], v[7]));
                } else if (ch < 396) {
#pragma unroll
                    for (int j = 0; j < 8; ++j) v[j] = tanhf(v[j]);
                    *(u32x4*)((bf16_t*)(p.ws + OFF_TW) + (size_t)row * 128 + col - C_XW) = mk4u(pk2(v[0], v[1]), pk2(v[2], v[3]), pk2(v[4], v[5]), pk2(v[6], v[7]));
                } else if (ch < 408) {
                    *(u32x4*)((bf16_t*)(p.ws + OFF_XA) + (size_t)row * 128 + col - C_XA) = mk4u(pk2(v[0], v[1]), pk2(v[2], v[3]), pk2(v[4], v[5]), pk2(v[6], v[7]));
                } else if (isx) {
#pragma unroll
                    for (int j = 0; j < 8; ++j) v[j] = sigmoidf_(v[j]);
                    *(u32x4*)((bf16_t*)(p.ws + OFF_SG) + (size_t)row * 256 + col - C_XG) = mk4u(pk2(v[0], v[1]), pk2(v[2], v[3]), pk2(v[4], v[5]), pk2(v[6], v[7]));
                }
            }
        }
        if (lane < 4) { *(u32x4*)((bf16_t*)(p.ws + OFF_TW) + (size_t)row * 128 + 96 + lane * 8) = mk4u(0, 0, 0, 0); *(u32x4*)((bf16_t*)(p.ws + OFF_XA) + (size_t)row * 128 + 96 + lane * 8) = mk4u(0, 0, 0, 0); }
    }
}

struct LoraSched {
    const char *A0, *B0, *A1, *B1; int G, c;
    __device__ __forceinline__ bool next(int i, pg8::Unit& u) const {
        const int per = (NR / 256) * 8; const long L = (long)i * G + c; if (L >= 2 * per) return false;
        const int job = (int)L / per, w = (int)L % per, pm = w >> 3, pn = w & 7;
        u.A = (job ? A1 : A0) + (size_t)pm * 256 * 128 * 2; u.B = (job ? B1 : B0) + (size_t)pn * 256 * 128 * 2; u.rowmap = nullptr; u.nvalid = 0; u.m0 = 0; u.row0 = pm * 256; u.col0 = pn * 256; u.pos0 = job;
        return true;
    }
};
struct FLORA { const float* dbias; const float* ibias; bf16_t* LWG; bf16_t* AIG; __device__ __forceinline__ void operator()(const pg8::Unit& u, int lr, int lc, f32x4 v0, f32x4 v1) const {
    const int row = u.row0 + lr, col = u.col0 + lc;
    const float* bp = (u.pos0 == 0 ? dbias : ibias) + col; const f32x4 b0 = *(const f32x4*)bp, b1 = *(const f32x4*)(bp + 4);
    const float sc = (u.pos0 == 0) ? -0.60653065971f : 1.f;
    float o[8];
#pragma unroll
    for (int e = 0; e < 4; ++e) { o[e] = sc * sigmoidf_(b0[e] + v0[e]); o[4 + e] = sc * sigmoidf_(b1[e] + v1[e]); }
    *(u32x4*)((u.pos0 == 0 ? LWG : AIG) + (size_t)row * 2048 + col) = mk4u(pk2(o[0], o[1]), pk2(o[2], o[3]), pk2(o[4], o[5]), pk2(o[6], o[7]));
} };
struct FGG { bf16_t* GG; __device__ __forceinline__ void operator()(const pg8::Unit& u, int lr, int lc, f32x4 v0, f32x4 v1) const {
    *(u32x4*)(GG + (size_t)(u.row0 + lr) * 1024 + u.col0 + lc) = mk4u(pk2(v0[0], v0[1]), pk2(v0[2], v0[3]), pk2(v1[0], v1[1]), pk2(v1[2], v1[3])); } };

constexpr int L_AT = 0, L_RT = 8192, L_BT = 16384, L_KT = 24576, L_BHT = 32768, L_KHT = 40960, L_VT = 49152, L_AAK = 57344, L_ARB = 65536, L_ARK = 73728,
              L_P0 = 81920, L_PT0 = 90112, L_P1 = 98304, L_PT1 = 106496, L_X0 = 114688, L_X1 = 131072, L_SEG = 147456, L_GL = 149504, L_END = 149760;
static_assert(L_END <= SMEM_BYTES, "R3 LDS map");

__device__ __forceinline__ int inst_index(int b, int h, int d, int chunk) { return ((b * 16 + h) * 2 + d) * NCHUNK + chunk; }

__device__ __forceinline__ void ld_frags(const LDSP unsigned char* M, int row0, int lane, bf16x8 (&f)[4]) {
    const int r = lane & 31, h = lane >> 5;
#pragma unroll
    for (int s = 0; s < 4; ++s) f[s] = *(const LDSP bf16x8*)(M + sw64(row0 + r, 16 * s + 8 * h));
}
__device__ __forceinline__ void store_t(LDSP unsigned char* dst, int yrow, int x0, const f32x16& acc, int lane) {
    const int hh = lane >> 5;
#pragma unroll
    for (int gq = 0; gq < 4; ++gq) *(LDSP u32x2*)(dst + sw64(yrow, x0 + 8 * gq + 4 * hh)) = mk2u(pk2(acc[4 * gq], acc[4 * gq + 1]), pk2(acc[4 * gq + 2], acc[4 * gq + 3]));
}

__device__ __forceinline__ void rwkv_prep_unit(LDSP unsigned char* lds, const Params& p, int unit) {
    int seq, c, h, d;
    if (unit < 4096) { seq = unit >> 11; c = (unit >> 5) & 63; h = (unit >> 1) & 15; d = unit & 1; } else { const int u = unit - 4096; seq = 2 + (u >> 7); c = (u >> 5) & 3; h = (u >> 1) & 15; d = u & 1; }
    const bool isx = seq < 2;
    const int b = seq & 1;
    const int s0 = isx ? b * T : NX + b * CL, t0 = c * 64;
    const int chunk_id = isx ? 4 + c : c;
    {
        const int tid = opaque(threadIdx.x), seg = tid >> 6, lane = tid & 63, k = lane, hk = h * 64 + k;
        const float kac = p.k_a[hk];
        const bf16_t* RS = (const bf16_t*)(p.ws + OFF_RS); const bf16_t* KS = (const bf16_t*)(p.ws + OFF_KS); const bf16_t* KKp = (const bf16_t*)(p.ws + OFF_KK); const bf16_t* VS = (const bf16_t*)(p.ws + OFF_VS);
        const bf16_t* LWG = (const bf16_t*)(p.ws + OFF_LWG); const bf16_t* AIG = (const bf16_t*)(p.ws + OFF_AIG);
        float rr[8], kd[8], vv[8], aa[8], bb[8], lw[8];
        float run = 0.f;
#pragma unroll
        for (int tt = 0; tt < 8; ++tt) {
            const int i = seg * 8 + tt, tau = d ? 63 - i : i; const size_t row = (size_t)(s0 + t0 + tau);
            rr[tt] = bf2f(RS[row * 1024 + hk]); const float kraw = bf2f(KS[row * 1024 + hk]), kk = bf2f(KKp[row * 1024 + hk]); vv[tt] = bf2f(VS[row * 1024 + hk]);
            const float lwv = bf2f(LWG[row * 2048 + d * 1024 + hk]), a = bf2f(AIG[row * 2048 + d * 1024 + hk]);
            kd[tt] = kraw * (1.f + (a - 1.f) * kac); bb[tt] = kk * a; aa[tt] = -kk;
            run += lwv; lw[tt] = run;
        }
        LDSP float* SEG = (LDSP float*)(lds + L_SEG);
        SEG[seg * 64 + k] = run;
        __syncthreads();
        float off = 0.f, gL = 0.f;
#pragma unroll
        for (int s = 0; s < 8; ++s) { const float sv = SEG[s * 64 + k]; if (s < seg) off += sv; gL += sv; }
        if (seg == 0) ((LDSP float*)(lds + L_GL))[k] = gL;
        const float egL = __expf(gL);
        float fat[8], frt[8], fbt[8], fkt[8], fbh[8], fkh[8];
#pragma unroll
        for (int tt = 0; tt < 8; ++tt) {
            const float g = off + lw[tt];
            const float ge = (tt == 0) ? off : off + lw[tt - 1];
            const float eg = __expf(g), ege = __expf(ge), eng = __builtin_amdgcn_rcpf(eg), egl = egL * eng;
            fat[tt] = aa[tt] * ege; frt[tt] = rr[tt] * eg; fbt[tt] = bb[tt] * eng; fkt[tt] = kd[tt] * eng; fbh[tt] = bb[tt] * egl; fkh[tt] = kd[tt] * egl;
        }
        unsigned wat[4], wbh[4], wkh[4], wv[4];
#pragma unroll
        for (int t2 = 0; t2 < 4; ++t2) {
            const int i0 = seg * 8 + 2 * t2;
            wat[t2] = pk2(fat[2 * t2], fat[2 * t2 + 1]); wbh[t2] = pk2(fbh[2 * t2], fbh[2 * t2 + 1]); wkh[t2] = pk2(fkh[2 * t2], fkh[2 * t2 + 1]); wv[t2] = pk2(vv[2 * t2], vv[2 * t2 + 1]);
            const unsigned wr = pk2(frt[2 * t2], frt[2 * t2 + 1]), wb = pk2(fbt[2 * t2], fbt[2 * t2 + 1]), wk = pk2(fkt[2 * t2], fkt[2 * t2 + 1]);
            *(LDSP bf16_t*)(lds + L_AT + sw64(i0, k)) = (bf16_t)(wat[t2] & 0xffffu); *(LDSP bf16_t*)(lds + L_AT + sw64(i0 + 1, k)) = (bf16_t)(wat[t2] >> 16);
            *(LDSP bf16_t*)(lds + L_RT + sw64(i0, k)) = (bf16_t)(wr & 0xffffu);      *(LDSP bf16_t*)(lds + L_RT + sw64(i0 + 1, k)) = (bf16_t)(wr >> 16);
            *(LDSP bf16_t*)(lds + L_BT + sw64(i0, k)) = (bf16_t)(wb & 0xffffu);      *(LDSP bf16_t*)(lds + L_BT + sw64(i0 + 1, k)) = (bf16_t)(wb >> 16);
            *(LDSP bf16_t*)(lds + L_KT + sw64(i0, k)) = (bf16_t)(wk & 0xffffu);      *(LDSP bf16_t*)(lds + L_KT + sw64(i0 + 1, k)) = (bf16_t)(wk >> 16);
        }
        *(LDSP u32x4*)(lds + L_X0 + sw64(k, seg * 8)) = mk4u(wat[0], wat[1], wat[2], wat[3]);
        *(LDSP u32x4*)(lds + L_BHT + sw64(k, seg * 8)) = mk4u(wbh[0], wbh[1], wbh[2], wbh[3]);
        *(LDSP u32x4*)(lds + L_KHT + sw64(k, seg * 8)) = mk4u(wkh[0], wkh[1], wkh[2], wkh[3]);
        *(LDSP u32x4*)(lds + L_VT + sw64(k, seg * 8)) = mk4u(wv[0], wv[1], wv[2], wv[3]);
    }
    __syncthreads();
    {
        const int tid = opaque(threadIdx.x), wid = tid >> 6, lane = tid & 63, r = lane & 31, hh = lane >> 5;
        const int xb = (wid >> 1) & 1, yb = wid & 1, hi = wid >> 2;
        const int A1 = hi ? L_AT : L_BT, B1 = hi ? L_BT : L_AT, D1 = hi ? L_PT0 : L_P0;
        const int A2 = hi ? L_BT : L_KT, B2 = hi ? L_RT : L_AT, D2 = hi ? L_ARB : L_AAK;
        bf16x8 a1[4], b1[4], a2[4], b2[4];
        ld_frags(lds + A1, 32 * xb, lane, a1); ld_frags(lds + B1, 32 * yb, lane, b1); ld_frags(lds + A2, 32 * xb, lane, a2); ld_frags(lds + B2, 32 * yb, lane, b2);
        f32x16 c1 = zero16(), c2 = zero16();
#pragma unroll
        for (int s = 0; s < 4; ++s) { c1 = __builtin_amdgcn_mfma_f32_32x32x16_bf16(a1[s], b1[s], c1, 0, 0, 0); c2 = __builtin_amdgcn_mfma_f32_32x32x16_bf16(a2[s], b2[s], c2, 0, 0, 0); }
        if (wid < 4) { ld_frags(lds + L_KT, 32 * xb, lane, a1); ld_frags(lds + L_RT, 32 * yb, lane, b1); }
        const int y = 32 * yb + r;
#pragma unroll
        for (int g = 0; g < 16; ++g) { const int x = 32 * xb + crow(g, hh);
            const bool k1 = hi ? (y < x) : (x < y), k2 = hi ? (x <= y) : (x < y);
            c1[g] = k1 ? c1[g] : 0.f; c2[g] = k2 ? c2[g] : 0.f; }
        store_t(lds + D1, y, 32 * xb, c1, lane);
        store_t(lds + D2, y, 32 * xb, c2, lane);
        if (wid < 4) {
            f32x16 c3 = zero16();
#pragma unroll
            for (int s = 0; s < 4; ++s) c3 = __builtin_amdgcn_mfma_f32_32x32x16_bf16(a1[s], b1[s], c3, 0, 0, 0);
#pragma unroll
            for (int g = 0; g < 16; ++g) { const int x = 32 * xb + crow(g, hh); c3[g] = (x <= y) ? c3[g] : 0.f; }
            store_t(lds + L_ARK, y, 32 * xb, c3, lane);
        }
    }
    __syncthreads();
    {
        const int tid = opaque(threadIdx.x), wid = tid >> 6, lane = tid & 63, r = lane & 31;
        if (wid < 4) { const int ib = wid >> 1, vb = wid & 1;
            bf16x8 a1[4], b1[4]; ld_frags(lds + L_AAK, 32 * ib, lane, a1); ld_frags(lds + L_VT, 32 * vb, lane, b1);
            f32x16 acc = zero16();
#pragma unroll
            for (int s = 0; s < 4; ++s) acc = __builtin_amdgcn_mfma_f32_32x32x16_bf16(a1[s], b1[s], acc, 0, 0, 0);
            store_t(lds + L_X0, 64 + 32 * vb + r, 32 * ib, acc, lane); }
    }
    __syncthreads();
#pragma unroll 1
    for (int s = 0; s < 6; ++s) {
        const int tid = opaque(threadIdx.x), wid = tid >> 6, lane = tid & 63, r = lane & 31, hh = lane >> 5;
        const LDSP unsigned char* Pc = lds + ((s & 1) ? L_P1 : L_P0); const LDSP unsigned char* PTc = lds + ((s & 1) ? L_PT1 : L_PT0); const LDSP unsigned char* Xc = lds + ((s & 1) ? L_X1 : L_X0);
        LDSP unsigned char* Pn = lds + ((s & 1) ? L_P0 : L_P1); LDSP unsigned char* PTn = lds + ((s & 1) ? L_PT0 : L_PT1); LDSP unsigned char* Xn = lds + ((s & 1) ? L_X0 : L_X1);
        if (wid < 4) {
            const int cb = wid, col = 32 * cb + r;
            bf16x8 xb_[4], p0[4], p1[4];
            ld_frags(Xc, 32 * cb, lane, xb_); ld_frags(Pc, 0, lane, p0); ld_frags(Pc, 32, lane, p1);
            f32x16 acc0, acc1;
#pragma unroll
            for (int gq = 0; gq < 4; ++gq) { const u32x2 w0 = *(const LDSP u32x2*)(Xc + sw64(col, 8 * gq + 4 * hh)), w1 = *(const LDSP u32x2*)(Xc + sw64(col, 32 + 8 * gq + 4 * hh));
                acc0[4 * gq] = bf2f(w0.x & 0xffff); acc0[4 * gq + 1] = bf2f(w0.x >> 16); acc0[4 * gq + 2] = bf2f(w0.y & 0xffff); acc0[4 * gq + 3] = bf2f(w0.y >> 16);
                acc1[4 * gq] = bf2f(w1.x & 0xffff); acc1[4 * gq + 1] = bf2f(w1.x >> 16); acc1[4 * gq + 2] = bf2f(w1.y & 0xffff); acc1[4 * gq + 3] = bf2f(w1.y >> 16); }
#pragma unroll
            for (int t = 0; t < 4; ++t) { if (t < 2) acc0 = __builtin_amdgcn_mfma_f32_32x32x16_bf16(p0[t], xb_[t], acc0, 0, 0, 0); acc1 = __builtin_amdgcn_mfma_f32_32x32x16_bf16(p1[t], xb_[t], acc1, 0, 0, 0); }
            store_t(Xn, col, 0, acc0, lane); store_t(Xn, col, 32, acc1, lane);
        } else if (s < 5) {
            const int a = (wid >> 1) & 1, bq = wid & 1;
            f32x16 z = zero16(), zt = zero16();
            if (a <= bq) {
                bf16x8 fa[4], fb[4];
                ld_frags(PTc, 32 * a, lane, fa); ld_frags(Pc, 32 * bq, lane, fb);
                const int t0 = (a == 1) ? 2 : 0, t1 = (bq == 0) ? 2 : 4;
#pragma unroll
                for (int t = 0; t < 4; ++t) if (t >= t0 && t < t1) { z = __builtin_amdgcn_mfma_f32_32x32x16_bf16(fa[t], fb[t], z, 0, 0, 0); zt = __builtin_amdgcn_mfma_f32_32x32x16_bf16(fb[t], fa[t], zt, 0, 0, 0); }
            }
            store_t(Pn, 32 * bq + r, 32 * a, z, lane);
            store_t(PTn, 32 * a + r, 32 * bq, zt, lane);
        }
        __syncthreads();
    }
    {
        const int tid = opaque(threadIdx.x), wid = tid >> 6, lane = tid & 63, r = lane & 31, hh = lane >> 5;
        const int mi = wid >> 1, half = wid & 1;
        const size_t inst = (size_t)inst_index(b, h, d, chunk_id) * 4096;
        bf16_t* dst = (bf16_t*)(p.ws + (mi == 0 ? OFF_CM : mi == 1 ? OFF_CN : mi == 2 ? OFF_CP : OFF_CQ)) + inst;
        if (isx || mi < 2) {
            const int Ax = (mi == 1) ? L_BHT : L_X0, Ax0 = (mi == 3) ? 64 : 0;
            const int By = (mi == 0) ? L_BHT : (mi == 1) ? L_X0 : L_ARB, By0 = (mi == 1) ? 64 : 0;
            bf16x8 a0[4], a1[4], b1[4];
            ld_frags(lds + Ax, Ax0, lane, a0); ld_frags(lds + Ax, Ax0 + 32, lane, a1); ld_frags(lds + By, By0 + 32 * half, lane, b1);
            f32x16 c0 = zero16(), c1 = zero16();
#pragma unroll
            for (int t = 0; t < 4; ++t) { c0 = __builtin_amdgcn_mfma_f32_32x32x16_bf16(a0[t], b1[t], c0, 0, 0, 0); c1 = __builtin_amdgcn_mfma_f32_32x32x16_bf16(a1[t], b1[t], c1, 0, 0, 0); }
            if (mi & 1) {
                const int A2 = (mi == 1) ? L_KHT : L_VT, B2 = (mi == 1) ? L_VT : L_ARK;
                ld_frags(lds + A2, 0, lane, a0); ld_frags(lds + A2, 32, lane, a1); ld_frags(lds + B2, 32 * half, lane, b1);
#pragma unroll
                for (int t = 0; t < 4; ++t) { c0 = __builtin_amdgcn_mfma_f32_32x32x16_bf16(a0[t], b1[t], c0, 0, 0, 0); c1 = __builtin_amdgcn_mfma_f32_32x32x16_bf16(a1[t], b1[t], c1, 0, 0, 0); }
            }
            const int y = 32 * half + r;
            const float dg = (mi == 0) ? __expf(((const LDSP float*)(lds + L_GL))[y]) : 0.f;
#pragma unroll
            for (int xb = 0; xb < 2; ++xb) {
#pragma unroll
                for (int gq = 0; gq < 4; ++gq) {
                    const int x0 = 32 * xb + 8 * gq + 4 * hh;
                    float v0 = xb ? c1[4 * gq] : c0[4 * gq], v1 = xb ? c1[4 * gq + 1] : c0[4 * gq + 1], v2 = xb ? c1[4 * gq + 2] : c0[4 * gq + 2], v3 = xb ? c1[4 * gq + 3] : c0[4 * gq + 3];
                    if (mi == 0) { if (x0 == y) v0 += dg; if (x0 + 1 == y) v1 += dg; if (x0 + 2 == y) v2 += dg; if (x0 + 3 == y) v3 += dg; }
                    if (mi == 2) { const u32x2 w = *(const LDSP u32x2*)(lds + L_RT + sw64(y, x0)); v0 += bf2f(w.x & 0xffff); v1 += bf2f(w.x >> 16); v2 += bf2f(w.y & 0xffff); v3 += bf2f(w.y >> 16); }
                    *(u32x2*)(dst + ((half * 4 + 2 * xb + (gq >> 1)) * 64 + hh * 32 + r) * 8 + 4 * (gq & 1)) = mk2u(pk2(v0, v1), pk2(v2, v3));
                }
            }
        }
    }
    __syncthreads();
}

constexpr int LA_K = 0  , LA_VT = 73728  , LA_END = LA_VT + 18 * 4608;
static_assert(LA_END <= SMEM_BYTES, "attention LDS map");

__device__ __forceinline__ void attn_unit(LDSP unsigned char* lds, const Params& p, int unit) {
    const int tid = opaque(threadIdx.x), wid = tid >> 6, lane = tid & 63;
    const int b = unit >> 8, kvh = (unit >> 6) & 3, qb = unit & 63, q0 = qb * 64;
    const bf16_t* PX = (const bf16_t*)(p.ws + OFF_PX);
    const float2* ROPE = (const float2*)(p.ws + OFF_ROPE);
    for (int task = tid; task < 576 * 4; task += 512) {
        const int key = task >> 2, pr = task & 3, c0 = (pr & 1) + 4 * (pr >> 1);
        u32x4 w0 = mk4u(0, 0, 0, 0), w1 = mk4u(0, 0, 0, 0);
        if (key < 320) {
            const int pos = q0 - 128 + key;
            if (pos >= 0 && pos < T) {
                const bf16_t* src = PX + (size_t)(b * T + pos) * INP + C_AK + kvh * 64 + c0 * 8;
                const u32x4 x1 = *(const u32x4*)src, x2 = *(const u32x4*)(src + 16);
                const int ppos = (pr < 2) ? (pos >> 6) : (pos & 63);
                const float2* tb = ROPE + ppos * 16 + (pr & 1) * 8;
                const unsigned a1[4] = {x1.x, x1.y, x1.z, x1.w}, a2[4] = {x2.x, x2.y, x2.z, x2.w};
                unsigned o1[4], o2[4];
#pragma unroll
                for (int j = 0; j < 4; ++j) {
                    const float2 cs0 = tb[2 * j], cs1 = tb[2 * j + 1];
                    const float u0 = bf2f(a1[j] & 0xffff), u1 = bf2f(a1[j] >> 16), v0 = bf2f(a2[j] & 0xffff), v1 = bf2f(a2[j] >> 16);
                    o1[j] = pk2(u0 * cs0.x - v0 * cs0.y, u1 * cs1.x - v1 * cs1.y);
                    o2[j] = pk2(v0 * cs0.x + u0 * cs0.y, v1 * cs1.x + u1 * cs1.y);
                }
                w0 = mk4u(o1[0], o1[1], o1[2], o1[3]); w1 = mk4u(o2[0], o2[1], o2[2], o2[3]);
            }
        } else {
            const bf16_t* src = PX + (size_t)(NX + b * CL + (key - 320)) * INP + C_AK + kvh * 64 + c0 * 8;
            w0 = *(const u32x4*)src; w1 = *(const u32x4*)(src + 16);
        }
        *(LDSP u32x4*)(lds + LA_K + sw64(key, c0 * 8)) = w0;
        *(LDSP u32x4*)(lds + LA_K + sw64(key, c0 * 8 + 16)) = w1;
    }
    for (int task = tid; task < 144 * 8; task += 512) {
        const int kg = task >> 3, dc = task & 7;
        unsigned short e[4][8];
#pragma unroll
        for (int q = 0; q < 4; ++q) {
            const int key = kg * 4 + q;
            u32x4 w = mk4u(0, 0, 0, 0);
            if (key < 320) { const int pos = q0 - 128 + key; if (pos >= 0 && pos < T) w = *(const u32x4*)(PX + (size_t)(b * T + pos) * INP + C_AV + kvh * 64 + dc * 8); }
            else w = *(const u32x4*)(PX + (size_t)(NX + b * CL + (key - 320)) * INP + C_AV + kvh * 64 + dc * 8);
            e[q][0] = w.x & 0xffff; e[q][1] = w.x >> 16; e[q][2] = w.y & 0xffff; e[q][3] = w.y >> 16; e[q][4] = w.z & 0xffff; e[q][5] = w.z >> 16; e[q][6] = w.w & 0xffff; e[q][7] = w.w >> 16;
        }
        const int tile = kg >> 3, kin = (kg & 7) * 4;
#pragma unroll
        for (int j = 0; j < 8; ++j) { u32x2 w; w.x = (unsigned)e[0][j] | ((unsigned)e[1][j] << 16); w.y = (unsigned)e[2][j] | ((unsigned)e[3][j] << 16);
            *(LDSP u32x2*)(lds + LA_VT + tile * 4608 + (dc * 8 + j) * 72 + kin * 2) = w; }
    }
    const int hq = kvh * 4 + (wid >> 1), qs = (wid & 1) * 32, r = lane & 31, hh = lane >> 5;
    const int qpos = q0 + qs + r;
    bf16x8 qf[4];
    {
        const bf16_t* src = PX + (size_t)(b * T + qpos) * INP + C_Q + hq * 64 + 8 * hh;
        u32x4 raw[4];
#pragma unroll
        for (int s = 0; s < 4; ++s) raw[s] = *(const u32x4*)(src + 16 * s);
#pragma unroll
        for (int pr = 0; pr < 2; ++pr) {
            const int ppos = pr == 0 ? (qpos >> 6) : (qpos & 63);
            const float2* tb = ROPE + ppos * 16 + 8 * hh;
            const unsigned a1[4] = {raw[2 * pr].x, raw[2 * pr].y, raw[2 * pr].z, raw[2 * pr].w}, a2[4] = {raw[2 * pr + 1].x, raw[2 * pr + 1].y, raw[2 * pr + 1].z, raw[2 * pr + 1].w};
            unsigned o1[4], o2[4];
#pragma unroll
            for (int j = 0; j < 4; ++j) {
                const float2 cs0 = tb[2 * j], cs1 = tb[2 * j + 1];
                const float u0 = bf2f(a1[j] & 0xffff), u1 = bf2f(a1[j] >> 16), v0 = bf2f(a2[j] & 0xffff), v1 = bf2f(a2[j] >> 16);
                o1[j] = pk2(0.125f * (u0 * cs0.x - v0 * cs0.y), 0.125f * (u1 * cs1.x - v1 * cs1.y));
                o2[j] = pk2(0.125f * (v0 * cs0.x + u0 * cs0.y), 0.125f * (v1 * cs1.x + u1 * cs1.y));
            }
            const u32x4 w1 = mk4u(o1[0], o1[1], o1[2], o1[3]), w2 = mk4u(o2[0], o2[1], o2[2], o2[3]);
            qf[2 * pr] = __builtin_bit_cast(bf16x8, w1); qf[2 * pr + 1] = __builtin_bit_cast(bf16x8, w2);
        }
    }
    __syncthreads();
    float m = p.attn_sink[hq], l = 1.f;
    f32x16 o0 = zero16(), o1 = zero16();
    for (int tl = 0; tl < 18; ++tl) {
        f32x16 st = zero16();
#pragma unroll
        for (int s = 0; s < 4; ++s) {
            const bf16x8 kf = *(const LDSP bf16x8*)(lds + LA_K + sw64(32 * tl + r, 16 * s + 8 * hh));
            st = __builtin_amdgcn_mfma_f32_32x32x16_bf16(kf, qf[s], st, 0, 0, 0);
        }
        if (tl < 10) {
#pragma unroll
            for (int g = 0; g < 16; ++g) { const int kp = q0 - 128 + 32 * tl + crow(g, hh); const int dlt = qpos - kp;
                const bool ok = (dlt <= 128) && (dlt >= -128) && (kp >= 0) && (kp < T); st[g] = ok ? st[g] : -1e30f; }
        }
        float mt = st[0];
#pragma unroll
        for (int g = 1; g < 16; ++g) mt = fmaxf(mt, st[g]);
        mt = fmaxf(mt, __shfl_xor(mt, 32));
        const float mn = fmaxf(m, mt), alpha = __expf(m - mn);
        float ps = 0.f;
#pragma unroll
        for (int g = 0; g < 16; ++g) { st[g] = __expf(st[g] - mn); ps += st[g]; }
        ps += __shfl_xor(ps, 32);
        l = l * alpha + ps; m = mn;
#pragma unroll
        for (int g = 0; g < 16; ++g) { o0[g] *= alpha; o1[g] *= alpha; }
#pragma unroll
        for (int s2 = 0; s2 < 2; ++s2) {
            const u32x4 pw = mk4u(pk2(st[8 * s2], st[8 * s2 + 1]), pk2(st[8 * s2 + 2], st[8 * s2 + 3]), pk2(st[8 * s2 + 4], st[8 * s2 + 5]), pk2(st[8 * s2 + 6], st[8 * s2 + 7]));
            const bf16x8 pf = __builtin_bit_cast(bf16x8, pw);
#pragma unroll
            for (int dm = 0; dm < 2; ++dm) {
                const LDSP unsigned char* vp = lds + LA_VT + tl * 4608 + (32 * dm + r) * 72 + (16 * s2 + 4 * hh) * 2;
                const u32x2 v0 = *(const LDSP u32x2*)vp, v1 = *(const LDSP u32x2*)(vp + 16);
                const bf16x8 vf = __builtin_bit_cast(bf16x8, mk4u(v0.x, v0.y, v1.x, v1.y));
                if (dm == 0) o0 = __builtin_amdgcn_mfma_f32_32x32x16_bf16(vf, pf, o0, 0, 0, 0); else o1 = __builtin_amdgcn_mfma_f32_32x32x16_bf16(vf, pf, o1, 0, 0, 0);
            }
        }
    }
    {
        const float inv = 1.f / l;
        bf16_t* dst = (bf16_t*)(p.ws + OFF_MIX) + (size_t)(b * T + qpos) * D + 1024 + hq * 64;
#pragma unroll
        for (int gq = 0; gq < 4; ++gq) {
            u32x2 w; w.x = pk2(o0[4 * gq] * inv, o0[4 * gq + 1] * inv); w.y = pk2(o0[4 * gq + 2] * inv, o0[4 * gq + 3] * inv); *(u32x2*)(dst + 8 * gq + 4 * hh) = w;
            u32x2 w2; w2.x = pk2(o1[4 * gq] * inv, o1[4 * gq + 1] * inv); w2.y = pk2(o1[4 * gq + 2] * inv, o1[4 * gq + 3] * inv); *(u32x2*)(dst + 32 + 8 * gq + 4 * hh) = w2;
        }
    }
    __syncthreads();
}

__device__ __forceinline__ void phaseR2(LDSP unsigned char* lds, const Params& p) {
    {
        pg8::Epi<FLORA> epi{FLORA{p.decay_bias, p.iclr_bias, (bf16_t*)(p.ws + OFF_LWG), (bf16_t*)(p.ws + OFF_AIG)}};
        LoraSched S{(const char*)(p.ws + OFF_TW), (const char*)(p.ws + OFF_WTDU), (const char*)(p.ws + OFF_XA), (const char*)(p.ws + OFF_WTIU), (int)gridDim.x, (int)blockIdx.x};
        pg8::gemm_phase<false>(lds, opaque_s(128), S, epi);
    }
    {
        pg8::Epi<FGG> epi{FGG{(bf16_t*)(p.ws + OFF_GG)}};
        pg8::DenseSched S{(const char*)(p.ws + OFF_SG), (const char*)(p.ws + OFF_WTGU), NX / 256, 1024 / 256, 256, (int)gridDim.x, (int)(gridDim.x - 1 - blockIdx.x)};
        pg8::gemm_phase<false>(lds, opaque_s(256), S, epi);
    }
    __syncthreads();
    for (int u = blockIdx.x; u < 512; u += gridDim.x) attn_unit(lds, p, u);
}

constexpr int G_RT = 0, G_VT = 8192, G_X0 = 16384, G_AT = 32768, G_BT = 40960, G_KT = 49152, G_P0 = 57344, G_PT0 = 65536, G_SEG = 73728, G_GL = 74752, G_CNT = 75008, G_BYTES = 79872;
static_assert(2 * G_BYTES <= SMEM_BYTES - 16, "two R3 groups fit the LDS");

__device__ __forceinline__ void gbar(LDSP unsigned* cnt, unsigned& target, int lane) {
    target += 4u;
    asm volatile("s_waitcnt lgkmcnt(0)" ::: "memory");
    if (lane == 0) {
        __hip_atomic_fetch_add(cnt, 1u, __ATOMIC_RELAXED, __HIP_MEMORY_SCOPE_WORKGROUP);
        while (__hip_atomic_load(cnt, __ATOMIC_RELAXED, __HIP_MEMORY_SCOPE_WORKGROUP) < target) __builtin_amdgcn_s_sleep(1);
    }
    asm volatile("" ::: "memory");
}
__device__ __forceinline__ void mask_lt(f32x16& c, int x0, int y, int hh, bool incl) {
#pragma unroll
    for (int g = 0; g < 16; ++g) { const int x = x0 + crow(g, hh); c[g] = (incl ? (x <= y) : (x < y)) ? c[g] : 0.f; }
}

#if defined(__HIP_DEVICE_COMPILE__)
#define LDS_AT(T, addr) (__builtin_bit_cast(LDSP T*, (unsigned)(addr)))
#define LDS_ADDR(ptr) (__builtin_bit_cast(unsigned, (ptr)))
#else
#define LDS_AT(T, addr) ((LDSP T*)(size_t)(addr))
#define LDS_ADDR(ptr) ((unsigned)(size_t)(ptr))
#endif
__device__ __forceinline__ void ldf(const unsigned (&FO)[4], unsigned off, bf16x8 (&f)[4]) {
#pragma unroll
    for (int s = 0; s < 4; ++s) f[s] = *LDS_AT(const bf16x8, FO[s] + off);
}
__device__ __forceinline__ void stt(const unsigned (&SO)[4], unsigned off, int xh, const f32x16& acc) {
#pragma unroll
    for (int gq = 0; gq < 4; ++gq) *LDS_AT(u32x2, (SO[gq] ^ ((unsigned)xh << 6)) + off) = mk2u(pk2(acc[4 * gq], acc[4 * gq + 1]), pk2(acc[4 * gq + 2], acc[4 * gq + 3]));
}
__device__ __forceinline__ u32x2 ld8(const unsigned (&SO)[4], int gq, unsigned off, int xh) { return *LDS_AT(const u32x2, (SO[gq] ^ ((unsigned)xh << 6)) + off); }

__device__ __forceinline__ void rwkv_prep_group(LDSP unsigned char* lg, LDSP unsigned* cnt, unsigned& bt, const Params& p, int unit, int wg_in, int lane_in, const unsigned (&FO)[4], const unsigned (&SO)[4]) {
    int seq, c, h, d;
    if (unit < 4096) { seq = unit >> 11; c = (unit >> 5) & 63; h = (unit >> 1) & 15; d = unit & 1; } else { const int u = unit - 4096; seq = 2 + (u >> 7); c = (u >> 5) & 3; h = (u >> 1) & 15; d = u & 1; }
    const bool isx = seq < 2;
    const int b = seq & 1;
    const int s0 = isx ? b * T : NX + b * CL, t0 = c * 64;
    const int chunk_id = isx ? 4 + c : c;
    u32x4 keep_bh[2], keep_kh[2];
#define STAGE_IDS const int lane = opaque(lane_in), wg = opaque(wg_in), r = lane & 31, hh = lane >> 5; (void)r; (void)hh; (void)wg;
    {
        STAGE_IDS
        const int k = lane, seg = wg, hk = h * 64 + k;
        const float kac = p.k_a[hk];
        const bf16_t* RS = (const bf16_t*)(p.ws + OFF_RS); const bf16_t* KS = (const bf16_t*)(p.ws + OFF_KS); const bf16_t* KKp = (const bf16_t*)(p.ws + OFF_KK); const bf16_t* VS = (const bf16_t*)(p.ws + OFF_VS);
        const bf16_t* LWG = (const bf16_t*)(p.ws + OFF_LWG); const bf16_t* AIG = (const bf16_t*)(p.ws + OFF_AIG);
        const int ibase = seg * 16;
        const size_t rowA = (size_t)(s0 + t0) + (d ? 63 - ibase : ibase);
        float lw[16];
        float run = 0.f;
#pragma unroll
        for (int tt = 0; tt < 16; ++tt) { const size_t row = d ? rowA - tt : rowA + tt; run += bf2f(LWG[row * 2048 + d * 1024 + hk]); lw[tt] = run; }
        LDSP float* SEG = (LDSP float*)(lg + G_SEG);
        SEG[seg * 64 + k] = run;
        gbar(cnt, bt, lane);
        float off = 0.f, gL = 0.f;
#pragma unroll
        for (int s = 0; s < 4; ++s) { const float sv = SEG[s * 64 + k]; if (s < seg) off += sv; gL += sv; }
        if (seg == 0) ((LDSP float*)(lg + G_GL))[k] = gL;
        const float egL = __expf(gL);
#pragma unroll
        for (int q = 0; q < 2; ++q) {
            float rr[8], kr[8], kk[8], vv[8], ai[8];
#pragma unroll
            for (int e = 0; e < 8; ++e) { const int tt = 8 * q + e; const size_t row = d ? rowA - tt : rowA + tt;
                rr[e] = bf2f(RS[row * 1024 + hk]); kr[e] = bf2f(KS[row * 1024 + hk]); kk[e] = bf2f(KKp[row * 1024 + hk]); vv[e] = bf2f(VS[row * 1024 + hk]); ai[e] = bf2f(AIG[row * 2048 + d * 1024 + hk]); }
            unsigned wat[4], wbh[4], wkh[4], wv[4];
#pragma unroll
            for (int t2 = 0; t2 < 4; ++t2) {
                const int i0 = ibase + 8 * q + 2 * t2;
                float fat[2], frt[2], fbt[2], fkt[2], fbh[2], fkh[2];
#pragma unroll
                for (int e2 = 0; e2 < 2; ++e2) { const int e = 2 * t2 + e2, tt = 8 * q + e;
                    const float kd = kr[e] * (1.f + (ai[e] - 1.f) * kac), bbv = kk[e] * ai[e];
                    const float g = off + lw[tt], ge = (tt == 0) ? off : off + lw[tt - 1];
                    const float eg = __expf(g), ege = __expf(ge), eng = __builtin_amdgcn_rcpf(eg), egl = egL * eng;
                    fat[e2] = -kk[e] * ege; frt[e2] = rr[e] * eg; fbt[e2] = bbv * eng; fkt[e2] = kd * eng; fbh[e2] = bbv * egl; fkh[e2] = kd * egl; }
                wat[t2] = pk2(fat[0], fat[1]); wbh[t2] = pk2(fbh[0], fbh[1]); wkh[t2] = pk2(fkh[0], fkh[1]); wv[t2] = pk2(vv[2 * t2], vv[2 * t2 + 1]);
                const unsigned wr = pk2(frt[0], frt[1]), wb = pk2(fbt[0], fbt[1]), wk = pk2(fkt[0], fkt[1]);
                *(LDSP bf16_t*)(lg + G_AT + sw64(i0, k)) = (bf16_t)(wat[t2] & 0xffffu); *(LDSP bf16_t*)(lg + G_AT + sw64(i0 + 1, k)) = (bf16_t)(wat[t2] >> 16);
                *(LDSP bf16_t*)(lg + G_RT + sw64(i0, k)) = (bf16_t)(wr & 0xffffu);      *(LDSP bf16_t*)(lg + G_RT + sw64(i0 + 1, k)) = (bf16_t)(wr >> 16);
                *(LDSP bf16_t*)(lg + G_BT + sw64(i0, k)) = (bf16_t)(wb & 0xffffu);      *(LDSP bf16_t*)(lg + G_BT + sw64(i0 + 1, k)) = (bf16_t)(wb >> 16);
                *(LDSP bf16_t*)(lg + G_KT + sw64(i0, k)) = (bf16_t)(wk & 0xffffu);      *(LDSP bf16_t*)(lg + G_KT + sw64(i0 + 1, k)) = (bf16_t)(wk >> 16);
            }
            *(LDSP u32x4*)(lg + G_X0 + sw64(k, ibase + 8 * q)) = mk4u(wat[0], wat[1], wat[2], wat[3]);
            *(LDSP u32x4*)(lg + G_VT + sw64(k, ibase + 8 * q)) = mk4u(wv[0], wv[1], wv[2], wv[3]);
            keep_bh[q] = mk4u(wbh[0], wbh[1], wbh[2], wbh[3]); keep_kh[q] = mk4u(wkh[0], wkh[1], wkh[2], wkh[3]);
            __builtin_amdgcn_sched_barrier(0);
        }
    }
    gbar(cnt, bt, lane_in);
    {
        STAGE_IDS
        const int a = wg >> 1, bq = wg & 1;
        f32x16 c1 = zero16(), c2 = zero16();
        if (a <= bq) {
            bf16x8 fB[4], fA[4]; ldf(FO, G_BT + 4096 * a, fB); ldf(FO, G_AT + 4096 * bq, fA);
#pragma unroll
            for (int t = 0; t < 4; ++t) { c1 = __builtin_amdgcn_mfma_f32_32x32x16_bf16(fB[t], fA[t], c1, 0, 0, 0); c2 = __builtin_amdgcn_mfma_f32_32x32x16_bf16(fA[t], fB[t], c2, 0, 0, 0); }
            mask_lt(c1, 32 * a, 32 * bq + r, hh, false);
#pragma unroll
            for (int g = 0; g < 16; ++g) { const int x = 32 * bq + crow(g, hh); c2[g] = (32 * a + r < x) ? c2[g] : 0.f; }
        }
        stt(SO, G_P0 + 4096 * bq, a, c1);
        stt(SO, G_PT0 + 4096 * a, bq, c2);
        const int ib = wg >> 1, vb = wg & 1;
        f32x16 z = zero16();
#pragma unroll
        for (int jb = 0; jb < 2; ++jb) if (jb <= ib) {
            bf16x8 fK[4], fA[4]; ldf(FO, G_KT + 4096 * jb, fK); ldf(FO, G_AT + 4096 * ib, fA);
            f32x16 t = zero16();
#pragma unroll
            for (int s = 0; s < 4; ++s) t = __builtin_amdgcn_mfma_f32_32x32x16_bf16(fK[s], fA[s], t, 0, 0, 0);
            mask_lt(t, 32 * jb, 32 * ib + r, hh, false);
#pragma unroll
            for (int s2 = 0; s2 < 2; ++s2) {
                const bf16x8 af = __builtin_bit_cast(bf16x8, mk4u(pk2(t[8 * s2], t[8 * s2 + 1]), pk2(t[8 * s2 + 2], t[8 * s2 + 3]), pk2(t[8 * s2 + 4], t[8 * s2 + 5]), pk2(t[8 * s2 + 6], t[8 * s2 + 7])));
                const u32x2 v0 = ld8(SO, 2 * s2, G_VT + 4096 * vb, jb), v1 = ld8(SO, 2 * s2 + 1, G_VT + 4096 * vb, jb);
                const bf16x8 bv = __builtin_bit_cast(bf16x8, mk4u(v0.x, v0.y, v1.x, v1.y));
                z = __builtin_amdgcn_mfma_f32_32x32x16_bf16(af, bv, z, 0, 0, 0);
            }
        }
        stt(SO, G_X0 + 128 * 64 + 4096 * vb, ib, z);
    }
    gbar(cnt, bt, lane_in);
#pragma unroll 1
    for (int s = 0; s < 6; ++s) {
        STAGE_IDS
        const int cb = wg, a = wg >> 1, bq = wg & 1;
        bf16x8 xf[4], p0[4], p1[4];
        ldf(FO, G_X0 + 4096 * cb, xf); ldf(FO, G_P0, p0); ldf(FO, G_P0 + 4096, p1);
        f32x16 acc0, acc1;
#pragma unroll
        for (int gq = 0; gq < 4; ++gq) { const u32x2 w0 = ld8(SO, gq, G_X0 + 4096 * cb, 0), w1 = ld8(SO, gq, G_X0 + 4096 * cb, 1);
            acc0[4 * gq] = bf2f(w0.x & 0xffff); acc0[4 * gq + 1] = bf2f(w0.x >> 16); acc0[4 * gq + 2] = bf2f(w0.y & 0xffff); acc0[4 * gq + 3] = bf2f(w0.y >> 16);
            acc1[4 * gq] = bf2f(w1.x & 0xffff); acc1[4 * gq + 1] = bf2f(w1.x >> 16); acc1[4 * gq + 2] = bf2f(w1.y & 0xffff); acc1[4 * gq + 3] = bf2f(w1.y >> 16); }
        f32x16 z = zero16(), zt = zero16();
        const bool sq = (s < 5) && (a <= bq);
        bf16x8 fa[4], fb[4];
        if (sq) { ldf(FO, G_PT0 + 4096 * a, fa); ldf(FO, G_P0 + 4096 * bq, fb); }
#pragma unroll
        for (int t = 0; t < 4; ++t) { if (t < 2) acc0 = __builtin_amdgcn_mfma_f32_32x32x16_bf16(p0[t], xf[t], acc0, 0, 0, 0); acc1 = __builtin_amdgcn_mfma_f32_32x32x16_bf16(p1[t], xf[t], acc1, 0, 0, 0); }
        if (sq) { const int t0 = (a == 1) ? 2 : 0, t1 = (bq == 0) ? 2 : 4;
#pragma unroll
            for (int t = 0; t < 4; ++t) if (t >= t0 && t < t1) { z = __builtin_amdgcn_mfma_f32_32x32x16_bf16(fa[t], fb[t], z, 0, 0, 0); zt = __builtin_amdgcn_mfma_f32_32x32x16_bf16(fb[t], fa[t], zt, 0, 0, 0); } }
        stt(SO, G_X0 + 4096 * cb, 0, acc0); stt(SO, G_X0 + 4096 * cb, 1, acc1);
        if (s < 5) {
            gbar(cnt, bt, lane);
            stt(SO, G_P0 + 4096 * bq, a, z); stt(SO, G_PT0 + 4096 * a, bq, zt);
        }
        gbar(cnt, bt, lane);
    }
    {
        STAGE_IDS
        const int jb = wg >> 1, ib = wg & 1;
        f32x16 c1 = zero16(), c2 = zero16();
        if (jb <= ib) {
            bf16x8 fR[4], fB[4], fK[4]; ldf(FO, G_RT + 4096 * ib, fR); ldf(FO, G_BT + 4096 * jb, fB); ldf(FO, G_KT + 4096 * jb, fK);
#pragma unroll
            for (int t = 0; t < 4; ++t) { c1 = __builtin_amdgcn_mfma_f32_32x32x16_bf16(fB[t], fR[t], c1, 0, 0, 0); c2 = __builtin_amdgcn_mfma_f32_32x32x16_bf16(fK[t], fR[t], c2, 0, 0, 0); }
            mask_lt(c1, 32 * jb, 32 * ib + r, hh, true); mask_lt(c2, 32 * jb, 32 * ib + r, hh, true);
        }
        stt(SO, G_P0 + 4096 * ib, jb, c1); stt(SO, G_PT0 + 4096 * ib, jb, c2);
    }
    gbar(cnt, bt, lane_in);
    {
        STAGE_IDS
#pragma unroll
        for (int q = 0; q < 2; ++q) { *(LDSP u32x4*)(lg + G_BT + sw64(lane, wg * 16 + 8 * q)) = keep_bh[q]; *(LDSP u32x4*)(lg + G_KT + sw64(lane, wg * 16 + 8 * q)) = keep_kh[q]; }
    }
    gbar(cnt, bt, lane_in);
    {
        STAGE_IDS
        const int mi = wg;
        const int L_BH = G_BT, L_KH = G_KT, L_RB = G_P0, L_RK = G_PT0;
        const size_t inst = (size_t)inst_index(b, h, d, chunk_id) * 4096;
        bf16_t* dst = (bf16_t*)(p.ws + (mi == 0 ? OFF_CM : mi == 1 ? OFF_CN : mi == 2 ? OFF_CP : OFF_CQ)) + inst;
        if (isx || mi < 2) {
            const int Ax = (mi == 1) ? L_BH : G_X0, Ax0 = (mi == 3) ? 64 : 0;
            const int By = (mi == 0) ? L_BH : (mi == 1) ? G_X0 : L_RB, By0 = (mi == 1) ? 64 : 0;
            const int A2 = (mi == 1) ? L_KH : G_VT, B2 = (mi == 1) ? G_VT : L_RK;
#pragma unroll 1
            for (int half = 0; half < 2; ++half) {
                bf16x8 a0[4], a1[4], b1[4];
                ldf(FO, Ax + 128 * Ax0, a0); ldf(FO, Ax + 128 * (Ax0 + 32), a1); ldf(FO, By + 128 * (By0 + 32 * half), b1);
                f32x16 c0 = zero16(), c1 = zero16();
#pragma unroll
                for (int t = 0; t < 4; ++t) { c0 = __builtin_amdgcn_mfma_f32_32x32x16_bf16(a0[t], b1[t], c0, 0, 0, 0); c1 = __builtin_amdgcn_mfma_f32_32x32x16_bf16(a1[t], b1[t], c1, 0, 0, 0); }
                if (mi & 1) {
                    ldf(FO, A2, a0); ldf(FO, A2 + 4096, a1); ldf(FO, B2 + 4096 * half, b1);
#pragma unroll
                    for (int t = 0; t < 4; ++t) { c0 = __builtin_amdgcn_mfma_f32_32x32x16_bf16(a0[t], b1[t], c0, 0, 0, 0); c1 = __builtin_amdgcn_mfma_f32_32x32x16_bf16(a1[t], b1[t], c1, 0, 0, 0); }
                }
                const int y = 32 * half + r;
                const float dg = (mi == 0) ? __expf(((const LDSP float*)(lg + G_GL))[y]) : 0.f;
#pragma unroll
                for (int xb = 0; xb < 2; ++xb) {
#pragma unroll
                    for (int gq = 0; gq < 4; ++gq) {
                        const int x0 = 32 * xb + 8 * gq + 4 * hh;
                        float v0 = xb ? c1[4 * gq] : c0[4 * gq], v1 = xb ? c1[4 * gq + 1] : c0[4 * gq + 1], v2 = xb ? c1[4 * gq + 2] : c0[4 * gq + 2], v3 = xb ? c1[4 * gq + 3] : c0[4 * gq + 3];
                        if (mi == 0) { if (x0 == y) v0 += dg; if (x0 + 1 == y) v1 += dg; if (x0 + 2 == y) v2 += dg; if (x0 + 3 == y) v3 += dg; }
                        if (mi == 2) { const u32x2 w = ld8(SO, gq, G_RT + 4096 * half, xb); v0 += bf2f(w.x & 0xffff); v1 += bf2f(w.x >> 16); v2 += bf2f(w.y & 0xffff); v3 += bf2f(w.y >> 16); }
                        *(u32x2*)(dst + ((half * 4 + 2 * xb + (gq >> 1)) * 64 + hh * 32 + r) * 8 + 4 * (gq & 1)) = mk2u(pk2(v0, v1), pk2(v2, v3));
                    }
                }
            }
        }
    }
    gbar(cnt, bt, lane_in);
#undef STAGE_IDS
}

__device__ __forceinline__ void phaseR3(LDSP unsigned char* lds, const Params& p) {
    const int tid = opaque(threadIdx.x), wid = tid >> 6, lane = tid & 63, gp = wid >> 2, wg = wid & 3;
    LDSP unsigned char* lg = lds + gp * G_BYTES;
    LDSP unsigned* cnt = (LDSP unsigned*)(lg + G_CNT);
    if ((tid & 255) == 0) *cnt = 0u;
    __syncthreads();
    unsigned bt = 0u;
    unsigned FO[4], SO[4];
    { const unsigned base = LDS_ADDR(lg), r = lane & 31, hh = lane >> 5;
#pragma unroll
      for (int q = 0; q < 4; ++q) { FO[q] = base + r * 128u + ((((2u * q + hh) ^ (r >> 1)) & 7u) << 4); SO[q] = base + r * 128u + ((((unsigned)q ^ (r >> 1)) & 7u) << 4) + 8u * hh; } }
    for (int u = blockIdx.x * 2 + gp; u < 4096 + 256; u += gridDim.x * 2) rwkv_prep_group(lg, cnt, bt, p, u, wg, lane, FO, SO);
    __syncthreads();
}

constexpr size_t OFF_HT = OFF_YD;
__device__ __forceinline__ void scan_wave(const Params& p, int item, int lane) {
    const int chain = item >> 1, vb = item & 1, b = chain >> 5, h = (chain >> 1) & 15, d = chain & 1;
    const bf16_t* CM = (const bf16_t*)(p.ws + OFF_CM); const bf16_t* CN = (const bf16_t*)(p.ws + OFF_CN); bf16_t* HT = (bf16_t*)(p.ws + OFF_HT);
    u32x4 na[2][4], nn[2][2];
    auto chunk_of = [&](int step) { return (step < 4) ? (d ? 3 - step : step) : (d ? 4 + (67 - step) : step); };
    auto prefetch = [&](int step) {
        const size_t inst = (size_t)inst_index(b, h, d, chunk_of(step)) * 4096;
#pragma unroll
        for (int rt = 0; rt < 2; ++rt) {
#pragma unroll
            for (int s = 0; s < 4; ++s) na[rt][s] = *(const u32x4*)(CM + inst + ((rt * 4 + s) * 64 + lane) * 8);
#pragma unroll
            for (int g2 = 0; g2 < 2; ++g2) nn[rt][g2] = *(const u32x4*)(CN + inst + (((vb * 2 + rt) * 2 + g2) * 64 + lane) * 8);
        }
    };
    f32x16 hacc[2]; hacc[0] = zero16(); hacc[1] = zero16();
    prefetch(0);
#pragma unroll 1
    for (int step = 0; step < NCHUNK; ++step) {
        const int chunk_id = chunk_of(step);
        u32x4 a[2][4], n[2][2];
#pragma unroll
        for (int rt = 0; rt < 2; ++rt) {
#pragma unroll
            for (int s = 0; s < 4; ++s) a[rt][s] = na[rt][s];
            n[rt][0] = nn[rt][0]; n[rt][1] = nn[rt][1];
        }
        if (step + 1 < NCHUNK) prefetch(step + 1);
        bf16x8 bfr[4];
#pragma unroll
        for (int s = 0; s < 4; ++s) { const f32x16& t = hacc[s >> 1]; const int o = 8 * (s & 1);
            bfr[s] = __builtin_bit_cast(bf16x8, mk4u(pk2(t[o], t[o + 1]), pk2(t[o + 2], t[o + 3]), pk2(t[o + 4], t[o + 5]), pk2(t[o + 6], t[o + 7]))); }
        if (chunk_id >= 4) {
            bf16_t* hp = HT + (size_t)inst_index(b, h, d, chunk_id) * 4096 + (vb * 4 * 64 + lane) * 8;
#pragma unroll
            for (int s = 0; s < 4; ++s) *(bf16x8*)(hp + s * 512) = bfr[s];
        }
#pragma unroll
        for (int rt = 0; rt < 2; ++rt) {
            f32x16 acc;
#pragma unroll
            for (int g2 = 0; g2 < 2; ++g2) { const u32x4 w = n[rt][g2];
                acc[8 * g2] = bf2f(w.x & 0xffff); acc[8 * g2 + 1] = bf2f(w.x >> 16); acc[8 * g2 + 2] = bf2f(w.y & 0xffff); acc[8 * g2 + 3] = bf2f(w.y >> 16);
                acc[8 * g2 + 4] = bf2f(w.z & 0xffff); acc[8 * g2 + 5] = bf2f(w.z >> 16); acc[8 * g2 + 6] = bf2f(w.w & 0xffff); acc[8 * g2 + 7] = bf2f(w.w >> 16); }
#pragma unroll
            for (int s = 0; s < 4; ++s) acc = __builtin_amdgcn_mfma_f32_32x32x16_bf16(__builtin_bit_cast(bf16x8, a[rt][s]), bfr[s], acc, 0, 0, 0);
            hacc[rt] = acc;
        }
    }
}
__device__ __forceinline__ void phaseR4(LDSP unsigned char* lds, const Params& p) {
    const int tid = opaque(threadIdx.x), wid = tid >> 6, lane = tid & 63;
    if (wid == 0) for (int it = blockIdx.x; it < 128; it += gridDim.x) scan_wave(p, it, lane);
}

__device__ __forceinline__ void phaseR5(LDSP unsigned char* lds, const Params& p) {
    const int tid = opaque(threadIdx.x), wid = tid >> 6, lane = tid & 63, r = lane & 31, hh = lane >> 5;
    const bf16_t* CP = (const bf16_t*)(p.ws + OFF_CP); const bf16_t* CQ = (const bf16_t*)(p.ws + OFF_CQ); const bf16_t* HT = (const bf16_t*)(p.ws + OFF_HT);
    for (int wu = blockIdx.x * 8 + wid; wu < 2 * 64 * 16 * 2; wu += gridDim.x * 8) {
        const int half = wu & 1, u = wu >> 1, b = u >> 10, c = (u >> 4) & 63, h = u & 15;
        f32x16 y0 = zero16(), y1 = zero16();
#pragma unroll
        for (int d = 0; d < 2; ++d) {
            const size_t inst = (size_t)inst_index(b, h, d, 4 + c) * 4096;
            const int ii = d ? 63 - (32 * half + r) : (32 * half + r);
            const int it = ii >> 5, lp = hh * 32 + (ii & 31);
            f32x16 a0, a1;
#pragma unroll
            for (int g2 = 0; g2 < 2; ++g2) {
                const u32x4 w0 = *(const u32x4*)(CQ + inst + (((it * 2 + 0) * 2 + g2) * 64 + lp) * 8), w1 = *(const u32x4*)(CQ + inst + (((it * 2 + 1) * 2 + g2) * 64 + lp) * 8);
                a0[8 * g2] = bf2f(w0.x & 0xffff); a0[8 * g2 + 1] = bf2f(w0.x >> 16); a0[8 * g2 + 2] = bf2f(w0.y & 0xffff); a0[8 * g2 + 3] = bf2f(w0.y >> 16);
                a0[8 * g2 + 4] = bf2f(w0.z & 0xffff); a0[8 * g2 + 5] = bf2f(w0.z >> 16); a0[8 * g2 + 6] = bf2f(w0.w & 0xffff); a0[8 * g2 + 7] = bf2f(w0.w >> 16);
                a1[8 * g2] = bf2f(w1.x & 0xffff); a1[8 * g2 + 1] = bf2f(w1.x >> 16); a1[8 * g2 + 2] = bf2f(w1.y & 0xffff); a1[8 * g2 + 3] = bf2f(w1.y >> 16);
                a1[8 * g2 + 4] = bf2f(w1.z & 0xffff); a1[8 * g2 + 5] = bf2f(w1.z >> 16); a1[8 * g2 + 6] = bf2f(w1.w & 0xffff); a1[8 * g2 + 7] = bf2f(w1.w >> 16);
            }
#pragma unroll
            for (int s = 0; s < 4; ++s) {
                const bf16x8 pf = *(const bf16x8*)(CP + inst + ((it * 4 + s) * 64 + lp) * 8);
                const bf16x8 h0 = *(const bf16x8*)(HT + inst + ((0 * 4 + s) * 64 + lane) * 8), h1 = *(const bf16x8*)(HT + inst + ((1 * 4 + s) * 64 + lane) * 8);
                a0 = __builtin_amdgcn_mfma_f32_32x32x16_bf16(h0, pf, a0, 0, 0, 0);
                a1 = __builtin_amdgcn_mfma_f32_32x32x16_bf16(h1, pf, a1, 0, 0, 0);
            }
#pragma unroll
            for (int g = 0; g < 16; ++g) { y0[g] += a0[g]; y1[g] += a1[g]; }
        }
        const int tau = 32 * half + r; const size_t row = (size_t)b * T + c * 64 + tau;
        float sm = 0.f;
#pragma unroll
        for (int g = 0; g < 16; ++g) sm += y0[g] + y1[g];
        sm += __shfl_xor(sm, 32);
        const float mean = sm * (1.f / 64.f);
        float q2 = 0.f;
#pragma unroll
        for (int g = 0; g < 16; ++g) { y0[g] -= mean; y1[g] -= mean; q2 += y0[g] * y0[g] + y1[g] * y1[g]; }
        q2 += __shfl_xor(q2, 32);
        const float rstd = rsqrtf(q2 * (1.f / 64.f) + 64e-5f);
        const bf16_t* rs = (const bf16_t*)(p.ws + OFF_RS) + row * 1024 + h * 64; const bf16_t* ks = (const bf16_t*)(p.ws + OFF_KS) + row * 1024 + h * 64;
        const bf16_t* ai0 = (const bf16_t*)(p.ws + OFF_AIG) + row * 2048 + h * 64; const bf16_t* ai1 = ai0 + 1024;
        const bf16_t* vs = (const bf16_t*)(p.ws + OFF_VS) + row * 1024 + h * 64; const bf16_t* gg = (const bf16_t*)(p.ws + OFF_GG) + row * 1024 + h * 64;
        float bon = 0.f;
#pragma unroll
        for (int q = 0; q < 8; ++q) {
            const int ch = 32 * (q >> 2) + 8 * (q & 3) + 4 * hh;
            const u32x2 r2 = *(const u32x2*)(rs + ch), k2 = *(const u32x2*)(ks + ch), x2 = *(const u32x2*)(ai0 + ch), z2 = *(const u32x2*)(ai1 + ch);
            const f32x4 ka = *(const f32x4*)(p.k_a + h * 64 + ch), rk = *(const f32x4*)(p.r_k + h * 64 + ch);
            const float rr[4] = {bf2f(r2.x & 0xffff), bf2f(r2.x >> 16), bf2f(r2.y & 0xffff), bf2f(r2.y >> 16)}, kk[4] = {bf2f(k2.x & 0xffff), bf2f(k2.x >> 16), bf2f(k2.y & 0xffff), bf2f(k2.y >> 16)};
            const float xa[4] = {bf2f(x2.x & 0xffff), bf2f(x2.x >> 16), bf2f(x2.y & 0xffff), bf2f(x2.y >> 16)}, za[4] = {bf2f(z2.x & 0xffff), bf2f(z2.x >> 16), bf2f(z2.y & 0xffff), bf2f(z2.y >> 16)};
#pragma unroll
            for (int e = 0; e < 4; ++e) bon += rr[e] * (kk[e] * ((1.f + (xa[e] - 1.f) * ka[e]) + (1.f + (za[e] - 1.f) * ka[e]))) * rk[e];
        }
        bon += __shfl_xor(bon, 32);
        bf16_t* dst = (bf16_t*)(p.ws + OFF_MIX) + row * D + h * 64;
#pragma unroll
        for (int q = 0; q < 8; ++q) {
            const int ch = 32 * (q >> 2) + 8 * (q & 3) + 4 * hh, g0 = 4 * (q & 3);
            const f32x4 lg = *(const f32x4*)(p.lnx_g + h * 64 + ch), lb = *(const f32x4*)(p.lnx_b + h * 64 + ch);
            const u32x2 v2 = *(const u32x2*)(vs + ch), g2 = *(const u32x2*)(gg + ch);
            const float vv[4] = {bf2f(v2.x & 0xffff), bf2f(v2.x >> 16), bf2f(v2.y & 0xffff), bf2f(v2.y >> 16)}, gv[4] = {bf2f(g2.x & 0xffff), bf2f(g2.x >> 16), bf2f(g2.y & 0xffff), bf2f(g2.y >> 16)};
            float o[4];
#pragma unroll
            for (int e = 0; e < 4; ++e) { const float yv = (q < 4) ? y0[g0 + e] : y1[g0 + e]; o[e] = (yv * rstd * lg[e] + lb[e] + bon * vv[e]) * gv[e]; }
            *(u32x2*)(dst + ch) = mk2u(pk2(o[0], o[1]), pk2(o[2], o[3]));
        }
    }
}

__device__ __forceinline__ void phase6(LDSP unsigned char* lds, const Params& p) {
    pg8::Epi<FX1> epi{FX1{p.x, (const float*)(p.ws + OFF_MOD), (float*)(p.ws + OFF_X1)}};
    pg8::DenseSched S{(const char*)(p.ws + OFF_MIX), (const char*)(p.ws + OFF_WTOUT), NX / 256, D / 256, D, (int)gridDim.x, (int)blockIdx.x};
    pg8::gemm_phase<false>(lds, D, S, epi);
}

__device__ __forceinline__ void phase7(LDSP unsigned char* lds, const Params& p) {
    const int tid = opaque(threadIdx.x), wid = tid >> 6, lane = tid & 63;
    LDSP float* GS = (LDSP float*)lds;
    LDSP float* RSTD = (LDSP float*)(lds + 16384);
    LDSP float* PART = (LDSP float*)(lds + 16896);
    LDSP float* CB = (LDSP float*)(lds + 16896 + 65536);
    const float* MOD = (const float*)(p.ws + OFF_MOD);
    const float* X1 = (const float*)(p.ws + OFF_X1);
    bf16_t* H2 = (bf16_t*)(p.ws + OFF_H2);
    int* CNT = (int*)(p.ws + OFF_CTL + 16384);
    for (int u = blockIdx.x; u < NX / 32; u += gridDim.x) {
        const float* md = MOD + (size_t)((u * 32) >> 12) * 12288;
        for (int idx = tid; idx < D / 4; idx += 512) { const f32x4 g = *(const f32x4*)(p.norm2_g + 4 * idx), sh = *(const f32x4*)(md + 3 * D + 4 * idx), sc = *(const f32x4*)(md + 4 * D + 4 * idx);
            *(LDSP f32x4*)(GS + 4 * idx) = g * (sc + 1.f); *(LDSP f32x4*)(GS + D + 4 * idx) = sh; }
        __syncthreads();
#pragma unroll 1
        for (int rr = 0; rr < 4; ++rr) {
            const int t = 4 * wid + rr, row = u * 32 + t; const float* src = X1 + (size_t)row * D;
            f32x4 xv[8]; float ss = 0.f;
#pragma unroll
            for (int i = 0; i < 8; ++i) { xv[i] = ((const f32x4*)src)[lane + 64 * i]; ss += xv[i].x * xv[i].x + xv[i].y * xv[i].y + xv[i].z * xv[i].z + xv[i].w * xv[i].w; }
            ss = wave_sum(ss); const float rs = rsqrtf(ss * (1.f / D) + 1e-6f);
            if (lane == 0) RSTD[t] = rs;
#pragma unroll
            for (int i = 0; i < 8; ++i) { const int col = 4 * (lane + 64 * i);
                const f32x4 g = *(const LDSP f32x4*)(GS + col), sh = *(const LDSP f32x4*)(GS + D + col);
                const f32x4 hv = xv[i] * rs * g + sh;
                *(u32x2*)(H2 + (size_t)row * D + col) = mk2u(pk2(hv.x, hv.y), pk2(hv.z, hv.w)); }
        }
        {
            const int j = lane & 31, kk = lane >> 5, k0 = wid * 256;
            unsigned xoff = (unsigned)((u * 32 + j) * D + k0 + 4 * kk) * 4u;
            unsigned woff = (unsigned)((k0 + 4 * kk) * 64 + j) * 4u;
            unsigned goff = (unsigned)(k0 + 4 * kk) * 4u;
            f32x16 acc0 = zero16(), acc1 = zero16(); float c0 = 0.f, c1 = 0.f;
#pragma unroll 2
            for (int q = 0; q < 32; ++q) {
                const f32x4 xa = *(const f32x4*)((const char*)X1 + xoff);
                const f32x4 gv = *(const LDSP f32x4*)((const LDSP char*)GS + goff), sv = *(const LDSP f32x4*)((const LDSP char*)GS + D * 4 + goff);
                float b0[4], b1[4];
#pragma unroll
                for (int e = 0; e < 4; ++e) { b0[e] = *(const float*)((const char*)p.w_router + woff + e * 256); b1[e] = *(const float*)((const char*)p.w_router + woff + e * 256 + 128); }
#pragma unroll
                for (int e = 0; e < 4; ++e) {
                    acc0 = __builtin_amdgcn_mfma_f32_32x32x2f32(xa[e], b0[e] * gv[e], acc0, 0, 0, 0);
                    acc1 = __builtin_amdgcn_mfma_f32_32x32x2f32(xa[e], b1[e] * gv[e], acc1, 0, 0, 0);
                    c0 += sv[e] * b0[e]; c1 += sv[e] * b1[e];
                }
                xoff += 32u; woff += 2048u; goff += 32u;
            }
            c0 += __shfl_xor(c0, 32); c1 += __shfl_xor(c1, 32);
#pragma unroll
            for (int g = 0; g < 16; ++g) { const int t = crow(g, kk); PART[(wid * 32 + t) * 64 + j] = acc0[g]; PART[(wid * 32 + t) * 64 + 32 + j] = acc1[g]; }
            if (kk == 0) { CB[wid * 64 + j] = c0; CB[wid * 64 + 32 + j] = c1; }
        }
        __syncthreads();
        float cb = 0.f;
#pragma unroll
        for (int w = 0; w < 8; ++w) cb += CB[w * 64 + lane];
        const float eb = p.expert_bias[lane];
#pragma unroll 1
        for (int rr = 0; rr < 4; ++rr) {
            const int t = 4 * wid + rr, token = u * 32 + t;
            float sum = 0.f;
#pragma unroll
            for (int w = 0; w < 8; ++w) sum += PART[(w * 32 + t) * 64 + lane];
            const float logit = RSTD[t] * sum + cb;
            const float score = 1.f / (1.f + expf(-logit));
            const float v = score + eb;
            const int gi = lane >> 3;
            float m1 = v;
            m1 = fmaxf(m1, __shfl_xor(m1, 1)); m1 = fmaxf(m1, __shfl_xor(m1, 2)); m1 = fmaxf(m1, __shfl_xor(m1, 4));
            const unsigned long long eq = __ballot(v == m1);
            const unsigned gbits = (unsigned)((eq >> (gi * 8)) & 0xffull);
            const bool first = (lane & 7) == (__ffs((int)gbits) - 1);
            float v2 = first ? -INFINITY : v;
            v2 = fmaxf(v2, __shfl_xor(v2, 1)); v2 = fmaxf(v2, __shfl_xor(v2, 2)); v2 = fmaxf(v2, __shfl_xor(v2, 4));
            const float gs = m1 + v2;
            int gr = 0;
#pragma unroll
            for (int jj = 0; jj < 8; ++jj) { const float gj = __builtin_bit_cast(float, __builtin_amdgcn_readlane(__builtin_bit_cast(int, gs), jj * 8)); gr += (gj > gs || (gj == gs && jj < gi)) ? 1 : 0; }
            const float mv = (gr < 4) ? v : -INFINITY;
            int rk = 0;
#pragma unroll
            for (int j8 = 0; j8 < 8; ++j8) {
#pragma unroll
                for (int j1 = 0; j1 < 8; ++j1) { const int jj = 8 * j8 + j1; const float vj = __builtin_bit_cast(float, __builtin_amdgcn_readlane(__builtin_bit_cast(int, mv), jj)); rk += (vj > mv || (vj == mv && jj < lane)) ? 1 : 0; }
                __builtin_amdgcn_sched_barrier(0);
            }
            const bool sel = (rk < 8) && (gr < 4);
            const float gsum = wave_sum(sel ? score : 0.f);
            if (sel) {
                const int slot = atomicAdd(&CNT[lane], 1);
                ((int*)(p.ws + OFF_EIDX))[token * 8 + rk] = lane;
                ((int*)(p.ws + OFF_ESLOT))[token * 8 + rk] = slot;
                ((float*)(p.ws + OFF_GATE))[token * 8 + rk] = score / gsum * 2.5f;
                ((int*)(p.ws + OFF_TOKL))[(size_t)lane * NX + slot] = token;
            }
        }
        __syncthreads();
    }
}

constexpr int LE_TAB = 131072;
__device__ __forceinline__ void build_expert_tables(LDSP unsigned char* lds, const Params& p) {
    LDSP int* TP = (LDSP int*)(lds + LE_TAB); LDSP int* ST = TP + 72; LDSP int* CN = ST + 72;
    if (threadIdx.x < NEX) CN[threadIdx.x] = (threadIdx.x < NE) ? ((const int*)(p.ws + OFF_CTL + 16384))[threadIdx.x] : NX;
    __syncthreads();
    if (threadIdx.x == 0) {
        int tp = 0, st = 0;
        for (int e = 0; e < NEX; ++e) { const int cn = CN[e]; TP[e] = tp; ST[e] = st; tp += (cn + 255) >> 8; st += cn; }
        TP[NEX] = tp; ST[NEX] = st;
    }
    __syncthreads();
}

struct GroupSched {
    const LDSP int* TP; const LDSP int* ST; const LDSP int* CN;
    const char* A; const char* B; const int* tokl; int ntn, K, G, c; size_t bstride; bool gather;
    __device__ __forceinline__ bool next(int i, pg8::Unit& u) const {
        const int total = __builtin_amdgcn_readfirstlane(TP[NEX]) * ntn; const long L = (long)i * G + c; if (L >= total) return false;
        const int w = pg8::xcd_remap((int)L, total);
        const int nt = w % ntn, mtg = w / ntn;
        int e = 0, hi = NEX;
        while (hi - e > 1) { const int mid = (e + hi) >> 1; if (__builtin_amdgcn_readfirstlane(TP[mid]) <= mtg) e = mid; else hi = mid; }
        const int tpe = __builtin_amdgcn_readfirstlane(TP[e]), ste = __builtin_amdgcn_readfirstlane(ST[e]), cne = __builtin_amdgcn_readfirstlane(CN[e]);
        const int mt = mtg - tpe;
        u.B = B + (size_t)e * bstride + (size_t)nt * 256 * K * 2;
        u.nvalid = cne; u.m0 = mt * 256; u.pos0 = ste; u.row0 = 0; u.col0 = nt * 256;
        if (gather) { u.A = A; u.rowmap = (e < NE) ? tokl + (size_t)e * NX : nullptr; }
        else { u.A = A + (size_t)(ste + mt * 256) * K * 2; u.rowmap = nullptr; }
        return true;
    }
};
__device__ __forceinline__ void phase8(LDSP unsigned char* lds, const Params& p) {
    build_expert_tables(lds, p);
    const LDSP int* TP = (const LDSP int*)(lds + LE_TAB);
    pg8::Epi<FH1> epi{FH1{(bf16_t*)(p.ws + OFF_H1)}};
    GroupSched S{TP, TP + 72, TP + 144, (const char*)(p.ws + OFF_H2), (const char*)(p.ws + OFF_WTE1), (const int*)(p.ws + OFF_TOKL), 4, D, (int)gridDim.x, (int)blockIdx.x,
                 (size_t)1024 * 2048 * 2, true};
    pg8::gemm_phase<true>(lds, D, S, epi);
}
__device__ __forceinline__ void phase9(LDSP unsigned char* lds, const Params& p) {
    build_expert_tables(lds, p);
    const LDSP int* TP = (const LDSP int*)(lds + LE_TAB);
    pg8::Epi<FEO> epi{FEO{(bf16_t*)(p.ws + OFF_EO)}};
    GroupSched S{TP, TP + 72, TP + 144, (const char*)(p.ws + OFF_H1), (const char*)(p.ws + OFF_WTE2), nullptr, 8, EFF, (int)gridDim.x, (int)blockIdx.x,
                 (size_t)2048 * 512 * 2, false};
    pg8::gemm_phase<false, false>(lds, EFF, S, epi);
}
__device__ __forceinline__ void phase10(LDSP unsigned char* lds, const Params& p) {
    build_expert_tables(lds, p);
    const LDSP int* ST = (const LDSP int*)(lds + LE_TAB) + 72;
    const int tid = opaque(threadIdx.x), wid = tid >> 6, lane = tid & 63;
    const float* MOD = (const float*)(p.ws + OFF_MOD);
    const float* X1 = (const float*)(p.ws + OFF_X1);
    const bf16_t* EO = (const bf16_t*)(p.ws + OFF_EO);
    for (int row = blockIdx.x * 8 + wid; row < NX; row += gridDim.x * 8) {
        unsigned er[9]; float gw[9];
#pragma unroll
        for (int k = 0; k < 8; ++k) { const int e = ((const int*)(p.ws + OFF_EIDX))[row * 8 + k], sl = ((const int*)(p.ws + OFF_ESLOT))[row * 8 + k];
            er[k] = (unsigned)(ST[e] + sl) * (unsigned)D; gw[k] = ((const float*)(p.ws + OFF_GATE))[row * 8 + k]; }
        er[8] = (unsigned)(ST[NE] + row) * (unsigned)D; gw[8] = 1.f;
        const float* md = MOD + (size_t)(row >> 12) * 12288 + 5 * D;
        LDSP float* RB = (LDSP float*)lds + wid * 2048;
        float ss = 0.f;
#pragma unroll 2
        for (int i = 0; i < 8; ++i) { const int col = 4 * (lane + 64 * i);
            f32x4 a = mk4f(0.f, 0.f, 0.f, 0.f);
#pragma unroll
            for (int k = 0; k < 9; ++k) { const u32x2 w = *(const u32x2*)(EO + er[k] + col);
                a.x += gw[k] * bf2f(w.x & 0xffff); a.y += gw[k] * bf2f(w.x >> 16); a.z += gw[k] * bf2f(w.y & 0xffff); a.w += gw[k] * bf2f(w.y >> 16); }
            const f32x4 x1 = *(const f32x4*)(X1 + (size_t)row * D + col), g2 = *(const f32x4*)(md + col);
            f32x4 xv; xv.x = x1.x + g2.x * a.x; xv.y = x1.y + g2.y * a.y; xv.z = x1.z + g2.z * a.z; xv.w = x1.w + g2.w * a.w;
            ss += xv.x * xv.x + xv.y * xv.y + xv.z * xv.z + xv.w * xv.w;
            *(LDSP f32x4*)(RB + col) = xv; }
        ss = wave_sum(ss); const float rs = rsqrtf(ss * (1.f / D) + 1e-6f);
#pragma unroll 4
        for (int i = 0; i < 8; ++i) { const int col = 4 * (lane + 64 * i); const f32x4 g = *(const f32x4*)(p.final_g + col);
            const f32x4 xv = *(const LDSP f32x4*)(RB + col);
            f32x4 o; o.x = xv.x * rs * g.x; o.y = xv.y * rs * g.y; o.z = xv.z * rs * g.z; o.w = xv.w * rs * g.w;
            *(f32x4*)(p.out + (size_t)row * D + col) = o; }
    }
}


#define XB_TMO      128
#define XB_XCNT(j)  (256  + 64 * (j))
#define XB_XSUB(j)  (1280 + 64 * (j))
#define XB_XGEN(j)  (2304 + 64 * (j))
#define XB_TOP      3328
#define XB_TOPGEN   3392
#define XB_SPIN_CAP (1u << 20)
__device__ __forceinline__ unsigned xb_ld(unsigned* p)              { return __hip_atomic_load(p, __ATOMIC_RELAXED, __HIP_MEMORY_SCOPE_AGENT); }
__device__ __forceinline__ unsigned xb_add(unsigned* p, unsigned v) { return __hip_atomic_fetch_add(p, v, __ATOMIC_RELAXED, __HIP_MEMORY_SCOPE_AGENT); }
__device__ __forceinline__ unsigned xb_xcc_id() { return (unsigned)__builtin_amdgcn_s_getreg((3 << 11) | 20) & 0xFu; }
#define XB_SPIN(cond, bar) do { unsigned _sp = 0; while (cond) { __builtin_amdgcn_s_sleep(1); \
    if ((++_sp & 255u) == 0u) { if (xb_ld(&(bar)[XB_TMO])) break; if (_sp > XB_SPIN_CAP) { atomicAdd(&(bar)[XB_TMO], 1u); break; } } } } while (0)
__device__ __forceinline__ unsigned xcd_barrier_complete(unsigned* bar, unsigned x) {
    const unsigned G = gridDim.x * gridDim.y * gridDim.z;
    unsigned sum, cnt, mine, sp = 0u;
    for (;;) {
        sum = 0u; cnt = 0u; mine = 0u;
#pragma unroll
        for (unsigned j = 0; j < 16; ++j) { const unsigned c = xb_ld(&bar[XB_XCNT(j)]); sum += c; cnt += (c > 0u) ? 1u : 0u; mine = (j == x) ? c : mine; }
        if (sum == G) break;
        __builtin_amdgcn_s_sleep(1);
        if ((++sp & 255u) == 0u) { if (xb_ld(&bar[XB_TMO])) break; if (sp > XB_SPIN_CAP) { atomicAdd(&bar[XB_TMO], 1u); break; } }
    }
    return (mine > 0u ? mine : 1u) | ((cnt > 0u ? cnt : 1u) << 16);
}
__device__ __forceinline__ void xcd_barrier(unsigned* bar, unsigned x, volatile LDSP unsigned* st) {
    asm volatile("s_waitcnt vmcnt(0)" ::: "memory");
    __syncthreads();
    if (threadIdx.x == 0) {
        __builtin_amdgcn_s_waitcnt(0);
        unsigned pk = st[0];
        if (pk == 0u) { pk = xcd_barrier_complete(bar, x); st[0] = pk; }
        const unsigned nloc = pk & 0xffffu, nx = pk >> 16;
        const unsigned old = xb_add(&bar[XB_XSUB(x)], 1u);
        const unsigned gen = old / nloc;
        if (old + 1u == (gen + 1u) * nloc) {
            __builtin_amdgcn_fence(__ATOMIC_RELEASE, "agent");
            asm volatile("s_waitcnt vmcnt(0)" ::: "memory");
            const unsigned og = xb_add(&bar[XB_TOP], 1u);
            const unsigned tg = og / nx;
            if (og + 1u == (tg + 1u) * nx) xb_add(&bar[XB_TOPGEN], 1u);
            else XB_SPIN(xb_ld(&bar[XB_TOPGEN]) == tg, bar);
            __builtin_amdgcn_fence(__ATOMIC_ACQUIRE, "agent");
            xb_add(&bar[XB_XGEN(x)], 1u);
            asm volatile("s_waitcnt vmcnt(0)" ::: "memory");
        } else {
            XB_SPIN(xb_ld(&bar[XB_XGEN(x)]) == gen, bar);
            __builtin_amdgcn_fence(__ATOMIC_ACQUIRE, "agent");
            asm volatile("s_waitcnt vmcnt(0)" ::: "memory");
        }
    }
    __syncthreads();
}

__global__ void __launch_bounds__(512, 2) fwd_megakernel(Params p) {
    __shared__ __attribute__((aligned(16))) unsigned char smem_raw[SMEM_BYTES];
    LDSP unsigned char* lds = (LDSP unsigned char*)smem_raw;
    volatile LDSP unsigned* xst = (volatile LDSP unsigned*)(lds + SMEM_BYTES - 16);
    if (threadIdx.x == 0) { xst[0] = 0u; xst[1] = 0u; }
    __syncthreads();
    const unsigned xcc = xb_xcc_id();
    if (threadIdx.x == 0) (void)xb_add(&((unsigned*)p.ws)[XB_XCNT(xcc)], 1u);
#define GSYNC xcd_barrier((unsigned*)p.ws, xcc, xst)
#ifndef PH_TWICE
#define PH_TWICE 0
#endif
#ifndef PH_MASK
#define PH_MASK 0xffff
#endif
#define RUN_PHASE(bit, fn) _Pragma("unroll 1") for (int rep = 0; rep < ((PH_TWICE & (bit)) ? 2 : 1); ++rep) { if (rep) GSYNC; if (PH_MASK & (bit)) { Params q = p; q.ws = opq(p.ws); fn(lds, q); } }
    RUN_PHASE(1, phase0)      GSYNC;
    RUN_PHASE(2, phase1)      GSYNC;
    RUN_PHASE(4, phase2)      GSYNC;
    RUN_PHASE(8, phaseR1)     GSYNC;
    RUN_PHASE(16, phaseR2)    GSYNC;
    RUN_PHASE(32, phaseR3)    GSYNC;
    RUN_PHASE(64, phaseR4)    GSYNC;
    RUN_PHASE(128, phaseR5)   GSYNC;
    RUN_PHASE(256, phase6)    GSYNC;
    RUN_PHASE(512, phase7)    GSYNC;
    RUN_PHASE(1024, phase8)   GSYNC;
    RUN_PHASE(2048, phase9)   GSYNC;
    RUN_PHASE(4096, phase10)
}

extern "C" void kernel_launch(void* const* d_in, const int* in_sizes, int n_in, void* d_out, int out_size, void* d_ws, size_t ws_size, hipStream_t stream) {
    static int grid_blocks = 0;
    if (!grid_blocks) {
        int dev = 0, cus = 0, per_cu = 0;
        (void)hipGetDevice(&dev);
        (void)hipDeviceGetAttribute(&cus, hipDeviceAttributeMultiprocessorCount, dev);
        (void)hipOccupancyMaxActiveBlocksPerMultiprocessor(&per_cu, fwd_megakernel, 512, 0);
        if (per_cu > 1) per_cu = 1;
        grid_blocks = cus * per_cu;
        if (ws_size < WS_END) fprintf(stderr, "workspace too small: %zu < %zu\n", ws_size, (size_t)WS_END);
    }
    Params p{};
    const float** f = (const float**)&p;
    for (int i = 0; i < 31; ++i) f[i] = (const float*)d_in[i];
    p.out = (float*)d_out; p.ws = (unsigned char*)d_ws;
    (void)hipMemsetAsync(d_ws, 0, 32768, stream);
    void* args[] = {&p};
    hipError_t e = hipLaunchCooperativeKernel((void*)fwd_megakernel, dim3(grid_blocks), dim3(512), args, 0, stream);
    if (e != hipSuccess) fprintf(stderr, "cooperative launch failed: %s (grid %d)\n", hipGetErrorString(e), grid_blocks);
}
```

```cpp
#include <hip/hip_runtime.h>
#include <hip/hip_cooperative_groups.h>
#include <cstdio>
#include <cstdint>
namespace cg = cooperative_groups;

#define LDSP __attribute__((address_space(3)))
typedef unsigned short bf16_t;
typedef short bf16x8 __attribute__((ext_vector_type(8)));
typedef float f32x4 __attribute__((ext_vector_type(4)));
typedef float f32x16 __attribute__((ext_vector_type(16)));
typedef unsigned u32x4 __attribute__((ext_vector_type(4)));
typedef unsigned u32x2 __attribute__((ext_vector_type(2)));
__device__ __forceinline__ u32x4 mk4u(unsigned a, unsigned b, unsigned c, unsigned d) { u32x4 r; r.x = a; r.y = b; r.z = c; r.w = d; return r; }
__device__ __forceinline__ u32x2 mk2u(unsigned a, unsigned b) { u32x2 r; r.x = a; r.y = b; return r; }
__device__ __forceinline__ f32x4 mk4f(float a, float b, float c, float d) { f32x4 r; r.x = a; r.y = b; r.z = c; r.w = d; return r; }

constexpr int D = 2048, NB = 2, T = 4096, CL = 256, NX = NB * T, NCX = NB * CL, NR = NX + NCX;
constexpr int INC = 5056, INP = 5120;
constexpr int C_R = 0, C_K = 1024, C_V = 2048, C_XW = 3072, C_XA = 3168, C_XG = 3264, C_Q = 3520, C_AK = 4544, C_AV = 4800;
constexpr int NE = 64, NEX = 65, EFF = 512;
constexpr int NCHUNK = 68;
constexpr int NINST = NB * 16 * 2 * NCHUNK;
constexpr int EROWS = NX * 8 + NX;

constexpr size_t al4k(size_t x) { return (x + 4095) & ~(size_t)4095; }
constexpr size_t OFF_CTL = 0;
constexpr size_t OFF_ROPE = 65536;
constexpr size_t OFF_MODP = OFF_ROPE + 8192;
constexpr size_t OFF_MOD = al4k(OFF_MODP + (size_t)16 * 3 * 12288 * 4);
constexpr size_t OFF_WTDU = al4k(OFF_MOD + (size_t)3 * 12288 * 4);
constexpr size_t OFF_WTIU = OFF_WTDU + (size_t)2 * 1024 * 128 * 2;
constexpr size_t OFF_WTGU = OFF_WTIU + (size_t)2 * 1024 * 128 * 2;
constexpr size_t OFF_WTE2 = OFF_WTGU + (size_t)1024 * 256 * 2;
constexpr size_t OFF_X1 = OFF_WTE2 + (size_t)NEX * 2048 * 512 * 2;
constexpr size_t OFF_H2 = OFF_X1 + (size_t)NX * D * 4;
constexpr size_t OFF_TOKL = OFF_H2 + (size_t)NX * D * 2;
constexpr size_t OFF_EIDX = OFF_TOKL + (size_t)NE * NX * 4;
constexpr size_t OFF_ESLOT = OFF_EIDX + (size_t)NX * 8 * 4;
constexpr size_t OFF_GATE = OFF_ESLOT + (size_t)NX * 8 * 4;
constexpr size_t OFF_H1 = OFF_GATE + (size_t)NX * 8 * 4;
constexpr size_t OFF_WTE1 = al4k(OFF_H1 + (size_t)(EROWS + 256) * EFF * 2);
constexpr size_t OFF_EO = OFF_WTE1;
constexpr size_t OFF_WTIN = OFF_WTE1 + (size_t)NEX * 1024 * 2048 * 2;
constexpr size_t OFF_WTOUT = OFF_WTIN + (size_t)INP * D * 2;
constexpr size_t OFF_HX = OFF_WTOUT + (size_t)D * D * 2;
constexpr size_t OFF_PX = OFF_HX + (size_t)NR * D * 2;
constexpr size_t OFF_CM = OFF_PX + (size_t)NR * INP * 2;
constexpr size_t OFF_CN = OFF_CM + (size_t)NINST * 4096 * 2;
constexpr size_t OFF_CP = OFF_CN + (size_t)NINST * 4096 * 2;
constexpr size_t OFF_CQ = OFF_CP + (size_t)NINST * 4096 * 2;
constexpr size_t OFF_YD = OFF_CQ + (size_t)NINST * 4096 * 2;
constexpr size_t OFF_BON = OFF_YD + (size_t)2 * NX * 1024 * 4;
constexpr size_t OFF_MIX = OFF_BON + (size_t)2 * NX * 16 * 4;
constexpr size_t WS_END = OFF_MIX + (size_t)NX * D * 2;
constexpr size_t OFF_RS = OFF_X1;
constexpr size_t OFF_KS = OFF_RS + (size_t)NR * 1024 * 2;
constexpr size_t OFF_KK = OFF_KS + (size_t)NR * 1024 * 2;
constexpr size_t OFF_VS = OFF_KK + (size_t)NR * 1024 * 2;
constexpr size_t OFF_TW = OFF_VS + (size_t)NR * 1024 * 2;
constexpr size_t OFF_XA = OFF_TW + (size_t)NR * 128 * 2;
constexpr size_t OFF_SG = OFF_XA + (size_t)NR * 128 * 2;
constexpr size_t OFF_LWG = OFF_SG + (size_t)NX * 256 * 2;
constexpr size_t OFF_AIG = OFF_LWG + (size_t)NR * 2048 * 2;
constexpr size_t OFF_GG = OFF_AIG + (size_t)NR * 2048 * 2;
static_assert(OFF_GG + (size_t)NX * 1024 * 2 <= OFF_WTE1, "RWKV token buffers fit the overlay region");
static_assert(OFF_EO + (size_t)EROWS * D * 2 <= OFF_HX, "EO overlays only WT_E1/WT_IN/WT_OUT");
static_assert(WS_END <= (size_t)1073741824, "workspace map must fit 1 GiB");

constexpr int SMEM_BYTES = 157 * 1024;

struct Params {
    const float *x, *c, *ctx, *c_ctx, *w_mod, *b_mod, *norm1_g, *norm2_g, *w_in, *shift_mu, *k_k, *k_a, *r_k, *decay_bias, *decay_up, *iclr_bias, *iclr_up,
        *gate_up, *lnx_g, *lnx_b, *attn_sink, *w_out, *w_router, *expert_bias, *e_gate, *e_up, *e_down, *s_gate, *s_up, *s_down, *final_g;
    float* out;
    unsigned char* ws;
};

__device__ __forceinline__ unsigned f2bf(float f) { unsigned u = __float_as_uint(f); return (u + 0x7fffu + ((u >> 16) & 1u)) >> 16; }
__device__ __forceinline__ float bf2f(unsigned h) { return __uint_as_float(h << 16); }
typedef float f32x2_t __attribute__((ext_vector_type(2)));
typedef __bf16 bf16x2_t __attribute__((ext_vector_type(2)));
__device__ __forceinline__ unsigned pk2(float lo, float hi) { f32x2_t v = {lo, hi}; bf16x2_t b = __builtin_convertvector(v, bf16x2_t); return __builtin_bit_cast(unsigned, b); }
__device__ __forceinline__ float wave_sum(float v) {
#pragma unroll
    for (int o = 32; o > 0; o >>= 1) v += __shfl_xor(v, o);
    return v;
}
__device__ __forceinline__ int opaque(int x) { asm volatile("" : "+v"(x)); return x; }
__device__ __forceinline__ int opaque_s(int x) { asm volatile("" : "+s"(x)); return x; }
__device__ __forceinline__ unsigned char* opq(unsigned char* x) {
    unsigned long long v = (unsigned long long)x; asm volatile("" : "+s"(v));
    return (unsigned char*)(__attribute__((address_space(1))) unsigned char*)v; }
__device__ __forceinline__ float sigmoidf_(float x) { return __builtin_amdgcn_rcpf(1.f + __expf(-x)); }
__device__ __forceinline__ int lds_byte(int r, int c) { const int st = (r >> 4) * 2 + (c >> 5), rr = r & 15, cc = c & 31, ob = rr * 64 + cc * 2; return st * 1024 + (ob ^ (((ob >> 9) & 1) << 5)); }
__device__ __forceinline__ int sw64(int r, int k) { return r * 128 + ((((k >> 3) ^ (r >> 1)) & 7) << 4) + (k & 7) * 2; }

__device__ __forceinline__ f32x16 zero16() { f32x16 z;
#pragma unroll
    for (int i = 0; i < 16; ++i) z[i] = 0.f; return z; }
__device__ __forceinline__ int crow(int reg, int hi) { return (reg & 3) + 8 * (reg >> 2) + 4 * hi; }

namespace pg8 {
constexpr int BM = 256, BK = 64, HALF = 128, HTB = HALF * BK * 2, NXCD = 8;
__device__ __forceinline__ void stage_rc(int b, int& R, int& C) { const int st = b / 1024, sb = b % 1024, swz = sb ^ (((sb >> 9) & 1) << 5); R = (st >> 1) * 16 + swz / 64; C = (st & 1) * 32 + (swz % 64) / 2; }
struct Unit { const char* A; const char* B; const int* rowmap; int nvalid, m0, row0, col0, pos0; };
__device__ __forceinline__ int xcd_remap(int L, int nwg) { const int q = nwg / NXCD, r = nwg % NXCD, xcd = L % NXCD, off = L / NXCD; return (xcd < r ? xcd * (q + 1) : r * (q + 1) + (xcd - r) * q) + off; }

__device__ __forceinline__ int perm32(int rho) { const int n = rho >> 4, i = rho & 15; return 8 * (i >> 2) + 4 * n + (i & 3); }
template <class F> struct Epi {
    F f;
    __device__ __forceinline__ void operator()(const f32x4 (&acc)[2][2][4][2], const Unit& u, int wr, int wc, int fr, int fq) const {
#pragma unroll
        for (int ai = 0; ai < 2; ++ai)
#pragma unroll
            for (int m = 0; m < 4; ++m)
#pragma unroll
                for (int bj = 0; bj < 2; ++bj) { f(u, 128 * ai + 64 * wr + 16 * m + fr, 128 * bj + 32 * wc + 8 * fq, acc[ai][bj][m][0], acc[ai][bj][m][1]); __builtin_amdgcn_sched_barrier(0); }
    }
};

template <bool GATHER, bool ALIGN_EPI = true, class EpiT, class Sched>
__device__ __forceinline__ void gemm_phase(LDSP unsigned char* lds, const int K, const Sched& S, const EpiT& E) {
    const int tid = opaque(threadIdx.x), wid = __builtin_amdgcn_readfirstlane(tid >> 6), lane = tid & 63, wr = wid >> 2, wc = wid & 3, fr = lane & 15, fq = lane >> 4;
    const int nt = K / BK;
    unsigned voffA[2], voffB[2];
#pragma unroll
    for (int i = 0; i < 2; ++i) { int R, C; stage_rc(tid * 16 + i * 8192, R, C); const int Rb = (R & ~31) + perm32(R & 31); voffA[i] = (unsigned)(R * K + C) * 2u; voffB[i] = (unsigned)(Rb * K + C) * 2u; }
    const size_t kstep = (size_t)(BK * 2);
    const size_t hstep = (size_t)HALF * K * 2;
    const unsigned ldsw = (unsigned)wid * 1024u;
    const int aoff = lds_byte(wr * 64 + fr, fq * 8), boff = lds_byte(wc * 32 + fr, fq * 8);
#define PG8_SA(b, h) (((b) * 2 + (h)) * HTB)
#define PG8_SB(b, h) ((4 + (b) * 2 + (h)) * HTB)
#define PG8_STAGE(bufoff, gbase, voff) do { _Pragma("unroll") for (int _i = 0; _i < 2; ++_i) \
        __builtin_amdgcn_global_load_lds((const unsigned*)((const char*)(gbase) + (voff)[_i]), (LDSP unsigned*)(lds + (bufoff) + ldsw + _i * 8192), 16, 0, 0); } while (0)
#define PG8_STAGE_A(bufoff, nx, h, ubase, koff) do { if constexpr (GATHER) { unsigned _v[2]; const LDSP unsigned* _ro = rowoff + ((((nx) ? (ui + 1) : ui) & 1) * 4 + (h) * 2) * 512; _v[0] = _ro[0]; _v[1] = _ro[512]; PG8_STAGE(bufoff, (ubase) + (koff), _v); } \
        else { PG8_STAGE(bufoff, (ubase) + (h) * hstep + (koff), voffA); } } while (0)
#define PG8_LDA(dst, b, h) do { _Pragma("unroll") for (int m = 0; m < 4; ++m) _Pragma("unroll") for (int k = 0; k < 2; ++k) dst[m][k] = *(const LDSP bf16x8*)(lds + PG8_SA(b, h) + aoff + m * 2048 + k * 1024); } while (0)
#define PG8_LDB(dst, b, h) do { _Pragma("unroll") for (int n = 0; n < 2; ++n) _Pragma("unroll") for (int k = 0; k < 2; ++k) dst[n][k] = *(const LDSP bf16x8*)(lds + PG8_SB(b, h) + boff + n * 2048 + k * 1024); } while (0)
#define PG8_MMA(ai, bj, At, Bt) do { __builtin_amdgcn_s_setprio(1); _Pragma("unroll") for (int m = 0; m < 4; ++m) _Pragma("unroll") for (int n = 0; n < 2; ++n) _Pragma("unroll") for (int k = 0; k < 2; ++k) \
        acc[ai][bj][m][n] = __builtin_amdgcn_mfma_f32_16x16x32_bf16(Bt[n][k], At[m][k], acc[ai][bj][m][n], 0, 0, 0); __builtin_amdgcn_s_setprio(0); } while (0)
#define PG8_WAIT_V(n) asm volatile("s_waitcnt vmcnt(" #n ")" ::: "memory")
#define PG8_WAIT_L(n) asm volatile("s_waitcnt lgkmcnt(" #n ")" ::: "memory")
#define PG8_BAR __builtin_amdgcn_s_barrier()
#define PG8_SCHED __builtin_amdgcn_sched_barrier(0)
    Unit cur, nxt; int ui = 0;
    if (!S.next(0, cur)) return;
    LDSP unsigned* rowoff = (LDSP unsigned*)(lds + 132096) + tid;
    auto rows_of = [&](const Unit& u, int slot) {
        if constexpr (GATHER) {
#pragma unroll
            for (int h = 0; h < 2; ++h)
#pragma unroll
                for (int i = 0; i < 2; ++i) { int R, C; stage_rc(tid * 16 + i * 8192, R, C); const int idx = u.m0 + h * HALF + R; int gr = idx; if (u.rowmap) gr = (idx < u.nvalid) ? u.rowmap[idx] : 0;
                    rowoff[((slot & 1) * 4 + h * 2 + i) * 512] = (unsigned)(gr * K + C) * 2u; }
        }
    };
    rows_of(cur, 0);
    f32x4 acc[2][2][4][2];
#pragma unroll
    for (int a = 0; a < 2; ++a)
#pragma unroll
        for (int b = 0; b < 2; ++b)
#pragma unroll
            for (int m = 0; m < 4; ++m)
#pragma unroll
                for (int n = 0; n < 2; ++n) acc[a][b][m][n] = (f32x4){0.f, 0.f, 0.f, 0.f};
    bf16x8 At[4][2], B0[2][2], B1[2][2];
    const char* cA = cur.A; const char* cB = cur.B;
    PG8_STAGE(PG8_SB(0, 0), cB, voffB); PG8_STAGE(PG8_SB(0, 1), cB + hstep, voffB); PG8_STAGE_A(PG8_SA(0, 0), false, 0, cA, 0); PG8_STAGE_A(PG8_SA(0, 1), false, 1, cA, 0);
    if (wr == 1) PG8_BAR;
    PG8_WAIT_V(2); PG8_BAR;
    PG8_STAGE(PG8_SB(1, 0), cB + kstep, voffB); PG8_STAGE_A(PG8_SA(1, 0), false, 0, cA, kstep); PG8_STAGE(PG8_SB(1, 1), cB + hstep + kstep, voffB);
    PG8_WAIT_V(6); PG8_BAR;
    for (;;) {
        const bool has_next = S.next(ui + 1, nxt);
        rows_of(has_next ? nxt : cur, ui + 1);
        const char* nA = has_next ? nxt.A : cA; const char* nB = has_next ? nxt.B : cB;
#pragma unroll 1
        for (int t = 0; t < nt; t += 2) {
            const bool last = (t == nt - 2);
            const size_t k1 = (size_t)(t + 1) * kstep;
            const char* a2 = last ? nA : cA; const size_t k2 = last ? 0 : (size_t)(t + 2) * kstep;
            const char* b2 = last ? nB : cB + (size_t)(t + 2) * kstep;
            const char* b3 = b2 + kstep;
            PG8_LDB(B0, 0, 0); PG8_LDB(B1, 0, 1); PG8_SCHED; PG8_LDA(At, 0, 0); PG8_STAGE_A(PG8_SA(1, 1), false, 1, cA, k1);
            PG8_WAIT_V(8); PG8_WAIT_L(0); PG8_BAR; PG8_MMA(0, 0, At, B0); PG8_MMA(0, 1, At, B1); PG8_BAR; PG8_SCHED;
            PG8_LDA(At, 0, 1); PG8_STAGE(PG8_SB(0, 0), b2, voffB); PG8_STAGE(PG8_SB(0, 1), b2 + hstep, voffB); PG8_STAGE_A(PG8_SA(0, 0), last, 0, a2, k2);
            PG8_WAIT_V(8); PG8_WAIT_L(0); PG8_BAR; PG8_MMA(1, 0, At, B0); PG8_MMA(1, 1, At, B1); PG8_BAR; PG8_SCHED;
            PG8_LDB(B0, 1, 0); PG8_LDB(B1, 1, 1); PG8_SCHED; PG8_LDA(At, 1, 0); PG8_STAGE_A(PG8_SA(0, 1), last, 1, a2, k2);
            PG8_WAIT_V(8); PG8_WAIT_L(0); PG8_BAR; PG8_MMA(0, 0, At, B0); PG8_MMA(0, 1, At, B1); PG8_BAR; PG8_SCHED;
            PG8_LDA(At, 1, 1); PG8_STAGE(PG8_SB(1, 0), b3, voffB); PG8_STAGE(PG8_SB(1, 1), b3 + hstep, voffB); PG8_STAGE_A(PG8_SA(1, 0), last, 0, a2, k2 + kstep);
            PG8_WAIT_V(8); PG8_WAIT_L(0); PG8_BAR; PG8_MMA(1, 0, At, B0); PG8_MMA(1, 1, At, B1); PG8_BAR; PG8_SCHED;
        }
        if constexpr (ALIGN_EPI) { if (wr == 0) PG8_BAR; }
        E(acc, cur, wr, wc, fr, fq);
        if (!has_next) break;
#pragma unroll
        for (int a = 0; a < 2; ++a)
#pragma unroll
            for (int b = 0; b < 2; ++b)
#pragma unroll
                for (int m = 0; m < 4; ++m)
#pragma unroll
                    for (int n = 0; n < 2; ++n) acc[a][b][m][n] = (f32x4){0.f, 0.f, 0.f, 0.f};
        cur = nxt; cA = nA; cB = nB; ++ui;
        if constexpr (ALIGN_EPI) { if (wr == 1) PG8_BAR; }
    }
    PG8_WAIT_V(0);
    if constexpr (!ALIGN_EPI) { if (wr == 0) PG8_BAR; }
    PG8_BAR;
#undef PG8_SA
#undef PG8_SB
#undef PG8_STAGE
#undef PG8_STAGE_A
#undef PG8_LDA
#undef PG8_LDB
#undef PG8_MMA
#undef PG8_WAIT_V
#undef PG8_WAIT_L
#undef PG8_BAR
#undef PG8_SCHED
}

struct DenseSched {
    const char* A; const char* B; int nM, nN, K, G, c;
    __device__ __forceinline__ bool next(int i, Unit& u) const {
        const int nwg = nM * nN; const long L = (long)i * G + c; if (L >= nwg) return false;
        const int wgid = xcd_remap((int)L, nwg);
        const int nig = 8 * nN, gid = wgid / nig, fm = gid * 8, gsz = (nM - fm) < 8 ? (nM - fm) : 8;
        const int pm = fm + ((wgid % nig) % gsz), pn = (wgid % nig) / gsz;
        u.A = A + (size_t)pm * 256 * K * 2; u.B = B + (size_t)pn * 256 * K * 2; u.rowmap = nullptr; u.nvalid = 0; u.m0 = 0; u.row0 = pm * 256; u.col0 = pn * 256; u.pos0 = 0;
        return true;
    }
};
}

struct FPX { bf16_t* PX; __device__ __forceinline__ void operator()(const pg8::Unit& u, int lr, int lc, f32x4 v0, f32x4 v1) const {
    *(u32x4*)(PX + (size_t)(u.row0 + lr) * INP + u.col0 + lc) = mk4u(pk2(v0[0], v0[1]), pk2(v0[2], v0[3]), pk2(v1[0], v1[1]), pk2(v1[2], v1[3])); } };
struct FX1 { const float* x; const float* mod; float* X1; __device__ __forceinline__ void operator()(const pg8::Unit& u, int lr, int lc, f32x4 v0, f32x4 v1) const {
    const int row = u.row0 + lr, col = u.col0 + lc; const float* xp = x + (size_t)row * D + col; const float* gp = mod + (size_t)(row >> 12) * 12288 + 2 * D + col; float* op = X1 + (size_t)row * D + col;
    *(f32x4*)op = *(const f32x4*)xp + *(const f32x4*)gp * v0; *(f32x4*)(op + 4) = *(const f32x4*)(xp + 4) + *(const f32x4*)(gp + 4) * v1; } };
struct FH1 { bf16_t* H1; __device__ __forceinline__ void operator()(const pg8::Unit& u, int lr, int lc, f32x4 v0, f32x4 v1) const {
    if (u.m0 + lr < u.nvalid) { float h[4];
#pragma unroll
        for (int e = 0; e < 4; ++e) h[e] = v0[e] * sigmoidf_(v0[e]) * v1[e];
        *(u32x2*)(H1 + (size_t)(u.pos0 + u.m0 + lr) * EFF + ((u.col0 + lc) >> 1)) = mk2u(pk2(h[0], h[1]), pk2(h[2], h[3])); } } };
struct FEO { bf16_t* EO; __device__ __forceinline__ void operator()(const pg8::Unit& u, int lr, int lc, f32x4 v0, f32x4 v1) const {
    if (u.m0 + lr < u.nvalid) *(u32x4*)(EO + (size_t)(u.pos0 + u.m0 + lr) * D + u.col0 + lc) = mk4u(pk2(v0[0], v0[1]), pk2(v0[2], v0[3]), pk2(v1[0], v1[1]), pk2(v1[2], v1[3])); } };

struct ConvJob { const float* src; bf16_t* dst; int K, N, ld, mode, ntk, ntn; size_t sbs, dbs; };
__device__ __forceinline__ int conv_row(int n, int mode) { return mode == 0 ? n : (8 * (n >> 2) + (n & 3) + (mode == 2 ? 4 : 0)); }

struct TileCtx { const float* src; bf16_t* dst; int N, ld, mode, k0, n0; };
constexpr int CT0 = 0, CT1 = CT0 + 8 * (INC / 64), CT2 = CT1 + 8 * 32, CT3 = CT2 + 64 * 64, CT4 = CT3 + 64 * 64, CT5 = CT4 + 64 * 64, CT6 = CT5 + 64, CT7 = CT6 + 64, CT8 = CT7 + 64, CT_END = CT8 + 16;
__device__ __forceinline__ void conv_decode(const Params& p, int g, const float*& src, bf16_t*& dst, int& N, int& ld, int& mode, int& k0, int& n0) {
    bf16_t* WTE1 = (bf16_t*)(p.ws + OFF_WTE1); bf16_t* WTE2 = (bf16_t*)(p.ws + OFF_WTE2);
    int t, ntk, ntn; size_t sbs = 0, dbs = 0;
    if (g < CT1)      { t = g - CT0; src = p.w_in; dst = (bf16_t*)(p.ws + OFF_WTIN); N = INC; ld = 2048; mode = 0; ntk = 8; ntn = INC / 64; }
    else if (g < CT2) { t = g - CT1; src = p.w_out; dst = (bf16_t*)(p.ws + OFF_WTOUT); N = 2048; ld = 2048; mode = 0; ntk = 8; ntn = 32; }
    else if (g < CT3) { t = g - CT2; src = p.e_gate; dst = WTE1; N = 512; ld = 2048; mode = 1; ntk = 8; ntn = 8; sbs = (size_t)2048 * 512; dbs = (size_t)1024 * 2048; }
    else if (g < CT4) { t = g - CT3; src = p.e_up; dst = WTE1; N = 512; ld = 2048; mode = 2; ntk = 8; ntn = 8; sbs = (size_t)2048 * 512; dbs = (size_t)1024 * 2048; }
    else if (g < CT5) { t = g - CT4; src = p.e_down; dst = WTE2; N = 2048; ld = 512; mode = 0; ntk = 2; ntn = 32; sbs = (size_t)512 * 2048; dbs = (size_t)2048 * 512; }
    else if (g < CT6) { t = g - CT5; src = p.s_gate; dst = WTE1 + (size_t)64 * 1024 * 2048; N = 512; ld = 2048; mode = 1; ntk = 8; ntn = 8; }
    else if (g < CT7) { t = g - CT6; src = p.s_up; dst = WTE1 + (size_t)64 * 1024 * 2048; N = 512; ld = 2048; mode = 2; ntk = 8; ntn = 8; }
    else if (g < CT8) { t = g - CT7; src = p.s_down; dst = WTE2 + (size_t)64 * 2048 * 512; N = 2048; ld = 512; mode = 0; ntk = 2; ntn = 32; }
    else              { t = g - CT8; src = p.gate_up; dst = (bf16_t*)(p.ws + OFF_WTGU); N = 1024; ld = 256; mode = 0; ntk = 1; ntn = 16; }
    const int per = ntk * ntn, bi = t / per, rem = t - bi * per, kt = rem / ntn, ntile = rem - kt * ntn;
    src += (size_t)bi * sbs; dst += (size_t)bi * dbs; k0 = kt * 256; n0 = ntile * 64;
}
__device__ __forceinline__ void conv_load(const float* src, int N, int k0, int n0, f32x4 (&v)[4][2], int tid) {
    const int kr = tid >> 3, nc = (tid & 7) * 8;
#pragma unroll
    for (int s = 0; s < 4; ++s) { const float* q = src + (size_t)(k0 + s * 64 + kr) * N + n0 + nc; v[s][0] = *(const f32x4*)q; v[s][1] = *(const f32x4*)(q + 4); }
}
__device__ __forceinline__ void conv_finish(LDSP unsigned char* lds, bf16_t* dst, int ld, int mode, int k0, int n0, const f32x4 (&v)[4][2], int tid) {
    LDSP float* Tm = (LDSP float*)lds;
    {
        const int kr = tid >> 3, nc = (tid & 7) * 8;
#pragma unroll
        for (int s = 0; s < 4; ++s) { LDSP float* q = Tm + (s * 64 + kr) * 65 + nc;
            q[0] = v[s][0].x; q[1] = v[s][0].y; q[2] = v[s][0].z; q[3] = v[s][0].w; q[4] = v[s][1].x; q[5] = v[s][1].y; q[6] = v[s][1].z; q[7] = v[s][1].w; }
    }
    __syncthreads();
    {
        const int n = tid >> 3; bf16_t* drow = dst + (size_t)conv_row(n0 + n, mode) * ld + k0;
#pragma unroll
        for (int s = 0; s < 4; ++s) { const int kc = ((tid & 7) + 8 * s) * 8; float f[8];
#pragma unroll
            for (int j = 0; j < 8; ++j) f[j] = Tm[(kc + j) * 65 + n];
            u32x4 w; w.x = pk2(f[0], f[1]); w.y = pk2(f[2], f[3]); w.z = pk2(f[4], f[5]); w.w = pk2(f[6], f[7]); *(u32x4*)(drow + kc) = w; }
    }
    __syncthreads();
}

__device__ __forceinline__ void mod_item(LDSP unsigned char* lds, const Params& p, int item) {
    const int kb = item >> 6, nb = item & 63, tid = opaque(threadIdx.x), wid = tid >> 6, lane = tid & 63;
    f32x4 acc[3];
#pragma unroll
    for (int v = 0; v < 3; ++v) acc[v] = mk4f(0.f, 0.f, 0.f, 0.f);
    if (lane < 48) {
#pragma unroll 8
        for (int i = 0; i < 64; ++i) {
            const int k = kb * 512 + wid * 64 + i;
            const float c0 = p.c[k], c1 = p.c[D + k], c2 = p.c_ctx[k];
            const float s0 = c0 * sigmoidf_(c0), s1 = c1 * sigmoidf_(c1), s2 = c2 * sigmoidf_(c2);
            const f32x4 w = *(const f32x4*)(p.w_mod + (size_t)k * 12288 + nb * 192 + 4 * lane);
            acc[0] += s0 * w; acc[1] += s1 * w; acc[2] += s2 * w;
        }
    }
    LDSP float* R = (LDSP float*)lds;
    if (lane < 48) {
#pragma unroll
        for (int v = 0; v < 3; ++v) *(LDSP f32x4*)(R + (wid * 3 + v) * 192 + 4 * lane) = acc[v];
    }
    __syncthreads();
    float* MODP = (float*)(p.ws + OFF_MODP);
    for (int o = tid; o < 3 * 192; o += 512) { const int v = o / 192, cidx = o - v * 192; float sum = 0.f;
#pragma unroll
        for (int w = 0; w < 8; ++w) sum += R[(w * 3 + v) * 192 + cidx];
        MODP[((size_t)kb * 3 + v) * 12288 + nb * 192 + cidx] = sum; }
    __syncthreads();
}

__device__ __forceinline__ void conv_range(LDSP unsigned char* lds, const Params& p, int g0, int g1, int rank, int nblk) {
    const int tid = opaque(threadIdx.x);
    int g = g0 + rank;
    const float* csrc = nullptr; bf16_t* cdst = nullptr; int cN = 0, cld = 0, cmode = 0, ck0 = 0, cn0 = 0;
    const float* nsrc = nullptr; bf16_t* ndst = nullptr; int nN = 0, nld = 0, nmode = 0, nk0 = 0, nn0 = 0;
    f32x4 va[4][2], vb[4][2];
    if (g < g1) { conv_decode(p, g, csrc, cdst, cN, cld, cmode, ck0, cn0); conv_load(csrc, cN, ck0, cn0, va, tid); }
#pragma unroll 1
    while (g < g1) {
        const int gn = g + nblk;
        if (gn < g1) { conv_decode(p, gn, nsrc, ndst, nN, nld, nmode, nk0, nn0); conv_load(nsrc, nN, nk0, nn0, vb, tid); }
        conv_finish(lds, cdst, cld, cmode, ck0, cn0, va, tid);
        cdst = ndst; cld = nld; cmode = nmode; ck0 = nk0; cn0 = nn0; g = gn;
#pragma unroll
        for (int s = 0; s < 4; ++s) { va[s][0] = vb[s][0]; va[s][1] = vb[s][1]; }
    }
}
constexpr int P2_UNITS = (NR / 256) * (INP / 256), P2_TILES_PER_IDLE = 10;
__device__ __forceinline__ int p2_idle_blocks(int G) { const int rounds = (P2_UNITS + G - 1) / G; return rounds * G - P2_UNITS; }
__device__ __forceinline__ int conv_split(int G) { const int t = CT_END - p2_idle_blocks(G) * P2_TILES_PER_IDLE; return t < CT4 ? CT4 : t; }

__device__ __forceinline__ void phase0(LDSP unsigned char* lds, const Params& p) {
    const int tid = opaque(threadIdx.x);
    for (int it = blockIdx.x; it < 256; it += gridDim.x) mod_item(lds, p, it);
    conv_range(lds, p, 0, conv_split(gridDim.x), blockIdx.x, gridDim.x);
    {
        const int total = 4 * 1024 * 128;
        for (int idx = blockIdx.x * 512 + tid; idx < total; idx += gridDim.x * 512) {
            const int mtx = idx >> 17, rem = idx & 131071, n = rem >> 7, k = rem & 127;
            const float* src = (mtx < 2 ? p.decay_up : p.iclr_up) + (size_t)(mtx & 1) * 96 * 1024;
            bf16_t* dst = (bf16_t*)(p.ws + (mtx < 2 ? OFF_WTDU : OFF_WTIU)) + (size_t)(mtx & 1) * 1024 * 128;
            dst[n * 128 + k] = (bf16_t)f2bf(k < 96 ? src[(size_t)k * 1024 + n] : 0.f);
        }
    }
    {
        u32x4* z = (u32x4*)((bf16_t*)(p.ws + OFF_WTIN) + (size_t)INC * D);
        const int total = (INP - INC) * D * 2 / 16;
        for (int idx = blockIdx.x * 512 + tid; idx < total; idx += gridDim.x * 512) z[idx] = mk4u(0, 0, 0, 0);
    }
    if (blockIdx.x == gridDim.x - 1) {
        float2* R = (float2*)(p.ws + OFF_ROPE);
        for (int idx = tid; idx < 1024; idx += 512) { const int pos = idx >> 4, f = idx & 15;
            const float freq = powf(10000.f, -(float)f / 16.f); const float ang = (float)pos * freq; R[idx] = make_float2(cosf(ang), sinf(ang)); }
    }
}

__device__ __forceinline__ void phase1(LDSP unsigned char* lds, const Params& p) {
    const int tid = opaque(threadIdx.x), wid = tid >> 6, lane = tid & 63;
    const float* MODP = (const float*)(p.ws + OFF_MODP);
    float* MOD = (float*)(p.ws + OFF_MOD);
    LDSP float* MV = (LDSP float*)lds;
    for (int idx = tid; idx < 3 * 4096; idx += 512) { const int v = idx >> 12, col = idx & 4095; float s = p.b_mod[col];
#pragma unroll
        for (int kb = 0; kb < 4; ++kb) s += MODP[((size_t)kb * 3 + v) * 12288 + col];
        MV[idx] = s; }
    for (int idx = blockIdx.x * 512 + tid; idx < 3 * 12288; idx += gridDim.x * 512) { const int v = idx / 12288, col = idx - v * 12288; float s = p.b_mod[col];
#pragma unroll
        for (int kb = 0; kb < 4; ++kb) s += MODP[((size_t)kb * 3 + v) * 12288 + col];
        MOD[idx] = s; }
    __syncthreads();
    bf16_t* HX = (bf16_t*)(p.ws + OFF_HX);
    for (int row = blockIdx.x * 8 + wid; row < NR; row += gridDim.x * 8) {
        const float* src = row < NX ? p.x + (size_t)row * D : p.ctx + (size_t)(row - NX) * D;
        const int v = row < NX ? (row >> 12) : 2;
        f32x4 xv[8]; float ss = 0.f;
#pragma unroll
        for (int i = 0; i < 8; ++i) { xv[i] = ((const f32x4*)src)[lane + 64 * i]; ss += xv[i].x * xv[i].x + xv[i].y * xv[i].y + xv[i].z * xv[i].z + xv[i].w * xv[i].w; }
        ss = wave_sum(ss);
        const float rs = rsqrtf(ss * (1.f / D) + 1e-6f);
#pragma unroll
        for (int i = 0; i < 8; ++i) { const int col = 4 * (lane + 64 * i);
            const f32x4 g = *(const f32x4*)(p.norm1_g + col); const LDSP float* sh = MV + v * 4096 + col; const LDSP float* sc = sh + 2048;
            const float h0 = xv[i].x * rs * g.x * (1.f + sc[0]) + sh[0], h1 = xv[i].y * rs * g.y * (1.f + sc[1]) + sh[1];
            const float h2 = xv[i].z * rs * g.z * (1.f + sc[2]) + sh[2], h3 = xv[i].w * rs * g.w * (1.f + sc[3]) + sh[3];
            u32x2 w; w.x = pk2(h0, h1); w.y = pk2(h2, h3); *(u32x2*)(HX + (size_t)row * D + col) = w; }
    }
}

__device__ __forceinline__ void phase2(LDSP unsigned char* lds, const Params& p) {
    pg8::Epi<FPX> epi{FPX{(bf16_t*)(p.ws + OFF_PX)}};
    pg8::DenseSched S{(const char*)(p.ws + OFF_HX), (const char*)(p.ws + OFF_WTIN), NR / 256, INP / 256, D, (int)gridDim.x, (int)blockIdx.x};
    pg8::gemm_phase<false>(lds, D, S, epi);
    const int G = gridDim.x, idle = p2_idle_blocks(G), split = conv_split(G);
    if (split < CT_END) {
        __syncthreads();
        if (idle > 0 && (int)blockIdx.x >= G - idle) conv_range(lds, p, split, CT_END, blockIdx.x - (G - idle), idle);
        else if (idle == 0) conv_range(lds, p, split, CT_END, blockIdx.x, G);
    }
}

__device__ __forceinline__ void phaseR1(LDSP unsigned char* lds, const Params& p) {
    const int tid = opaque(threadIdx.x), wid = tid >> 6, lane = tid & 63;
    const bf16_t* PX = (const bf16_t*)(p.ws + OFF_PX);
    for (int row = blockIdx.x * 8 + wid; row < NR; row += gridDim.x * 8) {
        const bool isx = row < NX;
        const int s0 = isx ? (row & ~(T - 1)) : NX + ((row - NX) & ~(CL - 1)), len = isx ? T : CL;
        const bool hp = row > s0, hn = row + 1 < s0 + len;
        const bf16_t* pc = PX + (size_t)row * INP;
#pragma unroll 1
        for (int it = 0; it < 7; ++it) {
            const int ch = lane + 64 * it;
            if (ch < 440) {
                const int col = ch * 8;
                const u32x4 c4 = *(const u32x4*)(pc + col);
                u32x4 p4 = mk4u(0, 0, 0, 0), n4 = mk4u(0, 0, 0, 0);
                if (hp) p4 = *(const u32x4*)(pc - INP + col);
                if (hn) n4 = *(const u32x4*)(pc + INP + col);
                const f32x4 m0 = *(const f32x4*)(p.shift_mu + col), m1 = *(const f32x4*)(p.shift_mu + col + 4);
                const float mu[8] = {m0.x, m0.y, m0.z, m0.w, m1.x, m1.y, m1.z, m1.w};
                const unsigned cw[4] = {c4.x, c4.y, c4.z, c4.w}, pw[4] = {p4.x, p4.y, p4.z, p4.w}, nw[4] = {n4.x, n4.y, n4.z, n4.w};
                float v[8];
#pragma unroll
                for (int j = 0; j < 4; ++j) {
                    const float c0 = bf2f(cw[j] & 0xffff), c1 = bf2f(cw[j] >> 16);
                    v[2 * j] = c0 + mu[2 * j] * (0.5f * (bf2f(pw[j] & 0xffff) + bf2f(nw[j] & 0xffff)) - c0);
                    v[2 * j + 1] = c1 + mu[2 * j + 1] * (0.5f * (bf2f(pw[j] >> 16) + bf2f(nw[j] >> 16)) - c1);
                }
                if (it < 2) {
                    *(u32x4*)((bf16_t*)(p.ws + OFF_RS) + (size_t)row * 1024 + col) = mk4u(pk2(v[0], v[1]), pk2(v[2], v[3]), pk2(v[4], v[5]), pk2(v[6], v[7]));
                } else if (it < 4) {
                    const int kc = col - C_K;
                    *(u32x4*)((bf16_t*)(p.ws + OFF_KS) + (size_t)row * 1024 + kc) = mk4u(pk2(v[0], v[1]), pk2(v[2], v[3]), pk2(v[4], v[5]), pk2(v[6], v[7]));
                    const f32x4 k0 = *(const f32x4*)(p.k_k + kc), k1 = *(const f32x4*)(p.k_k + kc + 4);
                    const float kq[8] = {k0.x, k0.y, k0.z, k0.w, k1.x, k1.y, k1.z, k1.w};
                    float ss = 0.f;
#pragma unroll
                    for (int j = 0; j < 8; ++j) { v[j] *= kq[j]; ss += v[j] * v[j]; }
                    ss += __shfl_xor(ss, 1); ss += __shfl_xor(ss, 2); ss += __shfl_xor(ss, 4);
                    const float sc = rsqrtf(ss + 1e-12f);
                    *(u32x4*)((bf16_t*)(p.ws + OFF_KK) + (size_t)row * 1024 + kc) = mk4u(pk2(v[0] * sc, v[1] * sc), pk2(v[2] * sc, v[3] * sc), pk2(v[4] * sc, v[5] * sc), pk2(v[6] * sc, v[7] * sc));
                } else if (it < 6) {
                    *(u32x4*)((bf16_t*)(p.ws + OFF_VS) + (size_t)row * 1024 + col - C_V) = mk4u(pk2(v[0], v[1]), pk2(v[2], v[3]), pk2(v[4], v[5]), pk2(v[6], v[7]));
                } else if (ch < 396) {
#pragma unroll
                    for (int j = 0; j < 8; ++j) v[j] = tanhf(v[j]);
                    *(u32x4*)((bf16_t*)(p.ws + OFF_TW) + (size_t)row * 128 + col - C_XW) = mk4u(pk2(v[0], v[1]), pk2(v[2], v[3]), pk2(v[4], v[5]), pk2(v[6], v[7]));
                } else if (ch < 408) {
                    *(u32x4*)((bf16_t*)(p.ws + OFF_XA) + (size_t)row * 128 + col - C_XA) = mk4u(pk2(v[0], v[1]), pk2(v[2], v[3]), pk2(v[4], v[5]), pk2(v[6], v[7]));
                } else if (isx) {
#pragma unroll
                    for (int j = 0; j < 8; ++j) v[j] = sigmoidf_(v[j]);
                    *(u32x4*)((bf16_t*)(p.ws + OFF_SG) + (size_t)row * 256 + col - C_XG) = mk4u(pk2(v[0], v[1]), pk2(v[2], v[3]), pk2(v[4], v[5]), pk2(v[6], v[7]));
                }
            }
        }
        if (lane < 4) { *(u32x4*)((bf16_t*)(p.ws + OFF_TW) + (size_t)row * 128 + 96 + lane * 8) = mk4u(0, 0, 0, 0); *(u32x4*)((bf16_t*)(p.ws + OFF_XA) + (size_t)row * 128 + 96 + lane * 8) = mk4u(0, 0, 0, 0); }
    }
}

struct LoraSched {
    const char *A0, *B0, *A1, *B1; int G, c;
    __device__ __forceinline__ bool next(int i, pg8::Unit& u) const {
        const int per = (NR / 256) * 8; const long L = (long)i * G + c; if (L >= 2 * per) return false;
        const int job = (int)L / per, w = (int)L % per, pm = w >> 3, pn = w & 7;
        u.A = (job ? A1 : A0) + (size_t)pm * 256 * 128 * 2; u.B = (job ? B1 : B0) + (size_t)pn * 256 * 128 * 2; u.rowmap = nullptr; u.nvalid = 0; u.m0 = 0; u.row0 = pm * 256; u.col0 = pn * 256; u.pos0 = job;
        return true;
    }
};
struct FLORA { const float* dbias; const float* ibias; bf16_t* LWG; bf16_t* AIG; __device__ __forceinline__ void operator()(const pg8::Unit& u, int lr, int lc, f32x4 v0, f32x4 v1) const {
    const int row = u.row0 + lr, col = u.col0 + lc;
    const float* bp = (u.pos0 == 0 ? dbias : ibias) + col; const f32x4 b0 = *(const f32x4*)bp, b1 = *(const f32x4*)(bp + 4);
    const float sc = (u.pos0 == 0) ? -0.60653065971f : 1.f;
    float o[8];
#pragma unroll
    for (int e = 0; e < 4; ++e) { o[e] = sc * sigmoidf_(b0[e] + v0[e]); o[4 + e] = sc * sigmoidf_(b1[e] + v1[e]); }
    *(u32x4*)((u.pos0 == 0 ? LWG : AIG) + (size_t)row * 2048 + col) = mk4u(pk2(o[0], o[1]), pk2(o[2], o[3]), pk2(o[4], o[5]), pk2(o[6], o[7]));
} };
struct FGG { bf16_t* GG; __device__ __forceinline__ void operator()(const pg8::Unit& u, int lr, int lc, f32x4 v0, f32x4 v1) const {
    *(u32x4*)(GG + (size_t)(u.row0 + lr) * 1024 + u.col0 + lc) = mk4u(pk2(v0[0], v0[1]), pk2(v0[2], v0[3]), pk2(v1[0], v1[1]), pk2(v1[2], v1[3])); } };

__device__ __forceinline__ int inst_index(int b, int h, int d, int chunk) { return ((b * 16 + h) * 2 + d) * NCHUNK + chunk; }

constexpr int LA_K = 0  , LA_VT = 73728  , LA_END = LA_VT + 18 * 4608;
static_assert(LA_END <= SMEM_BYTES, "attention LDS map");

__device__ __forceinline__ void attn_unit(LDSP unsigned char* lds, const Params& p, int unit) {
    const int tid = opaque(threadIdx.x), wid = tid >> 6, lane = tid & 63;
    const int b = unit >> 8, kvh = (unit >> 6) & 3, qb = unit & 63, q0 = qb * 64;
    const bf16_t* PX = (const bf16_t*)(p.ws + OFF_PX);
    const float2* ROPE = (const float2*)(p.ws + OFF_ROPE);
    {
        u32x4 kx1[5], kx2[5];
#pragma unroll
        for (int it = 0; it < 5; ++it) {
            const int task = tid + 512 * it; kx1[it] = mk4u(0, 0, 0, 0); kx2[it] = mk4u(0, 0, 0, 0);
            if (task < 576 * 4) {
                const int key = task >> 2, pr = task & 3, c0 = (pr & 1) + 4 * (pr >> 1);
                const int pos = q0 - 128 + key;
                const bool lat = key < 320;
                if (!lat || (pos >= 0 && pos < T)) {
                    const bf16_t* src = PX + (size_t)(lat ? (b * T + pos) : (NX + b * CL + (key - 320))) * INP + C_AK + kvh * 64 + c0 * 8;
                    kx1[it] = *(const u32x4*)src; kx2[it] = *(const u32x4*)(src + 16);
                }
            }
        }
#pragma unroll
        for (int it = 0; it < 5; ++it) {
            const int task = tid + 512 * it;
            if (task < 576 * 4) {
                const int key = task >> 2, pr = task & 3, c0 = (pr & 1) + 4 * (pr >> 1);
                u32x4 w0 = kx1[it], w1 = kx2[it];
                if (key < 320) {
                    const int pos = q0 - 128 + key;
                    if (pos >= 0 && pos < T) {
                        const int ppos = (pr < 2) ? (pos >> 6) : (pos & 63);
                        const float2* tb = ROPE + ppos * 16 + (pr & 1) * 8;
                        const unsigned a1[4] = {w0.x, w0.y, w0.z, w0.w}, a2[4] = {w1.x, w1.y, w1.z, w1.w};
                        unsigned o1[4], o2[4];
#pragma unroll
                        for (int j = 0; j < 4; ++j) {
                            const float2 cs0 = tb[2 * j], cs1 = tb[2 * j + 1];
                            const float u0 = bf2f(a1[j] & 0xffff), u1 = bf2f(a1[j] >> 16), v0 = bf2f(a2[j] & 0xffff), v1 = bf2f(a2[j] >> 16);
                            o1[j] = pk2(u0 * cs0.x - v0 * cs0.y, u1 * cs1.x - v1 * cs1.y);
                            o2[j] = pk2(v0 * cs0.x + u0 * cs0.y, v1 * cs1.x + u1 * cs1.y);
                        }
                        w0 = mk4u(o1[0], o1[1], o1[2], o1[3]); w1 = mk4u(o2[0], o2[1], o2[2], o2[3]);
                    }
                }
                *(LDSP u32x4*)(lds + LA_K + sw64(key, c0 * 8)) = w0;
                *(LDSP u32x4*)(lds + LA_K + sw64(key, c0 * 8 + 16)) = w1;
            }
        }
    }
    {
        u32x4 vx[3][4];
#pragma unroll
        for (int it = 0; it < 3; ++it) {
            const int task = tid + 512 * it;
#pragma unroll
            for (int q = 0; q < 4; ++q) {
                vx[it][q] = mk4u(0, 0, 0, 0);
                if (task < 144 * 8) {
                    const int kg = task >> 3, dc = task & 7, key = kg * 4 + q;
                    if (key < 320) { const int pos = q0 - 128 + key; if (pos >= 0 && pos < T) vx[it][q] = *(const u32x4*)(PX + (size_t)(b * T + pos) * INP + C_AV + kvh * 64 + dc * 8); }
                    else vx[it][q] = *(const u32x4*)(PX + (size_t)(NX + b * CL + (key - 320)) * INP + C_AV + kvh * 64 + dc * 8);
                }
            }
        }
#pragma unroll
        for (int it = 0; it < 3; ++it) {
            const int task = tid + 512 * it;
            if (task < 144 * 8) {
                const int kg = task >> 3, dc = task & 7;
                unsigned short e[4][8];
#pragma unroll
                for (int q = 0; q < 4; ++q) { const u32x4 w = vx[it][q];
                    e[q][0] = w.x & 0xffff; e[q][1] = w.x >> 16; e[q][2] = w.y & 0xffff; e[q][3] = w.y >> 16; e[q][4] = w.z & 0xffff; e[q][5] = w.z >> 16; e[q][6] = w.w & 0xffff; e[q][7] = w.w >> 16; }
                const int tile = kg >> 3, kin = (kg & 7) * 4;
#pragma unroll
                for (int j = 0; j < 8; ++j) { u32x2 w; w.x = (unsigned)e[0][j] | ((unsigned)e[1][j] << 16); w.y = (unsigned)e[2][j] | ((unsigned)e[3][j] << 16);
                    *(LDSP u32x2*)(lds + LA_VT + tile * 4608 + (dc * 8 + j) * 72 + kin * 2) = w; }
            }
        }
    }
    const int hq = kvh * 4 + (wid >> 1), qs = (wid & 1) * 32, r = lane & 31, hh = lane >> 5;
    const int qpos = q0 + qs + r;
    bf16x8 qf[4];
    {
        const bf16_t* src = PX + (size_t)(b * T + qpos) * INP + C_Q + hq * 64 + 8 * hh;
        u32x4 raw[4];
#pragma unroll
        for (int s = 0; s < 4; ++s) raw[s] = *(const u32x4*)(src + 16 * s);
#pragma unroll
        for (int pr = 0; pr < 2; ++pr) {
            const int ppos = pr == 0 ? (qpos >> 6) : (qpos & 63);
            const float2* tb = ROPE + ppos * 16 + 8 * hh;
            const unsigned a1[4] = {raw[2 * pr].x, raw[2 * pr].y, raw[2 * pr].z, raw[2 * pr].w}, a2[4] = {raw[2 * pr + 1].x, raw[2 * pr + 1].y, raw[2 * pr + 1].z, raw[2 * pr + 1].w};
            unsigned o1[4], o2[4];
#pragma unroll
            for (int j = 0; j < 4; ++j) {
                const float2 cs0 = tb[2 * j], cs1 = tb[2 * j + 1];
                const float u0 = bf2f(a1[j] & 0xffff), u1 = bf2f(a1[j] >> 16), v0 = bf2f(a2[j] & 0xffff), v1 = bf2f(a2[j] >> 16);
                o1[j] = pk2(0.125f * (u0 * cs0.x - v0 * cs0.y), 0.125f * (u1 * cs1.x - v1 * cs1.y));
                o2[j] = pk2(0.125f * (v0 * cs0.x + u0 * cs0.y), 0.125f * (v1 * cs1.x + u1 * cs1.y));
            }
            const u32x4 w1 = mk4u(o1[0], o1[1], o1[2], o1[3]), w2 = mk4u(o2[0], o2[1], o2[2], o2[3]);
            qf[2 * pr] = __builtin_bit_cast(bf16x8, w1); qf[2 * pr + 1] = __builtin_bit_cast(bf16x8, w2);
        }
    }
    __syncthreads();
    float m = p.attn_sink[hq], l = 1.f;
    f32x16 o0 = zero16(), o1 = zero16();
    for (int tl = 0; tl < 18; ++tl) {
        f32x16 st = zero16();
#pragma unroll
        for (int s = 0; s < 4; ++s) {
            const bf16x8 kf = *(const LDSP bf16x8*)(lds + LA_K + sw64(32 * tl + r, 16 * s + 8 * hh));
            st = __builtin_amdgcn_mfma_f32_32x32x16_bf16(kf, qf[s], st, 0, 0, 0);
        }
        const int kp0 = q0 - 128 + 32 * tl, qlo = q0 + qs;
        if (tl < 10 && (qlo + 31 - kp0 > 128 || qlo - (kp0 + 31) < -128 || kp0 < 0 || kp0 + 31 >= T)) {
#pragma unroll
            for (int g = 0; g < 16; ++g) { const int kp = q0 - 128 + 32 * tl + crow(g, hh); const int dlt = qpos - kp;
                const bool ok = (dlt <= 128) && (dlt >= -128) && (kp >= 0) && (kp < T); st[g] = ok ? st[g] : -1e30f; }
        }
        float mt = st[0];
#pragma unroll
        for (int g = 1; g < 16; ++g) mt = fmaxf(mt, st[g]);
        mt = fmaxf(mt, __shfl_xor(mt, 32));
        const float mn = fmaxf(m, mt), alpha = __expf(m - mn);
        float ps = 0.f;
#pragma unroll
        for (int g = 0; g < 16; ++g) { st[g] = __expf(st[g] - mn); ps += st[g]; }
        ps += __shfl_xor(ps, 32);
        l = l * alpha + ps; m = mn;
        if (__any(alpha != 1.f)) {
#pragma unroll
            for (int g = 0; g < 16; ++g) { o0[g] *= alpha; o1[g] *= alpha; }
        }
#pragma unroll
        for (int s2 = 0; s2 < 2; ++s2) {
            const u32x4 pw = mk4u(pk2(st[8 * s2], st[8 * s2 + 1]), pk2(st[8 * s2 + 2], st[8 * s2 + 3]), pk2(st[8 * s2 + 4], st[8 * s2 + 5]), pk2(st[8 * s2 + 6], st[8 * s2 + 7]));
            const bf16x8 pf = __builtin_bit_cast(bf16x8, pw);
#pragma unroll
            for (int dm = 0; dm < 2; ++dm) {
                const LDSP unsigned char* vp = lds + LA_VT + tl * 4608 + (32 * dm + r) * 72 + (16 * s2 + 4 * hh) * 2;
                const u32x2 v0 = *(const LDSP u32x2*)vp, v1 = *(const LDSP u32x2*)(vp + 16);
                const bf16x8 vf = __builtin_bit_cast(bf16x8, mk4u(v0.x, v0.y, v1.x, v1.y));
                if (dm == 0) o0 = __builtin_amdgcn_mfma_f32_32x32x16_bf16(vf, pf, o0, 0, 0, 0); else o1 = __builtin_amdgcn_mfma_f32_32x32x16_bf16(vf, pf, o1, 0, 0, 0);
            }
        }
    }
    {
        const float inv = 1.f / l;
        bf16_t* dst = (bf16_t*)(p.ws + OFF_MIX) + (size_t)(b * T + qpos) * D + 1024 + hq * 64;
#pragma unroll
        for (int gq = 0; gq < 4; ++gq) {
            u32x2 w; w.x = pk2(o0[4 * gq] * inv, o0[4 * gq + 1] * inv); w.y = pk2(o0[4 * gq + 2] * inv, o0[4 * gq + 3] * inv); *(u32x2*)(dst + 8 * gq + 4 * hh) = w;
            u32x2 w2; w2.x = pk2(o1[4 * gq] * inv, o1[4 * gq + 1] * inv); w2.y = pk2(o1[4 * gq + 2] * inv, o1[4 * gq + 3] * inv); *(u32x2*)(dst + 32 + 8 * gq + 4 * hh) = w2;
        }
    }
    __syncthreads();
}

__device__ __forceinline__ void phaseR2(LDSP unsigned char* lds, const Params& p) {
    {
        pg8::Epi<FLORA> epi{FLORA{p.decay_bias, p.iclr_bias, (bf16_t*)(p.ws + OFF_LWG), (bf16_t*)(p.ws + OFF_AIG)}};
        LoraSched S{(const char*)(p.ws + OFF_TW), (const char*)(p.ws + OFF_WTDU), (const char*)(p.ws + OFF_XA), (const char*)(p.ws + OFF_WTIU), (int)gridDim.x, (int)blockIdx.x};
        pg8::gemm_phase<false>(lds, opaque_s(128), S, epi);
    }
    {
        pg8::Epi<FGG> epi{FGG{(bf16_t*)(p.ws + OFF_GG)}};
        pg8::DenseSched S{(const char*)(p.ws + OFF_SG), (const char*)(p.ws + OFF_WTGU), NX / 256, 1024 / 256, 256, (int)gridDim.x, (int)(gridDim.x - 1 - blockIdx.x)};
        pg8::gemm_phase<false>(lds, opaque_s(256), S, epi);
    }
}

constexpr int G_RT = 0, G_VT = 8192, G_X0 = 16384, G_AT = 32768, G_BT = 40960, G_KT = 49152, G_P0 = 57344, G_PT0 = 65536, G_SEG = 73728, G_GL = 74752, G_CNT = 75008, G_BYTES = 79872;
static_assert(2 * G_BYTES <= SMEM_BYTES - 16, "two R3 groups fit the LDS");

__device__ __forceinline__ void gbar(LDSP unsigned* cnt, unsigned& target, int lane) {
    target += 4u;
    asm volatile("s_waitcnt lgkmcnt(0)" ::: "memory");
    if (lane == 0) {
        __hip_atomic_fetch_add(cnt, 1u, __ATOMIC_RELAXED, __HIP_MEMORY_SCOPE_WORKGROUP);
        while (__hip_atomic_load(cnt, __ATOMIC_RELAXED, __HIP_MEMORY_SCOPE_WORKGROUP) < target) __builtin_amdgcn_s_sleep(1);
    }
    asm volatile("" ::: "memory");
}
__device__ __forceinline__ void mask_lt(f32x16& c, int x0, int y, int hh, bool incl) {
#pragma unroll
    for (int g = 0; g < 16; ++g) { const int x = x0 + crow(g, hh); c[g] = (incl ? (x <= y) : (x < y)) ? c[g] : 0.f; }
}

#if defined(__HIP_DEVICE_COMPILE__)
#define LDS_AT(T, addr) (__builtin_bit_cast(LDSP T*, (unsigned)(addr)))
#define LDS_ADDR(ptr) (__builtin_bit_cast(unsigned, (ptr)))
#else
#define LDS_AT(T, addr) ((LDSP T*)(size_t)(addr))
#define LDS_ADDR(ptr) ((unsigned)(size_t)(ptr))
#endif
__device__ __forceinline__ void ldf(const unsigned (&FO)[4], unsigned off, bf16x8 (&f)[4]) {
#pragma unroll
    for (int s = 0; s < 4; ++s) f[s] = *LDS_AT(const bf16x8, FO[s] + off);
}
__device__ __forceinline__ void stt(const unsigned (&SO)[4], unsigned off, int xh, const f32x16& acc) {
#pragma unroll
    for (int gq = 0; gq < 4; ++gq) *LDS_AT(u32x2, (SO[gq] ^ ((unsigned)xh << 6)) + off) = mk2u(pk2(acc[4 * gq], acc[4 * gq + 1]), pk2(acc[4 * gq + 2], acc[4 * gq + 3]));
}
__device__ __forceinline__ u32x2 ld8(const unsigned (&SO)[4], int gq, unsigned off, int xh) { return *LDS_AT(const u32x2, (SO[gq] ^ ((unsigned)xh << 6)) + off); }

__device__ __forceinline__ void rwkv_prep_group(LDSP unsigned char* lg, LDSP unsigned* cnt, unsigned& bt, const Params& p, int unit, int wg_in, int lane_in, const unsigned (&FO)[4], const unsigned (&SO)[4]) {
    int seq, c, h, d;
    if (unit < 4096) { seq = unit >> 11; c = (unit >> 5) & 63; h = (unit >> 1) & 15; d = unit & 1; } else { const int u = unit - 4096; seq = 2 + (u >> 7); c = (u >> 5) & 3; h = (u >> 1) & 15; d = u & 1; }
    const bool isx = seq < 2;
    const int b = seq & 1;
    const int s0 = isx ? b * T : NX + b * CL, t0 = c * 64;
    const int chunk_id = isx ? 4 + c : c;
    u32x4 keep_bh[2], keep_kh[2];
#define STAGE_IDS const int lane = opaque(lane_in), wg = opaque(wg_in), r = lane & 31, hh = lane >> 5; (void)r; (void)hh; (void)wg;
    {
        STAGE_IDS
        const int k = lane, seg = wg, hk = h * 64 + k;
        const float kac = p.k_a[hk];
        const bf16_t* RS = (const bf16_t*)(p.ws + OFF_RS); const bf16_t* KS = (const bf16_t*)(p.ws + OFF_KS); const bf16_t* KKp = (const bf16_t*)(p.ws + OFF_KK); const bf16_t* VS = (const bf16_t*)(p.ws + OFF_VS);
        const bf16_t* LWG = (const bf16_t*)(p.ws + OFF_LWG); const bf16_t* AIG = (const bf16_t*)(p.ws + OFF_AIG);
        const int ibase = seg * 16;
        const size_t rowA = (size_t)(s0 + t0) + (d ? 63 - ibase : ibase);
        float lw[16];
        float run = 0.f;
#pragma unroll
        for (int tt = 0; tt < 16; ++tt) { const size_t row = d ? rowA - tt : rowA + tt; run += bf2f(LWG[row * 2048 + d * 1024 + hk]); lw[tt] = run; }
        LDSP float* SEG = (LDSP float*)(lg + G_SEG);
        SEG[seg * 64 + k] = run;
        gbar(cnt, bt, lane);
        float off = 0.f, gL = 0.f;
#pragma unroll
        for (int s = 0; s < 4; ++s) { const float sv = SEG[s * 64 + k]; if (s < seg) off += sv; gL += sv; }
        if (seg == 0) ((LDSP float*)(lg + G_GL))[k] = gL;
        const float egL = __expf(gL);
#pragma unroll
        for (int q = 0; q < 2; ++q) {
            float rr[8], kr[8], kk[8], vv[8], ai[8];
#pragma unroll
            for (int e = 0; e < 8; ++e) { const int tt = 8 * q + e; const size_t row = d ? rowA - tt : rowA + tt;
                rr[e] = bf2f(RS[row * 1024 + hk]); kr[e] = bf2f(KS[row * 1024 + hk]); kk[e] = bf2f(KKp[row * 1024 + hk]); vv[e] = bf2f(VS[row * 1024 + hk]); ai[e] = bf2f(AIG[row * 2048 + d * 1024 + hk]); }
            unsigned wat[4], wbh[4], wkh[4], wv[4];
#pragma unroll
            for (int t2 = 0; t2 < 4; ++t2) {
                const int i0 = ibase + 8 * q + 2 * t2;
                float fat[2], frt[2], fbt[2], fkt[2], fbh[2], fkh[2];
#pragma unroll
                for (int e2 = 0; e2 < 2; ++e2) { const int e = 2 * t2 + e2, tt = 8 * q + e;
                    const float kd = kr[e] * (1.f + (ai[e] - 1.f) * kac), bbv = kk[e] * ai[e];
                    const float g = off + lw[tt], ge = (tt == 0) ? off : off + lw[tt - 1];
                    const float eg = __expf(g), ege = __expf(ge), eng = __builtin_amdgcn_rcpf(eg), egl = egL * eng;
                    fat[e2] = -kk[e] * ege; frt[e2] = rr[e] * eg; fbt[e2] = bbv * eng; fkt[e2] = kd * eng; fbh[e2] = bbv * egl; fkh[e2] = kd * egl; }
                wat[t2] = pk2(fat[0], fat[1]); wbh[t2] = pk2(fbh[0], fbh[1]); wkh[t2] = pk2(fkh[0], fkh[1]); wv[t2] = pk2(vv[2 * t2], vv[2 * t2 + 1]);
                const unsigned wr = pk2(frt[0], frt[1]), wb = pk2(fbt[0], fbt[1]), wk = pk2(fkt[0], fkt[1]);
                *(LDSP bf16_t*)(lg + G_AT + sw64(i0, k)) = (bf16_t)(wat[t2] & 0xffffu); *(LDSP bf16_t*)(lg + G_AT + sw64(i0 + 1, k)) = (bf16_t)(wat[t2] >> 16);
                *(LDSP bf16_t*)(lg + G_RT + sw64(i0, k)) = (bf16_t)(wr & 0xffffu);      *(LDSP bf16_t*)(lg + G_RT + sw64(i0 + 1, k)) = (bf16_t)(wr >> 16);
                *(LDSP bf16_t*)(lg + G_BT + sw64(i0, k)) = (bf16_t)(wb & 0xffffu);      *(LDSP bf16_t*)(lg + G_BT + sw64(i0 + 1, k)) = (bf16_t)(wb >> 16);
                *(LDSP bf16_t*)(lg + G_KT + sw64(i0, k)) = (bf16_t)(wk & 0xffffu);      *(LDSP bf16_t*)(lg + G_KT + sw64(i0 + 1, k)) = (bf16_t)(wk >> 16);
            }
            *(LDSP u32x4*)(lg + G_X0 + sw64(k, ibase + 8 * q)) = mk4u(wat[0], wat[1], wat[2], wat[3]);
            *(LDSP u32x4*)(lg + G_VT + sw64(k, ibase + 8 * q)) = mk4u(wv[0], wv[1], wv[2], wv[3]);
            keep_bh[q] = mk4u(wbh[0], wbh[1], wbh[2], wbh[3]); keep_kh[q] = mk4u(wkh[0], wkh[1], wkh[2], wkh[3]);
            __builtin_amdgcn_sched_barrier(0);
        }
    }
    gbar(cnt, bt, lane_in);
    {
        STAGE_IDS
        const int a = wg >> 1, bq = wg & 1;
        f32x16 c1 = zero16(), c2 = zero16();
        if (a <= bq) {
            bf16x8 fB[4], fA[4]; ldf(FO, G_BT + 4096 * a, fB); ldf(FO, G_AT + 4096 * bq, fA);
#pragma unroll
            for (int t = 0; t < 4; ++t) { c1 = __builtin_amdgcn_mfma_f32_32x32x16_bf16(fB[t], fA[t], c1, 0, 0, 0); c2 = __builtin_amdgcn_mfma_f32_32x32x16_bf16(fA[t], fB[t], c2, 0, 0, 0); }
            mask_lt(c1, 32 * a, 32 * bq + r, hh, false);
#pragma unroll
            for (int g = 0; g < 16; ++g) { const int x = 32 * bq + crow(g, hh); c2[g] = (32 * a + r < x) ? c2[g] : 0.f; }
        }
        stt(SO, G_P0 + 4096 * bq, a, c1);
        stt(SO, G_PT0 + 4096 * a, bq, c2);
        const int ib = wg >> 1, vb = wg & 1;
        f32x16 z = zero16();
#pragma unroll
        for (int jb = 0; jb < 2; ++jb) if (jb <= ib) {
            bf16x8 fK[4], fA[4]; ldf(FO, G_KT + 4096 * jb, fK); ldf(FO, G_AT + 4096 * ib, fA);
            f32x16 t = zero16();
#pragma unroll
            for (int s = 0; s < 4; ++s) t = __builtin_amdgcn_mfma_f32_32x32x16_bf16(fK[s], fA[s], t, 0, 0, 0);
            mask_lt(t, 32 * jb, 32 * ib + r, hh, false);
#pragma unroll
            for (int s2 = 0; s2 < 2; ++s2) {
                const bf16x8 af = __builtin_bit_cast(bf16x8, mk4u(pk2(t[8 * s2], t[8 * s2 + 1]), pk2(t[8 * s2 + 2], t[8 * s2 + 3]), pk2(t[8 * s2 + 4], t[8 * s2 + 5]), pk2(t[8 * s2 + 6], t[8 * s2 + 7])));
                const u32x2 v0 = ld8(SO, 2 * s2, G_VT + 4096 * vb, jb), v1 = ld8(SO, 2 * s2 + 1, G_VT + 4096 * vb, jb);
                const bf16x8 bv = __builtin_bit_cast(bf16x8, mk4u(v0.x, v0.y, v1.x, v1.y));
                z = __builtin_amdgcn_mfma_f32_32x32x16_bf16(af, bv, z, 0, 0, 0);
            }
        }
        stt(SO, G_X0 + 128 * 64 + 4096 * vb, ib, z);
    }
    gbar(cnt, bt, lane_in);
#pragma unroll 1
    for (int s = 0; s < 6; ++s) {
        STAGE_IDS
        const int cb = wg, a = wg >> 1, bq = wg & 1;
        bf16x8 xf[4], p0[4], p1[4];
        ldf(FO, G_X0 + 4096 * cb, xf); ldf(FO, G_P0, p0); ldf(FO, G_P0 + 4096, p1);
        f32x16 acc0, acc1;
#pragma unroll
        for (int gq = 0; gq < 4; ++gq) { const u32x2 w0 = ld8(SO, gq, G_X0 + 4096 * cb, 0), w1 = ld8(SO, gq, G_X0 + 4096 * cb, 1);
            acc0[4 * gq] = bf2f(w0.x & 0xffff); acc0[4 * gq + 1] = bf2f(w0.x >> 16); acc0[4 * gq + 2] = bf2f(w0.y & 0xffff); acc0[4 * gq + 3] = bf2f(w0.y >> 16);
            acc1[4 * gq] = bf2f(w1.x & 0xffff); acc1[4 * gq + 1] = bf2f(w1.x >> 16); acc1[4 * gq + 2] = bf2f(w1.y & 0xffff); acc1[4 * gq + 3] = bf2f(w1.y >> 16); }
        f32x16 z = zero16(), zt = zero16();
        const bool sq = (s < 5) && (a <= bq);
        bf16x8 fa[4], fb[4];
        if (sq) { ldf(FO, G_PT0 + 4096 * a, fa); ldf(FO, G_P0 + 4096 * bq, fb); }
#pragma unroll
        for (int t = 0; t < 4; ++t) { if (t < 2) acc0 = __builtin_amdgcn_mfma_f32_32x32x16_bf16(p0[t], xf[t], acc0, 0, 0, 0); acc1 = __builtin_amdgcn_mfma_f32_32x32x16_bf16(p1[t], xf[t], acc1, 0, 0, 0); }
        if (sq) { const int t0 = (a == 1) ? 2 : 0, t1 = (bq == 0) ? 2 : 4;
#pragma unroll
            for (int t = 0; t < 4; ++t) if (t >= t0 && t < t1) { z = __builtin_amdgcn_mfma_f32_32x32x16_bf16(fa[t], fb[t], z, 0, 0, 0); zt = __builtin_amdgcn_mfma_f32_32x32x16_bf16(fb[t], fa[t], zt, 0, 0, 0); } }
        stt(SO, G_X0 + 4096 * cb, 0, acc0); stt(SO, G_X0 + 4096 * cb, 1, acc1);
        if (s < 5) {
            gbar(cnt, bt, lane);
            stt(SO, G_P0 + 4096 * bq, a, z); stt(SO, G_PT0 + 4096 * a, bq, zt);
        }
        gbar(cnt, bt, lane);
    }
    {
        STAGE_IDS
        const int jb = wg >> 1, ib = wg & 1;
        f32x16 c1 = zero16(), c2 = zero16();
        if (jb <= ib) {
            bf16x8 fR[4], fB[4], fK[4]; ldf(FO, G_RT + 4096 * ib, fR); ldf(FO, G_BT + 4096 * jb, fB); ldf(FO, G_KT + 4096 * jb, fK);
#pragma unroll
            for (int t = 0; t < 4; ++t) { c1 = __builtin_amdgcn_mfma_f32_32x32x16_bf16(fB[t], fR[t], c1, 0, 0, 0); c2 = __builtin_amdgcn_mfma_f32_32x32x16_bf16(fK[t], fR[t], c2, 0, 0, 0); }
            mask_lt(c1, 32 * jb, 32 * ib + r, hh, true); mask_lt(c2, 32 * jb, 32 * ib + r, hh, true);
        }
        stt(SO, G_P0 + 4096 * ib, jb, c1); stt(SO, G_PT0 + 4096 * ib, jb, c2);
    }
    gbar(cnt, bt, lane_in);
    {
        STAGE_IDS
#pragma unroll
        for (int q = 0; q < 2; ++q) { *(LDSP u32x4*)(lg + G_BT + sw64(lane, wg * 16 + 8 * q)) = keep_bh[q]; *(LDSP u32x4*)(lg + G_KT + sw64(lane, wg * 16 + 8 * q)) = keep_kh[q]; }
    }
    gbar(cnt, bt, lane_in);
    {
        STAGE_IDS
        const int mi = wg;
        const int L_BH = G_BT, L_KH = G_KT, L_RB = G_P0, L_RK = G_PT0;
        const size_t inst = (size_t)inst_index(b, h, d, chunk_id) * 4096;
        bf16_t* dst = (bf16_t*)(p.ws + (mi == 0 ? OFF_CM : mi == 1 ? OFF_CN : mi == 2 ? OFF_CP : OFF_CQ)) + inst;
        if (isx || mi < 2) {
            const int Ax = (mi == 1) ? L_BH : G_X0, Ax0 = (mi == 3) ? 64 : 0;
            const int By = (mi == 0) ? L_BH : (mi == 1) ? G_X0 : L_RB, By0 = (mi == 1) ? 64 : 0;
            const int A2 = (mi == 1) ? L_KH : G_VT, B2 = (mi == 1) ? G_VT : L_RK;
#pragma unroll 1
            for (int half = 0; half < 2; ++half) {
                bf16x8 a0[4], a1[4], b1[4];
                ldf(FO, Ax + 128 * Ax0, a0); ldf(FO, Ax + 128 * (Ax0 + 32), a1); ldf(FO, By + 128 * (By0 + 32 * half), b1);
                f32x16 c0 = zero16(), c1 = zero16();
#pragma unroll
                for (int t = 0; t < 4; ++t) { c0 = __builtin_amdgcn_mfma_f32_32x32x16_bf16(a0[t], b1[t], c0, 0, 0, 0); c1 = __builtin_amdgcn_mfma_f32_32x32x16_bf16(a1[t], b1[t], c1, 0, 0, 0); }
                if (mi & 1) {
                    ldf(FO, A2, a0); ldf(FO, A2 + 4096, a1); ldf(FO, B2 + 4096 * half, b1);
#pragma unroll
                    for (int t = 0; t < 4; ++t) { c0 = __builtin_amdgcn_mfma_f32_32x32x16_bf16(a0[t], b1[t], c0, 0, 0, 0); c1 = __builtin_amdgcn_mfma_f32_32x32x16_bf16(a1[t], b1[t], c1, 0, 0, 0); }
                }
                const int y = 32 * half + r;
                const float dg = (mi == 0) ? __expf(((const LDSP float*)(lg + G_GL))[y]) : 0.f;
#pragma unroll
                for (int xb = 0; xb < 2; ++xb) {
#pragma unroll
                    for (int gq = 0; gq < 4; ++gq) {
                        const int x0 = 32 * xb + 8 * gq + 4 * hh;
                        float v0 = xb ? c1[4 * gq] : c0[4 * gq], v1 = xb ? c1[4 * gq + 1] : c0[4 * gq + 1], v2 = xb ? c1[4 * gq + 2] : c0[4 * gq + 2], v3 = xb ? c1[4 * gq + 3] : c0[4 * gq + 3];
                        if (mi == 0) { if (x0 == y) v0 += dg; if (x0 + 1 == y) v1 += dg; if (x0 + 2 == y) v2 += dg; if (x0 + 3 == y) v3 += dg; }
                        if (mi == 2) { const u32x2 w = ld8(SO, gq, G_RT + 4096 * half, xb); v0 += bf2f(w.x & 0xffff); v1 += bf2f(w.x >> 16); v2 += bf2f(w.y & 0xffff); v3 += bf2f(w.y >> 16); }
                        *(u32x2*)(dst + ((half * 4 + 2 * xb + (gq >> 1)) * 64 + hh * 32 + r) * 8 + 4 * (gq & 1)) = mk2u(pk2(v0, v1), pk2(v2, v3));
                    }
                }
            }
        }
    }
    gbar(cnt, bt, lane_in);
#undef STAGE_IDS
}

__device__ __forceinline__ void phaseR3(LDSP unsigned char* lds, const Params& p) {
    const int tid = opaque(threadIdx.x), wid = tid >> 6, lane = tid & 63, gp = wid >> 2, wg = wid & 3;
    LDSP unsigned char* lg = lds + gp * G_BYTES;
    LDSP unsigned* cnt = (LDSP unsigned*)(lg + G_CNT);
    if ((tid & 255) == 0) *cnt = 0u;
    __syncthreads();
    unsigned bt = 0u;
    unsigned FO[4], SO[4];
    { const unsigned base = LDS_ADDR(lg), r = lane & 31, hh = lane >> 5;
#pragma unroll
      for (int q = 0; q < 4; ++q) { FO[q] = base + r * 128u + ((((2u * q + hh) ^ (r >> 1)) & 7u) << 4); SO[q] = base + r * 128u + ((((unsigned)q ^ (r >> 1)) & 7u) << 4) + 8u * hh; } }
    for (int u = blockIdx.x * 2 + gp; u < 4096 + 256; u += gridDim.x * 2) rwkv_prep_group(lg, cnt, bt, p, u, wg, lane, FO, SO);
    __syncthreads();
}

constexpr size_t OFF_HT = OFF_YD;
__device__ __forceinline__ void scan_wave(const Params& p, int item, int lane) {
    const int chain = item >> 1, vb = item & 1, b = chain >> 5, h = (chain >> 1) & 15, d = chain & 1;
    const bf16_t* CM = (const bf16_t*)(p.ws + OFF_CM); const bf16_t* CN = (const bf16_t*)(p.ws + OFF_CN); bf16_t* HT = (bf16_t*)(p.ws + OFF_HT);
    u32x4 na[2][4], nn[2][2];
    auto chunk_of = [&](int step) { return (step < 4) ? (d ? 3 - step : step) : (d ? 4 + (67 - step) : step); };
    auto prefetch = [&](int step) {
        const size_t inst = (size_t)inst_index(b, h, d, chunk_of(step)) * 4096;
#pragma unroll
        for (int rt = 0; rt < 2; ++rt) {
#pragma unroll
            for (int s = 0; s < 4; ++s) na[rt][s] = *(const u32x4*)(CM + inst + ((rt * 4 + s) * 64 + lane) * 8);
#pragma unroll
            for (int g2 = 0; g2 < 2; ++g2) nn[rt][g2] = *(const u32x4*)(CN + inst + (((vb * 2 + rt) * 2 + g2) * 64 + lane) * 8);
        }
    };
    f32x16 hacc[2]; hacc[0] = zero16(); hacc[1] = zero16();
    prefetch(0);
#pragma unroll 1
    for (int step = 0; step < NCHUNK; ++step) {
        const int chunk_id = chunk_of(step);
        u32x4 a[2][4], n[2][2];
#pragma unroll
        for (int rt = 0; rt < 2; ++rt) {
#pragma unroll
            for (int s = 0; s < 4; ++s) a[rt][s] = na[rt][s];
            n[rt][0] = nn[rt][0]; n[rt][1] = nn[rt][1];
        }
        if (step + 1 < NCHUNK) prefetch(step + 1);
        bf16x8 bfr[4];
#pragma unroll
        for (int s = 0; s < 4; ++s) { const f32x16& t = hacc[s >> 1]; const int o = 8 * (s & 1);
            bfr[s] = __builtin_bit_cast(bf16x8, mk4u(pk2(t[o], t[o + 1]), pk2(t[o + 2], t[o + 3]), pk2(t[o + 4], t[o + 5]), pk2(t[o + 6], t[o + 7]))); }
        if (chunk_id >= 4) {
            bf16_t* hp = HT + (size_t)inst_index(b, h, d, chunk_id) * 4096 + (vb * 4 * 64 + lane) * 8;
#pragma unroll
            for (int s = 0; s < 4; ++s) *(bf16x8*)(hp + s * 512) = bfr[s];
        }
#pragma unroll
        for (int rt = 0; rt < 2; ++rt) {
            f32x16 acc;
#pragma unroll
            for (int g2 = 0; g2 < 2; ++g2) { const u32x4 w = n[rt][g2];
                acc[8 * g2] = bf2f(w.x & 0xffff); acc[8 * g2 + 1] = bf2f(w.x >> 16); acc[8 * g2 + 2] = bf2f(w.y & 0xffff); acc[8 * g2 + 3] = bf2f(w.y >> 16);
                acc[8 * g2 + 4] = bf2f(w.z & 0xffff); acc[8 * g2 + 5] = bf2f(w.z >> 16); acc[8 * g2 + 6] = bf2f(w.w & 0xffff); acc[8 * g2 + 7] = bf2f(w.w >> 16); }
#pragma unroll
            for (int s = 0; s < 4; ++s) acc = __builtin_amdgcn_mfma_f32_32x32x16_bf16(__builtin_bit_cast(bf16x8, a[rt][s]), bfr[s], acc, 0, 0, 0);
            hacc[rt] = acc;
        }
    }
}
__device__ __forceinline__ void phaseR4(LDSP unsigned char* lds, const Params& p) {
    const int tid = opaque(threadIdx.x), wid = tid >> 6, lane = tid & 63;
    LDSP int* nxt = (LDSP int*)(lds + SMEM_BYTES - 32);
    unsigned* qctr = (unsigned*)(p.ws + OFF_CTL + 16384 + 512);
    if ((int)blockIdx.x < 64 && gridDim.x >= 128) { if (wid < 2) scan_wave(p, blockIdx.x * 2 + wid, lane); }
    else if (gridDim.x < 128) { if (wid == 0) for (int it = blockIdx.x; it < 128; it += gridDim.x) scan_wave(p, it, lane); }
    for (;;) {
        __syncthreads();
        if (tid == 0) *nxt = (int)atomicAdd(qctr, 1u);
        __syncthreads();
        const int u = *nxt;
        if (u >= 512) break;
        attn_unit(lds, p, u);
    }
}

__device__ __forceinline__ void phaseR5(LDSP unsigned char* lds, const Params& p) {
    const int tid = opaque(threadIdx.x), wid = tid >> 6, lane = tid & 63, r = lane & 31, hh = lane >> 5;
    const bf16_t* CP = (const bf16_t*)(p.ws + OFF_CP); const bf16_t* CQ = (const bf16_t*)(p.ws + OFF_CQ); const bf16_t* HT = (const bf16_t*)(p.ws + OFF_HT);
    for (int wu = blockIdx.x * 8 + wid; wu < 2 * 64 * 16 * 2; wu += gridDim.x * 8) {
        const int half = wu & 1, u = wu >> 1, b = u >> 10, c = (u >> 4) & 63, h = u & 15;
        f32x16 y0 = zero16(), y1 = zero16();
#pragma unroll
        for (int d = 0; d < 2; ++d) {
            const size_t inst = (size_t)inst_index(b, h, d, 4 + c) * 4096;
            const int ii = d ? 63 - (32 * half + r) : (32 * half + r);
            const int it = ii >> 5, lp = hh * 32 + (ii & 31);
            f32x16 a0, a1;
#pragma unroll
            for (int g2 = 0; g2 < 2; ++g2) {
                const u32x4 w0 = *(const u32x4*)(CQ + inst + (((it * 2 + 0) * 2 + g2) * 64 + lp) * 8), w1 = *(const u32x4*)(CQ + inst + (((it * 2 + 1) * 2 + g2) * 64 + lp) * 8);
                a0[8 * g2] = bf2f(w0.x & 0xffff); a0[8 * g2 + 1] = bf2f(w0.x >> 16); a0[8 * g2 + 2] = bf2f(w0.y & 0xffff); a0[8 * g2 + 3] = bf2f(w0.y >> 16);
                a0[8 * g2 + 4] = bf2f(w0.z & 0xffff); a0[8 * g2 + 5] = bf2f(w0.z >> 16); a0[8 * g2 + 6] = bf2f(w0.w & 0xffff); a0[8 * g2 + 7] = bf2f(w0.w >> 16);
                a1[8 * g2] = bf2f(w1.x & 0xffff); a1[8 * g2 + 1] = bf2f(w1.x >> 16); a1[8 * g2 + 2] = bf2f(w1.y & 0xffff); a1[8 * g2 + 3] = bf2f(w1.y >> 16);
                a1[8 * g2 + 4] = bf2f(w1.z & 0xffff); a1[8 * g2 + 5] = bf2f(w1.z >> 16); a1[8 * g2 + 6] = bf2f(w1.w & 0xffff); a1[8 * g2 + 7] = bf2f(w1.w >> 16);
            }
#pragma unroll
            for (int s = 0; s < 4; ++s) {
                const bf16x8 pf = *(const bf16x8*)(CP + inst + ((it * 4 + s) * 64 + lp) * 8);
                const bf16x8 h0 = *(const bf16x8*)(HT + inst + ((0 * 4 + s) * 64 + lane) * 8), h1 = *(const bf16x8*)(HT + inst + ((1 * 4 + s) * 64 + lane) * 8);
                a0 = __builtin_amdgcn_mfma_f32_32x32x16_bf16(h0, pf, a0, 0, 0, 0);
                a1 = __builtin_amdgcn_mfma_f32_32x32x16_bf16(h1, pf, a1, 0, 0, 0);
            }
#pragma unroll
            for (int g = 0; g < 16; ++g) { y0[g] += a0[g]; y1[g] += a1[g]; }
        }
        const int tau = 32 * half + r; const size_t row = (size_t)b * T + c * 64 + tau;
        float sm = 0.f;
#pragma unroll
        for (int g = 0; g < 16; ++g) sm += y0[g] + y1[g];
        sm += __shfl_xor(sm, 32);
        const float mean = sm * (1.f / 64.f);
        float q2 = 0.f;
#pragma unroll
        for (int g = 0; g < 16; ++g) { y0[g] -= mean; y1[g] -= mean; q2 += y0[g] * y0[g] + y1[g] * y1[g]; }
        q2 += __shfl_xor(q2, 32);
        const float rstd = rsqrtf(q2 * (1.f / 64.f) + 64e-5f);
        const bf16_t* rs = (const bf16_t*)(p.ws + OFF_RS) + row * 1024 + h * 64; const bf16_t* ks = (const bf16_t*)(p.ws + OFF_KS) + row * 1024 + h * 64;
        const bf16_t* ai0 = (const bf16_t*)(p.ws + OFF_AIG) + row * 2048 + h * 64; const bf16_t* ai1 = ai0 + 1024;
        const bf16_t* vs = (const bf16_t*)(p.ws + OFF_VS) + row * 1024 + h * 64; const bf16_t* gg = (const bf16_t*)(p.ws + OFF_GG) + row * 1024 + h * 64;
        float bon = 0.f;
#pragma unroll
        for (int q = 0; q < 8; ++q) {
            const int ch = 32 * (q >> 2) + 8 * (q & 3) + 4 * hh;
            const u32x2 r2 = *(const u32x2*)(rs + ch), k2 = *(const u32x2*)(ks + ch), x2 = *(const u32x2*)(ai0 + ch), z2 = *(const u32x2*)(ai1 + ch);
            const f32x4 ka = *(const f32x4*)(p.k_a + h * 64 + ch), rk = *(const f32x4*)(p.r_k + h * 64 + ch);
            const float rr[4] = {bf2f(r2.x & 0xffff), bf2f(r2.x >> 16), bf2f(r2.y & 0xffff), bf2f(r2.y >> 16)}, kk[4] = {bf2f(k2.x & 0xffff), bf2f(k2.x >> 16), bf2f(k2.y & 0xffff), bf2f(k2.y >> 16)};
            const float xa[4] = {bf2f(x2.x & 0xffff), bf2f(x2.x >> 16), bf2f(x2.y & 0xffff), bf2f(x2.y >> 16)}, za[4] = {bf2f(z2.x & 0xffff), bf2f(z2.x >> 16), bf2f(z2.y & 0xffff), bf2f(z2.y >> 16)};
#pragma unroll
            for (int e = 0; e < 4; ++e) bon += rr[e] * (kk[e] * ((1.f + (xa[e] - 1.f) * ka[e]) + (1.f + (za[e] - 1.f) * ka[e]))) * rk[e];
        }
        bon += __shfl_xor(bon, 32);
        bf16_t* dst = (bf16_t*)(p.ws + OFF_MIX) + row * D + h * 64;
#pragma unroll
        for (int q = 0; q < 8; ++q) {
            const int ch = 32 * (q >> 2) + 8 * (q & 3) + 4 * hh, g0 = 4 * (q & 3);
            const f32x4 lg = *(const f32x4*)(p.lnx_g + h * 64 + ch), lb = *(const f32x4*)(p.lnx_b + h * 64 + ch);
            const u32x2 v2 = *(const u32x2*)(vs + ch), g2 = *(const u32x2*)(gg + ch);
            const float vv[4] = {bf2f(v2.x & 0xffff), bf2f(v2.x >> 16), bf2f(v2.y & 0xffff), bf2f(v2.y >> 16)}, gv[4] = {bf2f(g2.x & 0xffff), bf2f(g2.x >> 16), bf2f(g2.y & 0xffff), bf2f(g2.y >> 16)};
            float o[4];
#pragma unroll
            for (int e = 0; e < 4; ++e) { const float yv = (q < 4) ? y0[g0 + e] : y1[g0 + e]; o[e] = (yv * rstd * lg[e] + lb[e] + bon * vv[e]) * gv[e]; }
            *(u32x2*)(dst + ch) = mk2u(pk2(o[0], o[1]), pk2(o[2], o[3]));
        }
    }
}

__device__ __forceinline__ void phase6(LDSP unsigned char* lds, const Params& p) {
    pg8::Epi<FX1> epi{FX1{p.x, (const float*)(p.ws + OFF_MOD), (float*)(p.ws + OFF_X1)}};
    pg8::DenseSched S{(const char*)(p.ws + OFF_MIX), (const char*)(p.ws + OFF_WTOUT), NX / 256, D / 256, D, (int)gridDim.x, (int)blockIdx.x};
    pg8::gemm_phase<false>(lds, D, S, epi);
}

__device__ __forceinline__ void phase7(LDSP unsigned char* lds, const Params& p) {
    const int tid = opaque(threadIdx.x), wid = tid >> 6, lane = tid & 63;
    LDSP float* GS = (LDSP float*)lds;
    LDSP float* RSTD = (LDSP float*)(lds + 16384);
    LDSP float* PART = (LDSP float*)(lds + 16896);
    LDSP float* CB = (LDSP float*)(lds + 16896 + 65536);
    const float* MOD = (const float*)(p.ws + OFF_MOD);
    const float* X1 = (const float*)(p.ws + OFF_X1);
    bf16_t* H2 = (bf16_t*)(p.ws + OFF_H2);
    int* CNT = (int*)(p.ws + OFF_CTL + 16384);
    for (int u = blockIdx.x; u < NX / 32; u += gridDim.x) {
        const float* md = MOD + (size_t)((u * 32) >> 12) * 12288;
        for (int idx = tid; idx < D / 4; idx += 512) { const f32x4 g = *(const f32x4*)(p.norm2_g + 4 * idx), sh = *(const f32x4*)(md + 3 * D + 4 * idx), sc = *(const f32x4*)(md + 4 * D + 4 * idx);
            *(LDSP f32x4*)(GS + 4 * idx) = g * (sc + 1.f); *(LDSP f32x4*)(GS + D + 4 * idx) = sh; }
        __syncthreads();
#pragma unroll 1
        for (int rr = 0; rr < 4; ++rr) {
            const int t = 4 * wid + rr, row = u * 32 + t; const float* src = X1 + (size_t)row * D;
            f32x4 xv[8]; float ss = 0.f;
#pragma unroll
            for (int i = 0; i < 8; ++i) { xv[i] = ((const f32x4*)src)[lane + 64 * i]; ss += xv[i].x * xv[i].x + xv[i].y * xv[i].y + xv[i].z * xv[i].z + xv[i].w * xv[i].w; }
            ss = wave_sum(ss); const float rs = rsqrtf(ss * (1.f / D) + 1e-6f);
            if (lane == 0) RSTD[t] = rs;
#pragma unroll
            for (int i = 0; i < 8; ++i) { const int col = 4 * (lane + 64 * i);
                const f32x4 g = *(const LDSP f32x4*)(GS + col), sh = *(const LDSP f32x4*)(GS + D + col);
                const f32x4 hv = xv[i] * rs * g + sh;
                *(u32x2*)(H2 + (size_t)row * D + col) = mk2u(pk2(hv.x, hv.y), pk2(hv.z, hv.w)); }
        }
        {
            const int j = lane & 31, kk = lane >> 5, k0 = wid * 256;
            unsigned xoff = (unsigned)((u * 32 + j) * D + k0 + 4 * kk) * 4u;
            unsigned woff = (unsigned)((k0 + 4 * kk) * 64 + j) * 4u;
            unsigned goff = (unsigned)(k0 + 4 * kk) * 4u;
            f32x16 acc0 = zero16(), acc1 = zero16(); float c0 = 0.f, c1 = 0.f;
#pragma unroll 2
            for (int q = 0; q < 32; ++q) {
                const f32x4 xa = *(const f32x4*)((const char*)X1 + xoff);
                const f32x4 gv = *(const LDSP f32x4*)((const LDSP char*)GS + goff), sv = *(const LDSP f32x4*)((const LDSP char*)GS + D * 4 + goff);
                float b0[4], b1[4];
#pragma unroll
                for (int e = 0; e < 4; ++e) { b0[e] = *(const float*)((const char*)p.w_router + woff + e * 256); b1[e] = *(const float*)((const char*)p.w_router + woff + e * 256 + 128); }
#pragma unroll
                for (int e = 0; e < 4; ++e) {
                    acc0 = __builtin_amdgcn_mfma_f32_32x32x2f32(xa[e], b0[e] * gv[e], acc0, 0, 0, 0);
                    acc1 = __builtin_amdgcn_mfma_f32_32x32x2f32(xa[e], b1[e] * gv[e], acc1, 0, 0, 0);
                    c0 += sv[e] * b0[e]; c1 += sv[e] * b1[e];
                }
                xoff += 32u; woff += 2048u; goff += 32u;
            }
            c0 += __shfl_xor(c0, 32); c1 += __shfl_xor(c1, 32);
#pragma unroll
            for (int g = 0; g < 16; ++g) { const int t = crow(g, kk); PART[(wid * 32 + t) * 64 + j] = acc0[g]; PART[(wid * 32 + t) * 64 + 32 + j] = acc1[g]; }
            if (kk == 0) { CB[wid * 64 + j] = c0; CB[wid * 64 + 32 + j] = c1; }
        }
        __syncthreads();
        float cb = 0.f;
#pragma unroll
        for (int w = 0; w < 8; ++w) cb += CB[w * 64 + lane];
        const float eb = p.expert_bias[lane];
#pragma unroll 1
        for (int rr = 0; rr < 4; ++rr) {
            const int t = 4 * wid + rr, token = u * 32 + t;
            float sum = 0.f;
#pragma unroll
            for (int w = 0; w < 8; ++w) sum += PART[(w * 32 + t) * 64 + lane];
            const float logit = RSTD[t] * sum + cb;
            const float score = 1.f / (1.f + expf(-logit));
            const float v = score + eb;
            const int gi = lane >> 3;
            float m1 = v;
            m1 = fmaxf(m1, __shfl_xor(m1, 1)); m1 = fmaxf(m1, __shfl_xor(m1, 2)); m1 = fmaxf(m1, __shfl_xor(m1, 4));
            const unsigned long long eq = __ballot(v == m1);
            const unsigned gbits = (unsigned)((eq >> (gi * 8)) & 0xffull);
            const bool first = (lane & 7) == (__ffs((int)gbits) - 1);
            float v2 = first ? -INFINITY : v;
            v2 = fmaxf(v2, __shfl_xor(v2, 1)); v2 = fmaxf(v2, __shfl_xor(v2, 2)); v2 = fmaxf(v2, __shfl_xor(v2, 4));
            const float gs = m1 + v2;
            int gr = 0;
#pragma unroll
            for (int jj = 0; jj < 8; ++jj) { const float gj = __builtin_bit_cast(float, __builtin_amdgcn_readlane(__builtin_bit_cast(int, gs), jj * 8)); gr += (gj > gs || (gj == gs && jj < gi)) ? 1 : 0; }
            const float mv = (gr < 4) ? v : -INFINITY;
            int rk = 0;
#pragma unroll
            for (int j8 = 0; j8 < 8; ++j8) {
#pragma unroll
                for (int j1 = 0; j1 < 8; ++j1) { const int jj = 8 * j8 + j1; const float vj = __builtin_bit_cast(float, __builtin_amdgcn_readlane(__builtin_bit_cast(int, mv), jj)); rk += (vj > mv || (vj == mv && jj < lane)) ? 1 : 0; }
                __builtin_amdgcn_sched_barrier(0);
            }
            const bool sel = (rk < 8) && (gr < 4);
            const float gsum = wave_sum(sel ? score : 0.f);
            if (sel) {
                const int slot = atomicAdd(&CNT[lane], 1);
                ((int*)(p.ws + OFF_EIDX))[token * 8 + rk] = lane;
                ((int*)(p.ws + OFF_ESLOT))[token * 8 + rk] = slot;
                ((float*)(p.ws + OFF_GATE))[token * 8 + rk] = score / gsum * 2.5f;
                ((int*)(p.ws + OFF_TOKL))[(size_t)lane * NX + slot] = token;
            }
        }
        __syncthreads();
    }
}

constexpr int LE_TAB = 131072;
__device__ __forceinline__ void build_expert_tables(LDSP unsigned char* lds, const Params& p) {
    LDSP int* TP = (LDSP int*)(lds + LE_TAB); LDSP int* ST = TP + 72; LDSP int* CN = ST + 72;
    if (threadIdx.x < NEX) CN[threadIdx.x] = (threadIdx.x < NE) ? ((const int*)(p.ws + OFF_CTL + 16384))[threadIdx.x] : NX;
    __syncthreads();
    if (threadIdx.x == 0) {
        int tp = 0, st = 0;
        for (int e = 0; e < NEX; ++e) { const int cn = CN[e]; TP[e] = tp; ST[e] = st; tp += (cn + 255) >> 8; st += cn; }
        TP[NEX] = tp; ST[NEX] = st;
    }
    __syncthreads();
}

struct GroupSched {
    const LDSP int* TP; const LDSP int* ST; const LDSP int* CN;
    const char* A; const char* B; const int* tokl; int ntn, K, G, c; size_t bstride; bool gather;
    __device__ __forceinline__ bool next(int i, pg8::Unit& u) const {
        const int total = __builtin_amdgcn_readfirstlane(TP[NEX]) * ntn; const long L = (long)i * G + c; if (L >= total) return false;
        const int w = pg8::xcd_remap((int)L, total);
        const int nt = w % ntn, mtg = w / ntn;
        int e = 0, hi = NEX;
        while (hi - e > 1) { const int mid = (e + hi) >> 1; if (__builtin_amdgcn_readfirstlane(TP[mid]) <= mtg) e = mid; else hi = mid; }
        const int tpe = __builtin_amdgcn_readfirstlane(TP[e]), ste = __builtin_amdgcn_readfirstlane(ST[e]), cne = __builtin_amdgcn_readfirstlane(CN[e]);
        const int mt = mtg - tpe;
        u.B = B + (size_t)e * bstride + (size_t)nt * 256 * K * 2;
        u.nvalid = cne; u.m0 = mt * 256; u.pos0 = ste; u.row0 = 0; u.col0 = nt * 256;
        if (gather) { u.A = A; u.rowmap = (e < NE) ? tokl + (size_t)e * NX : nullptr; }
        else { u.A = A + (size_t)(ste + mt * 256) * K * 2; u.rowmap = nullptr; }
        return true;
    }
};
__device__ __forceinline__ void phase8(LDSP unsigned char* lds, const Params& p) {
    build_expert_tables(lds, p);
    const LDSP int* TP = (const LDSP int*)(lds + LE_TAB);
    pg8::Epi<FH1> epi{FH1{(bf16_t*)(p.ws + OFF_H1)}};
    GroupSched S{TP, TP + 72, TP + 144, (const char*)(p.ws + OFF_H2), (const char*)(p.ws + OFF_WTE1), (const int*)(p.ws + OFF_TOKL), 4, D, (int)gridDim.x, (int)blockIdx.x,
                 (size_t)1024 * 2048 * 2, true};
    pg8::gemm_phase<true>(lds, D, S, epi);
}
__device__ __forceinline__ void phase9(LDSP unsigned char* lds, const Params& p) {
    build_expert_tables(lds, p);
    const LDSP int* TP = (const LDSP int*)(lds + LE_TAB);
    pg8::Epi<FEO> epi{FEO{(bf16_t*)(p.ws + OFF_EO)}};
    GroupSched S{TP, TP + 72, TP + 144, (const char*)(p.ws + OFF_H1), (const char*)(p.ws + OFF_WTE2), nullptr, 8, EFF, (int)gridDim.x, (int)blockIdx.x,
                 (size_t)2048 * 512 * 2, false};
    pg8::gemm_phase<false, false>(lds, EFF, S, epi);
}
__device__ __forceinline__ void phase10(LDSP unsigned char* lds, const Params& p) {
    build_expert_tables(lds, p);
    const LDSP int* ST = (const LDSP int*)(lds + LE_TAB) + 72;
    const int tid = opaque(threadIdx.x), wid = tid >> 6, lane = tid & 63;
    const float* MOD = (const float*)(p.ws + OFF_MOD);
    const float* X1 = (const float*)(p.ws + OFF_X1);
    const bf16_t* EO = (const bf16_t*)(p.ws + OFF_EO);
    for (int row = blockIdx.x * 8 + wid; row < NX; row += gridDim.x * 8) {
        unsigned er[9]; float gw[9];
#pragma unroll
        for (int k = 0; k < 8; ++k) { const int e = ((const int*)(p.ws + OFF_EIDX))[row * 8 + k], sl = ((const int*)(p.ws + OFF_ESLOT))[row * 8 + k];
            er[k] = (unsigned)(ST[e] + sl) * (unsigned)D; gw[k] = ((const float*)(p.ws + OFF_GATE))[row * 8 + k]; }
        er[8] = (unsigned)(ST[NE] + row) * (unsigned)D; gw[8] = 1.f;
        const float* md = MOD + (size_t)(row >> 12) * 12288 + 5 * D;
        LDSP float* RB = (LDSP float*)lds + wid * 2048;
        float ss = 0.f;
#pragma unroll 2
        for (int i = 0; i < 8; ++i) { const int col = 4 * (lane + 64 * i);
            f32x4 a = mk4f(0.f, 0.f, 0.f, 0.f);
#pragma unroll
            for (int k = 0; k < 9; ++k) { const u32x2 w = *(const u32x2*)(EO + er[k] + col);
                a.x += gw[k] * bf2f(w.x & 0xffff); a.y += gw[k] * bf2f(w.x >> 16); a.z += gw[k] * bf2f(w.y & 0xffff); a.w += gw[k] * bf2f(w.y >> 16); }
            const f32x4 x1 = *(const f32x4*)(X1 + (size_t)row * D + col), g2 = *(const f32x4*)(md + col);
            f32x4 xv; xv.x = x1.x + g2.x * a.x; xv.y = x1.y + g2.y * a.y; xv.z = x1.z + g2.z * a.z; xv.w = x1.w + g2.w * a.w;
            ss += xv.x * xv.x + xv.y * xv.y + xv.z * xv.z + xv.w * xv.w;
            *(LDSP f32x4*)(RB + col) = xv; }
        ss = wave_sum(ss); const float rs = rsqrtf(ss * (1.f / D) + 1e-6f);
#pragma unroll 4
        for (int i = 0; i < 8; ++i) { const int col = 4 * (lane + 64 * i); const f32x4 g = *(const f32x4*)(p.final_g + col);
            const f32x4 xv = *(const LDSP f32x4*)(RB + col);
            f32x4 o; o.x = xv.x * rs * g.x; o.y = xv.y * rs * g.y; o.z = xv.z * rs * g.z; o.w = xv.w * rs * g.w;
            *(f32x4*)(p.out + (size_t)row * D + col) = o; }
    }
}


#define XB_TMO      128
#define XB_XCNT(j)  (256  + 64 * (j))
#define XB_XSUB(j)  (1280 + 64 * (j))
#define XB_XGEN(j)  (2304 + 64 * (j))
#define XB_TOP      3328
#define XB_TOPGEN   3392
#define XB_SPIN_CAP (1u << 20)
__device__ __forceinline__ unsigned xb_ld(unsigned* p)              { return __hip_atomic_load(p, __ATOMIC_RELAXED, __HIP_MEMORY_SCOPE_AGENT); }
__device__ __forceinline__ unsigned xb_add(unsigned* p, unsigned v) { return __hip_atomic_fetch_add(p, v, __ATOMIC_RELAXED, __HIP_MEMORY_SCOPE_AGENT); }
__device__ __forceinline__ unsigned xb_xcc_id() { return (unsigned)__builtin_amdgcn_s_getreg((3 << 11) | 20) & 0xFu; }
#define XB_SPIN(cond, bar) do { unsigned _sp = 0; while (cond) { __builtin_amdgcn_s_sleep(1); \
    if ((++_sp & 255u) == 0u) { if (xb_ld(&(bar)[XB_TMO])) break; if (_sp > XB_SPIN_CAP) { atomicAdd(&(bar)[XB_TMO], 1u); break; } } } } while (0)
__device__ __forceinline__ unsigned xcd_barrier_complete(unsigned* bar, unsigned x) {
    const unsigned G = gridDim.x * gridDim.y * gridDim.z;
    unsigned sum, cnt, mine, sp = 0u;
    for (;;) {
        sum = 0u; cnt = 0u; mine = 0u;
#pragma unroll
        for (unsigned j = 0; j < 16; ++j) { const unsigned c = xb_ld(&bar[XB_XCNT(j)]); sum += c; cnt += (c > 0u) ? 1u : 0u; mine = (j == x) ? c : mine; }
        if (sum == G) break;
        __builtin_amdgcn_s_sleep(1);
        if ((++sp & 255u) == 0u) { if (xb_ld(&bar[XB_TMO])) break; if (sp > XB_SPIN_CAP) { atomicAdd(&bar[XB_TMO], 1u); break; } }
    }
    return (mine > 0u ? mine : 1u) | ((cnt > 0u ? cnt : 1u) << 16);
}
__device__ __forceinline__ void xcd_barrier(unsigned* bar, unsigned x, volatile LDSP unsigned* st) {
    asm volatile("s_waitcnt vmcnt(0)" ::: "memory");
    __syncthreads();
    if (threadIdx.x == 0) {
        __builtin_amdgcn_s_waitcnt(0);
        unsigned pk = st[0];
        if (pk == 0u) { pk = xcd_barrier_complete(bar, x); st[0] = pk; }
        const unsigned nloc = pk & 0xffffu, nx = pk >> 16;
        const unsigned old = xb_add(&bar[XB_XSUB(x)], 1u);
        const unsigned gen = old / nloc;
        if (old + 1u == (gen + 1u) * nloc) {
            __builtin_amdgcn_fence(__ATOMIC_RELEASE, "agent");
            asm volatile("s_waitcnt vmcnt(0)" ::: "memory");
            const unsigned og = xb_add(&bar[XB_TOP], 1u);
            const unsigned tg = og / nx;
            if (og + 1u == (tg + 1u) * nx) xb_add(&bar[XB_TOPGEN], 1u);
            else XB_SPIN(xb_ld(&bar[XB_TOPGEN]) == tg, bar);
            __builtin_amdgcn_fence(__ATOMIC_ACQUIRE, "agent");
            xb_add(&bar[XB_XGEN(x)], 1u);
            asm volatile("s_waitcnt vmcnt(0)" ::: "memory");
        } else {
            XB_SPIN(xb_ld(&bar[XB_XGEN(x)]) == gen, bar);
            __builtin_amdgcn_fence(__ATOMIC_ACQUIRE, "agent");
            asm volatile("s_waitcnt vmcnt(0)" ::: "memory");
        }
    }
    __syncthreads();
}

__global__ void __launch_bounds__(512, 2) fwd_megakernel(Params p) {
    __shared__ __attribute__((aligned(16))) unsigned char smem_raw[SMEM_BYTES];
    LDSP unsigned char* lds = (LDSP unsigned char*)smem_raw;
    volatile LDSP unsigned* xst = (volatile LDSP unsigned*)(lds + SMEM_BYTES - 16);
    if (threadIdx.x == 0) { xst[0] = 0u; xst[1] = 0u; }
    __syncthreads();
    const unsigned xcc = xb_xcc_id();
    if (threadIdx.x == 0) (void)xb_add(&((unsigned*)p.ws)[XB_XCNT(xcc)], 1u);
#define GSYNC xcd_barrier((unsigned*)p.ws, xcc, xst)
#ifndef PH_TWICE
#define PH_TWICE 0
#endif
#ifndef PH_MASK
#define PH_MASK 0xffff
#endif
#define RUN_PHASE(bit, fn) _Pragma("unroll 1") for (int rep = 0; rep < ((PH_TWICE & (bit)) ? 2 : 1); ++rep) { if (rep) GSYNC; if (PH_MASK & (bit)) { Params q = p; q.ws = opq(p.ws); fn(lds, q); } }
    RUN_PHASE(1, phase0)      GSYNC;
    RUN_PHASE(2, phase1)      GSYNC;
    RUN_PHASE(4, phase2)      GSYNC;
    RUN_PHASE(8, phaseR1)     GSYNC;
    RUN_PHASE(16, phaseR2)    GSYNC;
    RUN_PHASE(32, phaseR3)    GSYNC;
    RUN_PHASE(64, phaseR4)    GSYNC;
    RUN_PHASE(128, phaseR5)   GSYNC;
    RUN_PHASE(256, phase6)    GSYNC;
    RUN_PHASE(512, phase7)    GSYNC;
    RUN_PHASE(1024, phase8)   GSYNC;
    RUN_PHASE(2048, phase9)   GSYNC;
    RUN_PHASE(4096, phase10)
}

extern "C" void kernel_launch(void* const* d_in, const int* in_sizes, int n_in, void* d_out, int out_size, void* d_ws, size_t ws_size, hipStream_t stream) {
    static int grid_blocks = 0;
    if (!grid_blocks) {
        int dev = 0, cus = 0, per_cu = 0;
        (void)hipGetDevice(&dev);
        (void)hipDeviceGetAttribute(&cus, hipDeviceAttributeMultiprocessorCount, dev);
        (void)hipOccupancyMaxActiveBlocksPerMultiprocessor(&per_cu, fwd_megakernel, 512, 0);
        if (per_cu > 1) per_cu = 1;
        grid_blocks = cus * per_cu;
        if (ws_size < WS_END) fprintf(stderr, "workspace too small: %zu < %zu\n", ws_size, (size_t)WS_END);
    }
    Params p{};
    const float** f = (const float**)&p;
    for (int i = 0; i < 31; ++i) f[i] = (const float*)d_in[i];
    p.out = (float*)d_out; p.ws = (unsigned char*)d_ws;
    (void)hipMemsetAsync(d_ws, 0, 32768, stream);
    void* args[] = {&p};
    hipError_t e = hipLaunchCooperativeKernel((void*)fwd_megakernel, dim3(grid_blocks), dim3(512), args, 0, stream);
    if (e != hipSuccess) fprintf(stderr, "cooperative launch failed: %s (grid %d)\n", hipGetErrorString(e), grid_blocks);
}
```

```cpp
#include <hip/hip_runtime.h>
#include <hip/hip_cooperative_groups.h>
#include <cstdio>
#include <cstdint>
namespace cg = cooperative_groups;

#define LDSP __attribute__((address_space(3)))
typedef unsigned short bf16_t;
typedef short bf16x8 __attribute__((ext_vector_type(8)));
typedef float f32x4 __attribute__((ext_vector_type(4)));
typedef float f32x16 __attribute__((ext_vector_type(16)));
typedef unsigned u32x4 __attribute__((ext_vector_type(4)));
typedef unsigned u32x2 __attribute__((ext_vector_type(2)));
__device__ __forceinline__ u32x4 mk4u(unsigned a, unsigned b, unsigned c, unsigned d) { u32x4 r; r.x = a; r.y = b; r.z = c; r.w = d; return r; }
__device__ __forceinline__ u32x2 mk2u(unsigned a, unsigned b) { u32x2 r; r.x = a; r.y = b; return r; }
__device__ __forceinline__ f32x4 mk4f(float a, float b, float c, float d) { f32x4 r; r.x = a; r.y = b; r.z = c; r.w = d; return r; }

constexpr int D = 2048, NB = 2, T = 4096, CL = 256, NX = NB * T, NCX = NB * CL, NR = NX + NCX;
constexpr int INC = 5056, INP = 5120;
constexpr int C_R = 0, C_K = 1024, C_V = 2048, C_XW = 3072, C_XA = 3168, C_XG = 3264, C_Q = 3520, C_AK = 4544, C_AV = 4800;
constexpr int NE = 64, NEX = 65, EFF = 512;
constexpr int NCHUNK = 68;
constexpr int NINST = NB * 16 * 2 * NCHUNK;
constexpr int EROWS = NX * 8 + NX;

constexpr size_t al4k(size_t x) { return (x + 4095) & ~(size_t)4095; }
constexpr size_t OFF_CTL = 0;
constexpr size_t OFF_ROPE = 65536;
constexpr size_t OFF_MODP = OFF_ROPE + 8192;
constexpr size_t OFF_MOD = al4k(OFF_MODP + (size_t)16 * 3 * 12288 * 4);
constexpr size_t OFF_WTDU = al4k(OFF_MOD + (size_t)3 * 12288 * 4);
constexpr size_t OFF_WTIU = OFF_WTDU + (size_t)2 * 1024 * 128 * 2;
constexpr size_t OFF_WTGU = OFF_WTIU + (size_t)2 * 1024 * 128 * 2;
constexpr size_t OFF_WTE2 = OFF_WTGU + (size_t)1024 * 256 * 2;
constexpr size_t OFF_X1 = OFF_WTE2 + (size_t)NEX * 2048 * 512 * 2;
constexpr size_t OFF_H2 = OFF_X1 + (size_t)NX * D * 4;
constexpr size_t OFF_TOKL = OFF_H2 + (size_t)NX * D * 2;
constexpr size_t OFF_EIDX = OFF_TOKL + (size_t)NE * NX * 4;
constexpr size_t OFF_ESLOT = OFF_EIDX + (size_t)NX * 8 * 4;
constexpr size_t OFF_GATE = OFF_ESLOT + (size_t)NX * 8 * 4;
constexpr size_t OFF_H1 = OFF_GATE + (size_t)NX * 8 * 4;
constexpr size_t OFF_WTE1 = al4k(OFF_H1 + (size_t)(EROWS + 256) * EFF * 2);
constexpr size_t OFF_EO = OFF_WTE1;
constexpr size_t OFF_WTIN = OFF_WTE1 + (size_t)NEX * 1024 * 2048 * 2;
constexpr size_t OFF_WTOUT = OFF_WTIN + (size_t)INP * D * 2;
constexpr size_t OFF_HX = OFF_WTOUT + (size_t)D * D * 2;
constexpr size_t OFF_PX = OFF_HX + (size_t)NR * D * 2;
constexpr size_t OFF_CM = OFF_PX + (size_t)NR * INP * 2;
constexpr size_t OFF_CN = OFF_CM + (size_t)NINST * 4096 * 2;
constexpr size_t OFF_CP = OFF_CN + (size_t)NINST * 4096 * 2;
constexpr size_t OFF_CQ = OFF_CP + (size_t)NINST * 4096 * 2;
constexpr size_t OFF_YD = OFF_CQ + (size_t)NINST * 4096 * 2;
constexpr size_t OFF_BON = OFF_YD + (size_t)2 * NX * 1024 * 4;
constexpr size_t OFF_MIX = OFF_BON + (size_t)2 * NX * 16 * 4;
constexpr size_t WS_END = OFF_MIX + (size_t)NX * D * 2;
constexpr size_t OFF_RS = OFF_X1;
constexpr size_t OFF_KS = OFF_RS + (size_t)NR * 1024 * 2;
constexpr size_t OFF_KK = OFF_KS + (size_t)NR * 1024 * 2;
constexpr size_t OFF_VS = OFF_KK + (size_t)NR * 1024 * 2;
constexpr size_t OFF_TW = OFF_VS + (size_t)NR * 1024 * 2;
constexpr size_t OFF_XA = OFF_TW + (size_t)NR * 128 * 2;
constexpr size_t OFF_SG = OFF_XA + (size_t)NR * 128 * 2;
constexpr size_t OFF_LWG = OFF_SG + (size_t)NX * 256 * 2;
constexpr size_t OFF_AIG = OFF_LWG + (size_t)NR * 2048 * 2;
constexpr size_t OFF_GG = OFF_AIG + (size_t)NR * 2048 * 2;
static_assert(OFF_GG + (size_t)NX * 1024 * 2 <= OFF_WTE1, "RWKV token buffers fit the overlay region");
static_assert(OFF_EO + (size_t)EROWS * D * 2 <= OFF_HX, "EO overlays only WT_E1/WT_IN/WT_OUT");
static_assert(WS_END <= (size_t)1073741824, "workspace map must fit 1 GiB");

constexpr int SMEM_BYTES = 157 * 1024;

struct Params {
    const float *x, *c, *ctx, *c_ctx, *w_mod, *b_mod, *norm1_g, *norm2_g, *w_in, *shift_mu, *k_k, *k_a, *r_k, *decay_bias, *decay_up, *iclr_bias, *iclr_up,
        *gate_up, *lnx_g, *lnx_b, *attn_sink, *w_out, *w_router, *expert_bias, *e_gate, *e_up, *e_down, *s_gate, *s_up, *s_down, *final_g;
    float* out;
    unsigned char* ws;
};

__device__ __forceinline__ unsigned f2bf(float f) { unsigned u = __float_as_uint(f); return (u + 0x7fffu + ((u >> 16) & 1u)) >> 16; }
__device__ __forceinline__ float bf2f(unsigned h) { return __uint_as_float(h << 16); }
typedef float f32x2_t __attribute__((ext_vector_type(2)));
typedef __bf16 bf16x2_t __attribute__((ext_vector_type(2)));
__device__ __forceinline__ unsigned pk2(float lo, float hi) { f32x2_t v = {lo, hi}; bf16x2_t b = __builtin_convertvector(v, bf16x2_t); return __builtin_bit_cast(unsigned, b); }
__device__ __forceinline__ float wave_sum(float v) {
#pragma unroll
    for (int o = 32; o > 0; o >>= 1) v += __shfl_xor(v, o);
    return v;
}
__device__ __forceinline__ int opaque(int x) { asm volatile("" : "+v"(x)); return x; }
__device__ __forceinline__ int opaque_s(int x) { asm volatile("" : "+s"(x)); return x; }
__device__ __forceinline__ unsigned char* opq(unsigned char* x) {
    unsigned long long v = (unsigned long long)x; asm volatile("" : "+s"(v));
    return (unsigned char*)(__attribute__((address_space(1))) unsigned char*)v; }
__device__ __forceinline__ float sigmoidf_(float x) { return __builtin_amdgcn_rcpf(1.f + __expf(-x)); }
__device__ __forceinline__ int lds_byte(int r, int c) { const int st = (r >> 4) * 2 + (c >> 5), rr = r & 15, cc = c & 31, ob = rr * 64 + cc * 2; return st * 1024 + (ob ^ (((ob >> 9) & 1) << 5)); }
__device__ __forceinline__ int sw64(int r, int k) { return r * 128 + ((((k >> 3) ^ (r >> 1)) & 7) << 4) + (k & 7) * 2; }

__device__ __forceinline__ f32x16 zero16() { f32x16 z;
#pragma unroll
    for (int i = 0; i < 16; ++i) z[i] = 0.f; return z; }
__device__ __forceinline__ int crow(int reg, int hi) { return (reg & 3) + 8 * (reg >> 2) + 4 * hi; }

namespace pg8 {
constexpr int BM = 256, BK = 64, HALF = 128, HTB = HALF * BK * 2, NXCD = 8;
__device__ __forceinline__ void stage_rc(int b, int& R, int& C) { const int st = b / 1024, sb = b % 1024, swz = sb ^ (((sb >> 9) & 1) << 5); R = (st >> 1) * 16 + swz / 64; C = (st & 1) * 32 + (swz % 64) / 2; }
struct Unit { const char* A; const char* B; const int* rowmap; int nvalid, m0, row0, col0, pos0; };
__device__ __forceinline__ int xcd_remap(int L, int nwg) { const int q = nwg / NXCD, r = nwg % NXCD, xcd = L % NXCD, off = L / NXCD; return (xcd < r ? xcd * (q + 1) : r * (q + 1) + (xcd - r) * q) + off; }

__device__ __forceinline__ int perm32(int rho) { const int n = rho >> 4, i = rho & 15; return 8 * (i >> 2) + 4 * n + (i & 3); }
template <class F> struct Epi {
    F f;
    __device__ __forceinline__ void operator()(const f32x4 (&acc)[2][2][4][2], const Unit& u, int wr, int wc, int fr, int fq) const {
#pragma unroll
        for (int ai = 0; ai < 2; ++ai)
#pragma unroll
            for (int m = 0; m < 4; ++m)
#pragma unroll
                for (int bj = 0; bj < 2; ++bj) { f(u, 128 * ai + 64 * wr + 16 * m + fr, 128 * bj + 32 * wc + 8 * fq, acc[ai][bj][m][0], acc[ai][bj][m][1]); __builtin_amdgcn_sched_barrier(0); }
    }
};

template <bool GATHER, bool ALIGN_EPI = true, class EpiT, class Sched>
__device__ __forceinline__ void gemm_phase(LDSP unsigned char* lds, const int K, const Sched& S, const EpiT& E) {
    const int tid = opaque(threadIdx.x), wid = __builtin_amdgcn_readfirstlane(tid >> 6), lane = tid & 63, wr = wid >> 2, wc = wid & 3, fr = lane & 15, fq = lane >> 4;
    const int nt = K / BK;
    unsigned voffA[2], voffB[2];
#pragma unroll
    for (int i = 0; i < 2; ++i) { int R, C; stage_rc(tid * 16 + i * 8192, R, C); const int Rb = (R & ~31) + perm32(R & 31); voffA[i] = (unsigned)(R * K + C) * 2u; voffB[i] = (unsigned)(Rb * K + C) * 2u; }
    const size_t kstep = (size_t)(BK * 2);
    const size_t hstep = (size_t)HALF * K * 2;
    const unsigned ldsw = (unsigned)wid * 1024u;
    const int aoff = lds_byte(wr * 64 + fr, fq * 8), boff = lds_byte(wc * 32 + fr, fq * 8);
#define PG8_SA(b, h) (((b) * 2 + (h)) * HTB)
#define PG8_SB(b, h) ((4 + (b) * 2 + (h)) * HTB)
#define PG8_STAGE(bufoff, gbase, voff) do { _Pragma("unroll") for (int _i = 0; _i < 2; ++_i) \
        __builtin_amdgcn_global_load_lds((const unsigned*)((const char*)(gbase) + (voff)[_i]), (LDSP unsigned*)(lds + (bufoff) + ldsw + _i * 8192), 16, 0, 0); } while (0)
#define PG8_STAGE_A(bufoff, nx, h, ubase, koff) do { if constexpr (GATHER) { unsigned _v[2]; const LDSP unsigned* _ro = rowoff + ((((nx) ? (ui + 1) : ui) & 1) * 4 + (h) * 2) * 512; _v[0] = _ro[0]; _v[1] = _ro[512]; PG8_STAGE(bufoff, (ubase) + (koff), _v); } \
        else { PG8_STAGE(bufoff, (ubase) + (h) * hstep + (koff), voffA); } } while (0)
#define PG8_LDA(dst, b, h) do { _Pragma("unroll") for (int m = 0; m < 4; ++m) _Pragma("unroll") for (int k = 0; k < 2; ++k) dst[m][k] = *(const LDSP bf16x8*)(lds + PG8_SA(b, h) + aoff + m * 2048 + k * 1024); } while (0)
#define PG8_LDB(dst, b, h) do { _Pragma("unroll") for (int n = 0; n < 2; ++n) _Pragma("unroll") for (int k = 0; k < 2; ++k) dst[n][k] = *(const LDSP bf16x8*)(lds + PG8_SB(b, h) + boff + n * 2048 + k * 1024); } while (0)
#define PG8_MMA(ai, bj, At, Bt) do { __builtin_amdgcn_s_setprio(1); _Pragma("unroll") for (int m = 0; m < 4; ++m) _Pragma("unroll") for (int n = 0; n < 2; ++n) _Pragma("unroll") for (int k = 0; k < 2; ++k) \
        acc[ai][bj][m][n] = __builtin_amdgcn_mfma_f32_16x16x32_bf16(Bt[n][k], At[m][k], acc[ai][bj][m][n], 0, 0, 0); __builtin_amdgcn_s_setprio(0); } while (0)
#define PG8_WAIT_V(n) asm volatile("s_waitcnt vmcnt(" #n ")" ::: "memory")
#define PG8_WAIT_L(n) asm volatile("s_waitcnt lgkmcnt(" #n ")" ::: "memory")
#define PG8_BAR __builtin_amdgcn_s_barrier()
#define PG8_SCHED __builtin_amdgcn_sched_barrier(0)
    Unit cur, nxt; int ui = 0;
    if (!S.next(0, cur)) return;
    LDSP unsigned* rowoff = (LDSP unsigned*)(lds + 132096) + tid;
    auto rows_of = [&](const Unit& u, int slot) {
        if constexpr (GATHER) {
#pragma unroll
            for (int h = 0; h < 2; ++h)
#pragma unroll
                for (int i = 0; i < 2; ++i) { int R, C; stage_rc(tid * 16 + i * 8192, R, C); const int idx = u.m0 + h * HALF + R; int gr = idx; if (u.rowmap) gr = (idx < u.nvalid) ? u.rowmap[idx] : 0;
                    rowoff[((slot & 1) * 4 + h * 2 + i) * 512] = (unsigned)(gr * K + C) * 2u; }
        }
    };
    rows_of(cur, 0);
    f32x4 acc[2][2][4][2];
#pragma unroll
    for (int a = 0; a < 2; ++a)
#pragma unroll
        for (int b = 0; b < 2; ++b)
#pragma unroll
            for (int m = 0; m < 4; ++m)
#pragma unroll
                for (int n = 0; n < 2; ++n) acc[a][b][m][n] = (f32x4){0.f, 0.f, 0.f, 0.f};
    bf16x8 At[4][2], B0[2][2], B1[2][2];
    const char* cA = cur.A; const char* cB = cur.B;
    PG8_STAGE(PG8_SB(0, 0), cB, voffB); PG8_STAGE(PG8_SB(0, 1), cB + hstep, voffB); PG8_STAGE_A(PG8_SA(0, 0), false, 0, cA, 0); PG8_STAGE_A(PG8_SA(0, 1), false, 1, cA, 0);
    if (wr == 1) PG8_BAR;
    PG8_WAIT_V(2); PG8_BAR;
    PG8_STAGE(PG8_SB(1, 0), cB + kstep, voffB); PG8_STAGE_A(PG8_SA(1, 0), false, 0, cA, kstep); PG8_STAGE(PG8_SB(1, 1), cB + hstep + kstep, voffB);
    PG8_WAIT_V(6); PG8_BAR;
    for (;;) {
        const bool has_next = S.next(ui + 1, nxt);
        rows_of(has_next ? nxt : cur, ui + 1);
        const char* nA = has_next ? nxt.A : cA; const char* nB = has_next ? nxt.B : cB;
#pragma unroll 1
        for (int t = 0; t < nt; t += 2) {
            const bool last = (t == nt - 2);
            const size_t k1 = (size_t)(t + 1) * kstep;
            const char* a2 = last ? nA : cA; const size_t k2 = last ? 0 : (size_t)(t + 2) * kstep;
            const char* b2 = last ? nB : cB + (size_t)(t + 2) * kstep;
            const char* b3 = b2 + kstep;
            PG8_LDB(B0, 0, 0); PG8_LDB(B1, 0, 1); PG8_SCHED; PG8_LDA(At, 0, 0); PG8_STAGE_A(PG8_SA(1, 1), false, 1, cA, k1);
            PG8_WAIT_V(8); PG8_WAIT_L(0); PG8_BAR; PG8_MMA(0, 0, At, B0); PG8_MMA(0, 1, At, B1); PG8_BAR; PG8_SCHED;
            PG8_LDA(At, 0, 1); PG8_STAGE(PG8_SB(0, 0), b2, voffB); PG8_STAGE(PG8_SB(0, 1), b2 + hstep, voffB); PG8_STAGE_A(PG8_SA(0, 0), last, 0, a2, k2);
            PG8_WAIT_V(8); PG8_WAIT_L(0); PG8_BAR; PG8_MMA(1, 0, At, B0); PG8_MMA(1, 1, At, B1); PG8_BAR; PG8_SCHED;
            PG8_LDB(B0, 1, 0); PG8_LDB(B1, 1, 1); PG8_SCHED; PG8_LDA(At, 1, 0); PG8_STAGE_A(PG8_SA(0, 1), last, 1, a2, k2);
            PG8_WAIT_V(8); PG8_WAIT_L(0); PG8_BAR; PG8_MMA(0, 0, At, B0); PG8_MMA(0, 1, At, B1); PG8_BAR; PG8_SCHED;
            PG8_LDA(At, 1, 1); PG8_STAGE(PG8_SB(1, 0), b3, voffB); PG8_STAGE(PG8_SB(1, 1), b3 + hstep, voffB); PG8_STAGE_A(PG8_SA(1, 0), last, 0, a2, k2 + kstep);
            PG8_WAIT_V(8); PG8_WAIT_L(0); PG8_BAR; PG8_MMA(1, 0, At, B0); PG8_MMA(1, 1, At, B1); PG8_BAR; PG8_SCHED;
        }
        if constexpr (ALIGN_EPI) { if (wr == 0) PG8_BAR; }
        E(acc, cur, wr, wc, fr, fq);
        if (!has_next) break;
#pragma unroll
        for (int a = 0; a < 2; ++a)
#pragma unroll
            for (int b = 0; b < 2; ++b)
#pragma unroll
                for (int m = 0; m < 4; ++m)
#pragma unroll
                    for (int n = 0; n < 2; ++n) acc[a][b][m][n] = (f32x4){0.f, 0.f, 0.f, 0.f};
        cur = nxt; cA = nA; cB = nB; ++ui;
        if constexpr (ALIGN_EPI) { if (wr == 1) PG8_BAR; }
    }
    PG8_WAIT_V(0);
    if constexpr (!ALIGN_EPI) { if (wr == 0) PG8_BAR; }
    PG8_BAR;
#undef PG8_SA
#undef PG8_SB
#undef PG8_STAGE
#undef PG8_STAGE_A
#undef PG8_LDA
#undef PG8_LDB
#undef PG8_MMA
#undef PG8_WAIT_V
#undef PG8_WAIT_L
#undef PG8_BAR
#undef PG8_SCHED
}

struct DenseSched {
    const char* A; const char* B; int nM, nN, K, G, c;
    __device__ __forceinline__ bool next(int i, Unit& u) const {
        const int nwg = nM * nN; const long L = (long)i * G + c; if (L >= nwg) return false;
        const int wgid = xcd_remap((int)L, nwg);
        const int nig = 8 * nN, gid = wgid / nig, fm = gid * 8, gsz = (nM - fm) < 8 ? (nM - fm) : 8;
        const int pm = fm + ((wgid % nig) % gsz), pn = (wgid % nig) / gsz;
        u.A = A + (size_t)pm * 256 * K * 2; u.B = B + (size_t)pn * 256 * K * 2; u.rowmap = nullptr; u.nvalid = 0; u.m0 = 0; u.row0 = pm * 256; u.col0 = pn * 256; u.pos0 = 0;
        return true;
    }
};
}

struct FPX { bf16_t* PX; __device__ __forceinline__ void operator()(const pg8::Unit& u, int lr, int lc, f32x4 v0, f32x4 v1) const {
    *(u32x4*)(PX + (size_t)(u.row0 + lr) * INP + u.col0 + lc) = mk4u(pk2(v0[0], v0[1]), pk2(v0[2], v0[3]), pk2(v1[0], v1[1]), pk2(v1[2], v1[3])); } };
struct FX1 { const float* x; const float* mod; float* X1; __device__ __forceinline__ void operator()(const pg8::Unit& u, int lr, int lc, f32x4 v0, f32x4 v1) const {
    const int row = u.row0 + lr, col = u.col0 + lc; const float* xp = x + (size_t)row * D + col; const float* gp = mod + (size_t)(row >> 12) * 12288 + 2 * D + col; float* op = X1 + (size_t)row * D + col;
    *(f32x4*)op = *(const f32x4*)xp + *(const f32x4*)gp * v0; *(f32x4*)(op + 4) = *(const f32x4*)(xp + 4) + *(const f32x4*)(gp + 4) * v1; } };
struct FH1 { bf16_t* H1; __device__ __forceinline__ void operator()(const pg8::Unit& u, int lr, int lc, f32x4 v0, f32x4 v1) const {
    if (u.m0 + lr < u.nvalid) { float h[4];
#pragma unroll
        for (int e = 0; e < 4; ++e) h[e] = v0[e] * sigmoidf_(v0[e]) * v1[e];
        *(u32x2*)(H1 + (size_t)(u.pos0 + u.m0 + lr) * EFF + ((u.col0 + lc) >> 1)) = mk2u(pk2(h[0], h[1]), pk2(h[2], h[3])); } } };
struct FEO { bf16_t* EO; __device__ __forceinline__ void operator()(const pg8::Unit& u, int lr, int lc, f32x4 v0, f32x4 v1) const {
    if (u.m0 + lr < u.nvalid) *(u32x4*)(EO + (size_t)(u.pos0 + u.m0 + lr) * D + u.col0 + lc) = mk4u(pk2(v0[0], v0[1]), pk2(v0[2], v0[3]), pk2(v1[0], v1[1]), pk2(v1[2], v1[3])); } };

struct ConvJob { const float* src; bf16_t* dst; int K, N, ld, mode, ntk, ntn; size_t sbs, dbs; };
__device__ __forceinline__ int conv_row(int n, int mode) { return mode == 0 ? n : (8 * (n >> 2) + (n & 3) + (mode == 2 ? 4 : 0)); }

struct TileCtx { const float* src; bf16_t* dst; int N, ld, mode, k0, n0; };
constexpr int CT0 = 0, CT1 = CT0 + 8 * (INC / 64), CT2 = CT1 + 8 * 32, CT3 = CT2 + 64 * 64, CT4 = CT3 + 64 * 64, CT5 = CT4 + 64 * 64, CT6 = CT5 + 64, CT7 = CT6 + 64, CT8 = CT7 + 64, CT_END = CT8 + 16;
__device__ __forceinline__ void conv_decode(const Params& p, int g, const float*& src, bf16_t*& dst, int& N, int& ld, int& mode, int& k0, int& n0) {
    bf16_t* WTE1 = (bf16_t*)(p.ws + OFF_WTE1); bf16_t* WTE2 = (bf16_t*)(p.ws + OFF_WTE2);
    int t, ntk, ntn; size_t sbs = 0, dbs = 0;
    if (g < CT1)      { t = g - CT0; src = p.w_in; dst = (bf16_t*)(p.ws + OFF_WTIN); N = INC; ld = 2048; mode = 0; ntk = 8; ntn = INC / 64; }
    else if (g < CT2) { t = g - CT1; src = p.w_out; dst = (bf16_t*)(p.ws + OFF_WTOUT); N = 2048; ld = 2048; mode = 0; ntk = 8; ntn = 32; }
    else if (g < CT3) { t = g - CT2; src = p.e_gate; dst = WTE1; N = 512; ld = 2048; mode = 1; ntk = 8; ntn = 8; sbs = (size_t)2048 * 512; dbs = (size_t)1024 * 2048; }
    else if (g < CT4) { t = g - CT3; src = p.e_up; dst = WTE1; N = 512; ld = 2048; mode = 2; ntk = 8; ntn = 8; sbs = (size_t)2048 * 512; dbs = (size_t)1024 * 2048; }
    else if (g < CT5) { t = g - CT4; src = p.e_down; dst = WTE2; N = 2048; ld = 512; mode = 0; ntk = 2; ntn = 32; sbs = (size_t)512 * 2048; dbs = (size_t)2048 * 512; }
    else if (g < CT6) { t = g - CT5; src = p.s_gate; dst = WTE1 + (size_t)64 * 1024 * 2048; N = 512; ld = 2048; mode = 1; ntk = 8; ntn = 8; }
    else if (g < CT7) { t = g - CT6; src = p.s_up; dst = WTE1 + (size_t)64 * 1024 * 2048; N = 512; ld = 2048; mode = 2; ntk = 8; ntn = 8; }
    else if (g < CT8) { t = g - CT7; src = p.s_down; dst = WTE2 + (size_t)64 * 2048 * 512; N = 2048; ld = 512; mode = 0; ntk = 2; ntn = 32; }
    else              { t = g - CT8; src = p.gate_up; dst = (bf16_t*)(p.ws + OFF_WTGU); N = 1024; ld = 256; mode = 0; ntk = 1; ntn = 16; }
    const int per = ntk * ntn, bi = t / per, rem = t - bi * per, kt = rem / ntn, ntile = rem - kt * ntn;
    src += (size_t)bi * sbs; dst += (size_t)bi * dbs; k0 = kt * 256; n0 = ntile * 64;
}
__device__ __forceinline__ void conv_load(const float* src, int N, int k0, int n0, f32x4 (&v)[4][2], int tid) {
    const int kr = tid >> 3, nc = (tid & 7) * 8;
#pragma unroll
    for (int s = 0; s < 4; ++s) { const float* q = src + (size_t)(k0 + s * 64 + kr) * N + n0 + nc; v[s][0] = *(const f32x4*)q; v[s][1] = *(const f32x4*)(q + 4); }
}
__device__ __forceinline__ void conv_finish(LDSP unsigned char* lds, bf16_t* dst, int ld, int mode, int k0, int n0, const f32x4 (&v)[4][2], int tid) {
    LDSP float* Tm = (LDSP float*)lds;
    {
        const int kr = tid >> 3, nc = (tid & 7) * 8;
#pragma unroll
        for (int s = 0; s < 4; ++s) { LDSP float* q = Tm + (s * 64 + kr) * 65 + nc;
            q[0] = v[s][0].x; q[1] = v[s][0].y; q[2] = v[s][0].z; q[3] = v[s][0].w; q[4] = v[s][1].x; q[5] = v[s][1].y; q[6] = v[s][1].z; q[7] = v[s][1].w; }
    }
    __syncthreads();
    {
        const int n = tid >> 3; bf16_t* drow = dst + (size_t)conv_row(n0 + n, mode) * ld + k0;
#pragma unroll
        for (int s = 0; s < 4; ++s) { const int kc = ((tid & 7) + 8 * s) * 8; float f[8];
#pragma unroll
            for (int j = 0; j < 8; ++j) f[j] = Tm[(kc + j) * 65 + n];
            u32x4 w; w.x = pk2(f[0], f[1]); w.y = pk2(f[2], f[3]); w.z = pk2(f[4], f[5]); w.w = pk2(f[6], f[7]); *(u32x4*)(drow + kc) = w; }
    }
    __syncthreads();
}

__device__ __forceinline__ void mod_item(LDSP unsigned char* lds, const Params& p, int item) {
    const int kb = item >> 6, nb = item & 63, tid = opaque(threadIdx.x), wid = tid >> 6, lane = tid & 63;
    f32x4 acc[3];
#pragma unroll
    for (int v = 0; v < 3; ++v) acc[v] = mk4f(0.f, 0.f, 0.f, 0.f);
    if (lane < 48) {
#pragma unroll 8
        for (int i = 0; i < 64; ++i) {
            const int k = kb * 512 + wid * 64 + i;
            const float c0 = p.c[k], c1 = p.c[D + k], c2 = p.c_ctx[k];
            const float s0 = c0 * sigmoidf_(c0), s1 = c1 * sigmoidf_(c1), s2 = c2 * sigmoidf_(c2);
            const f32x4 w = *(const f32x4*)(p.w_mod + (size_t)k * 12288 + nb * 192 + 4 * lane);
            acc[0] += s0 * w; acc[1] += s1 * w; acc[2] += s2 * w;
        }
    }
    LDSP float* R = (LDSP float*)lds;
    if (lane < 48) {
#pragma unroll
        for (int v = 0; v < 3; ++v) *(LDSP f32x4*)(R + (wid * 3 + v) * 192 + 4 * lane) = acc[v];
    }
    __syncthreads();
    float* MODP = (float*)(p.ws + OFF_MODP);
    for (int o = tid; o < 3 * 192; o += 512) { const int v = o / 192, cidx = o - v * 192; float sum = 0.f;
#pragma unroll
        for (int w = 0; w < 8; ++w) sum += R[(w * 3 + v) * 192 + cidx];
        MODP[((size_t)kb * 3 + v) * 12288 + nb * 192 + cidx] = sum; }
    __syncthreads();
}

__device__ __forceinline__ void conv_range(LDSP unsigned char* lds, const Params& p, int g0, int g1, int rank, int nblk) {
    const int tid = opaque(threadIdx.x);
    int g = g0 + rank;
    const float* csrc = nullptr; bf16_t* cdst = nullptr; int cN = 0, cld = 0, cmode = 0, ck0 = 0, cn0 = 0;
    const float* nsrc = nullptr; bf16_t* ndst = nullptr; int nN = 0, nld = 0, nmode = 0, nk0 = 0, nn0 = 0;
    f32x4 va[4][2], vb[4][2];
    if (g < g1) { conv_decode(p, g, csrc, cdst, cN, cld, cmode, ck0, cn0); conv_load(csrc, cN, ck0, cn0, va, tid); }
#pragma unroll 1
    while (g < g1) {
        const int gn = g + nblk;
        if (gn < g1) { conv_decode(p, gn, nsrc, ndst, nN, nld, nmode, nk0, nn0); conv_load(nsrc, nN, nk0, nn0, vb, tid); }
        conv_finish(lds, cdst, cld, cmode, ck0, cn0, va, tid);
        cdst = ndst; cld = nld; cmode = nmode; ck0 = nk0; cn0 = nn0; g = gn;
#pragma unroll
        for (int s = 0; s < 4; ++s) { va[s][0] = vb[s][0]; va[s][1] = vb[s][1]; }
    }
}

__device__ __forceinline__ void phase0(LDSP unsigned char* lds, const Params& p) {
    const int tid = opaque(threadIdx.x);
    for (int it = blockIdx.x; it < 256; it += gridDim.x) mod_item(lds, p, it);
    conv_range(lds, p, 0, CT1, blockIdx.x, gridDim.x);
    conv_range(lds, p, CT8, CT_END, blockIdx.x, gridDim.x);
    {
        const int total = 4 * 1024 * 128;
        for (int idx = blockIdx.x * 512 + tid; idx < total; idx += gridDim.x * 512) {
            const int mtx = idx >> 17, rem = idx & 131071, n = rem >> 7, k = rem & 127;
            const float* src = (mtx < 2 ? p.decay_up : p.iclr_up) + (size_t)(mtx & 1) * 96 * 1024;
            bf16_t* dst = (bf16_t*)(p.ws + (mtx < 2 ? OFF_WTDU : OFF_WTIU)) + (size_t)(mtx & 1) * 1024 * 128;
            dst[n * 128 + k] = (bf16_t)f2bf(k < 96 ? src[(size_t)k * 1024 + n] : 0.f);
        }
    }
    {
        u32x4* z = (u32x4*)((bf16_t*)(p.ws + OFF_WTIN) + (size_t)INC * D);
        const int total = (INP - INC) * D * 2 / 16;
        for (int idx = blockIdx.x * 512 + tid; idx < total; idx += gridDim.x * 512) z[idx] = mk4u(0, 0, 0, 0);
    }
    if (blockIdx.x == gridDim.x - 1) {
        float2* R = (float2*)(p.ws + OFF_ROPE);
        for (int idx = tid; idx < 1024; idx += 512) { const int pos = idx >> 4, f = idx & 15;
            const float freq = powf(10000.f, -(float)f / 16.f); const float ang = (float)pos * freq; R[idx] = make_float2(cosf(ang), sinf(ang)); }
    }
}

__device__ __forceinline__ void phase1(LDSP unsigned char* lds, const Params& p) {
    const int tid = opaque(threadIdx.x), wid = tid >> 6, lane = tid & 63;
    const float* MODP = (const float*)(p.ws + OFF_MODP);
    float* MOD = (float*)(p.ws + OFF_MOD);
    LDSP float* MV = (LDSP float*)lds;
    for (int idx = tid; idx < 3 * 4096; idx += 512) { const int v = idx >> 12, col = idx & 4095; float s = p.b_mod[col];
#pragma unroll
        for (int kb = 0; kb < 4; ++kb) s += MODP[((size_t)kb * 3 + v) * 12288 + col];
        MV[idx] = s; }
    for (int idx = blockIdx.x * 512 + tid; idx < 3 * 12288; idx += gridDim.x * 512) { const int v = idx / 12288, col = idx - v * 12288; float s = p.b_mod[col];
#pragma unroll
        for (int kb = 0; kb < 4; ++kb) s += MODP[((size_t)kb * 3 + v) * 12288 + col];
        MOD[idx] = s; }
    __syncthreads();
    bf16_t* HX = (bf16_t*)(p.ws + OFF_HX);
    for (int row = blockIdx.x * 8 + wid; row < NR; row += gridDim.x * 8) {
        const float* src = row < NX ? p.x + (size_t)row * D : p.ctx + (size_t)(row - NX) * D;
        const int v = row < NX ? (row >> 12) : 2;
        f32x4 xv[8]; float ss = 0.f;
#pragma unroll
        for (int i = 0; i < 8; ++i) { xv[i] = ((const f32x4*)src)[lane + 64 * i]; ss += xv[i].x * xv[i].x + xv[i].y * xv[i].y + xv[i].z * xv[i].z + xv[i].w * xv[i].w; }
        ss = wave_sum(ss);
        const float rs = rsqrtf(ss * (1.f / D) + 1e-6f);
#pragma unroll
        for (int i = 0; i < 8; ++i) { const int col = 4 * (lane + 64 * i);
            const f32x4 g = *(const f32x4*)(p.norm1_g + col); const LDSP float* sh = MV + v * 4096 + col; const LDSP float* sc = sh + 2048;
            const float h0 = xv[i].x * rs * g.x * (1.f + sc[0]) + sh[0], h1 = xv[i].y * rs * g.y * (1.f + sc[1]) + sh[1];
            const float h2 = xv[i].z * rs * g.z * (1.f + sc[2]) + sh[2], h3 = xv[i].w * rs * g.w * (1.f + sc[3]) + sh[3];
            u32x2 w; w.x = pk2(h0, h1); w.y = pk2(h2, h3); *(u32x2*)(HX + (size_t)row * D + col) = w; }
    }
}

__device__ __forceinline__ void phase2(LDSP unsigned char* lds, const Params& p) {
    pg8::Epi<FPX> epi{FPX{(bf16_t*)(p.ws + OFF_PX)}};
    pg8::DenseSched S{(const char*)(p.ws + OFF_HX), (const char*)(p.ws + OFF_WTIN), NR / 256, INP / 256, D, (int)gridDim.x, (int)blockIdx.x};
    pg8::gemm_phase<false>(lds, D, S, epi);
}

__device__ __forceinline__ void phaseR1(LDSP unsigned char* lds, const Params& p) {
    const int tid = opaque(threadIdx.x), wid = tid >> 6, lane = tid & 63;
    const bf16_t* PX = (const bf16_t*)(p.ws + OFF_PX);
    for (int row = blockIdx.x * 8 + wid; row < NR; row += gridDim.x * 8) {
        const bool isx = row < NX;
        const int s0 = isx ? (row & ~(T - 1)) : NX + ((row - NX) & ~(CL - 1)), len = isx ? T : CL;
        const bool hp = row > s0, hn = row + 1 < s0 + len;
        const bf16_t* pc = PX + (size_t)row * INP;
#pragma unroll 1
        for (int it = 0; it < 7; ++it) {
            const int ch = lane + 64 * it;
            if (ch < 440) {
                const int col = ch * 8;
                const u32x4 c4 = *(const u32x4*)(pc + col);
                u32x4 p4 = mk4u(0, 0, 0, 0), n4 = mk4u(0, 0, 0, 0);
                if (hp) p4 = *(const u32x4*)(pc - INP + col);
                if (hn) n4 = *(const u32x4*)(pc + INP + col);
                const f32x4 m0 = *(const f32x4*)(p.shift_mu + col), m1 = *(const f32x4*)(p.shift_mu + col + 4);
                const float mu[8] = {m0.x, m0.y, m0.z, m0.w, m1.x, m1.y, m1.z, m1.w};
                const unsigned cw[4] = {c4.x, c4.y, c4.z, c4.w}, pw[4] = {p4.x, p4.y, p4.z, p4.w}, nw[4] = {n4.x, n4.y, n4.z, n4.w};
                float v[8];
#pragma unroll
                for (int j = 0; j < 4; ++j) {
                    const float c0 = bf2f(cw[j] & 0xffff), c1 = bf2f(cw[j] >> 16);
                    v[2 * j] = c0 + mu[2 * j] * (0.5f * (bf2f(pw[j] & 0xffff) + bf2f(nw[j] & 0xffff)) - c0);
                    v[2 * j + 1] = c1 + mu[2 * j + 1] * (0.5f * (bf2f(pw[j] >> 16) + bf2f(nw[j] >> 16)) - c1);
                }
                if (it < 2) {
                    *(u32x4*)((bf16_t*)(p.ws + OFF_RS) + (size_t)row * 1024 + col) = mk4u(pk2(v[0], v[1]), pk2(v[2], v[3]), pk2(v[4], v[5]), pk2(v[6], v[7]));
                } else if (it < 4) {
                    const int kc = col - C_K;
                    *(u32x4*)((bf16_t*)(p.ws + OFF_KS) + (size_t)row * 1024 + kc) = mk4u(pk2(v[0], v[1]), pk2(v[2], v[3]), pk2(v[4], v[5]), pk2(v[6], v[7]));
                    const f32x4 k0 = *(const f32x4*)(p.k_k + kc), k1 = *(const f32x4*)(p.k_k + kc + 4);
                    const float kq[8] = {k0.x, k0.y, k0.z, k0.w, k1.x, k1.y, k1.z, k1.w};
                    float ss = 0.f;
#pragma unroll
                    for (int j = 0; j < 8; ++j) { v[j] *= kq[j]; ss += v[j] * v[j]; }
                    ss += __shfl_xor(ss, 1); ss += __shfl_xor(ss, 2); ss += __shfl_xor(ss, 4);
                    const float sc = rsqrtf(ss + 1e-12f);
                    *(u32x4*)((bf16_t*)(p.ws + OFF_KK) + (size_t)row * 1024 + kc) = mk4u(pk2(v[0] * sc, v[1] * sc), pk2(v[2] * sc, v[3] * sc), pk2(v[4] * sc, v[5] * sc), pk2(v[6] * sc, v[7] * sc));
                } else if (it < 6) {
                    *(u32x4*)((bf16_t*)(p.ws + OFF_VS) + (size_t)row * 1024 + col - C_V) = mk4u(pk2(v[0], v[1]), pk2(v[2], v[3]), pk2(v[4], v[5]), pk2(v[6], v[7]));
                } else if (ch < 396) {
#pragma unroll
                    for (int j = 0; j < 8; ++j) v[j] = tanhf(v[j]);
                    *(u32x4*)((bf16_t*)(p.ws + OFF_TW) + (size_t)row * 128 + col - C_XW) = mk4u(pk2(v[0], v[1]), pk2(v[2], v[3]), pk2(v[4], v[5]), pk2(v[6], v[7]));
                } else if (ch < 408) {
                    *(u32x4*)((bf16_t*)(p.ws + OFF_XA) + (size_t)row * 128 + col - C_XA) = mk4u(pk2(v[0], v[1]), pk2(v[2], v[3]), pk2(v[4], v[5]), pk2(v[6], v[7]));
                } else if (isx) {
#pragma unroll
                    for (int j = 0; j < 8; ++j) v[j] = sigmoidf_(v[j]);
                    *(u32x4*)((bf16_t*)(p.ws + OFF_SG) + (size_t)row * 256 + col - C_XG) = mk4u(pk2(v[0], v[1]), pk2(v[2], v[3]), pk2(v[4], v[5]), pk2(v[6], v[7]));
                }
            }
        }
        if (lane < 4) { *(u32x4*)((bf16_t*)(p.ws + OFF_TW) + (size_t)row * 128 + 96 + lane * 8) = mk4u(0, 0, 0, 0); *(u32x4*)((bf16_t*)(p.ws + OFF_XA) + (size_t)row * 128 + 96 + lane * 8) = mk4u(0, 0, 0, 0); }
    }
}

struct LoraSched {
    const char *A0, *B0, *A1, *B1; int G, c;
    __device__ __forceinline__ bool next(int i, pg8::Unit& u) const {
        const int per = (NR / 256) * 8; const long L = (long)i * G + c; if (L >= 2 * per) return false;
        const int job = (int)L / per, w = (int)L % per, pm = w >> 3, pn = w & 7;
        u.A = (job ? A1 : A0) + (size_t)pm * 256 * 128 * 2; u.B = (job ? B1 : B0) + (size_t)pn * 256 * 128 * 2; u.rowmap = nullptr; u.nvalid = 0; u.m0 = 0; u.row0 = pm * 256; u.col0 = pn * 256; u.pos0 = job;
        return true;
    }
};
struct FLORA { const float* dbias; const float* ibias; bf16_t* LWG; bf16_t* AIG; __device__ __forceinline__ void operator()(const pg8::Unit& u, int lr, int lc, f32x4 v0, f32x4 v1) const {
    const int row = u.row0 + lr, col = u.col0 + lc;
    const float* bp = (u.pos0 == 0 ? dbias : ibias) + col; const f32x4 b0 = *(const f32x4*)bp, b1 = *(const f32x4*)(bp + 4);
    const float sc = (u.pos0 == 0) ? -0.60653065971f : 1.f;
    float o[8];
#pragma unroll
    for (int e = 0; e < 4; ++e) { o[e] = sc * sigmoidf_(b0[e] + v0[e]); o[4 + e] = sc * sigmoidf_(b1[e] + v1[e]); }
    *(u32x4*)((u.pos0 == 0 ? LWG : AIG) + (size_t)row * 2048 + col) = mk4u(pk2(o[0], o[1]), pk2(o[2], o[3]), pk2(o[4], o[5]), pk2(o[6], o[7]));
} };
struct FGG { bf16_t* GG; __device__ __forceinline__ void operator()(const pg8::Unit& u, int lr, int lc, f32x4 v0, f32x4 v1) const {
    *(u32x4*)(GG + (size_t)(u.row0 + lr) * 1024 + u.col0 + lc) = mk4u(pk2(v0[0], v0[1]), pk2(v0[2], v0[3]), pk2(v1[0], v1[1]), pk2(v1[2], v1[3])); } };

__device__ __forceinline__ int inst_index(int b, int h, int d, int chunk) { return ((b * 16 + h) * 2 + d) * NCHUNK + chunk; }

constexpr int LA_K = 0  , LA_VT = 73728  , LA_END = LA_VT + 18 * 4608;
static_assert(LA_END <= SMEM_BYTES, "attention LDS map");

__device__ __forceinline__ void attn_unit(LDSP unsigned char* lds, const Params& p, int unit) {
    const int tid = opaque(threadIdx.x), wid = tid >> 6, lane = tid & 63;
    const int b = unit >> 8, kvh = (unit >> 6) & 3, qb = unit & 63, q0 = qb * 64;
    const bf16_t* PX = (const bf16_t*)(p.ws + OFF_PX);
    const float2* ROPE = (const float2*)(p.ws + OFF_ROPE);
    {
        u32x4 kx1[5], kx2[5];
#pragma unroll
        for (int it = 0; it < 5; ++it) {
            const int task = tid + 512 * it; kx1[it] = mk4u(0, 0, 0, 0); kx2[it] = mk4u(0, 0, 0, 0);
            if (task < 576 * 4) {
                const int key = task >> 2, pr = task & 3, c0 = (pr & 1) + 4 * (pr >> 1);
                const int pos = q0 - 128 + key;
                const bool lat = key < 320;
                if (!lat || (pos >= 0 && pos < T)) {
                    const bf16_t* src = PX + (size_t)(lat ? (b * T + pos) : (NX + b * CL + (key - 320))) * INP + C_AK + kvh * 64 + c0 * 8;
                    kx1[it] = *(const u32x4*)src; kx2[it] = *(const u32x4*)(src + 16);
                }
            }
        }
#pragma unroll
        for (int it = 0; it < 5; ++it) {
            const int task = tid + 512 * it;
            if (task < 576 * 4) {
                const int key = task >> 2, pr = task & 3, c0 = (pr & 1) + 4 * (pr >> 1);
                u32x4 w0 = kx1[it], w1 = kx2[it];
                if (key < 320) {
                    const int pos = q0 - 128 + key;
                    if (pos >= 0 && pos < T) {
                        const int ppos = (pr < 2) ? (pos >> 6) : (pos & 63);
                        const float2* tb = ROPE + ppos * 16 + (pr & 1) * 8;
                        const unsigned a1[4] = {w0.x, w0.y, w0.z, w0.w}, a2[4] = {w1.x, w1.y, w1.z, w1.w};
                        unsigned o1[4], o2[4];
#pragma unroll
                        for (int j = 0; j < 4; ++j) {
                            const float2 cs0 = tb[2 * j], cs1 = tb[2 * j + 1];
                            const float u0 = bf2f(a1[j] & 0xffff), u1 = bf2f(a1[j] >> 16), v0 = bf2f(a2[j] & 0xffff), v1 = bf2f(a2[j] >> 16);
                            o1[j] = pk2(u0 * cs0.x - v0 * cs0.y, u1 * cs1.x - v1 * cs1.y);
                            o2[j] = pk2(v0 * cs0.x + u0 * cs0.y, v1 * cs1.x + u1 * cs1.y);
                        }
                        w0 = mk4u(o1[0], o1[1], o1[2], o1[3]); w1 = mk4u(o2[0], o2[1], o2[2], o2[3]);
                    }
                }
                *(LDSP u32x4*)(lds + LA_K + sw64(key, c0 * 8)) = w0;
                *(LDSP u32x4*)(lds + LA_K + sw64(key, c0 * 8 + 16)) = w1;
            }
        }
    }
    {
        u32x4 vx[3][4];
#pragma unroll
        for (int it = 0; it < 3; ++it) {
            const int task = tid + 512 * it;
#pragma unroll
            for (int q = 0; q < 4; ++q) {
                vx[it][q] = mk4u(0, 0, 0, 0);
                if (task < 144 * 8) {
                    const int kg = task >> 3, dc = task & 7, key = kg * 4 + q;
                    if (key < 320) { const int pos = q0 - 128 + key; if (pos >= 0 && pos < T) vx[it][q] = *(const u32x4*)(PX + (size_t)(b * T + pos) * INP + C_AV + kvh * 64 + dc * 8); }
                    else vx[it][q] = *(const u32x4*)(PX + (size_t)(NX + b * CL + (key - 320)) * INP + C_AV + kvh * 64 + dc * 8);
                }
            }
        }
#pragma unroll
        for (int it = 0; it < 3; ++it) {
            const int task = tid + 512 * it;
            if (task < 144 * 8) {
                const int kg = task >> 3, dc = task & 7;
                unsigned short e[4][8];
#pragma unroll
                for (int q = 0; q < 4; ++q) { const u32x4 w = vx[it][q];
                    e[q][0] = w.x & 0xffff; e[q][1] = w.x >> 16; e[q][2] = w.y & 0xffff; e[q][3] = w.y >> 16; e[q][4] = w.z & 0xffff; e[q][5] = w.z >> 16; e[q][6] = w.w & 0xffff; e[q][7] = w.w >> 16; }
                const int tile = kg >> 3, kin = (kg & 7) * 4;
#pragma unroll
                for (int j = 0; j < 8; ++j) { u32x2 w; w.x = (unsigned)e[0][j] | ((unsigned)e[1][j] << 16); w.y = (unsigned)e[2][j] | ((unsigned)e[3][j] << 16);
                    *(LDSP u32x2*)(lds + LA_VT + tile * 4608 + (dc * 8 + j) * 72 + kin * 2) = w; }
            }
        }
    }
    const int hq = kvh * 4 + (wid >> 1), qs = (wid & 1) * 32, r = lane & 31, hh = lane >> 5;
    const int qpos = q0 + qs + r;
    bf16x8 qf[4];
    {
        const bf16_t* src = PX + (size_t)(b * T + qpos) * INP + C_Q + hq * 64 + 8 * hh;
        u32x4 raw[4];
#pragma unroll
        for (int s = 0; s < 4; ++s) raw[s] = *(const u32x4*)(src + 16 * s);
#pragma unroll
        for (int pr = 0; pr < 2; ++pr) {
            const int ppos = pr == 0 ? (qpos >> 6) : (qpos & 63);
            const float2* tb = ROPE + ppos * 16 + 8 * hh;
            const unsigned a1[4] = {raw[2 * pr].x, raw[2 * pr].y, raw[2 * pr].z, raw[2 * pr].w}, a2[4] = {raw[2 * pr + 1].x, raw[2 * pr + 1].y, raw[2 * pr + 1].z, raw[2 * pr + 1].w};
            unsigned o1[4], o2[4];
#pragma unroll
            for (int j = 0; j < 4; ++j) {
                const float2 cs0 = tb[2 * j], cs1 = tb[2 * j + 1];
                const float u0 = bf2f(a1[j] & 0xffff), u1 = bf2f(a1[j] >> 16), v0 = bf2f(a2[j] & 0xffff), v1 = bf2f(a2[j] >> 16);
                o1[j] = pk2(0.125f * (u0 * cs0.x - v0 * cs0.y), 0.125f * (u1 * cs1.x - v1 * cs1.y));
                o2[j] = pk2(0.125f * (v0 * cs0.x + u0 * cs0.y), 0.125f * (v1 * cs1.x + u1 * cs1.y));
            }
            const u32x4 w1 = mk4u(o1[0], o1[1], o1[2], o1[3]), w2 = mk4u(o2[0], o2[1], o2[2], o2[3]);
            qf[2 * pr] = __builtin_bit_cast(bf16x8, w1); qf[2 * pr + 1] = __builtin_bit_cast(bf16x8, w2);
        }
    }
    __syncthreads();
    float m = p.attn_sink[hq], l = 1.f;
    f32x16 o0 = zero16(), o1 = zero16();
    for (int tl = 0; tl < 18; ++tl) {
        f32x16 st = zero16();
#pragma unroll
        for (int s = 0; s < 4; ++s) {
            const bf16x8 kf = *(const LDSP bf16x8*)(lds + LA_K + sw64(32 * tl + r, 16 * s + 8 * hh));
            st = __builtin_amdgcn_mfma_f32_32x32x16_bf16(kf, qf[s], st, 0, 0, 0);
        }
        const int kp0 = q0 - 128 + 32 * tl, qlo = q0 + qs;
        if (tl < 10 && (qlo + 31 - kp0 > 128 || qlo - (kp0 + 31) < -128 || kp0 < 0 || kp0 + 31 >= T)) {
#pragma unroll
            for (int g = 0; g < 16; ++g) { const int kp = q0 - 128 + 32 * tl + crow(g, hh); const int dlt = qpos - kp;
                const bool ok = (dlt <= 128) && (dlt >= -128) && (kp >= 0) && (kp < T); st[g] = ok ? st[g] : -1e30f; }
        }
        float mt = st[0];
#pragma unroll
        for (int g = 1; g < 16; ++g) mt = fmaxf(mt, st[g]);
        mt = fmaxf(mt, __shfl_xor(mt, 32));
        const float mn = fmaxf(m, mt), alpha = __expf(m - mn);
        float ps = 0.f;
#pragma unroll
        for (int g = 0; g < 16; ++g) { st[g] = __expf(st[g] - mn); ps += st[g]; }
        ps += __shfl_xor(ps, 32);
        l = l * alpha + ps; m = mn;
        if (__any(alpha != 1.f)) {
#pragma unroll
            for (int g = 0; g < 16; ++g) { o0[g] *= alpha; o1[g] *= alpha; }
        }
#pragma unroll
        for (int s2 = 0; s2 < 2; ++s2) {
            const u32x4 pw = mk4u(pk2(st[8 * s2], st[8 * s2 + 1]), pk2(st[8 * s2 + 2], st[8 * s2 + 3]), pk2(st[8 * s2 + 4], st[8 * s2 + 5]), pk2(st[8 * s2 + 6], st[8 * s2 + 7]));
            const bf16x8 pf = __builtin_bit_cast(bf16x8, pw);
#pragma unroll
            for (int dm = 0; dm < 2; ++dm) {
                const LDSP unsigned char* vp = lds + LA_VT + tl * 4608 + (32 * dm + r) * 72 + (16 * s2 + 4 * hh) * 2;
                const u32x2 v0 = *(const LDSP u32x2*)vp, v1 = *(const LDSP u32x2*)(vp + 16);
                const bf16x8 vf = __builtin_bit_cast(bf16x8, mk4u(v0.x, v0.y, v1.x, v1.y));
                if (dm == 0) o0 = __builtin_amdgcn_mfma_f32_32x32x16_bf16(vf, pf, o0, 0, 0, 0); else o1 = __builtin_amdgcn_mfma_f32_32x32x16_bf16(vf, pf, o1, 0, 0, 0);
            }
        }
    }
    {
        const float inv = 1.f / l;
        bf16_t* dst = (bf16_t*)(p.ws + OFF_MIX) + (size_t)(b * T + qpos) * D + 1024 + hq * 64;
#pragma unroll
        for (int gq = 0; gq < 4; ++gq) {
            u32x2 w; w.x = pk2(o0[4 * gq] * inv, o0[4 * gq + 1] * inv); w.y = pk2(o0[4 * gq + 2] * inv, o0[4 * gq + 3] * inv); *(u32x2*)(dst + 8 * gq + 4 * hh) = w;
            u32x2 w2; w2.x = pk2(o1[4 * gq] * inv, o1[4 * gq + 1] * inv); w2.y = pk2(o1[4 * gq + 2] * inv, o1[4 * gq + 3] * inv); *(u32x2*)(dst + 32 + 8 * gq + 4 * hh) = w2;
        }
    }
    __syncthreads();
}

__device__ __forceinline__ void phaseR2(LDSP unsigned char* lds, const Params& p) {
    {
        pg8::Epi<FLORA> epi{FLORA{p.decay_bias, p.iclr_bias, (bf16_t*)(p.ws + OFF_LWG), (bf16_t*)(p.ws + OFF_AIG)}};
        LoraSched S{(const char*)(p.ws + OFF_TW), (const char*)(p.ws + OFF_WTDU), (const char*)(p.ws + OFF_XA), (const char*)(p.ws + OFF_WTIU), (int)gridDim.x, (int)blockIdx.x};
        pg8::gemm_phase<false>(lds, opaque_s(128), S, epi);
    }
    {
        pg8::Epi<FGG> epi{FGG{(bf16_t*)(p.ws + OFF_GG)}};
        pg8::DenseSched S{(const char*)(p.ws + OFF_SG), (const char*)(p.ws + OFF_WTGU), NX / 256, 1024 / 256, 256, (int)gridDim.x, (int)(gridDim.x - 1 - blockIdx.x)};
        pg8::gemm_phase<false>(lds, opaque_s(256), S, epi);
    }
}

constexpr int G_RT = 0, G_VT = 8192, G_X0 = 16384, G_AT = 32768, G_BT = 40960, G_KT = 49152, G_P0 = 57344, G_PT0 = 65536, G_SEG = 73728, G_GL = 74752, G_CNT = 75008, G_BYTES = 79872;
static_assert(2 * G_BYTES <= SMEM_BYTES - 16, "two R3 groups fit the LDS");

__device__ __forceinline__ void gbar(LDSP unsigned* cnt, unsigned& target, int lane) {
    target += 4u;
    asm volatile("s_waitcnt lgkmcnt(0)" ::: "memory");
    if (lane == 0) {
        __hip_atomic_fetch_add(cnt, 1u, __ATOMIC_RELAXED, __HIP_MEMORY_SCOPE_WORKGROUP);
        while (__hip_atomic_load(cnt, __ATOMIC_RELAXED, __HIP_MEMORY_SCOPE_WORKGROUP) < target) __builtin_amdgcn_s_sleep(1);
    }
    asm volatile("" ::: "memory");
}
__device__ __forceinline__ void mask_lt(f32x16& c, int x0, int y, int hh, bool incl) {
#pragma unroll
    for (int g = 0; g < 16; ++g) { const int x = x0 + crow(g, hh); c[g] = (incl ? (x <= y) : (x < y)) ? c[g] : 0.f; }
}

#if defined(__HIP_DEVICE_COMPILE__)
#define LDS_AT(T, addr) (__builtin_bit_cast(LDSP T*, (unsigned)(addr)))
#define LDS_ADDR(ptr) (__builtin_bit_cast(unsigned, (ptr)))
#else
#define LDS_AT(T, addr) ((LDSP T*)(size_t)(addr))
#define LDS_ADDR(ptr) ((unsigned)(size_t)(ptr))
#endif
__device__ __forceinline__ void ldf(const unsigned (&FO)[4], unsigned off, bf16x8 (&f)[4]) {
#pragma unroll
    for (int s = 0; s < 4; ++s) f[s] = *LDS_AT(const bf16x8, FO[s] + off);
}
__device__ __forceinline__ void stt(const unsigned (&SO)[4], unsigned off, int xh, const f32x16& acc) {
#pragma unroll
    for (int gq = 0; gq < 4; ++gq) *LDS_AT(u32x2, (SO[gq] ^ ((unsigned)xh << 6)) + off) = mk2u(pk2(acc[4 * gq], acc[4 * gq + 1]), pk2(acc[4 * gq + 2], acc[4 * gq + 3]));
}
__device__ __forceinline__ u32x2 ld8(const unsigned (&SO)[4], int gq, unsigned off, int xh) { return *LDS_AT(const u32x2, (SO[gq] ^ ((unsigned)xh << 6)) + off); }

__device__ __forceinline__ void rwkv_prep_group(LDSP unsigned char* lg, LDSP unsigned* cnt, unsigned& bt, const Params& p, int unit, int wg_in, int lane_in, const unsigned (&FO)[4], const unsigned (&SO)[4]) {
    int seq, c, h, d;
    if (unit < 4096) { seq = unit >> 11; c = (unit >> 5) & 63; h = (unit >> 1) & 15; d = unit & 1; } else { const int u = unit - 4096; seq = 2 + (u >> 7); c = (u >> 5) & 3; h = (u >> 1) & 15; d = u & 1; }
    const bool isx = seq < 2;
    const int b = seq & 1;
    const int s0 = isx ? b * T : NX + b * CL, t0 = c * 64;
    const int chunk_id = isx ? 4 + c : c;
    u32x4 keep_bh[2], keep_kh[2];
#define STAGE_IDS const int lane = opaque(lane_in), wg = opaque(wg_in), r = lane & 31, hh = lane >> 5; (void)r; (void)hh; (void)wg;
    {
        STAGE_IDS
        const int k = lane, seg = wg, hk = h * 64 + k;
        const float kac = p.k_a[hk];
        const bf16_t* RS = (const bf16_t*)(p.ws + OFF_RS); const bf16_t* KS = (const bf16_t*)(p.ws + OFF_KS); const bf16_t* KKp = (const bf16_t*)(p.ws + OFF_KK); const bf16_t* VS = (const bf16_t*)(p.ws + OFF_VS);
        const bf16_t* LWG = (const bf16_t*)(p.ws + OFF_LWG); const bf16_t* AIG = (const bf16_t*)(p.ws + OFF_AIG);
        const int ibase = seg * 16;
        const size_t rowA = (size_t)(s0 + t0) + (d ? 63 - ibase : ibase);
        float lw[16];
        float run = 0.f;
#pragma unroll
        for (int tt = 0; tt < 16; ++tt) { const size_t row = d ? rowA - tt : rowA + tt; run += bf2f(LWG[row * 2048 + d * 1024 + hk]); lw[tt] = run; }
        LDSP float* SEG = (LDSP float*)(lg + G_SEG);
        SEG[seg * 64 + k] = run;
        gbar(cnt, bt, lane);
        float off = 0.f, gL = 0.f;
#pragma unroll
        for (int s = 0; s < 4; ++s) { const float sv = SEG[s * 64 + k]; if (s < seg) off += sv; gL += sv; }
        if (seg == 0) ((LDSP float*)(lg + G_GL))[k] = gL;
        const float egL = __expf(gL);
#pragma unroll
        for (int q = 0; q < 2; ++q) {
            float rr[8], kr[8], kk[8], vv[8], ai[8];
#pragma unroll
            for (int e = 0; e < 8; ++e) { const int tt = 8 * q + e; const size_t row = d ? rowA - tt : rowA + tt;
                rr[e] = bf2f(RS[row * 1024 + hk]); kr[e] = bf2f(KS[row * 1024 + hk]); kk[e] = bf2f(KKp[row * 1024 + hk]); vv[e] = bf2f(VS[row * 1024 + hk]); ai[e] = bf2f(AIG[row * 2048 + d * 1024 + hk]); }
            unsigned wat[4], wbh[4], wkh[4], wv[4];
#pragma unroll
            for (int t2 = 0; t2 < 4; ++t2) {
                const int i0 = ibase + 8 * q + 2 * t2;
                float fat[2], frt[2], fbt[2], fkt[2], fbh[2], fkh[2];
#pragma unroll
                for (int e2 = 0; e2 < 2; ++e2) { const int e = 2 * t2 + e2, tt = 8 * q + e;
                    const float kd = kr[e] * (1.f + (ai[e] - 1.f) * kac), bbv = kk[e] * ai[e];
                    const float g = off + lw[tt], ge = (tt == 0) ? off : off + lw[tt - 1];
                    const float eg = __expf(g), ege = __expf(ge), eng = __builtin_amdgcn_rcpf(eg), egl = egL * eng;
                    fat[e2] = -kk[e] * ege; frt[e2] = rr[e] * eg; fbt[e2] = bbv * eng; fkt[e2] = kd * eng; fbh[e2] = bbv * egl; fkh[e2] = kd * egl; }
                wat[t2] = pk2(fat[0], fat[1]); wbh[t2] = pk2(fbh[0], fbh[1]); wkh[t2] = pk2(fkh[0], fkh[1]); wv[t2] = pk2(vv[2 * t2], vv[2 * t2 + 1]);
                const unsigned wr = pk2(frt[0], frt[1]), wb = pk2(fbt[0], fbt[1]), wk = pk2(fkt[0], fkt[1]);
                *(LDSP bf16_t*)(lg + G_AT + sw64(i0, k)) = (bf16_t)(wat[t2] & 0xffffu); *(LDSP bf16_t*)(lg + G_AT + sw64(i0 + 1, k)) = (bf16_t)(wat[t2] >> 16);
                *(LDSP bf16_t*)(lg + G_RT + sw64(i0, k)) = (bf16_t)(wr & 0xffffu);      *(LDSP bf16_t*)(lg + G_RT + sw64(i0 + 1, k)) = (bf16_t)(wr >> 16);
                *(LDSP bf16_t*)(lg + G_BT + sw64(i0, k)) = (bf16_t)(wb & 0xffffu);      *(LDSP bf16_t*)(lg + G_BT + sw64(i0 + 1, k)) = (bf16_t)(wb >> 16);
                *(LDSP bf16_t*)(lg + G_KT + sw64(i0, k)) = (bf16_t)(wk & 0xffffu);      *(LDSP bf16_t*)(lg + G_KT + sw64(i0 + 1, k)) = (bf16_t)(wk >> 16);
            }
            *(LDSP u32x4*)(lg + G_X0 + sw64(k, ibase + 8 * q)) = mk4u(wat[0], wat[1], wat[2], wat[3]);
            *(LDSP u32x4*)(lg + G_VT + sw64(k, ibase + 8 * q)) = mk4u(wv[0], wv[1], wv[2], wv[3]);
            keep_bh[q] = mk4u(wbh[0], wbh[1], wbh[2], wbh[3]); keep_kh[q] = mk4u(wkh[0], wkh[1], wkh[2], wkh[3]);
            __builtin_amdgcn_sched_barrier(0);
        }
    }
    gbar(cnt, bt, lane_in);
    {
        STAGE_IDS
        const int a = wg >> 1, bq = wg & 1;
        f32x16 c1 = zero16(), c2 = zero16();
        if (a <= bq) {
            bf16x8 fB[4], fA[4]; ldf(FO, G_BT + 4096 * a, fB); ldf(FO, G_AT + 4096 * bq, fA);
#pragma unroll
            for (int t = 0; t < 4; ++t) { c1 = __builtin_amdgcn_mfma_f32_32x32x16_bf16(fB[t], fA[t], c1, 0, 0, 0); c2 = __builtin_amdgcn_mfma_f32_32x32x16_bf16(fA[t], fB[t], c2, 0, 0, 0); }
            mask_lt(c1, 32 * a, 32 * bq + r, hh, false);
#pragma unroll
            for (int g = 0; g < 16; ++g) { const int x = 32 * bq + crow(g, hh); c2[g] = (32 * a + r < x) ? c2[g] : 0.f; }
        }
        stt(SO, G_P0 + 4096 * bq, a, c1);
        stt(SO, G_PT0 + 4096 * a, bq, c2);
        const int ib = wg >> 1, vb = wg & 1;
        f32x16 z = zero16();
#pragma unroll
        for (int jb = 0; jb < 2; ++jb) if (jb <= ib) {
            bf16x8 fK[4], fA[4]; ldf(FO, G_KT + 4096 * jb, fK); ldf(FO, G_AT + 4096 * ib, fA);
            f32x16 t = zero16();
#pragma unroll
            for (int s = 0; s < 4; ++s) t = __builtin_amdgcn_mfma_f32_32x32x16_bf16(fK[s], fA[s], t, 0, 0, 0);
            mask_lt(t, 32 * jb, 32 * ib + r, hh, false);
#pragma unroll
            for (int s2 = 0; s2 < 2; ++s2) {
                const bf16x8 af = __builtin_bit_cast(bf16x8, mk4u(pk2(t[8 * s2], t[8 * s2 + 1]), pk2(t[8 * s2 + 2], t[8 * s2 + 3]), pk2(t[8 * s2 + 4], t[8 * s2 + 5]), pk2(t[8 * s2 + 6], t[8 * s2 + 7])));
                const u32x2 v0 = ld8(SO, 2 * s2, G_VT + 4096 * vb, jb), v1 = ld8(SO, 2 * s2 + 1, G_VT + 4096 * vb, jb);
                const bf16x8 bv = __builtin_bit_cast(bf16x8, mk4u(v0.x, v0.y, v1.x, v1.y));
                z = __builtin_amdgcn_mfma_f32_32x32x16_bf16(af, bv, z, 0, 0, 0);
            }
        }
        stt(SO, G_X0 + 128 * 64 + 4096 * vb, ib, z);
    }
    gbar(cnt, bt, lane_in);
#pragma unroll 1
    for (int s = 0; s < 6; ++s) {
        STAGE_IDS
        const int cb = wg, a = wg >> 1, bq = wg & 1;
        bf16x8 xf[4], p0[4], p1[4];
        ldf(FO, G_X0 + 4096 * cb, xf); ldf(FO, G_P0, p0); ldf(FO, G_P0 + 4096, p1);
        f32x16 acc0, acc1;
#pragma unroll
        for (int gq = 0; gq < 4; ++gq) { const u32x2 w0 = ld8(SO, gq, G_X0 + 4096 * cb, 0), w1 = ld8(SO, gq, G_X0 + 4096 * cb, 1);
            acc0[4 * gq] = bf2f(w0.x & 0xffff); acc0[4 * gq + 1] = bf2f(w0.x >> 16); acc0[4 * gq + 2] = bf2f(w0.y & 0xffff); acc0[4 * gq + 3] = bf2f(w0.y >> 16);
            acc1[4 * gq] = bf2f(w1.x & 0xffff); acc1[4 * gq + 1] = bf2f(w1.x >> 16); acc1[4 * gq + 2] = bf2f(w1.y & 0xffff); acc1[4 * gq + 3] = bf2f(w1.y >> 16); }
        f32x16 z = zero16(), zt = zero16();
        const bool sq = (s < 5) && (a <= bq);
        bf16x8 fa[4], fb[4];
        if (sq) { ldf(FO, G_PT0 + 4096 * a, fa); ldf(FO, G_P0 + 4096 * bq, fb); }
#pragma unroll
        for (int t = 0; t < 4; ++t) { if (t < 2) acc0 = __builtin_amdgcn_mfma_f32_32x32x16_bf16(p0[t], xf[t], acc0, 0, 0, 0); acc1 = __builtin_amdgcn_mfma_f32_32x32x16_bf16(p1[t], xf[t], acc1, 0, 0, 0); }
        if (sq) { const int t0 = (a == 1) ? 2 : 0, t1 = (bq == 0) ? 2 : 4;
#pragma unroll
            for (int t = 0; t < 4; ++t) if (t >= t0 && t < t1) { z = __builtin_amdgcn_mfma_f32_32x32x16_bf16(fa[t], fb[t], z, 0, 0, 0); zt = __builtin_amdgcn_mfma_f32_32x32x16_bf16(fb[t], fa[t], zt, 0, 0, 0); } }
        stt(SO, G_X0 + 4096 * cb, 0, acc0); stt(SO, G_X0 + 4096 * cb, 1, acc1);
        if (s < 5) {
            gbar(cnt, bt, lane);
            stt(SO, G_P0 + 4096 * bq, a, z); stt(SO, G_PT0 + 4096 * a, bq, zt);
        }
        gbar(cnt, bt, lane);
    }
    {
        STAGE_IDS
        const int jb = wg >> 1, ib = wg & 1;
        f32x16 c1 = zero16(), c2 = zero16();
        if (jb <= ib) {
            bf16x8 fR[4], fB[4], fK[4]; ldf(FO, G_RT + 4096 * ib, fR); ldf(FO, G_BT + 4096 * jb, fB); ldf(FO, G_KT + 4096 * jb, fK);
#pragma unroll
            for (int t = 0; t < 4; ++t) { c1 = __builtin_amdgcn_mfma_f32_32x32x16_bf16(fB[t], fR[t], c1, 0, 0, 0); c2 = __builtin_amdgcn_mfma_f32_32x32x16_bf16(fK[t], fR[t], c2, 0, 0, 0); }
            mask_lt(c1, 32 * jb, 32 * ib + r, hh, true); mask_lt(c2, 32 * jb, 32 * ib + r, hh, true);
        }
        stt(SO, G_P0 + 4096 * ib, jb, c1); stt(SO, G_PT0 + 4096 * ib, jb, c2);
    }
    gbar(cnt, bt, lane_in);
    {
        STAGE_IDS
#pragma unroll
        for (int q = 0; q < 2; ++q) { *(LDSP u32x4*)(lg + G_BT + sw64(lane, wg * 16 + 8 * q)) = keep_bh[q]; *(LDSP u32x4*)(lg + G_KT + sw64(lane, wg * 16 + 8 * q)) = keep_kh[q]; }
    }
    gbar(cnt, bt, lane_in);
    {
        STAGE_IDS
        const int mi = wg;
        const int L_BH = G_BT, L_KH = G_KT, L_RB = G_P0, L_RK = G_PT0;
        const size_t inst = (size_t)inst_index(b, h, d, chunk_id) * 4096;
        bf16_t* dst = (bf16_t*)(p.ws + (mi == 0 ? OFF_CM : mi == 1 ? OFF_CN : mi == 2 ? OFF_CP : OFF_CQ)) + inst;
        if (isx || mi < 2) {
            const int Ax = (mi == 1) ? L_BH : G_X0, Ax0 = (mi == 3) ? 64 : 0;
            const int By = (mi == 0) ? L_BH : (mi == 1) ? G_X0 : L_RB, By0 = (mi == 1) ? 64 : 0;
            const int A2 = (mi == 1) ? L_KH : G_VT, B2 = (mi == 1) ? G_VT : L_RK;
#pragma unroll 1
            for (int half = 0; half < 2; ++half) {
                bf16x8 a0[4], a1[4], b1[4];
                ldf(FO, Ax + 128 * Ax0, a0); ldf(FO, Ax + 128 * (Ax0 + 32), a1); ldf(FO, By + 128 * (By0 + 32 * half), b1);
                f32x16 c0 = zero16(), c1 = zero16();
#pragma unroll
                for (int t = 0; t < 4; ++t) { c0 = __builtin_amdgcn_mfma_f32_32x32x16_bf16(a0[t], b1[t], c0, 0, 0, 0); c1 = __builtin_amdgcn_mfma_f32_32x32x16_bf16(a1[t], b1[t], c1, 0, 0, 0); }
                if (mi & 1) {
                    ldf(FO, A2, a0); ldf(FO, A2 + 4096, a1); ldf(FO, B2 + 4096 * half, b1);
#pragma unroll
                    for (int t = 0; t < 4; ++t) { c0 = __builtin_amdgcn_mfma_f32_32x32x16_bf16(a0[t], b1[t], c0, 0, 0, 0); c1 = __builtin_amdgcn_mfma_f32_32x32x16_bf16(a1[t], b1[t], c1, 0, 0, 0); }
                }
                const int y = 32 * half + r;
                const float dg = (mi == 0) ? __expf(((const LDSP float*)(lg + G_GL))[y]) : 0.f;
#pragma unroll
                for (int xb = 0; xb < 2; ++xb) {
#pragma unroll
                    for (int gq = 0; gq < 4; ++gq) {
                        const int x0 = 32 * xb + 8 * gq + 4 * hh;
                        float v0 = xb ? c1[4 * gq] : c0[4 * gq], v1 = xb ? c1[4 * gq + 1] : c0[4 * gq + 1], v2 = xb ? c1[4 * gq + 2] : c0[4 * gq + 2], v3 = xb ? c1[4 * gq + 3] : c0[4 * gq + 3];
                        if (mi == 0) { if (x0 == y) v0 += dg; if (x0 + 1 == y) v1 += dg; if (x0 + 2 == y) v2 += dg; if (x0 + 3 == y) v3 += dg; }
                        if (mi == 2) { const u32x2 w = ld8(SO, gq, G_RT + 4096 * half, xb); v0 += bf2f(w.x & 0xffff); v1 += bf2f(w.x >> 16); v2 += bf2f(w.y & 0xffff); v3 += bf2f(w.y >> 16); }
                        *(u32x2*)(dst + ((half * 4 + 2 * xb + (gq >> 1)) * 64 + hh * 32 + r) * 8 + 4 * (gq & 1)) = mk2u(pk2(v0, v1), pk2(v2, v3));
                    }
                }
            }
        }
    }
    gbar(cnt, bt, lane_in);
#undef STAGE_IDS
}

__device__ __forceinline__ void conv_tile_group(LDSP unsigned char* lg, LDSP unsigned* cnt, unsigned& bt, const Params& p, int g, int tg, int lane) {
    const float* src = nullptr; bf16_t* dst = nullptr; int N = 0, ld = 0, mode = 0, k0 = 0, n0 = 0;
    conv_decode(p, g, src, dst, N, ld, mode, k0, n0);
    LDSP float* Tm = (LDSP float*)lg;
    {
        const int kr = tg >> 3, nc = (tg & 7) * 8;
        f32x4 v[8][2];
#pragma unroll
        for (int s = 0; s < 8; ++s) { const float* q = src + (size_t)(k0 + s * 32 + kr) * N + n0 + nc; v[s][0] = *(const f32x4*)q; v[s][1] = *(const f32x4*)(q + 4); }
#pragma unroll
        for (int s = 0; s < 8; ++s) { LDSP float* q = Tm + (s * 32 + kr) * 65 + nc;
            q[0] = v[s][0].x; q[1] = v[s][0].y; q[2] = v[s][0].z; q[3] = v[s][0].w; q[4] = v[s][1].x; q[5] = v[s][1].y; q[6] = v[s][1].z; q[7] = v[s][1].w; }
    }
    gbar(cnt, bt, lane);
    {
        const int n = tg >> 2; bf16_t* drow = dst + (size_t)conv_row(n0 + n, mode) * ld + k0;
#pragma unroll
        for (int s = 0; s < 8; ++s) { const int kc = ((tg & 3) + 4 * s) * 8; float f[8];
#pragma unroll
            for (int j = 0; j < 8; ++j) f[j] = Tm[(kc + j) * 65 + n];
            *(u32x4*)(drow + kc) = mk4u(pk2(f[0], f[1]), pk2(f[2], f[3]), pk2(f[4], f[5]), pk2(f[6], f[7])); }
    }
    gbar(cnt, bt, lane);
}

__device__ __forceinline__ void phaseR3(LDSP unsigned char* lds, const Params& p) {
    const int tid = opaque(threadIdx.x), wid = tid >> 6, lane = tid & 63, gp = wid >> 2, wg = wid & 3;
    LDSP unsigned char* lg = lds + gp * G_BYTES;
    LDSP unsigned* cnt = (LDSP unsigned*)(lg + G_CNT);
    LDSP unsigned* uq = (LDSP unsigned*)(lds + SMEM_BYTES - 48);
    LDSP unsigned* pick = (LDSP unsigned*)(lg + G_CNT + 8);
    if ((tid & 255) == 0) *cnt = 0u;
    if (tid == 0) *uq = 0u;
    __syncthreads();
    unsigned bt = 0u;
    if (gp == 1) for (int g = CT1 + blockIdx.x; g < CT8; g += gridDim.x) conv_tile_group(lg, cnt, bt, p, g, tid & 255, lane);
    unsigned FO[4], SO[4];
    { const unsigned base = LDS_ADDR(lg), r = lane & 31, hh = lane >> 5;
#pragma unroll
      for (int q = 0; q < 4; ++q) { FO[q] = base + r * 128u + ((((2u * q + hh) ^ (r >> 1)) & 7u) << 4); SO[q] = base + r * 128u + ((((unsigned)q ^ (r >> 1)) & 7u) << 4) + 8u * hh; } }
    for (;;) {
        if ((tid & 255) == 0) *pick = __hip_atomic_fetch_add(uq, 1u, __ATOMIC_RELAXED, __HIP_MEMORY_SCOPE_WORKGROUP);
        gbar(cnt, bt, lane);
        const int u = blockIdx.x + (int)(*pick) * gridDim.x;
        gbar(cnt, bt, lane);
        if (u >= 4096 + 256) break;
        rwkv_prep_group(lg, cnt, bt, p, u, wg, lane, FO, SO);
    }
    __syncthreads();
}

constexpr size_t OFF_HT = OFF_YD;
__device__ __forceinline__ void scan_wave(const Params& p, int item, int lane) {
    const int chain = item >> 1, vb = item & 1, b = chain >> 5, h = (chain >> 1) & 15, d = chain & 1;
    const bf16_t* CM = (const bf16_t*)(p.ws + OFF_CM); const bf16_t* CN = (const bf16_t*)(p.ws + OFF_CN); bf16_t* HT = (bf16_t*)(p.ws + OFF_HT);
    u32x4 na[2][4], nn[2][2];
    auto chunk_of = [&](int step) { return (step < 4) ? (d ? 3 - step : step) : (d ? 4 + (67 - step) : step); };
    auto prefetch = [&](int step) {
        const size_t inst = (size_t)inst_index(b, h, d, chunk_of(step)) * 4096;
#pragma unroll
        for (int rt = 0; rt < 2; ++rt) {
#pragma unroll
            for (int s = 0; s < 4; ++s) na[rt][s] = *(const u32x4*)(CM + inst + ((rt * 4 + s) * 64 + lane) * 8);
#pragma unroll
            for (int g2 = 0; g2 < 2; ++g2) nn[rt][g2] = *(const u32x4*)(CN + inst + (((vb * 2 + rt) * 2 + g2) * 64 + lane) * 8);
        }
    };
    f32x16 hacc[2]; hacc[0] = zero16(); hacc[1] = zero16();
    prefetch(0);
#pragma unroll 1
    for (int step = 0; step < NCHUNK; ++step) {
        const int chunk_id = chunk_of(step);
        u32x4 a[2][4], n[2][2];
#pragma unroll
        for (int rt = 0; rt < 2; ++rt) {
#pragma unroll
            for (int s = 0; s < 4; ++s) a[rt][s] = na[rt][s];
            n[rt][0] = nn[rt][0]; n[rt][1] = nn[rt][1];
        }
        if (step + 1 < NCHUNK) prefetch(step + 1);
        bf16x8 bfr[4];
#pragma unroll
        for (int s = 0; s < 4; ++s) { const f32x16& t = hacc[s >> 1]; const int o = 8 * (s & 1);
            bfr[s] = __builtin_bit_cast(bf16x8, mk4u(pk2(t[o], t[o + 1]), pk2(t[o + 2], t[o + 3]), pk2(t[o + 4], t[o + 5]), pk2(t[o + 6], t[o + 7]))); }
        if (chunk_id >= 4) {
            bf16_t* hp = HT + (size_t)inst_index(b, h, d, chunk_id) * 4096 + (vb * 4 * 64 + lane) * 8;
#pragma unroll
            for (int s = 0; s < 4; ++s) *(bf16x8*)(hp + s * 512) = bfr[s];
        }
#pragma unroll
        for (int rt = 0; rt < 2; ++rt) {
            f32x16 acc;
#pragma unroll
            for (int g2 = 0; g2 < 2; ++g2) { const u32x4 w = n[rt][g2];
                acc[8 * g2] = bf2f(w.x & 0xffff); acc[8 * g2 + 1] = bf2f(w.x >> 16); acc[8 * g2 + 2] = bf2f(w.y & 0xffff); acc[8 * g2 + 3] = bf2f(w.y >> 16);
                acc[8 * g2 + 4] = bf2f(w.z & 0xffff); acc[8 * g2 + 5] = bf2f(w.z >> 16); acc[8 * g2 + 6] = bf2f(w.w & 0xffff); acc[8 * g2 + 7] = bf2f(w.w >> 16); }
#pragma unroll
            for (int s = 0; s < 4; ++s) acc = __builtin_amdgcn_mfma_f32_32x32x16_bf16(__builtin_bit_cast(bf16x8, a[rt][s]), bfr[s], acc, 0, 0, 0);
            hacc[rt] = acc;
        }
    }
}
__device__ __forceinline__ void phaseR4(LDSP unsigned char* lds, const Params& p) {
    const int tid = opaque(threadIdx.x), wid = tid >> 6, lane = tid & 63;
    LDSP int* nxt = (LDSP int*)(lds + SMEM_BYTES - 32);
    unsigned* qctr = (unsigned*)(p.ws + OFF_CTL + 16384 + 512);
    if ((int)blockIdx.x < 64 && gridDim.x >= 128) { if (wid < 2) scan_wave(p, blockIdx.x * 2 + wid, lane); }
    else if (gridDim.x < 128) { if (wid == 0) for (int it = blockIdx.x; it < 128; it += gridDim.x) scan_wave(p, it, lane); }
    for (;;) {
        __syncthreads();
        if (tid == 0) *nxt = (int)atomicAdd(qctr, 1u);
        __syncthreads();
        const int u = *nxt;
        if (u >= 512) break;
        attn_unit(lds, p, u);
    }
}

__device__ __forceinline__ void phaseR5(LDSP unsigned char* lds, const Params& p) {
    const int tid = opaque(threadIdx.x), wid = tid >> 6, lane = tid & 63, r = lane & 31, hh = lane >> 5;
    const bf16_t* CP = (const bf16_t*)(p.ws + OFF_CP); const bf16_t* CQ = (const bf16_t*)(p.ws + OFF_CQ); const bf16_t* HT = (const bf16_t*)(p.ws + OFF_HT);
    for (int wu = blockIdx.x * 8 + wid; wu < 2 * 64 * 16 * 2; wu += gridDim.x * 8) {
        const int half = wu & 1, u = wu >> 1, b = u >> 10, c = (u >> 4) & 63, h = u & 15;
        f32x16 y0 = zero16(), y1 = zero16();
#pragma unroll
        for (int d = 0; d < 2; ++d) {
            const size_t inst = (size_t)inst_index(b, h, d, 4 + c) * 4096;
            const int ii = d ? 63 - (32 * half + r) : (32 * half + r);
            const int it = ii >> 5, lp = hh * 32 + (ii & 31);
            f32x16 a0, a1;
#pragma unroll
            for (int g2 = 0; g2 < 2; ++g2) {
                const u32x4 w0 = *(const u32x4*)(CQ + inst + (((it * 2 + 0) * 2 + g2) * 64 + lp) * 8), w1 = *(const u32x4*)(CQ + inst + (((it * 2 + 1) * 2 + g2) * 64 + lp) * 8);
                a0[8 * g2] = bf2f(w0.x & 0xffff); a0[8 * g2 + 1] = bf2f(w0.x >> 16); a0[8 * g2 + 2] = bf2f(w0.y & 0xffff); a0[8 * g2 + 3] = bf2f(w0.y >> 16);
                a0[8 * g2 + 4] = bf2f(w0.z & 0xffff); a0[8 * g2 + 5] = bf2f(w0.z >> 16); a0[8 * g2 + 6] = bf2f(w0.w & 0xffff); a0[8 * g2 + 7] = bf2f(w0.w >> 16);
                a1[8 * g2] = bf2f(w1.x & 0xffff); a1[8 * g2 + 1] = bf2f(w1.x >> 16); a1[8 * g2 + 2] = bf2f(w1.y & 0xffff); a1[8 * g2 + 3] = bf2f(w1.y >> 16);
                a1[8 * g2 + 4] = bf2f(w1.z & 0xffff); a1[8 * g2 + 5] = bf2f(w1.z >> 16); a1[8 * g2 + 6] = bf2f(w1.w & 0xffff); a1[8 * g2 + 7] = bf2f(w1.w >> 16);
            }
#pragma unroll
            for (int s = 0; s < 4; ++s) {
                const bf16x8 pf = *(const bf16x8*)(CP + inst + ((it * 4 + s) * 64 + lp) * 8);
                const bf16x8 h0 = *(const bf16x8*)(HT + inst + ((0 * 4 + s) * 64 + lane) * 8), h1 = *(const bf16x8*)(HT + inst + ((1 * 4 + s) * 64 + lane) * 8);
                a0 = __builtin_amdgcn_mfma_f32_32x32x16_bf16(h0, pf, a0, 0, 0, 0);
                a1 = __builtin_amdgcn_mfma_f32_32x32x16_bf16(h1, pf, a1, 0, 0, 0);
            }
#pragma unroll
            for (int g = 0; g < 16; ++g) { y0[g] += a0[g]; y1[g] += a1[g]; }
        }
        const int tau = 32 * half + r; const size_t row = (size_t)b * T + c * 64 + tau;
        float sm = 0.f;
#pragma unroll
        for (int g = 0; g < 16; ++g) sm += y0[g] + y1[g];
        sm += __shfl_xor(sm, 32);
        const float mean = sm * (1.f / 64.f);
        float q2 = 0.f;
#pragma unroll
        for (int g = 0; g < 16; ++g) { y0[g] -= mean; y1[g] -= mean; q2 += y0[g] * y0[g] + y1[g] * y1[g]; }
        q2 += __shfl_xor(q2, 32);
        const float rstd = rsqrtf(q2 * (1.f / 64.f) + 64e-5f);
        const bf16_t* rs = (const bf16_t*)(p.ws + OFF_RS) + row * 1024 + h * 64; const bf16_t* ks = (const bf16_t*)(p.ws + OFF_KS) + row * 1024 + h * 64;
        const bf16_t* ai0 = (const bf16_t*)(p.ws + OFF_AIG) + row * 2048 + h * 64; const bf16_t* ai1 = ai0 + 1024;
        const bf16_t* vs = (const bf16_t*)(p.ws + OFF_VS) + row * 1024 + h * 64; const bf16_t* gg = (const bf16_t*)(p.ws + OFF_GG) + row * 1024 + h * 64;
        float bon = 0.f;
#pragma unroll
        for (int q = 0; q < 8; ++q) {
            const int ch = 32 * (q >> 2) + 8 * (q & 3) + 4 * hh;
            const u32x2 r2 = *(const u32x2*)(rs + ch), k2 = *(const u32x2*)(ks + ch), x2 = *(const u32x2*)(ai0 + ch), z2 = *(const u32x2*)(ai1 + ch);
            const f32x4 ka = *(const f32x4*)(p.k_a + h * 64 + ch), rk = *(const f32x4*)(p.r_k + h * 64 + ch);
            const float rr[4] = {bf2f(r2.x & 0xffff), bf2f(r2.x >> 16), bf2f(r2.y & 0xffff), bf2f(r2.y >> 16)}, kk[4] = {bf2f(k2.x & 0xffff), bf2f(k2.x >> 16), bf2f(k2.y & 0xffff), bf2f(k2.y >> 16)};
            const float xa[4] = {bf2f(x2.x & 0xffff), bf2f(x2.x >> 16), bf2f(x2.y & 0xffff), bf2f(x2.y >> 16)}, za[4] = {bf2f(z2.x & 0xffff), bf2f(z2.x >> 16), bf2f(z2.y & 0xffff), bf2f(z2.y >> 16)};
#pragma unroll
            for (int e = 0; e < 4; ++e) bon += rr[e] * (kk[e] * ((1.f + (xa[e] - 1.f) * ka[e]) + (1.f + (za[e] - 1.f) * ka[e]))) * rk[e];
        }
        bon += __shfl_xor(bon, 32);
        bf16_t* dst = (bf16_t*)(p.ws + OFF_MIX) + row * D + h * 64;
#pragma unroll
        for (int q = 0; q < 8; ++q) {
            const int ch = 32 * (q >> 2) + 8 * (q & 3) + 4 * hh, g0 = 4 * (q & 3);
            const f32x4 lg = *(const f32x4*)(p.lnx_g + h * 64 + ch), lb = *(const f32x4*)(p.lnx_b + h * 64 + ch);
            const u32x2 v2 = *(const u32x2*)(vs + ch), g2 = *(const u32x2*)(gg + ch);
            const float vv[4] = {bf2f(v2.x & 0xffff), bf2f(v2.x >> 16), bf2f(v2.y & 0xffff), bf2f(v2.y >> 16)}, gv[4] = {bf2f(g2.x & 0xffff), bf2f(g2.x >> 16), bf2f(g2.y & 0xffff), bf2f(g2.y >> 16)};
            float o[4];
#pragma unroll
            for (int e = 0; e < 4; ++e) { const float yv = (q < 4) ? y0[g0 + e] : y1[g0 + e]; o[e] = (yv * rstd * lg[e] + lb[e] + bon * vv[e]) * gv[e]; }
            *(u32x2*)(dst + ch) = mk2u(pk2(o[0], o[1]), pk2(o[2], o[3]));
        }
    }
}

__device__ __forceinline__ void phase6(LDSP unsigned char* lds, const Params& p) {
    pg8::Epi<FX1> epi{FX1{p.x, (const float*)(p.ws + OFF_MOD), (float*)(p.ws + OFF_X1)}};
    pg8::DenseSched S{(const char*)(p.ws + OFF_MIX), (const char*)(p.ws + OFF_WTOUT), NX / 256, D / 256, D, (int)gridDim.x, (int)blockIdx.x};
    pg8::gemm_phase<false>(lds, D, S, epi);
}

__device__ __forceinline__ void phase7(LDSP unsigned char* lds, const Params& p) {
    const int tid = opaque(threadIdx.x), wid = tid >> 6, lane = tid & 63;
    LDSP float* GS = (LDSP float*)lds;
    LDSP float* RSTD = (LDSP float*)(lds + 16384);
    LDSP float* PART = (LDSP float*)(lds + 16896);
    LDSP float* CB = (LDSP float*)(lds + 16896 + 65536);
    const float* MOD = (const float*)(p.ws + OFF_MOD);
    const float* X1 = (const float*)(p.ws + OFF_X1);
    bf16_t* H2 = (bf16_t*)(p.ws + OFF_H2);
    int* CNT = (int*)(p.ws + OFF_CTL + 16384);
    for (int u = blockIdx.x; u < NX / 32; u += gridDim.x) {
        const float* md = MOD + (size_t)((u * 32) >> 12) * 12288;
        for (int idx = tid; idx < D / 4; idx += 512) { const f32x4 g = *(const f32x4*)(p.norm2_g + 4 * idx), sh = *(const f32x4*)(md + 3 * D + 4 * idx), sc = *(const f32x4*)(md + 4 * D + 4 * idx);
            *(LDSP f32x4*)(GS + 4 * idx) = g * (sc + 1.f); *(LDSP f32x4*)(GS + D + 4 * idx) = sh; }
        __syncthreads();
#pragma unroll 1
        for (int rr = 0; rr < 4; ++rr) {
            const int t = 4 * wid + rr, row = u * 32 + t; const float* src = X1 + (size_t)row * D;
            f32x4 xv[8]; float ss = 0.f;
#pragma unroll
            for (int i = 0; i < 8; ++i) { xv[i] = ((const f32x4*)src)[lane + 64 * i]; ss += xv[i].x * xv[i].x + xv[i].y * xv[i].y + xv[i].z * xv[i].z + xv[i].w * xv[i].w; }
            ss = wave_sum(ss); const float rs = rsqrtf(ss * (1.f / D) + 1e-6f);
            if (lane == 0) RSTD[t] = rs;
#pragma unroll
            for (int i = 0; i < 8; ++i) { const int col = 4 * (lane + 64 * i);
                const f32x4 g = *(const LDSP f32x4*)(GS + col), sh = *(const LDSP f32x4*)(GS + D + col);
                const f32x4 hv = xv[i] * rs * g + sh;
                *(u32x2*)(H2 + (size_t)row * D + col) = mk2u(pk2(hv.x, hv.y), pk2(hv.z, hv.w)); }
        }
        {
            const int j = lane & 31, kk = lane >> 5, k0 = wid * 256;
            unsigned xoff = (unsigned)((u * 32 + j) * D + k0 + 4 * kk) * 4u;
            unsigned woff = (unsigned)((k0 + 4 * kk) * 64 + j) * 4u;
            unsigned goff = (unsigned)(k0 + 4 * kk) * 4u;
            f32x16 acc0 = zero16(), acc1 = zero16(); float c0 = 0.f, c1 = 0.f;
#pragma unroll 2
            for (int q = 0; q < 32; ++q) {
                const f32x4 xa = *(const f32x4*)((const char*)X1 + xoff);
                const f32x4 gv = *(const LDSP f32x4*)((const LDSP char*)GS + goff), sv = *(const LDSP f32x4*)((const LDSP char*)GS + D * 4 + goff);
                float b0[4], b1[4];
#pragma unroll
                for (int e = 0; e < 4; ++e) { b0[e] = *(const float*)((const char*)p.w_router + woff + e * 256); b1[e] = *(const float*)((const char*)p.w_router + woff + e * 256 + 128); }
#pragma unroll
                for (int e = 0; e < 4; ++e) {
                    acc0 = __builtin_amdgcn_mfma_f32_32x32x2f32(xa[e], b0[e] * gv[e], acc0, 0, 0, 0);
                    acc1 = __builtin_amdgcn_mfma_f32_32x32x2f32(xa[e], b1[e] * gv[e], acc1, 0, 0, 0);
                    c0 += sv[e] * b0[e]; c1 += sv[e] * b1[e];
                }
                xoff += 32u; woff += 2048u; goff += 32u;
            }
            c0 += __shfl_xor(c0, 32); c1 += __shfl_xor(c1, 32);
#pragma unroll
            for (int g = 0; g < 16; ++g) { const int t = crow(g, kk); PART[(wid * 32 + t) * 64 + j] = acc0[g]; PART[(wid * 32 + t) * 64 + 32 + j] = acc1[g]; }
            if (kk == 0) { CB[wid * 64 + j] = c0; CB[wid * 64 + 32 + j] = c1; }
        }
        __syncthreads();
        float cb = 0.f;
#pragma unroll
        for (int w = 0; w < 8; ++w) cb += CB[w * 64 + lane];
        const float eb = p.expert_bias[lane];
#pragma unroll 1
        for (int rr = 0; rr < 4; ++rr) {
            const int t = 4 * wid + rr, token = u * 32 + t;
            float sum = 0.f;
#pragma unroll
            for (int w = 0; w < 8; ++w) sum += PART[(w * 32 + t) * 64 + lane];
            const float logit = RSTD[t] * sum + cb;
            const float score = 1.f / (1.f + expf(-logit));
            const float v = score + eb;
            const int gi = lane >> 3;
            float m1 = v;
            m1 = fmaxf(m1, __shfl_xor(m1, 1)); m1 = fmaxf(m1, __shfl_xor(m1, 2)); m1 = fmaxf(m1, __shfl_xor(m1, 4));
            const unsigned long long eq = __ballot(v == m1);
            const unsigned gbits = (unsigned)((eq >> (gi * 8)) & 0xffull);
            const bool first = (lane & 7) == (__ffs((int)gbits) - 1);
            float v2 = first ? -INFINITY : v;
            v2 = fmaxf(v2, __shfl_xor(v2, 1)); v2 = fmaxf(v2, __shfl_xor(v2, 2)); v2 = fmaxf(v2, __shfl_xor(v2, 4));
            const float gs = m1 + v2;
            int gr = 0;
#pragma unroll
            for (int jj = 0; jj < 8; ++jj) { const float gj = __builtin_bit_cast(float, __builtin_amdgcn_readlane(__builtin_bit_cast(int, gs), jj * 8)); gr += (gj > gs || (gj == gs && jj < gi)) ? 1 : 0; }
            const float mv = (gr < 4) ? v : -INFINITY;
            int rk = 0;
#pragma unroll
            for (int j8 = 0; j8 < 8; ++j8) {
#pragma unroll
                for (int j1 = 0; j1 < 8; ++j1) { const int jj = 8 * j8 + j1; const float vj = __builtin_bit_cast(float, __builtin_amdgcn_readlane(__builtin_bit_cast(int, mv), jj)); rk += (vj > mv || (vj == mv && jj < lane)) ? 1 : 0; }
                __builtin_amdgcn_sched_barrier(0);
            }
            const bool sel = (rk < 8) && (gr < 4);
            const float gsum = wave_sum(sel ? score : 0.f);
            if (sel) {
                const int slot = atomicAdd(&CNT[lane], 1);
                ((int*)(p.ws + OFF_EIDX))[token * 8 + rk] = lane;
                ((int*)(p.ws + OFF_ESLOT))[token * 8 + rk] = slot;
                ((float*)(p.ws + OFF_GATE))[token * 8 + rk] = score / gsum * 2.5f;
                ((int*)(p.ws + OFF_TOKL))[(size_t)lane * NX + slot] = token;
            }
        }
        __syncthreads();
    }
}

constexpr int LE_TAB = 131072;
__device__ __forceinline__ void build_expert_tables(LDSP unsigned char* lds, const Params& p) {
    LDSP int* TP = (LDSP int*)(lds + LE_TAB); LDSP int* ST = TP + 72; LDSP int* CN = ST + 72;
    if (threadIdx.x < NEX) CN[threadIdx.x] = (threadIdx.x < NE) ? ((const int*)(p.ws + OFF_CTL + 16384))[threadIdx.x] : NX;
    __syncthreads();
    if (threadIdx.x == 0) {
        int tp = 0, st = 0;
        for (int e = 0; e < NEX; ++e) { const int cn = CN[e]; TP[e] = tp; ST[e] = st; tp += (cn + 255) >> 8; st += cn; }
        TP[NEX] = tp; ST[NEX] = st;
    }
    __syncthreads();
}

struct GroupSched {
    const LDSP int* TP; const LDSP int* ST; const LDSP int* CN;
    const char* A; const char* B; const int* tokl; int ntn, K, G, c; size_t bstride; bool gather;
    __device__ __forceinline__ bool next(int i, pg8::Unit& u) const {
        const int total = __builtin_amdgcn_readfirstlane(TP[NEX]) * ntn; const long L = (long)i * G + c; if (L >= total) return false;
        const int w = pg8::xcd_remap((int)L, total);
        const int nt = w % ntn, mtg = w / ntn;
        int e = 0, hi = NEX;
        while (hi - e > 1) { const int mid = (e + hi) >> 1; if (__builtin_amdgcn_readfirstlane(TP[mid]) <= mtg) e = mid; else hi = mid; }
        const int tpe = __builtin_amdgcn_readfirstlane(TP[e]), ste = __builtin_amdgcn_readfirstlane(ST[e]), cne = __builtin_amdgcn_readfirstlane(CN[e]);
        const int mt = mtg - tpe;
        u.B = B + (size_t)e * bstride + (size_t)nt * 256 * K * 2;
        u.nvalid = cne; u.m0 = mt * 256; u.pos0 = ste; u.row0 = 0; u.col0 = nt * 256;
        if (gather) { u.A = A; u.rowmap = (e < NE) ? tokl + (size_t)e * NX : nullptr; }
        else { u.A = A + (size_t)(ste + mt * 256) * K * 2; u.rowmap = nullptr; }
        return true;
    }
};
__device__ __forceinline__ void phase8(LDSP unsigned char* lds, const Params& p) {
    build_expert_tables(lds, p);
    const LDSP int* TP = (const LDSP int*)(lds + LE_TAB);
    pg8::Epi<FH1> epi{FH1{(bf16_t*)(p.ws + OFF_H1)}};
    GroupSched S{TP, TP + 72, TP + 144, (const char*)(p.ws + OFF_H2), (const char*)(p.ws + OFF_WTE1), (const int*)(p.ws + OFF_TOKL), 4, D, (int)gridDim.x, (int)blockIdx.x,
                 (size_t)1024 * 2048 * 2, true};
    pg8::gemm_phase<true>(lds, D, S, epi);
}
__device__ __forceinline__ void phase9(LDSP unsigned char* lds, const Params& p) {
    build_expert_tables(lds, p);
    const LDSP int* TP = (const LDSP int*)(lds + LE_TAB);
    pg8::Epi<FEO> epi{FEO{(bf16_t*)(p.ws + OFF_EO)}};
    GroupSched S{TP, TP + 72, TP + 144, (const char*)(p.ws + OFF_H1), (const char*)(p.ws + OFF_WTE2), nullptr, 8, EFF, (int)gridDim.x, (int)blockIdx.x,
                 (size_t)2048 * 512 * 2, false};
    pg8::gemm_phase<false, false>(lds, EFF, S, epi);
}
__device__ __forceinline__ void phase10(LDSP unsigned char* lds, const Params& p) {
    build_expert_tables(lds, p);
    const LDSP int* ST = (const LDSP int*)(lds + LE_TAB) + 72;
    const int tid = opaque(threadIdx.x), wid = tid >> 6, lane = tid & 63;
    const float* MOD = (const float*)(p.ws + OFF_MOD);
    const float* X1 = (const float*)(p.ws + OFF_X1);
    const bf16_t* EO = (const bf16_t*)(p.ws + OFF_EO);
    for (int row = blockIdx.x * 8 + wid; row < NX; row += gridDim.x * 8) {
        unsigned er[9]; float gw[9];
#pragma unroll
        for (int k = 0; k < 8; ++k) { const int e = ((const int*)(p.ws + OFF_EIDX))[row * 8 + k], sl = ((const int*)(p.ws + OFF_ESLOT))[row * 8 + k];
            er[k] = (unsigned)(ST[e] + sl) * (unsigned)D; gw[k] = ((const float*)(p.ws + OFF_GATE))[row * 8 + k]; }
        er[8] = (unsigned)(ST[NE] + row) * (unsigned)D; gw[8] = 1.f;
        const float* md = MOD + (size_t)(row >> 12) * 12288 + 5 * D;
        LDSP float* RB = (LDSP float*)lds + wid * 2048;
        float ss = 0.f;
#pragma unroll 2
        for (int i = 0; i < 8; ++i) { const int col = 4 * (lane + 64 * i);
            f32x4 a = mk4f(0.f, 0.f, 0.f, 0.f);
#pragma unroll
            for (int k = 0; k < 9; ++k) { const u32x2 w = *(const u32x2*)(EO + er[k] + col);
                a.x += gw[k] * bf2f(w.x & 0xffff); a.y += gw[k] * bf2f(w.x >> 16); a.z += gw[k] * bf2f(w.y & 0xffff); a.w += gw[k] * bf2f(w.y >> 16); }
            const f32x4 x1 = *(const f32x4*)(X1 + (size_t)row * D + col), g2 = *(const f32x4*)(md + col);
            f32x4 xv; xv.x = x1.x + g2.x * a.x; xv.y = x1.y + g2.y * a.y; xv.z = x1.z + g2.z * a.z; xv.w = x1.w + g2.w * a.w;
            ss += xv.x * xv.x + xv.y * xv.y + xv.z * xv.z + xv.w * xv.w;
            *(LDSP f32x4*)(RB + col) = xv; }
        ss = wave_sum(ss); const float rs = rsqrtf(ss * (1.f / D) + 1e-6f);
#pragma unroll 4
        for (int i = 0; i < 8; ++i) { const int col = 4 * (lane + 64 * i); const f32x4 g = *(const f32x4*)(p.final_g + col);
            const f32x4 xv = *(const LDSP f32x4*)(RB + col);
            f32x4 o; o.x = xv.x * rs * g.x; o.y = xv.y * rs * g.y; o.z = xv.z * rs * g.z; o.w = xv.w * rs * g.w;
            *(f32x4*)(p.out + (size_t)row * D + col) = o; }
    }
}


#define XB_TMO      128
#define XB_XCNT(j)  (256  + 64 * (j))
#define XB_XSUB(j)  (1280 + 64 * (j))
#define XB_XGEN(j)  (2304 + 64 * (j))
#define XB_TOP      3328
#define XB_TOPGEN   3392
#define XB_SPIN_CAP (1u << 20)
__device__ __forceinline__ unsigned xb_ld(unsigned* p)              { return __hip_atomic_load(p, __ATOMIC_RELAXED, __HIP_MEMORY_SCOPE_AGENT); }
__device__ __forceinline__ unsigned xb_add(unsigned* p, unsigned v) { return __hip_atomic_fetch_add(p, v, __ATOMIC_RELAXED, __HIP_MEMORY_SCOPE_AGENT); }
__device__ __forceinline__ unsigned xb_xcc_id() { return (unsigned)__builtin_amdgcn_s_getreg((3 << 11) | 20) & 0xFu; }
#define XB_SPIN(cond, bar) do { unsigned _sp = 0; while (cond) { __builtin_amdgcn_s_sleep(1); \
    if ((++_sp & 255u) == 0u) { if (xb_ld(&(bar)[XB_TMO])) break; if (_sp > XB_SPIN_CAP) { atomicAdd(&(bar)[XB_TMO], 1u); break; } } } } while (0)
__device__ __forceinline__ unsigned xcd_barrier_complete(unsigned* bar, unsigned x) {
    const unsigned G = gridDim.x * gridDim.y * gridDim.z;
    unsigned sum, cnt, mine, sp = 0u;
    for (;;) {
        sum = 0u; cnt = 0u; mine = 0u;
#pragma unroll
        for (unsigned j = 0; j < 16; ++j) { const unsigned c = xb_ld(&bar[XB_XCNT(j)]); sum += c; cnt += (c > 0u) ? 1u : 0u; mine = (j == x) ? c : mine; }
        if (sum == G) break;
        __builtin_amdgcn_s_sleep(1);
        if ((++sp & 255u) == 0u) { if (xb_ld(&bar[XB_TMO])) break; if (sp > XB_SPIN_CAP) { atomicAdd(&bar[XB_TMO], 1u); break; } }
    }
    return (mine > 0u ? mine : 1u) | ((cnt > 0u ? cnt : 1u) << 16);
}
__device__ __forceinline__ void xcd_barrier(unsigned* bar, unsigned x, volatile LDSP unsigned* st) {
    asm volatile("s_waitcnt vmcnt(0)" ::: "memory");
    __syncthreads();
    if (threadIdx.x == 0) {
        __builtin_amdgcn_s_waitcnt(0);
        unsigned pk = st[0];
        if (pk == 0u) { pk = xcd_barrier_complete(bar, x); st[0] = pk; }
        const unsigned nloc = pk & 0xffffu, nx = pk >> 16;
        const unsigned old = xb_add(&bar[XB_XSUB(x)], 1u);
        const unsigned gen = old / nloc;
        if (old + 1u == (gen + 1u) * nloc) {
            __builtin_amdgcn_fence(__ATOMIC_RELEASE, "agent");
            asm volatile("s_waitcnt vmcnt(0)" ::: "memory");
            const unsigned og = xb_add(&bar[XB_TOP], 1u);
            const unsigned tg = og / nx;
            if (og + 1u == (tg + 1u) * nx) xb_add(&bar[XB_TOPGEN], 1u);
            else XB_SPIN(xb_ld(&bar[XB_TOPGEN]) == tg, bar);
            __builtin_amdgcn_fence(__ATOMIC_ACQUIRE, "agent");
            xb_add(&bar[XB_XGEN(x)], 1u);
            asm volatile("s_waitcnt vmcnt(0)" ::: "memory");
        } else {
            XB_SPIN(xb_ld(&bar[XB_XGEN(x)]) == gen, bar);
            __builtin_amdgcn_fence(__ATOMIC_ACQUIRE, "agent");
            asm volatile("s_waitcnt vmcnt(0)" ::: "memory");
        }
    }
    __syncthreads();
}

__global__ void __launch_bounds__(512, 2) fwd_megakernel(Params p) {
    __shared__ __attribute__((aligned(16))) unsigned char smem_raw[SMEM_BYTES];
    LDSP unsigned char* lds = (LDSP unsigned char*)smem_raw;
    volatile LDSP unsigned* xst = (volatile LDSP unsigned*)(lds + SMEM_BYTES - 16);
    if (threadIdx.x == 0) { xst[0] = 0u; xst[1] = 0u; }
    __syncthreads();
    const unsigned xcc = xb_xcc_id();
    if (threadIdx.x == 0) (void)xb_add(&((unsigned*)p.ws)[XB_XCNT(xcc)], 1u);
#define GSYNC xcd_barrier((unsigned*)p.ws, xcc, xst)
#ifndef PH_TWICE
#define PH_TWICE 0
#endif
#ifndef PH_MASK
#define PH_MASK 0xffff
#endif
#define RUN_PHASE(bit, fn) _Pragma("unroll 1") for (int rep = 0; rep < ((PH_TWICE & (bit)) ? 2 : 1); ++rep) { if (rep) GSYNC; if (PH_MASK & (bit)) { Params q = p; q.ws = opq(p.ws); fn(lds, q); } }
    RUN_PHASE(1, phase0)      GSYNC;
    RUN_PHASE(2, phase1)      GSYNC;
    RUN_PHASE(4, phase2)      GSYNC;
    RUN_PHASE(8, phaseR1)     GSYNC;
    RUN_PHASE(16, phaseR2)    GSYNC;
    RUN_PHASE(32, phaseR3)    GSYNC;
    RUN_PHASE(64, phaseR4)    GSYNC;
    RUN_PHASE(128, phaseR5)   GSYNC;
    RUN_PHASE(256, phase6)    GSYNC;
    RUN_PHASE(512, phase7)    GSYNC;
    RUN_PHASE(1024, phase8)   GSYNC;
    RUN_PHASE(2048, phase9)   GSYNC;
    RUN_PHASE(4096, phase10)
}

extern "C" void kernel_launch(void* const* d_in, const int* in_sizes, int n_in, void* d_out, int out_size, void* d_ws, size_t ws_size, hipStream_t stream) {
    static int grid_blocks = 0;
    if (!grid_blocks) {
        int dev = 0, cus = 0, per_cu = 0;
        (void)hipGetDevice(&dev);
        (void)hipDeviceGetAttribute(&cus, hipDeviceAttributeMultiprocessorCount, dev);
        (void)hipOccupancyMaxActiveBlocksPerMultiprocessor(&per_cu, fwd_megakernel, 512, 0);
        if (per_cu > 1) per_cu = 1;
        grid_blocks = cus * per_cu;
        if (ws_size < WS_END) fprintf(stderr, "workspace too small: %zu < %zu\n", ws_size, (size_t)WS_END);
    }
    Params p{};
    const float** f = (const float**)&p;
    for (int i = 0; i < 31; ++i) f[i] = (const float*)d_in[i];
    p.out = (float*)d_out; p.ws = (unsigned char*)d_ws;
    (void)hipMemsetAsync(d_ws, 0, 32768, stream);
    void* args[] = {&p};
    hipError_t e = hipLaunchCooperativeKernel((void*)fwd_megakernel, dim3(grid_blocks), dim3(512), args, 0, stream);
    if (e != hipSuccess) fprintf(stderr, "cooperative launch failed: %s (grid %d)\n", hipGetErrorString(e), grid_blocks);
}
```

```cpp
#include <hip/hip_runtime.h>
#include <hip/hip_cooperative_groups.h>
#include <cstdio>
#include <cstdint>
namespace cg = cooperative_groups;

#define LDSP __attribute__((address_space(3)))
typedef unsigned short bf16_t;
typedef short bf16x8 __attribute__((ext_vector_type(8)));
typedef float f32x4 __attribute__((ext_vector_type(4)));
typedef float f32x16 __attribute__((ext_vector_type(16)));
typedef unsigned u32x4 __attribute__((ext_vector_type(4)));
typedef unsigned u32x2 __attribute__((ext_vector_type(2)));
typedef int v4i __attribute__((ext_vector_type(4)));
typedef int v8i __attribute__((ext_vector_type(8)));
__device__ __forceinline__ u32x4 mk4u(unsigned a, unsigned b, unsigned c, unsigned d) { u32x4 r; r.x = a; r.y = b; r.z = c; r.w = d; return r; }
__device__ __forceinline__ u32x2 mk2u(unsigned a, unsigned b) { u32x2 r; r.x = a; r.y = b; return r; }
__device__ __forceinline__ f32x4 mk4f(float a, float b, float c, float d) { f32x4 r; r.x = a; r.y = b; r.z = c; r.w = d; return r; }

constexpr int D = 2048, NB = 2, T = 4096, CL = 256, NX = NB * T, NCX = NB * CL, NR = NX + NCX;
constexpr int INC = 5056, INP = 5120;
constexpr int C_R = 0, C_K = 1024, C_V = 2048, C_XW = 3072, C_XA = 3168, C_XG = 3264, C_Q = 3520, C_AK = 4544, C_AV = 4800;
constexpr int NE = 64, NEX = 65, EFF = 512;
constexpr int NCHUNK = 68;
constexpr int NINST = NB * 16 * 2 * NCHUNK;
constexpr int EROWS = NX * 8 + NX;

constexpr size_t al4k(size_t x) { return (x + 4095) & ~(size_t)4095; }
constexpr size_t OFF_CTL = 0;
constexpr size_t OFF_ROPE = 65536;
constexpr size_t OFF_MODP = OFF_ROPE + 8192;
constexpr size_t OFF_MOD = al4k(OFF_MODP + (size_t)16 * 3 * 12288 * 4);
constexpr size_t OFF_WTDU = al4k(OFF_MOD + (size_t)3 * 12288 * 4);
constexpr size_t OFF_WTIU = OFF_WTDU + (size_t)2 * 1024 * 128 * 2;
constexpr size_t OFF_WTGU = OFF_WTIU + (size_t)2 * 1024 * 128 * 2;
constexpr size_t OFF_WTE2 = OFF_WTGU + (size_t)1024 * 256 * 2;
constexpr size_t OFF_X1 = OFF_WTE2 + (size_t)NEX * 2048 * 512 * 2;
constexpr size_t OFF_H2 = OFF_X1 + (size_t)NX * D * 4;
constexpr size_t OFF_TOKL = OFF_H2 + (size_t)NX * D * 2;
constexpr size_t OFF_EIDX = OFF_TOKL + (size_t)NE * NX * 4;
constexpr size_t OFF_ESLOT = OFF_EIDX + (size_t)NX * 8 * 4;
constexpr size_t OFF_GATE = OFF_ESLOT + (size_t)NX * 8 * 4;
constexpr size_t OFF_H1 = OFF_GATE + (size_t)NX * 8 * 4;
constexpr size_t OFF_WTE1 = al4k(OFF_H1 + (size_t)(EROWS + 256) * EFF * 2);
constexpr size_t OFF_EO = OFF_WTE1;
constexpr size_t OFF_WTIN = OFF_WTE1 + (size_t)NEX * 1024 * 2048 * 2;
constexpr size_t OFF_WTOUT = OFF_WTIN + (size_t)INP * D * 2;
constexpr size_t OFF_HX = OFF_WTOUT + (size_t)D * D * 2;
constexpr size_t OFF_PX = OFF_HX + (size_t)NR * D * 2;
constexpr size_t OFF_CM = OFF_PX + (size_t)NR * INP * 2;
constexpr size_t OFF_CN = OFF_CM + (size_t)NINST * 4096 * 2;
constexpr size_t OFF_CP = OFF_CN + (size_t)NINST * 4096 * 2;
constexpr size_t OFF_CQ = OFF_CP + (size_t)NINST * 4096 * 2;
constexpr size_t OFF_YD = OFF_CQ + (size_t)NINST * 4096 * 2;
constexpr size_t OFF_BON = OFF_YD + (size_t)2 * NX * 1024 * 4;
constexpr size_t OFF_MIX = OFF_BON + (size_t)2 * NX * 16 * 4;
constexpr size_t WS_END = OFF_MIX + (size_t)NX * D * 2;
constexpr size_t OFF_RS = OFF_X1;
constexpr size_t OFF_KS = OFF_RS + (size_t)NR * 1024 * 2;
constexpr size_t OFF_KK = OFF_KS + (size_t)NR * 1024 * 2;
constexpr size_t OFF_VS = OFF_KK + (size_t)NR * 1024 * 2;
constexpr size_t OFF_TW = OFF_VS + (size_t)NR * 1024 * 2;
constexpr size_t OFF_XA = OFF_TW + (size_t)NR * 128 * 2;
constexpr size_t OFF_SG = OFF_XA + (size_t)NR * 128 * 2;
constexpr size_t OFF_LWG = OFF_SG + (size_t)NX * 256 * 2;
constexpr size_t OFF_AIG = OFF_LWG + (size_t)NR * 2048 * 2;
constexpr size_t OFF_GG = OFF_AIG + (size_t)NR * 2048 * 2;
static_assert(OFF_GG + (size_t)NX * 1024 * 2 <= OFF_WTE1, "RWKV token buffers fit the overlay region");
static_assert(OFF_EO + (size_t)EROWS * D * 2 <= OFF_HX, "EO overlays only WT_E1/WT_IN/WT_OUT");
static_assert(WS_END <= (size_t)1073741824, "workspace map must fit 1 GiB");

constexpr int SMEM_BYTES = 157 * 1024;

struct Params {
    const float *x, *c, *ctx, *c_ctx, *w_mod, *b_mod, *norm1_g, *norm2_g, *w_in, *shift_mu, *k_k, *k_a, *r_k, *decay_bias, *decay_up, *iclr_bias, *iclr_up,
        *gate_up, *lnx_g, *lnx_b, *attn_sink, *w_out, *w_router, *expert_bias, *e_gate, *e_up, *e_down, *s_gate, *s_up, *s_down, *final_g;
    float* out;
    unsigned char* ws;
};

__device__ __forceinline__ unsigned f2bf(float f) { unsigned u = __float_as_uint(f); return (u + 0x7fffu + ((u >> 16) & 1u)) >> 16; }
__device__ __forceinline__ float bf2f(unsigned h) { return __uint_as_float(h << 16); }
typedef float f32x2_t __attribute__((ext_vector_type(2)));
typedef __bf16 bf16x2_t __attribute__((ext_vector_type(2)));
__device__ __forceinline__ unsigned pk2(float lo, float hi) { f32x2_t v = {lo, hi}; bf16x2_t b = __builtin_convertvector(v, bf16x2_t); return __builtin_bit_cast(unsigned, b); }
__device__ __forceinline__ unsigned pk4_fp8(float a, float b, float c, float d) { int w = 0; w = __builtin_amdgcn_cvt_pk_fp8_f32(a, b, w, false); w = __builtin_amdgcn_cvt_pk_fp8_f32(c, d, w, true); return (unsigned)w; }
__device__ __forceinline__ float wave_sum(float v) {
#pragma unroll
    for (int o = 32; o > 0; o >>= 1) v += __shfl_xor(v, o);
    return v;
}
__device__ __forceinline__ int opaque(int x) { asm volatile("" : "+v"(x)); return x; }
__device__ __forceinline__ int opaque_s(int x) { asm volatile("" : "+s"(x)); return x; }
__device__ __forceinline__ unsigned char* opq(unsigned char* x) {
    unsigned long long v = (unsigned long long)x; asm volatile("" : "+s"(v));
    return (unsigned char*)(__attribute__((address_space(1))) unsigned char*)v; }
__device__ __forceinline__ float sigmoidf_(float x) { return __builtin_amdgcn_rcpf(1.f + __expf(-x)); }
__device__ __forceinline__ int lds_byte(int r, int c) { const int st = (r >> 4) * 2 + (c >> 5), rr = r & 15, cc = c & 31, ob = rr * 64 + cc * 2; return st * 1024 + (ob ^ (((ob >> 9) & 1) << 5)); }
__device__ __forceinline__ int sw64(int r, int k) { return r * 128 + ((((k >> 3) ^ (r >> 1)) & 7) << 4) + (k & 7) * 2; }

__device__ __forceinline__ f32x16 zero16() { f32x16 z;
#pragma unroll
    for (int i = 0; i < 16; ++i) z[i] = 0.f; return z; }
__device__ __forceinline__ int crow(int reg, int hi) { return (reg & 3) + 8 * (reg >> 2) + 4 * hi; }

namespace pg8 {
constexpr int BM = 256, BK = 64, HALF = 128, HTB = HALF * BK * 2, NXCD = 8;
__device__ __forceinline__ void stage_rc(int b, int& R, int& C) { const int st = b / 1024, sb = b % 1024, swz = sb ^ (((sb >> 9) & 1) << 5); R = (st >> 1) * 16 + swz / 64; C = (st & 1) * 32 + (swz % 64) / 2; }
struct Unit { const char* A; const char* B; const int* rowmap; int nvalid, m0, row0, col0, pos0; };
__device__ __forceinline__ int xcd_remap(int L, int nwg) { const int q = nwg / NXCD, r = nwg % NXCD, xcd = L % NXCD, off = L / NXCD; return (xcd < r ? xcd * (q + 1) : r * (q + 1) + (xcd - r) * q) + off; }

__device__ __forceinline__ int perm32(int rho) { const int n = rho >> 4, i = rho & 15; return 8 * (i >> 2) + 4 * n + (i & 3); }
template <class F, int NBJ = 2> struct Epi {
    F f;
    __device__ __forceinline__ void operator()(const f32x4 (&acc)[2][2][4][2], const Unit& u, int wr, int wc, int fr, int fq) const {
#pragma unroll
        for (int ai = 0; ai < 2; ++ai)
#pragma unroll
            for (int m = 0; m < 4; ++m)
#pragma unroll
                for (int bj = 0; bj < NBJ; ++bj) { f(u, 128 * ai + 64 * wr + 16 * m + fr, 128 * bj + 32 * wc + 8 * fq, acc[ai][bj][m][0], acc[ai][bj][m][1]); __builtin_amdgcn_sched_barrier(0); }
    }
};

template <bool GATHER, bool ALIGN_EPI = true, bool FP8 = false, class EpiT, class Sched>
__device__ __forceinline__ void gemm_phase(LDSP unsigned char* lds, const int K, const Sched& S, const EpiT& E) {
    const int tid = opaque(threadIdx.x), wid = __builtin_amdgcn_readfirstlane(tid >> 6), lane = tid & 63, wr = wid >> 2, wc = wid & 3, fr = lane & 15, fq = lane >> 4;
    const int nt = K / BK;
    unsigned voffA[2], voffB[2];
#pragma unroll
    for (int i = 0; i < 2; ++i) { int R, C; stage_rc(tid * 16 + i * 8192, R, C); const int Rb = (R & ~31) + perm32(R & 31); voffA[i] = (unsigned)(R * K + C) * 2u; voffB[i] = (unsigned)(Rb * K + C) * 2u; }
    const size_t kstep = (size_t)(BK * 2);
    const size_t hstep = (size_t)HALF * K * 2;
    const size_t hstepB = hstep;
    const unsigned ldsw = (unsigned)wid * 1024u;
    const int aoff = lds_byte(wr * 64 + fr, fq * 8), boff = lds_byte(wc * 32 + fr, fq * 8);
#define PG8_SA(b, h) (((b) * 2 + (h)) * HTB)
#define PG8_SB(b, h) ((4 + (b) * 2 + (h)) * HTB)
#define PG8_STAGE(bufoff, gbase, voff) do { _Pragma("unroll") for (int _i = 0; _i < 2; ++_i) \
        __builtin_amdgcn_global_load_lds((const unsigned*)((const char*)(gbase) + (voff)[_i]), (LDSP unsigned*)(lds + (bufoff) + ldsw + _i * 8192), 16, 0, 0); } while (0)
#define PG8_STAGE_B1(bufoff, gbase) do { if constexpr (!FP8) { PG8_STAGE(bufoff, gbase, voffB); } } while (0)
#define PG8_STAGE_A(bufoff, nx, h, ubase, koff) do { if constexpr (GATHER) { unsigned _v[2]; const LDSP unsigned* _ro = rowoff + ((((nx) ? (ui + 1) : ui) & 1) * 4 + (h) * 2) * 512; _v[0] = _ro[0]; _v[1] = _ro[512]; PG8_STAGE(bufoff, (ubase) + (koff), _v); } \
        else { PG8_STAGE(bufoff, (ubase) + (h) * hstep + (koff), voffA); } } while (0)
#define PG8_LD16(off) (*(const LDSP bf16x8*)(lds + (off)))
#define PG8_LDA(dst, b, h) do { _Pragma("unroll") for (int m = 0; m < 4; ++m) { if constexpr (FP8) dst##8[m] = __builtin_shufflevector(__builtin_bit_cast(v4i, PG8_LD16(PG8_SA(b, h) + aoff + m * 2048)), __builtin_bit_cast(v4i, PG8_LD16(PG8_SA(b, h) + aoff + m * 2048 + 1024)), 0, 1, 2, 3, 4, 5, 6, 7); \
        else { _Pragma("unroll") for (int k = 0; k < 2; ++k) dst[m][k] = PG8_LD16(PG8_SA(b, h) + aoff + m * 2048 + k * 1024); } } } while (0)
#define PG8_LDB(dst, b, h) do { if constexpr (!FP8 || (h) == 0) { _Pragma("unroll") for (int n = 0; n < 2; ++n) { if constexpr (FP8) dst##8[n] = __builtin_shufflevector(__builtin_bit_cast(v4i, PG8_LD16(PG8_SB(b, h) + boff + n * 2048)), __builtin_bit_cast(v4i, PG8_LD16(PG8_SB(b, h) + boff + n * 2048 + 1024)), 0, 1, 2, 3, 4, 5, 6, 7); \
        else { _Pragma("unroll") for (int k = 0; k < 2; ++k) dst[n][k] = PG8_LD16(PG8_SB(b, h) + boff + n * 2048 + k * 1024); } } } } while (0)
#define PG8_MMA(ai, bj, At, Bt) do { if constexpr (!FP8 || (bj) == 0) { __builtin_amdgcn_s_setprio(1); if constexpr (FP8) { _Pragma("unroll") for (int m = 0; m < 4; ++m) _Pragma("unroll") for (int n = 0; n < 2; ++n) \
            acc[ai][bj][m][n] = __builtin_amdgcn_mfma_scale_f32_16x16x128_f8f6f4(Bt##8[n], At##8[m], acc[ai][bj][m][n], 0, 0, 0, 0x7f7f7f7f, 0, 0x7f7f7f7f); } \
        else { _Pragma("unroll") for (int m = 0; m < 4; ++m) _Pragma("unroll") for (int n = 0; n < 2; ++n) _Pragma("unroll") for (int k = 0; k < 2; ++k) \
            acc[ai][bj][m][n] = __builtin_amdgcn_mfma_f32_16x16x32_bf16(Bt[n][k], At[m][k], acc[ai][bj][m][n], 0, 0, 0); } __builtin_amdgcn_s_setprio(0); } } while (0)
#define PG8_WAIT_V(n) asm volatile("s_waitcnt vmcnt(" #n ")" ::: "memory")
#define PG8_WAIT_L(n) asm volatile("s_waitcnt lgkmcnt(" #n ")" ::: "memory")
#define PG8_BAR __builtin_amdgcn_s_barrier()
#define PG8_SCHED __builtin_amdgcn_sched_barrier(0)
    Unit cur, nxt; int ui = 0;
    if (!S.next(0, cur)) return;
    LDSP unsigned* rowoff = (LDSP unsigned*)(lds + 132096) + tid;
    auto rows_of = [&](const Unit& u, int slot) {
        if constexpr (GATHER) {
#pragma unroll
            for (int h = 0; h < 2; ++h)
#pragma unroll
                for (int i = 0; i < 2; ++i) { int R, C; stage_rc(tid * 16 + i * 8192, R, C); const int idx = u.m0 + h * HALF + R; int gr = idx; if (u.rowmap) gr = (idx < u.nvalid) ? u.rowmap[idx] : 0;
                    rowoff[((slot & 1) * 4 + h * 2 + i) * 512] = (unsigned)(gr * K + C) * 2u; }
        }
    };
    rows_of(cur, 0);
    f32x4 acc[2][2][4][2];
#pragma unroll
    for (int a = 0; a < 2; ++a)
#pragma unroll
        for (int b = 0; b < 2; ++b)
#pragma unroll
            for (int m = 0; m < 4; ++m)
#pragma unroll
                for (int n = 0; n < 2; ++n) acc[a][b][m][n] = (f32x4){0.f, 0.f, 0.f, 0.f};
    bf16x8 At[4][2], B0[2][2], B1[2][2];
    v8i At8[4], B08[2], B18[2];
    const char* cA = cur.A; const char* cB = cur.B;
    PG8_STAGE(PG8_SB(0, 0), cB, voffB); PG8_STAGE_B1(PG8_SB(0, 1), cB + hstepB); PG8_STAGE_A(PG8_SA(0, 0), false, 0, cA, 0); PG8_STAGE_A(PG8_SA(0, 1), false, 1, cA, 0);
    if (wr == 1) PG8_BAR;
    PG8_WAIT_V(2); PG8_BAR;
    PG8_STAGE(PG8_SB(1, 0), cB + kstep, voffB); PG8_STAGE_A(PG8_SA(1, 0), false, 0, cA, kstep); PG8_STAGE_B1(PG8_SB(1, 1), cB + hstepB + kstep);
    if constexpr (FP8) PG8_WAIT_V(4); else PG8_WAIT_V(6);
    PG8_BAR;
    for (;;) {
        const bool has_next = S.next(ui + 1, nxt);
        rows_of(has_next ? nxt : cur, ui + 1);
        const char* nA = has_next ? nxt.A : cA; const char* nB = has_next ? nxt.B : cB;
#pragma unroll 1
        for (int t = 0; t < nt; t += 2) {
            const bool last = (t == nt - 2);
            const size_t k1 = (size_t)(t + 1) * kstep;
            const char* a2 = last ? nA : cA; const size_t k2 = last ? 0 : (size_t)(t + 2) * kstep;
            const char* b2 = last ? nB : cB + (size_t)(t + 2) * kstep;
            const char* b3 = b2 + kstep;
            PG8_LDB(B0, 0, 0); PG8_LDB(B1, 0, 1); PG8_SCHED; PG8_LDA(At, 0, 0); PG8_STAGE_A(PG8_SA(1, 1), false, 1, cA, k1);
            if constexpr (FP8) PG8_WAIT_V(6); else PG8_WAIT_V(8);
            PG8_WAIT_L(0); PG8_BAR; PG8_MMA(0, 0, At, B0); PG8_MMA(0, 1, At, B1); PG8_BAR; PG8_SCHED;
            PG8_LDA(At, 0, 1); PG8_STAGE(PG8_SB(0, 0), b2, voffB); PG8_STAGE_B1(PG8_SB(0, 1), b2 + hstepB); PG8_STAGE_A(PG8_SA(0, 0), last, 0, a2, k2);
            if constexpr (FP8) PG8_WAIT_V(6); else PG8_WAIT_V(8);
            PG8_WAIT_L(0); PG8_BAR; PG8_MMA(1, 0, At, B0); PG8_MMA(1, 1, At, B1); PG8_BAR; PG8_SCHED;
            PG8_LDB(B0, 1, 0); PG8_LDB(B1, 1, 1); PG8_SCHED; PG8_LDA(At, 1, 0); PG8_STAGE_A(PG8_SA(0, 1), last, 1, a2, k2);
            if constexpr (FP8) PG8_WAIT_V(6); else PG8_WAIT_V(8);
            PG8_WAIT_L(0); PG8_BAR; PG8_MMA(0, 0, At, B0); PG8_MMA(0, 1, At, B1); PG8_BAR; PG8_SCHED;
            PG8_LDA(At, 1, 1); PG8_STAGE(PG8_SB(1, 0), b3, voffB); PG8_STAGE_B1(PG8_SB(1, 1), b3 + hstepB); PG8_STAGE_A(PG8_SA(1, 0), last, 0, a2, k2 + kstep);
            if constexpr (FP8) PG8_WAIT_V(6); else PG8_WAIT_V(8);
            PG8_WAIT_L(0); PG8_BAR; PG8_MMA(1, 0, At, B0); PG8_MMA(1, 1, At, B1); PG8_BAR; PG8_SCHED;
        }
        if constexpr (ALIGN_EPI) { if (wr == 0) PG8_BAR; }
        E(acc, cur, wr, wc, fr, fq);
        if (!has_next) break;
#pragma unroll
        for (int a = 0; a < 2; ++a)
#pragma unroll
            for (int b = 0; b < 2; ++b)
#pragma unroll
                for (int m = 0; m < 4; ++m)
#pragma unroll
                    for (int n = 0; n < 2; ++n) acc[a][b][m][n] = (f32x4){0.f, 0.f, 0.f, 0.f};
        cur = nxt; cA = nA; cB = nB; ++ui;
        if constexpr (ALIGN_EPI) { if (wr == 1) PG8_BAR; }
    }
    PG8_WAIT_V(0);
    if constexpr (!ALIGN_EPI) { if (wr == 0) PG8_BAR; }
    PG8_BAR;
#undef PG8_SA
#undef PG8_SB
#undef PG8_STAGE
#undef PG8_STAGE_A
#undef PG8_STAGE_B1
#undef PG8_LDA
#undef PG8_LD16
#undef PG8_LDB
#undef PG8_MMA
#undef PG8_WAIT_V
#undef PG8_WAIT_L
#undef PG8_BAR
#undef PG8_SCHED
}

struct DenseSched {
    const char* A; const char* B; int nM, nN, K, G, c;
    __device__ __forceinline__ bool next(int i, Unit& u) const {
        const int nwg = nM * nN; const long L = (long)i * G + c; if (L >= nwg) return false;
        const int wgid = xcd_remap((int)L, nwg);
        const int nig = 8 * nN, gid = wgid / nig, fm = gid * 8, gsz = (nM - fm) < 8 ? (nM - fm) : 8;
        const int pm = fm + ((wgid % nig) % gsz), pn = (wgid % nig) / gsz;
        u.A = A + (size_t)pm * 256 * K * 2; u.B = B + (size_t)pn * 256 * K * 2; u.rowmap = nullptr; u.nvalid = 0; u.m0 = 0; u.row0 = pm * 256; u.col0 = pn * 256; u.pos0 = 0;
        return true;
    }
};
}

struct FPX { bf16_t* PX; __device__ __forceinline__ void operator()(const pg8::Unit& u, int lr, int lc, f32x4 v0, f32x4 v1) const {
    *(u32x4*)(PX + (size_t)(u.row0 + lr) * INP + u.col0 + lc) = mk4u(pk2(v0[0], v0[1]), pk2(v0[2], v0[3]), pk2(v1[0], v1[1]), pk2(v1[2], v1[3])); } };
struct FX1 { const float* x; const float* mod; float* X1; __device__ __forceinline__ void operator()(const pg8::Unit& u, int lr, int lc, f32x4 v0, f32x4 v1) const {
    const int row = u.row0 + lr, col = u.col0 + lc; const float* xp = x + (size_t)row * D + col; const float* gp = mod + (size_t)(row >> 12) * 12288 + 2 * D + col; float* op = X1 + (size_t)row * D + col;
    *(f32x4*)op = *(const f32x4*)xp + *(const f32x4*)gp * v0; *(f32x4*)(op + 4) = *(const f32x4*)(xp + 4) + *(const f32x4*)(gp + 4) * v1; } };
constexpr float W1_SCALE = 64.f, W2_SCALE = 32.f;
struct FH1 { unsigned char* H1; __device__ __forceinline__ void operator()(const pg8::Unit& u, int lr, int lc, f32x4 v0, f32x4 v1) const {
    if (u.m0 + lr < u.nvalid) { float h[4];
#pragma unroll
        for (int e = 0; e < 4; ++e) { const float g = v0[e] * (1.f / W1_SCALE); h[e] = g * sigmoidf_(g) * (v1[e] * (1.f / W1_SCALE)); }
        *(unsigned*)(H1 + (size_t)(u.pos0 + u.m0 + lr) * EFF + ((u.col0 + lc) >> 1)) = pk4_fp8(h[0], h[1], h[2], h[3]); } } };
struct FEO { bf16_t* EO; __device__ __forceinline__ void operator()(const pg8::Unit& u, int lr, int lc, f32x4 v0, f32x4 v1) const {
    if (u.m0 + lr < u.nvalid) { v0 *= (1.f / W2_SCALE); v1 *= (1.f / W2_SCALE);
        *(u32x4*)(EO + (size_t)(u.pos0 + u.m0 + lr) * D + u.col0 + lc) = mk4u(pk2(v0[0], v0[1]), pk2(v0[2], v0[3]), pk2(v1[0], v1[1]), pk2(v1[2], v1[3])); } } };

struct ConvJob { const float* src; bf16_t* dst; int K, N, ld, mode, ntk, ntn; size_t sbs, dbs; };
__device__ __forceinline__ int conv_row(int n, int mode) { return mode == 0 ? n : (8 * (n >> 2) + (n & 3) + (mode == 2 ? 4 : 0)); }

struct TileCtx { const float* src; bf16_t* dst; int N, ld, mode, k0, n0; };
constexpr int CT0 = 0, CT1 = CT0 + 8 * (INC / 64), CT2 = CT1 + 8 * 32, CT3 = CT2 + 64 * 64, CT4 = CT3 + 64 * 64, CT5 = CT4 + 64 * 64, CT6 = CT5 + 64, CT7 = CT6 + 64, CT8 = CT7 + 64, CT_END = CT8 + 16;
__device__ __forceinline__ void conv_decode(const Params& p, int g, const float*& src, bf16_t*& dst, int& N, int& ld, int& mode, int& k0, int& n0) {
    unsigned char* WTE1 = p.ws + OFF_WTE1; unsigned char* WTE2 = p.ws + OFF_WTE2;
    unsigned char* d8; int t, ntk, ntn; size_t sbs = 0, dbs = 0;
    if (g < CT1)      { t = g - CT0; src = p.w_in; d8 = p.ws + OFF_WTIN; N = INC; ld = 4096; mode = 0; ntk = 8; ntn = INC / 64; }
    else if (g < CT2) { t = g - CT1; src = p.w_out; d8 = p.ws + OFF_WTOUT; N = 2048; ld = 4096; mode = 0; ntk = 8; ntn = 32; }
    else if (g < CT3) { t = g - CT2; src = p.e_gate; d8 = WTE1; N = 512; ld = 2048; mode = 5; ntk = 8; ntn = 8; sbs = (size_t)2048 * 512; dbs = (size_t)1024 * 2048; }
    else if (g < CT4) { t = g - CT3; src = p.e_up; d8 = WTE1; N = 512; ld = 2048; mode = 6; ntk = 8; ntn = 8; sbs = (size_t)2048 * 512; dbs = (size_t)1024 * 2048; }
    else if (g < CT5) { t = g - CT4; src = p.e_down; d8 = WTE2; N = 2048; ld = 512; mode = 4; ntk = 2; ntn = 32; sbs = (size_t)512 * 2048; dbs = (size_t)2048 * 512; }
    else if (g < CT6) { t = g - CT5; src = p.s_gate; d8 = WTE1 + (size_t)64 * 1024 * 2048; N = 512; ld = 2048; mode = 5; ntk = 8; ntn = 8; }
    else if (g < CT7) { t = g - CT6; src = p.s_up; d8 = WTE1 + (size_t)64 * 1024 * 2048; N = 512; ld = 2048; mode = 6; ntk = 8; ntn = 8; }
    else if (g < CT8) { t = g - CT7; src = p.s_down; d8 = WTE2 + (size_t)64 * 2048 * 512; N = 2048; ld = 512; mode = 4; ntk = 2; ntn = 32; }
    else              { t = g - CT8; src = p.gate_up; d8 = p.ws + OFF_WTGU; N = 1024; ld = 512; mode = 0; ntk = 1; ntn = 16; }
    const int per = ntk * ntn, bi = t / per, rem = t - bi * per, kt = rem / ntn, ntile = rem - kt * ntn;
    src += (size_t)bi * sbs; dst = (bf16_t*)(d8 + (size_t)bi * dbs); k0 = kt * 256; n0 = ntile * 64;
}
__device__ __forceinline__ void conv_load(const float* src, int N, int k0, int n0, f32x4 (&v)[4][2], int tid) {
    const int kr = tid >> 3, nc = (tid & 7) * 8;
#pragma unroll
    for (int s = 0; s < 4; ++s) { const float* q = src + (size_t)(k0 + s * 64 + kr) * N + n0 + nc; v[s][0] = *(const f32x4*)q; v[s][1] = *(const f32x4*)(q + 4); }
}
__device__ __forceinline__ void conv_finish(LDSP unsigned char* lds, bf16_t* dst, int ld, int mode, int k0, int n0, const f32x4 (&v)[4][2], int tid) {
    LDSP float* Tm = (LDSP float*)lds;
    {
        const int kr = tid >> 3, nc = (tid & 7) * 8;
#pragma unroll
        for (int s = 0; s < 4; ++s) { LDSP float* q = Tm + (s * 64 + kr) * 65 + nc;
            q[0] = v[s][0].x; q[1] = v[s][0].y; q[2] = v[s][0].z; q[3] = v[s][0].w; q[4] = v[s][1].x; q[5] = v[s][1].y; q[6] = v[s][1].z; q[7] = v[s][1].w; }
    }
    __syncthreads();
    {
        const int n = tid >> 3; bf16_t* drow = (bf16_t*)((unsigned char*)dst + (size_t)conv_row(n0 + n, mode & 3) * ld) + k0;
#pragma unroll
        for (int s = 0; s < 4; ++s) { const int kc = ((tid & 7) + 8 * s) * 8; float f[8];
#pragma unroll
            for (int j = 0; j < 8; ++j) f[j] = Tm[(kc + j) * 65 + n];
            u32x4 w; w.x = pk2(f[0], f[1]); w.y = pk2(f[2], f[3]); w.z = pk2(f[4], f[5]); w.w = pk2(f[6], f[7]); *(u32x4*)(drow + kc) = w; }
    }
    __syncthreads();
}

__device__ __forceinline__ void mod_item(LDSP unsigned char* lds, const Params& p, int item) {
    const int kb = item >> 6, nb = item & 63, tid = opaque(threadIdx.x), wid = tid >> 6, lane = tid & 63;
    f32x4 acc[3];
#pragma unroll
    for (int v = 0; v < 3; ++v) acc[v] = mk4f(0.f, 0.f, 0.f, 0.f);
    if (lane < 48) {
#pragma unroll 8
        for (int i = 0; i < 64; ++i) {
            const int k = kb * 512 + wid * 64 + i;
            const float c0 = p.c[k], c1 = p.c[D + k], c2 = p.c_ctx[k];
            const float s0 = c0 * sigmoidf_(c0), s1 = c1 * sigmoidf_(c1), s2 = c2 * sigmoidf_(c2);
            const f32x4 w = *(const f32x4*)(p.w_mod + (size_t)k * 12288 + nb * 192 + 4 * lane);
            acc[0] += s0 * w; acc[1] += s1 * w; acc[2] += s2 * w;
        }
    }
    LDSP float* R = (LDSP float*)lds;
    if (lane < 48) {
#pragma unroll
        for (int v = 0; v < 3; ++v) *(LDSP f32x4*)(R + (wid * 3 + v) * 192 + 4 * lane) = acc[v];
    }
    __syncthreads();
    float* MODP = (float*)(p.ws + OFF_MODP);
    for (int o = tid; o < 3 * 192; o += 512) { const int v = o / 192, cidx = o - v * 192; float sum = 0.f;
#pragma unroll
        for (int w = 0; w < 8; ++w) sum += R[(w * 3 + v) * 192 + cidx];
        MODP[((size_t)kb * 3 + v) * 12288 + nb * 192 + cidx] = sum; }
    __syncthreads();
}

__device__ __forceinline__ void conv_range(LDSP unsigned char* lds, const Params& p, int g0, int g1, int rank, int nblk) {
    const int tid = opaque(threadIdx.x);
    int g = g0 + rank;
    const float* csrc = nullptr; bf16_t* cdst = nullptr; int cN = 0, cld = 0, cmode = 0, ck0 = 0, cn0 = 0;
    const float* nsrc = nullptr; bf16_t* ndst = nullptr; int nN = 0, nld = 0, nmode = 0, nk0 = 0, nn0 = 0;
    f32x4 va[4][2], vb[4][2];
    if (g < g1) { conv_decode(p, g, csrc, cdst, cN, cld, cmode, ck0, cn0); conv_load(csrc, cN, ck0, cn0, va, tid); }
#pragma unroll 1
    while (g < g1) {
        const int gn = g + nblk;
        if (gn < g1) { conv_decode(p, gn, nsrc, ndst, nN, nld, nmode, nk0, nn0); conv_load(nsrc, nN, nk0, nn0, vb, tid); }
        conv_finish(lds, cdst, cld, cmode, ck0, cn0, va, tid);
        cdst = ndst; cld = nld; cmode = nmode; ck0 = nk0; cn0 = nn0; g = gn;
#pragma unroll
        for (int s = 0; s < 4; ++s) { va[s][0] = vb[s][0]; va[s][1] = vb[s][1]; }
    }
}

__device__ __forceinline__ void phase0(LDSP unsigned char* lds, const Params& p) {
    const int tid = opaque(threadIdx.x);
    for (int it = blockIdx.x; it < 256; it += gridDim.x) mod_item(lds, p, it);
    conv_range(lds, p, 0, CT1, blockIdx.x, gridDim.x);
    conv_range(lds, p, CT8, CT_END, blockIdx.x, gridDim.x);
    {
        const int total = 4 * 1024 * 128;
        for (int idx = blockIdx.x * 512 + tid; idx < total; idx += gridDim.x * 512) {
            const int mtx = idx >> 17, rem = idx & 131071, n = rem >> 7, k = rem & 127;
            const float* src = (mtx < 2 ? p.decay_up : p.iclr_up) + (size_t)(mtx & 1) * 96 * 1024;
            bf16_t* dst = (bf16_t*)(p.ws + (mtx < 2 ? OFF_WTDU : OFF_WTIU)) + (size_t)(mtx & 1) * 1024 * 128;
            dst[n * 128 + k] = (bf16_t)f2bf(k < 96 ? src[(size_t)k * 1024 + n] : 0.f);
        }
    }
    {
        u32x4* z = (u32x4*)((bf16_t*)(p.ws + OFF_WTIN) + (size_t)INC * D);
        const int total = (INP - INC) * D * 2 / 16;
        for (int idx = blockIdx.x * 512 + tid; idx < total; idx += gridDim.x * 512) z[idx] = mk4u(0, 0, 0, 0);
    }
    if (blockIdx.x == gridDim.x - 1) {
        float2* R = (float2*)(p.ws + OFF_ROPE);
        for (int idx = tid; idx < 1024; idx += 512) { const int pos = idx >> 4, f = idx & 15;
            const float freq = powf(10000.f, -(float)f / 16.f); const float ang = (float)pos * freq; R[idx] = make_float2(cosf(ang), sinf(ang)); }
    }
}

__device__ __forceinline__ void phase1(LDSP unsigned char* lds, const Params& p) {
    const int tid = opaque(threadIdx.x), wid = tid >> 6, lane = tid & 63;
    const float* MODP = (const float*)(p.ws + OFF_MODP);
    float* MOD = (float*)(p.ws + OFF_MOD);
    LDSP float* MV = (LDSP float*)lds;
    for (int idx = tid; idx < 3 * 4096; idx += 512) { const int v = idx >> 12, col = idx & 4095; float s = p.b_mod[col];
#pragma unroll
        for (int kb = 0; kb < 4; ++kb) s += MODP[((size_t)kb * 3 + v) * 12288 + col];
        MV[idx] = s; }
    for (int idx = blockIdx.x * 512 + tid; idx < 3 * 12288; idx += gridDim.x * 512) { const int v = idx / 12288, col = idx - v * 12288; float s = p.b_mod[col];
#pragma unroll
        for (int kb = 0; kb < 4; ++kb) s += MODP[((size_t)kb * 3 + v) * 12288 + col];
        MOD[idx] = s; }
    __syncthreads();
    bf16_t* HX = (bf16_t*)(p.ws + OFF_HX);
    for (int row = blockIdx.x * 8 + wid; row < NR; row += gridDim.x * 8) {
        const float* src = row < NX ? p.x + (size_t)row * D : p.ctx + (size_t)(row - NX) * D;
        const int v = row < NX ? (row >> 12) : 2;
        f32x4 xv[8]; float ss = 0.f;
#pragma unroll
        for (int i = 0; i < 8; ++i) { xv[i] = ((const f32x4*)src)[lane + 64 * i]; ss += xv[i].x * xv[i].x + xv[i].y * xv[i].y + xv[i].z * xv[i].z + xv[i].w * xv[i].w; }
        ss = wave_sum(ss);
        const float rs = rsqrtf(ss * (1.f / D) + 1e-6f);
#pragma unroll
        for (int i = 0; i < 8; ++i) { const int col = 4 * (lane + 64 * i);
            const f32x4 g = *(const f32x4*)(p.norm1_g + col); const LDSP float* sh = MV + v * 4096 + col; const LDSP float* sc = sh + 2048;
            const float h0 = xv[i].x * rs * g.x * (1.f + sc[0]) + sh[0], h1 = xv[i].y * rs * g.y * (1.f + sc[1]) + sh[1];
            const float h2 = xv[i].z * rs * g.z * (1.f + sc[2]) + sh[2], h3 = xv[i].w * rs * g.w * (1.f + sc[3]) + sh[3];
            u32x2 w; w.x = pk2(h0, h1); w.y = pk2(h2, h3); *(u32x2*)(HX + (size_t)row * D + col) = w; }
    }
}

__device__ __forceinline__ void phase2(LDSP unsigned char* lds, const Params& p) {
    pg8::Epi<FPX> epi{FPX{(bf16_t*)(p.ws + OFF_PX)}};
    pg8::DenseSched S{(const char*)(p.ws + OFF_HX), (const char*)(p.ws + OFF_WTIN), NR / 256, INP / 256, D, (int)gridDim.x, (int)blockIdx.x};
    pg8::gemm_phase<false>(lds, D, S, epi);
}

__device__ __forceinline__ void phaseR1(LDSP unsigned char* lds, const Params& p) {
    const int tid = opaque(threadIdx.x), wid = tid >> 6, lane = tid & 63;
    const bf16_t* PX = (const bf16_t*)(p.ws + OFF_PX);
    for (int row = blockIdx.x * 8 + wid; row < NR; row += gridDim.x * 8) {
        const bool isx = row < NX;
        const int s0 = isx ? (row & ~(T - 1)) : NX + ((row - NX) & ~(CL - 1)), len = isx ? T : CL;
        const bool hp = row > s0, hn = row + 1 < s0 + len;
        const bf16_t* pc = PX + (size_t)row * INP;
#pragma unroll 1
        for (int it = 0; it < 7; ++it) {
            const int ch = lane + 64 * it;
            if (ch < 440) {
                const int col = ch * 8;
                const u32x4 c4 = *(const u32x4*)(pc + col);
                u32x4 p4 = mk4u(0, 0, 0, 0), n4 = mk4u(0, 0, 0, 0);
                if (hp) p4 = *(const u32x4*)(pc - INP + col);
                if (hn) n4 = *(const u32x4*)(pc + INP + col);
                const f32x4 m0 = *(const f32x4*)(p.shift_mu + col), m1 = *(const f32x4*)(p.shift_mu + col + 4);
                const float mu[8] = {m0.x, m0.y, m0.z, m0.w, m1.x, m1.y, m1.z, m1.w};
                const unsigned cw[4] = {c4.x, c4.y, c4.z, c4.w}, pw[4] = {p4.x, p4.y, p4.z, p4.w}, nw[4] = {n4.x, n4.y, n4.z, n4.w};
                float v[8];
#pragma unroll
                for (int j = 0; j < 4; ++j) {
                    const float c0 = bf2f(cw[j] & 0xffff), c1 = bf2f(cw[j] >> 16);
                    v[2 * j] = c0 + mu[2 * j] * (0.5f * (bf2f(pw[j] & 0xffff) + bf2f(nw[j] & 0xffff)) - c0);
                    v[2 * j + 1] = c1 + mu[2 * j + 1] * (0.5f * (bf2f(pw[j] >> 16) + bf2f(nw[j] >> 16)) - c1);
                }
                if (it < 2) {
                    *(u32x4*)((bf16_t*)(p.ws + OFF_RS) + (size_t)row * 1024 + col) = mk4u(pk2(v[0], v[1]), pk2(v[2], v[3]), pk2(v[4], v[5]), pk2(v[6], v[7]));
                } else if (it < 4) {
                    const int kc = col - C_K;
                    *(u32x4*)((bf16_t*)(p.ws + OFF_KS) + (size_t)row * 1024 + kc) = mk4u(pk2(v[0], v[1]), pk2(v[2], v[3]), pk2(v[4], v[5]), pk2(v[6], v[7]));
                    const f32x4 k0 = *(const f32x4*)(p.k_k + kc), k1 = *(const f32x4*)(p.k_k + kc + 4);
                    const float kq[8] = {k0.x, k0.y, k0.z, k0.w, k1.x, k1.y, k1.z, k1.w};
                    float ss = 0.f;
#pragma unroll
                    for (int j = 0; j < 8; ++j) { v[j] *= kq[j]; ss += v[j] * v[j]; }
                    ss += __shfl_xor(ss, 1); ss += __shfl_xor(ss, 2); ss += __shfl_xor(ss, 4);
                    const float sc = rsqrtf(ss + 1e-12f);
                    *(u32x4*)((bf16_t*)(p.ws + OFF_KK) + (size_t)row * 1024 + kc) = mk4u(pk2(v[0] * sc, v[1] * sc), pk2(v[2] * sc, v[3] * sc), pk2(v[4] * sc, v[5] * sc), pk2(v[6] * sc, v[7] * sc));
                } else if (it < 6) {
                    *(u32x4*)((bf16_t*)(p.ws + OFF_VS) + (size_t)row * 1024 + col - C_V) = mk4u(pk2(v[0], v[1]), pk2(v[2], v[3]), pk2(v[4], v[5]), pk2(v[6], v[7]));
                } else if (ch < 396) {
#pragma unroll
                    for (int j = 0; j < 8; ++j) v[j] = tanhf(v[j]);
                    *(u32x4*)((bf16_t*)(p.ws + OFF_TW) + (size_t)row * 128 + col - C_XW) = mk4u(pk2(v[0], v[1]), pk2(v[2], v[3]), pk2(v[4], v[5]), pk2(v[6], v[7]));
                } else if (ch < 408) {
                    *(u32x4*)((bf16_t*)(p.ws + OFF_XA) + (size_t)row * 128 + col - C_XA) = mk4u(pk2(v[0], v[1]), pk2(v[2], v[3]), pk2(v[4], v[5]), pk2(v[6], v[7]));
                } else if (isx) {
#pragma unroll
                    for (int j = 0; j < 8; ++j) v[j] = sigmoidf_(v[j]);
                    *(u32x4*)((bf16_t*)(p.ws + OFF_SG) + (size_t)row * 256 + col - C_XG) = mk4u(pk2(v[0], v[1]), pk2(v[2], v[3]), pk2(v[4], v[5]), pk2(v[6], v[7]));
                }
            }
        }
        if (lane < 4) { *(u32x4*)((bf16_t*)(p.ws + OFF_TW) + (size_t)row * 128 + 96 + lane * 8) = mk4u(0, 0, 0, 0); *(u32x4*)((bf16_t*)(p.ws + OFF_XA) + (size_t)row * 128 + 96 + lane * 8) = mk4u(0, 0, 0, 0); }
    }
}

struct LoraSched {
    const char *A0, *B0, *A1, *B1; int G, c;
    __device__ __forceinline__ bool next(int i, pg8::Unit& u) const {
        const int per = (NR / 256) * 8; const long L = (long)i * G + c; if (L >= 2 * per) return false;
        const int job = (int)L / per, w = (int)L % per, pm = w >> 3, pn = w & 7;
        u.A = (job ? A1 : A0) + (size_t)pm * 256 * 128 * 2; u.B = (job ? B1 : B0) + (size_t)pn * 256 * 128 * 2; u.rowmap = nullptr; u.nvalid = 0; u.m0 = 0; u.row0 = pm * 256; u.col0 = pn * 256; u.pos0 = job;
        return true;
    }
};
struct FLORA { const float* dbias; const float* ibias; bf16_t* LWG; bf16_t* AIG; __device__ __forceinline__ void operator()(const pg8::Unit& u, int lr, int lc, f32x4 v0, f32x4 v1) const {
    const int row = u.row0 + lr, col = u.col0 + lc;
    const float* bp = (u.pos0 == 0 ? dbias : ibias) + col; const f32x4 b0 = *(const f32x4*)bp, b1 = *(const f32x4*)(bp + 4);
    const float sc = (u.pos0 == 0) ? -0.60653065971f : 1.f;
    float o[8];
#pragma unroll
    for (int e = 0; e < 4; ++e) { o[e] = sc * sigmoidf_(b0[e] + v0[e]); o[4 + e] = sc * sigmoidf_(b1[e] + v1[e]); }
    *(u32x4*)((u.pos0 == 0 ? LWG : AIG) + (size_t)row * 2048 + col) = mk4u(pk2(o[0], o[1]), pk2(o[2], o[3]), pk2(o[4], o[5]), pk2(o[6], o[7]));
} };
struct FGG { bf16_t* GG; __device__ __forceinline__ void operator()(const pg8::Unit& u, int lr, int lc, f32x4 v0, f32x4 v1) const {
    *(u32x4*)(GG + (size_t)(u.row0 + lr) * 1024 + u.col0 + lc) = mk4u(pk2(v0[0], v0[1]), pk2(v0[2], v0[3]), pk2(v1[0], v1[1]), pk2(v1[2], v1[3])); } };

__device__ __forceinline__ int inst_index(int b, int h, int d, int chunk) { return ((b * 16 + h) * 2 + d) * NCHUNK + chunk; }

constexpr int LA_K = 0  , LA_VT = 73728  , LA_END = LA_VT + 18 * 4608;
static_assert(LA_END <= SMEM_BYTES, "attention LDS map");

__device__ __forceinline__ void attn_unit(LDSP unsigned char* lds, const Params& p, int unit) {
    const int tid = opaque(threadIdx.x), wid = tid >> 6, lane = tid & 63;
    const int b = unit >> 8, kvh = (unit >> 6) & 3, qb = unit & 63, q0 = qb * 64;
    const bf16_t* PX = (const bf16_t*)(p.ws + OFF_PX);
    const float2* ROPE = (const float2*)(p.ws + OFF_ROPE);
    {
        u32x4 kx1[5], kx2[5];
#pragma unroll
        for (int it = 0; it < 5; ++it) {
            const int task = tid + 512 * it; kx1[it] = mk4u(0, 0, 0, 0); kx2[it] = mk4u(0, 0, 0, 0);
            if (task < 576 * 4) {
                const int key = task >> 2, pr = task & 3, c0 = (pr & 1) + 4 * (pr >> 1);
                const int pos = q0 - 128 + key;
                const bool lat = key < 320;
                if (!lat || (pos >= 0 && pos < T)) {
                    const bf16_t* src = PX + (size_t)(lat ? (b * T + pos) : (NX + b * CL + (key - 320))) * INP + C_AK + kvh * 64 + c0 * 8;
                    kx1[it] = *(const u32x4*)src; kx2[it] = *(const u32x4*)(src + 16);
                }
            }
        }
#pragma unroll
        for (int it = 0; it < 5; ++it) {
            const int task = tid + 512 * it;
            if (task < 576 * 4) {
                const int key = task >> 2, pr = task & 3, c0 = (pr & 1) + 4 * (pr >> 1);
                u32x4 w0 = kx1[it], w1 = kx2[it];
                if (key < 320) {
                    const int pos = q0 - 128 + key;
                    if (pos >= 0 && pos < T) {
                        const int ppos = (pr < 2) ? (pos >> 6) : (pos & 63);
                        const float2* tb = ROPE + ppos * 16 + (pr & 1) * 8;
                        const unsigned a1[4] = {w0.x, w0.y, w0.z, w0.w}, a2[4] = {w1.x, w1.y, w1.z, w1.w};
                        unsigned o1[4], o2[4];
#pragma unroll
                        for (int j = 0; j < 4; ++j) {
                            const float2 cs0 = tb[2 * j], cs1 = tb[2 * j + 1];
                            const float u0 = bf2f(a1[j] & 0xffff), u1 = bf2f(a1[j] >> 16), v0 = bf2f(a2[j] & 0xffff), v1 = bf2f(a2[j] >> 16);
                            o1[j] = pk2(u0 * cs0.x - v0 * cs0.y, u1 * cs1.x - v1 * cs1.y);
                            o2[j] = pk2(v0 * cs0.x + u0 * cs0.y, v1 * cs1.x + u1 * cs1.y);
                        }
                        w0 = mk4u(o1[0], o1[1], o1[2], o1[3]); w1 = mk4u(o2[0], o2[1], o2[2], o2[3]);
                    }
                }
                *(LDSP u32x4*)(lds + LA_K + sw64(key, c0 * 8)) = w0;
                *(LDSP u32x4*)(lds + LA_K + sw64(key, c0 * 8 + 16)) = w1;
            }
        }
    }
    {
        u32x4 vx[3][4];
#pragma unroll
        for (int it = 0; it < 3; ++it) {
            const int task = tid + 512 * it;
#pragma unroll
            for (int q = 0; q < 4; ++q) {
                vx[it][q] = mk4u(0, 0, 0, 0);
                if (task < 144 * 8) {
                    const int kg = task >> 3, dc = task & 7, key = kg * 4 + q;
                    if (key < 320) { const int pos = q0 - 128 + key; if (pos >= 0 && pos < T) vx[it][q] = *(const u32x4*)(PX + (size_t)(b * T + pos) * INP + C_AV + kvh * 64 + dc * 8); }
                    else vx[it][q] = *(const u32x4*)(PX + (size_t)(NX + b * CL + (key - 320)) * INP + C_AV + kvh * 64 + dc * 8);
                }
            }
        }
#pragma unroll
        for (int it = 0; it < 3; ++it) {
            const int task = tid + 512 * it;
            if (task < 144 * 8) {
                const int kg = task >> 3, dc = task & 7;
                unsigned short e[4][8];
#pragma unroll
                for (int q = 0; q < 4; ++q) { const u32x4 w = vx[it][q];
                    e[q][0] = w.x & 0xffff; e[q][1] = w.x >> 16; e[q][2] = w.y & 0xffff; e[q][3] = w.y >> 16; e[q][4] = w.z & 0xffff; e[q][5] = w.z >> 16; e[q][6] = w.w & 0xffff; e[q][7] = w.w >> 16; }
                const int tile = kg >> 3, kin = (kg & 7) * 4;
#pragma unroll
                for (int j = 0; j < 8; ++j) { u32x2 w; w.x = (unsigned)e[0][j] | ((unsigned)e[1][j] << 16); w.y = (unsigned)e[2][j] | ((unsigned)e[3][j] << 16);
                    *(LDSP u32x2*)(lds + LA_VT + tile * 4608 + (dc * 8 + j) * 72 + kin * 2) = w; }
            }
        }
    }
    const int hq = kvh * 4 + (wid >> 1), qs = (wid & 1) * 32, r = lane & 31, hh = lane >> 5;
    const int qpos = q0 + qs + r;
    bf16x8 qf[4];
    {
        const bf16_t* src = PX + (size_t)(b * T + qpos) * INP + C_Q + hq * 64 + 8 * hh;
        u32x4 raw[4];
#pragma unroll
        for (int s = 0; s < 4; ++s) raw[s] = *(const u32x4*)(src + 16 * s);
#pragma unroll
        for (int pr = 0; pr < 2; ++pr) {
            const int ppos = pr == 0 ? (qpos >> 6) : (qpos & 63);
            const float2* tb = ROPE + ppos * 16 + 8 * hh;
            const unsigned a1[4] = {raw[2 * pr].x, raw[2 * pr].y, raw[2 * pr].z, raw[2 * pr].w}, a2[4] = {raw[2 * pr + 1].x, raw[2 * pr + 1].y, raw[2 * pr + 1].z, raw[2 * pr + 1].w};
            unsigned o1[4], o2[4];
#pragma unroll
            for (int j = 0; j < 4; ++j) {
                const float2 cs0 = tb[2 * j], cs1 = tb[2 * j + 1];
                const float u0 = bf2f(a1[j] & 0xffff), u1 = bf2f(a1[j] >> 16), v0 = bf2f(a2[j] & 0xffff), v1 = bf2f(a2[j] >> 16);
                o1[j] = pk2(0.125f * (u0 * cs0.x - v0 * cs0.y), 0.125f * (u1 * cs1.x - v1 * cs1.y));
                o2[j] = pk2(0.125f * (v0 * cs0.x + u0 * cs0.y), 0.125f * (v1 * cs1.x + u1 * cs1.y));
            }
            const u32x4 w1 = mk4u(o1[0], o1[1], o1[2], o1[3]), w2 = mk4u(o2[0], o2[1], o2[2], o2[3]);
            qf[2 * pr] = __builtin_bit_cast(bf16x8, w1); qf[2 * pr + 1] = __builtin_bit_cast(bf16x8, w2);
        }
    }
    __syncthreads();
    float m = p.attn_sink[hq], l = 1.f;
    f32x16 o0 = zero16(), o1 = zero16();
    for (int tl = 0; tl < 18; ++tl) {
        f32x16 st = zero16();
#pragma unroll
        for (int s = 0; s < 4; ++s) {
            const bf16x8 kf = *(const LDSP bf16x8*)(lds + LA_K + sw64(32 * tl + r, 16 * s + 8 * hh));
            st = __builtin_amdgcn_mfma_f32_32x32x16_bf16(kf, qf[s], st, 0, 0, 0);
        }
        const int kp0 = q0 - 128 + 32 * tl, qlo = q0 + qs;
        if (tl < 10 && (qlo + 31 - kp0 > 128 || qlo - (kp0 + 31) < -128 || kp0 < 0 || kp0 + 31 >= T)) {
#pragma unroll
            for (int g = 0; g < 16; ++g) { const int kp = q0 - 128 + 32 * tl + crow(g, hh); const int dlt = qpos - kp;
                const bool ok = (dlt <= 128) && (dlt >= -128) && (kp >= 0) && (kp < T); st[g] = ok ? st[g] : -1e30f; }
        }
        float mt = st[0];
#pragma unroll
        for (int g = 1; g < 16; ++g) mt = fmaxf(mt, st[g]);
        mt = fmaxf(mt, __shfl_xor(mt, 32));
        const float mn = fmaxf(m, mt), alpha = __expf(m - mn);
        float ps = 0.f;
#pragma unroll
        for (int g = 0; g < 16; ++g) { st[g] = __expf(st[g] - mn); ps += st[g]; }
        ps += __shfl_xor(ps, 32);
        l = l * alpha + ps; m = mn;
        if (__any(alpha != 1.f)) {
#pragma unroll
            for (int g = 0; g < 16; ++g) { o0[g] *= alpha; o1[g] *= alpha; }
        }
#pragma unroll
        for (int s2 = 0; s2 < 2; ++s2) {
            const u32x4 pw = mk4u(pk2(st[8 * s2], st[8 * s2 + 1]), pk2(st[8 * s2 + 2], st[8 * s2 + 3]), pk2(st[8 * s2 + 4], st[8 * s2 + 5]), pk2(st[8 * s2 + 6], st[8 * s2 + 7]));
            const bf16x8 pf = __builtin_bit_cast(bf16x8, pw);
#pragma unroll
            for (int dm = 0; dm < 2; ++dm) {
                const LDSP unsigned char* vp = lds + LA_VT + tl * 4608 + (32 * dm + r) * 72 + (16 * s2 + 4 * hh) * 2;
                const u32x2 v0 = *(const LDSP u32x2*)vp, v1 = *(const LDSP u32x2*)(vp + 16);
                const bf16x8 vf = __builtin_bit_cast(bf16x8, mk4u(v0.x, v0.y, v1.x, v1.y));
                if (dm == 0) o0 = __builtin_amdgcn_mfma_f32_32x32x16_bf16(vf, pf, o0, 0, 0, 0); else o1 = __builtin_amdgcn_mfma_f32_32x32x16_bf16(vf, pf, o1, 0, 0, 0);
            }
        }
    }
    {
        const float inv = 1.f / l;
        bf16_t* dst = (bf16_t*)(p.ws + OFF_MIX) + (size_t)(b * T + qpos) * D + 1024 + hq * 64;
#pragma unroll
        for (int gq = 0; gq < 4; ++gq) {
            u32x2 w; w.x = pk2(o0[4 * gq] * inv, o0[4 * gq + 1] * inv); w.y = pk2(o0[4 * gq + 2] * inv, o0[4 * gq + 3] * inv); *(u32x2*)(dst + 8 * gq + 4 * hh) = w;
            u32x2 w2; w2.x = pk2(o1[4 * gq] * inv, o1[4 * gq + 1] * inv); w2.y = pk2(o1[4 * gq + 2] * inv, o1[4 * gq + 3] * inv); *(u32x2*)(dst + 32 + 8 * gq + 4 * hh) = w2;
        }
    }
    __syncthreads();
}

__device__ __forceinline__ void phaseR2(LDSP unsigned char* lds, const Params& p) {
    {
        pg8::Epi<FLORA> epi{FLORA{p.decay_bias, p.iclr_bias, (bf16_t*)(p.ws + OFF_LWG), (bf16_t*)(p.ws + OFF_AIG)}};
        LoraSched S{(const char*)(p.ws + OFF_TW), (const char*)(p.ws + OFF_WTDU), (const char*)(p.ws + OFF_XA), (const char*)(p.ws + OFF_WTIU), (int)gridDim.x, (int)blockIdx.x};
        pg8::gemm_phase<false>(lds, opaque_s(128), S, epi);
    }
    {
        pg8::Epi<FGG> epi{FGG{(bf16_t*)(p.ws + OFF_GG)}};
        pg8::DenseSched S{(const char*)(p.ws + OFF_SG), (const char*)(p.ws + OFF_WTGU), NX / 256, 1024 / 256, 256, (int)gridDim.x, (int)(gridDim.x - 1 - blockIdx.x)};
        pg8::gemm_phase<false>(lds, opaque_s(256), S, epi);
    }
}

constexpr int G_RT = 0, G_VT = 8192, G_X0 = 16384, G_AT = 32768, G_BT = 40960, G_KT = 49152, G_P0 = 57344, G_PT0 = 65536, G_SEG = 73728, G_GL = 74752, G_CNT = 75008, G_BYTES = 79872;
static_assert(2 * G_BYTES <= SMEM_BYTES - 16, "two R3 groups fit the LDS");

__device__ __forceinline__ void gbar(LDSP unsigned* cnt, unsigned& target, int lane) {
    target += 4u;
    asm volatile("s_waitcnt lgkmcnt(0)" ::: "memory");
    if (lane == 0) {
        __hip_atomic_fetch_add(cnt, 1u, __ATOMIC_RELAXED, __HIP_MEMORY_SCOPE_WORKGROUP);
        while (__hip_atomic_load(cnt, __ATOMIC_RELAXED, __HIP_MEMORY_SCOPE_WORKGROUP) < target) __builtin_amdgcn_s_sleep(1);
    }
    asm volatile("" ::: "memory");
}
__device__ __forceinline__ void mask_lt(f32x16& c, int x0, int y, int hh, bool incl) {
#pragma unroll
    for (int g = 0; g < 16; ++g) { const int x = x0 + crow(g, hh); c[g] = (incl ? (x <= y) : (x < y)) ? c[g] : 0.f; }
}

#if defined(__HIP_DEVICE_COMPILE__)
#define LDS_AT(T, addr) (__builtin_bit_cast(LDSP T*, (unsigned)(addr)))
#define LDS_ADDR(ptr) (__builtin_bit_cast(unsigned, (ptr)))
#else
#define LDS_AT(T, addr) ((LDSP T*)(size_t)(addr))
#define LDS_ADDR(ptr) ((unsigned)(size_t)(ptr))
#endif
__device__ __forceinline__ void ldf(const unsigned (&FO)[4], unsigned off, bf16x8 (&f)[4]) {
#pragma unroll
    for (int s = 0; s < 4; ++s) f[s] = *LDS_AT(const bf16x8, FO[s] + off);
}
__device__ __forceinline__ void stt(const unsigned (&SO)[4], unsigned off, int xh, const f32x16& acc) {
#pragma unroll
    for (int gq = 0; gq < 4; ++gq) *LDS_AT(u32x2, (SO[gq] ^ ((unsigned)xh << 6)) + off) = mk2u(pk2(acc[4 * gq], acc[4 * gq + 1]), pk2(acc[4 * gq + 2], acc[4 * gq + 3]));
}
__device__ __forceinline__ u32x2 ld8(const unsigned (&SO)[4], int gq, unsigned off, int xh) { return *LDS_AT(const u32x2, (SO[gq] ^ ((unsigned)xh << 6)) + off); }

__device__ __forceinline__ void rwkv_prep_group(LDSP unsigned char* lg, LDSP unsigned* cnt, unsigned& bt, const Params& p, int unit, int wg_in, int lane_in, const unsigned (&FO)[4], const unsigned (&SO)[4]) {
    int seq, c, h, d;
    if (unit < 4096) { seq = unit >> 11; c = (unit >> 5) & 63; h = (unit >> 1) & 15; d = unit & 1; } else { const int u = unit - 4096; seq = 2 + (u >> 7); c = (u >> 5) & 3; h = (u >> 1) & 15; d = u & 1; }
    const bool isx = seq < 2;
    const int b = seq & 1;
    const int s0 = isx ? b * T : NX + b * CL, t0 = c * 64;
    const int chunk_id = isx ? 4 + c : c;
    u32x4 keep_bh[2], keep_kh[2];
#define STAGE_IDS const int lane = opaque(lane_in), wg = opaque(wg_in), r = lane & 31, hh = lane >> 5; (void)r; (void)hh; (void)wg;
    {
        STAGE_IDS
        const int k = lane, seg = wg, hk = h * 64 + k;
        const float kac = p.k_a[hk];
        const bf16_t* RS = (const bf16_t*)(p.ws + OFF_RS); const bf16_t* KS = (const bf16_t*)(p.ws + OFF_KS); const bf16_t* KKp = (const bf16_t*)(p.ws + OFF_KK); const bf16_t* VS = (const bf16_t*)(p.ws + OFF_VS);
        const bf16_t* LWG = (const bf16_t*)(p.ws + OFF_LWG); const bf16_t* AIG = (const bf16_t*)(p.ws + OFF_AIG);
        const int ibase = seg * 16;
        const size_t rowA = (size_t)(s0 + t0) + (d ? 63 - ibase : ibase);
        float lw[16];
        float run = 0.f;
#pragma unroll
        for (int tt = 0; tt < 16; ++tt) { const size_t row = d ? rowA - tt : rowA + tt; run += bf2f(LWG[row * 2048 + d * 1024 + hk]); lw[tt] = run; }
        LDSP float* SEG = (LDSP float*)(lg + G_SEG);
        SEG[seg * 64 + k] = run;
        gbar(cnt, bt, lane);
        float off = 0.f, gL = 0.f;
#pragma unroll
        for (int s = 0; s < 4; ++s) { const float sv = SEG[s * 64 + k]; if (s < seg) off += sv; gL += sv; }
        if (seg == 0) ((LDSP float*)(lg + G_GL))[k] = gL;
        const float egL = __expf(gL);
#pragma unroll
        for (int q = 0; q < 2; ++q) {
            float rr[8], kr[8], kk[8], vv[8], ai[8];
#pragma unroll
            for (int e = 0; e < 8; ++e) { const int tt = 8 * q + e; const size_t row = d ? rowA - tt : rowA + tt;
                rr[e] = bf2f(RS[row * 1024 + hk]); kr[e] = bf2f(KS[row * 1024 + hk]); kk[e] = bf2f(KKp[row * 1024 + hk]); vv[e] = bf2f(VS[row * 1024 + hk]); ai[e] = bf2f(AIG[row * 2048 + d * 1024 + hk]); }
            unsigned wat[4], wbh[4], wkh[4], wv[4];
#pragma unroll
            for (int t2 = 0; t2 < 4; ++t2) {
                const int i0 = ibase + 8 * q + 2 * t2;
                float fat[2], frt[2], fbt[2], fkt[2], fbh[2], fkh[2];
#pragma unroll
                for (int e2 = 0; e2 < 2; ++e2) { const int e = 2 * t2 + e2, tt = 8 * q + e;
                    const float kd = kr[e] * (1.f + (ai[e] - 1.f) * kac), bbv = kk[e] * ai[e];
                    const float g = off + lw[tt], ge = (tt == 0) ? off : off + lw[tt - 1];
                    const float eg = __expf(g), ege = __expf(ge), eng = __builtin_amdgcn_rcpf(eg), egl = egL * eng;
                    fat[e2] = -kk[e] * ege; frt[e2] = rr[e] * eg; fbt[e2] = bbv * eng; fkt[e2] = kd * eng; fbh[e2] = bbv * egl; fkh[e2] = kd * egl; }
                wat[t2] = pk2(fat[0], fat[1]); wbh[t2] = pk2(fbh[0], fbh[1]); wkh[t2] = pk2(fkh[0], fkh[1]); wv[t2] = pk2(vv[2 * t2], vv[2 * t2 + 1]);
                const unsigned wr = pk2(frt[0], frt[1]), wb = pk2(fbt[0], fbt[1]), wk = pk2(fkt[0], fkt[1]);
                *(LDSP bf16_t*)(lg + G_AT + sw64(i0, k)) = (bf16_t)(wat[t2] & 0xffffu); *(LDSP bf16_t*)(lg + G_AT + sw64(i0 + 1, k)) = (bf16_t)(wat[t2] >> 16);
                *(LDSP bf16_t*)(lg + G_RT + sw64(i0, k)) = (bf16_t)(wr & 0xffffu);      *(LDSP bf16_t*)(lg + G_RT + sw64(i0 + 1, k)) = (bf16_t)(wr >> 16);
                *(LDSP bf16_t*)(lg + G_BT + sw64(i0, k)) = (bf16_t)(wb & 0xffffu);      *(LDSP bf16_t*)(lg + G_BT + sw64(i0 + 1, k)) = (bf16_t)(wb >> 16);
                *(LDSP bf16_t*)(lg + G_KT + sw64(i0, k)) = (bf16_t)(wk & 0xffffu);      *(LDSP bf16_t*)(lg + G_KT + sw64(i0 + 1, k)) = (bf16_t)(wk >> 16);
            }
            *(LDSP u32x4*)(lg + G_X0 + sw64(k, ibase + 8 * q)) = mk4u(wat[0], wat[1], wat[2], wat[3]);
            *(LDSP u32x4*)(lg + G_VT + sw64(k, ibase + 8 * q)) = mk4u(wv[0], wv[1], wv[2], wv[3]);
            keep_bh[q] = mk4u(wbh[0], wbh[1], wbh[2], wbh[3]); keep_kh[q] = mk4u(wkh[0], wkh[1], wkh[2], wkh[3]);
            __builtin_amdgcn_sched_barrier(0);
        }
    }
    gbar(cnt, bt, lane_in);
    {
        STAGE_IDS
        const int a = wg >> 1, bq = wg & 1;
        f32x16 c1 = zero16(), c2 = zero16();
        if (a <= bq) {
            bf16x8 fB[4], fA[4]; ldf(FO, G_BT + 4096 * a, fB); ldf(FO, G_AT + 4096 * bq, fA);
#pragma unroll
            for (int t = 0; t < 4; ++t) { c1 = __builtin_amdgcn_mfma_f32_32x32x16_bf16(fB[t], fA[t], c1, 0, 0, 0); c2 = __builtin_amdgcn_mfma_f32_32x32x16_bf16(fA[t], fB[t], c2, 0, 0, 0); }
            mask_lt(c1, 32 * a, 32 * bq + r, hh, false);
#pragma unroll
            for (int g = 0; g < 16; ++g) { const int x = 32 * bq + crow(g, hh); c2[g] = (32 * a + r < x) ? c2[g] : 0.f; }
        }
        stt(SO, G_P0 + 4096 * bq, a, c1);
        stt(SO, G_PT0 + 4096 * a, bq, c2);
        const int ib = wg >> 1, vb = wg & 1;
        f32x16 z = zero16();
#pragma unroll
        for (int jb = 0; jb < 2; ++jb) if (jb <= ib) {
            bf16x8 fK[4], fA[4]; ldf(FO, G_KT + 4096 * jb, fK); ldf(FO, G_AT + 4096 * ib, fA);
            f32x16 t = zero16();
#pragma unroll
            for (int s = 0; s < 4; ++s) t = __builtin_amdgcn_mfma_f32_32x32x16_bf16(fK[s], fA[s], t, 0, 0, 0);
            mask_lt(t, 32 * jb, 32 * ib + r, hh, false);
#pragma unroll
            for (int s2 = 0; s2 < 2; ++s2) {
                const bf16x8 af = __builtin_bit_cast(bf16x8, mk4u(pk2(t[8 * s2], t[8 * s2 + 1]), pk2(t[8 * s2 + 2], t[8 * s2 + 3]), pk2(t[8 * s2 + 4], t[8 * s2 + 5]), pk2(t[8 * s2 + 6], t[8 * s2 + 7])));
                const u32x2 v0 = ld8(SO, 2 * s2, G_VT + 4096 * vb, jb), v1 = ld8(SO, 2 * s2 + 1, G_VT + 4096 * vb, jb);
                const bf16x8 bv = __builtin_bit_cast(bf16x8, mk4u(v0.x, v0.y, v1.x, v1.y));
                z = __builtin_amdgcn_mfma_f32_32x32x16_bf16(af, bv, z, 0, 0, 0);
            }
        }
        stt(SO, G_X0 + 128 * 64 + 4096 * vb, ib, z);
    }
    gbar(cnt, bt, lane_in);
#pragma unroll 1
    for (int s = 0; s < 6; ++s) {
        STAGE_IDS
        const int cb = wg, a = wg >> 1, bq = wg & 1;
        bf16x8 xf[4], p0[4], p1[4];
        ldf(FO, G_X0 + 4096 * cb, xf); ldf(FO, G_P0, p0); ldf(FO, G_P0 + 4096, p1);
        f32x16 acc0, acc1;
#pragma unroll
        for (int gq = 0; gq < 4; ++gq) { const u32x2 w0 = ld8(SO, gq, G_X0 + 4096 * cb, 0), w1 = ld8(SO, gq, G_X0 + 4096 * cb, 1);
            acc0[4 * gq] = bf2f(w0.x & 0xffff); acc0[4 * gq + 1] = bf2f(w0.x >> 16); acc0[4 * gq + 2] = bf2f(w0.y & 0xffff); acc0[4 * gq + 3] = bf2f(w0.y >> 16);
            acc1[4 * gq] = bf2f(w1.x & 0xffff); acc1[4 * gq + 1] = bf2f(w1.x >> 16); acc1[4 * gq + 2] = bf2f(w1.y & 0xffff); acc1[4 * gq + 3] = bf2f(w1.y >> 16); }
        f32x16 z = zero16(), zt = zero16();
        const bool sq = (s < 5) && (a <= bq);
        bf16x8 fa[4], fb[4];
        if (sq) { ldf(FO, G_PT0 + 4096 * a, fa); ldf(FO, G_P0 + 4096 * bq, fb); }
#pragma unroll
        for (int t = 0; t < 4; ++t) { if (t < 2) acc0 = __builtin_amdgcn_mfma_f32_32x32x16_bf16(p0[t], xf[t], acc0, 0, 0, 0); acc1 = __builtin_amdgcn_mfma_f32_32x32x16_bf16(p1[t], xf[t], acc1, 0, 0, 0); }
        if (sq) { const int t0 = (a == 1) ? 2 : 0, t1 = (bq == 0) ? 2 : 4;
#pragma unroll
            for (int t = 0; t < 4; ++t) if (t >= t0 && t < t1) { z = __builtin_amdgcn_mfma_f32_32x32x16_bf16(fa[t], fb[t], z, 0, 0, 0); zt = __builtin_amdgcn_mfma_f32_32x32x16_bf16(fb[t], fa[t], zt, 0, 0, 0); } }
        stt(SO, G_X0 + 4096 * cb, 0, acc0); stt(SO, G_X0 + 4096 * cb, 1, acc1);
        if (s < 5) {
            gbar(cnt, bt, lane);
            stt(SO, G_P0 + 4096 * bq, a, z); stt(SO, G_PT0 + 4096 * a, bq, zt);
        }
        gbar(cnt, bt, lane);
    }
    {
        STAGE_IDS
        const int jb = wg >> 1, ib = wg & 1;
        f32x16 c1 = zero16(), c2 = zero16();
        if (jb <= ib) {
            bf16x8 fR[4], fB[4], fK[4]; ldf(FO, G_RT + 4096 * ib, fR); ldf(FO, G_BT + 4096 * jb, fB); ldf(FO, G_KT + 4096 * jb, fK);
#pragma unroll
            for (int t = 0; t < 4; ++t) { c1 = __builtin_amdgcn_mfma_f32_32x32x16_bf16(fB[t], fR[t], c1, 0, 0, 0); c2 = __builtin_amdgcn_mfma_f32_32x32x16_bf16(fK[t], fR[t], c2, 0, 0, 0); }
            mask_lt(c1, 32 * jb, 32 * ib + r, hh, true); mask_lt(c2, 32 * jb, 32 * ib + r, hh, true);
        }
        stt(SO, G_P0 + 4096 * ib, jb, c1); stt(SO, G_PT0 + 4096 * ib, jb, c2);
    }
    gbar(cnt, bt, lane_in);
    {
        STAGE_IDS
#pragma unroll
        for (int q = 0; q < 2; ++q) { *(LDSP u32x4*)(lg + G_BT + sw64(lane, wg * 16 + 8 * q)) = keep_bh[q]; *(LDSP u32x4*)(lg + G_KT + sw64(lane, wg * 16 + 8 * q)) = keep_kh[q]; }
    }
    gbar(cnt, bt, lane_in);
    {
        STAGE_IDS
        const int mi = wg;
        const int L_BH = G_BT, L_KH = G_KT, L_RB = G_P0, L_RK = G_PT0;
        const size_t inst = (size_t)inst_index(b, h, d, chunk_id) * 4096;
        bf16_t* dst = (bf16_t*)(p.ws + (mi == 0 ? OFF_CM : mi == 1 ? OFF_CN : mi == 2 ? OFF_CP : OFF_CQ)) + inst;
        if (isx || mi < 2) {
            const int Ax = (mi == 1) ? L_BH : G_X0, Ax0 = (mi == 3) ? 64 : 0;
            const int By = (mi == 0) ? L_BH : (mi == 1) ? G_X0 : L_RB, By0 = (mi == 1) ? 64 : 0;
            const int A2 = (mi == 1) ? L_KH : G_VT, B2 = (mi == 1) ? G_VT : L_RK;
#pragma unroll 1
            for (int half = 0; half < 2; ++half) {
                bf16x8 a0[4], a1[4], b1[4];
                ldf(FO, Ax + 128 * Ax0, a0); ldf(FO, Ax + 128 * (Ax0 + 32), a1); ldf(FO, By + 128 * (By0 + 32 * half), b1);
                f32x16 c0 = zero16(), c1 = zero16();
#pragma unroll
                for (int t = 0; t < 4; ++t) { c0 = __builtin_amdgcn_mfma_f32_32x32x16_bf16(a0[t], b1[t], c0, 0, 0, 0); c1 = __builtin_amdgcn_mfma_f32_32x32x16_bf16(a1[t], b1[t], c1, 0, 0, 0); }
                if (mi & 1) {
                    ldf(FO, A2, a0); ldf(FO, A2 + 4096, a1); ldf(FO, B2 + 4096 * half, b1);
#pragma unroll
                    for (int t = 0; t < 4; ++t) { c0 = __builtin_amdgcn_mfma_f32_32x32x16_bf16(a0[t], b1[t], c0, 0, 0, 0); c1 = __builtin_amdgcn_mfma_f32_32x32x16_bf16(a1[t], b1[t], c1, 0, 0, 0); }
                }
                const int y = 32 * half + r;
                const float dg = (mi == 0) ? __expf(((const LDSP float*)(lg + G_GL))[y]) : 0.f;
#pragma unroll
                for (int xb = 0; xb < 2; ++xb) {
#pragma unroll
                    for (int gq = 0; gq < 4; ++gq) {
                        const int x0 = 32 * xb + 8 * gq + 4 * hh;
                        float v0 = xb ? c1[4 * gq] : c0[4 * gq], v1 = xb ? c1[4 * gq + 1] : c0[4 * gq + 1], v2 = xb ? c1[4 * gq + 2] : c0[4 * gq + 2], v3 = xb ? c1[4 * gq + 3] : c0[4 * gq + 3];
                        if (mi == 0) { if (x0 == y) v0 += dg; if (x0 + 1 == y) v1 += dg; if (x0 + 2 == y) v2 += dg; if (x0 + 3 == y) v3 += dg; }
                        if (mi == 2) { const u32x2 w = ld8(SO, gq, G_RT + 4096 * half, xb); v0 += bf2f(w.x & 0xffff); v1 += bf2f(w.x >> 16); v2 += bf2f(w.y & 0xffff); v3 += bf2f(w.y >> 16); }
                        *(u32x2*)(dst + ((half * 4 + 2 * xb + (gq >> 1)) * 64 + hh * 32 + r) * 8 + 4 * (gq & 1)) = mk2u(pk2(v0, v1), pk2(v2, v3));
                    }
                }
            }
        }
    }
    gbar(cnt, bt, lane_in);
#undef STAGE_IDS
}

__device__ __forceinline__ void conv_tile_group(LDSP unsigned char* lg, LDSP unsigned* cnt, unsigned& bt, const Params& p, int g, int tg, int lane) {
    const float* src = nullptr; bf16_t* dst = nullptr; int N = 0, ld = 0, mode = 0, k0 = 0, n0 = 0;
    conv_decode(p, g, src, dst, N, ld, mode, k0, n0);
    LDSP float* Tm = (LDSP float*)lg;
    {
        const int kr = tg >> 3, nc = (tg & 7) * 8;
        f32x4 v[8][2];
#pragma unroll
        for (int s = 0; s < 8; ++s) { const float* q = src + (size_t)(k0 + s * 32 + kr) * N + n0 + nc; v[s][0] = *(const f32x4*)q; v[s][1] = *(const f32x4*)(q + 4); }
#pragma unroll
        for (int s = 0; s < 8; ++s) { LDSP float* q = Tm + (s * 32 + kr) * 65 + nc;
            q[0] = v[s][0].x; q[1] = v[s][0].y; q[2] = v[s][0].z; q[3] = v[s][0].w; q[4] = v[s][1].x; q[5] = v[s][1].y; q[6] = v[s][1].z; q[7] = v[s][1].w; }
    }
    gbar(cnt, bt, lane);
    {
        const int n = tg >> 2; unsigned char* drow = (unsigned char*)dst + (size_t)conv_row(n0 + n, mode & 3) * ld;
        if (mode & 4) {
            const float sc = (mode & 3) ? W1_SCALE : W2_SCALE;
#pragma unroll
            for (int s = 0; s < 4; ++s) { const int kc = ((tg & 3) + 4 * s) * 16; float f[16];
#pragma unroll
                for (int j = 0; j < 16; ++j) f[j] = Tm[(kc + j) * 65 + n] * sc;
                *(u32x4*)(drow + k0 + kc) = mk4u(pk4_fp8(f[0], f[1], f[2], f[3]), pk4_fp8(f[4], f[5], f[6], f[7]), pk4_fp8(f[8], f[9], f[10], f[11]), pk4_fp8(f[12], f[13], f[14], f[15])); }
        } else {
#pragma unroll
            for (int s = 0; s < 8; ++s) { const int kc = ((tg & 3) + 4 * s) * 8; float f[8];
#pragma unroll
                for (int j = 0; j < 8; ++j) f[j] = Tm[(kc + j) * 65 + n];
                *(u32x4*)(drow + 2 * (k0 + kc)) = mk4u(pk2(f[0], f[1]), pk2(f[2], f[3]), pk2(f[4], f[5]), pk2(f[6], f[7])); }
        }
    }
    gbar(cnt, bt, lane);
}

__device__ __forceinline__ void phaseR3(LDSP unsigned char* lds, const Params& p) {
    const int tid = opaque(threadIdx.x), wid = tid >> 6, lane = tid & 63, gp = wid >> 2, wg = wid & 3;
    LDSP unsigned char* lg = lds + gp * G_BYTES;
    LDSP unsigned* cnt = (LDSP unsigned*)(lg + G_CNT);
    LDSP unsigned* uq = (LDSP unsigned*)(lds + SMEM_BYTES - 48);
    LDSP unsigned* pick = (LDSP unsigned*)(lg + G_CNT + 8);
    if ((tid & 255) == 0) *cnt = 0u;
    if (tid == 0) *uq = 0u;
    __syncthreads();
    unsigned bt = 0u;
    if (gp == 1) for (int g = CT1 + blockIdx.x; g < CT8; g += gridDim.x) conv_tile_group(lg, cnt, bt, p, g, tid & 255, lane);
    unsigned FO[4], SO[4];
    { const unsigned base = LDS_ADDR(lg), r = lane & 31, hh = lane >> 5;
#pragma unroll
      for (int q = 0; q < 4; ++q) { FO[q] = base + r * 128u + ((((2u * q + hh) ^ (r >> 1)) & 7u) << 4); SO[q] = base + r * 128u + ((((unsigned)q ^ (r >> 1)) & 7u) << 4) + 8u * hh; } }
    for (;;) {
        if ((tid & 255) == 0) *pick = __hip_atomic_fetch_add(uq, 1u, __ATOMIC_RELAXED, __HIP_MEMORY_SCOPE_WORKGROUP);
        gbar(cnt, bt, lane);
        const int u = blockIdx.x + (int)(*pick) * gridDim.x;
        gbar(cnt, bt, lane);
        if (u >= 4096 + 256) break;
        rwkv_prep_group(lg, cnt, bt, p, u, wg, lane, FO, SO);
    }
    __syncthreads();
}

constexpr size_t OFF_HT = OFF_YD;
__device__ __forceinline__ void scan_wave(const Params& p, int item, int lane) {
    const int chain = item >> 1, vb = item & 1, b = chain >> 5, h = (chain >> 1) & 15, d = chain & 1;
    const bf16_t* CM = (const bf16_t*)(p.ws + OFF_CM); const bf16_t* CN = (const bf16_t*)(p.ws + OFF_CN); bf16_t* HT = (bf16_t*)(p.ws + OFF_HT);
    u32x4 na[2][4], nn[2][2];
    auto chunk_of = [&](int step) { return (step < 4) ? (d ? 3 - step : step) : (d ? 4 + (67 - step) : step); };
    auto prefetch = [&](int step) {
        const size_t inst = (size_t)inst_index(b, h, d, chunk_of(step)) * 4096;
#pragma unroll
        for (int rt = 0; rt < 2; ++rt) {
#pragma unroll
            for (int s = 0; s < 4; ++s) na[rt][s] = *(const u32x4*)(CM + inst + ((rt * 4 + s) * 64 + lane) * 8);
#pragma unroll
            for (int g2 = 0; g2 < 2; ++g2) nn[rt][g2] = *(const u32x4*)(CN + inst + (((vb * 2 + rt) * 2 + g2) * 64 + lane) * 8);
        }
    };
    f32x16 hacc[2]; hacc[0] = zero16(); hacc[1] = zero16();
    prefetch(0);
#pragma unroll 1
    for (int step = 0; step < NCHUNK; ++step) {
        const int chunk_id = chunk_of(step);
        u32x4 a[2][4], n[2][2];
#pragma unroll
        for (int rt = 0; rt < 2; ++rt) {
#pragma unroll
            for (int s = 0; s < 4; ++s) a[rt][s] = na[rt][s];
            n[rt][0] = nn[rt][0]; n[rt][1] = nn[rt][1];
        }
        if (step + 1 < NCHUNK) prefetch(step + 1);
        bf16x8 bfr[4];
#pragma unroll
        for (int s = 0; s < 4; ++s) { const f32x16& t = hacc[s >> 1]; const int o = 8 * (s & 1);
            bfr[s] = __builtin_bit_cast(bf16x8, mk4u(pk2(t[o], t[o + 1]), pk2(t[o + 2], t[o + 3]), pk2(t[o + 4], t[o + 5]), pk2(t[o + 6], t[o + 7]))); }
        if (chunk_id >= 4) {
            bf16_t* hp = HT + (size_t)inst_index(b, h, d, chunk_id) * 4096 + (vb * 4 * 64 + lane) * 8;
#pragma unroll
            for (int s = 0; s < 4; ++s) *(bf16x8*)(hp + s * 512) = bfr[s];
        }
#pragma unroll
        for (int rt = 0; rt < 2; ++rt) {
            f32x16 acc;
#pragma unroll
            for (int g2 = 0; g2 < 2; ++g2) { const u32x4 w = n[rt][g2];
                acc[8 * g2] = bf2f(w.x & 0xffff); acc[8 * g2 + 1] = bf2f(w.x >> 16); acc[8 * g2 + 2] = bf2f(w.y & 0xffff); acc[8 * g2 + 3] = bf2f(w.y >> 16);
                acc[8 * g2 + 4] = bf2f(w.z & 0xffff); acc[8 * g2 + 5] = bf2f(w.z >> 16); acc[8 * g2 + 6] = bf2f(w.w & 0xffff); acc[8 * g2 + 7] = bf2f(w.w >> 16); }
#pragma unroll
            for (int s = 0; s < 4; ++s) acc = __builtin_amdgcn_mfma_f32_32x32x16_bf16(__builtin_bit_cast(bf16x8, a[rt][s]), bfr[s], acc, 0, 0, 0);
            hacc[rt] = acc;
        }
    }
}
__device__ __forceinline__ void phaseR4(LDSP unsigned char* lds, const Params& p) {
    const int tid = opaque(threadIdx.x), wid = tid >> 6, lane = tid & 63;
    LDSP int* nxt = (LDSP int*)(lds + SMEM_BYTES - 32);
    unsigned* qctr = (unsigned*)(p.ws + OFF_CTL + 16384 + 512);
    if ((int)blockIdx.x < 64 && gridDim.x >= 128) { if (wid < 2) scan_wave(p, blockIdx.x * 2 + wid, lane); }
    else if (gridDim.x < 128) { if (wid == 0) for (int it = blockIdx.x; it < 128; it += gridDim.x) scan_wave(p, it, lane); }
    for (;;) {
        __syncthreads();
        if (tid == 0) *nxt = (int)atomicAdd(qctr, 1u);
        __syncthreads();
        const int u = *nxt;
        if (u >= 512) break;
        attn_unit(lds, p, u);
    }
}

__device__ __forceinline__ void phaseR5(LDSP unsigned char* lds, const Params& p) {
    const int tid = opaque(threadIdx.x), wid = tid >> 6, lane = tid & 63, r = lane & 31, hh = lane >> 5;
    const bf16_t* CP = (const bf16_t*)(p.ws + OFF_CP); const bf16_t* CQ = (const bf16_t*)(p.ws + OFF_CQ); const bf16_t* HT = (const bf16_t*)(p.ws + OFF_HT);
    for (int wu = blockIdx.x * 8 + wid; wu < 2 * 64 * 16 * 2; wu += gridDim.x * 8) {
        const int half = wu & 1, u = wu >> 1, b = u >> 10, c = (u >> 4) & 63, h = u & 15;
        f32x16 y0 = zero16(), y1 = zero16();
#pragma unroll
        for (int d = 0; d < 2; ++d) {
            const size_t inst = (size_t)inst_index(b, h, d, 4 + c) * 4096;
            const int ii = d ? 63 - (32 * half + r) : (32 * half + r);
            const int it = ii >> 5, lp = hh * 32 + (ii & 31);
            f32x16 a0, a1;
#pragma unroll
            for (int g2 = 0; g2 < 2; ++g2) {
                const u32x4 w0 = *(const u32x4*)(CQ + inst + (((it * 2 + 0) * 2 + g2) * 64 + lp) * 8), w1 = *(const u32x4*)(CQ + inst + (((it * 2 + 1) * 2 + g2) * 64 + lp) * 8);
                a0[8 * g2] = bf2f(w0.x & 0xffff); a0[8 * g2 + 1] = bf2f(w0.x >> 16); a0[8 * g2 + 2] = bf2f(w0.y & 0xffff); a0[8 * g2 + 3] = bf2f(w0.y >> 16);
                a0[8 * g2 + 4] = bf2f(w0.z & 0xffff); a0[8 * g2 + 5] = bf2f(w0.z >> 16); a0[8 * g2 + 6] = bf2f(w0.w & 0xffff); a0[8 * g2 + 7] = bf2f(w0.w >> 16);
                a1[8 * g2] = bf2f(w1.x & 0xffff); a1[8 * g2 + 1] = bf2f(w1.x >> 16); a1[8 * g2 + 2] = bf2f(w1.y & 0xffff); a1[8 * g2 + 3] = bf2f(w1.y >> 16);
                a1[8 * g2 + 4] = bf2f(w1.z & 0xffff); a1[8 * g2 + 5] = bf2f(w1.z >> 16); a1[8 * g2 + 6] = bf2f(w1.w & 0xffff); a1[8 * g2 + 7] = bf2f(w1.w >> 16);
            }
#pragma unroll
            for (int s = 0; s < 4; ++s) {
                const bf16x8 pf = *(const bf16x8*)(CP + inst + ((it * 4 + s) * 64 + lp) * 8);
                const bf16x8 h0 = *(const bf16x8*)(HT + inst + ((0 * 4 + s) * 64 + lane) * 8), h1 = *(const bf16x8*)(HT + inst + ((1 * 4 + s) * 64 + lane) * 8);
                a0 = __builtin_amdgcn_mfma_f32_32x32x16_bf16(h0, pf, a0, 0, 0, 0);
                a1 = __builtin_amdgcn_mfma_f32_32x32x16_bf16(h1, pf, a1, 0, 0, 0);
            }
#pragma unroll
            for (int g = 0; g < 16; ++g) { y0[g] += a0[g]; y1[g] += a1[g]; }
        }
        const int tau = 32 * half + r; const size_t row = (size_t)b * T + c * 64 + tau;
        float sm = 0.f;
#pragma unroll
        for (int g = 0; g < 16; ++g) sm += y0[g] + y1[g];
        sm += __shfl_xor(sm, 32);
        const float mean = sm * (1.f / 64.f);
        float q2 = 0.f;
#pragma unroll
        for (int g = 0; g < 16; ++g) { y0[g] -= mean; y1[g] -= mean; q2 += y0[g] * y0[g] + y1[g] * y1[g]; }
        q2 += __shfl_xor(q2, 32);
        const float rstd = rsqrtf(q2 * (1.f / 64.f) + 64e-5f);
        const bf16_t* rs = (const bf16_t*)(p.ws + OFF_RS) + row * 1024 + h * 64; const bf16_t* ks = (const bf16_t*)(p.ws + OFF_KS) + row * 1024 + h * 64;
        const bf16_t* ai0 = (const bf16_t*)(p.ws + OFF_AIG) + row * 2048 + h * 64; const bf16_t* ai1 = ai0 + 1024;
        const bf16_t* vs = (const bf16_t*)(p.ws + OFF_VS) + row * 1024 + h * 64; const bf16_t* gg = (const bf16_t*)(p.ws + OFF_GG) + row * 1024 + h * 64;
        float bon = 0.f;
#pragma unroll
        for (int q = 0; q < 8; ++q) {
            const int ch = 32 * (q >> 2) + 8 * (q & 3) + 4 * hh;
            const u32x2 r2 = *(const u32x2*)(rs + ch), k2 = *(const u32x2*)(ks + ch), x2 = *(const u32x2*)(ai0 + ch), z2 = *(const u32x2*)(ai1 + ch);
            const f32x4 ka = *(const f32x4*)(p.k_a + h * 64 + ch), rk = *(const f32x4*)(p.r_k + h * 64 + ch);
            const float rr[4] = {bf2f(r2.x & 0xffff), bf2f(r2.x >> 16), bf2f(r2.y & 0xffff), bf2f(r2.y >> 16)}, kk[4] = {bf2f(k2.x & 0xffff), bf2f(k2.x >> 16), bf2f(k2.y & 0xffff), bf2f(k2.y >> 16)};
            const float xa[4] = {bf2f(x2.x & 0xffff), bf2f(x2.x >> 16), bf2f(x2.y & 0xffff), bf2f(x2.y >> 16)}, za[4] = {bf2f(z2.x & 0xffff), bf2f(z2.x >> 16), bf2f(z2.y & 0xffff), bf2f(z2.y >> 16)};
#pragma unroll
            for (int e = 0; e < 4; ++e) bon += rr[e] * (kk[e] * ((1.f + (xa[e] - 1.f) * ka[e]) + (1.f + (za[e] - 1.f) * ka[e]))) * rk[e];
        }
        bon += __shfl_xor(bon, 32);
        bf16_t* dst = (bf16_t*)(p.ws + OFF_MIX) + row * D + h * 64;
#pragma unroll
        for (int q = 0; q < 8; ++q) {
            const int ch = 32 * (q >> 2) + 8 * (q & 3) + 4 * hh, g0 = 4 * (q & 3);
            const f32x4 lg = *(const f32x4*)(p.lnx_g + h * 64 + ch), lb = *(const f32x4*)(p.lnx_b + h * 64 + ch);
            const u32x2 v2 = *(const u32x2*)(vs + ch), g2 = *(const u32x2*)(gg + ch);
            const float vv[4] = {bf2f(v2.x & 0xffff), bf2f(v2.x >> 16), bf2f(v2.y & 0xffff), bf2f(v2.y >> 16)}, gv[4] = {bf2f(g2.x & 0xffff), bf2f(g2.x >> 16), bf2f(g2.y & 0xffff), bf2f(g2.y >> 16)};
            float o[4];
#pragma unroll
            for (int e = 0; e < 4; ++e) { const float yv = (q < 4) ? y0[g0 + e] : y1[g0 + e]; o[e] = (yv * rstd * lg[e] + lb[e] + bon * vv[e]) * gv[e]; }
            *(u32x2*)(dst + ch) = mk2u(pk2(o[0], o[1]), pk2(o[2], o[3]));
        }
    }
}

__device__ __forceinline__ void phase6(LDSP unsigned char* lds, const Params& p) {
    pg8::Epi<FX1> epi{FX1{p.x, (const float*)(p.ws + OFF_MOD), (float*)(p.ws + OFF_X1)}};
    pg8::DenseSched S{(const char*)(p.ws + OFF_MIX), (const char*)(p.ws + OFF_WTOUT), NX / 256, D / 256, D, (int)gridDim.x, (int)blockIdx.x};
    pg8::gemm_phase<false>(lds, D, S, epi);
}

__device__ __forceinline__ void phase7(LDSP unsigned char* lds, const Params& p) {
    const int tid = opaque(threadIdx.x), wid = tid >> 6, lane = tid & 63;
    LDSP float* GS = (LDSP float*)lds;
    LDSP float* RSTD = (LDSP float*)(lds + 16384);
    LDSP float* PART = (LDSP float*)(lds + 16896);
    LDSP float* CB = (LDSP float*)(lds + 16896 + 65536);
    const float* MOD = (const float*)(p.ws + OFF_MOD);
    const float* X1 = (const float*)(p.ws + OFF_X1);
    unsigned char* H2 = p.ws + OFF_H2;
    int* CNT = (int*)(p.ws + OFF_CTL + 16384);
    for (int u = blockIdx.x; u < NX / 32; u += gridDim.x) {
        const float* md = MOD + (size_t)((u * 32) >> 12) * 12288;
        for (int idx = tid; idx < D / 4; idx += 512) { const f32x4 g = *(const f32x4*)(p.norm2_g + 4 * idx), sh = *(const f32x4*)(md + 3 * D + 4 * idx), sc = *(const f32x4*)(md + 4 * D + 4 * idx);
            *(LDSP f32x4*)(GS + 4 * idx) = g * (sc + 1.f); *(LDSP f32x4*)(GS + D + 4 * idx) = sh; }
        __syncthreads();
#pragma unroll 1
        for (int rr = 0; rr < 4; ++rr) {
            const int t = 4 * wid + rr, row = u * 32 + t; const float* src = X1 + (size_t)row * D;
            f32x4 xv[8]; float ss = 0.f;
#pragma unroll
            for (int i = 0; i < 8; ++i) { xv[i] = ((const f32x4*)src)[lane + 64 * i]; ss += xv[i].x * xv[i].x + xv[i].y * xv[i].y + xv[i].z * xv[i].z + xv[i].w * xv[i].w; }
            ss = wave_sum(ss); const float rs = rsqrtf(ss * (1.f / D) + 1e-6f);
            if (lane == 0) RSTD[t] = rs;
#pragma unroll
            for (int i = 0; i < 8; ++i) { const int col = 4 * (lane + 64 * i);
                const f32x4 g = *(const LDSP f32x4*)(GS + col), sh = *(const LDSP f32x4*)(GS + D + col);
                const f32x4 hv = xv[i] * rs * g + sh;
                *(unsigned*)(H2 + (size_t)row * D + col) = pk4_fp8(hv.x, hv.y, hv.z, hv.w); }
        }
        {
            const int j = lane & 31, kk = lane >> 5, k0 = wid * 256;
            unsigned xoff = (unsigned)((u * 32 + j) * D + k0 + 4 * kk) * 4u;
            unsigned woff = (unsigned)((k0 + 4 * kk) * 64 + j) * 4u;
            unsigned goff = (unsigned)(k0 + 4 * kk) * 4u;
            f32x16 acc0 = zero16(), acc1 = zero16(); float c0 = 0.f, c1 = 0.f;
#pragma unroll 2
            for (int q = 0; q < 32; ++q) {
                const f32x4 xa = *(const f32x4*)((const char*)X1 + xoff);
                const f32x4 gv = *(const LDSP f32x4*)((const LDSP char*)GS + goff), sv = *(const LDSP f32x4*)((const LDSP char*)GS + D * 4 + goff);
                float b0[4], b1[4];
#pragma unroll
                for (int e = 0; e < 4; ++e) { b0[e] = *(const float*)((const char*)p.w_router + woff + e * 256); b1[e] = *(const float*)((const char*)p.w_router + woff + e * 256 + 128); }
#pragma unroll
                for (int e = 0; e < 4; ++e) {
                    acc0 = __builtin_amdgcn_mfma_f32_32x32x2f32(xa[e], b0[e] * gv[e], acc0, 0, 0, 0);
                    acc1 = __builtin_amdgcn_mfma_f32_32x32x2f32(xa[e], b1[e] * gv[e], acc1, 0, 0, 0);
                    c0 += sv[e] * b0[e]; c1 += sv[e] * b1[e];
                }
                xoff += 32u; woff += 2048u; goff += 32u;
            }
            c0 += __shfl_xor(c0, 32); c1 += __shfl_xor(c1, 32);
#pragma unroll
            for (int g = 0; g < 16; ++g) { const int t = crow(g, kk); PART[(wid * 32 + t) * 64 + j] = acc0[g]; PART[(wid * 32 + t) * 64 + 32 + j] = acc1[g]; }
            if (kk == 0) { CB[wid * 64 + j] = c0; CB[wid * 64 + 32 + j] = c1; }
        }
        __syncthreads();
        float cb = 0.f;
#pragma unroll
        for (int w = 0; w < 8; ++w) cb += CB[w * 64 + lane];
        const float eb = p.expert_bias[lane];
#pragma unroll 1
        for (int rr = 0; rr < 4; ++rr) {
            const int t = 4 * wid + rr, token = u * 32 + t;
            float sum = 0.f;
#pragma unroll
            for (int w = 0; w < 8; ++w) sum += PART[(w * 32 + t) * 64 + lane];
            const float logit = RSTD[t] * sum + cb;
            const float score = 1.f / (1.f + expf(-logit));
            const float v = score + eb;
            const int gi = lane >> 3;
            float m1 = v;
            m1 = fmaxf(m1, __shfl_xor(m1, 1)); m1 = fmaxf(m1, __shfl_xor(m1, 2)); m1 = fmaxf(m1, __shfl_xor(m1, 4));
            const unsigned long long eq = __ballot(v == m1);
            const unsigned gbits = (unsigned)((eq >> (gi * 8)) & 0xffull);
            const bool first = (lane & 7) == (__ffs((int)gbits) - 1);
            float v2 = first ? -INFINITY : v;
            v2 = fmaxf(v2, __shfl_xor(v2, 1)); v2 = fmaxf(v2, __shfl_xor(v2, 2)); v2 = fmaxf(v2, __shfl_xor(v2, 4));
            const float gs = m1 + v2;
            int gr = 0;
#pragma unroll
            for (int jj = 0; jj < 8; ++jj) { const float gj = __builtin_bit_cast(float, __builtin_amdgcn_readlane(__builtin_bit_cast(int, gs), jj * 8)); gr += (gj > gs || (gj == gs && jj < gi)) ? 1 : 0; }
            const float mv = (gr < 4) ? v : -INFINITY;
            int rk = 0;
#pragma unroll
            for (int j8 = 0; j8 < 8; ++j8) {
#pragma unroll
                for (int j1 = 0; j1 < 8; ++j1) { const int jj = 8 * j8 + j1; const float vj = __builtin_bit_cast(float, __builtin_amdgcn_readlane(__builtin_bit_cast(int, mv), jj)); rk += (vj > mv || (vj == mv && jj < lane)) ? 1 : 0; }
                __builtin_amdgcn_sched_barrier(0);
            }
            const bool sel = (rk < 8) && (gr < 4);
            const float gsum = wave_sum(sel ? score : 0.f);
            if (sel) {
                const int slot = atomicAdd(&CNT[lane], 1);
                ((int*)(p.ws + OFF_EIDX))[token * 8 + rk] = lane;
                ((int*)(p.ws + OFF_ESLOT))[token * 8 + rk] = slot;
                ((float*)(p.ws + OFF_GATE))[token * 8 + rk] = score / gsum * 2.5f;
                ((int*)(p.ws + OFF_TOKL))[(size_t)lane * NX + slot] = token;
            }
        }
        __syncthreads();
    }
}

constexpr int LE_TAB = 131072;
__device__ __forceinline__ void build_expert_tables(LDSP unsigned char* lds, const Params& p) {
    LDSP int* TP = (LDSP int*)(lds + LE_TAB); LDSP int* ST = TP + 72; LDSP int* CN = ST + 72;
    if (threadIdx.x < NEX) CN[threadIdx.x] = (threadIdx.x < NE) ? ((const int*)(p.ws + OFF_CTL + 16384))[threadIdx.x] : NX;
    __syncthreads();
    if (threadIdx.x == 0) {
        int tp = 0, st = 0;
        for (int e = 0; e < NEX; ++e) { const int cn = CN[e]; TP[e] = tp; ST[e] = st; tp += (cn + 255) >> 8; st += cn; }
        TP[NEX] = tp; ST[NEX] = st;
    }
    __syncthreads();
}

struct GroupSched {
    const LDSP int* TP; const LDSP int* ST; const LDSP int* CN;
    const char* A; const char* B; const int* tokl; int ntn, K, G, c; size_t bstride; bool gather; int bn;
    __device__ __forceinline__ bool next(int i, pg8::Unit& u) const {
        const int total = __builtin_amdgcn_readfirstlane(TP[NEX]) * ntn; const long L = (long)i * G + c; if (L >= total) return false;
        const int w = pg8::xcd_remap((int)L, total);
        const int nt = w % ntn, mtg = w / ntn;
        int e = 0, hi = NEX;
        while (hi - e > 1) { const int mid = (e + hi) >> 1; if (__builtin_amdgcn_readfirstlane(TP[mid]) <= mtg) e = mid; else hi = mid; }
        const int tpe = __builtin_amdgcn_readfirstlane(TP[e]), ste = __builtin_amdgcn_readfirstlane(ST[e]), cne = __builtin_amdgcn_readfirstlane(CN[e]);
        const int mt = mtg - tpe;
        u.B = B + (size_t)e * bstride + (size_t)nt * bn * K * 2;
        u.nvalid = cne; u.m0 = mt * 256; u.pos0 = ste; u.row0 = 0; u.col0 = nt * bn;
        if (gather) { u.A = A; u.rowmap = (e < NE) ? tokl + (size_t)e * NX : nullptr; }
        else { u.A = A + (size_t)(ste + mt * 256) * K * 2; u.rowmap = nullptr; }
        return true;
    }
};
__device__ __forceinline__ void phase8(LDSP unsigned char* lds, const Params& p) {
    build_expert_tables(lds, p);
    const LDSP int* TP = (const LDSP int*)(lds + LE_TAB);
    pg8::Epi<FH1, 1> epi{FH1{p.ws + OFF_H1}};
    GroupSched S{TP, TP + 72, TP + 144, (const char*)(p.ws + OFF_H2), (const char*)(p.ws + OFF_WTE1), (const int*)(p.ws + OFF_TOKL), 8, D / 2, (int)gridDim.x, (int)blockIdx.x,
                 (size_t)1024 * 2048, true, 128};
    pg8::gemm_phase<true, true, true>(lds, D / 2, S, epi);
}
__device__ __forceinline__ void phase9(LDSP unsigned char* lds, const Params& p) {
    build_expert_tables(lds, p);
    const LDSP int* TP = (const LDSP int*)(lds + LE_TAB);
    pg8::Epi<FEO, 1> epi{FEO{(bf16_t*)(p.ws + OFF_EO)}};
    GroupSched S{TP, TP + 72, TP + 144, (const char*)(p.ws + OFF_H1), (const char*)(p.ws + OFF_WTE2), nullptr, 16, EFF / 2, (int)gridDim.x, (int)blockIdx.x,
                 (size_t)2048 * 512, false, 128};
    pg8::gemm_phase<false, false, true>(lds, EFF / 2, S, epi);
}
__device__ __forceinline__ void phase10(LDSP unsigned char* lds, const Params& p) {
    build_expert_tables(lds, p);
    const LDSP int* ST = (const LDSP int*)(lds + LE_TAB) + 72;
    const int tid = opaque(threadIdx.x), wid = tid >> 6, lane = tid & 63;
    const float* MOD = (const float*)(p.ws + OFF_MOD);
    const float* X1 = (const float*)(p.ws + OFF_X1);
    const bf16_t* EO = (const bf16_t*)(p.ws + OFF_EO);
    for (int row = blockIdx.x * 8 + wid; row < NX; row += gridDim.x * 8) {
        unsigned er[9]; float gw[9];
#pragma unroll
        for (int k = 0; k < 8; ++k) { const int e = ((const int*)(p.ws + OFF_EIDX))[row * 8 + k], sl = ((const int*)(p.ws + OFF_ESLOT))[row * 8 + k];
            er[k] = (unsigned)(ST[e] + sl) * (unsigned)D; gw[k] = ((const float*)(p.ws + OFF_GATE))[row * 8 + k]; }
        er[8] = (unsigned)(ST[NE] + row) * (unsigned)D; gw[8] = 1.f;
        const float* md = MOD + (size_t)(row >> 12) * 12288 + 5 * D;
        LDSP float* RB = (LDSP float*)lds + wid * 2048;
        float ss = 0.f;
#pragma unroll 2
        for (int i = 0; i < 8; ++i) { const int col = 4 * (lane + 64 * i);
            f32x4 a = mk4f(0.f, 0.f, 0.f, 0.f);
#pragma unroll
            for (int k = 0; k < 9; ++k) { const u32x2 w = *(const u32x2*)(EO + er[k] + col);
                a.x += gw[k] * bf2f(w.x & 0xffff); a.y += gw[k] * bf2f(w.x >> 16); a.z += gw[k] * bf2f(w.y & 0xffff); a.w += gw[k] * bf2f(w.y >> 16); }
            const f32x4 x1 = *(const f32x4*)(X1 + (size_t)row * D + col), g2 = *(const f32x4*)(md + col);
            f32x4 xv; xv.x = x1.x + g2.x * a.x; xv.y = x1.y + g2.y * a.y; xv.z = x1.z + g2.z * a.z; xv.w = x1.w + g2.w * a.w;
            ss += xv.x * xv.x + xv.y * xv.y + xv.z * xv.z + xv.w * xv.w;
            *(LDSP f32x4*)(RB + col) = xv; }
        ss = wave_sum(ss); const float rs = rsqrtf(ss * (1.f / D) + 1e-6f);
#pragma unroll 4
        for (int i = 0; i < 8; ++i) { const int col = 4 * (lane + 64 * i); const f32x4 g = *(const f32x4*)(p.final_g + col);
            const f32x4 xv = *(const LDSP f32x4*)(RB + col);
            f32x4 o; o.x = xv.x * rs * g.x; o.y = xv.y * rs * g.y; o.z = xv.z * rs * g.z; o.w = xv.w * rs * g.w;
            *(f32x4*)(p.out + (size_t)row * D + col) = o; }
    }
}


#define XB_TMO      128
#define XB_XCNT(j)  (256  + 64 * (j))
#define XB_XSUB(j)  (1280 + 64 * (j))
#define XB_XGEN(j)  (2304 + 64 * (j))
#define XB_TOP      3328
#define XB_TOPGEN   3392
#define XB_SPIN_CAP (1u << 20)
__device__ __forceinline__ unsigned xb_ld(unsigned* p)              { return __hip_atomic_load(p, __ATOMIC_RELAXED, __HIP_MEMORY_SCOPE_AGENT); }
__device__ __forceinline__ unsigned xb_add(unsigned* p, unsigned v) { return __hip_atomic_fetch_add(p, v, __ATOMIC_RELAXED, __HIP_MEMORY_SCOPE_AGENT); }
__device__ __forceinline__ unsigned xb_xcc_id() { return (unsigned)__builtin_amdgcn_s_getreg((3 << 11) | 20) & 0xFu; }
#define XB_SPIN(cond, bar) do { unsigned _sp = 0; while (cond) { __builtin_amdgcn_s_sleep(1); \
    if ((++_sp & 255u) == 0u) { if (xb_ld(&(bar)[XB_TMO])) break; if (_sp > XB_SPIN_CAP) { atomicAdd(&(bar)[XB_TMO], 1u); break; } } } } while (0)
__device__ __forceinline__ unsigned xcd_barrier_complete(unsigned* bar, unsigned x) {
    const unsigned G = gridDim.x * gridDim.y * gridDim.z;
    unsigned sum, cnt, mine, sp = 0u;
    for (;;) {
        sum = 0u; cnt = 0u; mine = 0u;
#pragma unroll
        for (unsigned j = 0; j < 16; ++j) { const unsigned c = xb_ld(&bar[XB_XCNT(j)]); sum += c; cnt += (c > 0u) ? 1u : 0u; mine = (j == x) ? c : mine; }
        if (sum == G) break;
        __builtin_amdgcn_s_sleep(1);
        if ((++sp & 255u) == 0u) { if (xb_ld(&bar[XB_TMO])) break; if (sp > XB_SPIN_CAP) { atomicAdd(&bar[XB_TMO], 1u); break; } }
    }
    return (mine > 0u ? mine : 1u) | ((cnt > 0u ? cnt : 1u) << 16);
}
__device__ __forceinline__ void xcd_barrier(unsigned* bar, unsigned x, volatile LDSP unsigned* st) {
    asm volatile("s_waitcnt vmcnt(0)" ::: "memory");
    __syncthreads();
    if (threadIdx.x == 0) {
        __builtin_amdgcn_s_waitcnt(0);
        unsigned pk = st[0];
        if (pk == 0u) { pk = xcd_barrier_complete(bar, x); st[0] = pk; }
        const unsigned nloc = pk & 0xffffu, nx = pk >> 16;
        const unsigned old = xb_add(&bar[XB_XSUB(x)], 1u);
        const unsigned gen = old / nloc;
        if (old + 1u == (gen + 1u) * nloc) {
            __builtin_amdgcn_fence(__ATOMIC_RELEASE, "agent");
            asm volatile("s_waitcnt vmcnt(0)" ::: "memory");
            const unsigned og = xb_add(&bar[XB_TOP], 1u);
            const unsigned tg = og / nx;
            if (og + 1u == (tg + 1u) * nx) xb_add(&bar[XB_TOPGEN], 1u);
            else XB_SPIN(xb_ld(&bar[XB_TOPGEN]) == tg, bar);
            __builtin_amdgcn_fence(__ATOMIC_ACQUIRE, "agent");
            xb_add(&bar[XB_XGEN(x)], 1u);
            asm volatile("s_waitcnt vmcnt(0)" ::: "memory");
        } else {
            XB_SPIN(xb_ld(&bar[XB_XGEN(x)]) == gen, bar);
            __builtin_amdgcn_fence(__ATOMIC_ACQUIRE, "agent");
            asm volatile("s_waitcnt vmcnt(0)" ::: "memory");
        }
    }
    __syncthreads();
}

__global__ void __launch_bounds__(512, 2) fwd_megakernel(Params p) {
    __shared__ __attribute__((aligned(16))) unsigned char smem_raw[SMEM_BYTES];
    LDSP unsigned char* lds = (LDSP unsigned char*)smem_raw;
    volatile LDSP unsigned* xst = (volatile LDSP unsigned*)(lds + SMEM_BYTES - 16);
    if (threadIdx.x == 0) { xst[0] = 0u; xst[1] = 0u; }
    __syncthreads();
    const unsigned xcc = xb_xcc_id();
    if (threadIdx.x == 0) (void)xb_add(&((unsigned*)p.ws)[XB_XCNT(xcc)], 1u);
#define GSYNC xcd_barrier((unsigned*)p.ws, xcc, xst)
#ifndef PH_TWICE
#define PH_TWICE 0
#endif
#ifndef PH_MASK
#define PH_MASK 0xffff
#endif
#define RUN_PHASE(bit, fn) _Pragma("unroll 1") for (int rep = 0; rep < ((PH_TWICE & (bit)) ? 2 : 1); ++rep) { if (rep) GSYNC; if (PH_MASK & (bit)) { Params q = p; q.ws = opq(p.ws); fn(lds, q); } }
    RUN_PHASE(1, phase0)      GSYNC;
    RUN_PHASE(2, phase1)      GSYNC;
    RUN_PHASE(4, phase2)      GSYNC;
    RUN_PHASE(8, phaseR1)     GSYNC;
    RUN_PHASE(16, phaseR2)    GSYNC;
    RUN_PHASE(32, phaseR3)    GSYNC;
    RUN_PHASE(64, phaseR4)    GSYNC;
    RUN_PHASE(128, phaseR5)   GSYNC;
    RUN_PHASE(256, phase6)    GSYNC;
    RUN_PHASE(512, phase7)    GSYNC;
    RUN_PHASE(1024, phase8)   GSYNC;
    RUN_PHASE(2048, phase9)   GSYNC;
    RUN_PHASE(4096, phase10)
}

extern "C" void kernel_launch(void* const* d_in, const int* in_sizes, int n_in, void* d_out, int out_size, void* d_ws, size_t ws_size, hipStream_t stream) {
    static int grid_blocks = 0;
    if (!grid_blocks) {
        int dev = 0, cus = 0, per_cu = 0;
        (void)hipGetDevice(&dev);
        (void)hipDeviceGetAttribute(&cus, hipDeviceAttributeMultiprocessorCount, dev);
        (void)hipOccupancyMaxActiveBlocksPerMultiprocessor(&per_cu, fwd_megakernel, 512, 0);
        if (per_cu > 1) per_cu = 1;
        grid_blocks = cus * per_cu;
        if (ws_size < WS_END) fprintf(stderr, "workspace too small: %zu < %zu\n", ws_size, (size_t)WS_END);
    }
    Params p{};
    const float** f = (const float**)&p;
    for (int i = 0; i < 31; ++i) f[i] = (const float*)d_in[i];
    p.out = (float*)d_out; p.ws = (unsigned char*)d_ws;
    (void)hipMemsetAsync(d_ws, 0, 32768, stream);
    void* args[] = {&p};
    hipError_t e = hipLaunchCooperativeKernel((void*)fwd_megakernel, dim3(grid_blocks), dim3(512), args, 0, stream);
    if (e != hipSuccess) fprintf(stderr, "cooperative launch failed: %s (grid %d)\n", hipGetErrorString(e), grid_blocks);
}
```

```cpp
#include <hip/hip_runtime.h>
#include <hip/hip_cooperative_groups.h>
#include <cstdio>
#include <cstdint>
namespace cg = cooperative_groups;

#define LDSP __attribute__((address_space(3)))
typedef unsigned short bf16_t;
typedef short bf16x8 __attribute__((ext_vector_type(8)));
typedef float f32x4 __attribute__((ext_vector_type(4)));
typedef float f32x16 __attribute__((ext_vector_type(16)));
typedef unsigned u32x4 __attribute__((ext_vector_type(4)));
typedef unsigned u32x2 __attribute__((ext_vector_type(2)));
typedef int v4i __attribute__((ext_vector_type(4)));
typedef int v8i __attribute__((ext_vector_type(8)));
__device__ __forceinline__ u32x4 mk4u(unsigned a, unsigned b, unsigned c, unsigned d) { u32x4 r; r.x = a; r.y = b; r.z = c; r.w = d; return r; }
__device__ __forceinline__ u32x2 mk2u(unsigned a, unsigned b) { u32x2 r; r.x = a; r.y = b; return r; }
__device__ __forceinline__ f32x4 mk4f(float a, float b, float c, float d) { f32x4 r; r.x = a; r.y = b; r.z = c; r.w = d; return r; }

constexpr int D = 2048, NB = 2, T = 4096, CL = 256, NX = NB * T, NCX = NB * CL, NR = NX + NCX;
constexpr int INC = 5056, INP = 5120;
constexpr int C_R = 0, C_K = 1024, C_V = 2048, C_XW = 3072, C_XA = 3168, C_XG = 3264, C_Q = 3520, C_AK = 4544, C_AV = 4800;
constexpr int NE = 64, NEX = 65, EFF = 512;
constexpr int NCHUNK = 68;
constexpr int NINST = NB * 16 * 2 * NCHUNK;
constexpr int EROWS = NX * 8 + NX;

constexpr size_t al4k(size_t x) { return (x + 4095) & ~(size_t)4095; }
constexpr size_t OFF_CTL = 0;
constexpr size_t OFF_ROPE = 65536;
constexpr size_t OFF_MODP = OFF_ROPE + 8192;
constexpr size_t OFF_MOD = al4k(OFF_MODP + (size_t)16 * 3 * 12288 * 4);
constexpr size_t OFF_WTDU = al4k(OFF_MOD + (size_t)3 * 12288 * 4);
constexpr size_t OFF_WTIU = OFF_WTDU + (size_t)2 * 1024 * 128 * 2;
constexpr size_t OFF_WTGU = OFF_WTIU + (size_t)2 * 1024 * 128 * 2;
constexpr size_t OFF_WTE2 = OFF_WTGU + (size_t)1024 * 256 * 2;
constexpr size_t OFF_X1 = OFF_WTE2 + (size_t)NEX * 2048 * 512 * 2;
constexpr size_t OFF_H2 = OFF_X1 + (size_t)NX * D * 4;
constexpr size_t OFF_TOKL = OFF_H2 + (size_t)NX * D * 2;
constexpr size_t OFF_EIDX = OFF_TOKL + (size_t)NE * NX * 4;
constexpr size_t OFF_ESLOT = OFF_EIDX + (size_t)NX * 8 * 4;
constexpr size_t OFF_GATE = OFF_ESLOT + (size_t)NX * 8 * 4;
constexpr size_t OFF_H1 = OFF_GATE + (size_t)NX * 8 * 4;
constexpr size_t OFF_WTE1 = al4k(OFF_H1 + (size_t)(EROWS + 256) * EFF * 2);
constexpr size_t OFF_EO = OFF_WTE1;
constexpr size_t OFF_WTIN = OFF_WTE1 + (size_t)NEX * 1024 * 2048 * 2;
constexpr size_t OFF_WTOUT = OFF_WTIN + (size_t)INP * D * 2;
constexpr size_t OFF_HX = OFF_WTOUT + (size_t)D * D * 2;
constexpr size_t OFF_PX = OFF_HX + (size_t)NR * D * 2;
constexpr size_t OFF_CM = OFF_PX + (size_t)NR * INP * 2;
constexpr size_t OFF_CN = OFF_CM + (size_t)NINST * 4096 * 2;
constexpr size_t OFF_CP = OFF_CN + (size_t)NINST * 4096 * 2;
constexpr size_t OFF_CQ = OFF_CP + (size_t)NINST * 4096 * 2;
constexpr size_t OFF_YD = OFF_CQ + (size_t)NINST * 4096 * 2;
constexpr size_t OFF_BON = OFF_YD + (size_t)2 * NX * 1024 * 4;
constexpr size_t OFF_MIX = OFF_BON + (size_t)2 * NX * 16 * 4;
constexpr size_t WS_END = OFF_MIX + (size_t)NX * D * 2;
constexpr size_t OFF_RS = OFF_X1;
constexpr size_t OFF_KS = OFF_RS + (size_t)NR * 1024 * 2;
constexpr size_t OFF_KK = OFF_KS + (size_t)NR * 1024 * 2;
constexpr size_t OFF_VS = OFF_KK + (size_t)NR * 1024 * 2;
constexpr size_t OFF_TW = OFF_VS + (size_t)NR * 1024 * 2;
constexpr size_t OFF_XA = OFF_TW + (size_t)NR * 128 * 2;
constexpr size_t OFF_SG = OFF_XA + (size_t)NR * 128 * 2;
constexpr size_t OFF_LWG = OFF_SG + (size_t)NX * 256 * 2;
constexpr size_t OFF_AIG = OFF_LWG + (size_t)NR * 2048 * 2;
constexpr size_t OFF_GG = OFF_AIG + (size_t)NR * 2048 * 2;
static_assert(OFF_GG + (size_t)NX * 1024 * 2 <= OFF_WTE1, "RWKV token buffers fit the overlay region");
static_assert(OFF_EO + (size_t)EROWS * D * 2 <= OFF_HX, "EO overlays only WT_E1/WT_IN/WT_OUT");
static_assert(WS_END <= (size_t)1073741824, "workspace map must fit 1 GiB");

constexpr int SMEM_BYTES = 157 * 1024;

struct Params {
    const float *x, *c, *ctx, *c_ctx, *w_mod, *b_mod, *norm1_g, *norm2_g, *w_in, *shift_mu, *k_k, *k_a, *r_k, *decay_bias, *decay_up, *iclr_bias, *iclr_up,
        *gate_up, *lnx_g, *lnx_b, *attn_sink, *w_out, *w_router, *expert_bias, *e_gate, *e_up, *e_down, *s_gate, *s_up, *s_down, *final_g;
    float* out;
    unsigned char* ws;
};

__device__ __forceinline__ unsigned f2bf(float f) { unsigned u = __float_as_uint(f); return (u + 0x7fffu + ((u >> 16) & 1u)) >> 16; }
__device__ __forceinline__ float bf2f(unsigned h) { return __uint_as_float(h << 16); }
typedef float f32x2_t __attribute__((ext_vector_type(2)));
typedef __bf16 bf16x2_t __attribute__((ext_vector_type(2)));
__device__ __forceinline__ unsigned pk2(float lo, float hi) { f32x2_t v = {lo, hi}; bf16x2_t b = __builtin_convertvector(v, bf16x2_t); return __builtin_bit_cast(unsigned, b); }
__device__ __forceinline__ unsigned pk4_fp8(float a, float b, float c, float d) { int w = 0; w = __builtin_amdgcn_cvt_pk_fp8_f32(a, b, w, false); w = __builtin_amdgcn_cvt_pk_fp8_f32(c, d, w, true); return (unsigned)w; }
__device__ __forceinline__ float wave_sum(float v) {
#pragma unroll
    for (int o = 32; o > 0; o >>= 1) v += __shfl_xor(v, o);
    return v;
}
__device__ __forceinline__ int opaque(int x) { asm volatile("" : "+v"(x)); return x; }
__device__ __forceinline__ int opaque_s(int x) { asm volatile("" : "+s"(x)); return x; }
__device__ __forceinline__ unsigned char* opq(unsigned char* x) {
    unsigned long long v = (unsigned long long)x; asm volatile("" : "+s"(v));
    return (unsigned char*)(__attribute__((address_space(1))) unsigned char*)v; }
__device__ __forceinline__ float sigmoidf_(float x) { return __builtin_amdgcn_rcpf(1.f + __expf(-x)); }
__device__ __forceinline__ int lds_byte(int r, int c) { const int st = (r >> 4) * 2 + (c >> 5), rr = r & 15, cc = c & 31, ob = rr * 64 + cc * 2; return st * 1024 + (ob ^ (((ob >> 9) & 1) << 5)); }
__device__ __forceinline__ int sw64(int r, int k) { return r * 128 + ((((k >> 3) ^ (r >> 1)) & 7) << 4) + (k & 7) * 2; }

__device__ __forceinline__ f32x16 zero16() { f32x16 z;
#pragma unroll
    for (int i = 0; i < 16; ++i) z[i] = 0.f; return z; }
__device__ __forceinline__ int crow(int reg, int hi) { return (reg & 3) + 8 * (reg >> 2) + 4 * hi; }

namespace pg8 {
constexpr int BM = 256, BK = 64, HALF = 128, HTB = HALF * BK * 2, NXCD = 8;
__device__ __forceinline__ void stage_rc(int b, int& R, int& C) { const int st = b / 1024, sb = b % 1024, swz = sb ^ (((sb >> 9) & 1) << 5); R = (st >> 1) * 16 + swz / 64; C = (st & 1) * 32 + (swz % 64) / 2; }
struct Unit { const char* A; const char* B; const int* rowmap; int nvalid, m0, row0, col0, pos0, e; };
__device__ __forceinline__ int xcd_remap(int L, int nwg) { const int q = nwg / NXCD, r = nwg % NXCD, xcd = L % NXCD, off = L / NXCD; return (xcd < r ? xcd * (q + 1) : r * (q + 1) + (xcd - r) * q) + off; }

__device__ __forceinline__ int perm32(int rho) { const int n = rho >> 4, i = rho & 15; return 8 * (i >> 2) + 4 * n + (i & 3); }
template <class F, int NBJ = 2> struct Epi {
    F f;
    __device__ __forceinline__ void operator()(const f32x4 (&acc)[2][2][4][2], const Unit& u, int wr, int wc, int fr, int fq) const {
#pragma unroll
        for (int ai = 0; ai < 2; ++ai)
#pragma unroll
            for (int m = 0; m < 4; ++m)
#pragma unroll
                for (int bj = 0; bj < NBJ; ++bj) { f(u, 128 * ai + 64 * wr + 16 * m + fr, 128 * bj + 32 * wc + 8 * fq, acc[ai][bj][m][0], acc[ai][bj][m][1]); __builtin_amdgcn_sched_barrier(0); }
    }
};

template <bool GATHER, bool ALIGN_EPI = true, bool FP8 = false, class EpiT, class Sched>
__device__ __forceinline__ void gemm_phase(LDSP unsigned char* lds, const int K, const Sched& S, const EpiT& E) {
    const int tid = opaque(threadIdx.x), wid = __builtin_amdgcn_readfirstlane(tid >> 6), lane = tid & 63, wr = wid >> 2, wc = wid & 3, fr = lane & 15, fq = lane >> 4;
    const int nt = K / BK;
    unsigned voffA[2], voffB[2];
#pragma unroll
    for (int i = 0; i < 2; ++i) { int R, C; stage_rc(tid * 16 + i * 8192, R, C); const int Rb = (R & ~31) + perm32(R & 31); voffA[i] = (unsigned)(R * K + C) * 2u; voffB[i] = (unsigned)(Rb * K + C) * 2u; }
    const size_t kstep = (size_t)(BK * 2);
    const size_t hstep = (size_t)HALF * K * 2;
    const size_t hstepB = hstep;
    const unsigned ldsw = (unsigned)wid * 1024u;
    const int aoff = lds_byte(wr * 64 + fr, fq * 8), boff = lds_byte(wc * 32 + fr, fq * 8);
#define PG8_SA(b, h) (((b) * 2 + (h)) * HTB)
#define PG8_SB(b, h) ((4 + (b) * 2 + (h)) * HTB)
#define PG8_STAGE(bufoff, gbase, voff) do { _Pragma("unroll") for (int _i = 0; _i < 2; ++_i) \
        __builtin_amdgcn_global_load_lds((const unsigned*)((const char*)(gbase) + (voff)[_i]), (LDSP unsigned*)(lds + (bufoff) + ldsw + _i * 8192), 16, 0, 0); } while (0)
#define PG8_STAGE_B1(bufoff, gbase) do { if constexpr (!FP8) { PG8_STAGE(bufoff, gbase, voffB); } } while (0)
#define PG8_STAGE_A(bufoff, nx, h, ubase, koff) do { if constexpr (GATHER) { unsigned _v[2]; const LDSP unsigned* _ro = rowoff + ((((nx) ? (ui + 1) : ui) & 1) * 4 + (h) * 2) * 512; _v[0] = _ro[0]; _v[1] = _ro[512]; PG8_STAGE(bufoff, (ubase) + (koff), _v); } \
        else { PG8_STAGE(bufoff, (ubase) + (h) * hstep + (koff), voffA); } } while (0)
#define PG8_LD16(off) (*(const LDSP bf16x8*)(lds + (off)))
#define PG8_LDA(dst, b, h) do { _Pragma("unroll") for (int m = 0; m < 4; ++m) { if constexpr (FP8) dst##8[m] = __builtin_shufflevector(__builtin_bit_cast(v4i, PG8_LD16(PG8_SA(b, h) + aoff + m * 2048)), __builtin_bit_cast(v4i, PG8_LD16(PG8_SA(b, h) + aoff + m * 2048 + 1024)), 0, 1, 2, 3, 4, 5, 6, 7); \
        else { _Pragma("unroll") for (int k = 0; k < 2; ++k) dst[m][k] = PG8_LD16(PG8_SA(b, h) + aoff + m * 2048 + k * 1024); } } } while (0)
#define PG8_LDB(dst, b, h) do { if constexpr (!FP8 || (h) == 0) { _Pragma("unroll") for (int n = 0; n < 2; ++n) { if constexpr (FP8) dst##8[n] = __builtin_shufflevector(__builtin_bit_cast(v4i, PG8_LD16(PG8_SB(b, h) + boff + n * 2048)), __builtin_bit_cast(v4i, PG8_LD16(PG8_SB(b, h) + boff + n * 2048 + 1024)), 0, 1, 2, 3, 4, 5, 6, 7); \
        else { _Pragma("unroll") for (int k = 0; k < 2; ++k) dst[n][k] = PG8_LD16(PG8_SB(b, h) + boff + n * 2048 + k * 1024); } } } } while (0)
#define PG8_MMA(ai, bj, At, Bt) do { if constexpr (!FP8 || (bj) == 0) { __builtin_amdgcn_s_setprio(1); if constexpr (FP8) { _Pragma("unroll") for (int m = 0; m < 4; ++m) _Pragma("unroll") for (int n = 0; n < 2; ++n) \
            acc[ai][bj][m][n] = __builtin_amdgcn_mfma_scale_f32_16x16x128_f8f6f4(Bt##8[n], At##8[m], acc[ai][bj][m][n], 0, 0, 0, 0x7f7f7f7f, 0, 0x7f7f7f7f); } \
        else { _Pragma("unroll") for (int m = 0; m < 4; ++m) _Pragma("unroll") for (int n = 0; n < 2; ++n) _Pragma("unroll") for (int k = 0; k < 2; ++k) \
            acc[ai][bj][m][n] = __builtin_amdgcn_mfma_f32_16x16x32_bf16(Bt[n][k], At[m][k], acc[ai][bj][m][n], 0, 0, 0); } __builtin_amdgcn_s_setprio(0); } } while (0)
#define PG8_WAIT_V(n) asm volatile("s_waitcnt vmcnt(" #n ")" ::: "memory")
#define PG8_WAIT_L(n) asm volatile("s_waitcnt lgkmcnt(" #n ")" ::: "memory")
#define PG8_BAR __builtin_amdgcn_s_barrier()
#define PG8_SCHED __builtin_amdgcn_sched_barrier(0)
    Unit cur, nxt; int ui = 0;
    cur.e = 0; nxt.e = 0;
    if (!S.next(0, cur)) return;
    LDSP unsigned* rowoff = (LDSP unsigned*)(lds + 132096) + tid;
    auto rows_of = [&](const Unit& u, int slot) {
        if constexpr (GATHER) {
#pragma unroll
            for (int h = 0; h < 2; ++h)
#pragma unroll
                for (int i = 0; i < 2; ++i) { int R, C; stage_rc(tid * 16 + i * 8192, R, C); const int idx = u.m0 + h * HALF + R; int gr = idx; if (u.rowmap) gr = (idx < u.nvalid) ? u.rowmap[idx] : 0;
                    rowoff[((slot & 1) * 4 + h * 2 + i) * 512] = (unsigned)(gr * K + C) * 2u; }
        }
    };
    rows_of(cur, 0);
    f32x4 acc[2][2][4][2];
#pragma unroll
    for (int a = 0; a < 2; ++a)
#pragma unroll
        for (int b = 0; b < 2; ++b)
#pragma unroll
            for (int m = 0; m < 4; ++m)
#pragma unroll
                for (int n = 0; n < 2; ++n) acc[a][b][m][n] = (f32x4){0.f, 0.f, 0.f, 0.f};
    bf16x8 At[4][2], B0[2][2], B1[2][2];
    v8i At8[4], B08[2], B18[2];
    const char* cA = cur.A; const char* cB = cur.B;
    PG8_STAGE(PG8_SB(0, 0), cB, voffB); PG8_STAGE_B1(PG8_SB(0, 1), cB + hstepB); PG8_STAGE_A(PG8_SA(0, 0), false, 0, cA, 0); PG8_STAGE_A(PG8_SA(0, 1), false, 1, cA, 0);
    if (wr == 1) PG8_BAR;
    PG8_WAIT_V(2); PG8_BAR;
    PG8_STAGE(PG8_SB(1, 0), cB + kstep, voffB); PG8_STAGE_A(PG8_SA(1, 0), false, 0, cA, kstep); PG8_STAGE_B1(PG8_SB(1, 1), cB + hstepB + kstep);
    if constexpr (FP8) PG8_WAIT_V(4); else PG8_WAIT_V(6);
    PG8_BAR;
    for (;;) {
        nxt.e = cur.e;
        const bool has_next = S.next(ui + 1, nxt);
        rows_of(has_next ? nxt : cur, ui + 1);
        const char* nA = has_next ? nxt.A : cA; const char* nB = has_next ? nxt.B : cB;
#pragma unroll 1
        for (int t = 0; t < nt; t += 2) {
            const bool last = (t == nt - 2);
            const size_t k1 = (size_t)(t + 1) * kstep;
            const char* a2 = last ? nA : cA; const size_t k2 = last ? 0 : (size_t)(t + 2) * kstep;
            const char* b2 = last ? nB : cB + (size_t)(t + 2) * kstep;
            const char* b3 = b2 + kstep;
            PG8_LDB(B0, 0, 0); PG8_LDB(B1, 0, 1); PG8_SCHED; PG8_LDA(At, 0, 0); PG8_STAGE_A(PG8_SA(1, 1), false, 1, cA, k1);
            if constexpr (FP8) PG8_WAIT_V(6); else PG8_WAIT_V(8);
            PG8_WAIT_L(0); PG8_BAR; PG8_MMA(0, 0, At, B0); PG8_MMA(0, 1, At, B1); PG8_BAR; PG8_SCHED;
            PG8_LDA(At, 0, 1); PG8_STAGE(PG8_SB(0, 0), b2, voffB); PG8_STAGE_B1(PG8_SB(0, 1), b2 + hstepB); PG8_STAGE_A(PG8_SA(0, 0), last, 0, a2, k2);
            if constexpr (FP8) PG8_WAIT_V(6); else PG8_WAIT_V(8);
            PG8_WAIT_L(0); PG8_BAR; PG8_MMA(1, 0, At, B0); PG8_MMA(1, 1, At, B1); PG8_BAR; PG8_SCHED;
            PG8_LDB(B0, 1, 0); PG8_LDB(B1, 1, 1); PG8_SCHED; PG8_LDA(At, 1, 0); PG8_STAGE_A(PG8_SA(0, 1), last, 1, a2, k2);
            if constexpr (FP8) PG8_WAIT_V(6); else PG8_WAIT_V(8);
            PG8_WAIT_L(0); PG8_BAR; PG8_MMA(0, 0, At, B0); PG8_MMA(0, 1, At, B1); PG8_BAR; PG8_SCHED;
            PG8_LDA(At, 1, 1); PG8_STAGE(PG8_SB(1, 0), b3, voffB); PG8_STAGE_B1(PG8_SB(1, 1), b3 + hstepB); PG8_STAGE_A(PG8_SA(1, 0), last, 0, a2, k2 + kstep);
            if constexpr (FP8) PG8_WAIT_V(6); else PG8_WAIT_V(8);
            PG8_WAIT_L(0); PG8_BAR; PG8_MMA(1, 0, At, B0); PG8_MMA(1, 1, At, B1); PG8_BAR; PG8_SCHED;
        }
        if constexpr (ALIGN_EPI) { if (wr == 0) PG8_BAR; }
        E(acc, cur, wr, wc, fr, fq);
        if (!has_next) break;
#pragma unroll
        for (int a = 0; a < 2; ++a)
#pragma unroll
            for (int b = 0; b < 2; ++b)
#pragma unroll
                for (int m = 0; m < 4; ++m)
#pragma unroll
                    for (int n = 0; n < 2; ++n) acc[a][b][m][n] = (f32x4){0.f, 0.f, 0.f, 0.f};
        cur = nxt; cA = nA; cB = nB; ++ui;
        if constexpr (ALIGN_EPI) { if (wr == 1) PG8_BAR; }
    }
    PG8_WAIT_V(0);
    if constexpr (!ALIGN_EPI) { if (wr == 0) PG8_BAR; }
    PG8_BAR;
#undef PG8_SA
#undef PG8_SB
#undef PG8_STAGE
#undef PG8_STAGE_A
#undef PG8_STAGE_B1
#undef PG8_LDA
#undef PG8_LD16
#undef PG8_LDB
#undef PG8_MMA
#undef PG8_WAIT_V
#undef PG8_WAIT_L
#undef PG8_BAR
#undef PG8_SCHED
}

struct DenseSched {
    const char* A; const char* B; int nM, nN, K, G, c;
    __device__ __forceinline__ bool next(int i, Unit& u) const {
        const int nwg = nM * nN; const long L = (long)i * G + c; if (L >= nwg) return false;
        const int wgid = xcd_remap((int)L, nwg);
        const int nig = 8 * nN, gid = wgid / nig, fm = gid * 8, gsz = (nM - fm) < 8 ? (nM - fm) : 8;
        const int pm = fm + ((wgid % nig) % gsz), pn = (wgid % nig) / gsz;
        u.A = A + (size_t)pm * 256 * K * 2; u.B = B + (size_t)pn * 256 * K * 2; u.rowmap = nullptr; u.nvalid = 0; u.m0 = 0; u.row0 = pm * 256; u.col0 = pn * 256; u.pos0 = 0;
        return true;
    }
};
}

struct FPX { bf16_t* PX; __device__ __forceinline__ void operator()(const pg8::Unit& u, int lr, int lc, f32x4 v0, f32x4 v1) const {
    *(u32x4*)(PX + (size_t)(u.row0 + lr) * INP + u.col0 + lc) = mk4u(pk2(v0[0], v0[1]), pk2(v0[2], v0[3]), pk2(v1[0], v1[1]), pk2(v1[2], v1[3])); } };
struct FX1 { const float* x; const float* mod; float* X1; __device__ __forceinline__ void operator()(const pg8::Unit& u, int lr, int lc, f32x4 v0, f32x4 v1) const {
    const int row = u.row0 + lr, col = u.col0 + lc; const float* xp = x + (size_t)row * D + col; const float* gp = mod + (size_t)(row >> 12) * 12288 + 2 * D + col; float* op = X1 + (size_t)row * D + col;
    *(f32x4*)op = *(const f32x4*)xp + *(const f32x4*)gp * v0; *(f32x4*)(op + 4) = *(const f32x4*)(xp + 4) + *(const f32x4*)(gp + 4) * v1; } };
constexpr float W1_SCALE = 64.f, W2_SCALE = 32.f;
struct FH1 { unsigned char* H1; __device__ __forceinline__ void operator()(const pg8::Unit& u, int lr, int lc, f32x4 v0, f32x4 v1) const {
    if (u.m0 + lr < u.nvalid) { float h[4];
#pragma unroll
        for (int e = 0; e < 4; ++e) { const float g = v0[e] * (1.f / W1_SCALE); h[e] = g * sigmoidf_(g) * (v1[e] * (1.f / W1_SCALE)); }
        *(unsigned*)(H1 + (size_t)(u.pos0 + u.m0 + lr) * EFF + ((u.col0 + lc) >> 1)) = pk4_fp8(h[0], h[1], h[2], h[3]); } } };
struct FEO { unsigned char* EO; __device__ __forceinline__ void operator()(const pg8::Unit& u, int lr, int lc, f32x4 v0, f32x4 v1) const {
    if (u.m0 + lr < u.nvalid) { v0 *= (1.f / W2_SCALE); v1 *= (1.f / W2_SCALE);
        *(u32x2*)(EO + (size_t)(u.pos0 + u.m0 + lr) * D + u.col0 + lc) = mk2u(pk4_fp8(v0[0], v0[1], v0[2], v0[3]), pk4_fp8(v1[0], v1[1], v1[2], v1[3])); } } };

struct ConvJob { const float* src; bf16_t* dst; int K, N, ld, mode, ntk, ntn; size_t sbs, dbs; };
__device__ __forceinline__ int conv_row(int n, int mode) { return mode == 0 ? n : (8 * (n >> 2) + (n & 3) + (mode == 2 ? 4 : 0)); }

struct TileCtx { const float* src; bf16_t* dst; int N, ld, mode, k0, n0; };
constexpr int CT0 = 0, CT1 = CT0 + 8 * (INC / 64), CT2 = CT1 + 8 * 32, CT3 = CT2 + 64 * 64, CT4 = CT3 + 64 * 64, CT5 = CT4 + 64 * 64, CT6 = CT5 + 64, CT7 = CT6 + 64, CT8 = CT7 + 64, CT_END = CT8 + 16;
__device__ __forceinline__ void conv_decode(const Params& p, int g, const float*& src, bf16_t*& dst, int& N, int& ld, int& mode, int& k0, int& n0) {
    unsigned char* WTE1 = p.ws + OFF_WTE1; unsigned char* WTE2 = p.ws + OFF_WTE2;
    unsigned char* d8; int t, ntk, ntn; size_t sbs = 0, dbs = 0;
    if (g < CT1)      { t = g - CT0; src = p.w_in; d8 = p.ws + OFF_WTIN; N = INC; ld = 4096; mode = 0; ntk = 8; ntn = INC / 64; }
    else if (g < CT2) { t = g - CT1; src = p.w_out; d8 = p.ws + OFF_WTOUT; N = 2048; ld = 4096; mode = 0; ntk = 8; ntn = 32; }
    else if (g < CT3) { t = g - CT2; src = p.e_gate; d8 = WTE1; N = 512; ld = 2048; mode = 5; ntk = 8; ntn = 8; sbs = (size_t)2048 * 512; dbs = (size_t)1024 * 2048; }
    else if (g < CT4) { t = g - CT3; src = p.e_up; d8 = WTE1; N = 512; ld = 2048; mode = 6; ntk = 8; ntn = 8; sbs = (size_t)2048 * 512; dbs = (size_t)1024 * 2048; }
    else if (g < CT5) { t = g - CT4; src = p.e_down; d8 = WTE2; N = 2048; ld = 512; mode = 4; ntk = 2; ntn = 32; sbs = (size_t)512 * 2048; dbs = (size_t)2048 * 512; }
    else if (g < CT6) { t = g - CT5; src = p.s_gate; d8 = WTE1 + (size_t)64 * 1024 * 2048; N = 512; ld = 2048; mode = 5; ntk = 8; ntn = 8; }
    else if (g < CT7) { t = g - CT6; src = p.s_up; d8 = WTE1 + (size_t)64 * 1024 * 2048; N = 512; ld = 2048; mode = 6; ntk = 8; ntn = 8; }
    else if (g < CT8) { t = g - CT7; src = p.s_down; d8 = WTE2 + (size_t)64 * 2048 * 512; N = 2048; ld = 512; mode = 4; ntk = 2; ntn = 32; }
    else              { t = g - CT8; src = p.gate_up; d8 = p.ws + OFF_WTGU; N = 1024; ld = 512; mode = 0; ntk = 1; ntn = 16; }
    const int per = ntk * ntn, bi = t / per, rem = t - bi * per, kt = rem / ntn, ntile = rem - kt * ntn;
    src += (size_t)bi * sbs; dst = (bf16_t*)(d8 + (size_t)bi * dbs); k0 = kt * 256; n0 = ntile * 64;
}
__device__ __forceinline__ void conv_load(const float* src, int N, int k0, int n0, f32x4 (&v)[4][2], int tid) {
    const int kr = tid >> 3, nc = (tid & 7) * 8;
#pragma unroll
    for (int s = 0; s < 4; ++s) { const float* q = src + (size_t)(k0 + s * 64 + kr) * N + n0 + nc; v[s][0] = *(const f32x4*)q; v[s][1] = *(const f32x4*)(q + 4); }
}
__device__ __forceinline__ void conv_finish(LDSP unsigned char* lds, bf16_t* dst, int ld, int mode, int k0, int n0, const f32x4 (&v)[4][2], int tid) {
    LDSP float* Tm = (LDSP float*)lds;
    {
        const int kr = tid >> 3, nc = (tid & 7) * 8;
#pragma unroll
        for (int s = 0; s < 4; ++s) { LDSP float* q = Tm + (s * 64 + kr) * 65 + nc;
            q[0] = v[s][0].x; q[1] = v[s][0].y; q[2] = v[s][0].z; q[3] = v[s][0].w; q[4] = v[s][1].x; q[5] = v[s][1].y; q[6] = v[s][1].z; q[7] = v[s][1].w; }
    }
    __syncthreads();
    {
        const int n = tid >> 3; bf16_t* drow = (bf16_t*)((unsigned char*)dst + (size_t)conv_row(n0 + n, mode & 3) * ld) + k0;
#pragma unroll
        for (int s = 0; s < 4; ++s) { const int kc = ((tid & 7) + 8 * s) * 8; float f[8];
#pragma unroll
            for (int j = 0; j < 8; ++j) f[j] = Tm[(kc + j) * 65 + n];
            u32x4 w; w.x = pk2(f[0], f[1]); w.y = pk2(f[2], f[3]); w.z = pk2(f[4], f[5]); w.w = pk2(f[6], f[7]); *(u32x4*)(drow + kc) = w; }
    }
    __syncthreads();
}

__device__ __forceinline__ void mod_item(LDSP unsigned char* lds, const Params& p, int item) {
    const int kb = item >> 6, nb = item & 63, tid = opaque(threadIdx.x), wid = tid >> 6, lane = tid & 63;
    f32x4 acc[3];
#pragma unroll
    for (int v = 0; v < 3; ++v) acc[v] = mk4f(0.f, 0.f, 0.f, 0.f);
    if (lane < 48) {
#pragma unroll 8
        for (int i = 0; i < 64; ++i) {
            const int k = kb * 512 + wid * 64 + i;
            const float c0 = p.c[k], c1 = p.c[D + k], c2 = p.c_ctx[k];
            const float s0 = c0 * sigmoidf_(c0), s1 = c1 * sigmoidf_(c1), s2 = c2 * sigmoidf_(c2);
            const f32x4 w = *(const f32x4*)(p.w_mod + (size_t)k * 12288 + nb * 192 + 4 * lane);
            acc[0] += s0 * w; acc[1] += s1 * w; acc[2] += s2 * w;
        }
    }
    LDSP float* R = (LDSP float*)lds;
    if (lane < 48) {
#pragma unroll
        for (int v = 0; v < 3; ++v) *(LDSP f32x4*)(R + (wid * 3 + v) * 192 + 4 * lane) = acc[v];
    }
    __syncthreads();
    float* MODP = (float*)(p.ws + OFF_MODP);
    for (int o = tid; o < 3 * 192; o += 512) { const int v = o / 192, cidx = o - v * 192; float sum = 0.f;
#pragma unroll
        for (int w = 0; w < 8; ++w) sum += R[(w * 3 + v) * 192 + cidx];
        MODP[((size_t)kb * 3 + v) * 12288 + nb * 192 + cidx] = sum; }
    __syncthreads();
}

__device__ __forceinline__ void conv_range(LDSP unsigned char* lds, const Params& p, int g0, int g1, int rank, int nblk) {
    const int tid = opaque(threadIdx.x);
    int g = g0 + rank;
    const float* csrc = nullptr; bf16_t* cdst = nullptr; int cN = 0, cld = 0, cmode = 0, ck0 = 0, cn0 = 0;
    const float* nsrc = nullptr; bf16_t* ndst = nullptr; int nN = 0, nld = 0, nmode = 0, nk0 = 0, nn0 = 0;
    f32x4 va[4][2], vb[4][2];
    if (g < g1) { conv_decode(p, g, csrc, cdst, cN, cld, cmode, ck0, cn0); conv_load(csrc, cN, ck0, cn0, va, tid); }
#pragma unroll 1
    while (g < g1) {
        const int gn = g + nblk;
        if (gn < g1) { conv_decode(p, gn, nsrc, ndst, nN, nld, nmode, nk0, nn0); conv_load(nsrc, nN, nk0, nn0, vb, tid); }
        conv_finish(lds, cdst, cld, cmode, ck0, cn0, va, tid);
        cdst = ndst; cld = nld; cmode = nmode; ck0 = nk0; cn0 = nn0; g = gn;
#pragma unroll
        for (int s = 0; s < 4; ++s) { va[s][0] = vb[s][0]; va[s][1] = vb[s][1]; }
    }
}

__device__ __forceinline__ void phase0(LDSP unsigned char* lds, const Params& p) {
    const int tid = opaque(threadIdx.x);
    for (int it = blockIdx.x; it < 256; it += gridDim.x) mod_item(lds, p, it);
    conv_range(lds, p, 0, CT1, blockIdx.x, gridDim.x);
    conv_range(lds, p, CT8, CT_END, blockIdx.x, gridDim.x);
    {
        const int total = 4 * 1024 * 128;
        for (int idx = blockIdx.x * 512 + tid; idx < total; idx += gridDim.x * 512) {
            const int mtx = idx >> 17, rem = idx & 131071, n = rem >> 7, k = rem & 127;
            const float* src = (mtx < 2 ? p.decay_up : p.iclr_up) + (size_t)(mtx & 1) * 96 * 1024;
            bf16_t* dst = (bf16_t*)(p.ws + (mtx < 2 ? OFF_WTDU : OFF_WTIU)) + (size_t)(mtx & 1) * 1024 * 128;
            dst[n * 128 + k] = (bf16_t)f2bf(k < 96 ? src[(size_t)k * 1024 + n] : 0.f);
        }
    }
    {
        u32x4* z = (u32x4*)((bf16_t*)(p.ws + OFF_WTIN) + (size_t)INC * D);
        const int total = (INP - INC) * D * 2 / 16;
        for (int idx = blockIdx.x * 512 + tid; idx < total; idx += gridDim.x * 512) z[idx] = mk4u(0, 0, 0, 0);
    }
    if (blockIdx.x == gridDim.x - 1) {
        float2* R = (float2*)(p.ws + OFF_ROPE);
        for (int idx = tid; idx < 1024; idx += 512) { const int pos = idx >> 4, f = idx & 15;
            const float freq = powf(10000.f, -(float)f / 16.f); const float ang = (float)pos * freq; R[idx] = make_float2(cosf(ang), sinf(ang)); }
    }
}

__device__ __forceinline__ void phase1(LDSP unsigned char* lds, const Params& p) {
    const int tid = opaque(threadIdx.x), wid = tid >> 6, lane = tid & 63;
    const float* MODP = (const float*)(p.ws + OFF_MODP);
    float* MOD = (float*)(p.ws + OFF_MOD);
    LDSP float* MV = (LDSP float*)lds;
    for (int idx = tid; idx < 3 * 4096; idx += 512) { const int v = idx >> 12, col = idx & 4095; float s = p.b_mod[col];
#pragma unroll
        for (int kb = 0; kb < 4; ++kb) s += MODP[((size_t)kb * 3 + v) * 12288 + col];
        MV[idx] = s; }
    for (int idx = blockIdx.x * 512 + tid; idx < 3 * 12288; idx += gridDim.x * 512) { const int v = idx / 12288, col = idx - v * 12288; float s = p.b_mod[col];
#pragma unroll
        for (int kb = 0; kb < 4; ++kb) s += MODP[((size_t)kb * 3 + v) * 12288 + col];
        MOD[idx] = s; }
    __syncthreads();
    bf16_t* HX = (bf16_t*)(p.ws + OFF_HX);
    for (int row = blockIdx.x * 8 + wid; row < NR; row += gridDim.x * 8) {
        const float* src = row < NX ? p.x + (size_t)row * D : p.ctx + (size_t)(row - NX) * D;
        const int v = row < NX ? (row >> 12) : 2;
        f32x4 xv[8]; float ss = 0.f;
#pragma unroll
        for (int i = 0; i < 8; ++i) { xv[i] = ((const f32x4*)src)[lane + 64 * i]; ss += xv[i].x * xv[i].x + xv[i].y * xv[i].y + xv[i].z * xv[i].z + xv[i].w * xv[i].w; }
        ss = wave_sum(ss);
        const float rs = rsqrtf(ss * (1.f / D) + 1e-6f);
#pragma unroll
        for (int i = 0; i < 8; ++i) { const int col = 4 * (lane + 64 * i);
            const f32x4 g = *(const f32x4*)(p.norm1_g + col); const LDSP float* sh = MV + v * 4096 + col; const LDSP float* sc = sh + 2048;
            const float h0 = xv[i].x * rs * g.x * (1.f + sc[0]) + sh[0], h1 = xv[i].y * rs * g.y * (1.f + sc[1]) + sh[1];
            const float h2 = xv[i].z * rs * g.z * (1.f + sc[2]) + sh[2], h3 = xv[i].w * rs * g.w * (1.f + sc[3]) + sh[3];
            u32x2 w; w.x = pk2(h0, h1); w.y = pk2(h2, h3); *(u32x2*)(HX + (size_t)row * D + col) = w; }
    }
}

__device__ __forceinline__ void phase2(LDSP unsigned char* lds, const Params& p) {
    pg8::Epi<FPX> epi{FPX{(bf16_t*)(p.ws + OFF_PX)}};
    pg8::DenseSched S{(const char*)(p.ws + OFF_HX), (const char*)(p.ws + OFF_WTIN), NR / 256, INP / 256, D, (int)gridDim.x, (int)blockIdx.x};
    pg8::gemm_phase<false>(lds, D, S, epi);
}

__device__ __forceinline__ void phaseR1(LDSP unsigned char* lds, const Params& p) {
    const int tid = opaque(threadIdx.x), wid = tid >> 6, lane = tid & 63;
    const bf16_t* PX = (const bf16_t*)(p.ws + OFF_PX);
    for (int row = blockIdx.x * 8 + wid; row < NR; row += gridDim.x * 8) {
        const bool isx = row < NX;
        const int s0 = isx ? (row & ~(T - 1)) : NX + ((row - NX) & ~(CL - 1)), len = isx ? T : CL;
        const bool hp = row > s0, hn = row + 1 < s0 + len;
        const bf16_t* pc = PX + (size_t)row * INP;
#pragma unroll 1
        for (int it = 0; it < 7; ++it) {
            const int ch = lane + 64 * it;
            if (ch < 440) {
                const int col = ch * 8;
                const u32x4 c4 = *(const u32x4*)(pc + col);
                u32x4 p4 = mk4u(0, 0, 0, 0), n4 = mk4u(0, 0, 0, 0);
                if (hp) p4 = *(const u32x4*)(pc - INP + col);
                if (hn) n4 = *(const u32x4*)(pc + INP + col);
                const f32x4 m0 = *(const f32x4*)(p.shift_mu + col), m1 = *(const f32x4*)(p.shift_mu + col + 4);
                const float mu[8] = {m0.x, m0.y, m0.z, m0.w, m1.x, m1.y, m1.z, m1.w};
                const unsigned cw[4] = {c4.x, c4.y, c4.z, c4.w}, pw[4] = {p4.x, p4.y, p4.z, p4.w}, nw[4] = {n4.x, n4.y, n4.z, n4.w};
                float v[8];
#pragma unroll
                for (int j = 0; j < 4; ++j) {
                    const float c0 = bf2f(cw[j] & 0xffff), c1 = bf2f(cw[j] >> 16);
                    v[2 * j] = c0 + mu[2 * j] * (0.5f * (bf2f(pw[j] & 0xffff) + bf2f(nw[j] & 0xffff)) - c0);
                    v[2 * j + 1] = c1 + mu[2 * j + 1] * (0.5f * (bf2f(pw[j] >> 16) + bf2f(nw[j] >> 16)) - c1);
                }
                if (it < 2) {
                    *(u32x4*)((bf16_t*)(p.ws + OFF_RS) + (size_t)row * 1024 + col) = mk4u(pk2(v[0], v[1]), pk2(v[2], v[3]), pk2(v[4], v[5]), pk2(v[6], v[7]));
                } else if (it < 4) {
                    const int kc = col - C_K;
                    *(u32x4*)((bf16_t*)(p.ws + OFF_KS) + (size_t)row * 1024 + kc) = mk4u(pk2(v[0], v[1]), pk2(v[2], v[3]), pk2(v[4], v[5]), pk2(v[6], v[7]));
                    const f32x4 k0 = *(const f32x4*)(p.k_k + kc), k1 = *(const f32x4*)(p.k_k + kc + 4);
                    const float kq[8] = {k0.x, k0.y, k0.z, k0.w, k1.x, k1.y, k1.z, k1.w};
                    float ss = 0.f;
#pragma unroll
                    for (int j = 0; j < 8; ++j) { v[j] *= kq[j]; ss += v[j] * v[j]; }
                    ss += __shfl_xor(ss, 1); ss += __shfl_xor(ss, 2); ss += __shfl_xor(ss, 4);
                    const float sc = rsqrtf(ss + 1e-12f);
                    *(u32x4*)((bf16_t*)(p.ws + OFF_KK) + (size_t)row * 1024 + kc) = mk4u(pk2(v[0] * sc, v[1] * sc), pk2(v[2] * sc, v[3] * sc), pk2(v[4] * sc, v[5] * sc), pk2(v[6] * sc, v[7] * sc));
                } else if (it < 6) {
                    *(u32x4*)((bf16_t*)(p.ws + OFF_VS) + (size_t)row * 1024 + col - C_V) = mk4u(pk2(v[0], v[1]), pk2(v[2], v[3]), pk2(v[4], v[5]), pk2(v[6], v[7]));
                } else if (ch < 396) {
#pragma unroll
                    for (int j = 0; j < 8; ++j) v[j] = tanhf(v[j]);
                    *(u32x4*)((bf16_t*)(p.ws + OFF_TW) + (size_t)row * 128 + col - C_XW) = mk4u(pk2(v[0], v[1]), pk2(v[2], v[3]), pk2(v[4], v[5]), pk2(v[6], v[7]));
                } else if (ch < 408) {
                    *(u32x4*)((bf16_t*)(p.ws + OFF_XA) + (size_t)row * 128 + col - C_XA) = mk4u(pk2(v[0], v[1]), pk2(v[2], v[3]), pk2(v[4], v[5]), pk2(v[6], v[7]));
                } else if (isx) {
#pragma unroll
                    for (int j = 0; j < 8; ++j) v[j] = sigmoidf_(v[j]);
                    *(u32x4*)((bf16_t*)(p.ws + OFF_SG) + (size_t)row * 256 + col - C_XG) = mk4u(pk2(v[0], v[1]), pk2(v[2], v[3]), pk2(v[4], v[5]), pk2(v[6], v[7]));
                }
            }
        }
        if (lane < 4) { *(u32x4*)((bf16_t*)(p.ws + OFF_TW) + (size_t)row * 128 + 96 + lane * 8) = mk4u(0, 0, 0, 0); *(u32x4*)((bf16_t*)(p.ws + OFF_XA) + (size_t)row * 128 + 96 + lane * 8) = mk4u(0, 0, 0, 0); }
    }
}

struct LoraSched {
    const char *A0, *B0, *A1, *B1; int G, c;
    __device__ __forceinline__ bool next(int i, pg8::Unit& u) const {
        const int per = (NR / 256) * 8; const long L = (long)i * G + c; if (L >= 2 * per) return false;
        const int job = (int)L / per, w = (int)L % per, pm = w >> 3, pn = w & 7;
        u.A = (job ? A1 : A0) + (size_t)pm * 256 * 128 * 2; u.B = (job ? B1 : B0) + (size_t)pn * 256 * 128 * 2; u.rowmap = nullptr; u.nvalid = 0; u.m0 = 0; u.row0 = pm * 256; u.col0 = pn * 256; u.pos0 = job;
        return true;
    }
};
struct FLORA { const float* dbias; const float* ibias; bf16_t* LWG; bf16_t* AIG; __device__ __forceinline__ void operator()(const pg8::Unit& u, int lr, int lc, f32x4 v0, f32x4 v1) const {
    const int row = u.row0 + lr, col = u.col0 + lc;
    const float* bp = (u.pos0 == 0 ? dbias : ibias) + col; const f32x4 b0 = *(const f32x4*)bp, b1 = *(const f32x4*)(bp + 4);
    const float sc = (u.pos0 == 0) ? -0.60653065971f : 1.f;
    float o[8];
#pragma unroll
    for (int e = 0; e < 4; ++e) { o[e] = sc * sigmoidf_(b0[e] + v0[e]); o[4 + e] = sc * sigmoidf_(b1[e] + v1[e]); }
    *(u32x4*)((u.pos0 == 0 ? LWG : AIG) + (size_t)row * 2048 + col) = mk4u(pk2(o[0], o[1]), pk2(o[2], o[3]), pk2(o[4], o[5]), pk2(o[6], o[7]));
} };
struct FGG { bf16_t* GG; __device__ __forceinline__ void operator()(const pg8::Unit& u, int lr, int lc, f32x4 v0, f32x4 v1) const {
    *(u32x4*)(GG + (size_t)(u.row0 + lr) * 1024 + u.col0 + lc) = mk4u(pk2(v0[0], v0[1]), pk2(v0[2], v0[3]), pk2(v1[0], v1[1]), pk2(v1[2], v1[3])); } };

__device__ __forceinline__ int inst_index(int b, int h, int d, int chunk) { return ((b * 16 + h) * 2 + d) * NCHUNK + chunk; }

constexpr int LA_K = 0  , LA_VT = 73728  , LA_END = LA_VT + 18 * 4608;
static_assert(LA_END <= SMEM_BYTES, "attention LDS map");

__device__ __forceinline__ void attn_unit(LDSP unsigned char* lds, const Params& p, int unit) {
    const int tid = opaque(threadIdx.x), wid = tid >> 6, lane = tid & 63;
    const int b = unit >> 8, kvh = (unit >> 6) & 3, qb = unit & 63, q0 = qb * 64;
    const bf16_t* PX = (const bf16_t*)(p.ws + OFF_PX);
    const float2* ROPE = (const float2*)(p.ws + OFF_ROPE);
    {
        u32x4 kx1[5], kx2[5];
#pragma unroll
        for (int it = 0; it < 5; ++it) {
            const int task = tid + 512 * it; kx1[it] = mk4u(0, 0, 0, 0); kx2[it] = mk4u(0, 0, 0, 0);
            if (task < 576 * 4) {
                const int key = task >> 2, pr = task & 3, c0 = (pr & 1) + 4 * (pr >> 1);
                const int pos = q0 - 128 + key;
                const bool lat = key < 320;
                if (!lat || (pos >= 0 && pos < T)) {
                    const bf16_t* src = PX + (size_t)(lat ? (b * T + pos) : (NX + b * CL + (key - 320))) * INP + C_AK + kvh * 64 + c0 * 8;
                    kx1[it] = *(const u32x4*)src; kx2[it] = *(const u32x4*)(src + 16);
                }
            }
        }
#pragma unroll
        for (int it = 0; it < 5; ++it) {
            const int task = tid + 512 * it;
            if (task < 576 * 4) {
                const int key = task >> 2, pr = task & 3, c0 = (pr & 1) + 4 * (pr >> 1);
                u32x4 w0 = kx1[it], w1 = kx2[it];
                if (key < 320) {
                    const int pos = q0 - 128 + key;
                    if (pos >= 0 && pos < T) {
                        const int ppos = (pr < 2) ? (pos >> 6) : (pos & 63);
                        const float2* tb = ROPE + ppos * 16 + (pr & 1) * 8;
                        const unsigned a1[4] = {w0.x, w0.y, w0.z, w0.w}, a2[4] = {w1.x, w1.y, w1.z, w1.w};
                        unsigned o1[4], o2[4];
#pragma unroll
                        for (int j = 0; j < 4; ++j) {
                            const float2 cs0 = tb[2 * j], cs1 = tb[2 * j + 1];
                            const float u0 = bf2f(a1[j] & 0xffff), u1 = bf2f(a1[j] >> 16), v0 = bf2f(a2[j] & 0xffff), v1 = bf2f(a2[j] >> 16);
                            o1[j] = pk2(u0 * cs0.x - v0 * cs0.y, u1 * cs1.x - v1 * cs1.y);
                            o2[j] = pk2(v0 * cs0.x + u0 * cs0.y, v1 * cs1.x + u1 * cs1.y);
                        }
                        w0 = mk4u(o1[0], o1[1], o1[2], o1[3]); w1 = mk4u(o2[0], o2[1], o2[2], o2[3]);
                    }
                }
                *(LDSP u32x4*)(lds + LA_K + sw64(key, c0 * 8)) = w0;
                *(LDSP u32x4*)(lds + LA_K + sw64(key, c0 * 8 + 16)) = w1;
            }
        }
    }
    {
        u32x4 vx[3][4];
#pragma unroll
        for (int it = 0; it < 3; ++it) {
            const int task = tid + 512 * it;
#pragma unroll
            for (int q = 0; q < 4; ++q) {
                vx[it][q] = mk4u(0, 0, 0, 0);
                if (task < 144 * 8) {
                    const int kg = task >> 3, dc = task & 7, key = kg * 4 + q;
                    if (key < 320) { const int pos = q0 - 128 + key; if (pos >= 0 && pos < T) vx[it][q] = *(const u32x4*)(PX + (size_t)(b * T + pos) * INP + C_AV + kvh * 64 + dc * 8); }
                    else vx[it][q] = *(const u32x4*)(PX + (size_t)(NX + b * CL + (key - 320)) * INP + C_AV + kvh * 64 + dc * 8);
                }
            }
        }
#pragma unroll
        for (int it = 0; it < 3; ++it) {
            const int task = tid + 512 * it;
            if (task < 144 * 8) {
                const int kg = task >> 3, dc = task & 7;
                unsigned short e[4][8];
#pragma unroll
                for (int q = 0; q < 4; ++q) { const u32x4 w = vx[it][q];
                    e[q][0] = w.x & 0xffff; e[q][1] = w.x >> 16; e[q][2] = w.y & 0xffff; e[q][3] = w.y >> 16; e[q][4] = w.z & 0xffff; e[q][5] = w.z >> 16; e[q][6] = w.w & 0xffff; e[q][7] = w.w >> 16; }
                const int tile = kg >> 3, kin = (kg & 7) * 4;
#pragma unroll
                for (int j = 0; j < 8; ++j) { u32x2 w; w.x = (unsigned)e[0][j] | ((unsigned)e[1][j] << 16); w.y = (unsigned)e[2][j] | ((unsigned)e[3][j] << 16);
                    *(LDSP u32x2*)(lds + LA_VT + tile * 4608 + (dc * 8 + j) * 72 + kin * 2) = w; }
            }
        }
    }
    const int hq = kvh * 4 + (wid >> 1), qs = (wid & 1) * 32, r = lane & 31, hh = lane >> 5;
    const int qpos = q0 + qs + r;
    bf16x8 qf[4];
    {
        const bf16_t* src = PX + (size_t)(b * T + qpos) * INP + C_Q + hq * 64 + 8 * hh;
        u32x4 raw[4];
#pragma unroll
        for (int s = 0; s < 4; ++s) raw[s] = *(const u32x4*)(src + 16 * s);
#pragma unroll
        for (int pr = 0; pr < 2; ++pr) {
            const int ppos = pr == 0 ? (qpos >> 6) : (qpos & 63);
            const float2* tb = ROPE + ppos * 16 + 8 * hh;
            const unsigned a1[4] = {raw[2 * pr].x, raw[2 * pr].y, raw[2 * pr].z, raw[2 * pr].w}, a2[4] = {raw[2 * pr + 1].x, raw[2 * pr + 1].y, raw[2 * pr + 1].z, raw[2 * pr + 1].w};
            unsigned o1[4], o2[4];
#pragma unroll
            for (int j = 0; j < 4; ++j) {
                const float2 cs0 = tb[2 * j], cs1 = tb[2 * j + 1];
                const float u0 = bf2f(a1[j] & 0xffff), u1 = bf2f(a1[j] >> 16), v0 = bf2f(a2[j] & 0xffff), v1 = bf2f(a2[j] >> 16);
                o1[j] = pk2(0.125f * (u0 * cs0.x - v0 * cs0.y), 0.125f * (u1 * cs1.x - v1 * cs1.y));
                o2[j] = pk2(0.125f * (v0 * cs0.x + u0 * cs0.y), 0.125f * (v1 * cs1.x + u1 * cs1.y));
            }
            const u32x4 w1 = mk4u(o1[0], o1[1], o1[2], o1[3]), w2 = mk4u(o2[0], o2[1], o2[2], o2[3]);
            qf[2 * pr] = __builtin_bit_cast(bf16x8, w1); qf[2 * pr + 1] = __builtin_bit_cast(bf16x8, w2);
        }
    }
    __syncthreads();
    float m = p.attn_sink[hq], l = 1.f;
    f32x16 o0 = zero16(), o1 = zero16();
    for (int tl = 0; tl < 18; ++tl) {
        f32x16 st = zero16();
#pragma unroll
        for (int s = 0; s < 4; ++s) {
            const bf16x8 kf = *(const LDSP bf16x8*)(lds + LA_K + sw64(32 * tl + r, 16 * s + 8 * hh));
            st = __builtin_amdgcn_mfma_f32_32x32x16_bf16(kf, qf[s], st, 0, 0, 0);
        }
        const int kp0 = q0 - 128 + 32 * tl, qlo = q0 + qs;
        if (tl < 10 && (qlo + 31 - kp0 > 128 || qlo - (kp0 + 31) < -128 || kp0 < 0 || kp0 + 31 >= T)) {
#pragma unroll
            for (int g = 0; g < 16; ++g) { const int kp = q0 - 128 + 32 * tl + crow(g, hh); const int dlt = qpos - kp;
                const bool ok = (dlt <= 128) && (dlt >= -128) && (kp >= 0) && (kp < T); st[g] = ok ? st[g] : -1e30f; }
        }
        float mt = st[0];
#pragma unroll
        for (int g = 1; g < 16; ++g) mt = fmaxf(mt, st[g]);
        mt = fmaxf(mt, __shfl_xor(mt, 32));
        const float mn = fmaxf(m, mt), alpha = __expf(m - mn);
        float ps = 0.f;
#pragma unroll
        for (int g = 0; g < 16; ++g) { st[g] = __expf(st[g] - mn); ps += st[g]; }
        ps += __shfl_xor(ps, 32);
        l = l * alpha + ps; m = mn;
        if (__any(alpha != 1.f)) {
#pragma unroll
            for (int g = 0; g < 16; ++g) { o0[g] *= alpha; o1[g] *= alpha; }
        }
#pragma unroll
        for (int s2 = 0; s2 < 2; ++s2) {
            const u32x4 pw = mk4u(pk2(st[8 * s2], st[8 * s2 + 1]), pk2(st[8 * s2 + 2], st[8 * s2 + 3]), pk2(st[8 * s2 + 4], st[8 * s2 + 5]), pk2(st[8 * s2 + 6], st[8 * s2 + 7]));
            const bf16x8 pf = __builtin_bit_cast(bf16x8, pw);
#pragma unroll
            for (int dm = 0; dm < 2; ++dm) {
                const LDSP unsigned char* vp = lds + LA_VT + tl * 4608 + (32 * dm + r) * 72 + (16 * s2 + 4 * hh) * 2;
                const u32x2 v0 = *(const LDSP u32x2*)vp, v1 = *(const LDSP u32x2*)(vp + 16);
                const bf16x8 vf = __builtin_bit_cast(bf16x8, mk4u(v0.x, v0.y, v1.x, v1.y));
                if (dm == 0) o0 = __builtin_amdgcn_mfma_f32_32x32x16_bf16(vf, pf, o0, 0, 0, 0); else o1 = __builtin_amdgcn_mfma_f32_32x32x16_bf16(vf, pf, o1, 0, 0, 0);
            }
        }
    }
    {
        const float inv = 1.f / l;
        bf16_t* dst = (bf16_t*)(p.ws + OFF_MIX) + (size_t)(b * T + qpos) * D + 1024 + hq * 64;
#pragma unroll
        for (int gq = 0; gq < 4; ++gq) {
            u32x2 w; w.x = pk2(o0[4 * gq] * inv, o0[4 * gq + 1] * inv); w.y = pk2(o0[4 * gq + 2] * inv, o0[4 * gq + 3] * inv); *(u32x2*)(dst + 8 * gq + 4 * hh) = w;
            u32x2 w2; w2.x = pk2(o1[4 * gq] * inv, o1[4 * gq + 1] * inv); w2.y = pk2(o1[4 * gq + 2] * inv, o1[4 * gq + 3] * inv); *(u32x2*)(dst + 32 + 8 * gq + 4 * hh) = w2;
        }
    }
    __syncthreads();
}

__device__ __forceinline__ void phaseR2(LDSP unsigned char* lds, const Params& p) {
    {
        pg8::Epi<FLORA> epi{FLORA{p.decay_bias, p.iclr_bias, (bf16_t*)(p.ws + OFF_LWG), (bf16_t*)(p.ws + OFF_AIG)}};
        LoraSched S{(const char*)(p.ws + OFF_TW), (const char*)(p.ws + OFF_WTDU), (const char*)(p.ws + OFF_XA), (const char*)(p.ws + OFF_WTIU), (int)gridDim.x, (int)blockIdx.x};
        pg8::gemm_phase<false>(lds, opaque_s(128), S, epi);
    }
    {
        pg8::Epi<FGG> epi{FGG{(bf16_t*)(p.ws + OFF_GG)}};
        pg8::DenseSched S{(const char*)(p.ws + OFF_SG), (const char*)(p.ws + OFF_WTGU), NX / 256, 1024 / 256, 256, (int)gridDim.x, (int)(gridDim.x - 1 - blockIdx.x)};
        pg8::gemm_phase<false>(lds, opaque_s(256), S, epi);
    }
}

constexpr int G_RT = 0, G_VT = 8192, G_X0 = 16384, G_AT = 32768, G_BT = 40960, G_KT = 49152, G_P0 = 57344, G_PT0 = 65536, G_SEG = 73728, G_GL = 74752, G_CNT = 75008, G_BYTES = 79872;
static_assert(2 * G_BYTES <= SMEM_BYTES - 16, "two R3 groups fit the LDS");

__device__ __forceinline__ void gbar(LDSP unsigned* cnt, unsigned& target, int lane) {
    target += 4u;
    asm volatile("s_waitcnt lgkmcnt(0)" ::: "memory");
    if (lane == 0) {
        __hip_atomic_fetch_add(cnt, 1u, __ATOMIC_RELAXED, __HIP_MEMORY_SCOPE_WORKGROUP);
        while (__hip_atomic_load(cnt, __ATOMIC_RELAXED, __HIP_MEMORY_SCOPE_WORKGROUP) < target) __builtin_amdgcn_s_sleep(1);
    }
    asm volatile("" ::: "memory");
}
__device__ __forceinline__ void mask_lt(f32x16& c, int x0, int y, int hh, bool incl) {
#pragma unroll
    for (int g = 0; g < 16; ++g) { const int x = x0 + crow(g, hh); c[g] = (incl ? (x <= y) : (x < y)) ? c[g] : 0.f; }
}

#if defined(__HIP_DEVICE_COMPILE__)
#define LDS_AT(T, addr) (__builtin_bit_cast(LDSP T*, (unsigned)(addr)))
#define LDS_ADDR(ptr) (__builtin_bit_cast(unsigned, (ptr)))
#else
#define LDS_AT(T, addr) ((LDSP T*)(size_t)(addr))
#define LDS_ADDR(ptr) ((unsigned)(size_t)(ptr))
#endif
__device__ __forceinline__ void ldf(const unsigned (&FO)[4], unsigned off, bf16x8 (&f)[4]) {
#pragma unroll
    for (int s = 0; s < 4; ++s) f[s] = *LDS_AT(const bf16x8, FO[s] + off);
}
__device__ __forceinline__ void stt(const unsigned (&SO)[4], unsigned off, int xh, const f32x16& acc) {
#pragma unroll
    for (int gq = 0; gq < 4; ++gq) *LDS_AT(u32x2, (SO[gq] ^ ((unsigned)xh << 6)) + off) = mk2u(pk2(acc[4 * gq], acc[4 * gq + 1]), pk2(acc[4 * gq + 2], acc[4 * gq + 3]));
}
__device__ __forceinline__ u32x2 ld8(const unsigned (&SO)[4], int gq, unsigned off, int xh) { return *LDS_AT(const u32x2, (SO[gq] ^ ((unsigned)xh << 6)) + off); }

__device__ __forceinline__ void rwkv_prep_group(LDSP unsigned char* lg, LDSP unsigned* cnt, unsigned& bt, const Params& p, int unit, int wg_in, int lane_in, const unsigned (&FO)[4], const unsigned (&SO)[4]) {
    int seq, c, h, d;
    if (unit < 4096) { seq = unit >> 11; c = (unit >> 5) & 63; h = (unit >> 1) & 15; d = unit & 1; } else { const int u = unit - 4096; seq = 2 + (u >> 7); c = (u >> 5) & 3; h = (u >> 1) & 15; d = u & 1; }
    const bool isx = seq < 2;
    const int b = seq & 1;
    const int s0 = isx ? b * T : NX + b * CL, t0 = c * 64;
    const int chunk_id = isx ? 4 + c : c;
    u32x4 keep_bh[2], keep_kh[2];
#define STAGE_IDS const int lane = opaque(lane_in), wg = opaque(wg_in), r = lane & 31, hh = lane >> 5; (void)r; (void)hh; (void)wg;
    {
        STAGE_IDS
        const int k = lane, seg = wg, hk = h * 64 + k;
        const float kac = p.k_a[hk];
        const bf16_t* RS = (const bf16_t*)(p.ws + OFF_RS); const bf16_t* KS = (const bf16_t*)(p.ws + OFF_KS); const bf16_t* KKp = (const bf16_t*)(p.ws + OFF_KK); const bf16_t* VS = (const bf16_t*)(p.ws + OFF_VS);
        const bf16_t* LWG = (const bf16_t*)(p.ws + OFF_LWG); const bf16_t* AIG = (const bf16_t*)(p.ws + OFF_AIG);
        const int ibase = seg * 16;
        const int rowA = (s0 + t0) + (d ? 63 - ibase : ibase);
        const int sgn = d ? -1 : 1;
        const unsigned o1 = ((unsigned)rowA * 1024u + (unsigned)hk) * 2u, o2 = ((unsigned)rowA * 2048u + (unsigned)(d * 1024 + hk)) * 2u;
        const int st1 = sgn * 2048, st2 = sgn * 4096;
#define LD16(base, off) bf2f(*(const bf16_t*)((const char*)(base) + (unsigned)(off)))
        float lw[16];
        float run = 0.f;
#pragma unroll
        for (int tt = 0; tt < 16; ++tt) { run += LD16(LWG, o2 + tt * st2); lw[tt] = run; }
        LDSP float* SEG = (LDSP float*)(lg + G_SEG);
        SEG[seg * 64 + k] = run;
        gbar(cnt, bt, lane);
        float off = 0.f, gL = 0.f;
#pragma unroll
        for (int s = 0; s < 4; ++s) { const float sv = SEG[s * 64 + k]; if (s < seg) off += sv; gL += sv; }
        if (seg == 0) ((LDSP float*)(lg + G_GL))[k] = gL;
        const float egL = __expf(gL);
#pragma unroll
        for (int q = 0; q < 2; ++q) {
            float rr[8], kr[8], kk[8], vv[8], ai[8];
#pragma unroll
            for (int e = 0; e < 8; ++e) { const int tt = 8 * q + e;
                rr[e] = LD16(RS, o1 + tt * st1); kr[e] = LD16(KS, o1 + tt * st1); kk[e] = LD16(KKp, o1 + tt * st1); vv[e] = LD16(VS, o1 + tt * st1); ai[e] = LD16(AIG, o2 + tt * st2); }
            unsigned wat[4], wbh[4], wkh[4], wv[4];
#pragma unroll
            for (int t2 = 0; t2 < 4; ++t2) {
                const int i0 = ibase + 8 * q + 2 * t2;
                float fat[2], frt[2], fbt[2], fkt[2], fbh[2], fkh[2];
#pragma unroll
                for (int e2 = 0; e2 < 2; ++e2) { const int e = 2 * t2 + e2, tt = 8 * q + e;
                    const float kd = kr[e] * (1.f + (ai[e] - 1.f) * kac), bbv = kk[e] * ai[e];
                    const float g = off + lw[tt], ge = (tt == 0) ? off : off + lw[tt - 1];
                    const float eg = __expf(g), ege = __expf(ge), eng = __builtin_amdgcn_rcpf(eg), egl = egL * eng;
                    fat[e2] = -kk[e] * ege; frt[e2] = rr[e] * eg; fbt[e2] = bbv * eng; fkt[e2] = kd * eng; fbh[e2] = bbv * egl; fkh[e2] = kd * egl; }
                wat[t2] = pk2(fat[0], fat[1]); wbh[t2] = pk2(fbh[0], fbh[1]); wkh[t2] = pk2(fkh[0], fkh[1]); wv[t2] = pk2(vv[2 * t2], vv[2 * t2 + 1]);
                const unsigned wr = pk2(frt[0], frt[1]), wb = pk2(fbt[0], fbt[1]), wk = pk2(fkt[0], fkt[1]);
                *(LDSP bf16_t*)(lg + G_AT + sw64(i0, k)) = (bf16_t)(wat[t2] & 0xffffu); *(LDSP bf16_t*)(lg + G_AT + sw64(i0 + 1, k)) = (bf16_t)(wat[t2] >> 16);
                *(LDSP bf16_t*)(lg + G_RT + sw64(i0, k)) = (bf16_t)(wr & 0xffffu);      *(LDSP bf16_t*)(lg + G_RT + sw64(i0 + 1, k)) = (bf16_t)(wr >> 16);
                *(LDSP bf16_t*)(lg + G_BT + sw64(i0, k)) = (bf16_t)(wb & 0xffffu);      *(LDSP bf16_t*)(lg + G_BT + sw64(i0 + 1, k)) = (bf16_t)(wb >> 16);
                *(LDSP bf16_t*)(lg + G_KT + sw64(i0, k)) = (bf16_t)(wk & 0xffffu);      *(LDSP bf16_t*)(lg + G_KT + sw64(i0 + 1, k)) = (bf16_t)(wk >> 16);
            }
            *(LDSP u32x4*)(lg + G_X0 + sw64(k, ibase + 8 * q)) = mk4u(wat[0], wat[1], wat[2], wat[3]);
            *(LDSP u32x4*)(lg + G_VT + sw64(k, ibase + 8 * q)) = mk4u(wv[0], wv[1], wv[2], wv[3]);
            keep_bh[q] = mk4u(wbh[0], wbh[1], wbh[2], wbh[3]); keep_kh[q] = mk4u(wkh[0], wkh[1], wkh[2], wkh[3]);
            __builtin_amdgcn_sched_barrier(0);
        }
#undef LD16
    }
    gbar(cnt, bt, lane_in);
    {
        STAGE_IDS
        const int a = wg >> 1, bq = wg & 1;
        f32x16 c1 = zero16(), c2 = zero16();
        if (a <= bq) {
            bf16x8 fB[4], fA[4]; ldf(FO, G_BT + 4096 * a, fB); ldf(FO, G_AT + 4096 * bq, fA);
#pragma unroll
            for (int t = 0; t < 4; ++t) { c1 = __builtin_amdgcn_mfma_f32_32x32x16_bf16(fB[t], fA[t], c1, 0, 0, 0); c2 = __builtin_amdgcn_mfma_f32_32x32x16_bf16(fA[t], fB[t], c2, 0, 0, 0); }
            if (a == bq) {
                mask_lt(c1, 32 * a, 32 * bq + r, hh, false);
#pragma unroll
                for (int g = 0; g < 16; ++g) { const int x = 32 * bq + crow(g, hh); c2[g] = (32 * a + r < x) ? c2[g] : 0.f; }
            }
        }
        stt(SO, G_P0 + 4096 * bq, a, c1);
        stt(SO, G_PT0 + 4096 * a, bq, c2);
        const int ib = wg >> 1, vb = wg & 1;
        f32x16 z = zero16();
#pragma unroll
        for (int jb = 0; jb < 2; ++jb) if (jb <= ib) {
            bf16x8 fK[4], fA[4]; ldf(FO, G_KT + 4096 * jb, fK); ldf(FO, G_AT + 4096 * ib, fA);
            f32x16 t = zero16();
#pragma unroll
            for (int s = 0; s < 4; ++s) t = __builtin_amdgcn_mfma_f32_32x32x16_bf16(fK[s], fA[s], t, 0, 0, 0);
            if (jb == ib) mask_lt(t, 32 * jb, 32 * ib + r, hh, false);
#pragma unroll
            for (int s2 = 0; s2 < 2; ++s2) {
                const bf16x8 af = __builtin_bit_cast(bf16x8, mk4u(pk2(t[8 * s2], t[8 * s2 + 1]), pk2(t[8 * s2 + 2], t[8 * s2 + 3]), pk2(t[8 * s2 + 4], t[8 * s2 + 5]), pk2(t[8 * s2 + 6], t[8 * s2 + 7])));
                const u32x2 v0 = ld8(SO, 2 * s2, G_VT + 4096 * vb, jb), v1 = ld8(SO, 2 * s2 + 1, G_VT + 4096 * vb, jb);
                const bf16x8 bv = __builtin_bit_cast(bf16x8, mk4u(v0.x, v0.y, v1.x, v1.y));
                z = __builtin_amdgcn_mfma_f32_32x32x16_bf16(af, bv, z, 0, 0, 0);
            }
        }
        stt(SO, G_X0 + 128 * 64 + 4096 * vb, ib, z);
    }
    gbar(cnt, bt, lane_in);
#pragma unroll 1
    for (int s = 0; s < 6; ++s) {
        STAGE_IDS
        const int cb = wg, a = wg >> 1, bq = wg & 1;
        bf16x8 xf[4], p0[4], p1[4];
        ldf(FO, G_X0 + 4096 * cb, xf); ldf(FO, G_P0, p0); ldf(FO, G_P0 + 4096, p1);
        f32x16 acc0, acc1;
#pragma unroll
        for (int gq = 0; gq < 4; ++gq) { const u32x2 w0 = ld8(SO, gq, G_X0 + 4096 * cb, 0), w1 = ld8(SO, gq, G_X0 + 4096 * cb, 1);
            acc0[4 * gq] = bf2f(w0.x & 0xffff); acc0[4 * gq + 1] = bf2f(w0.x >> 16); acc0[4 * gq + 2] = bf2f(w0.y & 0xffff); acc0[4 * gq + 3] = bf2f(w0.y >> 16);
            acc1[4 * gq] = bf2f(w1.x & 0xffff); acc1[4 * gq + 1] = bf2f(w1.x >> 16); acc1[4 * gq + 2] = bf2f(w1.y & 0xffff); acc1[4 * gq + 3] = bf2f(w1.y >> 16); }
        f32x16 z = zero16(), zt = zero16();
        const bool sq = (s < 5) && (a <= bq);
        bf16x8 fa[4], fb[4];
        if (sq) { ldf(FO, G_PT0 + 4096 * a, fa); ldf(FO, G_P0 + 4096 * bq, fb); }
#pragma unroll
        for (int t = 0; t < 4; ++t) { if (t < 2) acc0 = __builtin_amdgcn_mfma_f32_32x32x16_bf16(p0[t], xf[t], acc0, 0, 0, 0); acc1 = __builtin_amdgcn_mfma_f32_32x32x16_bf16(p1[t], xf[t], acc1, 0, 0, 0); }
        if (sq) { const int t0 = (a == 1) ? 2 : 0, t1 = (bq == 0) ? 2 : 4;
#pragma unroll
            for (int t = 0; t < 4; ++t) if (t >= t0 && t < t1) { z = __builtin_amdgcn_mfma_f32_32x32x16_bf16(fa[t], fb[t], z, 0, 0, 0); zt = __builtin_amdgcn_mfma_f32_32x32x16_bf16(fb[t], fa[t], zt, 0, 0, 0); } }
        stt(SO, G_X0 + 4096 * cb, 0, acc0); stt(SO, G_X0 + 4096 * cb, 1, acc1);
        if (s < 5) {
            gbar(cnt, bt, lane);
            stt(SO, G_P0 + 4096 * bq, a, z); stt(SO, G_PT0 + 4096 * a, bq, zt);
        }
        gbar(cnt, bt, lane);
    }
    {
        STAGE_IDS
        const int jb = wg >> 1, ib = wg & 1;
        f32x16 c1 = zero16(), c2 = zero16();
        if (jb <= ib) {
            bf16x8 fR[4], fB[4], fK[4]; ldf(FO, G_RT + 4096 * ib, fR); ldf(FO, G_BT + 4096 * jb, fB); ldf(FO, G_KT + 4096 * jb, fK);
#pragma unroll
            for (int t = 0; t < 4; ++t) { c1 = __builtin_amdgcn_mfma_f32_32x32x16_bf16(fB[t], fR[t], c1, 0, 0, 0); c2 = __builtin_amdgcn_mfma_f32_32x32x16_bf16(fK[t], fR[t], c2, 0, 0, 0); }
            if (jb == ib) { mask_lt(c1, 32 * jb, 32 * ib + r, hh, true); mask_lt(c2, 32 * jb, 32 * ib + r, hh, true); }
        }
        stt(SO, G_P0 + 4096 * ib, jb, c1); stt(SO, G_PT0 + 4096 * ib, jb, c2);
    }
    gbar(cnt, bt, lane_in);
    {
        STAGE_IDS
#pragma unroll
        for (int q = 0; q < 2; ++q) { *(LDSP u32x4*)(lg + G_BT + sw64(lane, wg * 16 + 8 * q)) = keep_bh[q]; *(LDSP u32x4*)(lg + G_KT + sw64(lane, wg * 16 + 8 * q)) = keep_kh[q]; }
    }
    gbar(cnt, bt, lane_in);
    {
        STAGE_IDS
        const int mi = wg;
        const int L_BH = G_BT, L_KH = G_KT, L_RB = G_P0, L_RK = G_PT0;
        const size_t inst = (size_t)inst_index(b, h, d, chunk_id) * 4096;
        bf16_t* dst = (bf16_t*)(p.ws + (mi == 0 ? OFF_CM : mi == 1 ? OFF_CN : mi == 2 ? OFF_CP : OFF_CQ)) + inst;
        if (isx || mi < 2) {
            const int Ax = (mi == 1) ? L_BH : G_X0, Ax0 = (mi == 3) ? 64 : 0;
            const int By = (mi == 0) ? L_BH : (mi == 1) ? G_X0 : L_RB, By0 = (mi == 1) ? 64 : 0;
            const int A2 = (mi == 1) ? L_KH : G_VT, B2 = (mi == 1) ? G_VT : L_RK;
#pragma unroll 1
            for (int half = 0; half < 2; ++half) {
                bf16x8 a0[4], a1[4], b1[4];
                ldf(FO, Ax + 128 * Ax0, a0); ldf(FO, Ax + 128 * (Ax0 + 32), a1); ldf(FO, By + 128 * (By0 + 32 * half), b1);
                f32x16 c0 = zero16(), c1 = zero16();
#pragma unroll
                for (int t = 0; t < 4; ++t) { c0 = __builtin_amdgcn_mfma_f32_32x32x16_bf16(a0[t], b1[t], c0, 0, 0, 0); c1 = __builtin_amdgcn_mfma_f32_32x32x16_bf16(a1[t], b1[t], c1, 0, 0, 0); }
                if (mi & 1) {
                    ldf(FO, A2, a0); ldf(FO, A2 + 4096, a1); ldf(FO, B2 + 4096 * half, b1);
#pragma unroll
                    for (int t = 0; t < 4; ++t) { c0 = __builtin_amdgcn_mfma_f32_32x32x16_bf16(a0[t], b1[t], c0, 0, 0, 0); c1 = __builtin_amdgcn_mfma_f32_32x32x16_bf16(a1[t], b1[t], c1, 0, 0, 0); }
                }
                const int y = 32 * half + r;
                const float dg = (mi == 0) ? __expf(((const LDSP float*)(lg + G_GL))[y]) : 0.f;
#pragma unroll
                for (int xb = 0; xb < 2; ++xb) {
#pragma unroll
                    for (int gq = 0; gq < 4; ++gq) {
                        const int x0 = 32 * xb + 8 * gq + 4 * hh;
                        float v0 = xb ? c1[4 * gq] : c0[4 * gq], v1 = xb ? c1[4 * gq + 1] : c0[4 * gq + 1], v2 = xb ? c1[4 * gq + 2] : c0[4 * gq + 2], v3 = xb ? c1[4 * gq + 3] : c0[4 * gq + 3];
                        if (mi == 0) { if (x0 == y) v0 += dg; if (x0 + 1 == y) v1 += dg; if (x0 + 2 == y) v2 += dg; if (x0 + 3 == y) v3 += dg; }
                        if (mi == 2) { const u32x2 w = ld8(SO, gq, G_RT + 4096 * half, xb); v0 += bf2f(w.x & 0xffff); v1 += bf2f(w.x >> 16); v2 += bf2f(w.y & 0xffff); v3 += bf2f(w.y >> 16); }
                        *(u32x2*)(dst + ((half * 4 + 2 * xb + (gq >> 1)) * 64 + hh * 32 + r) * 8 + 4 * (gq & 1)) = mk2u(pk2(v0, v1), pk2(v2, v3));
                    }
                }
            }
        }
    }
    gbar(cnt, bt, lane_in);
#undef STAGE_IDS
}

__device__ __forceinline__ void conv_tile_group(LDSP unsigned char* lg, LDSP unsigned* cnt, unsigned& bt, const Params& p, int g, int tg, int lane) {
    const float* src = nullptr; bf16_t* dst = nullptr; int N = 0, ld = 0, mode = 0, k0 = 0, n0 = 0;
    conv_decode(p, g, src, dst, N, ld, mode, k0, n0);
    LDSP float* Tm = (LDSP float*)lg;
    {
        const int kr = tg >> 3, nc = (tg & 7) * 8;
        f32x4 v[8][2];
#pragma unroll
        for (int s = 0; s < 8; ++s) { const float* q = src + (size_t)(k0 + s * 32 + kr) * N + n0 + nc; v[s][0] = *(const f32x4*)q; v[s][1] = *(const f32x4*)(q + 4); }
#pragma unroll
        for (int s = 0; s < 8; ++s) { LDSP float* q = Tm + (s * 32 + kr) * 65 + nc;
            q[0] = v[s][0].x; q[1] = v[s][0].y; q[2] = v[s][0].z; q[3] = v[s][0].w; q[4] = v[s][1].x; q[5] = v[s][1].y; q[6] = v[s][1].z; q[7] = v[s][1].w; }
    }
    gbar(cnt, bt, lane);
    {
        const int n = tg >> 2; unsigned char* drow = (unsigned char*)dst + (size_t)conv_row(n0 + n, mode & 3) * ld;
        if (mode & 4) {
            const float sc = (mode & 3) ? W1_SCALE : W2_SCALE;
#pragma unroll
            for (int s = 0; s < 4; ++s) { const int kc = ((tg & 3) + 4 * s) * 16; float f[16];
#pragma unroll
                for (int j = 0; j < 16; ++j) f[j] = Tm[(kc + j) * 65 + n] * sc;
                *(u32x4*)(drow + k0 + kc) = mk4u(pk4_fp8(f[0], f[1], f[2], f[3]), pk4_fp8(f[4], f[5], f[6], f[7]), pk4_fp8(f[8], f[9], f[10], f[11]), pk4_fp8(f[12], f[13], f[14], f[15])); }
        } else {
#pragma unroll
            for (int s = 0; s < 8; ++s) { const int kc = ((tg & 3) + 4 * s) * 8; float f[8];
#pragma unroll
                for (int j = 0; j < 8; ++j) f[j] = Tm[(kc + j) * 65 + n];
                *(u32x4*)(drow + 2 * (k0 + kc)) = mk4u(pk2(f[0], f[1]), pk2(f[2], f[3]), pk2(f[4], f[5]), pk2(f[6], f[7])); }
        }
    }
    gbar(cnt, bt, lane);
}

__device__ __forceinline__ void phaseR3(LDSP unsigned char* lds, const Params& p) {
    const int tid = opaque(threadIdx.x), wid = tid >> 6, lane = tid & 63, gp = wid >> 2, wg = wid & 3;
    LDSP unsigned char* lg = lds + gp * G_BYTES;
    LDSP unsigned* cnt = (LDSP unsigned*)(lg + G_CNT);
    LDSP unsigned* uq = (LDSP unsigned*)(lds + SMEM_BYTES - 48);
    LDSP unsigned* pick = (LDSP unsigned*)(lg + G_CNT + 8);
    if ((tid & 255) == 0) *cnt = 0u;
    if (tid == 0) *uq = 0u;
    __syncthreads();
    unsigned bt = 0u;
    if (gp == 1) for (int g = CT1 + blockIdx.x; g < CT8; g += gridDim.x) conv_tile_group(lg, cnt, bt, p, g, tid & 255, lane);
    unsigned FO[4], SO[4];
    { const unsigned base = LDS_ADDR(lg), r = lane & 31, hh = lane >> 5;
#pragma unroll
      for (int q = 0; q < 4; ++q) { FO[q] = base + r * 128u + ((((2u * q + hh) ^ (r >> 1)) & 7u) << 4); SO[q] = base + r * 128u + ((((unsigned)q ^ (r >> 1)) & 7u) << 4) + 8u * hh; } }
    for (;;) {
        if ((tid & 255) == 0) *pick = __hip_atomic_fetch_add(uq, 1u, __ATOMIC_RELAXED, __HIP_MEMORY_SCOPE_WORKGROUP);
        gbar(cnt, bt, lane);
        const int u = blockIdx.x + (int)(*pick) * gridDim.x;
        gbar(cnt, bt, lane);
        if (u >= 4096 + 256) break;
        rwkv_prep_group(lg, cnt, bt, p, u, wg, lane, FO, SO);
    }
    __syncthreads();
}

constexpr size_t OFF_HT = OFF_YD;
__device__ __forceinline__ void scan_wave(const Params& p, int item, int lane) {
    const int chain = item >> 1, vb = item & 1, b = chain >> 5, h = (chain >> 1) & 15, d = chain & 1;
    const bf16_t* CM = (const bf16_t*)(p.ws + OFF_CM); const bf16_t* CN = (const bf16_t*)(p.ws + OFF_CN); bf16_t* HT = (bf16_t*)(p.ws + OFF_HT);
    u32x4 na[2][4], nn[2][2];
    auto chunk_of = [&](int step) { return (step < 4) ? (d ? 3 - step : step) : (d ? 4 + (67 - step) : step); };
    auto prefetch = [&](int step) {
        const size_t inst = (size_t)inst_index(b, h, d, chunk_of(step)) * 4096;
#pragma unroll
        for (int rt = 0; rt < 2; ++rt) {
#pragma unroll
            for (int s = 0; s < 4; ++s) na[rt][s] = *(const u32x4*)(CM + inst + ((rt * 4 + s) * 64 + lane) * 8);
#pragma unroll
            for (int g2 = 0; g2 < 2; ++g2) nn[rt][g2] = *(const u32x4*)(CN + inst + (((vb * 2 + rt) * 2 + g2) * 64 + lane) * 8);
        }
    };
    f32x16 hacc[2]; hacc[0] = zero16(); hacc[1] = zero16();
    prefetch(0);
#pragma unroll 1
    for (int step = 0; step < NCHUNK; ++step) {
        const int chunk_id = chunk_of(step);
        u32x4 a[2][4], n[2][2];
#pragma unroll
        for (int rt = 0; rt < 2; ++rt) {
#pragma unroll
            for (int s = 0; s < 4; ++s) a[rt][s] = na[rt][s];
            n[rt][0] = nn[rt][0]; n[rt][1] = nn[rt][1];
        }
        if (step + 1 < NCHUNK) prefetch(step + 1);
        bf16x8 bfr[4];
#pragma unroll
        for (int s = 0; s < 4; ++s) { const f32x16& t = hacc[s >> 1]; const int o = 8 * (s & 1);
            bfr[s] = __builtin_bit_cast(bf16x8, mk4u(pk2(t[o], t[o + 1]), pk2(t[o + 2], t[o + 3]), pk2(t[o + 4], t[o + 5]), pk2(t[o + 6], t[o + 7]))); }
        if (chunk_id >= 4) {
            bf16_t* hp = HT + (size_t)inst_index(b, h, d, chunk_id) * 4096 + (vb * 4 * 64 + lane) * 8;
#pragma unroll
            for (int s = 0; s < 4; ++s) *(bf16x8*)(hp + s * 512) = bfr[s];
        }
#pragma unroll
        for (int rt = 0; rt < 2; ++rt) {
            f32x16 acc;
#pragma unroll
            for (int g2 = 0; g2 < 2; ++g2) { const u32x4 w = n[rt][g2];
                acc[8 * g2] = bf2f(w.x & 0xffff); acc[8 * g2 + 1] = bf2f(w.x >> 16); acc[8 * g2 + 2] = bf2f(w.y & 0xffff); acc[8 * g2 + 3] = bf2f(w.y >> 16);
                acc[8 * g2 + 4] = bf2f(w.z & 0xffff); acc[8 * g2 + 5] = bf2f(w.z >> 16); acc[8 * g2 + 6] = bf2f(w.w & 0xffff); acc[8 * g2 + 7] = bf2f(w.w >> 16); }
#pragma unroll
            for (int s = 0; s < 4; ++s) acc = __builtin_amdgcn_mfma_f32_32x32x16_bf16(__builtin_bit_cast(bf16x8, a[rt][s]), bfr[s], acc, 0, 0, 0);
            hacc[rt] = acc;
        }
    }
}
__device__ __forceinline__ void phaseR4(LDSP unsigned char* lds, const Params& p) {
    const int tid = opaque(threadIdx.x), wid = tid >> 6, lane = tid & 63;
    LDSP int* nxt = (LDSP int*)(lds + SMEM_BYTES - 32);
    unsigned* qctr = (unsigned*)(p.ws + OFF_CTL + 16384 + 512);
    if ((int)blockIdx.x < 64 && gridDim.x >= 128) { if (wid < 2) scan_wave(p, blockIdx.x * 2 + wid, lane); }
    else if (gridDim.x < 128) { if (wid == 0) for (int it = blockIdx.x; it < 128; it += gridDim.x) scan_wave(p, it, lane); }
    for (;;) {
        __syncthreads();
        if (tid == 0) *nxt = (int)atomicAdd(qctr, 1u);
        __syncthreads();
        const int u = *nxt;
        if (u >= 512) break;
        attn_unit(lds, p, u);
    }
}

__device__ __forceinline__ void phaseR5(LDSP unsigned char* lds, const Params& p) {
    const int tid = opaque(threadIdx.x), wid = tid >> 6, lane = tid & 63, r = lane & 31, hh = lane >> 5;
    const bf16_t* CP = (const bf16_t*)(p.ws + OFF_CP); const bf16_t* CQ = (const bf16_t*)(p.ws + OFF_CQ); const bf16_t* HT = (const bf16_t*)(p.ws + OFF_HT);
    for (int wu = blockIdx.x * 8 + wid; wu < 2 * 64 * 16 * 2; wu += gridDim.x * 8) {
        const int half = wu & 1, u = wu >> 1, b = u >> 10, c = (u >> 4) & 63, h = u & 15;
        f32x16 y0 = zero16(), y1 = zero16();
#pragma unroll
        for (int d = 0; d < 2; ++d) {
            const size_t inst = (size_t)inst_index(b, h, d, 4 + c) * 4096;
            const int ii = d ? 63 - (32 * half + r) : (32 * half + r);
            const int it = ii >> 5, lp = hh * 32 + (ii & 31);
            f32x16 a0, a1;
#pragma unroll
            for (int g2 = 0; g2 < 2; ++g2) {
                const u32x4 w0 = *(const u32x4*)(CQ + inst + (((it * 2 + 0) * 2 + g2) * 64 + lp) * 8), w1 = *(const u32x4*)(CQ + inst + (((it * 2 + 1) * 2 + g2) * 64 + lp) * 8);
                a0[8 * g2] = bf2f(w0.x & 0xffff); a0[8 * g2 + 1] = bf2f(w0.x >> 16); a0[8 * g2 + 2] = bf2f(w0.y & 0xffff); a0[8 * g2 + 3] = bf2f(w0.y >> 16);
                a0[8 * g2 + 4] = bf2f(w0.z & 0xffff); a0[8 * g2 + 5] = bf2f(w0.z >> 16); a0[8 * g2 + 6] = bf2f(w0.w & 0xffff); a0[8 * g2 + 7] = bf2f(w0.w >> 16);
                a1[8 * g2] = bf2f(w1.x & 0xffff); a1[8 * g2 + 1] = bf2f(w1.x >> 16); a1[8 * g2 + 2] = bf2f(w1.y & 0xffff); a1[8 * g2 + 3] = bf2f(w1.y >> 16);
                a1[8 * g2 + 4] = bf2f(w1.z & 0xffff); a1[8 * g2 + 5] = bf2f(w1.z >> 16); a1[8 * g2 + 6] = bf2f(w1.w & 0xffff); a1[8 * g2 + 7] = bf2f(w1.w >> 16);
            }
#pragma unroll
            for (int s = 0; s < 4; ++s) {
                const bf16x8 pf = *(const bf16x8*)(CP + inst + ((it * 4 + s) * 64 + lp) * 8);
                const bf16x8 h0 = *(const bf16x8*)(HT + inst + ((0 * 4 + s) * 64 + lane) * 8), h1 = *(const bf16x8*)(HT + inst + ((1 * 4 + s) * 64 + lane) * 8);
                a0 = __builtin_amdgcn_mfma_f32_32x32x16_bf16(h0, pf, a0, 0, 0, 0);
                a1 = __builtin_amdgcn_mfma_f32_32x32x16_bf16(h1, pf, a1, 0, 0, 0);
            }
#pragma unroll
            for (int g = 0; g < 16; ++g) { y0[g] += a0[g]; y1[g] += a1[g]; }
        }
        const int tau = 32 * half + r; const size_t row = (size_t)b * T + c * 64 + tau;
        float sm = 0.f;
#pragma unroll
        for (int g = 0; g < 16; ++g) sm += y0[g] + y1[g];
        sm += __shfl_xor(sm, 32);
        const float mean = sm * (1.f / 64.f);
        float q2 = 0.f;
#pragma unroll
        for (int g = 0; g < 16; ++g) { y0[g] -= mean; y1[g] -= mean; q2 += y0[g] * y0[g] + y1[g] * y1[g]; }
        q2 += __shfl_xor(q2, 32);
        const float rstd = rsqrtf(q2 * (1.f / 64.f) + 64e-5f);
        const bf16_t* rs = (const bf16_t*)(p.ws + OFF_RS) + row * 1024 + h * 64; const bf16_t* ks = (const bf16_t*)(p.ws + OFF_KS) + row * 1024 + h * 64;
        const bf16_t* ai0 = (const bf16_t*)(p.ws + OFF_AIG) + row * 2048 + h * 64; const bf16_t* ai1 = ai0 + 1024;
        const bf16_t* vs = (const bf16_t*)(p.ws + OFF_VS) + row * 1024 + h * 64; const bf16_t* gg = (const bf16_t*)(p.ws + OFF_GG) + row * 1024 + h * 64;
        float bon = 0.f;
#pragma unroll
        for (int q = 0; q < 8; ++q) {
            const int ch = 32 * (q >> 2) + 8 * (q & 3) + 4 * hh;
            const u32x2 r2 = *(const u32x2*)(rs + ch), k2 = *(const u32x2*)(ks + ch), x2 = *(const u32x2*)(ai0 + ch), z2 = *(const u32x2*)(ai1 + ch);
            const f32x4 ka = *(const f32x4*)(p.k_a + h * 64 + ch), rk = *(const f32x4*)(p.r_k + h * 64 + ch);
            const float rr[4] = {bf2f(r2.x & 0xffff), bf2f(r2.x >> 16), bf2f(r2.y & 0xffff), bf2f(r2.y >> 16)}, kk[4] = {bf2f(k2.x & 0xffff), bf2f(k2.x >> 16), bf2f(k2.y & 0xffff), bf2f(k2.y >> 16)};
            const float xa[4] = {bf2f(x2.x & 0xffff), bf2f(x2.x >> 16), bf2f(x2.y & 0xffff), bf2f(x2.y >> 16)}, za[4] = {bf2f(z2.x & 0xffff), bf2f(z2.x >> 16), bf2f(z2.y & 0xffff), bf2f(z2.y >> 16)};
#pragma unroll
            for (int e = 0; e < 4; ++e) bon += rr[e] * (kk[e] * ((1.f + (xa[e] - 1.f) * ka[e]) + (1.f + (za[e] - 1.f) * ka[e]))) * rk[e];
        }
        bon += __shfl_xor(bon, 32);
        bf16_t* dst = (bf16_t*)(p.ws + OFF_MIX) + row * D + h * 64;
#pragma unroll
        for (int q = 0; q < 8; ++q) {
            const int ch = 32 * (q >> 2) + 8 * (q & 3) + 4 * hh, g0 = 4 * (q & 3);
            const f32x4 lg = *(const f32x4*)(p.lnx_g + h * 64 + ch), lb = *(const f32x4*)(p.lnx_b + h * 64 + ch);
            const u32x2 v2 = *(const u32x2*)(vs + ch), g2 = *(const u32x2*)(gg + ch);
            const float vv[4] = {bf2f(v2.x & 0xffff), bf2f(v2.x >> 16), bf2f(v2.y & 0xffff), bf2f(v2.y >> 16)}, gv[4] = {bf2f(g2.x & 0xffff), bf2f(g2.x >> 16), bf2f(g2.y & 0xffff), bf2f(g2.y >> 16)};
            float o[4];
#pragma unroll
            for (int e = 0; e < 4; ++e) { const float yv = (q < 4) ? y0[g0 + e] : y1[g0 + e]; o[e] = (yv * rstd * lg[e] + lb[e] + bon * vv[e]) * gv[e]; }
            *(u32x2*)(dst + ch) = mk2u(pk2(o[0], o[1]), pk2(o[2], o[3]));
        }
    }
}

__device__ __forceinline__ void phase6(LDSP unsigned char* lds, const Params& p) {
    pg8::Epi<FX1> epi{FX1{p.x, (const float*)(p.ws + OFF_MOD), (float*)(p.ws + OFF_X1)}};
    pg8::DenseSched S{(const char*)(p.ws + OFF_MIX), (const char*)(p.ws + OFF_WTOUT), NX / 256, D / 256, D, (int)gridDim.x, (int)blockIdx.x};
    pg8::gemm_phase<false>(lds, D, S, epi);
}

__device__ __forceinline__ void phase7(LDSP unsigned char* lds, const Params& p) {
    const int tid = opaque(threadIdx.x), wid = tid >> 6, lane = tid & 63;
    LDSP float* GS = (LDSP float*)lds;
    LDSP float* RSTD = (LDSP float*)(lds + 16384);
    LDSP float* PART = (LDSP float*)(lds + 16896);
    LDSP float* CB = (LDSP float*)(lds + 16896 + 65536);
    const float* MOD = (const float*)(p.ws + OFF_MOD);
    const float* X1 = (const float*)(p.ws + OFF_X1);
    unsigned char* H2 = p.ws + OFF_H2;
    int* CNT = (int*)(p.ws + OFF_CTL + 16384);
    for (int u = blockIdx.x; u < NX / 32; u += gridDim.x) {
        const float* md = MOD + (size_t)((u * 32) >> 12) * 12288;
        for (int idx = tid; idx < D / 4; idx += 512) { const f32x4 g = *(const f32x4*)(p.norm2_g + 4 * idx), sh = *(const f32x4*)(md + 3 * D + 4 * idx), sc = *(const f32x4*)(md + 4 * D + 4 * idx);
            *(LDSP f32x4*)(GS + 4 * idx) = g * (sc + 1.f); *(LDSP f32x4*)(GS + D + 4 * idx) = sh; }
        __syncthreads();
#pragma unroll 1
        for (int rr = 0; rr < 4; ++rr) {
            const int t = 4 * wid + rr, row = u * 32 + t; const float* src = X1 + (size_t)row * D;
            f32x4 xv[8]; float ss = 0.f;
#pragma unroll
            for (int i = 0; i < 8; ++i) { xv[i] = ((const f32x4*)src)[lane + 64 * i]; ss += xv[i].x * xv[i].x + xv[i].y * xv[i].y + xv[i].z * xv[i].z + xv[i].w * xv[i].w; }
            ss = wave_sum(ss); const float rs = rsqrtf(ss * (1.f / D) + 1e-6f);
            if (lane == 0) RSTD[t] = rs;
#pragma unroll
            for (int i = 0; i < 8; ++i) { const int col = 4 * (lane + 64 * i);
                const f32x4 g = *(const LDSP f32x4*)(GS + col), sh = *(const LDSP f32x4*)(GS + D + col);
                const f32x4 hv = xv[i] * rs * g + sh;
                *(unsigned*)(H2 + (size_t)row * D + col) = pk4_fp8(hv.x, hv.y, hv.z, hv.w); }
        }
        {
            const int j = lane & 31, kk = lane >> 5, k0 = wid * 256;
            unsigned xoff = (unsigned)((u * 32 + j) * D + k0 + 4 * kk) * 4u;
            unsigned woff = (unsigned)((k0 + 4 * kk) * 64 + j) * 4u;
            unsigned goff = (unsigned)(k0 + 4 * kk) * 4u;
            f32x16 acc0 = zero16(), acc1 = zero16(); float c0 = 0.f, c1 = 0.f;
#pragma unroll 2
            for (int q = 0; q < 32; ++q) {
                const f32x4 xa = *(const f32x4*)((const char*)X1 + xoff);
                const f32x4 gv = *(const LDSP f32x4*)((const LDSP char*)GS + goff), sv = *(const LDSP f32x4*)((const LDSP char*)GS + D * 4 + goff);
                float b0[4], b1[4];
#pragma unroll
                for (int e = 0; e < 4; ++e) { b0[e] = *(const float*)((const char*)p.w_router + woff + e * 256); b1[e] = *(const float*)((const char*)p.w_router + woff + e * 256 + 128); }
#pragma unroll
                for (int e = 0; e < 4; ++e) {
                    acc0 = __builtin_amdgcn_mfma_f32_32x32x2f32(xa[e], b0[e] * gv[e], acc0, 0, 0, 0);
                    acc1 = __builtin_amdgcn_mfma_f32_32x32x2f32(xa[e], b1[e] * gv[e], acc1, 0, 0, 0);
                    c0 += sv[e] * b0[e]; c1 += sv[e] * b1[e];
                }
                xoff += 32u; woff += 2048u; goff += 32u;
            }
            c0 += __shfl_xor(c0, 32); c1 += __shfl_xor(c1, 32);
#pragma unroll
            for (int g = 0; g < 16; ++g) { const int t = crow(g, kk); PART[(wid * 32 + t) * 64 + j] = acc0[g]; PART[(wid * 32 + t) * 64 + 32 + j] = acc1[g]; }
            if (kk == 0) { CB[wid * 64 + j] = c0; CB[wid * 64 + 32 + j] = c1; }
        }
        __syncthreads();
        float cb = 0.f;
#pragma unroll
        for (int w = 0; w < 8; ++w) cb += CB[w * 64 + lane];
        const float eb = p.expert_bias[lane];
#pragma unroll 1
        for (int rr = 0; rr < 4; ++rr) {
            const int t = 4 * wid + rr, token = u * 32 + t;
            float sum = 0.f;
#pragma unroll
            for (int w = 0; w < 8; ++w) sum += PART[(w * 32 + t) * 64 + lane];
            const float logit = RSTD[t] * sum + cb;
            const float score = 1.f / (1.f + expf(-logit));
            const float v = score + eb;
            const int gi = lane >> 3;
            float m1 = v;
            m1 = fmaxf(m1, __shfl_xor(m1, 1)); m1 = fmaxf(m1, __shfl_xor(m1, 2)); m1 = fmaxf(m1, __shfl_xor(m1, 4));
            const unsigned long long eq = __ballot(v == m1);
            const unsigned gbits = (unsigned)((eq >> (gi * 8)) & 0xffull);
            const bool first = (lane & 7) == (__ffs((int)gbits) - 1);
            float v2 = first ? -INFINITY : v;
            v2 = fmaxf(v2, __shfl_xor(v2, 1)); v2 = fmaxf(v2, __shfl_xor(v2, 2)); v2 = fmaxf(v2, __shfl_xor(v2, 4));
            const float gs = m1 + v2;
            int gr = 0;
#pragma unroll
            for (int jj = 0; jj < 8; ++jj) { const float gj = __builtin_bit_cast(float, __builtin_amdgcn_readlane(__builtin_bit_cast(int, gs), jj * 8)); gr += (gj > gs || (gj == gs && jj < gi)) ? 1 : 0; }
            const float mv = (gr < 4) ? v : -INFINITY;
            int rk = 0;
#pragma unroll
            for (int j8 = 0; j8 < 8; ++j8) {
#pragma unroll
                for (int j1 = 0; j1 < 8; ++j1) { const int jj = 8 * j8 + j1; const float vj = __builtin_bit_cast(float, __builtin_amdgcn_readlane(__builtin_bit_cast(int, mv), jj)); rk += (vj > mv || (vj == mv && jj < lane)) ? 1 : 0; }
                __builtin_amdgcn_sched_barrier(0);
            }
            const bool sel = (rk < 8) && (gr < 4);
            const float gsum = wave_sum(sel ? score : 0.f);
            if (sel) {
                const int slot = atomicAdd(&CNT[lane], 1);
                ((int*)(p.ws + OFF_EIDX))[token * 8 + rk] = lane;
                ((int*)(p.ws + OFF_ESLOT))[token * 8 + rk] = slot;
                ((float*)(p.ws + OFF_GATE))[token * 8 + rk] = score / gsum * 2.5f;
                ((int*)(p.ws + OFF_TOKL))[(size_t)lane * NX + slot] = token;
            }
        }
        __syncthreads();
    }
}

constexpr int LE_TAB = 131072;
__device__ __forceinline__ void build_expert_tables(LDSP unsigned char* lds, const Params& p) {
    LDSP int* TP = (LDSP int*)(lds + LE_TAB); LDSP int* ST = TP + 72; LDSP int* CN = ST + 72;
    if (threadIdx.x < NEX) CN[threadIdx.x] = (threadIdx.x < NE) ? ((const int*)(p.ws + OFF_CTL + 16384))[threadIdx.x] : NX;
    __syncthreads();
    if (threadIdx.x == 0) {
        int tp = 0, st = 0;
        for (int e = 0; e < NEX; ++e) { const int cn = CN[e]; TP[e] = tp; ST[e] = st; tp += (cn + 255) >> 8; st += cn; }
        TP[NEX] = tp; ST[NEX] = st;
    }
    __syncthreads();
}

struct GroupSched {
    const LDSP int* TP; const LDSP int* ST; const LDSP int* CN;
    const char* A; const char* B; const int* tokl; int ntn, K, G, c; size_t bstride; bool gather; int bn;
    __device__ __forceinline__ bool next(int i, pg8::Unit& u) const {
        const int total = __builtin_amdgcn_readfirstlane(TP[NEX]) * ntn; const long L = (long)i * G + c; if (L >= total) return false;
        const int w = pg8::xcd_remap((int)L, total);
        const int nt = w % ntn, mtg = w / ntn;
        int e = u.e;
        if (__builtin_amdgcn_readfirstlane(TP[e]) > mtg) e = 0;
        while (__builtin_amdgcn_readfirstlane(TP[e + 1]) <= mtg) ++e;
        const int tpe = __builtin_amdgcn_readfirstlane(TP[e]), ste = __builtin_amdgcn_readfirstlane(ST[e]), cne = __builtin_amdgcn_readfirstlane(CN[e]);
        const int mt = mtg - tpe;
        u.B = B + (size_t)e * bstride + (size_t)nt * bn * K * 2;
        u.nvalid = cne; u.m0 = mt * 256; u.pos0 = ste; u.row0 = 0; u.col0 = nt * bn; u.e = e;
        if (gather) { u.A = A; u.rowmap = (e < NE) ? tokl + (size_t)e * NX : nullptr; }
        else { u.A = A + (size_t)(ste + mt * 256) * K * 2; u.rowmap = nullptr; }
        return true;
    }
};
__device__ __forceinline__ void phase8(LDSP unsigned char* lds, const Params& p) {
    build_expert_tables(lds, p);
    const LDSP int* TP = (const LDSP int*)(lds + LE_TAB);
    pg8::Epi<FH1, 1> epi{FH1{p.ws + OFF_H1}};
    GroupSched S{TP, TP + 72, TP + 144, (const char*)(p.ws + OFF_H2), (const char*)(p.ws + OFF_WTE1), (const int*)(p.ws + OFF_TOKL), 8, D / 2, (int)gridDim.x, (int)blockIdx.x,
                 (size_t)1024 * 2048, true, 128};
    pg8::gemm_phase<true, true, true>(lds, D / 2, S, epi);
}
__device__ __forceinline__ void phase9(LDSP unsigned char* lds, const Params& p) {
    build_expert_tables(lds, p);
    const LDSP int* TP = (const LDSP int*)(lds + LE_TAB);
    pg8::Epi<FEO, 1> epi{FEO{p.ws + OFF_EO}};
    GroupSched S{TP, TP + 72, TP + 144, (const char*)(p.ws + OFF_H1), (const char*)(p.ws + OFF_WTE2), nullptr, 16, EFF / 2, (int)gridDim.x, (int)blockIdx.x,
                 (size_t)2048 * 512, false, 128};
    pg8::gemm_phase<false, false, true>(lds, EFF / 2, S, epi);
}
typedef float f32x2v __attribute__((ext_vector_type(2)));
__device__ __forceinline__ void phase10(LDSP unsigned char* lds, const Params& p) {
    build_expert_tables(lds, p);
    const LDSP int* ST = (const LDSP int*)(lds + LE_TAB) + 72;
    const int tid = opaque(threadIdx.x), wid = tid >> 6, lane = tid & 63;
    const float* MOD = (const float*)(p.ws + OFF_MOD);
    const float* X1 = (const float*)(p.ws + OFF_X1);
    const unsigned char* EO = p.ws + OFF_EO;
    for (int row = blockIdx.x * 8 + wid; row < NX; row += gridDim.x * 8) {
        unsigned er[9]; float gw[9];
#pragma unroll
        for (int k = 0; k < 8; ++k) { const int e = ((const int*)(p.ws + OFF_EIDX))[row * 8 + k], sl = ((const int*)(p.ws + OFF_ESLOT))[row * 8 + k];
            er[k] = (unsigned)(ST[e] + sl) * (unsigned)D; gw[k] = ((const float*)(p.ws + OFF_GATE))[row * 8 + k]; }
        er[8] = (unsigned)(ST[NE] + row) * (unsigned)D; gw[8] = 1.f;
        const float* md = MOD + (size_t)(row >> 12) * 12288 + 5 * D;
        LDSP float* RB = (LDSP float*)lds + wid * 2048;
        float ss = 0.f;
#pragma unroll 2
        for (int i = 0; i < 4; ++i) { const int col = 8 * (lane + 64 * i);
            float a[8];
#pragma unroll
            for (int j = 0; j < 8; ++j) a[j] = 0.f;
#pragma unroll
            for (int k = 0; k < 9; ++k) { const u32x2 w = *(const u32x2*)(EO + er[k] + col);
                const f32x2v f0 = __builtin_amdgcn_cvt_pk_f32_fp8((int)w.x, false), f1 = __builtin_amdgcn_cvt_pk_f32_fp8((int)w.x, true), f2 = __builtin_amdgcn_cvt_pk_f32_fp8((int)w.y, false), f3 = __builtin_amdgcn_cvt_pk_f32_fp8((int)w.y, true);
                a[0] += gw[k] * f0.x; a[1] += gw[k] * f0.y; a[2] += gw[k] * f1.x; a[3] += gw[k] * f1.y; a[4] += gw[k] * f2.x; a[5] += gw[k] * f2.y; a[6] += gw[k] * f3.x; a[7] += gw[k] * f3.y; }
            const f32x4 xa = *(const f32x4*)(X1 + (size_t)row * D + col), xb = *(const f32x4*)(X1 + (size_t)row * D + col + 4), ga = *(const f32x4*)(md + col), gb = *(const f32x4*)(md + col + 4);
            f32x4 va, vb; va.x = xa.x + ga.x * a[0]; va.y = xa.y + ga.y * a[1]; va.z = xa.z + ga.z * a[2]; va.w = xa.w + ga.w * a[3];
            vb.x = xb.x + gb.x * a[4]; vb.y = xb.y + gb.y * a[5]; vb.z = xb.z + gb.z * a[6]; vb.w = xb.w + gb.w * a[7];
            ss += va.x * va.x + va.y * va.y + va.z * va.z + va.w * va.w + vb.x * vb.x + vb.y * vb.y + vb.z * vb.z + vb.w * vb.w;
            *(LDSP f32x4*)(RB + col) = va; *(LDSP f32x4*)(RB + col + 4) = vb; }
        ss = wave_sum(ss); const float rs = rsqrtf(ss * (1.f / D) + 1e-6f);
#pragma unroll 4
        for (int i = 0; i < 8; ++i) { const int col = 4 * (lane + 64 * i); const f32x4 g = *(const f32x4*)(p.final_g + col);
            const f32x4 xv = *(const LDSP f32x4*)(RB + col);
            f32x4 o; o.x = xv.x * rs * g.x; o.y = xv.y * rs * g.y; o.z = xv.z * rs * g.z; o.w = xv.w * rs * g.w;
            *(f32x4*)(p.out + (size_t)row * D + col) = o; }
    }
}

#define XB_TMO      128
#define XB_XCNT(j)  (256  + 64 * (j))
#define XB_XSUB(j)  (1280 + 64 * (j))
#define XB_XGEN(j)  (2304 + 64 * (j))
#define XB_TOP      3328
#define XB_TOPGEN   3392
#define XB_SPIN_CAP (1u << 20)
__device__ __forceinline__ unsigned xb_ld(unsigned* p)              { return __hip_atomic_load(p, __ATOMIC_RELAXED, __HIP_MEMORY_SCOPE_AGENT); }
__device__ __forceinline__ unsigned xb_add(unsigned* p, unsigned v) { return __hip_atomic_fetch_add(p, v, __ATOMIC_RELAXED, __HIP_MEMORY_SCOPE_AGENT); }
__device__ __forceinline__ unsigned xb_xcc_id() { return (unsigned)__builtin_amdgcn_s_getreg((3 << 11) | 20) & 0xFu; }
#define XB_SPIN(cond, bar) do { unsigned _sp = 0; while (cond) { __builtin_amdgcn_s_sleep(1); \
    if ((++_sp & 255u) == 0u) { if (xb_ld(&(bar)[XB_TMO])) break; if (_sp > XB_SPIN_CAP) { atomicAdd(&(bar)[XB_TMO], 1u); break; } } } } while (0)
__device__ __forceinline__ unsigned xcd_barrier_complete(unsigned* bar, unsigned x) {
    const unsigned G = gridDim.x * gridDim.y * gridDim.z;
    unsigned sum, cnt, mine, sp = 0u;
    for (;;) {
        sum = 0u; cnt = 0u; mine = 0u;
#pragma unroll
        for (unsigned j = 0; j < 16; ++j) { const unsigned c = xb_ld(&bar[XB_XCNT(j)]); sum += c; cnt += (c > 0u) ? 1u : 0u; mine = (j == x) ? c : mine; }
        if (sum == G) break;
        __builtin_amdgcn_s_sleep(1);
        if ((++sp & 255u) == 0u) { if (xb_ld(&bar[XB_TMO])) break; if (sp > XB_SPIN_CAP) { atomicAdd(&bar[XB_TMO], 1u); break; } }
    }
    return (mine > 0u ? mine : 1u) | ((cnt > 0u ? cnt : 1u) << 16);
}
__device__ __forceinline__ void xcd_barrier(unsigned* bar, unsigned x, volatile LDSP unsigned* st) {
    asm volatile("s_waitcnt vmcnt(0)" ::: "memory");
    __syncthreads();
    if (threadIdx.x == 0) {
        __builtin_amdgcn_s_waitcnt(0);
        unsigned pk = st[0];
        if (pk == 0u) { pk = xcd_barrier_complete(bar, x); st[0] = pk; }
        const unsigned nloc = pk & 0xffffu, nx = pk >> 16;
        const unsigned old = xb_add(&bar[XB_XSUB(x)], 1u);
        const unsigned gen = old / nloc;
        if (old + 1u == (gen + 1u) * nloc) {
            __builtin_amdgcn_fence(__ATOMIC_RELEASE, "agent");
            asm volatile("s_waitcnt vmcnt(0)" ::: "memory");
            const unsigned og = xb_add(&bar[XB_TOP], 1u);
            const unsigned tg = og / nx;
            if (og + 1u == (tg + 1u) * nx) xb_add(&bar[XB_TOPGEN], 1u);
            else XB_SPIN(xb_ld(&bar[XB_TOPGEN]) == tg, bar);
            __builtin_amdgcn_fence(__ATOMIC_ACQUIRE, "agent");
            xb_add(&bar[XB_XGEN(x)], 1u);
            asm volatile("s_waitcnt vmcnt(0)" ::: "memory");
        } else {
            XB_SPIN(xb_ld(&bar[XB_XGEN(x)]) == gen, bar);
            __builtin_amdgcn_fence(__ATOMIC_ACQUIRE, "agent");
            asm volatile("s_waitcnt vmcnt(0)" ::: "memory");
        }
    }
    __syncthreads();
}

__global__ void __launch_bounds__(512, 2) fwd_megakernel(Params p) {
    __shared__ __attribute__((aligned(16))) unsigned char smem_raw[SMEM_BYTES];
    LDSP unsigned char* lds = (LDSP unsigned char*)smem_raw;
    volatile LDSP unsigned* xst = (volatile LDSP unsigned*)(lds + SMEM_BYTES - 16);
    if (threadIdx.x == 0) { xst[0] = 0u; xst[1] = 0u; }
    __syncthreads();
    const unsigned xcc = xb_xcc_id();
    if (threadIdx.x == 0) (void)xb_add(&((unsigned*)p.ws)[XB_XCNT(xcc)], 1u);
#define GSYNC xcd_barrier((unsigned*)p.ws, xcc, xst)
#ifndef PH_TWICE
#define PH_TWICE 0
#endif
#ifndef PH_MASK
#define PH_MASK 0xffff
#endif
#define RUN_PHASE(bit, fn) _Pragma("unroll 1") for (int rep = 0; rep < ((PH_TWICE & (bit)) ? 2 : 1); ++rep) { if (rep) GSYNC; if (PH_MASK & (bit)) { Params q = p; q.ws = opq(p.ws); fn(lds, q); } }
    RUN_PHASE(1, phase0)      GSYNC;
    RUN_PHASE(2, phase1)      GSYNC;
    RUN_PHASE(4, phase2)      GSYNC;
    RUN_PHASE(8, phaseR1)     GSYNC;
    RUN_PHASE(16, phaseR2)    GSYNC;
    RUN_PHASE(32, phaseR3)    GSYNC;
    RUN_PHASE(64, phaseR4)    GSYNC;
    RUN_PHASE(128, phaseR5)   GSYNC;
    RUN_PHASE(256, phase6)    GSYNC;
    RUN_PHASE(512, phase7)    GSYNC;
    RUN_PHASE(1024, phase8)   GSYNC;
    RUN_PHASE(2048, phase9)   GSYNC;
    RUN_PHASE(4096, phase10)
}

extern "C" void kernel_launch(void* const* d_in, const int* in_sizes, int n_in, void* d_out, int out_size, void* d_ws, size_t ws_size, hipStream_t stream) {
    static int grid_blocks = 0;
    if (!grid_blocks) {
        int dev = 0, cus = 0, per_cu = 0;
        (void)hipGetDevice(&dev);
        (void)hipDeviceGetAttribute(&cus, hipDeviceAttributeMultiprocessorCount, dev);
        (void)hipOccupancyMaxActiveBlocksPerMultiprocessor(&per_cu, fwd_megakernel, 512, 0);
        if (per_cu > 1) per_cu = 1;
        grid_blocks = cus * per_cu;
        if (ws_size < WS_END) fprintf(stderr, "workspace too small: %zu < %zu\n", ws_size, (size_t)WS_END);
    }
    Params p{};
    const float** f = (const float**)&p;
    for (int i = 0; i < 31; ++i) f[i] = (const float*)d_in[i];
    p.out = (float*)d_out; p.ws = (unsigned char*)d_ws;
    (void)hipMemsetAsync(d_ws, 0, 32768, stream);
    void* args[] = {&p};
    hipError_t e = hipLaunchCooperativeKernel((void*)fwd_megakernel, dim3(grid_blocks), dim3(512), args, 0, stream);
    if (e != hipSuccess) fprintf(stderr, "cooperative launch failed: %s (grid %d)\n", hipGetErrorString(e), grid_blocks);
}
```

```cpp
#include <hip/hip_runtime.h>
#include <hip/hip_cooperative_groups.h>
#include <cstdio>
#include <cstdint>
namespace cg = cooperative_groups;

#define LDSP __attribute__((address_space(3)))
typedef unsigned short bf16_t;
typedef short bf16x8 __attribute__((ext_vector_type(8)));
typedef float f32x4 __attribute__((ext_vector_type(4)));
typedef float f32x16 __attribute__((ext_vector_type(16)));
typedef unsigned u32x4 __attribute__((ext_vector_type(4)));
typedef unsigned u32x2 __attribute__((ext_vector_type(2)));
typedef int v4i __attribute__((ext_vector_type(4)));
typedef int v8i __attribute__((ext_vector_type(8)));
__device__ __forceinline__ u32x4 mk4u(unsigned a, unsigned b, unsigned c, unsigned d) { u32x4 r; r.x = a; r.y = b; r.z = c; r.w = d; return r; }
__device__ __forceinline__ u32x2 mk2u(unsigned a, unsigned b) { u32x2 r; r.x = a; r.y = b; return r; }
__device__ __forceinline__ f32x4 mk4f(float a, float b, float c, float d) { f32x4 r; r.x = a; r.y = b; r.z = c; r.w = d; return r; }

constexpr int D = 2048, NB = 2, T = 4096, CL = 256, NX = NB * T, NCX = NB * CL, NR = NX + NCX;
constexpr int INC = 5056, INP = 5120;
constexpr int C_R = 0, C_K = 1024, C_V = 2048, C_XW = 3072, C_XA = 3168, C_XG = 3264, C_Q = 3520, C_AK = 4544, C_AV = 4800;
constexpr int NE = 64, NEX = 65, EFF = 512;
constexpr int NCHUNK = 68;
constexpr int NINST = NB * 16 * 2 * NCHUNK;
constexpr int EROWS = NX * 8 + NX;

constexpr size_t al4k(size_t x) { return (x + 4095) & ~(size_t)4095; }
constexpr size_t OFF_CTL = 0;
constexpr size_t OFF_ROPE = 65536;
constexpr size_t OFF_MODP = OFF_ROPE + 8192;
constexpr size_t OFF_MOD = al4k(OFF_MODP + (size_t)16 * 3 * 12288 * 4);
constexpr size_t OFF_WTDU = al4k(OFF_MOD + (size_t)3 * 12288 * 4);
constexpr size_t OFF_WTIU = OFF_WTDU + (size_t)2 * 1024 * 128 * 2;
constexpr size_t OFF_WTGU = OFF_WTIU + (size_t)2 * 1024 * 128 * 2;
constexpr size_t OFF_WTE2 = OFF_WTGU + (size_t)1024 * 256 * 2;
constexpr size_t OFF_X1 = OFF_WTE2 + (size_t)NEX * 2048 * 512 * 2;
constexpr size_t OFF_H2 = OFF_X1 + (size_t)NX * D * 4;
constexpr size_t OFF_TOKL = OFF_H2 + (size_t)NX * D * 2;
constexpr size_t OFF_EIDX = OFF_TOKL + (size_t)NE * NX * 4;
constexpr size_t OFF_ESLOT = OFF_EIDX + (size_t)NX * 8 * 4;
constexpr size_t OFF_GATE = OFF_ESLOT + (size_t)NX * 8 * 4;
constexpr size_t OFF_H1 = OFF_GATE + (size_t)NX * 8 * 4;
constexpr size_t OFF_WTE1 = al4k(OFF_H1 + (size_t)(EROWS + 256) * EFF * 2);
constexpr size_t OFF_EO = OFF_WTE1;
constexpr size_t OFF_WTIN = OFF_WTE1 + (size_t)NEX * 1024 * 2048 * 2;
constexpr size_t OFF_WTOUT = OFF_WTIN + (size_t)INP * D * 2;
constexpr size_t OFF_HX = OFF_WTOUT + (size_t)D * D * 2;
constexpr size_t OFF_PX = OFF_HX + (size_t)NR * D * 2;
constexpr size_t OFF_CM = OFF_PX + (size_t)NR * INP * 2;
constexpr size_t OFF_CN = OFF_CM + (size_t)NINST * 4096 * 2;
constexpr size_t OFF_CP = OFF_CN + (size_t)NINST * 4096 * 2;
constexpr size_t OFF_CQ = OFF_CP + (size_t)NINST * 4096 * 2;
constexpr size_t OFF_YD = OFF_CQ + (size_t)NINST * 4096 * 2;
constexpr size_t OFF_BON = OFF_YD + (size_t)2 * NX * 1024 * 4;
constexpr size_t OFF_MIX = OFF_BON + (size_t)2 * NX * 16 * 4;
constexpr size_t WS_END = OFF_MIX + (size_t)NX * D * 2;
constexpr size_t OFF_RS = OFF_X1;
constexpr size_t OFF_KS = OFF_RS + (size_t)NR * 1024 * 2;
constexpr size_t OFF_KK = OFF_KS + (size_t)NR * 1024 * 2;
constexpr size_t OFF_VS = OFF_KK + (size_t)NR * 1024 * 2;
constexpr size_t OFF_TW = OFF_VS + (size_t)NR * 1024 * 2;
constexpr size_t OFF_XA = OFF_TW + (size_t)NR * 128 * 2;
constexpr size_t OFF_SG = OFF_XA + (size_t)NR * 128 * 2;
constexpr size_t OFF_LWG = OFF_SG + (size_t)NX * 256 * 2;
constexpr size_t OFF_AIG = OFF_LWG + (size_t)NR * 2048 * 2;
constexpr size_t OFF_GG = OFF_AIG + (size_t)NR * 2048 * 2;
static_assert(OFF_GG + (size_t)NX * 1024 * 2 <= OFF_WTE1, "RWKV token buffers fit the overlay region");
static_assert(OFF_EO + (size_t)EROWS * D * 2 <= OFF_HX, "EO overlays only WT_E1/WT_IN/WT_OUT");
static_assert(WS_END <= (size_t)1073741824, "workspace map must fit 1 GiB");

constexpr int SMEM_BYTES = 157 * 1024;

struct Params {
    const float *x, *c, *ctx, *c_ctx, *w_mod, *b_mod, *norm1_g, *norm2_g, *w_in, *shift_mu, *k_k, *k_a, *r_k, *decay_bias, *decay_up, *iclr_bias, *iclr_up,
        *gate_up, *lnx_g, *lnx_b, *attn_sink, *w_out, *w_router, *expert_bias, *e_gate, *e_up, *e_down, *s_gate, *s_up, *s_down, *final_g;
    float* out;
    unsigned char* ws;
};

__device__ __forceinline__ unsigned f2bf(float f) { unsigned u = __float_as_uint(f); return (u + 0x7fffu + ((u >> 16) & 1u)) >> 16; }
__device__ __forceinline__ float bf2f(unsigned h) { return __uint_as_float(h << 16); }
typedef float f32x2_t __attribute__((ext_vector_type(2)));
typedef __bf16 bf16x2_t __attribute__((ext_vector_type(2)));
__device__ __forceinline__ unsigned pk2(float lo, float hi) { f32x2_t v = {lo, hi}; bf16x2_t b = __builtin_convertvector(v, bf16x2_t); return __builtin_bit_cast(unsigned, b); }
__device__ __forceinline__ unsigned pk4_fp8(float a, float b, float c, float d) { int w = 0; w = __builtin_amdgcn_cvt_pk_fp8_f32(a, b, w, false); w = __builtin_amdgcn_cvt_pk_fp8_f32(c, d, w, true); return (unsigned)w; }
__device__ __forceinline__ int opaque(int x);
__device__ __forceinline__ float shx(float v, int o) {
    const int l = opaque((int)threadIdx.x) & 63;
    return __builtin_bit_cast(float, __builtin_amdgcn_ds_bpermute((l ^ o) << 2, __builtin_bit_cast(int, v))); }
__device__ __forceinline__ float wave_sum(float v) {
#pragma unroll
    for (int o = 32; o > 0; o >>= 1) v += shx(v, o);
    return v;
}
__device__ __forceinline__ int opaque(int x) { asm volatile("" : "+v"(x)); return x; }
__device__ __forceinline__ int opaque_s(int x) { asm volatile("" : "+s"(x)); return x; }
__device__ __forceinline__ unsigned char* opq(unsigned char* x) {
    unsigned long long v = (unsigned long long)x; asm volatile("" : "+s"(v));
    return (unsigned char*)(__attribute__((address_space(1))) unsigned char*)v; }
__device__ __forceinline__ float sigmoidf_(float x) { return __builtin_amdgcn_rcpf(1.f + __expf(-x)); }
__device__ __forceinline__ int lds_byte(int r, int c) { const int st = (r >> 4) * 2 + (c >> 5), rr = r & 15, cc = c & 31, ob = rr * 64 + cc * 2; return st * 1024 + (ob ^ (((ob >> 9) & 1) << 5)); }
__device__ __forceinline__ int sw64(int r, int k) { return r * 128 + ((((k >> 3) ^ (r >> 1)) & 7) << 4) + (k & 7) * 2; }

__device__ __forceinline__ f32x16 zero16() { f32x16 z;
#pragma unroll
    for (int i = 0; i < 16; ++i) z[i] = 0.f; return z; }
__device__ __forceinline__ int crow(int reg, int hi) { return (reg & 3) + 8 * (reg >> 2) + 4 * hi; }

#if defined(__HIP_DEVICE_COMPILE__)
#define LDS_AT(T, addr) (__builtin_bit_cast(LDSP T*, (unsigned)(addr)))
#define LDS_ADDR(ptr) (__builtin_bit_cast(unsigned, (ptr)))
#else
#define LDS_AT(T, addr) ((LDSP T*)(size_t)(addr))
#define LDS_ADDR(ptr) ((unsigned)(size_t)(ptr))
#endif
namespace pg8 {
constexpr int BM = 256, BK = 64, HALF = 128, HTB = HALF * BK * 2, NXCD = 8;
__device__ __forceinline__ void stage_rc(int b, int& R, int& C) { const int st = b / 1024, sb = b % 1024, swz = sb ^ (((sb >> 9) & 1) << 5); R = (st >> 1) * 16 + swz / 64; C = (st & 1) * 32 + (swz % 64) / 2; }
struct Unit { const char* A; const char* B; const int* rowmap; int nvalid, m0, row0, col0, pos0, e; };
__device__ __forceinline__ int xcd_remap(int L, int nwg) { const int q = nwg / NXCD, r = nwg % NXCD, xcd = L % NXCD, off = L / NXCD; return (xcd < r ? xcd * (q + 1) : r * (q + 1) + (xcd - r) * q) + off; }

__device__ __forceinline__ int perm32(int rho) { const int n = rho >> 4, i = rho & 15; return 8 * (i >> 2) + 4 * n + (i & 3); }
template <class F, int NBJ = 2> struct Epi {
    F f;
    __device__ __forceinline__ void operator()(const f32x4 (&acc)[2][2][4][2], const Unit& u, int wr, int wc, int fr, int fq) const {
        { const int lane = opaque((int)threadIdx.x) & 63; fr = lane & 15; fq = lane >> 4; }
#pragma unroll
        for (int ai = 0; ai < 2; ++ai)
#pragma unroll
            for (int m = 0; m < 4; ++m)
#pragma unroll
                for (int bj = 0; bj < NBJ; ++bj) { f(u, 128 * ai + 64 * wr + 16 * m + fr, 128 * bj + 32 * wc + 8 * fq, acc[ai][bj][m][0], acc[ai][bj][m][1]); __builtin_amdgcn_sched_barrier(0); }
    }
};

template <bool GATHER, bool ALIGN_EPI = true, int FP8M = 0, class EpiT, class Sched>
__device__ __forceinline__ void gemm_phase(LDSP unsigned char* lds, const int K, const Sched& S, const EpiT& E) {
    const int tid = opaque(threadIdx.x), wid = __builtin_amdgcn_readfirstlane(tid >> 6), lane = tid & 63, wr = wid >> 2, wc = wid & 3, fr = lane & 15, fq = lane >> 4;
    constexpr bool FP8 = (FP8M != 0), NARROW = (FP8M == 1);
    const int nt = K / BK;
    unsigned voffA[2], voffB[2];
#pragma unroll
    for (int i = 0; i < 2; ++i) { int R, C; stage_rc(tid * 16 + i * 8192, R, C); const int Rb = (R & ~31) + perm32(R & 31); voffA[i] = (unsigned)(R * K + C) * 2u; voffB[i] = (unsigned)(Rb * K + C) * 2u; }
    const size_t kstep = (size_t)(BK * 2);
    const size_t hstep = (size_t)HALF * K * 2;
    const size_t hstepB = hstep;
    const unsigned ldsw = (unsigned)wid * 1024u;
    const int aoff = lds_byte(wr * 64 + fr, fq * 8), boff = lds_byte(wc * 32 + fr, fq * 8);
    const unsigned abase = LDS_ADDR(lds) + (unsigned)aoff, bbase = LDS_ADDR(lds) + 65536u + (unsigned)boff;
#define PG8_SA(b, h) (((b) * 2 + (h)) * HTB)
#define PG8_SB(b, h) ((4 + (b) * 2 + (h)) * HTB)
#define PG8_STAGE(bufoff, gbase, voff) do { _Pragma("unroll") for (int _i = 0; _i < 2; ++_i) \
        { unsigned _o = (voff)[_i]; asm volatile("" : "+v"(_o)); __builtin_amdgcn_global_load_lds((const unsigned*)((const char*)(gbase) + _o), (LDSP unsigned*)(lds + (bufoff) + ldsw + _i * 8192), 16, 0, 0); } } while (0)
#define PG8_STAGE_B1(bufoff, gbase) do { if constexpr (!NARROW) { PG8_STAGE(bufoff, gbase, voffB); } } while (0)
#define PG8_STAGE_A(bufoff, nx, h, ubase, koff) do { if constexpr (GATHER) { unsigned _v[2]; const LDSP unsigned* _ro = rowoff + ((((nx) ? (ui + 1) : ui) & 1) * 4 + (h) * 2) * 512; _v[0] = _ro[0]; _v[1] = _ro[512]; PG8_STAGE(bufoff, (ubase) + (koff), _v); } \
        else { PG8_STAGE(bufoff, (ubase) + (h) * hstep + (koff), voffA); } } while (0)
#define PG8_LD16(off) (*(const LDSP bf16x8*)(lds + (off)))
#define PG8_DSR(base, off) ({ v4i _r; asm volatile("ds_read_b128 %0, %1 offset:%2" : "=v"(_r) : "v"(base), "n"(off)); _r; })
#define PG8_LDA(dst, b, h) do { _Pragma("unroll") for (int m = 0; m < 4; ++m) { if constexpr (FP8) dst##8[m] = __builtin_shufflevector(PG8_DSR(abase, PG8_SA(b, h) + m * 2048), PG8_DSR(abase, PG8_SA(b, h) + m * 2048 + 1024), 0, 1, 2, 3, 4, 5, 6, 7); \
        else { _Pragma("unroll") for (int k = 0; k < 2; ++k) dst[m][k] = PG8_LD16(PG8_SA(b, h) + aoff + m * 2048 + k * 1024); } } } while (0)
#define PG8_LDB(dst, b, h) do { if constexpr (!NARROW || (h) == 0) { _Pragma("unroll") for (int n = 0; n < 2; ++n) { if constexpr (FP8) dst##8[n] = __builtin_shufflevector(PG8_DSR(bbase, PG8_SB(b, h) - 65536 + n * 2048), PG8_DSR(bbase, PG8_SB(b, h) - 65536 + n * 2048 + 1024), 0, 1, 2, 3, 4, 5, 6, 7); \
        else { _Pragma("unroll") for (int k = 0; k < 2; ++k) dst[n][k] = PG8_LD16(PG8_SB(b, h) + boff + n * 2048 + k * 1024); } } } } while (0)
#define PG8_MMA(ai, bj, At, Bt) do { if constexpr (!NARROW || (bj) == 0) { if constexpr (FP8) __builtin_amdgcn_sched_barrier(0); __builtin_amdgcn_s_setprio(1); if constexpr (FP8) { _Pragma("unroll") for (int m = 0; m < 4; ++m) _Pragma("unroll") for (int n = 0; n < 2; ++n) \
            acc[ai][bj][m][n] = __builtin_amdgcn_mfma_scale_f32_16x16x128_f8f6f4(Bt##8[n], At##8[m], acc[ai][bj][m][n], 0, 0, 0, 0x7f7f7f7f, 0, 0x7f7f7f7f); } \
        else { _Pragma("unroll") for (int m = 0; m < 4; ++m) _Pragma("unroll") for (int n = 0; n < 2; ++n) _Pragma("unroll") for (int k = 0; k < 2; ++k) \
            acc[ai][bj][m][n] = __builtin_amdgcn_mfma_f32_16x16x32_bf16(Bt[n][k], At[m][k], acc[ai][bj][m][n], 0, 0, 0); } __builtin_amdgcn_s_setprio(0); } } while (0)
#define PG8_WAIT_V(n) asm volatile("s_waitcnt vmcnt(" #n ")" ::: "memory")
#define PG8_WAIT_L(n) asm volatile("s_waitcnt lgkmcnt(" #n ")" ::: "memory")
#define PG8_BAR __builtin_amdgcn_s_barrier()
#define PG8_SCHED __builtin_amdgcn_sched_barrier(0)
    Unit cur, nxt; int ui = 0;
    cur.e = 0; nxt.e = 0;
    if (!S.next(0, cur)) return;
    LDSP unsigned* rowoff = (LDSP unsigned*)(lds + 132096) + tid;
    auto rows_of = [&](const Unit& u, int slot) {
        if constexpr (GATHER) {
#pragma unroll
            for (int h = 0; h < 2; ++h)
#pragma unroll
                for (int i = 0; i < 2; ++i) { int R, C; stage_rc(tid * 16 + i * 8192, R, C); const int idx = u.m0 + h * HALF + R; int gr = idx; if (u.rowmap) gr = (idx < u.nvalid) ? u.rowmap[idx] : 0;
                    rowoff[((slot & 1) * 4 + h * 2 + i) * 512] = (unsigned)(gr * K + C) * 2u; }
        }
    };
    rows_of(cur, 0);
    f32x4 acc[2][2][4][2];
#pragma unroll
    for (int a = 0; a < 2; ++a)
#pragma unroll
        for (int b = 0; b < 2; ++b)
#pragma unroll
            for (int m = 0; m < 4; ++m)
#pragma unroll
                for (int n = 0; n < 2; ++n) acc[a][b][m][n] = (f32x4){0.f, 0.f, 0.f, 0.f};
    bf16x8 At[4][2], B0[2][2], B1[2][2];
    v8i At8[4], B08[2], B18[2];
    const char* cA = cur.A; const char* cB = cur.B;
    PG8_STAGE(PG8_SB(0, 0), cB, voffB); PG8_STAGE_B1(PG8_SB(0, 1), cB + hstepB); PG8_STAGE_A(PG8_SA(0, 0), false, 0, cA, 0); PG8_STAGE_A(PG8_SA(0, 1), false, 1, cA, 0);
    if (wr == 1) PG8_BAR;
    PG8_WAIT_V(2); PG8_BAR;
    PG8_STAGE(PG8_SB(1, 0), cB + kstep, voffB); PG8_STAGE_A(PG8_SA(1, 0), false, 0, cA, kstep); PG8_STAGE_B1(PG8_SB(1, 1), cB + hstepB + kstep);
    if constexpr (NARROW) PG8_WAIT_V(4); else PG8_WAIT_V(6);
    PG8_BAR;
    for (;;) {
        nxt.e = cur.e;
        const bool has_next = S.next(ui + 1, nxt);
        rows_of(has_next ? nxt : cur, ui + 1);
        const char* nA = has_next ? nxt.A : cA; const char* nB = has_next ? nxt.B : cB;
#pragma unroll 1
        for (int t = 0; t < nt; t += 2) {
            const bool last = (t == nt - 2);
            const size_t k1 = (size_t)(t + 1) * kstep;
            const char* a2 = last ? nA : cA; const size_t k2 = last ? 0 : (size_t)(t + 2) * kstep;
            const char* b2 = last ? nB : cB + (size_t)(t + 2) * kstep;
            const char* b3 = b2 + kstep;
            PG8_LDB(B0, 0, 0); PG8_LDB(B1, 0, 1); PG8_SCHED; PG8_LDA(At, 0, 0); PG8_STAGE_A(PG8_SA(1, 1), false, 1, cA, k1);
            if constexpr (NARROW) PG8_WAIT_V(6); else PG8_WAIT_V(8);
            PG8_WAIT_L(0); PG8_BAR; PG8_MMA(0, 0, At, B0); PG8_MMA(0, 1, At, B1); PG8_BAR; PG8_SCHED;
            PG8_LDA(At, 0, 1); PG8_STAGE(PG8_SB(0, 0), b2, voffB); PG8_STAGE_B1(PG8_SB(0, 1), b2 + hstepB); PG8_STAGE_A(PG8_SA(0, 0), last, 0, a2, k2);
            if constexpr (NARROW) PG8_WAIT_V(6); else PG8_WAIT_V(8);
            PG8_WAIT_L(0); PG8_BAR; PG8_MMA(1, 0, At, B0); PG8_MMA(1, 1, At, B1); PG8_BAR; PG8_SCHED;
            PG8_LDB(B0, 1, 0); PG8_LDB(B1, 1, 1); PG8_SCHED; PG8_LDA(At, 1, 0); PG8_STAGE_A(PG8_SA(0, 1), last, 1, a2, k2);
            if constexpr (NARROW) PG8_WAIT_V(6); else PG8_WAIT_V(8);
            PG8_WAIT_L(0); PG8_BAR; PG8_MMA(0, 0, At, B0); PG8_MMA(0, 1, At, B1); PG8_BAR; PG8_SCHED;
            PG8_LDA(At, 1, 1); PG8_STAGE(PG8_SB(1, 0), b3, voffB); PG8_STAGE_B1(PG8_SB(1, 1), b3 + hstepB); PG8_STAGE_A(PG8_SA(1, 0), last, 0, a2, k2 + kstep);
            if constexpr (NARROW) PG8_WAIT_V(6); else PG8_WAIT_V(8);
            PG8_WAIT_L(0); PG8_BAR; PG8_MMA(1, 0, At, B0); PG8_MMA(1, 1, At, B1); PG8_BAR; PG8_SCHED;
        }
        if constexpr (ALIGN_EPI) { if (wr == 0) PG8_BAR; }
        E(acc, cur, wr, wc, fr, fq);
        if (!has_next) break;
#pragma unroll
        for (int a = 0; a < 2; ++a)
#pragma unroll
            for (int b = 0; b < 2; ++b)
#pragma unroll
                for (int m = 0; m < 4; ++m)
#pragma unroll
                    for (int n = 0; n < 2; ++n) acc[a][b][m][n] = (f32x4){0.f, 0.f, 0.f, 0.f};
        cur = nxt; cA = nA; cB = nB; ++ui;
        if constexpr (ALIGN_EPI) { if (wr == 1) PG8_BAR; }
    }
    PG8_WAIT_V(0);
    if constexpr (!ALIGN_EPI) { if (wr == 0) PG8_BAR; }
    PG8_BAR;
#undef PG8_SA
#undef PG8_SB
#undef PG8_STAGE
#undef PG8_STAGE_A
#undef PG8_STAGE_B1
#undef PG8_LDA
#undef PG8_LD16
#undef PG8_DSR
#undef PG8_LDB
#undef PG8_MMA
#undef PG8_WAIT_V
#undef PG8_WAIT_L
#undef PG8_BAR
#undef PG8_SCHED
}

struct DenseSched {
    const char* A; const char* B; int nM, nN, K, G, c;
    __device__ __forceinline__ bool next(int i, Unit& u) const {
        const int nwg = nM * nN; const long L = (long)i * G + c; if (L >= nwg) return false;
        const int wgid = xcd_remap((int)L, nwg);
        const int nig = 8 * nN, gid = wgid / nig, fm = gid * 8, gsz = (nM - fm) < 8 ? (nM - fm) : 8;
        const int pm = fm + ((wgid % nig) % gsz), pn = (wgid % nig) / gsz;
        u.A = A + (size_t)pm * 256 * K * 2; u.B = B + (size_t)pn * 256 * K * 2; u.rowmap = nullptr; u.nvalid = 0; u.m0 = 0; u.row0 = pm * 256; u.col0 = pn * 256; u.pos0 = 0;
        return true;
    }
};
}

struct FPX { bf16_t* PX; __device__ __forceinline__ void operator()(const pg8::Unit& u, int lr, int lc, f32x4 v0, f32x4 v1) const {
    *(u32x4*)(PX + (size_t)(u.row0 + lr) * INP + u.col0 + lc) = mk4u(pk2(v0[0], v0[1]), pk2(v0[2], v0[3]), pk2(v1[0], v1[1]), pk2(v1[2], v1[3])); } };
struct FX1 { const float* x; const float* mod; float* X1; __device__ __forceinline__ void operator()(const pg8::Unit& u, int lr, int lc, f32x4 v0, f32x4 v1) const {
    const int row = u.row0 + lr, col = u.col0 + lc; const float* xp = x + (size_t)row * D + col; const float* gp = mod + (size_t)(row >> 12) * 12288 + 2 * D + col; float* op = X1 + (size_t)row * D + col;
    *(f32x4*)op = *(const f32x4*)xp + *(const f32x4*)gp * v0; *(f32x4*)(op + 4) = *(const f32x4*)(xp + 4) + *(const f32x4*)(gp + 4) * v1; } };
constexpr float W1_SCALE = 64.f, W2_SCALE = 32.f;
struct FH1 { unsigned char* H1; __device__ __forceinline__ void operator()(const pg8::Unit& u, int lr, int lc, f32x4 v0, f32x4 v1) const {
    if (u.m0 + lr < u.nvalid) { float h[4];
#pragma unroll
        for (int e = 0; e < 4; ++e) { const float g = v0[e] * (1.f / W1_SCALE); h[e] = g * sigmoidf_(g) * (v1[e] * (1.f / W1_SCALE)); }
        *(unsigned*)(H1 + (unsigned)((u.pos0 + u.m0 + lr) * EFF + ((u.col0 + lc) >> 1))) = pk4_fp8(h[0], h[1], h[2], h[3]); } } };
struct FEO { unsigned char* EO; __device__ __forceinline__ void operator()(const pg8::Unit& u, int lr, int lc, f32x4 v0, f32x4 v1) const {
    if (u.m0 + lr < u.nvalid) { v0 *= (1.f / W2_SCALE); v1 *= (1.f / W2_SCALE);
        *(u32x2*)(EO + (unsigned)((u.pos0 + u.m0 + lr) * D + u.col0 + lc)) = mk2u(pk4_fp8(v0[0], v0[1], v0[2], v0[3]), pk4_fp8(v1[0], v1[1], v1[2], v1[3])); } } };

struct ConvJob { const float* src; bf16_t* dst; int K, N, ld, mode, ntk, ntn; size_t sbs, dbs; };
__device__ __forceinline__ int conv_row(int n, int mode) { return mode == 0 ? n : (8 * (n >> 2) + (n & 3) + (mode == 2 ? 4 : 0)); }

struct TileCtx { const float* src; bf16_t* dst; int N, ld, mode, k0, n0; };
constexpr int CT0 = 0, CT1 = CT0 + 8 * (INC / 64), CT2 = CT1 + 8 * 32, CT3 = CT2 + 64 * 64, CT4 = CT3 + 64 * 64, CT5 = CT4 + 64 * 64, CT6 = CT5 + 64, CT7 = CT6 + 64, CT8 = CT7 + 64, CT_END = CT8 + 16;
__device__ __forceinline__ void conv_decode(const Params& p, int g, const float*& src, bf16_t*& dst, int& N, int& ld, int& mode, int& k0, int& n0) {
    unsigned char* WTE1 = p.ws + OFF_WTE1; unsigned char* WTE2 = p.ws + OFF_WTE2;
    unsigned char* d8; int t, ntk, ntn; size_t sbs = 0, dbs = 0;
    if (g < CT1)      { t = g - CT0; src = p.w_in; d8 = p.ws + OFF_WTIN; N = INC; ld = 4096; mode = 0; ntk = 8; ntn = INC / 64; }
    else if (g < CT2) { t = g - CT1; src = p.w_out; d8 = p.ws + OFF_WTOUT; N = 2048; ld = 4096; mode = 0; ntk = 8; ntn = 32; }
    else if (g < CT3) { t = g - CT2; src = p.e_gate; d8 = WTE1; N = 512; ld = 2048; mode = 5; ntk = 8; ntn = 8; sbs = (size_t)2048 * 512; dbs = (size_t)1024 * 2048; }
    else if (g < CT4) { t = g - CT3; src = p.e_up; d8 = WTE1; N = 512; ld = 2048; mode = 6; ntk = 8; ntn = 8; sbs = (size_t)2048 * 512; dbs = (size_t)1024 * 2048; }
    else if (g < CT5) { t = g - CT4; src = p.e_down; d8 = WTE2; N = 2048; ld = 512; mode = 4; ntk = 2; ntn = 32; sbs = (size_t)512 * 2048; dbs = (size_t)2048 * 512; }
    else if (g < CT6) { t = g - CT5; src = p.s_gate; d8 = WTE1 + (size_t)64 * 1024 * 2048; N = 512; ld = 2048; mode = 5; ntk = 8; ntn = 8; }
    else if (g < CT7) { t = g - CT6; src = p.s_up; d8 = WTE1 + (size_t)64 * 1024 * 2048; N = 512; ld = 2048; mode = 6; ntk = 8; ntn = 8; }
    else if (g < CT8) { t = g - CT7; src = p.s_down; d8 = WTE2 + (size_t)64 * 2048 * 512; N = 2048; ld = 512; mode = 4; ntk = 2; ntn = 32; }
    else              { t = g - CT8; src = p.gate_up; d8 = p.ws + OFF_WTGU; N = 1024; ld = 512; mode = 0; ntk = 1; ntn = 16; }
    const int per = ntk * ntn, bi = t / per, rem = t - bi * per, kt = rem / ntn, ntile = rem - kt * ntn;
    src += (size_t)bi * sbs; dst = (bf16_t*)(d8 + (size_t)bi * dbs); k0 = kt * 256; n0 = ntile * 64;
}
__device__ __forceinline__ void conv_load(const float* src, int N, int k0, int n0, f32x4 (&v)[4][2], int tid) {
    const int kr = tid >> 3, nc = (tid & 7) * 8;
#pragma unroll
    for (int s = 0; s < 4; ++s) { const float* q = src + (size_t)(k0 + s * 64 + kr) * N + n0 + nc; v[s][0] = *(const f32x4*)q; v[s][1] = *(const f32x4*)(q + 4); }
}
__device__ __forceinline__ void conv_finish(LDSP unsigned char* lds, bf16_t* dst, int ld, int mode, int k0, int n0, const f32x4 (&v)[4][2], int tid) {
    LDSP float* Tm = (LDSP float*)lds;
    {
        const int kr = tid >> 3, nc = (tid & 7) * 8;
#pragma unroll
        for (int s = 0; s < 4; ++s) { LDSP float* q = Tm + (s * 64 + kr) * 65 + nc;
            q[0] = v[s][0].x; q[1] = v[s][0].y; q[2] = v[s][0].z; q[3] = v[s][0].w; q[4] = v[s][1].x; q[5] = v[s][1].y; q[6] = v[s][1].z; q[7] = v[s][1].w; }
    }
    __syncthreads();
    {
        const int n = tid >> 3; bf16_t* drow = (bf16_t*)((unsigned char*)dst + (size_t)conv_row(n0 + n, mode & 3) * ld) + k0;
#pragma unroll
        for (int s = 0; s < 4; ++s) { const int kc = ((tid & 7) + 8 * s) * 8; float f[8];
#pragma unroll
            for (int j = 0; j < 8; ++j) f[j] = Tm[(kc + j) * 65 + n];
            u32x4 w; w.x = pk2(f[0], f[1]); w.y = pk2(f[2], f[3]); w.z = pk2(f[4], f[5]); w.w = pk2(f[6], f[7]); *(u32x4*)(drow + kc) = w; }
    }
    __syncthreads();
}

__device__ __forceinline__ void mod_item(LDSP unsigned char* lds, const Params& p, int item) {
    const int kb = item >> 6, nb = item & 63, tid = opaque(threadIdx.x), wid = tid >> 6, lane = tid & 63;
    f32x4 acc[3];
#pragma unroll
    for (int v = 0; v < 3; ++v) acc[v] = mk4f(0.f, 0.f, 0.f, 0.f);
    if (lane < 48) {
#pragma unroll 8
        for (int i = 0; i < 64; ++i) {
            const int k = kb * 512 + wid * 64 + i;
            const float c0 = p.c[k], c1 = p.c[D + k], c2 = p.c_ctx[k];
            const float s0 = c0 * sigmoidf_(c0), s1 = c1 * sigmoidf_(c1), s2 = c2 * sigmoidf_(c2);
            const f32x4 w = *(const f32x4*)(p.w_mod + (size_t)k * 12288 + nb * 192 + 4 * lane);
            acc[0] += s0 * w; acc[1] += s1 * w; acc[2] += s2 * w;
        }
    }
    LDSP float* R = (LDSP float*)lds;
    if (lane < 48) {
#pragma unroll
        for (int v = 0; v < 3; ++v) *(LDSP f32x4*)(R + (wid * 3 + v) * 192 + 4 * lane) = acc[v];
    }
    __syncthreads();
    float* MODP = (float*)(p.ws + OFF_MODP);
    for (int o = tid; o < 3 * 192; o += 512) { const int v = o / 192, cidx = o - v * 192; float sum = 0.f;
#pragma unroll
        for (int w = 0; w < 8; ++w) sum += R[(w * 3 + v) * 192 + cidx];
        MODP[((size_t)kb * 3 + v) * 12288 + nb * 192 + cidx] = sum; }
    __syncthreads();
}

__device__ __forceinline__ void conv_range(LDSP unsigned char* lds, const Params& p, int g0, int g1, int rank, int nblk) {
    const int tid = opaque(threadIdx.x);
    int g = g0 + rank;
    const float* csrc = nullptr; bf16_t* cdst = nullptr; int cN = 0, cld = 0, cmode = 0, ck0 = 0, cn0 = 0;
    const float* nsrc = nullptr; bf16_t* ndst = nullptr; int nN = 0, nld = 0, nmode = 0, nk0 = 0, nn0 = 0;
    f32x4 va[4][2], vb[4][2];
    if (g < g1) { conv_decode(p, g, csrc, cdst, cN, cld, cmode, ck0, cn0); conv_load(csrc, cN, ck0, cn0, va, tid); }
#pragma unroll 1
    while (g < g1) {
        const int gn = g + nblk;
        if (gn < g1) { conv_decode(p, gn, nsrc, ndst, nN, nld, nmode, nk0, nn0); conv_load(nsrc, nN, nk0, nn0, vb, tid); }
        conv_finish(lds, cdst, cld, cmode, ck0, cn0, va, tid);
        cdst = ndst; cld = nld; cmode = nmode; ck0 = nk0; cn0 = nn0; g = gn;
#pragma unroll
        for (int s = 0; s < 4; ++s) { va[s][0] = vb[s][0]; va[s][1] = vb[s][1]; }
    }
}

__device__ __forceinline__ void phase0(LDSP unsigned char* lds, const Params& p) {
    const int tid = opaque(threadIdx.x);
    for (int it = blockIdx.x; it < 256; it += gridDim.x) mod_item(lds, p, it);
    conv_range(lds, p, 0, CT1, blockIdx.x, gridDim.x);
    conv_range(lds, p, CT8, CT_END, blockIdx.x, gridDim.x);
    {
        const int total = 4 * 1024 * 128;
        for (int idx = blockIdx.x * 512 + tid; idx < total; idx += gridDim.x * 512) {
            const int mtx = idx >> 17, rem = idx & 131071, n = rem >> 7, k = rem & 127;
            const float* src = (mtx < 2 ? p.decay_up : p.iclr_up) + (size_t)(mtx & 1) * 96 * 1024;
            bf16_t* dst = (bf16_t*)(p.ws + (mtx < 2 ? OFF_WTDU : OFF_WTIU)) + (size_t)(mtx & 1) * 1024 * 128;
            dst[n * 128 + k] = (bf16_t)f2bf(k < 96 ? src[(size_t)k * 1024 + n] : 0.f);
        }
    }
    {
        u32x4* z = (u32x4*)((bf16_t*)(p.ws + OFF_WTIN) + (size_t)INC * D);
        const int total = (INP - INC) * D * 2 / 16;
        for (int idx = blockIdx.x * 512 + tid; idx < total; idx += gridDim.x * 512) z[idx] = mk4u(0, 0, 0, 0);
    }
    if (blockIdx.x == gridDim.x - 1) {
        float2* R = (float2*)(p.ws + OFF_ROPE);
        for (int idx = tid; idx < 1024; idx += 512) { const int pos = idx >> 4, f = idx & 15;
            const float freq = powf(10000.f, -(float)f / 16.f); const float ang = (float)pos * freq; R[idx] = make_float2(cosf(ang), sinf(ang)); }
    }
}

__device__ __forceinline__ void phase1(LDSP unsigned char* lds, const Params& p) {
    const int tid = opaque(threadIdx.x), wid = tid >> 6, lane = tid & 63;
    const float* MODP = (const float*)(p.ws + OFF_MODP);
    float* MOD = (float*)(p.ws + OFF_MOD);
    LDSP float* MV = (LDSP float*)lds;
    for (int idx = tid; idx < 3 * 4096; idx += 512) { const int v = idx >> 12, col = idx & 4095; float s = p.b_mod[col];
#pragma unroll
        for (int kb = 0; kb < 4; ++kb) s += MODP[((size_t)kb * 3 + v) * 12288 + col];
        MV[idx] = s; }
    for (int idx = blockIdx.x * 512 + tid; idx < 3 * 12288; idx += gridDim.x * 512) { const int v = idx / 12288, col = idx - v * 12288; float s = p.b_mod[col];
#pragma unroll
        for (int kb = 0; kb < 4; ++kb) s += MODP[((size_t)kb * 3 + v) * 12288 + col];
        MOD[idx] = s; }
    __syncthreads();
    bf16_t* HX = (bf16_t*)(p.ws + OFF_HX);
    for (int row = blockIdx.x * 8 + wid; row < NR; row += gridDim.x * 8) {
        const float* src = row < NX ? p.x + (size_t)row * D : p.ctx + (size_t)(row - NX) * D;
        const int v = row < NX ? (row >> 12) : 2;
        f32x4 xv[8]; float ss = 0.f;
#pragma unroll
        for (int i = 0; i < 8; ++i) { xv[i] = ((const f32x4*)src)[lane + 64 * i]; ss += xv[i].x * xv[i].x + xv[i].y * xv[i].y + xv[i].z * xv[i].z + xv[i].w * xv[i].w; }
        ss = wave_sum(ss);
        const float rs = rsqrtf(ss * (1.f / D) + 1e-6f);
#pragma unroll
        for (int i = 0; i < 8; ++i) { const int col = 4 * (lane + 64 * i);
            const f32x4 g = *(const f32x4*)(p.norm1_g + col); const LDSP float* sh = MV + v * 4096 + col; const LDSP float* sc = sh + 2048;
            const float h0 = xv[i].x * rs * g.x * (1.f + sc[0]) + sh[0], h1 = xv[i].y * rs * g.y * (1.f + sc[1]) + sh[1];
            const float h2 = xv[i].z * rs * g.z * (1.f + sc[2]) + sh[2], h3 = xv[i].w * rs * g.w * (1.f + sc[3]) + sh[3];
            u32x2 w; w.x = pk2(h0, h1); w.y = pk2(h2, h3); *(u32x2*)(HX + (size_t)row * D + col) = w; }
    }
}

__device__ __forceinline__ void phase2(LDSP unsigned char* lds, const Params& p) {
    pg8::Epi<FPX> epi{FPX{(bf16_t*)(p.ws + OFF_PX)}};
    pg8::DenseSched S{(const char*)(p.ws + OFF_HX), (const char*)(p.ws + OFF_WTIN), NR / 256, INP / 256, D, (int)gridDim.x, (int)blockIdx.x};
    pg8::gemm_phase<false>(lds, D, S, epi);
}

__device__ __forceinline__ void phaseR1(LDSP unsigned char* lds, const Params& p) {
    const int tid = opaque(threadIdx.x), wid = tid >> 6, lane = tid & 63;
    const bf16_t* PX = (const bf16_t*)(p.ws + OFF_PX);
    for (int row = blockIdx.x * 8 + wid; row < NR; row += gridDim.x * 8) {
        const bool isx = row < NX;
        const int s0 = isx ? (row & ~(T - 1)) : NX + ((row - NX) & ~(CL - 1)), len = isx ? T : CL;
        const bool hp = row > s0, hn = row + 1 < s0 + len;
        const bf16_t* pc = PX + (size_t)row * INP;
#pragma unroll 1
        for (int it = 0; it < 7; ++it) {
            const int ch = lane + 64 * it;
            if (ch < 440) {
                const int col = ch * 8;
                const u32x4 c4 = *(const u32x4*)(pc + col);
                u32x4 p4 = mk4u(0, 0, 0, 0), n4 = mk4u(0, 0, 0, 0);
                if (hp) p4 = *(const u32x4*)(pc - INP + col);
                if (hn) n4 = *(const u32x4*)(pc + INP + col);
                const f32x4 m0 = *(const f32x4*)(p.shift_mu + col), m1 = *(const f32x4*)(p.shift_mu + col + 4);
                const float mu[8] = {m0.x, m0.y, m0.z, m0.w, m1.x, m1.y, m1.z, m1.w};
                const unsigned cw[4] = {c4.x, c4.y, c4.z, c4.w}, pw[4] = {p4.x, p4.y, p4.z, p4.w}, nw[4] = {n4.x, n4.y, n4.z, n4.w};
                float v[8];
#pragma unroll
                for (int j = 0; j < 4; ++j) {
                    const float c0 = bf2f(cw[j] & 0xffff), c1 = bf2f(cw[j] >> 16);
                    v[2 * j] = c0 + mu[2 * j] * (0.5f * (bf2f(pw[j] & 0xffff) + bf2f(nw[j] & 0xffff)) - c0);
                    v[2 * j + 1] = c1 + mu[2 * j + 1] * (0.5f * (bf2f(pw[j] >> 16) + bf2f(nw[j] >> 16)) - c1);
                }
                if (it < 2) {
                    *(u32x4*)((bf16_t*)(p.ws + OFF_RS) + (size_t)row * 1024 + col) = mk4u(pk2(v[0], v[1]), pk2(v[2], v[3]), pk2(v[4], v[5]), pk2(v[6], v[7]));
                } else if (it < 4) {
                    const int kc = col - C_K;
                    *(u32x4*)((bf16_t*)(p.ws + OFF_KS) + (size_t)row * 1024 + kc) = mk4u(pk2(v[0], v[1]), pk2(v[2], v[3]), pk2(v[4], v[5]), pk2(v[6], v[7]));
                    const f32x4 k0 = *(const f32x4*)(p.k_k + kc), k1 = *(const f32x4*)(p.k_k + kc + 4);
                    const float kq[8] = {k0.x, k0.y, k0.z, k0.w, k1.x, k1.y, k1.z, k1.w};
                    float ss = 0.f;
#pragma unroll
                    for (int j = 0; j < 8; ++j) { v[j] *= kq[j]; ss += v[j] * v[j]; }
                    ss += shx(ss, 1); ss += shx(ss, 2); ss += shx(ss, 4);
                    const float sc = rsqrtf(ss + 1e-12f);
                    *(u32x4*)((bf16_t*)(p.ws + OFF_KK) + (size_t)row * 1024 + kc) = mk4u(pk2(v[0] * sc, v[1] * sc), pk2(v[2] * sc, v[3] * sc), pk2(v[4] * sc, v[5] * sc), pk2(v[6] * sc, v[7] * sc));
                } else if (it < 6) {
                    *(u32x4*)((bf16_t*)(p.ws + OFF_VS) + (size_t)row * 1024 + col - C_V) = mk4u(pk2(v[0], v[1]), pk2(v[2], v[3]), pk2(v[4], v[5]), pk2(v[6], v[7]));
                } else if (ch < 396) {
#pragma unroll
                    for (int j = 0; j < 8; ++j) v[j] = tanhf(v[j]);
                    *(u32x4*)((bf16_t*)(p.ws + OFF_TW) + (size_t)row * 128 + col - C_XW) = mk4u(pk2(v[0], v[1]), pk2(v[2], v[3]), pk2(v[4], v[5]), pk2(v[6], v[7]));
                } else if (ch < 408) {
                    *(u32x4*)((bf16_t*)(p.ws + OFF_XA) + (size_t)row * 128 + col - C_XA) = mk4u(pk2(v[0], v[1]), pk2(v[2], v[3]), pk2(v[4], v[5]), pk2(v[6], v[7]));
                } else if (isx) {
#pragma unroll
                    for (int j = 0; j < 8; ++j) v[j] = sigmoidf_(v[j]);
                    *(u32x4*)((bf16_t*)(p.ws + OFF_SG) + (size_t)row * 256 + col - C_XG) = mk4u(pk2(v[0], v[1]), pk2(v[2], v[3]), pk2(v[4], v[5]), pk2(v[6], v[7]));
                }
            }
        }
        if (lane < 4) { *(u32x4*)((bf16_t*)(p.ws + OFF_TW) + (size_t)row * 128 + 96 + lane * 8) = mk4u(0, 0, 0, 0); *(u32x4*)((bf16_t*)(p.ws + OFF_XA) + (size_t)row * 128 + 96 + lane * 8) = mk4u(0, 0, 0, 0); }
    }
}

struct LoraSched {
    const char *A0, *B0, *A1, *B1; int G, c;
    __device__ __forceinline__ bool next(int i, pg8::Unit& u) const {
        const int per = (NR / 256) * 8; const long L = (long)i * G + c; if (L >= 2 * per) return false;
        const int job = (int)L / per, w = (int)L % per, pm = w >> 3, pn = w & 7;
        u.A = (job ? A1 : A0) + (size_t)pm * 256 * 128 * 2; u.B = (job ? B1 : B0) + (size_t)pn * 256 * 128 * 2; u.rowmap = nullptr; u.nvalid = 0; u.m0 = 0; u.row0 = pm * 256; u.col0 = pn * 256; u.pos0 = job;
        return true;
    }
};
struct FLORA { const float* dbias; const float* ibias; bf16_t* LWG; bf16_t* AIG; __device__ __forceinline__ void operator()(const pg8::Unit& u, int lr, int lc, f32x4 v0, f32x4 v1) const {
    const int row = u.row0 + lr, col = u.col0 + lc;
    const float* bp = (u.pos0 == 0 ? dbias : ibias) + col; const f32x4 b0 = *(const f32x4*)bp, b1 = *(const f32x4*)(bp + 4);
    const float sc = (u.pos0 == 0) ? -0.60653065971f : 1.f;
    float o[8];
#pragma unroll
    for (int e = 0; e < 4; ++e) { o[e] = sc * sigmoidf_(b0[e] + v0[e]); o[4 + e] = sc * sigmoidf_(b1[e] + v1[e]); }
    *(u32x4*)((u.pos0 == 0 ? LWG : AIG) + (size_t)row * 2048 + col) = mk4u(pk2(o[0], o[1]), pk2(o[2], o[3]), pk2(o[4], o[5]), pk2(o[6], o[7]));
} };
struct FGG { bf16_t* GG; __device__ __forceinline__ void operator()(const pg8::Unit& u, int lr, int lc, f32x4 v0, f32x4 v1) const {
    *(u32x4*)(GG + (size_t)(u.row0 + lr) * 1024 + u.col0 + lc) = mk4u(pk2(v0[0], v0[1]), pk2(v0[2], v0[3]), pk2(v1[0], v1[1]), pk2(v1[2], v1[3])); } };

__device__ __forceinline__ int inst_index(int b, int h, int d, int chunk) { return ((b * 16 + h) * 2 + d) * NCHUNK + chunk; }

constexpr int LA_K = 0  , LA_VT = 73728  , LA_END = LA_VT + 18 * 4608;
static_assert(LA_END <= SMEM_BYTES, "attention LDS map");

__device__ __forceinline__ void attn_unit(LDSP unsigned char* lds, const Params& p, int unit) {
    const int tid = opaque(threadIdx.x), wid = tid >> 6, lane = tid & 63;
    const int b = unit >> 8, kvh = (unit >> 6) & 3, qb = unit & 63, q0 = qb * 64;
    const bf16_t* PX = (const bf16_t*)(p.ws + OFF_PX);
    const float2* ROPE = (const float2*)(p.ws + OFF_ROPE);
    {
        u32x4 kx1[5], kx2[5];
#pragma unroll
        for (int it = 0; it < 5; ++it) {
            const int task = tid + 512 * it; kx1[it] = mk4u(0, 0, 0, 0); kx2[it] = mk4u(0, 0, 0, 0);
            if (task < 576 * 4) {
                const int key = task >> 2, pr = task & 3, c0 = (pr & 1) + 4 * (pr >> 1);
                const int pos = q0 - 128 + key;
                const bool lat = key < 320;
                if (!lat || (pos >= 0 && pos < T)) {
                    const bf16_t* src = PX + (size_t)(lat ? (b * T + pos) : (NX + b * CL + (key - 320))) * INP + C_AK + kvh * 64 + c0 * 8;
                    kx1[it] = *(const u32x4*)src; kx2[it] = *(const u32x4*)(src + 16);
                }
            }
        }
#pragma unroll
        for (int it = 0; it < 5; ++it) {
            const int task = tid + 512 * it;
            if (task < 576 * 4) {
                const int key = task >> 2, pr = task & 3, c0 = (pr & 1) + 4 * (pr >> 1);
                u32x4 w0 = kx1[it], w1 = kx2[it];
                if (key < 320) {
                    const int pos = q0 - 128 + key;
                    if (pos >= 0 && pos < T) {
                        const int ppos = (pr < 2) ? (pos >> 6) : (pos & 63);
                        const float2* tb = ROPE + ppos * 16 + (pr & 1) * 8;
                        const unsigned a1[4] = {w0.x, w0.y, w0.z, w0.w}, a2[4] = {w1.x, w1.y, w1.z, w1.w};
                        unsigned o1[4], o2[4];
#pragma unroll
                        for (int j = 0; j < 4; ++j) {
                            const float2 cs0 = tb[2 * j], cs1 = tb[2 * j + 1];
                            const float u0 = bf2f(a1[j] & 0xffff), u1 = bf2f(a1[j] >> 16), v0 = bf2f(a2[j] & 0xffff), v1 = bf2f(a2[j] >> 16);
                            o1[j] = pk2(u0 * cs0.x - v0 * cs0.y, u1 * cs1.x - v1 * cs1.y);
                            o2[j] = pk2(v0 * cs0.x + u0 * cs0.y, v1 * cs1.x + u1 * cs1.y);
                        }
                        w0 = mk4u(o1[0], o1[1], o1[2], o1[3]); w1 = mk4u(o2[0], o2[1], o2[2], o2[3]);
                    }
                }
                *(LDSP u32x4*)(lds + LA_K + sw64(key, c0 * 8)) = w0;
                *(LDSP u32x4*)(lds + LA_K + sw64(key, c0 * 8 + 16)) = w1;
            }
        }
    }
    {
        u32x4 vx[3][4];
#pragma unroll
        for (int it = 0; it < 3; ++it) {
            const int task = tid + 512 * it;
#pragma unroll
            for (int q = 0; q < 4; ++q) {
                vx[it][q] = mk4u(0, 0, 0, 0);
                if (task < 144 * 8) {
                    const int kg = task >> 3, dc = task & 7, key = kg * 4 + q;
                    if (key < 320) { const int pos = q0 - 128 + key; if (pos >= 0 && pos < T) vx[it][q] = *(const u32x4*)(PX + (size_t)(b * T + pos) * INP + C_AV + kvh * 64 + dc * 8); }
                    else vx[it][q] = *(const u32x4*)(PX + (size_t)(NX + b * CL + (key - 320)) * INP + C_AV + kvh * 64 + dc * 8);
                }
            }
        }
#pragma unroll
        for (int it = 0; it < 3; ++it) {
            const int task = tid + 512 * it;
            if (task < 144 * 8) {
                const int kg = task >> 3, dc = task & 7;
                unsigned short e[4][8];
#pragma unroll
                for (int q = 0; q < 4; ++q) { const u32x4 w = vx[it][q];
                    e[q][0] = w.x & 0xffff; e[q][1] = w.x >> 16; e[q][2] = w.y & 0xffff; e[q][3] = w.y >> 16; e[q][4] = w.z & 0xffff; e[q][5] = w.z >> 16; e[q][6] = w.w & 0xffff; e[q][7] = w.w >> 16; }
                const int tile = kg >> 3, kin = (kg & 7) * 4;
#pragma unroll
                for (int j = 0; j < 8; ++j) { u32x2 w; w.x = (unsigned)e[0][j] | ((unsigned)e[1][j] << 16); w.y = (unsigned)e[2][j] | ((unsigned)e[3][j] << 16);
                    *(LDSP u32x2*)(lds + LA_VT + tile * 4608 + (dc * 8 + j) * 72 + kin * 2) = w; }
            }
        }
    }
    const int hq = kvh * 4 + (wid >> 1), qs = (wid & 1) * 32, r = lane & 31, hh = lane >> 5;
    const int qpos = q0 + qs + r;
    bf16x8 qf[4];
    {
        const bf16_t* src = PX + (size_t)(b * T + qpos) * INP + C_Q + hq * 64 + 8 * hh;
        u32x4 raw[4];
#pragma unroll
        for (int s = 0; s < 4; ++s) raw[s] = *(const u32x4*)(src + 16 * s);
#pragma unroll
        for (int pr = 0; pr < 2; ++pr) {
            const int ppos = pr == 0 ? (qpos >> 6) : (qpos & 63);
            const float2* tb = ROPE + ppos * 16 + 8 * hh;
            const unsigned a1[4] = {raw[2 * pr].x, raw[2 * pr].y, raw[2 * pr].z, raw[2 * pr].w}, a2[4] = {raw[2 * pr + 1].x, raw[2 * pr + 1].y, raw[2 * pr + 1].z, raw[2 * pr + 1].w};
            unsigned o1[4], o2[4];
#pragma unroll
            for (int j = 0; j < 4; ++j) {
                const float2 cs0 = tb[2 * j], cs1 = tb[2 * j + 1];
                const float u0 = bf2f(a1[j] & 0xffff), u1 = bf2f(a1[j] >> 16), v0 = bf2f(a2[j] & 0xffff), v1 = bf2f(a2[j] >> 16);
                o1[j] = pk2(0.125f * (u0 * cs0.x - v0 * cs0.y), 0.125f * (u1 * cs1.x - v1 * cs1.y));
                o2[j] = pk2(0.125f * (v0 * cs0.x + u0 * cs0.y), 0.125f * (v1 * cs1.x + u1 * cs1.y));
            }
            const u32x4 w1 = mk4u(o1[0], o1[1], o1[2], o1[3]), w2 = mk4u(o2[0], o2[1], o2[2], o2[3]);
            qf[2 * pr] = __builtin_bit_cast(bf16x8, w1); qf[2 * pr + 1] = __builtin_bit_cast(bf16x8, w2);
        }
    }
    __syncthreads();
    float m = p.attn_sink[hq], l = 1.f;
    f32x16 o0 = zero16(), o1 = zero16();
    for (int tl = 0; tl < 18; ++tl) {
        f32x16 st = zero16();
#pragma unroll
        for (int s = 0; s < 4; ++s) {
            const bf16x8 kf = *(const LDSP bf16x8*)(lds + LA_K + sw64(32 * tl + r, 16 * s + 8 * hh));
            st = __builtin_amdgcn_mfma_f32_32x32x16_bf16(kf, qf[s], st, 0, 0, 0);
        }
        const int kp0 = q0 - 128 + 32 * tl, qlo = q0 + qs;
        if (tl < 10 && (qlo + 31 - kp0 > 128 || qlo - (kp0 + 31) < -128 || kp0 < 0 || kp0 + 31 >= T)) {
#pragma unroll
            for (int g = 0; g < 16; ++g) { const int kp = q0 - 128 + 32 * tl + crow(g, hh); const int dlt = qpos - kp;
                const bool ok = (dlt <= 128) && (dlt >= -128) && (kp >= 0) && (kp < T); st[g] = ok ? st[g] : -1e30f; }
        }
        float mt = st[0];
#pragma unroll
        for (int g = 1; g < 16; ++g) mt = fmaxf(mt, st[g]);
        mt = fmaxf(mt, shx(mt, 32));
        const float mn = fmaxf(m, mt), alpha = __expf(m - mn);
        float ps = 0.f;
#pragma unroll
        for (int g = 0; g < 16; ++g) { st[g] = __expf(st[g] - mn); ps += st[g]; }
        ps += shx(ps, 32);
        l = l * alpha + ps; m = mn;
        if (__any(alpha != 1.f)) {
#pragma unroll
            for (int g = 0; g < 16; ++g) { o0[g] *= alpha; o1[g] *= alpha; }
        }
#pragma unroll
        for (int s2 = 0; s2 < 2; ++s2) {
            const u32x4 pw = mk4u(pk2(st[8 * s2], st[8 * s2 + 1]), pk2(st[8 * s2 + 2], st[8 * s2 + 3]), pk2(st[8 * s2 + 4], st[8 * s2 + 5]), pk2(st[8 * s2 + 6], st[8 * s2 + 7]));
            const bf16x8 pf = __builtin_bit_cast(bf16x8, pw);
#pragma unroll
            for (int dm = 0; dm < 2; ++dm) {
                const LDSP unsigned char* vp = lds + LA_VT + tl * 4608 + (32 * dm + r) * 72 + (16 * s2 + 4 * hh) * 2;
                const u32x2 v0 = *(const LDSP u32x2*)vp, v1 = *(const LDSP u32x2*)(vp + 16);
                const bf16x8 vf = __builtin_bit_cast(bf16x8, mk4u(v0.x, v0.y, v1.x, v1.y));
                if (dm == 0) o0 = __builtin_amdgcn_mfma_f32_32x32x16_bf16(vf, pf, o0, 0, 0, 0); else o1 = __builtin_amdgcn_mfma_f32_32x32x16_bf16(vf, pf, o1, 0, 0, 0);
            }
        }
    }
    {
        const float inv = 1.f / l;
        bf16_t* dst = (bf16_t*)(p.ws + OFF_MIX) + (size_t)(b * T + qpos) * D + 1024 + hq * 64;
#pragma unroll
        for (int gq = 0; gq < 4; ++gq) {
            u32x2 w; w.x = pk2(o0[4 * gq] * inv, o0[4 * gq + 1] * inv); w.y = pk2(o0[4 * gq + 2] * inv, o0[4 * gq + 3] * inv); *(u32x2*)(dst + 8 * gq + 4 * hh) = w;
            u32x2 w2; w2.x = pk2(o1[4 * gq] * inv, o1[4 * gq + 1] * inv); w2.y = pk2(o1[4 * gq + 2] * inv, o1[4 * gq + 3] * inv); *(u32x2*)(dst + 32 + 8 * gq + 4 * hh) = w2;
        }
    }
    __syncthreads();
}

__device__ __forceinline__ void phaseR2(LDSP unsigned char* lds, const Params& p) {
    {
        pg8::Epi<FLORA> epi{FLORA{p.decay_bias, p.iclr_bias, (bf16_t*)(p.ws + OFF_LWG), (bf16_t*)(p.ws + OFF_AIG)}};
        LoraSched S{(const char*)(p.ws + OFF_TW), (const char*)(p.ws + OFF_WTDU), (const char*)(p.ws + OFF_XA), (const char*)(p.ws + OFF_WTIU), (int)gridDim.x, (int)blockIdx.x};
        pg8::gemm_phase<false>(lds, opaque_s(128), S, epi);
    }
    {
        pg8::Epi<FGG> epi{FGG{(bf16_t*)(p.ws + OFF_GG)}};
        pg8::DenseSched S{(const char*)(p.ws + OFF_SG), (const char*)(p.ws + OFF_WTGU), NX / 256, 1024 / 256, 256, (int)gridDim.x, (int)(gridDim.x - 1 - blockIdx.x)};
        pg8::gemm_phase<false>(lds, opaque_s(256), S, epi);
    }
}

constexpr int G_RT = 0, G_VT = 8192, G_X0 = 16384, G_AT = 32768, G_BT = 40960, G_KT = 49152, G_P0 = 57344, G_PT0 = 65536, G_SEG = 73728, G_GL = 74752, G_CNT = 75008, G_BYTES = 79872;
static_assert(2 * G_BYTES <= SMEM_BYTES - 16, "two R3 groups fit the LDS");

__device__ __forceinline__ void gbar(LDSP unsigned* cnt, unsigned& target, int lane) {
    target += 4u;
    asm volatile("s_waitcnt lgkmcnt(0)" ::: "memory");
    if (lane == 0) {
        __hip_atomic_fetch_add(cnt, 1u, __ATOMIC_RELAXED, __HIP_MEMORY_SCOPE_WORKGROUP);
        while (__hip_atomic_load(cnt, __ATOMIC_RELAXED, __HIP_MEMORY_SCOPE_WORKGROUP) < target) __builtin_amdgcn_s_sleep(1);
    }
    asm volatile("" ::: "memory");
}
__device__ __forceinline__ void mask_lt(f32x16& c, int x0, int y, int hh, bool incl) {
#pragma unroll
    for (int g = 0; g < 16; ++g) { const int x = x0 + crow(g, hh); c[g] = (incl ? (x <= y) : (x < y)) ? c[g] : 0.f; }
}

__device__ __forceinline__ void ldf(const unsigned (&FO)[4], unsigned off, bf16x8 (&f)[4]) {
#pragma unroll
    for (int s = 0; s < 4; ++s) f[s] = *LDS_AT(const bf16x8, FO[s] + off);
}
__device__ __forceinline__ void stt(const unsigned (&SO)[4], unsigned off, int xh, const f32x16& acc) {
#pragma unroll
    for (int gq = 0; gq < 4; ++gq) *LDS_AT(u32x2, (SO[gq] ^ ((unsigned)xh << 6)) + off) = mk2u(pk2(acc[4 * gq], acc[4 * gq + 1]), pk2(acc[4 * gq + 2], acc[4 * gq + 3]));
}
__device__ __forceinline__ u32x2 ld8(const unsigned (&SO)[4], int gq, unsigned off, int xh) { return *LDS_AT(const u32x2, (SO[gq] ^ ((unsigned)xh << 6)) + off); }

__device__ __forceinline__ void rwkv_prep_group(LDSP unsigned char* lg, LDSP unsigned* cnt, unsigned& bt, const Params& p, int unit, int wg_in, int lane_in, const unsigned (&FO)[4], const unsigned (&SO)[4]) {
    int seq, c, h, d;
    if (unit < 4096) { seq = unit >> 11; c = (unit >> 5) & 63; h = (unit >> 1) & 15; d = unit & 1; } else { const int u = unit - 4096; seq = 2 + (u >> 7); c = (u >> 5) & 3; h = (u >> 1) & 15; d = u & 1; }
    const bool isx = seq < 2;
    const int b = seq & 1;
    const int s0 = isx ? b * T : NX + b * CL, t0 = c * 64;
    const int chunk_id = isx ? 4 + c : c;
    u32x4 keep_bh[2], keep_kh[2];
#define STAGE_IDS const int lane = opaque(lane_in), wg = opaque(wg_in), r = lane & 31, hh = lane >> 5; (void)r; (void)hh; (void)wg;
    {
        STAGE_IDS
        const int k = lane, seg = wg, hk = h * 64 + k;
        const float kac = p.k_a[hk];
        const bf16_t* RS = (const bf16_t*)(p.ws + OFF_RS); const bf16_t* KS = (const bf16_t*)(p.ws + OFF_KS); const bf16_t* KKp = (const bf16_t*)(p.ws + OFF_KK); const bf16_t* VS = (const bf16_t*)(p.ws + OFF_VS);
        const bf16_t* LWG = (const bf16_t*)(p.ws + OFF_LWG); const bf16_t* AIG = (const bf16_t*)(p.ws + OFF_AIG);
        const int ibase = seg * 16;
        const int rowA = (s0 + t0) + (d ? 63 - ibase : ibase);
        const int sgn = d ? -1 : 1;
        const unsigned o1 = ((unsigned)rowA * 1024u + (unsigned)hk) * 2u, o2 = ((unsigned)rowA * 2048u + (unsigned)(d * 1024 + hk)) * 2u;
        const int st1 = sgn * 2048, st2 = sgn * 4096;
#define LD16(base, off) bf2f(*(const bf16_t*)((const char*)(base) + (unsigned)(off)))
        float lw[16];
        float run = 0.f;
#pragma unroll
        for (int tt = 0; tt < 16; ++tt) { run += LD16(LWG, o2 + tt * st2); lw[tt] = run; }
        LDSP float* SEG = (LDSP float*)(lg + G_SEG);
        SEG[seg * 64 + k] = run;
        gbar(cnt, bt, lane);
        float off = 0.f, gL = 0.f;
#pragma unroll
        for (int s = 0; s < 4; ++s) { const float sv = SEG[s * 64 + k]; if (s < seg) off += sv; gL += sv; }
        if (seg == 0) ((LDSP float*)(lg + G_GL))[k] = gL;
        const float egL = __expf(gL);
#pragma unroll
        for (int q = 0; q < 2; ++q) {
            float rr[8], kr[8], kk[8], vv[8], ai[8];
#pragma unroll
            for (int e = 0; e < 8; ++e) { const int tt = 8 * q + e;
                rr[e] = LD16(RS, o1 + tt * st1); kr[e] = LD16(KS, o1 + tt * st1); kk[e] = LD16(KKp, o1 + tt * st1); vv[e] = LD16(VS, o1 + tt * st1); ai[e] = LD16(AIG, o2 + tt * st2); }
            unsigned wat[4], wbh[4], wkh[4], wv[4];
#pragma unroll
            for (int t2 = 0; t2 < 4; ++t2) {
                const int i0 = ibase + 8 * q + 2 * t2;
                float fat[2], frt[2], fbt[2], fkt[2], fbh[2], fkh[2];
#pragma unroll
                for (int e2 = 0; e2 < 2; ++e2) { const int e = 2 * t2 + e2, tt = 8 * q + e;
                    const float kd = kr[e] * (1.f + (ai[e] - 1.f) * kac), bbv = kk[e] * ai[e];
                    const float g = off + lw[tt], ge = (tt == 0) ? off : off + lw[tt - 1];
                    const float eg = __expf(g), ege = __expf(ge), eng = __builtin_amdgcn_rcpf(eg), egl = egL * eng;
                    fat[e2] = -kk[e] * ege; frt[e2] = rr[e] * eg; fbt[e2] = bbv * eng; fkt[e2] = kd * eng; fbh[e2] = bbv * egl; fkh[e2] = kd * egl; }
                wat[t2] = pk2(fat[0], fat[1]); wbh[t2] = pk2(fbh[0], fbh[1]); wkh[t2] = pk2(fkh[0], fkh[1]); wv[t2] = pk2(vv[2 * t2], vv[2 * t2 + 1]);
                const unsigned wr = pk2(frt[0], frt[1]), wb = pk2(fbt[0], fbt[1]), wk = pk2(fkt[0], fkt[1]);
                *(LDSP bf16_t*)(lg + G_AT + sw64(i0, k)) = (bf16_t)(wat[t2] & 0xffffu); *(LDSP bf16_t*)(lg + G_AT + sw64(i0 + 1, k)) = (bf16_t)(wat[t2] >> 16);
                *(LDSP bf16_t*)(lg + G_RT + sw64(i0, k)) = (bf16_t)(wr & 0xffffu);      *(LDSP bf16_t*)(lg + G_RT + sw64(i0 + 1, k)) = (bf16_t)(wr >> 16);
                *(LDSP bf16_t*)(lg + G_BT + sw64(i0, k)) = (bf16_t)(wb & 0xffffu);      *(LDSP bf16_t*)(lg + G_BT + sw64(i0 + 1, k)) = (bf16_t)(wb >> 16);
                *(LDSP bf16_t*)(lg + G_KT + sw64(i0, k)) = (bf16_t)(wk & 0xffffu);      *(LDSP bf16_t*)(lg + G_KT + sw64(i0 + 1, k)) = (bf16_t)(wk >> 16);
            }
            *(LDSP u32x4*)(lg + G_X0 + sw64(k, ibase + 8 * q)) = mk4u(wat[0], wat[1], wat[2], wat[3]);
            *(LDSP u32x4*)(lg + G_VT + sw64(k, ibase + 8 * q)) = mk4u(wv[0], wv[1], wv[2], wv[3]);
            keep_bh[q] = mk4u(wbh[0], wbh[1], wbh[2], wbh[3]); keep_kh[q] = mk4u(wkh[0], wkh[1], wkh[2], wkh[3]);
            __builtin_amdgcn_sched_barrier(0);
        }
#undef LD16
    }
    gbar(cnt, bt, lane_in);
    {
        STAGE_IDS
        const int a = wg >> 1, bq = wg & 1;
        f32x16 c1 = zero16(), c2 = zero16();
        if (a <= bq) {
            bf16x8 fB[4], fA[4]; ldf(FO, G_BT + 4096 * a, fB); ldf(FO, G_AT + 4096 * bq, fA);
#pragma unroll
            for (int t = 0; t < 4; ++t) { c1 = __builtin_amdgcn_mfma_f32_32x32x16_bf16(fB[t], fA[t], c1, 0, 0, 0); c2 = __builtin_amdgcn_mfma_f32_32x32x16_bf16(fA[t], fB[t], c2, 0, 0, 0); }
            if (a == bq) {
                mask_lt(c1, 32 * a, 32 * bq + r, hh, false);
#pragma unroll
                for (int g = 0; g < 16; ++g) { const int x = 32 * bq + crow(g, hh); c2[g] = (32 * a + r < x) ? c2[g] : 0.f; }
            }
        }
        stt(SO, G_P0 + 4096 * bq, a, c1);
        stt(SO, G_PT0 + 4096 * a, bq, c2);
        const int ib = wg >> 1, vb = wg & 1;
        f32x16 z = zero16();
#pragma unroll
        for (int jb = 0; jb < 2; ++jb) if (jb <= ib) {
            bf16x8 fK[4], fA[4]; ldf(FO, G_KT + 4096 * jb, fK); ldf(FO, G_AT + 4096 * ib, fA);
            f32x16 t = zero16();
#pragma unroll
            for (int s = 0; s < 4; ++s) t = __builtin_amdgcn_mfma_f32_32x32x16_bf16(fK[s], fA[s], t, 0, 0, 0);
            if (jb == ib) mask_lt(t, 32 * jb, 32 * ib + r, hh, false);
#pragma unroll
            for (int s2 = 0; s2 < 2; ++s2) {
                const bf16x8 af = __builtin_bit_cast(bf16x8, mk4u(pk2(t[8 * s2], t[8 * s2 + 1]), pk2(t[8 * s2 + 2], t[8 * s2 + 3]), pk2(t[8 * s2 + 4], t[8 * s2 + 5]), pk2(t[8 * s2 + 6], t[8 * s2 + 7])));
                const u32x2 v0 = ld8(SO, 2 * s2, G_VT + 4096 * vb, jb), v1 = ld8(SO, 2 * s2 + 1, G_VT + 4096 * vb, jb);
                const bf16x8 bv = __builtin_bit_cast(bf16x8, mk4u(v0.x, v0.y, v1.x, v1.y));
                z = __builtin_amdgcn_mfma_f32_32x32x16_bf16(af, bv, z, 0, 0, 0);
            }
        }
        stt(SO, G_X0 + 128 * 64 + 4096 * vb, ib, z);
    }
    gbar(cnt, bt, lane_in);
#pragma unroll 1
    for (int s = 0; s < 6; ++s) {
        STAGE_IDS
        const int cb = wg, a = wg >> 1, bq = wg & 1;
        bf16x8 xf[4], p0[4], p1[4];
        ldf(FO, G_X0 + 4096 * cb, xf); ldf(FO, G_P0, p0); ldf(FO, G_P0 + 4096, p1);
        f32x16 acc0, acc1;
#pragma unroll
        for (int gq = 0; gq < 4; ++gq) { const u32x2 w0 = ld8(SO, gq, G_X0 + 4096 * cb, 0), w1 = ld8(SO, gq, G_X0 + 4096 * cb, 1);
            acc0[4 * gq] = bf2f(w0.x & 0xffff); acc0[4 * gq + 1] = bf2f(w0.x >> 16); acc0[4 * gq + 2] = bf2f(w0.y & 0xffff); acc0[4 * gq + 3] = bf2f(w0.y >> 16);
            acc1[4 * gq] = bf2f(w1.x & 0xffff); acc1[4 * gq + 1] = bf2f(w1.x >> 16); acc1[4 * gq + 2] = bf2f(w1.y & 0xffff); acc1[4 * gq + 3] = bf2f(w1.y >> 16); }
        f32x16 z = zero16(), zt = zero16();
        const bool sq = (s < 5) && (a <= bq);
        bf16x8 fa[4], fb[4];
        if (sq) { ldf(FO, G_PT0 + 4096 * a, fa); ldf(FO, G_P0 + 4096 * bq, fb); }
#pragma unroll
        for (int t = 0; t < 4; ++t) { if (t < 2) acc0 = __builtin_amdgcn_mfma_f32_32x32x16_bf16(p0[t], xf[t], acc0, 0, 0, 0); acc1 = __builtin_amdgcn_mfma_f32_32x32x16_bf16(p1[t], xf[t], acc1, 0, 0, 0); }
        if (sq) { const int t0 = (a == 1) ? 2 : 0, t1 = (bq == 0) ? 2 : 4;
#pragma unroll
            for (int t = 0; t < 4; ++t) if (t >= t0 && t < t1) { z = __builtin_amdgcn_mfma_f32_32x32x16_bf16(fa[t], fb[t], z, 0, 0, 0); zt = __builtin_amdgcn_mfma_f32_32x32x16_bf16(fb[t], fa[t], zt, 0, 0, 0); } }
        stt(SO, G_X0 + 4096 * cb, 0, acc0); stt(SO, G_X0 + 4096 * cb, 1, acc1);
        if (s < 5) {
            gbar(cnt, bt, lane);
            stt(SO, G_P0 + 4096 * bq, a, z); stt(SO, G_PT0 + 4096 * a, bq, zt);
        }
        gbar(cnt, bt, lane);
    }
    {
        STAGE_IDS
        const int jb = wg >> 1, ib = wg & 1;
        f32x16 c1 = zero16(), c2 = zero16();
        if (jb <= ib) {
            bf16x8 fR[4], fB[4], fK[4]; ldf(FO, G_RT + 4096 * ib, fR); ldf(FO, G_BT + 4096 * jb, fB); ldf(FO, G_KT + 4096 * jb, fK);
#pragma unroll
            for (int t = 0; t < 4; ++t) { c1 = __builtin_amdgcn_mfma_f32_32x32x16_bf16(fB[t], fR[t], c1, 0, 0, 0); c2 = __builtin_amdgcn_mfma_f32_32x32x16_bf16(fK[t], fR[t], c2, 0, 0, 0); }
            if (jb == ib) { mask_lt(c1, 32 * jb, 32 * ib + r, hh, true); mask_lt(c2, 32 * jb, 32 * ib + r, hh, true); }
        }
        stt(SO, G_P0 + 4096 * ib, jb, c1); stt(SO, G_PT0 + 4096 * ib, jb, c2);
    }
    gbar(cnt, bt, lane_in);
    {
        STAGE_IDS
#pragma unroll
        for (int q = 0; q < 2; ++q) { *(LDSP u32x4*)(lg + G_BT + sw64(lane, wg * 16 + 8 * q)) = keep_bh[q]; *(LDSP u32x4*)(lg + G_KT + sw64(lane, wg * 16 + 8 * q)) = keep_kh[q]; }
    }
    gbar(cnt, bt, lane_in);
    {
        STAGE_IDS
        const int mi = wg;
        const int L_BH = G_BT, L_KH = G_KT, L_RB = G_P0, L_RK = G_PT0;
        const size_t inst = (size_t)inst_index(b, h, d, chunk_id) * 4096;
        bf16_t* dst = (bf16_t*)(p.ws + (mi == 0 ? OFF_CM : mi == 1 ? OFF_CN : mi == 2 ? OFF_CP : OFF_CQ)) + inst;
        if (isx || mi < 2) {
            const int Ax = (mi == 1) ? L_BH : G_X0, Ax0 = (mi == 3) ? 64 : 0;
            const int By = (mi == 0) ? L_BH : (mi == 1) ? G_X0 : L_RB, By0 = (mi == 1) ? 64 : 0;
            const int A2 = (mi == 1) ? L_KH : G_VT, B2 = (mi == 1) ? G_VT : L_RK;
#pragma unroll 1
            for (int half = 0; half < 2; ++half) {
                bf16x8 a0[4], a1[4], b1[4];
                ldf(FO, Ax + 128 * Ax0, a0); ldf(FO, Ax + 128 * (Ax0 + 32), a1); ldf(FO, By + 128 * (By0 + 32 * half), b1);
                f32x16 c0 = zero16(), c1 = zero16();
#pragma unroll
                for (int t = 0; t < 4; ++t) { c0 = __builtin_amdgcn_mfma_f32_32x32x16_bf16(a0[t], b1[t], c0, 0, 0, 0); c1 = __builtin_amdgcn_mfma_f32_32x32x16_bf16(a1[t], b1[t], c1, 0, 0, 0); }
                if (mi & 1) {
                    ldf(FO, A2, a0); ldf(FO, A2 + 4096, a1); ldf(FO, B2 + 4096 * half, b1);
#pragma unroll
                    for (int t = 0; t < 4; ++t) { c0 = __builtin_amdgcn_mfma_f32_32x32x16_bf16(a0[t], b1[t], c0, 0, 0, 0); c1 = __builtin_amdgcn_mfma_f32_32x32x16_bf16(a1[t], b1[t], c1, 0, 0, 0); }
                }
                const int y = 32 * half + r;
                const float dg = (mi == 0) ? __expf(((const LDSP float*)(lg + G_GL))[y]) : 0.f;
#pragma unroll
                for (int xb = 0; xb < 2; ++xb) {
#pragma unroll
                    for (int gq = 0; gq < 4; ++gq) {
                        const int x0 = 32 * xb + 8 * gq + 4 * hh;
                        float v0 = xb ? c1[4 * gq] : c0[4 * gq], v1 = xb ? c1[4 * gq + 1] : c0[4 * gq + 1], v2 = xb ? c1[4 * gq + 2] : c0[4 * gq + 2], v3 = xb ? c1[4 * gq + 3] : c0[4 * gq + 3];
                        if (mi == 0) { if (x0 == y) v0 += dg; if (x0 + 1 == y) v1 += dg; if (x0 + 2 == y) v2 += dg; if (x0 + 3 == y) v3 += dg; }
                        if (mi == 2) { const u32x2 w = ld8(SO, gq, G_RT + 4096 * half, xb); v0 += bf2f(w.x & 0xffff); v1 += bf2f(w.x >> 16); v2 += bf2f(w.y & 0xffff); v3 += bf2f(w.y >> 16); }
                        *(u32x2*)(dst + ((half * 4 + 2 * xb + (gq >> 1)) * 64 + hh * 32 + r) * 8 + 4 * (gq & 1)) = mk2u(pk2(v0, v1), pk2(v2, v3));
                    }
                }
            }
        }
    }
    gbar(cnt, bt, lane_in);
#undef STAGE_IDS
}

__device__ __forceinline__ void conv_tile_group(LDSP unsigned char* lg, LDSP unsigned* cnt, unsigned& bt, const Params& p, int g, int tg, int lane) {
    const float* src = nullptr; bf16_t* dst = nullptr; int N = 0, ld = 0, mode = 0, k0 = 0, n0 = 0;
    conv_decode(p, g, src, dst, N, ld, mode, k0, n0);
    LDSP float* Tm = (LDSP float*)lg;
    {
        const int kr = tg >> 3, nc = (tg & 7) * 8;
        f32x4 v[8][2];
#pragma unroll
        for (int s = 0; s < 8; ++s) { const float* q = src + (size_t)(k0 + s * 32 + kr) * N + n0 + nc; v[s][0] = *(const f32x4*)q; v[s][1] = *(const f32x4*)(q + 4); }
#pragma unroll
        for (int s = 0; s < 8; ++s) { LDSP float* q = Tm + (s * 32 + kr) * 65 + nc;
            q[0] = v[s][0].x; q[1] = v[s][0].y; q[2] = v[s][0].z; q[3] = v[s][0].w; q[4] = v[s][1].x; q[5] = v[s][1].y; q[6] = v[s][1].z; q[7] = v[s][1].w; }
    }
    gbar(cnt, bt, lane);
    {
        const int n = tg >> 2; unsigned char* drow = (unsigned char*)dst + (size_t)conv_row(n0 + n, mode & 3) * ld;
        if (mode & 4) {
            const float sc = (mode & 3) ? W1_SCALE : W2_SCALE;
#pragma unroll
            for (int s = 0; s < 4; ++s) { const int kc = ((tg & 3) + 4 * s) * 16; float f[16];
#pragma unroll
                for (int j = 0; j < 16; ++j) f[j] = Tm[(kc + j) * 65 + n] * sc;
                *(u32x4*)(drow + k0 + kc) = mk4u(pk4_fp8(f[0], f[1], f[2], f[3]), pk4_fp8(f[4], f[5], f[6], f[7]), pk4_fp8(f[8], f[9], f[10], f[11]), pk4_fp8(f[12], f[13], f[14], f[15])); }
        } else {
#pragma unroll
            for (int s = 0; s < 8; ++s) { const int kc = ((tg & 3) + 4 * s) * 8; float f[8];
#pragma unroll
                for (int j = 0; j < 8; ++j) f[j] = Tm[(kc + j) * 65 + n];
                *(u32x4*)(drow + 2 * (k0 + kc)) = mk4u(pk2(f[0], f[1]), pk2(f[2], f[3]), pk2(f[4], f[5]), pk2(f[6], f[7])); }
        }
    }
    gbar(cnt, bt, lane);
}

__device__ __forceinline__ void phaseR3(LDSP unsigned char* lds, const Params& p) {
    const int tid = opaque(threadIdx.x), wid = tid >> 6, lane = tid & 63, gp = wid >> 2, wg = wid & 3;
    LDSP unsigned char* lg = lds + gp * G_BYTES;
    LDSP unsigned* cnt = (LDSP unsigned*)(lg + G_CNT);
    LDSP unsigned* uq = (LDSP unsigned*)(lds + SMEM_BYTES - 48);
    LDSP unsigned* pick = (LDSP unsigned*)(lg + G_CNT + 8);
    if ((tid & 255) == 0) *cnt = 0u;
    if (tid == 0) *uq = 0u;
    __syncthreads();
    unsigned bt = 0u;
    if (gp == 1) for (int g = CT1 + blockIdx.x; g < CT8; g += gridDim.x) conv_tile_group(lg, cnt, bt, p, g, tid & 255, lane);
    unsigned FO[4], SO[4];
    { const unsigned base = LDS_ADDR(lg), r = lane & 31, hh = lane >> 5;
#pragma unroll
      for (int q = 0; q < 4; ++q) { FO[q] = base + r * 128u + ((((2u * q + hh) ^ (r >> 1)) & 7u) << 4); SO[q] = base + r * 128u + ((((unsigned)q ^ (r >> 1)) & 7u) << 4) + 8u * hh; } }
    for (;;) {
        if ((tid & 255) == 0) *pick = __hip_atomic_fetch_add(uq, 1u, __ATOMIC_RELAXED, __HIP_MEMORY_SCOPE_WORKGROUP);
        gbar(cnt, bt, lane);
        const int u = blockIdx.x + (int)(*pick) * gridDim.x;
        gbar(cnt, bt, lane);
        if (u >= 4096 + 256) break;
        rwkv_prep_group(lg, cnt, bt, p, u, wg, lane, FO, SO);
    }
    __syncthreads();
}

constexpr size_t OFF_HT = OFF_YD;
__device__ __forceinline__ void scan_wave(const Params& p, int item, int lane) {
    const int chain = item >> 1, vb = item & 1, b = chain >> 5, h = (chain >> 1) & 15, d = chain & 1;
    const bf16_t* CM = (const bf16_t*)(p.ws + OFF_CM); const bf16_t* CN = (const bf16_t*)(p.ws + OFF_CN); bf16_t* HT = (bf16_t*)(p.ws + OFF_HT);
    u32x4 na[2][4], nn[2][2];
    auto chunk_of = [&](int step) { return (step < 4) ? (d ? 3 - step : step) : (d ? 4 + (67 - step) : step); };
    auto prefetch = [&](int step) {
        const size_t inst = (size_t)inst_index(b, h, d, chunk_of(step)) * 4096;
#pragma unroll
        for (int rt = 0; rt < 2; ++rt) {
#pragma unroll
            for (int s = 0; s < 4; ++s) na[rt][s] = *(const u32x4*)(CM + inst + ((rt * 4 + s) * 64 + lane) * 8);
#pragma unroll
            for (int g2 = 0; g2 < 2; ++g2) nn[rt][g2] = *(const u32x4*)(CN + inst + (((vb * 2 + rt) * 2 + g2) * 64 + lane) * 8);
        }
    };
    f32x16 hacc[2]; hacc[0] = zero16(); hacc[1] = zero16();
    prefetch(0);
#pragma unroll 1
    for (int step = 0; step < NCHUNK; ++step) {
        const int chunk_id = chunk_of(step);
        u32x4 a[2][4], n[2][2];
#pragma unroll
        for (int rt = 0; rt < 2; ++rt) {
#pragma unroll
            for (int s = 0; s < 4; ++s) a[rt][s] = na[rt][s];
            n[rt][0] = nn[rt][0]; n[rt][1] = nn[rt][1];
        }
        if (step + 1 < NCHUNK) prefetch(step + 1);
        bf16x8 bfr[4];
#pragma unroll
        for (int s = 0; s < 4; ++s) { const f32x16& t = hacc[s >> 1]; const int o = 8 * (s & 1);
            bfr[s] = __builtin_bit_cast(bf16x8, mk4u(pk2(t[o], t[o + 1]), pk2(t[o + 2], t[o + 3]), pk2(t[o + 4], t[o + 5]), pk2(t[o + 6], t[o + 7]))); }
        if (chunk_id >= 4) {
            bf16_t* hp = HT + (size_t)inst_index(b, h, d, chunk_id) * 4096 + (vb * 4 * 64 + lane) * 8;
#pragma unroll
            for (int s = 0; s < 4; ++s) *(bf16x8*)(hp + s * 512) = bfr[s];
        }
#pragma unroll
        for (int rt = 0; rt < 2; ++rt) {
            f32x16 acc;
#pragma unroll
            for (int g2 = 0; g2 < 2; ++g2) { const u32x4 w = n[rt][g2];
                acc[8 * g2] = bf2f(w.x & 0xffff); acc[8 * g2 + 1] = bf2f(w.x >> 16); acc[8 * g2 + 2] = bf2f(w.y & 0xffff); acc[8 * g2 + 3] = bf2f(w.y >> 16);
                acc[8 * g2 + 4] = bf2f(w.z & 0xffff); acc[8 * g2 + 5] = bf2f(w.z >> 16); acc[8 * g2 + 6] = bf2f(w.w & 0xffff); acc[8 * g2 + 7] = bf2f(w.w >> 16); }
#pragma unroll
            for (int s = 0; s < 4; ++s) acc = __builtin_amdgcn_mfma_f32_32x32x16_bf16(__builtin_bit_cast(bf16x8, a[rt][s]), bfr[s], acc, 0, 0, 0);
            hacc[rt] = acc;
        }
    }
}
__device__ __forceinline__ void phaseR4(LDSP unsigned char* lds, const Params& p) {
    const int tid = opaque(threadIdx.x), wid = tid >> 6, lane = tid & 63;
    LDSP int* nxt = (LDSP int*)(lds + SMEM_BYTES - 32);
    unsigned* qctr = (unsigned*)(p.ws + OFF_CTL + 16384 + 512);
    if ((int)blockIdx.x < 64 && gridDim.x >= 128) { if (wid < 2) scan_wave(p, blockIdx.x * 2 + wid, lane); }
    else if (gridDim.x < 128) { if (wid == 0) for (int it = blockIdx.x; it < 128; it += gridDim.x) scan_wave(p, it, lane); }
    for (;;) {
        __syncthreads();
        if (tid == 0) *nxt = (int)atomicAdd(qctr, 1u);
        __syncthreads();
        const int u = *nxt;
        if (u >= 512) break;
        attn_unit(lds, p, u);
    }
}

__device__ __forceinline__ void phaseR5(LDSP unsigned char* lds, const Params& p) {
    const int tid = opaque(threadIdx.x), wid = tid >> 6, lane = tid & 63, r = lane & 31, hh = lane >> 5;
    const bf16_t* CP = (const bf16_t*)(p.ws + OFF_CP); const bf16_t* CQ = (const bf16_t*)(p.ws + OFF_CQ); const bf16_t* HT = (const bf16_t*)(p.ws + OFF_HT);
    for (int wu = blockIdx.x * 8 + wid; wu < 2 * 64 * 16 * 2; wu += gridDim.x * 8) {
        const int half = wu & 1, u = wu >> 1, b = u >> 10, c = (u >> 4) & 63, h = u & 15;
        f32x16 y0 = zero16(), y1 = zero16();
#pragma unroll
        for (int d = 0; d < 2; ++d) {
            const size_t inst = (size_t)inst_index(b, h, d, 4 + c) * 4096;
            const int ii = d ? 63 - (32 * half + r) : (32 * half + r);
            const int it = ii >> 5, lp = hh * 32 + (ii & 31);
            f32x16 a0, a1;
#pragma unroll
            for (int g2 = 0; g2 < 2; ++g2) {
                const u32x4 w0 = *(const u32x4*)(CQ + inst + (((it * 2 + 0) * 2 + g2) * 64 + lp) * 8), w1 = *(const u32x4*)(CQ + inst + (((it * 2 + 1) * 2 + g2) * 64 + lp) * 8);
                a0[8 * g2] = bf2f(w0.x & 0xffff); a0[8 * g2 + 1] = bf2f(w0.x >> 16); a0[8 * g2 + 2] = bf2f(w0.y & 0xffff); a0[8 * g2 + 3] = bf2f(w0.y >> 16);
                a0[8 * g2 + 4] = bf2f(w0.z & 0xffff); a0[8 * g2 + 5] = bf2f(w0.z >> 16); a0[8 * g2 + 6] = bf2f(w0.w & 0xffff); a0[8 * g2 + 7] = bf2f(w0.w >> 16);
                a1[8 * g2] = bf2f(w1.x & 0xffff); a1[8 * g2 + 1] = bf2f(w1.x >> 16); a1[8 * g2 + 2] = bf2f(w1.y & 0xffff); a1[8 * g2 + 3] = bf2f(w1.y >> 16);
                a1[8 * g2 + 4] = bf2f(w1.z & 0xffff); a1[8 * g2 + 5] = bf2f(w1.z >> 16); a1[8 * g2 + 6] = bf2f(w1.w & 0xffff); a1[8 * g2 + 7] = bf2f(w1.w >> 16);
            }
#pragma unroll
            for (int s = 0; s < 4; ++s) {
                const bf16x8 pf = *(const bf16x8*)(CP + inst + ((it * 4 + s) * 64 + lp) * 8);
                const bf16x8 h0 = *(const bf16x8*)(HT + inst + ((0 * 4 + s) * 64 + lane) * 8), h1 = *(const bf16x8*)(HT + inst + ((1 * 4 + s) * 64 + lane) * 8);
                a0 = __builtin_amdgcn_mfma_f32_32x32x16_bf16(h0, pf, a0, 0, 0, 0);
                a1 = __builtin_amdgcn_mfma_f32_32x32x16_bf16(h1, pf, a1, 0, 0, 0);
            }
#pragma unroll
            for (int g = 0; g < 16; ++g) { y0[g] += a0[g]; y1[g] += a1[g]; }
        }
        const int tau = 32 * half + r; const size_t row = (size_t)b * T + c * 64 + tau;
        float sm = 0.f;
#pragma unroll
        for (int g = 0; g < 16; ++g) sm += y0[g] + y1[g];
        sm += shx(sm, 32);
        const float mean = sm * (1.f / 64.f);
        float q2 = 0.f;
#pragma unroll
        for (int g = 0; g < 16; ++g) { y0[g] -= mean; y1[g] -= mean; q2 += y0[g] * y0[g] + y1[g] * y1[g]; }
        q2 += shx(q2, 32);
        const float rstd = rsqrtf(q2 * (1.f / 64.f) + 64e-5f);
        const bf16_t* rs = (const bf16_t*)(p.ws + OFF_RS) + row * 1024 + h * 64; const bf16_t* ks = (const bf16_t*)(p.ws + OFF_KS) + row * 1024 + h * 64;
        const bf16_t* ai0 = (const bf16_t*)(p.ws + OFF_AIG) + row * 2048 + h * 64; const bf16_t* ai1 = ai0 + 1024;
        const bf16_t* vs = (const bf16_t*)(p.ws + OFF_VS) + row * 1024 + h * 64; const bf16_t* gg = (const bf16_t*)(p.ws + OFF_GG) + row * 1024 + h * 64;
        float bon = 0.f;
#pragma unroll
        for (int q = 0; q < 8; ++q) {
            const int ch = 32 * (q >> 2) + 8 * (q & 3) + 4 * hh;
            const u32x2 r2 = *(const u32x2*)(rs + ch), k2 = *(const u32x2*)(ks + ch), x2 = *(const u32x2*)(ai0 + ch), z2 = *(const u32x2*)(ai1 + ch);
            const f32x4 ka = *(const f32x4*)(p.k_a + h * 64 + ch), rk = *(const f32x4*)(p.r_k + h * 64 + ch);
            const float rr[4] = {bf2f(r2.x & 0xffff), bf2f(r2.x >> 16), bf2f(r2.y & 0xffff), bf2f(r2.y >> 16)}, kk[4] = {bf2f(k2.x & 0xffff), bf2f(k2.x >> 16), bf2f(k2.y & 0xffff), bf2f(k2.y >> 16)};
            const float xa[4] = {bf2f(x2.x & 0xffff), bf2f(x2.x >> 16), bf2f(x2.y & 0xffff), bf2f(x2.y >> 16)}, za[4] = {bf2f(z2.x & 0xffff), bf2f(z2.x >> 16), bf2f(z2.y & 0xffff), bf2f(z2.y >> 16)};
#pragma unroll
            for (int e = 0; e < 4; ++e) bon += rr[e] * (kk[e] * ((1.f + (xa[e] - 1.f) * ka[e]) + (1.f + (za[e] - 1.f) * ka[e]))) * rk[e];
        }
        bon += shx(bon, 32);
        bf16_t* dst = (bf16_t*)(p.ws + OFF_MIX) + row * D + h * 64;
#pragma unroll
        for (int q = 0; q < 8; ++q) {
            const int ch = 32 * (q >> 2) + 8 * (q & 3) + 4 * hh, g0 = 4 * (q & 3);
            const f32x4 lg = *(const f32x4*)(p.lnx_g + h * 64 + ch), lb = *(const f32x4*)(p.lnx_b + h * 64 + ch);
            const u32x2 v2 = *(const u32x2*)(vs + ch), g2 = *(const u32x2*)(gg + ch);
            const float vv[4] = {bf2f(v2.x & 0xffff), bf2f(v2.x >> 16), bf2f(v2.y & 0xffff), bf2f(v2.y >> 16)}, gv[4] = {bf2f(g2.x & 0xffff), bf2f(g2.x >> 16), bf2f(g2.y & 0xffff), bf2f(g2.y >> 16)};
            float o[4];
#pragma unroll
            for (int e = 0; e < 4; ++e) { const float yv = (q < 4) ? y0[g0 + e] : y1[g0 + e]; o[e] = (yv * rstd * lg[e] + lb[e] + bon * vv[e]) * gv[e]; }
            *(u32x2*)(dst + ch) = mk2u(pk2(o[0], o[1]), pk2(o[2], o[3]));
        }
    }
}

__device__ __forceinline__ void phase6(LDSP unsigned char* lds, const Params& p) {
    pg8::Epi<FX1> epi{FX1{p.x, (const float*)(p.ws + OFF_MOD), (float*)(p.ws + OFF_X1)}};
    pg8::DenseSched S{(const char*)(p.ws + OFF_MIX), (const char*)(p.ws + OFF_WTOUT), NX / 256, D / 256, D, (int)gridDim.x, (int)blockIdx.x};
    pg8::gemm_phase<false>(lds, D, S, epi);
}

__device__ __forceinline__ void phase7(LDSP unsigned char* lds, const Params& p) {
    const int tid = opaque(threadIdx.x), wid = tid >> 6, lane = tid & 63;
    LDSP float* GS = (LDSP float*)lds;
    LDSP float* RSTD = (LDSP float*)(lds + 16384);
    LDSP float* PART = (LDSP float*)(lds + 16896);
    LDSP float* CB = (LDSP float*)(lds + 16896 + 65536);
    const float* MOD = (const float*)(p.ws + OFF_MOD);
    const float* X1 = (const float*)(p.ws + OFF_X1);
    unsigned char* H2 = p.ws + OFF_H2;
    int* CNT = (int*)(p.ws + OFF_CTL + 16384);
    for (int u = blockIdx.x; u < NX / 32; u += gridDim.x) {
        const float* md = MOD + (size_t)((u * 32) >> 12) * 12288;
        for (int idx = tid; idx < D / 4; idx += 512) { const f32x4 g = *(const f32x4*)(p.norm2_g + 4 * idx), sh = *(const f32x4*)(md + 3 * D + 4 * idx), sc = *(const f32x4*)(md + 4 * D + 4 * idx);
            *(LDSP f32x4*)(GS + 4 * idx) = g * (sc + 1.f); *(LDSP f32x4*)(GS + D + 4 * idx) = sh; }
        __syncthreads();
#pragma unroll 1
        for (int rr = 0; rr < 4; ++rr) {
            const int t = 4 * wid + rr, row = u * 32 + t; const float* src = X1 + (size_t)row * D;
            f32x4 xv[8]; float ss = 0.f;
#pragma unroll
            for (int i = 0; i < 8; ++i) { xv[i] = ((const f32x4*)src)[lane + 64 * i]; ss += xv[i].x * xv[i].x + xv[i].y * xv[i].y + xv[i].z * xv[i].z + xv[i].w * xv[i].w; }
            ss = wave_sum(ss); const float rs = rsqrtf(ss * (1.f / D) + 1e-6f);
            if (lane == 0) RSTD[t] = rs;
#pragma unroll
            for (int i = 0; i < 8; ++i) { const int col = 4 * (lane + 64 * i);
                const f32x4 g = *(const LDSP f32x4*)(GS + col), sh = *(const LDSP f32x4*)(GS + D + col);
                const f32x4 hv = xv[i] * rs * g + sh;
                *(unsigned*)(H2 + (size_t)row * D + col) = pk4_fp8(hv.x, hv.y, hv.z, hv.w); }
        }
        {
            const int j = lane & 31, kk = lane >> 5, k0 = wid * 256;
            unsigned xoff = (unsigned)((u * 32 + j) * D + k0 + 4 * kk) * 4u;
            unsigned woff = (unsigned)((k0 + 4 * kk) * 64 + j) * 4u;
            unsigned goff = (unsigned)(k0 + 4 * kk) * 4u;
            f32x16 acc0 = zero16(), acc1 = zero16(); float c0 = 0.f, c1 = 0.f;
#pragma unroll 2
            for (int q = 0; q < 32; ++q) {
                const f32x4 xa = *(const f32x4*)((const char*)X1 + xoff);
                const f32x4 gv = *(const LDSP f32x4*)((const LDSP char*)GS + goff), sv = *(const LDSP f32x4*)((const LDSP char*)GS + D * 4 + goff);
                float b0[4], b1[4];
#pragma unroll
                for (int e = 0; e < 4; ++e) { b0[e] = *(const float*)((const char*)p.w_router + woff + e * 256); b1[e] = *(const float*)((const char*)p.w_router + woff + e * 256 + 128); }
#pragma unroll
                for (int e = 0; e < 4; ++e) {
                    acc0 = __builtin_amdgcn_mfma_f32_32x32x2f32(xa[e], b0[e] * gv[e], acc0, 0, 0, 0);
                    acc1 = __builtin_amdgcn_mfma_f32_32x32x2f32(xa[e], b1[e] * gv[e], acc1, 0, 0, 0);
                    c0 += sv[e] * b0[e]; c1 += sv[e] * b1[e];
                }
                xoff += 32u; woff += 2048u; goff += 32u;
            }
            c0 += shx(c0, 32); c1 += shx(c1, 32);
#pragma unroll
            for (int g = 0; g < 16; ++g) { const int t = crow(g, kk); PART[(wid * 32 + t) * 64 + j] = acc0[g]; PART[(wid * 32 + t) * 64 + 32 + j] = acc1[g]; }
            if (kk == 0) { CB[wid * 64 + j] = c0; CB[wid * 64 + 32 + j] = c1; }
        }
        __syncthreads();
        float cb = 0.f;
#pragma unroll
        for (int w = 0; w < 8; ++w) cb += CB[w * 64 + lane];
        const float eb = p.expert_bias[lane];
#pragma unroll 1
        for (int rr = 0; rr < 4; ++rr) {
            const int t = 4 * wid + rr, token = u * 32 + t;
            float sum = 0.f;
#pragma unroll
            for (int w = 0; w < 8; ++w) sum += PART[(w * 32 + t) * 64 + lane];
            const float logit = RSTD[t] * sum + cb;
            const float score = 1.f / (1.f + expf(-logit));
            const float v = score + eb;
            const int gi = lane >> 3;
            float m1 = v;
            m1 = fmaxf(m1, shx(m1, 1)); m1 = fmaxf(m1, shx(m1, 2)); m1 = fmaxf(m1, shx(m1, 4));
            const unsigned long long eq = __ballot(v == m1);
            const unsigned gbits = (unsigned)((eq >> (gi * 8)) & 0xffull);
            const bool first = (lane & 7) == (__ffs((int)gbits) - 1);
            float v2 = first ? -INFINITY : v;
            v2 = fmaxf(v2, shx(v2, 1)); v2 = fmaxf(v2, shx(v2, 2)); v2 = fmaxf(v2, shx(v2, 4));
            const float gs = m1 + v2;
            int gr = 0;
#pragma unroll
            for (int jj = 0; jj < 8; ++jj) { const float gj = __builtin_bit_cast(float, __builtin_amdgcn_readlane(__builtin_bit_cast(int, gs), jj * 8)); gr += (gj > gs || (gj == gs && jj < gi)) ? 1 : 0; }
            const float mv = (gr < 4) ? v : -INFINITY;
            int rk = 0;
#pragma unroll
            for (int j8 = 0; j8 < 8; ++j8) {
#pragma unroll
                for (int j1 = 0; j1 < 8; ++j1) { const int jj = 8 * j8 + j1; const float vj = __builtin_bit_cast(float, __builtin_amdgcn_readlane(__builtin_bit_cast(int, mv), jj)); rk += (vj > mv || (vj == mv && jj < lane)) ? 1 : 0; }
                __builtin_amdgcn_sched_barrier(0);
            }
            const bool sel = (rk < 8) && (gr < 4);
            const float gsum = wave_sum(sel ? score : 0.f);
            if (sel) {
                const int slot = atomicAdd(&CNT[lane], 1);
                ((int*)(p.ws + OFF_EIDX))[token * 8 + rk] = lane;
                ((int*)(p.ws + OFF_ESLOT))[token * 8 + rk] = slot;
                ((float*)(p.ws + OFF_GATE))[token * 8 + rk] = score / gsum * 2.5f;
                ((int*)(p.ws + OFF_TOKL))[(size_t)lane * NX + slot] = token;
            }
        }
        __syncthreads();
    }
}

constexpr int LE_TAB = 131072;
__device__ __forceinline__ void build_expert_tables(LDSP unsigned char* lds, const Params& p) {
    LDSP int* TP = (LDSP int*)(lds + LE_TAB); LDSP int* ST = TP + 72; LDSP int* CN = ST + 72;
    const int tid = opaque(threadIdx.x);
    if (tid < NEX) CN[tid] = (tid < NE) ? ((const int*)(p.ws + OFF_CTL + 16384))[tid] : NX;
    __syncthreads();
    if (tid == 0) {
        int tp = 0, st = 0;
        for (int e = 0; e < NEX; ++e) { const int cn = CN[e]; TP[e] = tp; ST[e] = st; tp += (cn + 255) >> 8; st += cn; }
        TP[NEX] = tp; ST[NEX] = st;
    }
    __syncthreads();
}

struct GroupSched {
    const LDSP int* TP; const LDSP int* ST; const LDSP int* CN;
    const char* A; const char* B; const int* tokl; int ntn, K, G, c; size_t bstride; bool gather; int bn;
    __device__ __forceinline__ bool next(int i, pg8::Unit& u) const {
        const int total = __builtin_amdgcn_readfirstlane(TP[NEX]) * ntn; const long L = (long)i * G + c; if (L >= total) return false;
        const int w = pg8::xcd_remap((int)L, total);
        const int nt = w % ntn, mtg = w / ntn;
        int e = u.e;
        if (__builtin_amdgcn_readfirstlane(TP[e]) > mtg) e = 0;
        while (__builtin_amdgcn_readfirstlane(TP[e + 1]) <= mtg) ++e;
        const int tpe = __builtin_amdgcn_readfirstlane(TP[e]), ste = __builtin_amdgcn_readfirstlane(ST[e]), cne = __builtin_amdgcn_readfirstlane(CN[e]);
        const int mt = mtg - tpe;
        u.B = B + (size_t)e * bstride + (size_t)nt * bn * K * 2;
        u.nvalid = cne; u.m0 = mt * 256; u.pos0 = ste; u.row0 = 0; u.col0 = nt * bn; u.e = e;
        if (gather) { u.A = A; u.rowmap = (e < NE) ? tokl + (size_t)e * NX : nullptr; }
        else { u.A = A + (size_t)(ste + mt * 256) * K * 2; u.rowmap = nullptr; }
        return true;
    }
};
#ifndef P8MODE
#define P8MODE 2
#endif
#ifndef P9MODE
#define P9MODE 2
#endif
__device__ __forceinline__ void phase8(LDSP unsigned char* lds, const Params& p) {
    build_expert_tables(lds, p);
    const LDSP int* TP = (const LDSP int*)(lds + LE_TAB);
    pg8::Epi<FH1, P8MODE> epi{FH1{p.ws + OFF_H1}};
    GroupSched S{TP, TP + 72, TP + 144, (const char*)(p.ws + OFF_H2), (const char*)(p.ws + OFF_WTE1), (const int*)(p.ws + OFF_TOKL), 8 / P8MODE, D / 2, (int)gridDim.x, (int)blockIdx.x,
                 (size_t)1024 * 2048, true, 128 * P8MODE};
    pg8::gemm_phase<true, true, P8MODE>(lds, D / 2, S, epi);
}
__device__ __forceinline__ void phase9(LDSP unsigned char* lds, const Params& p) {
    build_expert_tables(lds, p);
    const LDSP int* TP = (const LDSP int*)(lds + LE_TAB);
    pg8::Epi<FEO, P9MODE> epi{FEO{p.ws + OFF_EO}};
    GroupSched S{TP, TP + 72, TP + 144, (const char*)(p.ws + OFF_H1), (const char*)(p.ws + OFF_WTE2), nullptr, 16 / P9MODE, EFF / 2, (int)gridDim.x, (int)blockIdx.x,
                 (size_t)2048 * 512, false, 128 * P9MODE};
    pg8::gemm_phase<false, false, P9MODE>(lds, EFF / 2, S, epi);
}
typedef float f32x2v __attribute__((ext_vector_type(2)));
__device__ __forceinline__ void phase10(LDSP unsigned char* lds, const Params& p) {
    build_expert_tables(lds, p);
    const LDSP int* ST = (const LDSP int*)(lds + LE_TAB) + 72;
    const int tid = opaque(threadIdx.x), wid = tid >> 6, lane = tid & 63;
    const float* MOD = (const float*)(p.ws + OFF_MOD);
    const float* X1 = (const float*)(p.ws + OFF_X1);
    const unsigned char* EO = p.ws + OFF_EO;
    for (int row = blockIdx.x * 8 + wid; row < NX; row += gridDim.x * 8) {
        unsigned er[9]; float gw[9];
#pragma unroll
        for (int k = 0; k < 8; ++k) { const int e = ((const int*)(p.ws + OFF_EIDX))[row * 8 + k], sl = ((const int*)(p.ws + OFF_ESLOT))[row * 8 + k];
            er[k] = (unsigned)(ST[e] + sl) * (unsigned)D; gw[k] = ((const float*)(p.ws + OFF_GATE))[row * 8 + k]; }
        er[8] = (unsigned)(ST[NE] + row) * (unsigned)D; gw[8] = 1.f;
        const float* md = MOD + (size_t)(row >> 12) * 12288 + 5 * D;
        LDSP float* RB = (LDSP float*)lds + wid * 2048;
        float ss = 0.f;
#pragma unroll 2
        for (int i = 0; i < 4; ++i) { const int col = 8 * (lane + 64 * i);
            float a[8];
#pragma unroll
            for (int j = 0; j < 8; ++j) a[j] = 0.f;
#pragma unroll
            for (int k = 0; k < 9; ++k) { const u32x2 w = *(const u32x2*)(EO + er[k] + col);
                const f32x2v f0 = __builtin_amdgcn_cvt_pk_f32_fp8((int)w.x, false), f1 = __builtin_amdgcn_cvt_pk_f32_fp8((int)w.x, true), f2 = __builtin_amdgcn_cvt_pk_f32_fp8((int)w.y, false), f3 = __builtin_amdgcn_cvt_pk_f32_fp8((int)w.y, true);
                a[0] += gw[k] * f0.x; a[1] += gw[k] * f0.y; a[2] += gw[k] * f1.x; a[3] += gw[k] * f1.y; a[4] += gw[k] * f2.x; a[5] += gw[k] * f2.y; a[6] += gw[k] * f3.x; a[7] += gw[k] * f3.y; }
            const f32x4 xa = *(const f32x4*)(X1 + (size_t)row * D + col), xb = *(const f32x4*)(X1 + (size_t)row * D + col + 4), ga = *(const f32x4*)(md + col), gb = *(const f32x4*)(md + col + 4);
            f32x4 va, vb; va.x = xa.x + ga.x * a[0]; va.y = xa.y + ga.y * a[1]; va.z = xa.z + ga.z * a[2]; va.w = xa.w + ga.w * a[3];
            vb.x = xb.x + gb.x * a[4]; vb.y = xb.y + gb.y * a[5]; vb.z = xb.z + gb.z * a[6]; vb.w = xb.w + gb.w * a[7];
            ss += va.x * va.x + va.y * va.y + va.z * va.z + va.w * va.w + vb.x * vb.x + vb.y * vb.y + vb.z * vb.z + vb.w * vb.w;
            *(LDSP f32x4*)(RB + col) = va; *(LDSP f32x4*)(RB + col + 4) = vb; }
        ss = wave_sum(ss); const float rs = rsqrtf(ss * (1.f / D) + 1e-6f);
#pragma unroll 4
        for (int i = 0; i < 8; ++i) { const int col = 4 * (lane + 64 * i); const f32x4 g = *(const f32x4*)(p.final_g + col);
            const f32x4 xv = *(const LDSP f32x4*)(RB + col);
            f32x4 o; o.x = xv.x * rs * g.x; o.y = xv.y * rs * g.y; o.z = xv.z * rs * g.z; o.w = xv.w * rs * g.w;
            *(f32x4*)(p.out + (size_t)row * D + col) = o; }
    }
}

#define XB_TMO      128
#define XB_XCNT(j)  (256  + 64 * (j))
#define XB_XSUB(j)  (1280 + 64 * (j))
#define XB_XGEN(j)  (2304 + 64 * (j))
#define XB_TOP      3328
#define XB_TOPGEN   3392
#define XB_SPIN_CAP (1u << 20)
__device__ __forceinline__ unsigned xb_ld(unsigned* p)              { return __hip_atomic_load(p, __ATOMIC_RELAXED, __HIP_MEMORY_SCOPE_AGENT); }
__device__ __forceinline__ unsigned xb_add(unsigned* p, unsigned v) { return __hip_atomic_fetch_add(p, v, __ATOMIC_RELAXED, __HIP_MEMORY_SCOPE_AGENT); }
__device__ __forceinline__ unsigned xb_xcc_id() { return (unsigned)__builtin_amdgcn_s_getreg((3 << 11) | 20) & 0xFu; }
#define XB_SPIN(cond, bar) do { unsigned _sp = 0; while (cond) { __builtin_amdgcn_s_sleep(1); \
    if ((++_sp & 255u) == 0u) { if (xb_ld(&(bar)[XB_TMO])) break; if (_sp > XB_SPIN_CAP) { atomicAdd(&(bar)[XB_TMO], 1u); break; } } } } while (0)
__device__ __forceinline__ unsigned xcd_barrier_complete(unsigned* bar, unsigned x) {
    const unsigned G = gridDim.x * gridDim.y * gridDim.z;
    unsigned sum, cnt, mine, sp = 0u;
    for (;;) {
        sum = 0u; cnt = 0u; mine = 0u;
#pragma unroll
        for (unsigned j = 0; j < 16; ++j) { const unsigned c = xb_ld(&bar[XB_XCNT(j)]); sum += c; cnt += (c > 0u) ? 1u : 0u; mine = (j == x) ? c : mine; }
        if (sum == G) break;
        __builtin_amdgcn_s_sleep(1);
        if ((++sp & 255u) == 0u) { if (xb_ld(&bar[XB_TMO])) break; if (sp > XB_SPIN_CAP) { atomicAdd(&bar[XB_TMO], 1u); break; } }
    }
    return (mine > 0u ? mine : 1u) | ((cnt > 0u ? cnt : 1u) << 16);
}
__device__ __forceinline__ void xcd_barrier(unsigned* bar, unsigned x, volatile LDSP unsigned* st) {
    asm volatile("s_waitcnt vmcnt(0)" ::: "memory");
    __syncthreads();
    if (threadIdx.x == 0) {
        __builtin_amdgcn_s_waitcnt(0);
        unsigned pk = st[0];
        if (pk == 0u) { pk = xcd_barrier_complete(bar, x); st[0] = pk; }
        const unsigned nloc = pk & 0xffffu, nx = pk >> 16;
        const unsigned old = xb_add(&bar[XB_XSUB(x)], 1u);
        const unsigned gen = old / nloc;
        if (old + 1u == (gen + 1u) * nloc) {
            __builtin_amdgcn_fence(__ATOMIC_RELEASE, "agent");
            asm volatile("s_waitcnt vmcnt(0)" ::: "memory");
            const unsigned og = xb_add(&bar[XB_TOP], 1u);
            const unsigned tg = og / nx;
            if (og + 1u == (tg + 1u) * nx) xb_add(&bar[XB_TOPGEN], 1u);
            else XB_SPIN(xb_ld(&bar[XB_TOPGEN]) == tg, bar);
            __builtin_amdgcn_fence(__ATOMIC_ACQUIRE, "agent");
            xb_add(&bar[XB_XGEN(x)], 1u);
            asm volatile("s_waitcnt vmcnt(0)" ::: "memory");
        } else {
            XB_SPIN(xb_ld(&bar[XB_XGEN(x)]) == gen, bar);
            __builtin_amdgcn_fence(__ATOMIC_ACQUIRE, "agent");
            asm volatile("s_waitcnt vmcnt(0)" ::: "memory");
        }
    }
    __syncthreads();
}

__global__ void __launch_bounds__(512, 2) fwd_megakernel(Params p) {
    __shared__ __attribute__((aligned(16))) unsigned char smem_raw[SMEM_BYTES];
    LDSP unsigned char* lds = (LDSP unsigned char*)smem_raw;
    volatile LDSP unsigned* xst = (volatile LDSP unsigned*)(lds + SMEM_BYTES - 16);
    if (threadIdx.x == 0) { xst[0] = 0u; xst[1] = 0u; }
    __syncthreads();
    const unsigned xcc = xb_xcc_id();
    if (threadIdx.x == 0) (void)xb_add(&((unsigned*)p.ws)[XB_XCNT(xcc)], 1u);
#define GSYNC xcd_barrier((unsigned*)p.ws, xcc, xst)
#ifndef PH_TWICE
#define PH_TWICE 0
#endif
#ifndef PH_MASK
#define PH_MASK 0xffff
#endif
#define RUN_PHASE(bit, fn) _Pragma("unroll 1") for (int rep = 0; rep < ((PH_TWICE & (bit)) ? 2 : 1); ++rep) { if (rep) GSYNC; if (PH_MASK & (bit)) { Params q = p; q.ws = opq(p.ws); fn(lds, q); } }
    RUN_PHASE(1, phase0)      GSYNC;
    RUN_PHASE(2, phase1)      GSYNC;
    RUN_PHASE(4, phase2)      GSYNC;
    RUN_PHASE(8, phaseR1)     GSYNC;
    RUN_PHASE(16, phaseR2)    GSYNC;
    RUN_PHASE(32, phaseR3)    GSYNC;
    RUN_PHASE(64, phaseR4)    GSYNC;
    RUN_PHASE(128, phaseR5)   GSYNC;
    RUN_PHASE(256, phase6)    GSYNC;
    RUN_PHASE(512, phase7)    GSYNC;
    RUN_PHASE(1024, phase8)   GSYNC;
    RUN_PHASE(2048, phase9)   GSYNC;
    RUN_PHASE(4096, phase10)
}

extern "C" void kernel_launch(void* const* d_in, const int* in_sizes, int n_in, void* d_out, int out_size, void* d_ws, size_t ws_size, hipStream_t stream) {
    static int grid_blocks = 0;
    if (!grid_blocks) {
        int dev = 0, cus = 0, per_cu = 0;
        (void)hipGetDevice(&dev);
        (void)hipDeviceGetAttribute(&cus, hipDeviceAttributeMultiprocessorCount, dev);
        (void)hipOccupancyMaxActiveBlocksPerMultiprocessor(&per_cu, fwd_megakernel, 512, 0);
        if (per_cu > 1) per_cu = 1;
        grid_blocks = cus * per_cu;
        if (ws_size < WS_END) fprintf(stderr, "workspace too small: %zu < %zu\n", ws_size, (size_t)WS_END);
    }
    Params p{};
    const float** f = (const float**)&p;
    for (int i = 0; i < 31; ++i) f[i] = (const float*)d_in[i];
    p.out = (float*)d_out; p.ws = (unsigned char*)d_ws;
    (void)hipMemsetAsync(d_ws, 0, 32768, stream);
    void* args[] = {&p};
    hipError_t e = hipLaunchCooperativeKernel((void*)fwd_megakernel, dim3(grid_blocks), dim3(512), args, 0, stream);
    if (e != hipSuccess) fprintf(stderr, "cooperative launch failed: %s (grid %d)\n", hipGetErrorString(e), grid_blocks);
}
```

```cpp
#include <hip/hip_runtime.h>
#include <hip/hip_cooperative_groups.h>
#include <cstdio>
#include <cstdint>
namespace cg = cooperative_groups;

#define LDSP __attribute__((address_space(3)))
typedef unsigned short bf16_t;
typedef short bf16x8 __attribute__((ext_vector_type(8)));
typedef float f32x4 __attribute__((ext_vector_type(4)));
typedef float f32x16 __attribute__((ext_vector_type(16)));
typedef unsigned u32x4 __attribute__((ext_vector_type(4)));
typedef unsigned u32x2 __attribute__((ext_vector_type(2)));
typedef int v4i __attribute__((ext_vector_type(4)));
typedef int v8i __attribute__((ext_vector_type(8)));
__device__ __forceinline__ u32x4 mk4u(unsigned a, unsigned b, unsigned c, unsigned d) { u32x4 r; r.x = a; r.y = b; r.z = c; r.w = d; return r; }
__device__ __forceinline__ u32x2 mk2u(unsigned a, unsigned b) { u32x2 r; r.x = a; r.y = b; return r; }
__device__ __forceinline__ f32x4 mk4f(float a, float b, float c, float d) { f32x4 r; r.x = a; r.y = b; r.z = c; r.w = d; return r; }

constexpr int D = 2048, NB = 2, T = 4096, CL = 256, NX = NB * T, NCX = NB * CL, NR = NX + NCX;
constexpr int INC = 5056, INP = 5120;
constexpr int C_R = 0, C_K = 1024, C_V = 2048, C_XW = 3072, C_XA = 3168, C_XG = 3264, C_Q = 3520, C_AK = 4544, C_AV = 4800;
constexpr int NE = 64, NEX = 65, EFF = 512;
constexpr int NCHUNK = 68;
constexpr int NINST = NB * 16 * 2 * NCHUNK;
constexpr int EROWS = NX * 8 + NX;

constexpr size_t al4k(size_t x) { return (x + 4095) & ~(size_t)4095; }
constexpr size_t OFF_CTL = 0;
constexpr size_t OFF_ROPE = 65536;
constexpr size_t OFF_MODP = OFF_ROPE + 8192;
constexpr size_t OFF_MOD = al4k(OFF_MODP + (size_t)16 * 3 * 12288 * 4);
constexpr size_t OFF_WTDU = al4k(OFF_MOD + (size_t)3 * 12288 * 4);
constexpr size_t OFF_WTIU = OFF_WTDU + (size_t)2 * 1024 * 128 * 2;
constexpr size_t OFF_WTGU = OFF_WTIU + (size_t)2 * 1024 * 128 * 2;
constexpr size_t OFF_WTE2 = OFF_WTGU + (size_t)1024 * 256 * 2;
constexpr size_t OFF_X1 = OFF_WTE2 + (size_t)NEX * 2048 * 512 * 2;
constexpr size_t OFF_H2 = OFF_X1 + (size_t)NX * D * 4;
constexpr size_t OFF_TOKL = OFF_H2 + (size_t)NX * D * 2;
constexpr size_t OFF_EIDX = OFF_TOKL + (size_t)NE * NX * 4;
constexpr size_t OFF_ESLOT = OFF_EIDX + (size_t)NX * 8 * 4;
constexpr size_t OFF_GATE = OFF_ESLOT + (size_t)NX * 8 * 4;
constexpr size_t OFF_H1 = OFF_GATE + (size_t)NX * 8 * 4;
constexpr size_t OFF_WTE1 = al4k(OFF_H1 + (size_t)(EROWS + 256) * EFF * 2);
constexpr size_t OFF_EO = OFF_WTE1;
constexpr size_t OFF_WTIN = OFF_WTE1 + (size_t)NEX * 1024 * 2048 * 2;
constexpr size_t OFF_WTOUT = OFF_WTIN + (size_t)INP * D * 2;
constexpr size_t OFF_HX = OFF_WTOUT + (size_t)D * D * 2;
constexpr size_t OFF_PX = OFF_HX + (size_t)NR * D * 2;
constexpr size_t OFF_CM = OFF_PX + (size_t)NR * INP * 2;
constexpr size_t OFF_CN = OFF_CM + (size_t)NINST * 4096 * 2;
constexpr size_t OFF_CP = OFF_CN + (size_t)NINST * 4096 * 2;
constexpr size_t OFF_CQ = OFF_CP + (size_t)NINST * 4096 * 2;
constexpr size_t OFF_YD = OFF_CQ + (size_t)NINST * 4096 * 2;
constexpr size_t OFF_BON = OFF_YD + (size_t)2 * NX * 1024 * 4;
constexpr size_t OFF_MIX = OFF_BON + (size_t)2 * NX * 16 * 4;
constexpr size_t WS_END = OFF_MIX + (size_t)NX * D * 2;
constexpr size_t OFF_RS = OFF_X1;
constexpr size_t OFF_KS = OFF_RS + (size_t)NR * 1024 * 2;
constexpr size_t OFF_KK = OFF_KS + (size_t)NR * 1024 * 2;
constexpr size_t OFF_VS = OFF_KK + (size_t)NR * 1024 * 2;
constexpr size_t OFF_TW = OFF_VS + (size_t)NR * 1024 * 2;
constexpr size_t OFF_XA = OFF_TW + (size_t)NR * 128 * 2;
constexpr size_t OFF_SG = OFF_XA + (size_t)NR * 128 * 2;
constexpr size_t OFF_LWG = OFF_SG + (size_t)NX * 256 * 2;
constexpr size_t OFF_AIG = OFF_LWG + (size_t)NR * 2048 * 2;
constexpr size_t OFF_GG = OFF_AIG + (size_t)NR * 2048 * 2;
static_assert(OFF_GG + (size_t)NX * 1024 * 2 <= OFF_WTE1, "RWKV token buffers fit the overlay region");
static_assert(OFF_EO + (size_t)EROWS * D * 2 <= OFF_HX, "EO overlays only WT_E1/WT_IN/WT_OUT");
static_assert(WS_END <= (size_t)1073741824, "workspace map must fit 1 GiB");

constexpr int SMEM_BYTES = 157 * 1024;

struct Params {
    const float *x, *c, *ctx, *c_ctx, *w_mod, *b_mod, *norm1_g, *norm2_g, *w_in, *shift_mu, *k_k, *k_a, *r_k, *decay_bias, *decay_up, *iclr_bias, *iclr_up,
        *gate_up, *lnx_g, *lnx_b, *attn_sink, *w_out, *w_router, *expert_bias, *e_gate, *e_up, *e_down, *s_gate, *s_up, *s_down, *final_g;
    float* out;
    unsigned char* ws;
    int flags;
};

__device__ __forceinline__ unsigned f2bf(float f) { unsigned u = __float_as_uint(f); return (u + 0x7fffu + ((u >> 16) & 1u)) >> 16; }
__device__ __forceinline__ float bf2f(unsigned h) { return __uint_as_float(h << 16); }
typedef float f32x2_t __attribute__((ext_vector_type(2)));
typedef __bf16 bf16x2_t __attribute__((ext_vector_type(2)));
__device__ __forceinline__ unsigned pk2(float lo, float hi) { f32x2_t v = {lo, hi}; bf16x2_t b = __builtin_convertvector(v, bf16x2_t); return __builtin_bit_cast(unsigned, b); }
__device__ __forceinline__ unsigned pk4_fp8(float a, float b, float c, float d) { int w = 0; w = __builtin_amdgcn_cvt_pk_fp8_f32(a, b, w, false); w = __builtin_amdgcn_cvt_pk_fp8_f32(c, d, w, true); return (unsigned)w; }
__device__ __forceinline__ int opaque(int x);
__device__ __forceinline__ float shx(float v, int o) {
    const int l = opaque((int)threadIdx.x) & 63;
    return __builtin_bit_cast(float, __builtin_amdgcn_ds_bpermute((l ^ o) << 2, __builtin_bit_cast(int, v))); }
__device__ __forceinline__ float wave_sum(float v) {
#pragma unroll
    for (int o = 32; o > 0; o >>= 1) v += shx(v, o);
    return v;
}
__device__ __forceinline__ int opaque(int x) { asm volatile("" : "+v"(x)); return x; }
__device__ __forceinline__ int opaque_s(int x) { asm volatile("" : "+s"(x)); return x; }
__device__ __forceinline__ unsigned char* opq(unsigned char* x) {
    unsigned long long v = (unsigned long long)x; asm volatile("" : "+s"(v));
    return (unsigned char*)(__attribute__((address_space(1))) unsigned char*)v; }
__device__ __forceinline__ float sigmoidf_(float x) { return __builtin_amdgcn_rcpf(1.f + __expf(-x)); }
__device__ __forceinline__ int lds_byte(int r, int c) { const int st = (r >> 4) * 2 + (c >> 5), rr = r & 15, cc = c & 31, ob = rr * 64 + cc * 2; return st * 1024 + (ob ^ (((ob >> 9) & 1) << 5)); }
__device__ __forceinline__ int sw64(int r, int k) { return r * 128 + ((((k >> 3) ^ (r >> 1)) & 7) << 4) + (k & 7) * 2; }

__device__ __forceinline__ f32x16 zero16() { f32x16 z;
#pragma unroll
    for (int i = 0; i < 16; ++i) z[i] = 0.f; return z; }
__device__ __forceinline__ int crow(int reg, int hi) { return (reg & 3) + 8 * (reg >> 2) + 4 * hi; }

#if defined(__HIP_DEVICE_COMPILE__)
#define LDS_AT(T, addr) (__builtin_bit_cast(LDSP T*, (unsigned)(addr)))
#define LDS_ADDR(ptr) (__builtin_bit_cast(unsigned, (ptr)))
#else
#define LDS_AT(T, addr) ((LDSP T*)(size_t)(addr))
#define LDS_ADDR(ptr) ((unsigned)(size_t)(ptr))
#endif
namespace pg8 {
constexpr int BM = 256, BK = 64, HALF = 128, HTB = HALF * BK * 2, NXCD = 8;
__device__ __forceinline__ void stage_rc(int b, int& R, int& C) { const int st = b / 1024, sb = b % 1024, swz = sb ^ (((sb >> 9) & 1) << 5); R = (st >> 1) * 16 + swz / 64; C = (st & 1) * 32 + (swz % 64) / 2; }
struct Unit { const char* A; const char* B; const int* rowmap; int nvalid, m0, row0, col0, pos0, e; };
__device__ __forceinline__ int xcd_remap(int L, int nwg) { const int q = nwg / NXCD, r = nwg % NXCD, xcd = L % NXCD, off = L / NXCD; return (xcd < r ? xcd * (q + 1) : r * (q + 1) + (xcd - r) * q) + off; }

__device__ __forceinline__ int perm32(int rho) { const int n = rho >> 4, i = rho & 15; return 8 * (i >> 2) + 4 * n + (i & 3); }
template <class F, int NBJ = 2> struct Epi {
    F f;
    __device__ __forceinline__ void operator()(const f32x4 (&acc)[2][2][4][2], const Unit& u, int wr, int wc, int fr, int fq) const {
        { const int lane = opaque((int)threadIdx.x) & 63; fr = lane & 15; fq = lane >> 4; }
#pragma unroll
        for (int ai = 0; ai < 2; ++ai)
#pragma unroll
            for (int m = 0; m < 4; ++m)
#pragma unroll
                for (int bj = 0; bj < NBJ; ++bj) { f(u, 128 * ai + 64 * wr + 16 * m + fr, 128 * bj + 32 * wc + 8 * fq, acc[ai][bj][m][0], acc[ai][bj][m][1]); __builtin_amdgcn_sched_barrier(0); }
    }
};

template <bool GATHER, bool ALIGN_EPI = true, int FP8M = 0, class EpiT, class Sched>
__device__ __forceinline__ void gemm_phase(LDSP unsigned char* lds, const int K, const Sched& S, const EpiT& E) {
    const int tid = opaque(threadIdx.x), wid = __builtin_amdgcn_readfirstlane(tid >> 6), lane = tid & 63, wr = wid >> 2, wc = wid & 3, fr = lane & 15, fq = lane >> 4;
    constexpr bool FP8 = (FP8M != 0), NARROW = (FP8M == 1);
    const int nt = K / BK;
    unsigned voffA[2], voffB[2];
#pragma unroll
    for (int i = 0; i < 2; ++i) { int R, C; stage_rc(tid * 16 + i * 8192, R, C); const int Rb = (R & ~31) + perm32(R & 31); voffA[i] = (unsigned)(R * K + C) * 2u; voffB[i] = (unsigned)(Rb * K + C) * 2u; }
    const size_t kstep = (size_t)(BK * 2);
    const size_t hstep = (size_t)HALF * K * 2;
    const size_t hstepB = hstep;
    const unsigned ldsw = (unsigned)wid * 1024u;
    const int aoff = lds_byte(wr * 64 + fr, fq * 8), boff = lds_byte(wc * 32 + fr, fq * 8);
    const unsigned abase = LDS_ADDR(lds) + (unsigned)aoff, bbase = LDS_ADDR(lds) + 65536u + (unsigned)boff;
#define PG8_SA(b, h) (((b) * 2 + (h)) * HTB)
#define PG8_SB(b, h) ((4 + (b) * 2 + (h)) * HTB)
#define PG8_STAGE(bufoff, gbase, voff) do { _Pragma("unroll") for (int _i = 0; _i < 2; ++_i) \
        { unsigned _o = (voff)[_i]; asm volatile("" : "+v"(_o)); __builtin_amdgcn_global_load_lds((const unsigned*)((const char*)(gbase) + _o), (LDSP unsigned*)(lds + (bufoff) + ldsw + _i * 8192), 16, 0, 0); } } while (0)
#define PG8_STAGE_B1(bufoff, gbase) do { if constexpr (!NARROW) { PG8_STAGE(bufoff, gbase, voffB); } } while (0)
#define PG8_STAGE_A(bufoff, nx, h, ubase, koff) do { if constexpr (GATHER) { unsigned _v[2]; const LDSP unsigned* _ro = rowoff + ((((nx) ? (ui + 1) : ui) & 1) * 4 + (h) * 2) * 512; _v[0] = _ro[0]; _v[1] = _ro[512]; PG8_STAGE(bufoff, (ubase) + (koff), _v); } \
        else { PG8_STAGE(bufoff, (ubase) + (h) * hstep + (koff), voffA); } } while (0)
#define PG8_LD16(off) (*(const LDSP bf16x8*)(lds + (off)))
#define PG8_DSR(base, off) ({ v4i _r; asm volatile("ds_read_b128 %0, %1 offset:%2" : "=v"(_r) : "v"(base), "n"(off)); _r; })
#define PG8_LDA(dst, b, h) do { _Pragma("unroll") for (int m = 0; m < 4; ++m) { if constexpr (FP8) dst##8[m] = __builtin_shufflevector(PG8_DSR(abase, PG8_SA(b, h) + m * 2048), PG8_DSR(abase, PG8_SA(b, h) + m * 2048 + 1024), 0, 1, 2, 3, 4, 5, 6, 7); \
        else { _Pragma("unroll") for (int k = 0; k < 2; ++k) dst[m][k] = PG8_LD16(PG8_SA(b, h) + aoff + m * 2048 + k * 1024); } } } while (0)
#define PG8_LDB(dst, b, h) do { if constexpr (!NARROW || (h) == 0) { _Pragma("unroll") for (int n = 0; n < 2; ++n) { if constexpr (FP8) dst##8[n] = __builtin_shufflevector(PG8_DSR(bbase, PG8_SB(b, h) - 65536 + n * 2048), PG8_DSR(bbase, PG8_SB(b, h) - 65536 + n * 2048 + 1024), 0, 1, 2, 3, 4, 5, 6, 7); \
        else { _Pragma("unroll") for (int k = 0; k < 2; ++k) dst[n][k] = PG8_LD16(PG8_SB(b, h) + boff + n * 2048 + k * 1024); } } } } while (0)
#define PG8_MMA(ai, bj, At, Bt) do { if constexpr (!NARROW || (bj) == 0) { if constexpr (FP8) __builtin_amdgcn_sched_barrier(0); __builtin_amdgcn_s_setprio(1); if constexpr (FP8) { _Pragma("unroll") for (int m = 0; m < 4; ++m) _Pragma("unroll") for (int n = 0; n < 2; ++n) \
            acc[ai][bj][m][n] = __builtin_amdgcn_mfma_scale_f32_16x16x128_f8f6f4(Bt##8[n], At##8[m], acc[ai][bj][m][n], 0, 0, 0, 0x7f7f7f7f, 0, 0x7f7f7f7f); } \
        else { _Pragma("unroll") for (int m = 0; m < 4; ++m) _Pragma("unroll") for (int n = 0; n < 2; ++n) _Pragma("unroll") for (int k = 0; k < 2; ++k) \
            acc[ai][bj][m][n] = __builtin_amdgcn_mfma_f32_16x16x32_bf16(Bt[n][k], At[m][k], acc[ai][bj][m][n], 0, 0, 0); } __builtin_amdgcn_s_setprio(0); } } while (0)
#define PG8_WAIT_V(n) asm volatile("s_waitcnt vmcnt(" #n ")" ::: "memory")
#define PG8_WAIT_L(n) asm volatile("s_waitcnt lgkmcnt(" #n ")" ::: "memory")
#define PG8_BAR __builtin_amdgcn_s_barrier()
#define PG8_SCHED __builtin_amdgcn_sched_barrier(0)
    Unit cur, nxt; int ui = 0;
    cur.e = 0; nxt.e = 0;
    if (!S.next(0, cur)) return;
    LDSP unsigned* rowoff = (LDSP unsigned*)(lds + 132096) + tid;
    auto rows_of = [&](const Unit& u, int slot) {
        if constexpr (GATHER) {
#pragma unroll
            for (int h = 0; h < 2; ++h)
#pragma unroll
                for (int i = 0; i < 2; ++i) { int R, C; stage_rc(tid * 16 + i * 8192, R, C); const int idx = u.m0 + h * HALF + R; int gr = idx; if (u.rowmap) gr = (idx < u.nvalid) ? u.rowmap[idx] : 0;
                    rowoff[((slot & 1) * 4 + h * 2 + i) * 512] = (unsigned)(gr * K + C) * 2u; }
        }
    };
    rows_of(cur, 0);
    f32x4 acc[2][2][4][2];
#pragma unroll
    for (int a = 0; a < 2; ++a)
#pragma unroll
        for (int b = 0; b < 2; ++b)
#pragma unroll
            for (int m = 0; m < 4; ++m)
#pragma unroll
                for (int n = 0; n < 2; ++n) acc[a][b][m][n] = (f32x4){0.f, 0.f, 0.f, 0.f};
    bf16x8 At[4][2], B0[2][2], B1[2][2];
    v8i At8[4], B08[2], B18[2];
    const char* cA = cur.A; const char* cB = cur.B;
    PG8_STAGE(PG8_SB(0, 0), cB, voffB); PG8_STAGE_B1(PG8_SB(0, 1), cB + hstepB); PG8_STAGE_A(PG8_SA(0, 0), false, 0, cA, 0); PG8_STAGE_A(PG8_SA(0, 1), false, 1, cA, 0);
    if (wr == 1) PG8_BAR;
    PG8_WAIT_V(2); PG8_BAR;
    PG8_STAGE(PG8_SB(1, 0), cB + kstep, voffB); PG8_STAGE_A(PG8_SA(1, 0), false, 0, cA, kstep); PG8_STAGE_B1(PG8_SB(1, 1), cB + hstepB + kstep);
    if constexpr (NARROW) PG8_WAIT_V(4); else PG8_WAIT_V(6);
    PG8_BAR;
    for (;;) {
        nxt.e = cur.e;
        const bool has_next = S.next(ui + 1, nxt);
        rows_of(has_next ? nxt : cur, ui + 1);
        const char* nA = has_next ? nxt.A : cA; const char* nB = has_next ? nxt.B : cB;
#pragma unroll 1
        for (int t = 0; t < nt; t += 2) {
            const bool last = (t == nt - 2);
            const size_t k1 = (size_t)(t + 1) * kstep;
            const char* a2 = last ? nA : cA; const size_t k2 = last ? 0 : (size_t)(t + 2) * kstep;
            const char* b2 = last ? nB : cB + (size_t)(t + 2) * kstep;
            const char* b3 = b2 + kstep;
            PG8_LDB(B0, 0, 0); PG8_LDB(B1, 0, 1); PG8_SCHED; PG8_LDA(At, 0, 0); PG8_STAGE_A(PG8_SA(1, 1), false, 1, cA, k1);
            if constexpr (NARROW) PG8_WAIT_V(6); else PG8_WAIT_V(8);
            PG8_WAIT_L(0); PG8_BAR; PG8_MMA(0, 0, At, B0); PG8_MMA(0, 1, At, B1); PG8_BAR; PG8_SCHED;
            PG8_LDA(At, 0, 1); PG8_STAGE(PG8_SB(0, 0), b2, voffB); PG8_STAGE_B1(PG8_SB(0, 1), b2 + hstepB); PG8_STAGE_A(PG8_SA(0, 0), last, 0, a2, k2);
            if constexpr (NARROW) PG8_WAIT_V(6); else PG8_WAIT_V(8);
            PG8_WAIT_L(0); PG8_BAR; PG8_MMA(1, 0, At, B0); PG8_MMA(1, 1, At, B1); PG8_BAR; PG8_SCHED;
            PG8_LDB(B0, 1, 0); PG8_LDB(B1, 1, 1); PG8_SCHED; PG8_LDA(At, 1, 0); PG8_STAGE_A(PG8_SA(0, 1), last, 1, a2, k2);
            if constexpr (NARROW) PG8_WAIT_V(6); else PG8_WAIT_V(8);
            PG8_WAIT_L(0); PG8_BAR; PG8_MMA(0, 0, At, B0); PG8_MMA(0, 1, At, B1); PG8_BAR; PG8_SCHED;
            PG8_LDA(At, 1, 1); PG8_STAGE(PG8_SB(1, 0), b3, voffB); PG8_STAGE_B1(PG8_SB(1, 1), b3 + hstepB); PG8_STAGE_A(PG8_SA(1, 0), last, 0, a2, k2 + kstep);
            if constexpr (NARROW) PG8_WAIT_V(6); else PG8_WAIT_V(8);
            PG8_WAIT_L(0); PG8_BAR; PG8_MMA(1, 0, At, B0); PG8_MMA(1, 1, At, B1); PG8_BAR; PG8_SCHED;
        }
        if constexpr (ALIGN_EPI) { if (wr == 0) PG8_BAR; }
        E(acc, cur, wr, wc, fr, fq);
        if (!has_next) break;
#pragma unroll
        for (int a = 0; a < 2; ++a)
#pragma unroll
            for (int b = 0; b < 2; ++b)
#pragma unroll
                for (int m = 0; m < 4; ++m)
#pragma unroll
                    for (int n = 0; n < 2; ++n) acc[a][b][m][n] = (f32x4){0.f, 0.f, 0.f, 0.f};
        cur = nxt; cA = nA; cB = nB; ++ui;
        if constexpr (ALIGN_EPI) { if (wr == 1) PG8_BAR; }
    }
    PG8_WAIT_V(0);
    if constexpr (!ALIGN_EPI) { if (wr == 0) PG8_BAR; }
    PG8_BAR;
#undef PG8_SA
#undef PG8_SB
#undef PG8_STAGE
#undef PG8_STAGE_A
#undef PG8_STAGE_B1
#undef PG8_LDA
#undef PG8_LD16
#undef PG8_DSR
#undef PG8_LDB
#undef PG8_MMA
#undef PG8_WAIT_V
#undef PG8_WAIT_L
#undef PG8_BAR
#undef PG8_SCHED
}

struct DenseSched {
    const char* A; const char* B; int nM, nN, K, G, c;
    __device__ __forceinline__ bool next(int i, Unit& u) const {
        const int nwg = nM * nN; const long L = (long)i * G + c; if (L >= nwg) return false;
        const int wgid = xcd_remap((int)L, nwg);
        const int nig = 8 * nN, gid = wgid / nig, fm = gid * 8, gsz = (nM - fm) < 8 ? (nM - fm) : 8;
        const int pm = fm + ((wgid % nig) % gsz), pn = (wgid % nig) / gsz;
        u.A = A + (size_t)pm * 256 * K * 2; u.B = B + (size_t)pn * 256 * K * 2; u.rowmap = nullptr; u.nvalid = 0; u.m0 = 0; u.row0 = pm * 256; u.col0 = pn * 256; u.pos0 = 0;
        return true;
    }
};
}

struct FPX { bf16_t* PX; __device__ __forceinline__ void operator()(const pg8::Unit& u, int lr, int lc, f32x4 v0, f32x4 v1) const {
    *(u32x4*)(PX + (size_t)(u.row0 + lr) * INP + u.col0 + lc) = mk4u(pk2(v0[0], v0[1]), pk2(v0[2], v0[3]), pk2(v1[0], v1[1]), pk2(v1[2], v1[3])); } };
struct FX1 { const float* x; const float* mod; float* X1; float sc; __device__ __forceinline__ void operator()(const pg8::Unit& u, int lr, int lc, f32x4 v0, f32x4 v1) const {
    const int row = u.row0 + lr, col = u.col0 + lc; const float* xp = x + (size_t)row * D + col; const float* gp = mod + (size_t)(row >> 12) * 12288 + 2 * D + col; float* op = X1 + (size_t)row * D + col;
    *(f32x4*)op = *(const f32x4*)xp + *(const f32x4*)gp * (v0 * sc); *(f32x4*)(op + 4) = *(const f32x4*)(xp + 4) + *(const f32x4*)(gp + 4) * (v1 * sc); } };
constexpr float W1_SCALE = 64.f, W2_SCALE = 32.f;
struct FH1 { unsigned char* H1; __device__ __forceinline__ void operator()(const pg8::Unit& u, int lr, int lc, f32x4 v0, f32x4 v1) const {
    if (u.m0 + lr < u.nvalid) { float h[4];
#pragma unroll
        for (int e = 0; e < 4; ++e) { const float g = v0[e] * (1.f / W1_SCALE); h[e] = g * sigmoidf_(g) * (v1[e] * (1.f / W1_SCALE)); }
        *(unsigned*)(H1 + (unsigned)((u.pos0 + u.m0 + lr) * EFF + ((u.col0 + lc) >> 1))) = pk4_fp8(h[0], h[1], h[2], h[3]); } } };
struct FEO { unsigned char* EO; __device__ __forceinline__ void operator()(const pg8::Unit& u, int lr, int lc, f32x4 v0, f32x4 v1) const {
    if (u.m0 + lr < u.nvalid) { v0 *= (1.f / W2_SCALE); v1 *= (1.f / W2_SCALE);
        *(u32x2*)(EO + (unsigned)((u.pos0 + u.m0 + lr) * D + u.col0 + lc)) = mk2u(pk4_fp8(v0[0], v0[1], v0[2], v0[3]), pk4_fp8(v1[0], v1[1], v1[2], v1[3])); } } };

struct ConvJob { const float* src; bf16_t* dst; int K, N, ld, mode, ntk, ntn; size_t sbs, dbs; };
__device__ __forceinline__ int conv_row(int n, int mode) { return mode == 0 ? n : (8 * (n >> 2) + (n & 3) + (mode == 2 ? 4 : 0)); }

struct TileCtx { const float* src; bf16_t* dst; int N, ld, mode, k0, n0; };
constexpr int CT0 = 0, CT1 = CT0 + 8 * (INC / 64), CT2 = CT1 + 8 * 32, CT3 = CT2 + 64 * 64, CT4 = CT3 + 64 * 64, CT5 = CT4 + 64 * 64, CT6 = CT5 + 64, CT7 = CT6 + 64, CT8 = CT7 + 64, CT_END = CT8 + 16;
__device__ __forceinline__ void conv_decode(const Params& p, int g, const float*& src, bf16_t*& dst, int& N, int& ld, int& mode, int& k0, int& n0) {
    unsigned char* WTE1 = p.ws + OFF_WTE1; unsigned char* WTE2 = p.ws + OFF_WTE2;
    unsigned char* d8; int t, ntk, ntn; size_t sbs = 0, dbs = 0;
    if (g < CT1)      { t = g - CT0; src = p.w_in; d8 = p.ws + OFF_WTIN; N = INC; ld = 4096; mode = 0; ntk = 8; ntn = INC / 64; }
    else if (g < CT2) { t = g - CT1; src = p.w_out; d8 = p.ws + OFF_WTOUT; N = 2048; ld = 2048; mode = 4; ntk = 8; ntn = 32; }
    else if (g < CT3) { t = g - CT2; src = p.e_gate; d8 = WTE1; N = 512; ld = 2048; mode = 5; ntk = 8; ntn = 8; sbs = (size_t)2048 * 512; dbs = (size_t)1024 * 2048; }
    else if (g < CT4) { t = g - CT3; src = p.e_up; d8 = WTE1; N = 512; ld = 2048; mode = 6; ntk = 8; ntn = 8; sbs = (size_t)2048 * 512; dbs = (size_t)1024 * 2048; }
    else if (g < CT5) { t = g - CT4; src = p.e_down; d8 = WTE2; N = 2048; ld = 512; mode = 4; ntk = 2; ntn = 32; sbs = (size_t)512 * 2048; dbs = (size_t)2048 * 512; }
    else if (g < CT6) { t = g - CT5; src = p.s_gate; d8 = WTE1 + (size_t)64 * 1024 * 2048; N = 512; ld = 2048; mode = 5; ntk = 8; ntn = 8; }
    else if (g < CT7) { t = g - CT6; src = p.s_up; d8 = WTE1 + (size_t)64 * 1024 * 2048; N = 512; ld = 2048; mode = 6; ntk = 8; ntn = 8; }
    else if (g < CT8) { t = g - CT7; src = p.s_down; d8 = WTE2 + (size_t)64 * 2048 * 512; N = 2048; ld = 512; mode = 4; ntk = 2; ntn = 32; }
    else              { t = g - CT8; src = p.gate_up; d8 = p.ws + OFF_WTGU; N = 1024; ld = 512; mode = 0; ntk = 1; ntn = 16; }
    const int per = ntk * ntn, bi = t / per, rem = t - bi * per, kt = rem / ntn, ntile = rem - kt * ntn;
    src += (size_t)bi * sbs; dst = (bf16_t*)(d8 + (size_t)bi * dbs); k0 = kt * 256; n0 = ntile * 64;
}
__device__ __forceinline__ void conv_load(const float* src, int N, int k0, int n0, f32x4 (&v)[4][2], int tid) {
    const int kr = tid >> 3, nc = (tid & 7) * 8;
#pragma unroll
    for (int s = 0; s < 4; ++s) { const float* q = src + (size_t)(k0 + s * 64 + kr) * N + n0 + nc; v[s][0] = *(const f32x4*)q; v[s][1] = *(const f32x4*)(q + 4); }
}
__device__ __forceinline__ void conv_finish(LDSP unsigned char* lds, bf16_t* dst, int ld, int mode, int k0, int n0, const f32x4 (&v)[4][2], int tid) {
    LDSP float* Tm = (LDSP float*)lds;
    {
        const int kr = tid >> 3, nc = (tid & 7) * 8;
#pragma unroll
        for (int s = 0; s < 4; ++s) { LDSP float* q = Tm + (s * 64 + kr) * 65 + nc;
            q[0] = v[s][0].x; q[1] = v[s][0].y; q[2] = v[s][0].z; q[3] = v[s][0].w; q[4] = v[s][1].x; q[5] = v[s][1].y; q[6] = v[s][1].z; q[7] = v[s][1].w; }
    }
    __syncthreads();
    {
        const int n = tid >> 3; bf16_t* drow = (bf16_t*)((unsigned char*)dst + (size_t)conv_row(n0 + n, mode & 3) * ld) + k0;
#pragma unroll
        for (int s = 0; s < 4; ++s) { const int kc = ((tid & 7) + 8 * s) * 8; float f[8];
#pragma unroll
            for (int j = 0; j < 8; ++j) f[j] = Tm[(kc + j) * 65 + n];
            u32x4 w; w.x = pk2(f[0], f[1]); w.y = pk2(f[2], f[3]); w.z = pk2(f[4], f[5]); w.w = pk2(f[6], f[7]); *(u32x4*)(drow + kc) = w; }
    }
    __syncthreads();
}

__device__ __forceinline__ void mod_item(LDSP unsigned char* lds, const Params& p, int item) {
    const int kb = item >> 6, nb = item & 63, tid = opaque(threadIdx.x), wid = tid >> 6, lane = tid & 63;
    f32x4 acc[3];
#pragma unroll
    for (int v = 0; v < 3; ++v) acc[v] = mk4f(0.f, 0.f, 0.f, 0.f);
    if (lane < 48) {
#pragma unroll 8
        for (int i = 0; i < 64; ++i) {
            const int k = kb * 512 + wid * 64 + i;
            const float c0 = p.c[k], c1 = p.c[D + k], c2 = p.c_ctx[k];
            const float s0 = c0 * sigmoidf_(c0), s1 = c1 * sigmoidf_(c1), s2 = c2 * sigmoidf_(c2);
            const f32x4 w = *(const f32x4*)(p.w_mod + (size_t)k * 12288 + nb * 192 + 4 * lane);
            acc[0] += s0 * w; acc[1] += s1 * w; acc[2] += s2 * w;
        }
    }
    LDSP float* R = (LDSP float*)lds;
    if (lane < 48) {
#pragma unroll
        for (int v = 0; v < 3; ++v) *(LDSP f32x4*)(R + (wid * 3 + v) * 192 + 4 * lane) = acc[v];
    }
    __syncthreads();
    float* MODP = (float*)(p.ws + OFF_MODP);
    for (int o = tid; o < 3 * 192; o += 512) { const int v = o / 192, cidx = o - v * 192; float sum = 0.f;
#pragma unroll
        for (int w = 0; w < 8; ++w) sum += R[(w * 3 + v) * 192 + cidx];
        MODP[((size_t)kb * 3 + v) * 12288 + nb * 192 + cidx] = sum; }
    __syncthreads();
}

__device__ __forceinline__ void conv_range(LDSP unsigned char* lds, const Params& p, int g0, int g1, int rank, int nblk) {
    const int tid = opaque(threadIdx.x);
    int g = g0 + rank;
    const float* csrc = nullptr; bf16_t* cdst = nullptr; int cN = 0, cld = 0, cmode = 0, ck0 = 0, cn0 = 0;
    const float* nsrc = nullptr; bf16_t* ndst = nullptr; int nN = 0, nld = 0, nmode = 0, nk0 = 0, nn0 = 0;
    f32x4 va[4][2], vb[4][2];
    if (g < g1) { conv_decode(p, g, csrc, cdst, cN, cld, cmode, ck0, cn0); conv_load(csrc, cN, ck0, cn0, va, tid); }
    __builtin_amdgcn_s_waitcnt(0);
#pragma unroll 1
    while (g < g1) {
        const int gn = g + nblk;
        if (gn < g1) { conv_decode(p, gn, nsrc, ndst, nN, nld, nmode, nk0, nn0); conv_load(nsrc, nN, nk0, nn0, vb, tid); }
        conv_finish(lds, cdst, cld, cmode, ck0, cn0, va, tid);
        cdst = ndst; cld = nld; cmode = nmode; ck0 = nk0; cn0 = nn0; g = gn;
#pragma unroll
        for (int s = 0; s < 4; ++s) { va[s][0] = vb[s][0]; va[s][1] = vb[s][1]; }
    }
}

__device__ __forceinline__ void phase0(LDSP unsigned char* lds, const Params& p) {
    const int tid = opaque(threadIdx.x);
    for (int it = blockIdx.x; it < 256; it += gridDim.x) mod_item(lds, p, it);
    conv_range(lds, p, 0, CT1, blockIdx.x, gridDim.x);
    conv_range(lds, p, CT8, CT_END, blockIdx.x, gridDim.x);
    {
        const int total = 4 * 1024 * 128;
        for (int idx = blockIdx.x * 512 + tid; idx < total; idx += gridDim.x * 512) {
            const int mtx = idx >> 17, rem = idx & 131071, n = rem >> 7, k = rem & 127;
            const float* src = (mtx < 2 ? p.decay_up : p.iclr_up) + (size_t)(mtx & 1) * 96 * 1024;
            bf16_t* dst = (bf16_t*)(p.ws + (mtx < 2 ? OFF_WTDU : OFF_WTIU)) + (size_t)(mtx & 1) * 1024 * 128;
            dst[n * 128 + k] = (bf16_t)f2bf(k < 96 ? src[(size_t)k * 1024 + n] : 0.f);
        }
    }
    {
        u32x4* z = (u32x4*)((bf16_t*)(p.ws + OFF_WTIN) + (size_t)INC * D);
        const int total = (INP - INC) * D * 2 / 16;
        for (int idx = blockIdx.x * 512 + tid; idx < total; idx += gridDim.x * 512) z[idx] = mk4u(0, 0, 0, 0);
    }
    if (blockIdx.x == gridDim.x - 1) {
        float2* R = (float2*)(p.ws + OFF_ROPE);
        for (int idx = tid; idx < 1024; idx += 512) { const int pos = idx >> 4, f = idx & 15;
            const float freq = powf(10000.f, -(float)f / 16.f); const float ang = (float)pos * freq; R[idx] = make_float2(cosf(ang), sinf(ang)); }
    }
}

__device__ __forceinline__ void phase1(LDSP unsigned char* lds, const Params& p) {
    const int tid = opaque(threadIdx.x), wid = tid >> 6, lane = tid & 63;
    const float* MODP = (const float*)(p.ws + OFF_MODP);
    float* MOD = (float*)(p.ws + OFF_MOD);
    LDSP float* MV = (LDSP float*)lds;
    for (int idx = tid; idx < 3 * 4096; idx += 512) { const int v = idx >> 12, col = idx & 4095; float s = p.b_mod[col];
#pragma unroll
        for (int kb = 0; kb < 4; ++kb) s += MODP[((size_t)kb * 3 + v) * 12288 + col];
        MV[idx] = s; }
    for (int idx = blockIdx.x * 512 + tid; idx < 3 * 12288; idx += gridDim.x * 512) { const int v = idx / 12288, col = idx - v * 12288; float s = p.b_mod[col];
#pragma unroll
        for (int kb = 0; kb < 4; ++kb) s += MODP[((size_t)kb * 3 + v) * 12288 + col];
        MOD[idx] = s; }
    __syncthreads();
    bf16_t* HX = (bf16_t*)(p.ws + OFF_HX);
    for (int row = blockIdx.x * 8 + wid; row < NR; row += gridDim.x * 8) {
        const float* src = row < NX ? p.x + (size_t)row * D : p.ctx + (size_t)(row - NX) * D;
        const int v = row < NX ? (row >> 12) : 2;
        f32x4 xv[8]; float ss = 0.f;
#pragma unroll
        for (int i = 0; i < 8; ++i) { xv[i] = ((const f32x4*)src)[lane + 64 * i]; ss += xv[i].x * xv[i].x + xv[i].y * xv[i].y + xv[i].z * xv[i].z + xv[i].w * xv[i].w; }
        ss = wave_sum(ss);
        const float rs = rsqrtf(ss * (1.f / D) + 1e-6f);
#pragma unroll
        for (int i = 0; i < 8; ++i) { const int col = 4 * (lane + 64 * i);
            const f32x4 g = *(const f32x4*)(p.norm1_g + col); const LDSP float* sh = MV + v * 4096 + col; const LDSP float* sc = sh + 2048;
            const float h0 = xv[i].x * rs * g.x * (1.f + sc[0]) + sh[0], h1 = xv[i].y * rs * g.y * (1.f + sc[1]) + sh[1];
            const float h2 = xv[i].z * rs * g.z * (1.f + sc[2]) + sh[2], h3 = xv[i].w * rs * g.w * (1.f + sc[3]) + sh[3];
            u32x2 w; w.x = pk2(h0, h1); w.y = pk2(h2, h3); *(u32x2*)(HX + (size_t)row * D + col) = w; }
    }
}

__device__ __forceinline__ void phase2(LDSP unsigned char* lds, const Params& p) {
    pg8::Epi<FPX> epi{FPX{(bf16_t*)(p.ws + OFF_PX)}};
    pg8::DenseSched S{(const char*)(p.ws + OFF_HX), (const char*)(p.ws + OFF_WTIN), NR / 256, INP / 256, D, (int)gridDim.x, (int)blockIdx.x};
    pg8::gemm_phase<false>(lds, D, S, epi);
}

__device__ __forceinline__ void phaseR1(LDSP unsigned char* lds, const Params& p) {
    const int tid = opaque(threadIdx.x), wid = tid >> 6, lane = tid & 63;
    const bf16_t* PX = (const bf16_t*)(p.ws + OFF_PX);
    for (int row = blockIdx.x * 8 + wid; row < NR; row += gridDim.x * 8) {
        const bool isx = row < NX;
        const int s0 = isx ? (row & ~(T - 1)) : NX + ((row - NX) & ~(CL - 1)), len = isx ? T : CL;
        const bool hp = row > s0, hn = row + 1 < s0 + len;
        const bf16_t* pc = PX + (size_t)row * INP;
#pragma unroll 1
        for (int it = 0; it < 7; ++it) {
            const int ch = lane + 64 * it;
            if (ch < 440) {
                const int col = ch * 8;
                const u32x4 c4 = *(const u32x4*)(pc + col);
                u32x4 p4 = mk4u(0, 0, 0, 0), n4 = mk4u(0, 0, 0, 0);
                if (hp) p4 = *(const u32x4*)(pc - INP + col);
                if (hn) n4 = *(const u32x4*)(pc + INP + col);
                const f32x4 m0 = *(const f32x4*)(p.shift_mu + col), m1 = *(const f32x4*)(p.shift_mu + col + 4);
                const float mu[8] = {m0.x, m0.y, m0.z, m0.w, m1.x, m1.y, m1.z, m1.w};
                const unsigned cw[4] = {c4.x, c4.y, c4.z, c4.w}, pw[4] = {p4.x, p4.y, p4.z, p4.w}, nw[4] = {n4.x, n4.y, n4.z, n4.w};
                float v[8];
#pragma unroll
                for (int j = 0; j < 4; ++j) {
                    const float c0 = bf2f(cw[j] & 0xffff), c1 = bf2f(cw[j] >> 16);
                    v[2 * j] = c0 + mu[2 * j] * (0.5f * (bf2f(pw[j] & 0xffff) + bf2f(nw[j] & 0xffff)) - c0);
                    v[2 * j + 1] = c1 + mu[2 * j + 1] * (0.5f * (bf2f(pw[j] >> 16) + bf2f(nw[j] >> 16)) - c1);
                }
                if (it < 2) {
                    *(u32x4*)((bf16_t*)(p.ws + OFF_RS) + (size_t)row * 1024 + col) = mk4u(pk2(v[0], v[1]), pk2(v[2], v[3]), pk2(v[4], v[5]), pk2(v[6], v[7]));
                } else if (it < 4) {
                    const int kc = col - C_K;
                    *(u32x4*)((bf16_t*)(p.ws + OFF_KS) + (size_t)row * 1024 + kc) = mk4u(pk2(v[0], v[1]), pk2(v[2], v[3]), pk2(v[4], v[5]), pk2(v[6], v[7]));
                    const f32x4 k0 = *(const f32x4*)(p.k_k + kc), k1 = *(const f32x4*)(p.k_k + kc + 4);
                    const float kq[8] = {k0.x, k0.y, k0.z, k0.w, k1.x, k1.y, k1.z, k1.w};
                    float ss = 0.f;
#pragma unroll
                    for (int j = 0; j < 8; ++j) { v[j] *= kq[j]; ss += v[j] * v[j]; }
                    ss += shx(ss, 1); ss += shx(ss, 2); ss += shx(ss, 4);
                    const float sc = rsqrtf(ss + 1e-12f);
                    *(u32x4*)((bf16_t*)(p.ws + OFF_KK) + (size_t)row * 1024 + kc) = mk4u(pk2(v[0] * sc, v[1] * sc), pk2(v[2] * sc, v[3] * sc), pk2(v[4] * sc, v[5] * sc), pk2(v[6] * sc, v[7] * sc));
                } else if (it < 6) {
                    *(u32x4*)((bf16_t*)(p.ws + OFF_VS) + (size_t)row * 1024 + col - C_V) = mk4u(pk2(v[0], v[1]), pk2(v[2], v[3]), pk2(v[4], v[5]), pk2(v[6], v[7]));
                } else if (ch < 396) {
#pragma unroll
                    for (int j = 0; j < 8; ++j) v[j] = tanhf(v[j]);
                    *(u32x4*)((bf16_t*)(p.ws + OFF_TW) + (size_t)row * 128 + col - C_XW) = mk4u(pk2(v[0], v[1]), pk2(v[2], v[3]), pk2(v[4], v[5]), pk2(v[6], v[7]));
                } else if (ch < 408) {
                    *(u32x4*)((bf16_t*)(p.ws + OFF_XA) + (size_t)row * 128 + col - C_XA) = mk4u(pk2(v[0], v[1]), pk2(v[2], v[3]), pk2(v[4], v[5]), pk2(v[6], v[7]));
                } else if (isx) {
#pragma unroll
                    for (int j = 0; j < 8; ++j) v[j] = sigmoidf_(v[j]);
                    *(u32x4*)((bf16_t*)(p.ws + OFF_SG) + (size_t)row * 256 + col - C_XG) = mk4u(pk2(v[0], v[1]), pk2(v[2], v[3]), pk2(v[4], v[5]), pk2(v[6], v[7]));
                }
            }
        }
        if (lane < 4) { *(u32x4*)((bf16_t*)(p.ws + OFF_TW) + (size_t)row * 128 + 96 + lane * 8) = mk4u(0, 0, 0, 0); *(u32x4*)((bf16_t*)(p.ws + OFF_XA) + (size_t)row * 128 + 96 + lane * 8) = mk4u(0, 0, 0, 0); }
    }
}

struct LoraSched {
    const char *A0, *B0, *A1, *B1; int G, c;
    __device__ __forceinline__ bool next(int i, pg8::Unit& u) const {
        const int per = (NR / 256) * 8; const long L = (long)i * G + c; if (L >= 2 * per) return false;
        const int job = (int)L / per, w = (int)L % per, pm = w >> 3, pn = w & 7;
        u.A = (job ? A1 : A0) + (size_t)pm * 256 * 128 * 2; u.B = (job ? B1 : B0) + (size_t)pn * 256 * 128 * 2; u.rowmap = nullptr; u.nvalid = 0; u.m0 = 0; u.row0 = pm * 256; u.col0 = pn * 256; u.pos0 = job;
        return true;
    }
};
struct FLORA { const float* dbias; const float* ibias; bf16_t* LWG; bf16_t* AIG; __device__ __forceinline__ void operator()(const pg8::Unit& u, int lr, int lc, f32x4 v0, f32x4 v1) const {
    const int row = u.row0 + lr, col = u.col0 + lc;
    const float* bp = (u.pos0 == 0 ? dbias : ibias) + col; const f32x4 b0 = *(const f32x4*)bp, b1 = *(const f32x4*)(bp + 4);
    const float sc = (u.pos0 == 0) ? -0.60653065971f : 1.f;
    float o[8];
#pragma unroll
    for (int e = 0; e < 4; ++e) { o[e] = sc * sigmoidf_(b0[e] + v0[e]); o[4 + e] = sc * sigmoidf_(b1[e] + v1[e]); }
    *(u32x4*)((u.pos0 == 0 ? LWG : AIG) + (size_t)row * 2048 + col) = mk4u(pk2(o[0], o[1]), pk2(o[2], o[3]), pk2(o[4], o[5]), pk2(o[6], o[7]));
} };
struct FGG { bf16_t* GG; __device__ __forceinline__ void operator()(const pg8::Unit& u, int lr, int lc, f32x4 v0, f32x4 v1) const {
    *(u32x4*)(GG + (size_t)(u.row0 + lr) * 1024 + u.col0 + lc) = mk4u(pk2(v0[0], v0[1]), pk2(v0[2], v0[3]), pk2(v1[0], v1[1]), pk2(v1[2], v1[3])); } };

__device__ __forceinline__ int inst_index(int b, int h, int d, int chunk) { return ((b * 16 + h) * 2 + d) * NCHUNK + chunk; }

constexpr int LA_K = 0  , LA_VT = 73728  , LA_END = LA_VT + 18 * 4608;
static_assert(LA_END <= SMEM_BYTES, "attention LDS map");

__device__ __forceinline__ void attn_unit(LDSP unsigned char* lds, const Params& p, int unit) {
    const int tid = opaque(threadIdx.x), wid = tid >> 6, lane = tid & 63;
    const int b = unit >> 8, kvh = (unit >> 6) & 3, qb = unit & 63, q0 = qb * 64;
    const bf16_t* PX = (const bf16_t*)(p.ws + OFF_PX);
    const float2* ROPE = (const float2*)(p.ws + OFF_ROPE);
    {
        u32x4 kx1[5], kx2[5];
#pragma unroll
        for (int it = 0; it < 5; ++it) {
            const int task = tid + 512 * it; kx1[it] = mk4u(0, 0, 0, 0); kx2[it] = mk4u(0, 0, 0, 0);
            if (task < 576 * 4) {
                const int key = task >> 2, pr = task & 3, c0 = (pr & 1) + 4 * (pr >> 1);
                const int pos = q0 - 128 + key;
                const bool lat = key < 320;
                if (!lat || (pos >= 0 && pos < T)) {
                    const bf16_t* src = PX + (size_t)(lat ? (b * T + pos) : (NX + b * CL + (key - 320))) * INP + C_AK + kvh * 64 + c0 * 8;
                    kx1[it] = *(const u32x4*)src; kx2[it] = *(const u32x4*)(src + 16);
                }
            }
        }
#pragma unroll
        for (int it = 0; it < 5; ++it) {
            const int task = tid + 512 * it;
            if (task < 576 * 4) {
                const int key = task >> 2, pr = task & 3, c0 = (pr & 1) + 4 * (pr >> 1);
                u32x4 w0 = kx1[it], w1 = kx2[it];
                if (key < 320) {
                    const int pos = q0 - 128 + key;
                    if (pos >= 0 && pos < T) {
                        const int ppos = (pr < 2) ? (pos >> 6) : (pos & 63);
                        const float2* tb = ROPE + ppos * 16 + (pr & 1) * 8;
                        const unsigned a1[4] = {w0.x, w0.y, w0.z, w0.w}, a2[4] = {w1.x, w1.y, w1.z, w1.w};
                        unsigned o1[4], o2[4];
#pragma unroll
                        for (int j = 0; j < 4; ++j) {
                            const float2 cs0 = tb[2 * j], cs1 = tb[2 * j + 1];
                            const float u0 = bf2f(a1[j] & 0xffff), u1 = bf2f(a1[j] >> 16), v0 = bf2f(a2[j] & 0xffff), v1 = bf2f(a2[j] >> 16);
                            o1[j] = pk2(u0 * cs0.x - v0 * cs0.y, u1 * cs1.x - v1 * cs1.y);
                            o2[j] = pk2(v0 * cs0.x + u0 * cs0.y, v1 * cs1.x + u1 * cs1.y);
                        }
                        w0 = mk4u(o1[0], o1[1], o1[2], o1[3]); w1 = mk4u(o2[0], o2[1], o2[2], o2[3]);
                    }
                }
                *(LDSP u32x4*)(lds + LA_K + sw64(key, c0 * 8)) = w0;
                *(LDSP u32x4*)(lds + LA_K + sw64(key, c0 * 8 + 16)) = w1;
            }
        }
    }
    {
        u32x4 vx[3][4];
#pragma unroll
        for (int it = 0; it < 3; ++it) {
            const int task = tid + 512 * it;
#pragma unroll
            for (int q = 0; q < 4; ++q) {
                vx[it][q] = mk4u(0, 0, 0, 0);
                if (task < 144 * 8) {
                    const int kg = task >> 3, dc = task & 7, key = kg * 4 + q;
                    if (key < 320) { const int pos = q0 - 128 + key; if (pos >= 0 && pos < T) vx[it][q] = *(const u32x4*)(PX + (size_t)(b * T + pos) * INP + C_AV + kvh * 64 + dc * 8); }
                    else vx[it][q] = *(const u32x4*)(PX + (size_t)(NX + b * CL + (key - 320)) * INP + C_AV + kvh * 64 + dc * 8);
                }
            }
        }
#pragma unroll
        for (int it = 0; it < 3; ++it) {
            const int task = tid + 512 * it;
            if (task < 144 * 8) {
                const int kg = task >> 3, dc = task & 7;
                unsigned short e[4][8];
#pragma unroll
                for (int q = 0; q < 4; ++q) { const u32x4 w = vx[it][q];
                    e[q][0] = w.x & 0xffff; e[q][1] = w.x >> 16; e[q][2] = w.y & 0xffff; e[q][3] = w.y >> 16; e[q][4] = w.z & 0xffff; e[q][5] = w.z >> 16; e[q][6] = w.w & 0xffff; e[q][7] = w.w >> 16; }
                const int tile = kg >> 3, kin = (kg & 7) * 4;
#pragma unroll
                for (int j = 0; j < 8; ++j) { u32x2 w; w.x = (unsigned)e[0][j] | ((unsigned)e[1][j] << 16); w.y = (unsigned)e[2][j] | ((unsigned)e[3][j] << 16);
                    *(LDSP u32x2*)(lds + LA_VT + tile * 4608 + (dc * 8 + j) * 72 + kin * 2) = w; }
            }
        }
    }
    const int hq = kvh * 4 + (wid >> 1), qs = (wid & 1) * 32, r = lane & 31, hh = lane >> 5;
    const int qpos = q0 + qs + r;
    bf16x8 qf[4];
    {
        const bf16_t* src = PX + (size_t)(b * T + qpos) * INP + C_Q + hq * 64 + 8 * hh;
        u32x4 raw[4];
#pragma unroll
        for (int s = 0; s < 4; ++s) raw[s] = *(const u32x4*)(src + 16 * s);
#pragma unroll
        for (int pr = 0; pr < 2; ++pr) {
            const int ppos = pr == 0 ? (qpos >> 6) : (qpos & 63);
            const float2* tb = ROPE + ppos * 16 + 8 * hh;
            const unsigned a1[4] = {raw[2 * pr].x, raw[2 * pr].y, raw[2 * pr].z, raw[2 * pr].w}, a2[4] = {raw[2 * pr + 1].x, raw[2 * pr + 1].y, raw[2 * pr + 1].z, raw[2 * pr + 1].w};
            unsigned o1[4], o2[4];
#pragma unroll
            for (int j = 0; j < 4; ++j) {
                const float2 cs0 = tb[2 * j], cs1 = tb[2 * j + 1];
                const float u0 = bf2f(a1[j] & 0xffff), u1 = bf2f(a1[j] >> 16), v0 = bf2f(a2[j] & 0xffff), v1 = bf2f(a2[j] >> 16);
                o1[j] = pk2(0.125f * (u0 * cs0.x - v0 * cs0.y), 0.125f * (u1 * cs1.x - v1 * cs1.y));
                o2[j] = pk2(0.125f * (v0 * cs0.x + u0 * cs0.y), 0.125f * (v1 * cs1.x + u1 * cs1.y));
            }
            const u32x4 w1 = mk4u(o1[0], o1[1], o1[2], o1[3]), w2 = mk4u(o2[0], o2[1], o2[2], o2[3]);
            qf[2 * pr] = __builtin_bit_cast(bf16x8, w1); qf[2 * pr + 1] = __builtin_bit_cast(bf16x8, w2);
        }
    }
    __syncthreads();
    float m = p.attn_sink[hq], l = 1.f;
    f32x16 o0 = zero16(), o1 = zero16();
    for (int tl = 0; tl < 18; ++tl) {
        f32x16 st = zero16();
#pragma unroll
        for (int s = 0; s < 4; ++s) {
            const bf16x8 kf = *(const LDSP bf16x8*)(lds + LA_K + sw64(32 * tl + r, 16 * s + 8 * hh));
            st = __builtin_amdgcn_mfma_f32_32x32x16_bf16(kf, qf[s], st, 0, 0, 0);
        }
        const int kp0 = q0 - 128 + 32 * tl, qlo = q0 + qs;
        if (tl < 10 && (qlo + 31 - kp0 > 128 || qlo - (kp0 + 31) < -128 || kp0 < 0 || kp0 + 31 >= T)) {
#pragma unroll
            for (int g = 0; g < 16; ++g) { const int kp = q0 - 128 + 32 * tl + crow(g, hh); const int dlt = qpos - kp;
                const bool ok = (dlt <= 128) && (dlt >= -128) && (kp >= 0) && (kp < T); st[g] = ok ? st[g] : -1e30f; }
        }
        float mt = st[0];
#pragma unroll
        for (int g = 1; g < 16; ++g) mt = fmaxf(mt, st[g]);
        mt = fmaxf(mt, shx(mt, 32));
        const float mn = fmaxf(m, mt), alpha = __expf(m - mn);
        float ps = 0.f;
#pragma unroll
        for (int g = 0; g < 16; ++g) { st[g] = __expf(st[g] - mn); ps += st[g]; }
        ps += shx(ps, 32);
        l = l * alpha + ps; m = mn;
        if (__any(alpha != 1.f)) {
#pragma unroll
            for (int g = 0; g < 16; ++g) { o0[g] *= alpha; o1[g] *= alpha; }
        }
#pragma unroll
        for (int s2 = 0; s2 < 2; ++s2) {
            const u32x4 pw = mk4u(pk2(st[8 * s2], st[8 * s2 + 1]), pk2(st[8 * s2 + 2], st[8 * s2 + 3]), pk2(st[8 * s2 + 4], st[8 * s2 + 5]), pk2(st[8 * s2 + 6], st[8 * s2 + 7]));
            const bf16x8 pf = __builtin_bit_cast(bf16x8, pw);
#pragma unroll
            for (int dm = 0; dm < 2; ++dm) {
                const LDSP unsigned char* vp = lds + LA_VT + tl * 4608 + (32 * dm + r) * 72 + (16 * s2 + 4 * hh) * 2;
                const u32x2 v0 = *(const LDSP u32x2*)vp, v1 = *(const LDSP u32x2*)(vp + 16);
                const bf16x8 vf = __builtin_bit_cast(bf16x8, mk4u(v0.x, v0.y, v1.x, v1.y));
                if (dm == 0) o0 = __builtin_amdgcn_mfma_f32_32x32x16_bf16(vf, pf, o0, 0, 0, 0); else o1 = __builtin_amdgcn_mfma_f32_32x32x16_bf16(vf, pf, o1, 0, 0, 0);
            }
        }
    }
    {
        const float inv = 1.f / l;
        unsigned char* dst = p.ws + OFF_MIX + (size_t)(b * T + qpos) * D + 1024 + hq * 64;
#pragma unroll
        for (int gq = 0; gq < 4; ++gq) {
            *(unsigned*)(dst + 8 * gq + 4 * hh) = pk4_fp8(o0[4 * gq] * inv, o0[4 * gq + 1] * inv, o0[4 * gq + 2] * inv, o0[4 * gq + 3] * inv);
            *(unsigned*)(dst + 32 + 8 * gq + 4 * hh) = pk4_fp8(o1[4 * gq] * inv, o1[4 * gq + 1] * inv, o1[4 * gq + 2] * inv, o1[4 * gq + 3] * inv);
        }
    }
    __syncthreads();
}

__device__ __forceinline__ void phaseR2(LDSP unsigned char* lds, const Params& p) {
    {
        pg8::Epi<FLORA> epi{FLORA{p.decay_bias, p.iclr_bias, (bf16_t*)(p.ws + OFF_LWG), (bf16_t*)(p.ws + OFF_AIG)}};
        LoraSched S{(const char*)(p.ws + OFF_TW), (const char*)(p.ws + OFF_WTDU), (const char*)(p.ws + OFF_XA), (const char*)(p.ws + OFF_WTIU), (int)gridDim.x, (int)blockIdx.x};
        pg8::gemm_phase<false>(lds, opaque_s(128), S, epi);
    }
    {
        pg8::Epi<FGG> epi{FGG{(bf16_t*)(p.ws + OFF_GG)}};
        pg8::DenseSched S{(const char*)(p.ws + OFF_SG), (const char*)(p.ws + OFF_WTGU), NX / 256, 1024 / 256, 256, (int)gridDim.x, (int)(gridDim.x - 1 - blockIdx.x)};
        pg8::gemm_phase<false>(lds, opaque_s(256), S, epi);
    }
}

constexpr int G_RT = 0, G_VT = 8192, G_X0 = 16384, G_AT = 32768, G_BT = 40960, G_KT = 49152, G_P0 = 57344, G_PT0 = 65536, G_SEG = 73728, G_GL = 74752, G_CNT = 75008, G_BYTES = 79872;
static_assert(2 * G_BYTES <= SMEM_BYTES - 16, "two R3 groups fit the LDS");

__device__ __forceinline__ void gbar(LDSP unsigned* cnt, unsigned& target, int lane) {
    target += 4u;
    asm volatile("s_waitcnt lgkmcnt(0)" ::: "memory");
    if (lane == 0) {
        __hip_atomic_fetch_add(cnt, 1u, __ATOMIC_RELAXED, __HIP_MEMORY_SCOPE_WORKGROUP);
        while (__hip_atomic_load(cnt, __ATOMIC_RELAXED, __HIP_MEMORY_SCOPE_WORKGROUP) < target) __builtin_amdgcn_s_sleep(1);
    }
    asm volatile("" ::: "memory");
}
__device__ __forceinline__ void mask_lt(f32x16& c, int x0, int y, int hh, bool incl) {
#pragma unroll
    for (int g = 0; g < 16; ++g) { const int x = x0 + crow(g, hh); c[g] = (incl ? (x <= y) : (x < y)) ? c[g] : 0.f; }
}

__device__ __forceinline__ void ldf(const unsigned (&FO)[4], unsigned off, bf16x8 (&f)[4]) {
#pragma unroll
    for (int s = 0; s < 4; ++s) f[s] = *LDS_AT(const bf16x8, FO[s] + off);
}
__device__ __forceinline__ void stt(const unsigned (&SO)[4], unsigned off, int xh, const f32x16& acc) {
#pragma unroll
    for (int gq = 0; gq < 4; ++gq) *LDS_AT(u32x2, (SO[gq] ^ ((unsigned)xh << 6)) + off) = mk2u(pk2(acc[4 * gq], acc[4 * gq + 1]), pk2(acc[4 * gq + 2], acc[4 * gq + 3]));
}
__device__ __forceinline__ u32x2 ld8(const unsigned (&SO)[4], int gq, unsigned off, int xh) { return *LDS_AT(const u32x2, (SO[gq] ^ ((unsigned)xh << 6)) + off); }

__device__ __forceinline__ void pack_op(const f32x16& t, bf16x8 (&o)[2]) {
#pragma unroll
    for (int s2 = 0; s2 < 2; ++s2) o[s2] = __builtin_bit_cast(bf16x8, mk4u(pk2(t[8 * s2], t[8 * s2 + 1]), pk2(t[8 * s2 + 2], t[8 * s2 + 3]), pk2(t[8 * s2 + 4], t[8 * s2 + 5]), pk2(t[8 * s2 + 6], t[8 * s2 + 7])));
}
__device__ __forceinline__ void rwkv_prep_group(LDSP unsigned char* lg, LDSP unsigned* cnt, unsigned& bt, const Params& p, int unit, int wg_in, int lane_in, const unsigned (&FO)[4], const unsigned (&SO)[4]) {
    int seq, c, h, d;
    if (unit < 4096) { seq = unit >> 11; c = (unit >> 5) & 63; h = (unit >> 1) & 15; d = unit & 1; } else { const int u = unit - 4096; seq = 2 + (u >> 7); c = (u >> 5) & 3; h = (u >> 1) & 15; d = u & 1; }
    const bool isx = seq < 2;
    const int b = seq & 1;
    const int s0 = isx ? b * T : NX + b * CL, t0 = c * 64;
    const int chunk_id = isx ? 4 + c : c;
    u32x4 keep_bh[2], keep_kh[2];
#define STAGE_IDS const int lane = opaque(lane_in), wg = opaque(wg_in), r = lane & 31, hh = lane >> 5; (void)r; (void)hh; (void)wg;
    {
        STAGE_IDS
        const int k = lane, seg = wg, hk = h * 64 + k;
        const float kac = p.k_a[hk];
        const bf16_t* RS = (const bf16_t*)(p.ws + OFF_RS); const bf16_t* KS = (const bf16_t*)(p.ws + OFF_KS); const bf16_t* KKp = (const bf16_t*)(p.ws + OFF_KK); const bf16_t* VS = (const bf16_t*)(p.ws + OFF_VS);
        const bf16_t* LWG = (const bf16_t*)(p.ws + OFF_LWG); const bf16_t* AIG = (const bf16_t*)(p.ws + OFF_AIG);
        const int ibase = seg * 16;
        const int rowA = (s0 + t0) + (d ? 63 - ibase : ibase);
        const int sgn = d ? -1 : 1;
        const unsigned o1 = ((unsigned)rowA * 1024u + (unsigned)hk) * 2u, o2 = ((unsigned)rowA * 2048u + (unsigned)(d * 1024 + hk)) * 2u;
        const int st1 = sgn * 2048, st2 = sgn * 4096;
#define LD16(base, off) bf2f(*(const bf16_t*)((const char*)(base) + (unsigned)(off)))
        float lw[16];
        float run = 0.f;
#pragma unroll
        for (int tt = 0; tt < 16; ++tt) { run += LD16(LWG, o2 + tt * st2); lw[tt] = run; }
        LDSP float* SEG = (LDSP float*)(lg + G_SEG);
        SEG[seg * 64 + k] = run;
        gbar(cnt, bt, lane);
        float off = 0.f, gL = 0.f;
#pragma unroll
        for (int s = 0; s < 4; ++s) { const float sv = SEG[s * 64 + k]; if (s < seg) off += sv; gL += sv; }
        if (seg == 0) ((LDSP float*)(lg + G_GL))[k] = gL;
        const float egL = __expf(gL);
#pragma unroll
        for (int q = 0; q < 2; ++q) {
            float rr[8], kr[8], kk[8], vv[8], ai[8];
#pragma unroll
            for (int e = 0; e < 8; ++e) { const int tt = 8 * q + e;
                rr[e] = LD16(RS, o1 + tt * st1); kr[e] = LD16(KS, o1 + tt * st1); kk[e] = LD16(KKp, o1 + tt * st1); vv[e] = LD16(VS, o1 + tt * st1); ai[e] = LD16(AIG, o2 + tt * st2); }
            unsigned wat[4], wbh[4], wkh[4], wv[4];
#pragma unroll
            for (int t2 = 0; t2 < 4; ++t2) {
                const int i0 = ibase + 8 * q + 2 * t2;
                float fat[2], frt[2], fbt[2], fkt[2], fbh[2], fkh[2];
#pragma unroll
                for (int e2 = 0; e2 < 2; ++e2) { const int e = 2 * t2 + e2, tt = 8 * q + e;
                    const float kd = kr[e] * (1.f + (ai[e] - 1.f) * kac), bbv = kk[e] * ai[e];
                    const float g = off + lw[tt], ge = (tt == 0) ? off : off + lw[tt - 1];
                    const float eg = __expf(g), ege = __expf(ge), eng = __builtin_amdgcn_rcpf(eg), egl = egL * eng;
                    fat[e2] = -kk[e] * ege; frt[e2] = rr[e] * eg; fbt[e2] = bbv * eng; fkt[e2] = kd * eng; fbh[e2] = bbv * egl; fkh[e2] = kd * egl; }
                wat[t2] = pk2(fat[0], fat[1]); wbh[t2] = pk2(fbh[0], fbh[1]); wkh[t2] = pk2(fkh[0], fkh[1]); wv[t2] = pk2(vv[2 * t2], vv[2 * t2 + 1]);
                const unsigned wr = pk2(frt[0], frt[1]), wb = pk2(fbt[0], fbt[1]), wk = pk2(fkt[0], fkt[1]);
                *(LDSP bf16_t*)(lg + G_AT + sw64(i0, k)) = (bf16_t)(wat[t2] & 0xffffu); *(LDSP bf16_t*)(lg + G_AT + sw64(i0 + 1, k)) = (bf16_t)(wat[t2] >> 16);
                *(LDSP bf16_t*)(lg + G_RT + sw64(i0, k)) = (bf16_t)(wr & 0xffffu);      *(LDSP bf16_t*)(lg + G_RT + sw64(i0 + 1, k)) = (bf16_t)(wr >> 16);
                *(LDSP bf16_t*)(lg + G_BT + sw64(i0, k)) = (bf16_t)(wb & 0xffffu);      *(LDSP bf16_t*)(lg + G_BT + sw64(i0 + 1, k)) = (bf16_t)(wb >> 16);
                *(LDSP bf16_t*)(lg + G_KT + sw64(i0, k)) = (bf16_t)(wk & 0xffffu);      *(LDSP bf16_t*)(lg + G_KT + sw64(i0 + 1, k)) = (bf16_t)(wk >> 16);
            }
            *(LDSP u32x4*)(lg + G_X0 + sw64(k, ibase + 8 * q)) = mk4u(wat[0], wat[1], wat[2], wat[3]);
            *(LDSP u32x4*)(lg + G_VT + sw64(k, ibase + 8 * q)) = mk4u(wv[0], wv[1], wv[2], wv[3]);
            keep_bh[q] = mk4u(wbh[0], wbh[1], wbh[2], wbh[3]); keep_kh[q] = mk4u(wkh[0], wkh[1], wkh[2], wkh[3]);
            __builtin_amdgcn_sched_barrier(0);
        }
#undef LD16
    }
    gbar(cnt, bt, lane_in);
    {
        STAGE_IDS
        const int cb = wg;
        bf16x8 PT00[2], PT01[2], PT11[2], Z00[2], Z10[2], Z11[2];
        f32x16 X0 = zero16(), X1 = zero16();
        {
            bf16x8 fA0[4], fA1[4];
            ldf(FO, G_AT, fA0); ldf(FO, G_AT + 4096, fA1);
            if (cb >= 2) {
                const int vb = cb - 2;
                bf16x8 fK[4];
                ldf(FO, G_KT, fK);
#pragma unroll
                for (int q = 0; q < 3; ++q) {
                    const int jb = (q == 2) ? 1 : 0, ib = (q == 0) ? 0 : 1;
                    if (q == 2) { __builtin_amdgcn_sched_barrier(0); ldf(FO, G_KT + 4096, fK); }
                    f32x16 t = zero16();
#pragma unroll
                    for (int s4 = 0; s4 < 4; ++s4) t = __builtin_amdgcn_mfma_f32_32x32x16_bf16(fK[s4], ib ? fA1[s4] : fA0[s4], t, 0, 0, 0);
                    if (jb == ib) mask_lt(t, 0, r, hh, false);
                    bf16x8 af[2]; pack_op(t, af);
#pragma unroll
                    for (int s2 = 0; s2 < 2; ++s2) {
                        const u32x2 v0 = ld8(SO, 2 * s2, G_VT + 4096 * vb, jb), v1 = ld8(SO, 2 * s2 + 1, G_VT + 4096 * vb, jb);
                        const bf16x8 bv = __builtin_bit_cast(bf16x8, mk4u(v0.x, v0.y, v1.x, v1.y));
                        if (ib) X1 = __builtin_amdgcn_mfma_f32_32x32x16_bf16(af[s2], bv, X1, 0, 0, 0); else X0 = __builtin_amdgcn_mfma_f32_32x32x16_bf16(af[s2], bv, X0, 0, 0, 0);
                    }
                }
            } else {
#pragma unroll
                for (int gq = 0; gq < 4; ++gq) { const u32x2 w0 = ld8(SO, gq, G_X0 + 4096 * cb, 0), w1 = ld8(SO, gq, G_X0 + 4096 * cb, 1);
                    X0[4 * gq] = bf2f(w0.x & 0xffff); X0[4 * gq + 1] = bf2f(w0.x >> 16); X0[4 * gq + 2] = bf2f(w0.y & 0xffff); X0[4 * gq + 3] = bf2f(w0.y >> 16);
                    X1[4 * gq] = bf2f(w1.x & 0xffff); X1[4 * gq + 1] = bf2f(w1.x >> 16); X1[4 * gq + 2] = bf2f(w1.y & 0xffff); X1[4 * gq + 3] = bf2f(w1.y >> 16); }
            }
            __builtin_amdgcn_sched_barrier(0);
            {
                bf16x8 fB[4];
                ldf(FO, G_BT, fB);
                f32x16 c1 = zero16(), c2 = zero16();
#pragma unroll
                for (int t = 0; t < 4; ++t) { c1 = __builtin_amdgcn_mfma_f32_32x32x16_bf16(fB[t], fA0[t], c1, 0, 0, 0); c2 = __builtin_amdgcn_mfma_f32_32x32x16_bf16(fA0[t], fB[t], c2, 0, 0, 0); }
                mask_lt(c1, 0, r, hh, false);
#pragma unroll
                for (int g = 0; g < 16; ++g) c2[g] = (r < crow(g, hh)) ? c2[g] : 0.f;
                pack_op(c1, PT00); pack_op(c2, Z00);
                c1 = zero16(); c2 = zero16();
#pragma unroll
                for (int t = 0; t < 4; ++t) { c1 = __builtin_amdgcn_mfma_f32_32x32x16_bf16(fB[t], fA1[t], c1, 0, 0, 0); c2 = __builtin_amdgcn_mfma_f32_32x32x16_bf16(fA1[t], fB[t], c2, 0, 0, 0); }
                pack_op(c1, PT01); pack_op(c2, Z10);
                __builtin_amdgcn_sched_barrier(0);
                ldf(FO, G_BT + 4096, fB);
                c1 = zero16(); c2 = zero16();
#pragma unroll
                for (int t = 0; t < 4; ++t) { c1 = __builtin_amdgcn_mfma_f32_32x32x16_bf16(fB[t], fA1[t], c1, 0, 0, 0); c2 = __builtin_amdgcn_mfma_f32_32x32x16_bf16(fA1[t], fB[t], c2, 0, 0, 0); }
                mask_lt(c1, 0, r, hh, false);
#pragma unroll
                for (int g = 0; g < 16; ++g) c2[g] = (r < crow(g, hh)) ? c2[g] : 0.f;
                pack_op(c1, PT11); pack_op(c2, Z11);
            }
        }
        __builtin_amdgcn_sched_barrier(0);
#pragma unroll 1
        for (int s = 0; s < 6; ++s) {
            bf16x8 x0[2], x1[2]; pack_op(X0, x0); pack_op(X1, x1);
#pragma unroll
            for (int s2 = 0; s2 < 2; ++s2) { X0 = __builtin_amdgcn_mfma_f32_32x32x16_bf16(PT00[s2], x0[s2], X0, 0, 0, 0); X1 = __builtin_amdgcn_mfma_f32_32x32x16_bf16(PT01[s2], x0[s2], X1, 0, 0, 0); }
#pragma unroll
            for (int s2 = 0; s2 < 2; ++s2) X1 = __builtin_amdgcn_mfma_f32_32x32x16_bf16(PT11[s2], x1[s2], X1, 0, 0, 0);
            if (s < 5) {
                bf16x8 nPT00[2], nPT11[2], nPT01[2];
                {
                    f32x16 n0 = zero16(), n1 = zero16(), n2 = zero16();
#pragma unroll
                    for (int s2 = 0; s2 < 2; ++s2) {
                        n0 = __builtin_amdgcn_mfma_f32_32x32x16_bf16(Z00[s2], PT00[s2], n0, 0, 0, 0);
                        n1 = __builtin_amdgcn_mfma_f32_32x32x16_bf16(Z11[s2], PT11[s2], n1, 0, 0, 0);
                        n2 = __builtin_amdgcn_mfma_f32_32x32x16_bf16(Z00[s2], PT01[s2], n2, 0, 0, 0);
                    }
#pragma unroll
                    for (int s2 = 0; s2 < 2; ++s2) n2 = __builtin_amdgcn_mfma_f32_32x32x16_bf16(Z10[s2], PT11[s2], n2, 0, 0, 0);
                    pack_op(n0, nPT00); pack_op(n1, nPT11); pack_op(n2, nPT01);
                }
                __builtin_amdgcn_sched_barrier(0);
                {
                    f32x16 n3 = zero16(), n4 = zero16(), n5 = zero16();
#pragma unroll
                    for (int s2 = 0; s2 < 2; ++s2) {
                        n3 = __builtin_amdgcn_mfma_f32_32x32x16_bf16(PT00[s2], Z00[s2], n3, 0, 0, 0);
                        n4 = __builtin_amdgcn_mfma_f32_32x32x16_bf16(PT11[s2], Z11[s2], n4, 0, 0, 0);
                        n5 = __builtin_amdgcn_mfma_f32_32x32x16_bf16(PT01[s2], Z00[s2], n5, 0, 0, 0);
                    }
#pragma unroll
                    for (int s2 = 0; s2 < 2; ++s2) n5 = __builtin_amdgcn_mfma_f32_32x32x16_bf16(PT11[s2], Z10[s2], n5, 0, 0, 0);
                    pack_op(n3, Z00); pack_op(n4, Z11); pack_op(n5, Z10);
                }
#pragma unroll
                for (int s2 = 0; s2 < 2; ++s2) { PT00[s2] = nPT00[s2]; PT11[s2] = nPT11[s2]; PT01[s2] = nPT01[s2]; }
            }
        }
        stt(SO, G_X0 + 4096 * cb, 0, X0); stt(SO, G_X0 + 4096 * cb, 1, X1);
    }
    {
        STAGE_IDS
        const int jb = wg >> 1, ib = wg & 1;
        f32x16 c1 = zero16(), c2 = zero16();
        if (jb <= ib) {
            bf16x8 fR[4], fB[4], fK[4]; ldf(FO, G_RT + 4096 * ib, fR); ldf(FO, G_BT + 4096 * jb, fB); ldf(FO, G_KT + 4096 * jb, fK);
#pragma unroll
            for (int t = 0; t < 4; ++t) { c1 = __builtin_amdgcn_mfma_f32_32x32x16_bf16(fB[t], fR[t], c1, 0, 0, 0); c2 = __builtin_amdgcn_mfma_f32_32x32x16_bf16(fK[t], fR[t], c2, 0, 0, 0); }
            if (jb == ib) { mask_lt(c1, 32 * jb, 32 * ib + r, hh, true); mask_lt(c2, 32 * jb, 32 * ib + r, hh, true); }
        }
        stt(SO, G_P0 + 4096 * ib, jb, c1); stt(SO, G_PT0 + 4096 * ib, jb, c2);
    }
    gbar(cnt, bt, lane_in);
    {
        STAGE_IDS
#pragma unroll
        for (int q = 0; q < 2; ++q) { *(LDSP u32x4*)(lg + G_BT + sw64(lane, wg * 16 + 8 * q)) = keep_bh[q]; *(LDSP u32x4*)(lg + G_KT + sw64(lane, wg * 16 + 8 * q)) = keep_kh[q]; }
    }
    gbar(cnt, bt, lane_in);
    {
        STAGE_IDS
        const int mi = wg;
        const int L_BH = G_BT, L_KH = G_KT, L_RB = G_P0, L_RK = G_PT0;
        const size_t inst = (size_t)inst_index(b, h, d, chunk_id) * 4096;
        bf16_t* dst = (bf16_t*)(p.ws + (mi == 0 ? OFF_CM : mi == 1 ? OFF_CN : mi == 2 ? OFF_CP : OFF_CQ)) + inst;
        if (isx || mi < 2) {
            const int Ax = (mi == 1) ? L_BH : G_X0, Ax0 = (mi == 3) ? 64 : 0;
            const int By = (mi == 0) ? L_BH : (mi == 1) ? G_X0 : L_RB, By0 = (mi == 1) ? 64 : 0;
            const int A2 = (mi == 1) ? L_KH : G_VT, B2 = (mi == 1) ? G_VT : L_RK;
#pragma unroll 1
            for (int half = 0; half < 2; ++half) {
                bf16x8 a0[4], a1[4], b1[4];
                ldf(FO, Ax + 128 * Ax0, a0); ldf(FO, Ax + 128 * (Ax0 + 32), a1); ldf(FO, By + 128 * (By0 + 32 * half), b1);
                f32x16 c0 = zero16(), c1 = zero16();
#pragma unroll
                for (int t = 0; t < 4; ++t) { c0 = __builtin_amdgcn_mfma_f32_32x32x16_bf16(a0[t], b1[t], c0, 0, 0, 0); c1 = __builtin_amdgcn_mfma_f32_32x32x16_bf16(a1[t], b1[t], c1, 0, 0, 0); }
                if (mi & 1) {
                    ldf(FO, A2, a0); ldf(FO, A2 + 4096, a1); ldf(FO, B2 + 4096 * half, b1);
#pragma unroll
                    for (int t = 0; t < 4; ++t) { c0 = __builtin_amdgcn_mfma_f32_32x32x16_bf16(a0[t], b1[t], c0, 0, 0, 0); c1 = __builtin_amdgcn_mfma_f32_32x32x16_bf16(a1[t], b1[t], c1, 0, 0, 0); }
                }
                const int y = 32 * half + r;
                const float dg = (mi == 0) ? __expf(((const LDSP float*)(lg + G_GL))[y]) : 0.f;
#pragma unroll
                for (int xb = 0; xb < 2; ++xb) {
#pragma unroll
                    for (int gq = 0; gq < 4; ++gq) {
                        const int x0 = 32 * xb + 8 * gq + 4 * hh;
                        float v0 = xb ? c1[4 * gq] : c0[4 * gq], v1 = xb ? c1[4 * gq + 1] : c0[4 * gq + 1], v2 = xb ? c1[4 * gq + 2] : c0[4 * gq + 2], v3 = xb ? c1[4 * gq + 3] : c0[4 * gq + 3];
                        if (mi == 0) { if (x0 == y) v0 += dg; if (x0 + 1 == y) v1 += dg; if (x0 + 2 == y) v2 += dg; if (x0 + 3 == y) v3 += dg; }
                        if (mi == 2) { const u32x2 w = ld8(SO, gq, G_RT + 4096 * half, xb); v0 += bf2f(w.x & 0xffff); v1 += bf2f(w.x >> 16); v2 += bf2f(w.y & 0xffff); v3 += bf2f(w.y >> 16); }
                        *(u32x2*)(dst + ((half * 4 + 2 * xb + (gq >> 1)) * 64 + hh * 32 + r) * 8 + 4 * (gq & 1)) = mk2u(pk2(v0, v1), pk2(v2, v3));
                    }
                }
            }
        }
    }
    gbar(cnt, bt, lane_in);
#undef STAGE_IDS
}

__device__ __forceinline__ void conv_group_load(const float* src, int N, int k0, int n0, int tg, f32x4 (&v)[8][2]) {
    const int kr = tg >> 3, nc = (tg & 7) * 8;
#pragma unroll
    for (int s = 0; s < 8; ++s) { const float* q = src + (size_t)(k0 + s * 32 + kr) * N + n0 + nc; v[s][0] = *(const f32x4*)q; v[s][1] = *(const f32x4*)(q + 4); }
}
__device__ __forceinline__ void conv_group_finish(LDSP unsigned char* lg, LDSP unsigned* cnt, unsigned& bt, bf16_t* dst, int ld, int mode, int k0, int n0, const f32x4 (&v)[8][2], int tg, int lane) {
    LDSP float* Tm = (LDSP float*)lg;
    {
        const int kr = tg >> 3, nc = (tg & 7) * 8;
#pragma unroll
        for (int s = 0; s < 8; ++s) { LDSP float* q = Tm + (s * 32 + kr) * 65 + nc;
            q[0] = v[s][0].x; q[1] = v[s][0].y; q[2] = v[s][0].z; q[3] = v[s][0].w; q[4] = v[s][1].x; q[5] = v[s][1].y; q[6] = v[s][1].z; q[7] = v[s][1].w; }
    }
    gbar(cnt, bt, lane);
    {
        const int n = tg >> 2; unsigned char* drow = (unsigned char*)dst + (size_t)conv_row(n0 + n, mode & 3) * ld;
        if (mode & 4) {
            const float sc = (mode & 3) ? W1_SCALE : W2_SCALE;
#pragma unroll
            for (int s = 0; s < 4; ++s) { const int kc = ((tg & 3) + 4 * s) * 16; float f[16];
#pragma unroll
                for (int j = 0; j < 16; ++j) f[j] = Tm[(kc + j) * 65 + n] * sc;
                *(u32x4*)(drow + k0 + kc) = mk4u(pk4_fp8(f[0], f[1], f[2], f[3]), pk4_fp8(f[4], f[5], f[6], f[7]), pk4_fp8(f[8], f[9], f[10], f[11]), pk4_fp8(f[12], f[13], f[14], f[15])); }
        } else {
#pragma unroll
            for (int s = 0; s < 8; ++s) { const int kc = ((tg & 3) + 4 * s) * 8; float f[8];
#pragma unroll
                for (int j = 0; j < 8; ++j) f[j] = Tm[(kc + j) * 65 + n];
                *(u32x4*)(drow + 2 * (k0 + kc)) = mk4u(pk2(f[0], f[1]), pk2(f[2], f[3]), pk2(f[4], f[5]), pk2(f[6], f[7])); }
        }
    }
    gbar(cnt, bt, lane);
}
__device__ __forceinline__ void conv_group_range(LDSP unsigned char* lg, LDSP unsigned* cnt, unsigned& bt, const Params& p, int g0, int g1, int tg, int lane) {
    int g = g0 + blockIdx.x;
    const float* csrc = nullptr; bf16_t* cdst = nullptr; int cN = 0, cld = 0, cmode = 0, ck0 = 0, cn0 = 0;
    const float* nsrc = nullptr; bf16_t* ndst = nullptr; int nN = 0, nld = 0, nmode = 0, nk0 = 0, nn0 = 0;
    f32x4 va[8][2], vb[8][2];
    if (g < g1) { conv_decode(p, g, csrc, cdst, cN, cld, cmode, ck0, cn0); conv_group_load(csrc, cN, ck0, cn0, tg, va); }
    __builtin_amdgcn_s_waitcnt(0);
#pragma unroll 1
    while (g < g1) {
        const int gn = g + gridDim.x;
        if (gn < g1) { conv_decode(p, gn, nsrc, ndst, nN, nld, nmode, nk0, nn0); conv_group_load(nsrc, nN, nk0, nn0, tg, vb); }
        conv_group_finish(lg, cnt, bt, cdst, cld, cmode, ck0, cn0, va, tg, lane);
        cdst = ndst; cld = nld; cmode = nmode; ck0 = nk0; cn0 = nn0; g = gn;
#pragma unroll
        for (int s = 0; s < 8; ++s) { va[s][0] = vb[s][0]; va[s][1] = vb[s][1]; }
    }
}

__device__ __forceinline__ void phaseR3(LDSP unsigned char* lds, const Params& p) {
    const int tid = opaque(threadIdx.x), wid = tid >> 6, lane = tid & 63, gp = wid >> 2, wg = wid & 3;
    LDSP unsigned char* lg = lds + gp * G_BYTES;
    LDSP unsigned* cnt = (LDSP unsigned*)(lg + G_CNT);
    LDSP unsigned* uq = (LDSP unsigned*)(lds + SMEM_BYTES - 48);
    LDSP unsigned* pick = (LDSP unsigned*)(lg + G_CNT + 8);
    if ((tid & 255) == 0) *cnt = 0u;
    if (tid == 0) *uq = 0u;
    __syncthreads();
    unsigned bt = 0u;
    if (!(p.flags & 1) && gp == 1) conv_group_range(lg, cnt, bt, p, CT1, CT8, tid & 255, lane);
    unsigned FO[4], SO[4];
    { const unsigned base = LDS_ADDR(lg), r = lane & 31, hh = lane >> 5;
#pragma unroll
      for (int q = 0; q < 4; ++q) { FO[q] = base + r * 128u + ((((2u * q + hh) ^ (r >> 1)) & 7u) << 4); SO[q] = base + r * 128u + ((((unsigned)q ^ (r >> 1)) & 7u) << 4) + 8u * hh; } }
    for (;;) {
        if ((tid & 255) == 0) *pick = __hip_atomic_fetch_add(uq, 1u, __ATOMIC_RELAXED, __HIP_MEMORY_SCOPE_WORKGROUP);
        gbar(cnt, bt, lane);
        const int u = blockIdx.x + (int)(*pick) * gridDim.x;
        gbar(cnt, bt, lane);
        if ((p.flags & 2) || u >= 4096 + 256) break;
        rwkv_prep_group(lg, cnt, bt, p, u, wg, lane, FO, SO);
    }
    __syncthreads();
}

constexpr size_t OFF_HT = OFF_YD;
__device__ __forceinline__ void scan_wave(const Params& p, int item, int lane) {
    const int chain = item >> 1, vb = item & 1, b = chain >> 5, h = (chain >> 1) & 15, d = chain & 1;
    const bf16_t* CM = (const bf16_t*)(p.ws + OFF_CM); const bf16_t* CN = (const bf16_t*)(p.ws + OFF_CN); bf16_t* HT = (bf16_t*)(p.ws + OFF_HT);
    u32x4 na[2][4], nn[2][2];
    auto chunk_of = [&](int step) { return (step < 4) ? (d ? 3 - step : step) : (d ? 4 + (67 - step) : step); };
    auto prefetch = [&](int step) {
        const size_t inst = (size_t)inst_index(b, h, d, chunk_of(step)) * 4096;
#pragma unroll
        for (int rt = 0; rt < 2; ++rt) {
#pragma unroll
            for (int s = 0; s < 4; ++s) na[rt][s] = *(const u32x4*)(CM + inst + ((rt * 4 + s) * 64 + lane) * 8);
#pragma unroll
            for (int g2 = 0; g2 < 2; ++g2) nn[rt][g2] = *(const u32x4*)(CN + inst + (((vb * 2 + rt) * 2 + g2) * 64 + lane) * 8);
        }
    };
    f32x16 hacc[2]; hacc[0] = zero16(); hacc[1] = zero16();
    prefetch(0);
#pragma unroll 1
    for (int step = 0; step < NCHUNK; ++step) {
        const int chunk_id = chunk_of(step);
        u32x4 a[2][4], n[2][2];
#pragma unroll
        for (int rt = 0; rt < 2; ++rt) {
#pragma unroll
            for (int s = 0; s < 4; ++s) a[rt][s] = na[rt][s];
            n[rt][0] = nn[rt][0]; n[rt][1] = nn[rt][1];
        }
        if (step + 1 < NCHUNK) prefetch(step + 1);
        bf16x8 bfr[4];
#pragma unroll
        for (int s = 0; s < 4; ++s) { const f32x16& t = hacc[s >> 1]; const int o = 8 * (s & 1);
            bfr[s] = __builtin_bit_cast(bf16x8, mk4u(pk2(t[o], t[o + 1]), pk2(t[o + 2], t[o + 3]), pk2(t[o + 4], t[o + 5]), pk2(t[o + 6], t[o + 7]))); }
        if (chunk_id >= 4) {
            bf16_t* hp = HT + (size_t)inst_index(b, h, d, chunk_id) * 4096 + (vb * 4 * 64 + lane) * 8;
#pragma unroll
            for (int s = 0; s < 4; ++s) *(bf16x8*)(hp + s * 512) = bfr[s];
        }
#pragma unroll
        for (int rt = 0; rt < 2; ++rt) {
            f32x16 acc;
#pragma unroll
            for (int g2 = 0; g2 < 2; ++g2) { const u32x4 w = n[rt][g2];
                acc[8 * g2] = bf2f(w.x & 0xffff); acc[8 * g2 + 1] = bf2f(w.x >> 16); acc[8 * g2 + 2] = bf2f(w.y & 0xffff); acc[8 * g2 + 3] = bf2f(w.y >> 16);
                acc[8 * g2 + 4] = bf2f(w.z & 0xffff); acc[8 * g2 + 5] = bf2f(w.z >> 16); acc[8 * g2 + 6] = bf2f(w.w & 0xffff); acc[8 * g2 + 7] = bf2f(w.w >> 16); }
#pragma unroll
            for (int s = 0; s < 4; ++s) acc = __builtin_amdgcn_mfma_f32_32x32x16_bf16(__builtin_bit_cast(bf16x8, a[rt][s]), bfr[s], acc, 0, 0, 0);
            hacc[rt] = acc;
        }
    }
}
__device__ __forceinline__ void phaseR4(LDSP unsigned char* lds, const Params& p) {
    const int tid = opaque(threadIdx.x), wid = tid >> 6, lane = tid & 63;
    LDSP int* nxt = (LDSP int*)(lds + SMEM_BYTES - 32);
    unsigned* qctr = (unsigned*)(p.ws + OFF_CTL + 16384 + 512);
    if ((int)blockIdx.x < 64 && gridDim.x >= 128) { if (wid < 2) scan_wave(p, blockIdx.x * 2 + wid, lane); }
    else if (gridDim.x < 128) { if (wid == 0) for (int it = blockIdx.x; it < 128; it += gridDim.x) scan_wave(p, it, lane); }
    for (;;) {
        __syncthreads();
        if (tid == 0) *nxt = (int)atomicAdd(qctr, 1u);
        __syncthreads();
        const int u = *nxt;
        if (u >= 512) break;
        attn_unit(lds, p, u);
    }
}

__device__ __forceinline__ void phaseR5(LDSP unsigned char* lds, const Params& p) {
    const int tid = opaque(threadIdx.x), wid = tid >> 6, lane = tid & 63, r = lane & 31, hh = lane >> 5;
    const bf16_t* CP = (const bf16_t*)(p.ws + OFF_CP); const bf16_t* CQ = (const bf16_t*)(p.ws + OFF_CQ); const bf16_t* HT = (const bf16_t*)(p.ws + OFF_HT);
    for (int wu = blockIdx.x * 8 + wid; wu < 2 * 64 * 16 * 2; wu += gridDim.x * 8) {
        const int half = wu & 1, u = wu >> 1, b = u >> 10, c = (u >> 4) & 63, h = u & 15;
        f32x16 y0 = zero16(), y1 = zero16();
#pragma unroll
        for (int d = 0; d < 2; ++d) {
            const size_t inst = (size_t)inst_index(b, h, d, 4 + c) * 4096;
            const int ii = d ? 63 - (32 * half + r) : (32 * half + r);
            const int it = ii >> 5, lp = hh * 32 + (ii & 31);
            f32x16 a0, a1;
#pragma unroll
            for (int g2 = 0; g2 < 2; ++g2) {
                const u32x4 w0 = *(const u32x4*)(CQ + inst + (((it * 2 + 0) * 2 + g2) * 64 + lp) * 8), w1 = *(const u32x4*)(CQ + inst + (((it * 2 + 1) * 2 + g2) * 64 + lp) * 8);
                a0[8 * g2] = bf2f(w0.x & 0xffff); a0[8 * g2 + 1] = bf2f(w0.x >> 16); a0[8 * g2 + 2] = bf2f(w0.y & 0xffff); a0[8 * g2 + 3] = bf2f(w0.y >> 16);
                a0[8 * g2 + 4] = bf2f(w0.z & 0xffff); a0[8 * g2 + 5] = bf2f(w0.z >> 16); a0[8 * g2 + 6] = bf2f(w0.w & 0xffff); a0[8 * g2 + 7] = bf2f(w0.w >> 16);
                a1[8 * g2] = bf2f(w1.x & 0xffff); a1[8 * g2 + 1] = bf2f(w1.x >> 16); a1[8 * g2 + 2] = bf2f(w1.y & 0xffff); a1[8 * g2 + 3] = bf2f(w1.y >> 16);
                a1[8 * g2 + 4] = bf2f(w1.z & 0xffff); a1[8 * g2 + 5] = bf2f(w1.z >> 16); a1[8 * g2 + 6] = bf2f(w1.w & 0xffff); a1[8 * g2 + 7] = bf2f(w1.w >> 16);
            }
#pragma unroll
            for (int s = 0; s < 4; ++s) {
                const bf16x8 pf = *(const bf16x8*)(CP + inst + ((it * 4 + s) * 64 + lp) * 8);
                const bf16x8 h0 = *(const bf16x8*)(HT + inst + ((0 * 4 + s) * 64 + lane) * 8), h1 = *(const bf16x8*)(HT + inst + ((1 * 4 + s) * 64 + lane) * 8);
                a0 = __builtin_amdgcn_mfma_f32_32x32x16_bf16(h0, pf, a0, 0, 0, 0);
                a1 = __builtin_amdgcn_mfma_f32_32x32x16_bf16(h1, pf, a1, 0, 0, 0);
            }
#pragma unroll
            for (int g = 0; g < 16; ++g) { y0[g] += a0[g]; y1[g] += a1[g]; }
        }
        const int tau = 32 * half + r; const size_t row = (size_t)b * T + c * 64 + tau;
        float sm = 0.f;
#pragma unroll
        for (int g = 0; g < 16; ++g) sm += y0[g] + y1[g];
        sm += shx(sm, 32);
        const float mean = sm * (1.f / 64.f);
        float q2 = 0.f;
#pragma unroll
        for (int g = 0; g < 16; ++g) { y0[g] -= mean; y1[g] -= mean; q2 += y0[g] * y0[g] + y1[g] * y1[g]; }
        q2 += shx(q2, 32);
        const float rstd = rsqrtf(q2 * (1.f / 64.f) + 64e-5f);
        const bf16_t* rs = (const bf16_t*)(p.ws + OFF_RS) + row * 1024 + h * 64; const bf16_t* ks = (const bf16_t*)(p.ws + OFF_KS) + row * 1024 + h * 64;
        const bf16_t* ai0 = (const bf16_t*)(p.ws + OFF_AIG) + row * 2048 + h * 64; const bf16_t* ai1 = ai0 + 1024;
        const bf16_t* vs = (const bf16_t*)(p.ws + OFF_VS) + row * 1024 + h * 64; const bf16_t* gg = (const bf16_t*)(p.ws + OFF_GG) + row * 1024 + h * 64;
        float bon = 0.f;
#pragma unroll
        for (int q = 0; q < 8; ++q) {
            const int ch = 32 * (q >> 2) + 8 * (q & 3) + 4 * hh;
            const u32x2 r2 = *(const u32x2*)(rs + ch), k2 = *(const u32x2*)(ks + ch), x2 = *(const u32x2*)(ai0 + ch), z2 = *(const u32x2*)(ai1 + ch);
            const f32x4 ka = *(const f32x4*)(p.k_a + h * 64 + ch), rk = *(const f32x4*)(p.r_k + h * 64 + ch);
            const float rr[4] = {bf2f(r2.x & 0xffff), bf2f(r2.x >> 16), bf2f(r2.y & 0xffff), bf2f(r2.y >> 16)}, kk[4] = {bf2f(k2.x & 0xffff), bf2f(k2.x >> 16), bf2f(k2.y & 0xffff), bf2f(k2.y >> 16)};
            const float xa[4] = {bf2f(x2.x & 0xffff), bf2f(x2.x >> 16), bf2f(x2.y & 0xffff), bf2f(x2.y >> 16)}, za[4] = {bf2f(z2.x & 0xffff), bf2f(z2.x >> 16), bf2f(z2.y & 0xffff), bf2f(z2.y >> 16)};
#pragma unroll
            for (int e = 0; e < 4; ++e) bon += rr[e] * (kk[e] * ((1.f + (xa[e] - 1.f) * ka[e]) + (1.f + (za[e] - 1.f) * ka[e]))) * rk[e];
        }
        bon += shx(bon, 32);
        unsigned char* dst = p.ws + OFF_MIX + (size_t)row * D + h * 64;
#pragma unroll
        for (int q = 0; q < 8; ++q) {
            const int ch = 32 * (q >> 2) + 8 * (q & 3) + 4 * hh, g0 = 4 * (q & 3);
            const f32x4 lg = *(const f32x4*)(p.lnx_g + h * 64 + ch), lb = *(const f32x4*)(p.lnx_b + h * 64 + ch);
            const u32x2 v2 = *(const u32x2*)(vs + ch), g2 = *(const u32x2*)(gg + ch);
            const float vv[4] = {bf2f(v2.x & 0xffff), bf2f(v2.x >> 16), bf2f(v2.y & 0xffff), bf2f(v2.y >> 16)}, gv[4] = {bf2f(g2.x & 0xffff), bf2f(g2.x >> 16), bf2f(g2.y & 0xffff), bf2f(g2.y >> 16)};
            float o[4];
#pragma unroll
            for (int e = 0; e < 4; ++e) { const float yv = (q < 4) ? y0[g0 + e] : y1[g0 + e]; o[e] = (yv * rstd * lg[e] + lb[e] + bon * vv[e]) * gv[e]; }
            *(unsigned*)(dst + ch) = pk4_fp8(o[0], o[1], o[2], o[3]);
        }
    }
}

__device__ __forceinline__ void phase6(LDSP unsigned char* lds, const Params& p) {
    pg8::Epi<FX1> epi{FX1{p.x, (const float*)(p.ws + OFF_MOD), (float*)(p.ws + OFF_X1), 1.f / W2_SCALE}};
    pg8::DenseSched S{(const char*)(p.ws + OFF_MIX), (const char*)(p.ws + OFF_WTOUT), NX / 256, D / 256, D / 2, (int)gridDim.x, (int)blockIdx.x};
    pg8::gemm_phase<false, true, 2>(lds, D / 2, S, epi);
}

__device__ __forceinline__ void phase7(LDSP unsigned char* lds, const Params& p) {
    const int tid = opaque(threadIdx.x), wid = tid >> 6, lane = tid & 63;
    LDSP float* GS = (LDSP float*)lds;
    LDSP float* RSTD = (LDSP float*)(lds + 16384);
    LDSP float* PART = (LDSP float*)(lds + 16896);
    LDSP float* CB = (LDSP float*)(lds + 16896 + 65536);
    const float* MOD = (const float*)(p.ws + OFF_MOD);
    const float* X1 = (const float*)(p.ws + OFF_X1);
    unsigned char* H2 = p.ws + OFF_H2;
    int* CNT = (int*)(p.ws + OFF_CTL + 16384);
    for (int u = blockIdx.x; u < NX / 32; u += gridDim.x) {
        const float* md = MOD + (size_t)((u * 32) >> 12) * 12288;
        for (int idx = tid; idx < D / 4; idx += 512) { const f32x4 g = *(const f32x4*)(p.norm2_g + 4 * idx), sh = *(const f32x4*)(md + 3 * D + 4 * idx), sc = *(const f32x4*)(md + 4 * D + 4 * idx);
            *(LDSP f32x4*)(GS + 4 * idx) = g * (sc + 1.f); *(LDSP f32x4*)(GS + D + 4 * idx) = sh; }
        __syncthreads();
#pragma unroll 1
        for (int rr = 0; rr < 4; ++rr) {
            const int t = 4 * wid + rr, row = u * 32 + t; const float* src = X1 + (size_t)row * D;
            f32x4 xv[8]; float ss = 0.f;
#pragma unroll
            for (int i = 0; i < 8; ++i) { xv[i] = ((const f32x4*)src)[lane + 64 * i]; ss += xv[i].x * xv[i].x + xv[i].y * xv[i].y + xv[i].z * xv[i].z + xv[i].w * xv[i].w; }
            ss = wave_sum(ss); const float rs = rsqrtf(ss * (1.f / D) + 1e-6f);
            if (lane == 0) RSTD[t] = rs;
#pragma unroll
            for (int i = 0; i < 8; ++i) { const int col = 4 * (lane + 64 * i);
                const f32x4 g = *(const LDSP f32x4*)(GS + col), sh = *(const LDSP f32x4*)(GS + D + col);
                const f32x4 hv = xv[i] * rs * g + sh;
                *(unsigned*)(H2 + (size_t)row * D + col) = pk4_fp8(hv.x, hv.y, hv.z, hv.w); }
        }
        {
            const int j = lane & 31, kk = lane >> 5, k0 = wid * 256;
            unsigned xoff = (unsigned)((u * 32 + j) * D + k0 + 4 * kk) * 4u;
            unsigned woff = (unsigned)((k0 + 4 * kk) * 64 + j) * 4u;
            unsigned goff = (unsigned)(k0 + 4 * kk) * 4u;
            f32x16 acc0 = zero16(), acc1 = zero16(); float c0 = 0.f, c1 = 0.f;
#pragma unroll 2
            for (int q = 0; q < 32; ++q) {
                const f32x4 xa = *(const f32x4*)((const char*)X1 + xoff);
                const f32x4 gv = *(const LDSP f32x4*)((const LDSP char*)GS + goff), sv = *(const LDSP f32x4*)((const LDSP char*)GS + D * 4 + goff);
                float b0[4], b1[4];
#pragma unroll
                for (int e = 0; e < 4; ++e) { b0[e] = *(const float*)((const char*)p.w_router + woff + e * 256); b1[e] = *(const float*)((const char*)p.w_router + woff + e * 256 + 128); }
#pragma unroll
                for (int e = 0; e < 4; ++e) {
                    acc0 = __builtin_amdgcn_mfma_f32_32x32x2f32(xa[e], b0[e] * gv[e], acc0, 0, 0, 0);
                    acc1 = __builtin_amdgcn_mfma_f32_32x32x2f32(xa[e], b1[e] * gv[e], acc1, 0, 0, 0);
                    c0 += sv[e] * b0[e]; c1 += sv[e] * b1[e];
                }
                xoff += 32u; woff += 2048u; goff += 32u;
            }
            c0 += shx(c0, 32); c1 += shx(c1, 32);
#pragma unroll
            for (int g = 0; g < 16; ++g) { const int t = crow(g, kk); PART[(wid * 32 + t) * 64 + j] = acc0[g]; PART[(wid * 32 + t) * 64 + 32 + j] = acc1[g]; }
            if (kk == 0) { CB[wid * 64 + j] = c0; CB[wid * 64 + 32 + j] = c1; }
        }
        __syncthreads();
        float cb = 0.f;
#pragma unroll
        for (int w = 0; w < 8; ++w) cb += CB[w * 64 + lane];
        const float eb = p.expert_bias[lane];
#pragma unroll 1
        for (int rr = 0; rr < 4; ++rr) {
            const int t = 4 * wid + rr, token = u * 32 + t;
            float sum = 0.f;
#pragma unroll
            for (int w = 0; w < 8; ++w) sum += PART[(w * 32 + t) * 64 + lane];
            const float logit = RSTD[t] * sum + cb;
            const float score = 1.f / (1.f + expf(-logit));
            const float v = score + eb;
            const int gi = lane >> 3;
            float m1 = v;
            m1 = fmaxf(m1, shx(m1, 1)); m1 = fmaxf(m1, shx(m1, 2)); m1 = fmaxf(m1, shx(m1, 4));
            const unsigned long long eq = __ballot(v == m1);
            const unsigned gbits = (unsigned)((eq >> (gi * 8)) & 0xffull);
            const bool first = (lane & 7) == (__ffs((int)gbits) - 1);
            float v2 = first ? -INFINITY : v;
            v2 = fmaxf(v2, shx(v2, 1)); v2 = fmaxf(v2, shx(v2, 2)); v2 = fmaxf(v2, shx(v2, 4));
            const float gs = m1 + v2;
            int gr = 0;
#pragma unroll
            for (int jj = 0; jj < 8; ++jj) { const float gj = __builtin_bit_cast(float, __builtin_amdgcn_readlane(__builtin_bit_cast(int, gs), jj * 8)); gr += (gj > gs || (gj == gs && jj < gi)) ? 1 : 0; }
            const float mv = (gr < 4) ? v : -INFINITY;
            int rk = 0;
#pragma unroll
            for (int j8 = 0; j8 < 8; ++j8) {
#pragma unroll
                for (int j1 = 0; j1 < 8; ++j1) { const int jj = 8 * j8 + j1; const float vj = __builtin_bit_cast(float, __builtin_amdgcn_readlane(__builtin_bit_cast(int, mv), jj)); rk += (vj > mv || (vj == mv && jj < lane)) ? 1 : 0; }
                __builtin_amdgcn_sched_barrier(0);
            }
            const bool sel = (rk < 8) && (gr < 4);
            const float gsum = wave_sum(sel ? score : 0.f);
            if (sel) {
                const int slot = atomicAdd(&CNT[lane], 1);
                ((int*)(p.ws + OFF_EIDX))[token * 8 + rk] = lane;
                ((int*)(p.ws + OFF_ESLOT))[token * 8 + rk] = slot;
                ((float*)(p.ws + OFF_GATE))[token * 8 + rk] = score / gsum * 2.5f;
                ((int*)(p.ws + OFF_TOKL))[(size_t)lane * NX + slot] = token;
            }
        }
        __syncthreads();
    }
}

constexpr int LE_TAB = 131072;
__device__ __forceinline__ void build_expert_tables(LDSP unsigned char* lds, const Params& p) {
    LDSP int* TP = (LDSP int*)(lds + LE_TAB); LDSP int* ST = TP + 72; LDSP int* CN = ST + 72;
    const int tid = opaque(threadIdx.x);
    if (tid < NEX) CN[tid] = (tid < NE) ? ((const int*)(p.ws + OFF_CTL + 16384))[tid] : NX;
    __syncthreads();
    if (tid == 0) {
        int tp = 0, st = 0;
        for (int e = 0; e < NEX; ++e) { const int cn = CN[e]; TP[e] = tp; ST[e] = st; tp += (cn + 255) >> 8; st += cn; }
        TP[NEX] = tp; ST[NEX] = st;
    }
    __syncthreads();
}

struct GroupSched {
    const LDSP int* TP; const LDSP int* ST; const LDSP int* CN;
    const char* A; const char* B; const int* tokl; int ntn, K, G, c; size_t bstride; bool gather; int bn;
    __device__ __forceinline__ bool next(int i, pg8::Unit& u) const {
        const int total = __builtin_amdgcn_readfirstlane(TP[NEX]) * ntn; const long L = (long)i * G + c; if (L >= total) return false;
        const int w = pg8::xcd_remap((int)L, total);
        const int nt = w % ntn, mtg = w / ntn;
        int e = u.e;
        if (__builtin_amdgcn_readfirstlane(TP[e]) > mtg) e = 0;
        while (__builtin_amdgcn_readfirstlane(TP[e + 1]) <= mtg) ++e;
        const int tpe = __builtin_amdgcn_readfirstlane(TP[e]), ste = __builtin_amdgcn_readfirstlane(ST[e]), cne = __builtin_amdgcn_readfirstlane(CN[e]);
        const int mt = mtg - tpe;
        u.B = B + (size_t)e * bstride + (size_t)nt * bn * K * 2;
        u.nvalid = cne; u.m0 = mt * 256; u.pos0 = ste; u.row0 = 0; u.col0 = nt * bn; u.e = e;
        if (gather) { u.A = A; u.rowmap = (e < NE) ? tokl + (size_t)e * NX : nullptr; }
        else { u.A = A + (size_t)(ste + mt * 256) * K * 2; u.rowmap = nullptr; }
        return true;
    }
};
#ifndef P8MODE
#define P8MODE 2
#endif
#ifndef P9MODE
#define P9MODE 2
#endif
__device__ __forceinline__ void phase8(LDSP unsigned char* lds, const Params& p) {
    build_expert_tables(lds, p);
    const LDSP int* TP = (const LDSP int*)(lds + LE_TAB);
    pg8::Epi<FH1, P8MODE> epi{FH1{p.ws + OFF_H1}};
    GroupSched S{TP, TP + 72, TP + 144, (const char*)(p.ws + OFF_H2), (const char*)(p.ws + OFF_WTE1), (const int*)(p.ws + OFF_TOKL), 8 / P8MODE, D / 2, (int)gridDim.x, (int)blockIdx.x,
                 (size_t)1024 * 2048, true, 128 * P8MODE};
    pg8::gemm_phase<true, true, P8MODE>(lds, D / 2, S, epi);
}
__device__ __forceinline__ void phase9(LDSP unsigned char* lds, const Params& p) {
    build_expert_tables(lds, p);
    const LDSP int* TP = (const LDSP int*)(lds + LE_TAB);
    pg8::Epi<FEO, P9MODE> epi{FEO{p.ws + OFF_EO}};
    GroupSched S{TP, TP + 72, TP + 144, (const char*)(p.ws + OFF_H1), (const char*)(p.ws + OFF_WTE2), nullptr, 16 / P9MODE, EFF / 2, (int)gridDim.x, (int)blockIdx.x,
                 (size_t)2048 * 512, false, 128 * P9MODE};
    pg8::gemm_phase<false, false, P9MODE>(lds, EFF / 2, S, epi);
}
typedef float f32x2v __attribute__((ext_vector_type(2)));
__device__ __forceinline__ void phase10(LDSP unsigned char* lds, const Params& p) {
    build_expert_tables(lds, p);
    const LDSP int* ST = (const LDSP int*)(lds + LE_TAB) + 72;
    const int tid = opaque(threadIdx.x), wid = tid >> 6, lane = tid & 63;
    const float* MOD = (const float*)(p.ws + OFF_MOD);
    const float* X1 = (const float*)(p.ws + OFF_X1);
    const unsigned char* EO = p.ws + OFF_EO;
    for (int row = blockIdx.x * 8 + wid; row < NX; row += gridDim.x * 8) {
        unsigned er[9]; float gw[9];
#pragma unroll
        for (int k = 0; k < 8; ++k) { const int e = ((const int*)(p.ws + OFF_EIDX))[row * 8 + k], sl = ((const int*)(p.ws + OFF_ESLOT))[row * 8 + k];
            er[k] = (unsigned)(ST[e] + sl) * (unsigned)D; gw[k] = ((const float*)(p.ws + OFF_GATE))[row * 8 + k]; }
        er[8] = (unsigned)(ST[NE] + row) * (unsigned)D; gw[8] = 1.f;
        const float* md = MOD + (size_t)(row >> 12) * 12288 + 5 * D;
        LDSP float* RB = (LDSP float*)lds + wid * 2048;
        float ss = 0.f;
#pragma unroll 2
        for (int i = 0; i < 4; ++i) { const int col = 8 * (lane + 64 * i);
            float a[8];
#pragma unroll
            for (int j = 0; j < 8; ++j) a[j] = 0.f;
#pragma unroll
            for (int k = 0; k < 9; ++k) { const u32x2 w = *(const u32x2*)(EO + er[k] + col);
                const f32x2v f0 = __builtin_amdgcn_cvt_pk_f32_fp8((int)w.x, false), f1 = __builtin_amdgcn_cvt_pk_f32_fp8((int)w.x, true), f2 = __builtin_amdgcn_cvt_pk_f32_fp8((int)w.y, false), f3 = __builtin_amdgcn_cvt_pk_f32_fp8((int)w.y, true);
                a[0] += gw[k] * f0.x; a[1] += gw[k] * f0.y; a[2] += gw[k] * f1.x; a[3] += gw[k] * f1.y; a[4] += gw[k] * f2.x; a[5] += gw[k] * f2.y; a[6] += gw[k] * f3.x; a[7] += gw[k] * f3.y; }
            const f32x4 xa = *(const f32x4*)(X1 + (size_t)row * D + col), xb = *(const f32x4*)(X1 + (size_t)row * D + col + 4), ga = *(const f32x4*)(md + col), gb = *(const f32x4*)(md + col + 4);
            f32x4 va, vb; va.x = xa.x + ga.x * a[0]; va.y = xa.y + ga.y * a[1]; va.z = xa.z + ga.z * a[2]; va.w = xa.w + ga.w * a[3];
            vb.x = xb.x + gb.x * a[4]; vb.y = xb.y + gb.y * a[5]; vb.z = xb.z + gb.z * a[6]; vb.w = xb.w + gb.w * a[7];
            ss += va.x * va.x + va.y * va.y + va.z * va.z + va.w * va.w + vb.x * vb.x + vb.y * vb.y + vb.z * vb.z + vb.w * vb.w;
            *(LDSP f32x4*)(RB + col) = va; *(LDSP f32x4*)(RB + col + 4) = vb; }
        ss = wave_sum(ss); const float rs = rsqrtf(ss * (1.f / D) + 1e-6f);
#pragma unroll 4
        for (int i = 0; i < 8; ++i) { const int col = 4 * (lane + 64 * i); const f32x4 g = *(const f32x4*)(p.final_g + col);
            const f32x4 xv = *(const LDSP f32x4*)(RB + col);
            f32x4 o; o.x = xv.x * rs * g.x; o.y = xv.y * rs * g.y; o.z = xv.z * rs * g.z; o.w = xv.w * rs * g.w;
            *(f32x4*)(p.out + (size_t)row * D + col) = o; }
    }
}

#define XB_TMO      128
#define XB_XCNT(j)  (256  + 64 * (j))
#define XB_XSUB(j)  (1280 + 64 * (j))
#define XB_XGEN(j)  (2304 + 64 * (j))
#define XB_TOP      3328
#define XB_TOPGEN   3392
#define XB_SPIN_CAP (1u << 20)
__device__ __forceinline__ unsigned xb_ld(unsigned* p)              { return __hip_atomic_load(p, __ATOMIC_RELAXED, __HIP_MEMORY_SCOPE_AGENT); }
__device__ __forceinline__ unsigned xb_add(unsigned* p, unsigned v) { return __hip_atomic_fetch_add(p, v, __ATOMIC_RELAXED, __HIP_MEMORY_SCOPE_AGENT); }
__device__ __forceinline__ unsigned xb_xcc_id() { return (unsigned)__builtin_amdgcn_s_getreg((3 << 11) | 20) & 0xFu; }
#define XB_SPIN(cond, bar) do { unsigned _sp = 0; while (cond) { __builtin_amdgcn_s_sleep(1); \
    if ((++_sp & 255u) == 0u) { if (xb_ld(&(bar)[XB_TMO])) break; if (_sp > XB_SPIN_CAP) { atomicAdd(&(bar)[XB_TMO], 1u); break; } } } } while (0)
__device__ __forceinline__ unsigned xcd_barrier_complete(unsigned* bar, unsigned x) {
    const unsigned G = gridDim.x * gridDim.y * gridDim.z;
    unsigned sum, cnt, mine, sp = 0u;
    for (;;) {
        sum = 0u; cnt = 0u; mine = 0u;
#pragma unroll
        for (unsigned j = 0; j < 16; ++j) { const unsigned c = xb_ld(&bar[XB_XCNT(j)]); sum += c; cnt += (c > 0u) ? 1u : 0u; mine = (j == x) ? c : mine; }
        if (sum == G) break;
        __builtin_amdgcn_s_sleep(1);
        if ((++sp & 255u) == 0u) { if (xb_ld(&bar[XB_TMO])) break; if (sp > XB_SPIN_CAP) { atomicAdd(&bar[XB_TMO], 1u); break; } }
    }
    return (mine > 0u ? mine : 1u) | ((cnt > 0u ? cnt : 1u) << 16);
}
__device__ __forceinline__ void xcd_barrier(unsigned* bar, unsigned x, volatile LDSP unsigned* st) {
    x = (unsigned)opaque_s((int)x);
    asm volatile("s_waitcnt vmcnt(0)" ::: "memory");
    __syncthreads();
    if (threadIdx.x == 0) {
        __builtin_amdgcn_s_waitcnt(0);
        unsigned pk = st[0];
        if (pk == 0u) { pk = xcd_barrier_complete(bar, x); st[0] = pk; }
        const unsigned nloc = pk & 0xffffu, nx = pk >> 16;
        const unsigned old = xb_add(&bar[XB_XSUB(x)], 1u);
        const unsigned gen = old / nloc;
        if (old + 1u == (gen + 1u) * nloc) {
            __builtin_amdgcn_fence(__ATOMIC_RELEASE, "agent");
            asm volatile("s_waitcnt vmcnt(0)" ::: "memory");
            const unsigned og = xb_add(&bar[XB_TOP], 1u);
            const unsigned tg = og / nx;
            if (og + 1u == (tg + 1u) * nx) xb_add(&bar[XB_TOPGEN], 1u);
            else XB_SPIN(xb_ld(&bar[XB_TOPGEN]) == tg, bar);
            __builtin_amdgcn_fence(__ATOMIC_ACQUIRE, "agent");
            xb_add(&bar[XB_XGEN(x)], 1u);
            asm volatile("s_waitcnt vmcnt(0)" ::: "memory");
        } else {
            XB_SPIN(xb_ld(&bar[XB_XGEN(x)]) == gen, bar);
            __builtin_amdgcn_fence(__ATOMIC_ACQUIRE, "agent");
            asm volatile("s_waitcnt vmcnt(0)" ::: "memory");
        }
    }
    __syncthreads();
}

__global__ void __launch_bounds__(512, 2) fwd_megakernel(Params p) {
    __shared__ __attribute__((aligned(16))) unsigned char smem_raw[SMEM_BYTES];
    LDSP unsigned char* lds = (LDSP unsigned char*)smem_raw;
    volatile LDSP unsigned* xst = (volatile LDSP unsigned*)(lds + SMEM_BYTES - 16);
    if (threadIdx.x == 0) { xst[0] = 0u; xst[1] = 0u; }
    __syncthreads();
    const unsigned xcc = xb_xcc_id();
    if (threadIdx.x == 0) (void)xb_add(&((unsigned*)p.ws)[XB_XCNT(xcc)], 1u);
#define GSYNC xcd_barrier((unsigned*)p.ws, xcc, xst)
#ifndef PH_TWICE
#define PH_TWICE 0
#endif
#ifndef PROBE_FLAGS
#define PROBE_FLAGS 0
#endif
#ifndef PH_MASK
#define PH_MASK 0xffff
#endif
#define RUN_PHASE(bit, fn) _Pragma("unroll 1") for (int rep = 0; rep < ((PH_TWICE & (bit)) ? 2 : 1); ++rep) { if (rep) GSYNC; if (PH_MASK & (bit)) { Params q = p; q.ws = opq(p.ws); q.flags = rep ? PROBE_FLAGS : 0; fn(lds, q); } }
    RUN_PHASE(1, phase0)      GSYNC;
    RUN_PHASE(2, phase1)      GSYNC;
    RUN_PHASE(4, phase2)      GSYNC;
    RUN_PHASE(8, phaseR1)     GSYNC;
    RUN_PHASE(16, phaseR2)    GSYNC;
    RUN_PHASE(32, phaseR3)    GSYNC;
    RUN_PHASE(64, phaseR4)    GSYNC;
    RUN_PHASE(128, phaseR5)   GSYNC;
    RUN_PHASE(256, phase6)    GSYNC;
    RUN_PHASE(512, phase7)    GSYNC;
    RUN_PHASE(1024, phase8)   GSYNC;
    RUN_PHASE(2048, phase9)   GSYNC;
    RUN_PHASE(4096, phase10)
}

extern "C" void kernel_launch(void* const* d_in, const int* in_sizes, int n_in, void* d_out, int out_size, void* d_ws, size_t ws_size, hipStream_t stream) {
    static int grid_blocks = 0;
    if (!grid_blocks) {
        int dev = 0, cus = 0, per_cu = 0;
        (void)hipGetDevice(&dev);
        (void)hipDeviceGetAttribute(&cus, hipDeviceAttributeMultiprocessorCount, dev);
        (void)hipOccupancyMaxActiveBlocksPerMultiprocessor(&per_cu, fwd_megakernel, 512, 0);
        if (per_cu > 1) per_cu = 1;
        grid_blocks = cus * per_cu;
        if (ws_size < WS_END) fprintf(stderr, "workspace too small: %zu < %zu\n", ws_size, (size_t)WS_END);
    }
    Params p{};
    const float** f = (const float**)&p;
    for (int i = 0; i < 31; ++i) f[i] = (const float*)d_in[i];
    p.out = (float*)d_out; p.ws = (unsigned char*)d_ws;
    (void)hipMemsetAsync(d_ws, 0, 32768, stream);
    void* args[] = {&p};
    hipError_t e = hipLaunchCooperativeKernel((void*)fwd_megakernel, dim3(grid_blocks), dim3(512), args, 0, stream);
    if (e != hipSuccess) fprintf(stderr, "cooperative launch failed: %s (grid %d)\n", hipGetErrorString(e), grid_blocks);
}
```

```cpp
#include <hip/hip_runtime.h>
#include <hip/hip_cooperative_groups.h>
#include <cstdio>
#include <cstdint>
namespace cg = cooperative_groups;

#define LDSP __attribute__((address_space(3)))
typedef unsigned short bf16_t;
typedef short bf16x8 __attribute__((ext_vector_type(8)));
typedef float f32x4 __attribute__((ext_vector_type(4)));
typedef float f32x16 __attribute__((ext_vector_type(16)));
typedef unsigned u32x4 __attribute__((ext_vector_type(4)));
typedef unsigned u32x2 __attribute__((ext_vector_type(2)));
typedef int v4i __attribute__((ext_vector_type(4)));
typedef int v8i __attribute__((ext_vector_type(8)));
__device__ __forceinline__ u32x4 mk4u(unsigned a, unsigned b, unsigned c, unsigned d) { u32x4 r; r.x = a; r.y = b; r.z = c; r.w = d; return r; }
__device__ __forceinline__ u32x2 mk2u(unsigned a, unsigned b) { u32x2 r; r.x = a; r.y = b; return r; }
__device__ __forceinline__ f32x4 mk4f(float a, float b, float c, float d) { f32x4 r; r.x = a; r.y = b; r.z = c; r.w = d; return r; }

constexpr int D = 2048, NB = 2, T = 4096, CL = 256, NX = NB * T, NCX = NB * CL, NR = NX + NCX;
constexpr int INC = 5056, INP = 5120;
constexpr int C_R = 0, C_K = 1024, C_V = 2048, C_XW = 3072, C_XA = 3168, C_XG = 3264, C_Q = 3520, C_AK = 4544, C_AV = 4800;
constexpr int NE = 64, NEX = 65, EFF = 512;
constexpr int NCHUNK = 68;
constexpr int NINST = NB * 16 * 2 * NCHUNK;
constexpr int EROWS = NX * 8 + NX;

constexpr size_t al4k(size_t x) { return (x + 4095) & ~(size_t)4095; }
constexpr size_t OFF_CTL = 0;
constexpr size_t OFF_ROPE = 65536;
constexpr size_t OFF_MODP = OFF_ROPE + 8192;
constexpr size_t OFF_MOD = al4k(OFF_MODP + (size_t)16 * 3 * 12288 * 4);
constexpr size_t OFF_WTDU = al4k(OFF_MOD + (size_t)3 * 12288 * 4);
constexpr size_t OFF_WTIU = OFF_WTDU + (size_t)2 * 1024 * 128 * 2;
constexpr size_t OFF_WTGU = OFF_WTIU + (size_t)2 * 1024 * 128 * 2;
constexpr size_t OFF_WTE2 = OFF_WTGU + (size_t)1024 * 256 * 2;
constexpr size_t OFF_X1 = OFF_WTE2 + (size_t)NEX * 2048 * 512 * 2;
constexpr size_t OFF_H2 = OFF_X1 + (size_t)NX * D * 4;
constexpr size_t OFF_TOKL = OFF_H2 + (size_t)NX * D * 2;
constexpr size_t OFF_EIDX = OFF_TOKL + (size_t)NE * NX * 4;
constexpr size_t OFF_ESLOT = OFF_EIDX + (size_t)NX * 8 * 4;
constexpr size_t OFF_GATE = OFF_ESLOT + (size_t)NX * 8 * 4;
constexpr size_t OFF_H1 = OFF_GATE + (size_t)NX * 8 * 4;
constexpr size_t OFF_WTE1 = al4k(OFF_H1 + (size_t)(EROWS + 256) * EFF * 2);
constexpr size_t OFF_EO = OFF_WTE1;
constexpr size_t OFF_WTIN = OFF_WTE1 + (size_t)NEX * 1024 * 2048 * 2;
constexpr size_t OFF_WTOUT = OFF_WTIN + (size_t)INP * D * 2;
constexpr size_t OFF_HX = OFF_WTOUT + (size_t)D * D * 2;
constexpr size_t OFF_PX = OFF_HX + (size_t)NR * D * 2;
constexpr size_t OFF_CM = OFF_PX + (size_t)NR * INP * 2;
constexpr size_t OFF_CN = OFF_CM + (size_t)NINST * 4096 * 2;
constexpr size_t OFF_CP = OFF_CN + (size_t)NINST * 4096 * 2;
constexpr size_t OFF_CQ = OFF_CP + (size_t)NINST * 4096 * 2;
constexpr size_t OFF_YD = OFF_CQ + (size_t)NINST * 4096 * 2;
constexpr size_t OFF_BON = OFF_YD + (size_t)2 * NX * 1024 * 4;
constexpr size_t OFF_MIX = OFF_BON + (size_t)2 * NX * 16 * 4;
constexpr size_t OFF_WRT = OFF_MIX + (size_t)NX * D * 2;
constexpr size_t WS_END = OFF_WRT + (size_t)NE * D * 4;
constexpr size_t OFF_CNTB = OFF_MODP;
constexpr size_t OFF_RS = OFF_X1;
constexpr size_t OFF_KS = OFF_RS + (size_t)NR * 1024 * 2;
constexpr size_t OFF_KK = OFF_KS + (size_t)NR * 1024 * 2;
constexpr size_t OFF_VS = OFF_KK + (size_t)NR * 1024 * 2;
constexpr size_t OFF_TW = OFF_VS + (size_t)NR * 1024 * 2;
constexpr size_t OFF_XA = OFF_TW + (size_t)NR * 128 * 2;
constexpr size_t OFF_SG = OFF_XA + (size_t)NR * 128 * 2;
constexpr size_t OFF_LWG = OFF_SG + (size_t)NX * 256 * 2;
constexpr size_t OFF_AIG = OFF_LWG + (size_t)NR * 2048 * 2;
constexpr size_t OFF_GG = OFF_AIG + (size_t)NR * 2048 * 2;
static_assert(OFF_GG + (size_t)NX * 1024 * 2 <= OFF_WTE1, "RWKV token buffers fit the overlay region");
static_assert(OFF_EO + (size_t)EROWS * D * 2 <= OFF_HX, "EO overlays only WT_E1/WT_IN/WT_OUT");
static_assert(WS_END <= (size_t)1073741824, "workspace map must fit 1 GiB");

constexpr int SMEM_BYTES = 157 * 1024;

struct Params {
    const float *x, *c, *ctx, *c_ctx, *w_mod, *b_mod, *norm1_g, *norm2_g, *w_in, *shift_mu, *k_k, *k_a, *r_k, *decay_bias, *decay_up, *iclr_bias, *iclr_up,
        *gate_up, *lnx_g, *lnx_b, *attn_sink, *w_out, *w_router, *expert_bias, *e_gate, *e_up, *e_down, *s_gate, *s_up, *s_down, *final_g;
    float* out;
    unsigned char* ws;
    int flags;
};

#if defined(__HIP_DEVICE_COMPILE__)
#define LDS_AT(T, addr) (__builtin_bit_cast(LDSP T*, (unsigned)(addr)))
#define LDS_ADDR(ptr) (__builtin_bit_cast(unsigned, (ptr)))
#else
#define LDS_AT(T, addr) ((LDSP T*)(size_t)(addr))
#define LDS_ADDR(ptr) ((unsigned)(size_t)(ptr))
#endif
constexpr int TID_TAB = SMEM_BYTES - 320;
__device__ __forceinline__ int TIDX() {
    const unsigned hw = (unsigned)__builtin_amdgcn_s_getreg(0x2804) & 63u;
    unsigned z = 0u; asm volatile("" : "+v"(z));
    const int wv = __builtin_amdgcn_readfirstlane(*LDS_AT(const int, TID_TAB + 4u * hw));
    return (wv << 6) | (int)__builtin_amdgcn_mbcnt_hi(~0u, __builtin_amdgcn_mbcnt_lo(~0u, z));
}
__device__ __forceinline__ unsigned f2bf(float f) { unsigned u = __float_as_uint(f); return (u + 0x7fffu + ((u >> 16) & 1u)) >> 16; }
__device__ __forceinline__ float bf2f(unsigned h) { return __uint_as_float(h << 16); }
typedef float f32x2_t __attribute__((ext_vector_type(2)));
typedef __bf16 bf16x2_t __attribute__((ext_vector_type(2)));
__device__ __forceinline__ unsigned pk2(float lo, float hi) { f32x2_t v = {lo, hi}; bf16x2_t b = __builtin_convertvector(v, bf16x2_t); return __builtin_bit_cast(unsigned, b); }
__device__ __forceinline__ unsigned pk4_fp8(float a, float b, float c, float d) { int w = 0; w = __builtin_amdgcn_cvt_pk_fp8_f32(a, b, w, false); w = __builtin_amdgcn_cvt_pk_fp8_f32(c, d, w, true); return (unsigned)w; }
__device__ __forceinline__ int opaque(int x);
__device__ __forceinline__ float shx(float v, int o) {
    const int l = TIDX() & 63;
    return __builtin_bit_cast(float, __builtin_amdgcn_ds_bpermute((l ^ o) << 2, __builtin_bit_cast(int, v))); }
__device__ __forceinline__ float wave_sum(float v) {
#pragma unroll
    for (int o = 32; o > 0; o >>= 1) v += shx(v, o);
    return v;
}
__device__ __forceinline__ int opaque(int x) { asm volatile("" : "+v"(x)); return x; }
__device__ __forceinline__ int opaque_s(int x) { asm volatile("" : "+s"(x)); return x; }
__device__ __forceinline__ unsigned char* opq(unsigned char* x) {
    unsigned long long v = (unsigned long long)x; asm volatile("" : "+s"(v));
    return (unsigned char*)(__attribute__((address_space(1))) unsigned char*)v; }
__device__ __forceinline__ float sigmoidf_(float x) { return __builtin_amdgcn_rcpf(1.f + __expf(-x)); }
__device__ __forceinline__ int lds_byte(int r, int c) { const int st = (r >> 4) * 2 + (c >> 5), rr = r & 15, cc = c & 31, ob = rr * 64 + cc * 2; return st * 1024 + (ob ^ (((ob >> 9) & 1) << 5)); }
__device__ __forceinline__ int sw64(int r, int k) { return r * 128 + ((((k >> 3) ^ (r >> 1)) & 7) << 4) + (k & 7) * 2; }

__device__ __forceinline__ f32x16 zero16() { f32x16 z;
#pragma unroll
    for (int i = 0; i < 16; ++i) z[i] = 0.f; return z; }
__device__ __forceinline__ int crow(int reg, int hi) { return (reg & 3) + 8 * (reg >> 2) + 4 * hi; }

namespace pg8 {
constexpr int BM = 256, BK = 64, HALF = 128, HTB = HALF * BK * 2, NXCD = 8;
__device__ __forceinline__ void stage_rc(int b, int& R, int& C) { const int st = b / 1024, sb = b % 1024, swz = sb ^ (((sb >> 9) & 1) << 5); R = (st >> 1) * 16 + swz / 64; C = (st & 1) * 32 + (swz % 64) / 2; }
struct Unit { const char* A; const char* B; const int* rowmap; int nvalid, m0, row0, col0, pos0, e; };
__device__ __forceinline__ int xcd_remap(int L, int nwg) { const int q = nwg / NXCD, r = nwg % NXCD, xcd = L % NXCD, off = L / NXCD; return (xcd < r ? xcd * (q + 1) : r * (q + 1) + (xcd - r) * q) + off; }

__device__ __forceinline__ int perm32(int rho) { const int n = rho >> 4, i = rho & 15; return 8 * (i >> 2) + 4 * n + (i & 3); }
template <class F, int NBJ = 2> struct Epi {
    F f;
    __device__ __forceinline__ void operator()(const f32x4 (&acc)[2][2][4][2], const Unit& u, int wr, int wc, int fr, int fq) const {
        { const int lane = TIDX() & 63; fr = lane & 15; fq = lane >> 4; }
#pragma unroll
        for (int ai = 0; ai < 2; ++ai)
#pragma unroll
            for (int m = 0; m < 4; ++m)
#pragma unroll
                for (int bj = 0; bj < NBJ; ++bj) { f(u, 128 * ai + 64 * wr + 16 * m + fr, 128 * bj + 32 * wc + 8 * fq, acc[ai][bj][m][0], acc[ai][bj][m][1]); __builtin_amdgcn_sched_barrier(0); }
    }
};

template <bool GATHER, bool ALIGN_EPI = true, int FP8M = 0, class EpiT, class Sched>
__device__ __forceinline__ void gemm_phase(LDSP unsigned char* lds, const int K, const Sched& S, const EpiT& E) {
    const int tid = TIDX(), wid = __builtin_amdgcn_readfirstlane(tid >> 6), lane = tid & 63, wr = wid >> 2, wc = wid & 3, fr = lane & 15, fq = lane >> 4;
    constexpr bool FP8 = (FP8M != 0), NARROW = (FP8M == 1);
    const int nt = K / BK;
    unsigned voffA[2], voffB[2];
#pragma unroll
    for (int i = 0; i < 2; ++i) { int R, C; stage_rc(tid * 16 + i * 8192, R, C); const int Rb = (R & ~31) + perm32(R & 31); voffA[i] = (unsigned)(R * K + C) * 2u; voffB[i] = (unsigned)(Rb * K + C) * 2u; }
    const size_t kstep = (size_t)(BK * 2);
    const size_t hstep = (size_t)HALF * K * 2;
    const size_t hstepB = hstep;
    const unsigned ldsw = (unsigned)wid * 1024u;
    const int aoff = lds_byte(wr * 64 + fr, fq * 8), boff = lds_byte(wc * 32 + fr, fq * 8);
    const unsigned abase = LDS_ADDR(lds) + (unsigned)aoff, bbase = LDS_ADDR(lds) + 65536u + (unsigned)boff;
#define PG8_SA(b, h) (((b) * 2 + (h)) * HTB)
#define PG8_SB(b, h) ((4 + (b) * 2 + (h)) * HTB)
#define PG8_STAGE(bufoff, gbase, voff) do { _Pragma("unroll") for (int _i = 0; _i < 2; ++_i) \
        { unsigned _o = (voff)[_i]; asm volatile("" : "+v"(_o)); __builtin_amdgcn_global_load_lds((const unsigned*)((const char*)(gbase) + _o), (LDSP unsigned*)(lds + (bufoff) + ldsw + _i * 8192), 16, 0, 0); } } while (0)
#define PG8_STAGE_B1(bufoff, gbase) do { if constexpr (!NARROW) { PG8_STAGE(bufoff, gbase, voffB); } } while (0)
#define PG8_STAGE_A(bufoff, nx, h, ubase, koff) do { if constexpr (GATHER) { unsigned _v[2]; const LDSP unsigned* _ro = rowoff + ((((nx) ? (ui + 1) : ui) & 1) * 4 + (h) * 2) * 512; _v[0] = _ro[0]; _v[1] = _ro[512]; PG8_STAGE(bufoff, (ubase) + (koff), _v); } \
        else { PG8_STAGE(bufoff, (ubase) + (h) * hstep + (koff), voffA); } } while (0)
#define PG8_LD16(off) (*(const LDSP bf16x8*)(lds + (off)))
#define PG8_DSR(base, off) ({ v4i _r; asm volatile("ds_read_b128 %0, %1 offset:%2" : "=v"(_r) : "v"(base), "n"(off)); _r; })
#define PG8_LDA(dst, b, h) do { _Pragma("unroll") for (int m = 0; m < 4; ++m) { if constexpr (FP8) dst##8[m] = __builtin_shufflevector(PG8_DSR(abase, PG8_SA(b, h) + m * 2048), PG8_DSR(abase, PG8_SA(b, h) + m * 2048 + 1024), 0, 1, 2, 3, 4, 5, 6, 7); \
        else { _Pragma("unroll") for (int k = 0; k < 2; ++k) dst[m][k] = PG8_LD16(PG8_SA(b, h) + aoff + m * 2048 + k * 1024); } } } while (0)
#define PG8_LDB(dst, b, h) do { if constexpr (!NARROW || (h) == 0) { _Pragma("unroll") for (int n = 0; n < 2; ++n) { if constexpr (FP8) dst##8[n] = __builtin_shufflevector(PG8_DSR(bbase, PG8_SB(b, h) - 65536 + n * 2048), PG8_DSR(bbase, PG8_SB(b, h) - 65536 + n * 2048 + 1024), 0, 1, 2, 3, 4, 5, 6, 7); \
        else { _Pragma("unroll") for (int k = 0; k < 2; ++k) dst[n][k] = PG8_LD16(PG8_SB(b, h) + boff + n * 2048 + k * 1024); } } } } while (0)
#define PG8_MMA(ai, bj, At, Bt) do { if constexpr (!NARROW || (bj) == 0) { if constexpr (FP8) __builtin_amdgcn_sched_barrier(0); __builtin_amdgcn_s_setprio(1); if constexpr (FP8) { _Pragma("unroll") for (int m = 0; m < 4; ++m) _Pragma("unroll") for (int n = 0; n < 2; ++n) \
            acc[ai][bj][m][n] = __builtin_amdgcn_mfma_scale_f32_16x16x128_f8f6f4(Bt##8[n], At##8[m], acc[ai][bj][m][n], 0, 0, 0, 0x7f7f7f7f, 0, 0x7f7f7f7f); } \
        else { _Pragma("unroll") for (int m = 0; m < 4; ++m) _Pragma("unroll") for (int n = 0; n < 2; ++n) _Pragma("unroll") for (int k = 0; k < 2; ++k) \
            acc[ai][bj][m][n] = __builtin_amdgcn_mfma_f32_16x16x32_bf16(Bt[n][k], At[m][k], acc[ai][bj][m][n], 0, 0, 0); } __builtin_amdgcn_s_setprio(0); } } while (0)
#define PG8_WAIT_V(n) asm volatile("s_waitcnt vmcnt(" #n ")" ::: "memory")
#define PG8_WAIT_L(n) asm volatile("s_waitcnt lgkmcnt(" #n ")" ::: "memory")
#define PG8_BAR __builtin_amdgcn_s_barrier()
#define PG8_SCHED __builtin_amdgcn_sched_barrier(0)
    Unit cur, nxt; int ui = 0;
    cur.e = 0; nxt.e = 0;
    if (!S.next(0, cur)) return;
    LDSP unsigned* rowoff = (LDSP unsigned*)(lds + 132096) + tid;
    auto rows_of = [&](const Unit& u, int slot) {
        if constexpr (GATHER) {
#pragma unroll
            for (int h = 0; h < 2; ++h)
#pragma unroll
                for (int i = 0; i < 2; ++i) { int R, C; stage_rc(TIDX() * 16 + i * 8192, R, C); const int idx = u.m0 + h * HALF + R; int gr = idx; if (u.rowmap) gr = (idx < u.nvalid) ? u.rowmap[idx] : 0;
                    rowoff[((slot & 1) * 4 + h * 2 + i) * 512] = (unsigned)(gr * K + C) * 2u; }
        }
    };
    rows_of(cur, 0);
    f32x4 acc[2][2][4][2];
#pragma unroll
    for (int a = 0; a < 2; ++a)
#pragma unroll
        for (int b = 0; b < 2; ++b)
#pragma unroll
            for (int m = 0; m < 4; ++m)
#pragma unroll
                for (int n = 0; n < 2; ++n) acc[a][b][m][n] = (f32x4){0.f, 0.f, 0.f, 0.f};
    bf16x8 At[4][2], B0[2][2], B1[2][2];
    v8i At8[4], B08[2], B18[2];
    const char* cA = cur.A; const char* cB = cur.B;
    PG8_STAGE(PG8_SB(0, 0), cB, voffB); PG8_STAGE_B1(PG8_SB(0, 1), cB + hstepB); PG8_STAGE_A(PG8_SA(0, 0), false, 0, cA, 0); PG8_STAGE_A(PG8_SA(0, 1), false, 1, cA, 0);
    if (wr == 1) PG8_BAR;
    PG8_WAIT_V(2); PG8_BAR;
    PG8_STAGE(PG8_SB(1, 0), cB + kstep, voffB); PG8_STAGE_A(PG8_SA(1, 0), false, 0, cA, kstep); PG8_STAGE_B1(PG8_SB(1, 1), cB + hstepB + kstep);
    if constexpr (NARROW) PG8_WAIT_V(4); else PG8_WAIT_V(6);
    PG8_BAR;
    for (;;) {
        nxt.e = cur.e;
        const bool has_next = S.next(ui + 1, nxt);
        rows_of(has_next ? nxt : cur, ui + 1);
        const char* nA = has_next ? nxt.A : cA; const char* nB = has_next ? nxt.B : cB;
#pragma unroll 1
        for (int t = 0; t < nt; t += 2) {
            const bool last = (t == nt - 2);
            const size_t k1 = (size_t)(t + 1) * kstep;
            const char* a2 = last ? nA : cA; const size_t k2 = last ? 0 : (size_t)(t + 2) * kstep;
            const char* b2 = last ? nB : cB + (size_t)(t + 2) * kstep;
            const char* b3 = b2 + kstep;
            PG8_LDB(B0, 0, 0); PG8_LDB(B1, 0, 1); PG8_SCHED; PG8_LDA(At, 0, 0); PG8_STAGE_A(PG8_SA(1, 1), false, 1, cA, k1);
            if constexpr (NARROW) PG8_WAIT_V(6); else PG8_WAIT_V(8);
            PG8_WAIT_L(0); PG8_BAR; PG8_MMA(0, 0, At, B0); PG8_MMA(0, 1, At, B1); PG8_BAR; PG8_SCHED;
            PG8_LDA(At, 0, 1); PG8_STAGE(PG8_SB(0, 0), b2, voffB); PG8_STAGE_B1(PG8_SB(0, 1), b2 + hstepB); PG8_STAGE_A(PG8_SA(0, 0), last, 0, a2, k2);
            if constexpr (NARROW) PG8_WAIT_V(6); else PG8_WAIT_V(8);
            PG8_WAIT_L(0); PG8_BAR; PG8_MMA(1, 0, At, B0); PG8_MMA(1, 1, At, B1); PG8_BAR; PG8_SCHED;
            PG8_LDB(B0, 1, 0); PG8_LDB(B1, 1, 1); PG8_SCHED; PG8_LDA(At, 1, 0); PG8_STAGE_A(PG8_SA(0, 1), last, 1, a2, k2);
            if constexpr (NARROW) PG8_WAIT_V(6); else PG8_WAIT_V(8);
            PG8_WAIT_L(0); PG8_BAR; PG8_MMA(0, 0, At, B0); PG8_MMA(0, 1, At, B1); PG8_BAR; PG8_SCHED;
            PG8_LDA(At, 1, 1); PG8_STAGE(PG8_SB(1, 0), b3, voffB); PG8_STAGE_B1(PG8_SB(1, 1), b3 + hstepB); PG8_STAGE_A(PG8_SA(1, 0), last, 0, a2, k2 + kstep);
            if constexpr (NARROW) PG8_WAIT_V(6); else PG8_WAIT_V(8);
            PG8_WAIT_L(0); PG8_BAR; PG8_MMA(1, 0, At, B0); PG8_MMA(1, 1, At, B1); PG8_BAR; PG8_SCHED;
        }
        if constexpr (ALIGN_EPI) { if (wr == 0) PG8_BAR; }
        E(acc, cur, wr, wc, fr, fq);
        if (!has_next) break;
#pragma unroll
        for (int a = 0; a < 2; ++a)
#pragma unroll
            for (int b = 0; b < 2; ++b)
#pragma unroll
                for (int m = 0; m < 4; ++m)
#pragma unroll
                    for (int n = 0; n < 2; ++n) acc[a][b][m][n] = (f32x4){0.f, 0.f, 0.f, 0.f};
        cur = nxt; cA = nA; cB = nB; ++ui;
        if constexpr (ALIGN_EPI) { if (wr == 1) PG8_BAR; }
    }
    PG8_WAIT_V(0);
    if constexpr (!ALIGN_EPI) { if (wr == 0) PG8_BAR; }
    PG8_BAR;
#undef PG8_SA
#undef PG8_SB
#undef PG8_STAGE
#undef PG8_STAGE_A
#undef PG8_STAGE_B1
#undef PG8_LDA
#undef PG8_LD16
#undef PG8_DSR
#undef PG8_LDB
#undef PG8_MMA
#undef PG8_WAIT_V
#undef PG8_WAIT_L
#undef PG8_BAR
#undef PG8_SCHED
}

struct DenseSched {
    const char* A; const char* B; int nM, nN, K, G, c;
    __device__ __forceinline__ bool next(int i, Unit& u) const {
        const int nwg = nM * nN; const long L = (long)i * G + c; if (L >= nwg) return false;
        const int wgid = xcd_remap((int)L, nwg);
        const int nig = 8 * nN, gid = wgid / nig, fm = gid * 8, gsz = (nM - fm) < 8 ? (nM - fm) : 8;
        const int pm = fm + ((wgid % nig) % gsz), pn = (wgid % nig) / gsz;
        u.A = A + (size_t)pm * 256 * K * 2; u.B = B + (size_t)pn * 256 * K * 2; u.rowmap = nullptr; u.nvalid = 0; u.m0 = 0; u.row0 = pm * 256; u.col0 = pn * 256; u.pos0 = 0;
        return true;
    }
};
}

struct FPX { bf16_t* PX; __device__ __forceinline__ void operator()(const pg8::Unit& u, int lr, int lc, f32x4 v0, f32x4 v1) const {
    *(u32x4*)(PX + (size_t)(u.row0 + lr) * INP + u.col0 + lc) = mk4u(pk2(v0[0], v0[1]), pk2(v0[2], v0[3]), pk2(v1[0], v1[1]), pk2(v1[2], v1[3])); } };
struct FX1 { const float* x; const float* mod; float* X1; float sc; __device__ __forceinline__ void operator()(const pg8::Unit& u, int lr, int lc, f32x4 v0, f32x4 v1) const {
    const int row = u.row0 + lr, col = u.col0 + lc; const float* xp = x + (size_t)row * D + col; const float* gp = mod + (size_t)(row >> 12) * 12288 + 2 * D + col; float* op = X1 + (size_t)row * D + col;
    *(f32x4*)op = *(const f32x4*)xp + *(const f32x4*)gp * (v0 * sc); *(f32x4*)(op + 4) = *(const f32x4*)(xp + 4) + *(const f32x4*)(gp + 4) * (v1 * sc); } };
constexpr float W1_SCALE = 64.f, W2_SCALE = 32.f;
struct FH1 { unsigned char* H1; __device__ __forceinline__ void operator()(const pg8::Unit& u, int lr, int lc, f32x4 v0, f32x4 v1) const {
    if (u.m0 + lr < u.nvalid) { float h[4];
#pragma unroll
        for (int e = 0; e < 4; ++e) { const float g = v0[e] * (1.f / W1_SCALE); h[e] = g * sigmoidf_(g) * (v1[e] * (1.f / W1_SCALE)); }
        *(unsigned*)(H1 + (unsigned)((u.pos0 + u.m0 + lr) * EFF + ((u.col0 + lc) >> 1))) = pk4_fp8(h[0], h[1], h[2], h[3]); } } };
struct FEO { unsigned char* EO; __device__ __forceinline__ void operator()(const pg8::Unit& u, int lr, int lc, f32x4 v0, f32x4 v1) const {
    if (u.m0 + lr < u.nvalid) { v0 *= (1.f / W2_SCALE); v1 *= (1.f / W2_SCALE);
        *(u32x2*)(EO + (unsigned)((u.pos0 + u.m0 + lr) * D + u.col0 + lc)) = mk2u(pk4_fp8(v0[0], v0[1], v0[2], v0[3]), pk4_fp8(v1[0], v1[1], v1[2], v1[3])); } } };

struct ConvJob { const float* src; bf16_t* dst; int K, N, ld, mode, ntk, ntn; size_t sbs, dbs; };
__device__ __forceinline__ int conv_row(int n, int mode) { return mode == 0 ? n : (8 * (n >> 2) + (n & 3) + (mode == 2 ? 4 : 0)); }

struct TileCtx { const float* src; bf16_t* dst; int N, ld, mode, k0, n0; };
constexpr int CT0 = 0, CT1 = CT0 + 8 * (INC / 64), CT2 = CT1 + 8 * 32, CT3 = CT2 + 64 * 64, CT4 = CT3 + 64 * 64, CT5 = CT4 + 64 * 64, CT6 = CT5 + 64, CT7 = CT6 + 64, CT8 = CT7 + 64, CT_END = CT8 + 16;
__device__ __forceinline__ void conv_decode(const Params& p, int g, const float*& src, bf16_t*& dst, int& N, int& ld, int& mode, int& k0, int& n0) {
    unsigned char* WTE1 = p.ws + OFF_WTE1; unsigned char* WTE2 = p.ws + OFF_WTE2;
    unsigned char* d8; int t, ntk, ntn; size_t sbs = 0, dbs = 0;
    if (g < CT1)      { t = g - CT0; src = p.w_in; d8 = p.ws + OFF_WTIN; N = INC; ld = 4096; mode = 0; ntk = 8; ntn = INC / 64; }
    else if (g < CT2) { t = g - CT1; src = p.w_out; d8 = p.ws + OFF_WTOUT; N = 2048; ld = 2048; mode = 4; ntk = 8; ntn = 32; }
    else if (g < CT3) { t = g - CT2; src = p.e_gate; d8 = WTE1; N = 512; ld = 2048; mode = 5; ntk = 8; ntn = 8; sbs = (size_t)2048 * 512; dbs = (size_t)1024 * 2048; }
    else if (g < CT4) { t = g - CT3; src = p.e_up; d8 = WTE1; N = 512; ld = 2048; mode = 6; ntk = 8; ntn = 8; sbs = (size_t)2048 * 512; dbs = (size_t)1024 * 2048; }
    else if (g < CT5) { t = g - CT4; src = p.e_down; d8 = WTE2; N = 2048; ld = 512; mode = 4; ntk = 2; ntn = 32; sbs = (size_t)512 * 2048; dbs = (size_t)2048 * 512; }
    else if (g < CT6) { t = g - CT5; src = p.s_gate; d8 = WTE1 + (size_t)64 * 1024 * 2048; N = 512; ld = 2048; mode = 5; ntk = 8; ntn = 8; }
    else if (g < CT7) { t = g - CT6; src = p.s_up; d8 = WTE1 + (size_t)64 * 1024 * 2048; N = 512; ld = 2048; mode = 6; ntk = 8; ntn = 8; }
    else if (g < CT8) { t = g - CT7; src = p.s_down; d8 = WTE2 + (size_t)64 * 2048 * 512; N = 2048; ld = 512; mode = 4; ntk = 2; ntn = 32; }
    else              { t = g - CT8; src = p.gate_up; d8 = p.ws + OFF_WTGU; N = 1024; ld = 512; mode = 0; ntk = 1; ntn = 16; }
    const int per = ntk * ntn, bi = t / per, rem = t - bi * per, kt = rem / ntn, ntile = rem - kt * ntn;
    src += (size_t)bi * sbs; dst = (bf16_t*)(d8 + (size_t)bi * dbs); k0 = kt * 256; n0 = ntile * 64;
}
__device__ __forceinline__ void conv_load(const float* src, int N, int k0, int n0, f32x4 (&v)[4][2], int tid) {
    const int kr = tid >> 3, nc = (tid & 7) * 8;
#pragma unroll
    for (int s = 0; s < 4; ++s) { const float* q = src + (size_t)(k0 + s * 64 + kr) * N + n0 + nc; v[s][0] = *(const f32x4*)q; v[s][1] = *(const f32x4*)(q + 4); }
}
__device__ __forceinline__ void conv_finish(LDSP unsigned char* lds, bf16_t* dst, int ld, int mode, int k0, int n0, const f32x4 (&v)[4][2], int tid) {
    LDSP float* Tm = (LDSP float*)lds;
    {
        const int kr = tid >> 3, nc = (tid & 7) * 8;
#pragma unroll
        for (int s = 0; s < 4; ++s) { LDSP float* q = Tm + (s * 64 + kr) * 65 + nc;
            q[0] = v[s][0].x; q[1] = v[s][0].y; q[2] = v[s][0].z; q[3] = v[s][0].w; q[4] = v[s][1].x; q[5] = v[s][1].y; q[6] = v[s][1].z; q[7] = v[s][1].w; }
    }
    __syncthreads();
    {
        const int n = tid >> 3; unsigned char* drow8 = (unsigned char*)dst + (size_t)conv_row(n0 + n, mode & 3) * ld;
        if (mode & 4) {
            const float sc = (mode & 3) ? W1_SCALE : W2_SCALE;
#pragma unroll
            for (int s = 0; s < 2; ++s) { const int kc = ((tid & 7) + 8 * s) * 16; float f[16];
#pragma unroll
                for (int j = 0; j < 16; ++j) f[j] = Tm[(kc + j) * 65 + n] * sc;
                *(u32x4*)(drow8 + k0 + kc) = mk4u(pk4_fp8(f[0], f[1], f[2], f[3]), pk4_fp8(f[4], f[5], f[6], f[7]), pk4_fp8(f[8], f[9], f[10], f[11]), pk4_fp8(f[12], f[13], f[14], f[15])); }
        } else {
            bf16_t* drow = (bf16_t*)drow8 + k0;
#pragma unroll
            for (int s = 0; s < 4; ++s) { const int kc = ((tid & 7) + 8 * s) * 8; float f[8];
#pragma unroll
                for (int j = 0; j < 8; ++j) f[j] = Tm[(kc + j) * 65 + n];
                u32x4 w; w.x = pk2(f[0], f[1]); w.y = pk2(f[2], f[3]); w.z = pk2(f[4], f[5]); w.w = pk2(f[6], f[7]); *(u32x4*)(drow + kc) = w; }
        }
    }
    __syncthreads();
}

__device__ __forceinline__ void mod_item(LDSP unsigned char* lds, const Params& p, int item) {
    const int kb = item >> 6, nb = item & 63, tid = TIDX(), wid = tid >> 6, lane = tid & 63;
    f32x4 acc[3];
#pragma unroll
    for (int v = 0; v < 3; ++v) acc[v] = mk4f(0.f, 0.f, 0.f, 0.f);
    if (lane < 48) {
#pragma unroll 8
        for (int i = 0; i < 64; ++i) {
            const int k = kb * 512 + wid * 64 + i;
            const float c0 = p.c[k], c1 = p.c[D + k], c2 = p.c_ctx[k];
            const float s0 = c0 * sigmoidf_(c0), s1 = c1 * sigmoidf_(c1), s2 = c2 * sigmoidf_(c2);
            const f32x4 w = *(const f32x4*)(p.w_mod + (size_t)k * 12288 + nb * 192 + 4 * lane);
            acc[0] += s0 * w; acc[1] += s1 * w; acc[2] += s2 * w;
        }
    }
    LDSP float* R = (LDSP float*)lds;
    if (lane < 48) {
#pragma unroll
        for (int v = 0; v < 3; ++v) *(LDSP f32x4*)(R + (wid * 3 + v) * 192 + 4 * lane) = acc[v];
    }
    __syncthreads();
    float* MODP = (float*)(p.ws + OFF_MODP);
    for (int o = tid; o < 3 * 192; o += 512) { const int v = o / 192, cidx = o - v * 192; float sum = 0.f;
#pragma unroll
        for (int w = 0; w < 8; ++w) sum += R[(w * 3 + v) * 192 + cidx];
        MODP[((size_t)kb * 3 + v) * 12288 + nb * 192 + cidx] = sum; }
    __syncthreads();
}

__device__ __forceinline__ void conv_range(LDSP unsigned char* lds, const Params& p, int g0, int g1, int rank, int nblk) {
    const int tid = TIDX();
    int g = g0 + rank;
    const float* csrc = nullptr; bf16_t* cdst = nullptr; int cN = 0, cld = 0, cmode = 0, ck0 = 0, cn0 = 0;
    const float* nsrc = nullptr; bf16_t* ndst = nullptr; int nN = 0, nld = 0, nmode = 0, nk0 = 0, nn0 = 0;
    f32x4 va[4][2], vb[4][2];
    if (g < g1) { conv_decode(p, g, csrc, cdst, cN, cld, cmode, ck0, cn0); conv_load(csrc, cN, ck0, cn0, va, tid); }
    __builtin_amdgcn_s_waitcnt(0);
#pragma unroll 1
    while (g < g1) {
        const int gn = g + nblk;
        if (gn < g1) { conv_decode(p, gn, nsrc, ndst, nN, nld, nmode, nk0, nn0); conv_load(nsrc, nN, nk0, nn0, vb, tid); }
        conv_finish(lds, cdst, cld, cmode, ck0, cn0, va, tid);
        cdst = ndst; cld = nld; cmode = nmode; ck0 = nk0; cn0 = nn0; g = gn;
#pragma unroll
        for (int s = 0; s < 4; ++s) { va[s][0] = vb[s][0]; va[s][1] = vb[s][1]; }
    }
}

__device__ __forceinline__ void phase0(LDSP unsigned char* lds, const Params& p) {
    const int tid = TIDX();
    for (int it = blockIdx.x; it < 256; it += gridDim.x) mod_item(lds, p, it);
    conv_range(lds, p, 0, CT1, blockIdx.x, gridDim.x);
    conv_range(lds, p, CT8, CT_END, blockIdx.x, gridDim.x);
    {
        const int total = 4 * 1024 * 128;
        for (int idx = blockIdx.x * 512 + tid; idx < total; idx += gridDim.x * 512) {
            const int mtx = idx >> 17, rem = idx & 131071, n = rem >> 7, k = rem & 127;
            const float* src = (mtx < 2 ? p.decay_up : p.iclr_up) + (size_t)(mtx & 1) * 96 * 1024;
            bf16_t* dst = (bf16_t*)(p.ws + (mtx < 2 ? OFF_WTDU : OFF_WTIU)) + (size_t)(mtx & 1) * 1024 * 128;
            dst[n * 128 + k] = (bf16_t)f2bf(k < 96 ? src[(size_t)k * 1024 + n] : 0.f);
        }
    }
    {
        float* WRT = (float*)(p.ws + OFF_WRT);
        for (int idx = blockIdx.x * 512 + tid; idx < D * NE; idx += gridDim.x * 512) WRT[(size_t)(idx & 63) * D + (idx >> 6)] = p.w_router[idx];
    }
    {
        u32x4* z = (u32x4*)((bf16_t*)(p.ws + OFF_WTIN) + (size_t)INC * D);
        const int total = (INP - INC) * D * 2 / 16;
        for (int idx = blockIdx.x * 512 + tid; idx < total; idx += gridDim.x * 512) z[idx] = mk4u(0, 0, 0, 0);
    }
    if (blockIdx.x == gridDim.x - 1) {
        float2* R = (float2*)(p.ws + OFF_ROPE);
        for (int idx = tid; idx < 1024; idx += 512) { const int pos = idx >> 4, f = idx & 15;
            const float freq = powf(10000.f, -(float)f / 16.f); const float ang = (float)pos * freq; R[idx] = make_float2(cosf(ang), sinf(ang)); }
    }
}

__device__ __forceinline__ void phase1(LDSP unsigned char* lds, const Params& p) {
    const int tid = TIDX(), wid = tid >> 6, lane = tid & 63;
    const float* MODP = (const float*)(p.ws + OFF_MODP);
    float* MOD = (float*)(p.ws + OFF_MOD);
    LDSP float* MV = (LDSP float*)lds;
    for (int idx = tid; idx < 3 * 4096; idx += 512) { const int v = idx >> 12, col = idx & 4095; float s = p.b_mod[col];
#pragma unroll
        for (int kb = 0; kb < 4; ++kb) s += MODP[((size_t)kb * 3 + v) * 12288 + col];
        MV[idx] = s; }
    for (int idx = blockIdx.x * 512 + tid; idx < 3 * 12288; idx += gridDim.x * 512) { const int v = idx / 12288, col = idx - v * 12288; float s = p.b_mod[col];
#pragma unroll
        for (int kb = 0; kb < 4; ++kb) s += MODP[((size_t)kb * 3 + v) * 12288 + col];
        MOD[idx] = s; }
    __syncthreads();
    bf16_t* HX = (bf16_t*)(p.ws + OFF_HX);
    for (int row = blockIdx.x * 8 + wid; row < NR; row += gridDim.x * 8) {
        const float* src = row < NX ? p.x + (size_t)row * D : p.ctx + (size_t)(row - NX) * D;
        const int v = row < NX ? (row >> 12) : 2;
        f32x4 xv[8]; float ss = 0.f;
#pragma unroll
        for (int i = 0; i < 8; ++i) { xv[i] = ((const f32x4*)src)[lane + 64 * i]; ss += xv[i].x * xv[i].x + xv[i].y * xv[i].y + xv[i].z * xv[i].z + xv[i].w * xv[i].w; }
        ss = wave_sum(ss);
        const float rs = rsqrtf(ss * (1.f / D) + 1e-6f);
#pragma unroll
        for (int i = 0; i < 8; ++i) { const int col = 4 * (lane + 64 * i);
            const f32x4 g = *(const f32x4*)(p.norm1_g + col); const LDSP float* sh = MV + v * 4096 + col; const LDSP float* sc = sh + 2048;
            const float h0 = xv[i].x * rs * g.x * (1.f + sc[0]) + sh[0], h1 = xv[i].y * rs * g.y * (1.f + sc[1]) + sh[1];
            const float h2 = xv[i].z * rs * g.z * (1.f + sc[2]) + sh[2], h3 = xv[i].w * rs * g.w * (1.f + sc[3]) + sh[3];
            u32x2 w; w.x = pk2(h0, h1); w.y = pk2(h2, h3); *(u32x2*)(HX + (size_t)row * D + col) = w; }
    }
}

#ifndef P2_CONV_TILES
#define P2_CONV_TILES (24 * 24)
#endif
__device__ __forceinline__ int p2_gemm_blocks(int grid) { return grid == 256 ? 232 : grid; }
__device__ __forceinline__ int p2_conv_end(int grid) { return grid == 256 ? CT1 + P2_CONV_TILES : CT1; }
__device__ __forceinline__ void phase2(LDSP unsigned char* lds, const Params& p) {
    pg8::Epi<FPX> epi{FPX{(bf16_t*)(p.ws + OFF_PX)}};
    const int ng = p2_gemm_blocks((int)gridDim.x);
    if ((int)blockIdx.x >= ng) { conv_range(lds, p, CT1, p2_conv_end((int)gridDim.x), (int)blockIdx.x - ng, (int)gridDim.x - ng); return; }
    pg8::DenseSched S{(const char*)(p.ws + OFF_HX), (const char*)(p.ws + OFF_WTIN), NR / 256, INP / 256, D, ng, (int)blockIdx.x};
    pg8::gemm_phase<false>(lds, D, S, epi);
}

__device__ __forceinline__ void phaseR1(LDSP unsigned char* lds, const Params& p) {
    const int tid = TIDX(), wid = tid >> 6, lane = tid & 63;
    const bf16_t* PX = (const bf16_t*)(p.ws + OFF_PX);
    for (int row = blockIdx.x * 8 + wid; row < NR; row += gridDim.x * 8) {
        const bool isx = row < NX;
        const int s0 = isx ? (row & ~(T - 1)) : NX + ((row - NX) & ~(CL - 1)), len = isx ? T : CL;
        const bool hp = row > s0, hn = row + 1 < s0 + len;
        const bf16_t* pc = PX + (size_t)row * INP;
#pragma unroll 1
        for (int it = 0; it < 7; ++it) {
            const int ch = lane + 64 * it;
            if (ch < 440) {
                const int col = ch * 8;
                const u32x4 c4 = *(const u32x4*)(pc + col);
                u32x4 p4 = mk4u(0, 0, 0, 0), n4 = mk4u(0, 0, 0, 0);
                if (hp) p4 = *(const u32x4*)(pc - INP + col);
                if (hn) n4 = *(const u32x4*)(pc + INP + col);
                const f32x4 m0 = *(const f32x4*)(p.shift_mu + col), m1 = *(const f32x4*)(p.shift_mu + col + 4);
                const float mu[8] = {m0.x, m0.y, m0.z, m0.w, m1.x, m1.y, m1.z, m1.w};
                const unsigned cw[4] = {c4.x, c4.y, c4.z, c4.w}, pw[4] = {p4.x, p4.y, p4.z, p4.w}, nw[4] = {n4.x, n4.y, n4.z, n4.w};
                float v[8];
#pragma unroll
                for (int j = 0; j < 4; ++j) {
                    const float c0 = bf2f(cw[j] & 0xffff), c1 = bf2f(cw[j] >> 16);
                    v[2 * j] = c0 + mu[2 * j] * (0.5f * (bf2f(pw[j] & 0xffff) + bf2f(nw[j] & 0xffff)) - c0);
                    v[2 * j + 1] = c1 + mu[2 * j + 1] * (0.5f * (bf2f(pw[j] >> 16) + bf2f(nw[j] >> 16)) - c1);
                }
                if (it < 2) {
                    *(u32x4*)((bf16_t*)(p.ws + OFF_RS) + (size_t)row * 1024 + col) = mk4u(pk2(v[0], v[1]), pk2(v[2], v[3]), pk2(v[4], v[5]), pk2(v[6], v[7]));
                } else if (it < 4) {
                    const int kc = col - C_K;
                    *(u32x4*)((bf16_t*)(p.ws + OFF_KS) + (size_t)row * 1024 + kc) = mk4u(pk2(v[0], v[1]), pk2(v[2], v[3]), pk2(v[4], v[5]), pk2(v[6], v[7]));
                    const f32x4 k0 = *(const f32x4*)(p.k_k + kc), k1 = *(const f32x4*)(p.k_k + kc + 4);
                    const float kq[8] = {k0.x, k0.y, k0.z, k0.w, k1.x, k1.y, k1.z, k1.w};
                    float ss = 0.f;
#pragma unroll
                    for (int j = 0; j < 8; ++j) { v[j] *= kq[j]; ss += v[j] * v[j]; }
                    ss += shx(ss, 1); ss += shx(ss, 2); ss += shx(ss, 4);
                    const float sc = rsqrtf(ss + 1e-12f);
                    *(u32x4*)((bf16_t*)(p.ws + OFF_KK) + (size_t)row * 1024 + kc) = mk4u(pk2(v[0] * sc, v[1] * sc), pk2(v[2] * sc, v[3] * sc), pk2(v[4] * sc, v[5] * sc), pk2(v[6] * sc, v[7] * sc));
                } else if (it < 6) {
                    *(u32x4*)((bf16_t*)(p.ws + OFF_VS) + (size_t)row * 1024 + col - C_V) = mk4u(pk2(v[0], v[1]), pk2(v[2], v[3]), pk2(v[4], v[5]), pk2(v[6], v[7]));
                } else if (ch < 396) {
#pragma unroll
                    for (int j = 0; j < 8; ++j) v[j] = tanhf(v[j]);
                    *(u32x4*)((bf16_t*)(p.ws + OFF_TW) + (size_t)row * 128 + col - C_XW) = mk4u(pk2(v[0], v[1]), pk2(v[2], v[3]), pk2(v[4], v[5]), pk2(v[6], v[7]));
                } else if (ch < 408) {
                    *(u32x4*)((bf16_t*)(p.ws + OFF_XA) + (size_t)row * 128 + col - C_XA) = mk4u(pk2(v[0], v[1]), pk2(v[2], v[3]), pk2(v[4], v[5]), pk2(v[6], v[7]));
                } else if (isx) {
#pragma unroll
                    for (int j = 0; j < 8; ++j) v[j] = sigmoidf_(v[j]);
                    *(u32x4*)((bf16_t*)(p.ws + OFF_SG) + (size_t)row * 256 + col - C_XG) = mk4u(pk2(v[0], v[1]), pk2(v[2], v[3]), pk2(v[4], v[5]), pk2(v[6], v[7]));
                }
            }
        }
        if (lane < 4) { *(u32x4*)((bf16_t*)(p.ws + OFF_TW) + (size_t)row * 128 + 96 + lane * 8) = mk4u(0, 0, 0, 0); *(u32x4*)((bf16_t*)(p.ws + OFF_XA) + (size_t)row * 128 + 96 + lane * 8) = mk4u(0, 0, 0, 0); }
    }
}

struct LoraSched {
    const char *A0, *B0, *A1, *B1; int G, c;
    __device__ __forceinline__ bool next(int i, pg8::Unit& u) const {
        const int per = (NR / 256) * 8; const long L = (long)i * G + c; if (L >= 2 * per) return false;
        const int job = (int)L / per, w = (int)L % per, pm = w >> 3, pn = w & 7;
        u.A = (job ? A1 : A0) + (size_t)pm * 256 * 128 * 2; u.B = (job ? B1 : B0) + (size_t)pn * 256 * 128 * 2; u.rowmap = nullptr; u.nvalid = 0; u.m0 = 0; u.row0 = pm * 256; u.col0 = pn * 256; u.pos0 = job;
        return true;
    }
};
struct FLORA { const float* dbias; const float* ibias; bf16_t* LWG; bf16_t* AIG; __device__ __forceinline__ void operator()(const pg8::Unit& u, int lr, int lc, f32x4 v0, f32x4 v1) const {
    const int row = u.row0 + lr, col = u.col0 + lc;
    const float* bp = (u.pos0 == 0 ? dbias : ibias) + col; const f32x4 b0 = *(const f32x4*)bp, b1 = *(const f32x4*)(bp + 4);
    const float sc = (u.pos0 == 0) ? -0.60653065971f : 1.f;
    float o[8];
#pragma unroll
    for (int e = 0; e < 4; ++e) { o[e] = sc * sigmoidf_(b0[e] + v0[e]); o[4 + e] = sc * sigmoidf_(b1[e] + v1[e]); }
    *(u32x4*)((u.pos0 == 0 ? LWG : AIG) + (size_t)row * 2048 + col) = mk4u(pk2(o[0], o[1]), pk2(o[2], o[3]), pk2(o[4], o[5]), pk2(o[6], o[7]));
} };
struct FGG { bf16_t* GG; __device__ __forceinline__ void operator()(const pg8::Unit& u, int lr, int lc, f32x4 v0, f32x4 v1) const {
    *(u32x4*)(GG + (size_t)(u.row0 + lr) * 1024 + u.col0 + lc) = mk4u(pk2(v0[0], v0[1]), pk2(v0[2], v0[3]), pk2(v1[0], v1[1]), pk2(v1[2], v1[3])); } };

__device__ __forceinline__ int inst_index(int b, int h, int d, int chunk) { return ((b * 16 + h) * 2 + d) * NCHUNK + chunk; }

constexpr int LA_K = 0  , LA_VT = 73728  , LA_END = LA_VT + 18 * 4608;
static_assert(LA_END <= SMEM_BYTES, "attention LDS map");

__device__ __forceinline__ void attn_unit(LDSP unsigned char* lds, const Params& p, int unit) {
    const int tid = TIDX(), wid = tid >> 6, lane = tid & 63;
    const int b = unit >> 8, kvh = (unit >> 6) & 3, qb = unit & 63, q0 = qb * 64;
    const bf16_t* PX = (const bf16_t*)(p.ws + OFF_PX);
    const float2* ROPE = (const float2*)(p.ws + OFF_ROPE);
    {
        u32x4 kx1[5], kx2[5];
#pragma unroll
        for (int it = 0; it < 5; ++it) {
            const int task = tid + 512 * it; kx1[it] = mk4u(0, 0, 0, 0); kx2[it] = mk4u(0, 0, 0, 0);
            if (task < 576 * 4) {
                const int key = task >> 2, pr = task & 3, c0 = (pr & 1) + 4 * (pr >> 1);
                const int pos = q0 - 128 + key;
                const bool lat = key < 320;
                if (!lat || (pos >= 0 && pos < T)) {
                    const bf16_t* src = PX + (size_t)(lat ? (b * T + pos) : (NX + b * CL + (key - 320))) * INP + C_AK + kvh * 64 + c0 * 8;
                    kx1[it] = *(const u32x4*)src; kx2[it] = *(const u32x4*)(src + 16);
                }
            }
        }
#pragma unroll
        for (int it = 0; it < 5; ++it) {
            const int task = tid + 512 * it;
            if (task < 576 * 4) {
                const int key = task >> 2, pr = task & 3, c0 = (pr & 1) + 4 * (pr >> 1);
                u32x4 w0 = kx1[it], w1 = kx2[it];
                if (key < 320) {
                    const int pos = q0 - 128 + key;
                    if (pos >= 0 && pos < T) {
                        const int ppos = (pr < 2) ? (pos >> 6) : (pos & 63);
                        const float2* tb = ROPE + ppos * 16 + (pr & 1) * 8;
                        const unsigned a1[4] = {w0.x, w0.y, w0.z, w0.w}, a2[4] = {w1.x, w1.y, w1.z, w1.w};
                        unsigned o1[4], o2[4];
#pragma unroll
                        for (int j = 0; j < 4; ++j) {
                            const float2 cs0 = tb[2 * j], cs1 = tb[2 * j + 1];
                            const float u0 = bf2f(a1[j] & 0xffff), u1 = bf2f(a1[j] >> 16), v0 = bf2f(a2[j] & 0xffff), v1 = bf2f(a2[j] >> 16);
                            o1[j] = pk2(u0 * cs0.x - v0 * cs0.y, u1 * cs1.x - v1 * cs1.y);
                            o2[j] = pk2(v0 * cs0.x + u0 * cs0.y, v1 * cs1.x + u1 * cs1.y);
                        }
                        w0 = mk4u(o1[0], o1[1], o1[2], o1[3]); w1 = mk4u(o2[0], o2[1], o2[2], o2[3]);
                    }
                }
                *(LDSP u32x4*)(lds + LA_K + sw64(key, c0 * 8)) = w0;
                *(LDSP u32x4*)(lds + LA_K + sw64(key, c0 * 8 + 16)) = w1;
            }
        }
    }
    {
        u32x4 vx[3][4];
#pragma unroll
        for (int it = 0; it < 3; ++it) {
            const int task = tid + 512 * it;
#pragma unroll
            for (int q = 0; q < 4; ++q) {
                vx[it][q] = mk4u(0, 0, 0, 0);
                if (task < 144 * 8) {
                    const int kg = task >> 3, dc = task & 7, key = kg * 4 + q;
                    if (key < 320) { const int pos = q0 - 128 + key; if (pos >= 0 && pos < T) vx[it][q] = *(const u32x4*)(PX + (size_t)(b * T + pos) * INP + C_AV + kvh * 64 + dc * 8); }
                    else vx[it][q] = *(const u32x4*)(PX + (size_t)(NX + b * CL + (key - 320)) * INP + C_AV + kvh * 64 + dc * 8);
                }
            }
        }
#pragma unroll
        for (int it = 0; it < 3; ++it) {
            const int task = tid + 512 * it;
            if (task < 144 * 8) {
                const int kg = task >> 3, dc = task & 7;
                unsigned short e[4][8];
#pragma unroll
                for (int q = 0; q < 4; ++q) { const u32x4 w = vx[it][q];
                    e[q][0] = w.x & 0xffff; e[q][1] = w.x >> 16; e[q][2] = w.y & 0xffff; e[q][3] = w.y >> 16; e[q][4] = w.z & 0xffff; e[q][5] = w.z >> 16; e[q][6] = w.w & 0xffff; e[q][7] = w.w >> 16; }
                const int tile = kg >> 3, kin = (kg & 7) * 4;
#pragma unroll
                for (int j = 0; j < 8; ++j) { u32x2 w; w.x = (unsigned)e[0][j] | ((unsigned)e[1][j] << 16); w.y = (unsigned)e[2][j] | ((unsigned)e[3][j] << 16);
                    *(LDSP u32x2*)(lds + LA_VT + tile * 4608 + (dc * 8 + j) * 72 + kin * 2) = w; }
            }
        }
    }
    const int hq = kvh * 4 + (wid >> 1), qs = (wid & 1) * 32, r = lane & 31, hh = lane >> 5;
    const int qpos = q0 + qs + r;
    bf16x8 qf[4];
    {
        const bf16_t* src = PX + (size_t)(b * T + qpos) * INP + C_Q + hq * 64 + 8 * hh;
        u32x4 raw[4];
#pragma unroll
        for (int s = 0; s < 4; ++s) raw[s] = *(const u32x4*)(src + 16 * s);
#pragma unroll
        for (int pr = 0; pr < 2; ++pr) {
            const int ppos = pr == 0 ? (qpos >> 6) : (qpos & 63);
            const float2* tb = ROPE + ppos * 16 + 8 * hh;
            const unsigned a1[4] = {raw[2 * pr].x, raw[2 * pr].y, raw[2 * pr].z, raw[2 * pr].w}, a2[4] = {raw[2 * pr + 1].x, raw[2 * pr + 1].y, raw[2 * pr + 1].z, raw[2 * pr + 1].w};
            unsigned o1[4], o2[4];
#pragma unroll
            for (int j = 0; j < 4; ++j) {
                const float2 cs0 = tb[2 * j], cs1 = tb[2 * j + 1];
                const float u0 = bf2f(a1[j] & 0xffff), u1 = bf2f(a1[j] >> 16), v0 = bf2f(a2[j] & 0xffff), v1 = bf2f(a2[j] >> 16);
                o1[j] = pk2(0.125f * (u0 * cs0.x - v0 * cs0.y), 0.125f * (u1 * cs1.x - v1 * cs1.y));
                o2[j] = pk2(0.125f * (v0 * cs0.x + u0 * cs0.y), 0.125f * (v1 * cs1.x + u1 * cs1.y));
            }
            const u32x4 w1 = mk4u(o1[0], o1[1], o1[2], o1[3]), w2 = mk4u(o2[0], o2[1], o2[2], o2[3]);
            qf[2 * pr] = __builtin_bit_cast(bf16x8, w1); qf[2 * pr + 1] = __builtin_bit_cast(bf16x8, w2);
        }
    }
    __syncthreads();
    float m = p.attn_sink[hq], l = 1.f;
    f32x16 o0 = zero16(), o1 = zero16();
    for (int tl = 0; tl < 18; ++tl) {
        f32x16 st = zero16();
#pragma unroll
        for (int s = 0; s < 4; ++s) {
            const bf16x8 kf = *(const LDSP bf16x8*)(lds + LA_K + sw64(32 * tl + r, 16 * s + 8 * hh));
            st = __builtin_amdgcn_mfma_f32_32x32x16_bf16(kf, qf[s], st, 0, 0, 0);
        }
        const int kp0 = q0 - 128 + 32 * tl, qlo = q0 + qs;
        if (tl < 10 && (qlo + 31 - kp0 > 128 || qlo - (kp0 + 31) < -128 || kp0 < 0 || kp0 + 31 >= T)) {
#pragma unroll
            for (int g = 0; g < 16; ++g) { const int kp = q0 - 128 + 32 * tl + crow(g, hh); const int dlt = qpos - kp;
                const bool ok = (dlt <= 128) && (dlt >= -128) && (kp >= 0) && (kp < T); st[g] = ok ? st[g] : -1e30f; }
        }
        float mt = st[0];
#pragma unroll
        for (int g = 1; g < 16; ++g) mt = fmaxf(mt, st[g]);
        mt = fmaxf(mt, shx(mt, 32));
        const float mn = fmaxf(m, mt), alpha = __expf(m - mn);
        float ps = 0.f;
#pragma unroll
        for (int g = 0; g < 16; ++g) { st[g] = __expf(st[g] - mn); ps += st[g]; }
        ps += shx(ps, 32);
        l = l * alpha + ps; m = mn;
        if (__any(alpha != 1.f)) {
#pragma unroll
            for (int g = 0; g < 16; ++g) { o0[g] *= alpha; o1[g] *= alpha; }
        }
#pragma unroll
        for (int s2 = 0; s2 < 2; ++s2) {
            const u32x4 pw = mk4u(pk2(st[8 * s2], st[8 * s2 + 1]), pk2(st[8 * s2 + 2], st[8 * s2 + 3]), pk2(st[8 * s2 + 4], st[8 * s2 + 5]), pk2(st[8 * s2 + 6], st[8 * s2 + 7]));
            const bf16x8 pf = __builtin_bit_cast(bf16x8, pw);
#pragma unroll
            for (int dm = 0; dm < 2; ++dm) {
                const LDSP unsigned char* vp = lds + LA_VT + tl * 4608 + (32 * dm + r) * 72 + (16 * s2 + 4 * hh) * 2;
                const u32x2 v0 = *(const LDSP u32x2*)vp, v1 = *(const LDSP u32x2*)(vp + 16);
                const bf16x8 vf = __builtin_bit_cast(bf16x8, mk4u(v0.x, v0.y, v1.x, v1.y));
                if (dm == 0) o0 = __builtin_amdgcn_mfma_f32_32x32x16_bf16(vf, pf, o0, 0, 0, 0); else o1 = __builtin_amdgcn_mfma_f32_32x32x16_bf16(vf, pf, o1, 0, 0, 0);
            }
        }
    }
    {
        const float inv = 1.f / l;
        unsigned char* dst = p.ws + OFF_MIX + (size_t)(b * T + qpos) * D + 1024 + hq * 64;
#pragma unroll
        for (int gq = 0; gq < 4; ++gq) {
            *(unsigned*)(dst + 8 * gq + 4 * hh) = pk4_fp8(o0[4 * gq] * inv, o0[4 * gq + 1] * inv, o0[4 * gq + 2] * inv, o0[4 * gq + 3] * inv);
            *(unsigned*)(dst + 32 + 8 * gq + 4 * hh) = pk4_fp8(o1[4 * gq] * inv, o1[4 * gq + 1] * inv, o1[4 * gq + 2] * inv, o1[4 * gq + 3] * inv);
        }
    }
    __syncthreads();
}

__device__ __forceinline__ void phaseR2(LDSP unsigned char* lds, const Params& p) {
    {
        pg8::Epi<FLORA> epi{FLORA{p.decay_bias, p.iclr_bias, (bf16_t*)(p.ws + OFF_LWG), (bf16_t*)(p.ws + OFF_AIG)}};
        LoraSched S{(const char*)(p.ws + OFF_TW), (const char*)(p.ws + OFF_WTDU), (const char*)(p.ws + OFF_XA), (const char*)(p.ws + OFF_WTIU), (int)gridDim.x, (int)blockIdx.x};
        pg8::gemm_phase<false>(lds, opaque_s(128), S, epi);
    }
    {
        pg8::Epi<FGG> epi{FGG{(bf16_t*)(p.ws + OFF_GG)}};
        pg8::DenseSched S{(const char*)(p.ws + OFF_SG), (const char*)(p.ws + OFF_WTGU), NX / 256, 1024 / 256, 256, (int)gridDim.x, (int)(gridDim.x - 1 - blockIdx.x)};
        pg8::gemm_phase<false>(lds, opaque_s(256), S, epi);
    }
}

constexpr int G_RT = 0, G_VT = 8192, G_X0 = 16384, G_AT = 32768, G_BT = 40960, G_KT = 49152, G_P0 = 57344, G_PT0 = 65536, G_SEG = 73728, G_GL = 74752, G_CNT = 75008, G_BYTES = 79872;
static_assert(2 * G_BYTES <= SMEM_BYTES - 16, "two R3 groups fit the LDS");

__device__ __forceinline__ void gbar(LDSP unsigned* cnt, unsigned& target, int lane) {
    target += 4u;
    asm volatile("s_waitcnt lgkmcnt(0)" ::: "memory");
    if (lane == 0) {
        __hip_atomic_fetch_add(cnt, 1u, __ATOMIC_RELAXED, __HIP_MEMORY_SCOPE_WORKGROUP);
        while (__hip_atomic_load(cnt, __ATOMIC_RELAXED, __HIP_MEMORY_SCOPE_WORKGROUP) < target) __builtin_amdgcn_s_sleep(1);
    }
    asm volatile("" ::: "memory");
}
__device__ __forceinline__ void mask_lt(f32x16& c, int x0, int y, int hh, bool incl) {
#pragma unroll
    for (int g = 0; g < 16; ++g) { const int x = x0 + crow(g, hh); c[g] = (incl ? (x <= y) : (x < y)) ? c[g] : 0.f; }
}

__device__ __forceinline__ void ldf(const unsigned (&FO)[4], unsigned off, bf16x8 (&f)[4]) {
#pragma unroll
    for (int s = 0; s < 4; ++s) f[s] = *LDS_AT(const bf16x8, FO[s] + off);
}
__device__ __forceinline__ void stt(const unsigned (&SO)[4], unsigned off, int xh, const f32x16& acc) {
#pragma unroll
    for (int gq = 0; gq < 4; ++gq) *LDS_AT(u32x2, (SO[gq] ^ ((unsigned)xh << 6)) + off) = mk2u(pk2(acc[4 * gq], acc[4 * gq + 1]), pk2(acc[4 * gq + 2], acc[4 * gq + 3]));
}
__device__ __forceinline__ u32x2 ld8(const unsigned (&SO)[4], int gq, unsigned off, int xh) { return *LDS_AT(const u32x2, (SO[gq] ^ ((unsigned)xh << 6)) + off); }

__device__ __forceinline__ void pack_op(const f32x16& t, bf16x8 (&o)[2]) {
#pragma unroll
    for (int s2 = 0; s2 < 2; ++s2) o[s2] = __builtin_bit_cast(bf16x8, mk4u(pk2(t[8 * s2], t[8 * s2 + 1]), pk2(t[8 * s2 + 2], t[8 * s2 + 3]), pk2(t[8 * s2 + 4], t[8 * s2 + 5]), pk2(t[8 * s2 + 6], t[8 * s2 + 7])));
}
__device__ __forceinline__ void rwkv_prep_group(LDSP unsigned char* lg, LDSP unsigned* cnt, unsigned& bt, const Params& p, int unit, int wg_in, int lane_in, const unsigned (&FO)[4], const unsigned (&SO)[4]) {
    int seq, c, h, d;
    if (unit < 4096) { seq = unit >> 11; c = (unit >> 5) & 63; h = (unit >> 1) & 15; d = unit & 1; } else { const int u = unit - 4096; seq = 2 + (u >> 7); c = (u >> 5) & 3; h = (u >> 1) & 15; d = u & 1; }
    const bool isx = seq < 2;
    const int b = seq & 1;
    const int s0 = isx ? b * T : NX + b * CL, t0 = c * 64;
    const int chunk_id = isx ? 4 + c : c;
    u32x4 keep_bh[2], keep_kh[2];
#define STAGE_IDS const int lane = opaque(lane_in), wg = opaque(wg_in), r = lane & 31, hh = lane >> 5; (void)r; (void)hh; (void)wg;
    {
        STAGE_IDS
        const int k = lane, seg = wg, hk = h * 64 + k;
        const float kac = p.k_a[hk];
        const bf16_t* RS = (const bf16_t*)(p.ws + OFF_RS); const bf16_t* KS = (const bf16_t*)(p.ws + OFF_KS); const bf16_t* KKp = (const bf16_t*)(p.ws + OFF_KK); const bf16_t* VS = (const bf16_t*)(p.ws + OFF_VS);
        const bf16_t* LWG = (const bf16_t*)(p.ws + OFF_LWG); const bf16_t* AIG = (const bf16_t*)(p.ws + OFF_AIG);
        const int ibase = seg * 16;
        const int rowA = (s0 + t0) + (d ? 63 - ibase : ibase);
        const int sgn = d ? -1 : 1;
        const unsigned o1 = ((unsigned)rowA * 1024u + (unsigned)hk) * 2u, o2 = ((unsigned)rowA * 2048u + (unsigned)(d * 1024 + hk)) * 2u;
        const int st1 = sgn * 2048, st2 = sgn * 4096;
#define LD16(base, off) bf2f(*(const bf16_t*)((const char*)(base) + (unsigned)(off)))
        float lw[16];
        float run = 0.f;
#pragma unroll
        for (int tt = 0; tt < 16; ++tt) { run += LD16(LWG, o2 + tt * st2); lw[tt] = run; }
        LDSP float* SEG = (LDSP float*)(lg + G_SEG);
        SEG[seg * 64 + k] = run;
        gbar(cnt, bt, lane);
        float off = 0.f, gL = 0.f;
#pragma unroll
        for (int s = 0; s < 4; ++s) { const float sv = SEG[s * 64 + k]; if (s < seg) off += sv; gL += sv; }
        if (seg == 0) ((LDSP float*)(lg + G_GL))[k] = gL;
        const float egL = __expf(gL);
#pragma unroll
        for (int q = 0; q < 2; ++q) {
            float rr[8], kr[8], kk[8], vv[8], ai[8];
#pragma unroll
            for (int e = 0; e < 8; ++e) { const int tt = 8 * q + e;
                rr[e] = LD16(RS, o1 + tt * st1); kr[e] = LD16(KS, o1 + tt * st1); kk[e] = LD16(KKp, o1 + tt * st1); vv[e] = LD16(VS, o1 + tt * st1); ai[e] = LD16(AIG, o2 + tt * st2); }
            unsigned wat[4], wbh[4], wkh[4], wv[4];
#pragma unroll
            for (int t2 = 0; t2 < 4; ++t2) {
                const int i0 = ibase + 8 * q + 2 * t2;
                float fat[2], frt[2], fbt[2], fkt[2], fbh[2], fkh[2];
#pragma unroll
                for (int e2 = 0; e2 < 2; ++e2) { const int e = 2 * t2 + e2, tt = 8 * q + e;
                    const float kd = kr[e] * (1.f + (ai[e] - 1.f) * kac), bbv = kk[e] * ai[e];
                    const float g = off + lw[tt], ge = (tt == 0) ? off : off + lw[tt - 1];
                    const float eg = __expf(g), ege = __expf(ge), eng = __builtin_amdgcn_rcpf(eg), egl = egL * eng;
                    fat[e2] = -kk[e] * ege; frt[e2] = rr[e] * eg; fbt[e2] = bbv * eng; fkt[e2] = kd * eng; fbh[e2] = bbv * egl; fkh[e2] = kd * egl; }
                wat[t2] = pk2(fat[0], fat[1]); wbh[t2] = pk2(fbh[0], fbh[1]); wkh[t2] = pk2(fkh[0], fkh[1]); wv[t2] = pk2(vv[2 * t2], vv[2 * t2 + 1]);
                const unsigned wr = pk2(frt[0], frt[1]), wb = pk2(fbt[0], fbt[1]), wk = pk2(fkt[0], fkt[1]);
                *(LDSP bf16_t*)(lg + G_AT + sw64(i0, k)) = (bf16_t)(wat[t2] & 0xffffu); *(LDSP bf16_t*)(lg + G_AT + sw64(i0 + 1, k)) = (bf16_t)(wat[t2] >> 16);
                *(LDSP bf16_t*)(lg + G_RT + sw64(i0, k)) = (bf16_t)(wr & 0xffffu);      *(LDSP bf16_t*)(lg + G_RT + sw64(i0 + 1, k)) = (bf16_t)(wr >> 16);
                *(LDSP bf16_t*)(lg + G_BT + sw64(i0, k)) = (bf16_t)(wb & 0xffffu);      *(LDSP bf16_t*)(lg + G_BT + sw64(i0 + 1, k)) = (bf16_t)(wb >> 16);
                *(LDSP bf16_t*)(lg + G_KT + sw64(i0, k)) = (bf16_t)(wk & 0xffffu);      *(LDSP bf16_t*)(lg + G_KT + sw64(i0 + 1, k)) = (bf16_t)(wk >> 16);
            }
            *(LDSP u32x4*)(lg + G_X0 + sw64(k, ibase + 8 * q)) = mk4u(wat[0], wat[1], wat[2], wat[3]);
            *(LDSP u32x4*)(lg + G_VT + sw64(k, ibase + 8 * q)) = mk4u(wv[0], wv[1], wv[2], wv[3]);
            keep_bh[q] = mk4u(wbh[0], wbh[1], wbh[2], wbh[3]); keep_kh[q] = mk4u(wkh[0], wkh[1], wkh[2], wkh[3]);
            __builtin_amdgcn_sched_barrier(0);
        }
#undef LD16
    }
    gbar(cnt, bt, lane_in);
    {
        STAGE_IDS
        const int cb = wg;
        bf16x8 PT00[2], PT01[2], PT11[2], Z00[2], Z10[2], Z11[2];
        f32x16 X0 = zero16(), X1 = zero16();
        {
            bf16x8 fA0[4], fA1[4];
            ldf(FO, G_AT, fA0); ldf(FO, G_AT + 4096, fA1);
            if (cb >= 2) {
                const int vb = cb - 2;
                bf16x8 fK[4];
                ldf(FO, G_KT, fK);
#pragma unroll
                for (int q = 0; q < 3; ++q) {
                    const int jb = (q == 2) ? 1 : 0, ib = (q == 0) ? 0 : 1;
                    if (q == 2) { __builtin_amdgcn_sched_barrier(0); ldf(FO, G_KT + 4096, fK); }
                    f32x16 t = zero16();
#pragma unroll
                    for (int s4 = 0; s4 < 4; ++s4) t = __builtin_amdgcn_mfma_f32_32x32x16_bf16(fK[s4], ib ? fA1[s4] : fA0[s4], t, 0, 0, 0);
                    if (jb == ib) mask_lt(t, 0, r, hh, false);
                    bf16x8 af[2]; pack_op(t, af);
#pragma unroll
                    for (int s2 = 0; s2 < 2; ++s2) {
                        const u32x2 v0 = ld8(SO, 2 * s2, G_VT + 4096 * vb, jb), v1 = ld8(SO, 2 * s2 + 1, G_VT + 4096 * vb, jb);
                        const bf16x8 bv = __builtin_bit_cast(bf16x8, mk4u(v0.x, v0.y, v1.x, v1.y));
                        if (ib) X1 = __builtin_amdgcn_mfma_f32_32x32x16_bf16(af[s2], bv, X1, 0, 0, 0); else X0 = __builtin_amdgcn_mfma_f32_32x32x16_bf16(af[s2], bv, X0, 0, 0, 0);
                    }
                }
            } else {
#pragma unroll
                for (int gq = 0; gq < 4; ++gq) { const u32x2 w0 = ld8(SO, gq, G_X0 + 4096 * cb, 0), w1 = ld8(SO, gq, G_X0 + 4096 * cb, 1);
                    X0[4 * gq] = bf2f(w0.x & 0xffff); X0[4 * gq + 1] = bf2f(w0.x >> 16); X0[4 * gq + 2] = bf2f(w0.y & 0xffff); X0[4 * gq + 3] = bf2f(w0.y >> 16);
                    X1[4 * gq] = bf2f(w1.x & 0xffff); X1[4 * gq + 1] = bf2f(w1.x >> 16); X1[4 * gq + 2] = bf2f(w1.y & 0xffff); X1[4 * gq + 3] = bf2f(w1.y >> 16); }
            }
            __builtin_amdgcn_sched_barrier(0);
            {
                bf16x8 fB[4];
                ldf(FO, G_BT, fB);
                f32x16 c1 = zero16(), c2 = zero16();
#pragma unroll
                for (int t = 0; t < 4; ++t) { c1 = __builtin_amdgcn_mfma_f32_32x32x16_bf16(fB[t], fA0[t], c1, 0, 0, 0); c2 = __builtin_amdgcn_mfma_f32_32x32x16_bf16(fA0[t], fB[t], c2, 0, 0, 0); }
                mask_lt(c1, 0, r, hh, false);
#pragma unroll
                for (int g = 0; g < 16; ++g) c2[g] = (r < crow(g, hh)) ? c2[g] : 0.f;
                pack_op(c1, PT00); pack_op(c2, Z00);
                c1 = zero16(); c2 = zero16();
#pragma unroll
                for (int t = 0; t < 4; ++t) { c1 = __builtin_amdgcn_mfma_f32_32x32x16_bf16(fB[t], fA1[t], c1, 0, 0, 0); c2 = __builtin_amdgcn_mfma_f32_32x32x16_bf16(fA1[t], fB[t], c2, 0, 0, 0); }
                pack_op(c1, PT01); pack_op(c2, Z10);
                __builtin_amdgcn_sched_barrier(0);
                ldf(FO, G_BT + 4096, fB);
                c1 = zero16(); c2 = zero16();
#pragma unroll
                for (int t = 0; t < 4; ++t) { c1 = __builtin_amdgcn_mfma_f32_32x32x16_bf16(fB[t], fA1[t], c1, 0, 0, 0); c2 = __builtin_amdgcn_mfma_f32_32x32x16_bf16(fA1[t], fB[t], c2, 0, 0, 0); }
                mask_lt(c1, 0, r, hh, false);
#pragma unroll
                for (int g = 0; g < 16; ++g) c2[g] = (r < crow(g, hh)) ? c2[g] : 0.f;
                pack_op(c1, PT11); pack_op(c2, Z11);
            }
        }
        __builtin_amdgcn_sched_barrier(0);
#pragma unroll 1
        for (int s = 0; s < 6; ++s) {
            bf16x8 x0[2], x1[2]; pack_op(X0, x0); pack_op(X1, x1);
#pragma unroll
            for (int s2 = 0; s2 < 2; ++s2) { X0 = __builtin_amdgcn_mfma_f32_32x32x16_bf16(PT00[s2], x0[s2], X0, 0, 0, 0); X1 = __builtin_amdgcn_mfma_f32_32x32x16_bf16(PT01[s2], x0[s2], X1, 0, 0, 0); }
#pragma unroll
            for (int s2 = 0; s2 < 2; ++s2) X1 = __builtin_amdgcn_mfma_f32_32x32x16_bf16(PT11[s2], x1[s2], X1, 0, 0, 0);
            if (s < 5) {
                bf16x8 nPT00[2], nPT11[2], nPT01[2];
                {
                    f32x16 n0 = zero16(), n1 = zero16(), n2 = zero16();
#pragma unroll
                    for (int s2 = 0; s2 < 2; ++s2) {
                        n0 = __builtin_amdgcn_mfma_f32_32x32x16_bf16(Z00[s2], PT00[s2], n0, 0, 0, 0);
                        n1 = __builtin_amdgcn_mfma_f32_32x32x16_bf16(Z11[s2], PT11[s2], n1, 0, 0, 0);
                        n2 = __builtin_amdgcn_mfma_f32_32x32x16_bf16(Z00[s2], PT01[s2], n2, 0, 0, 0);
                    }
#pragma unroll
                    for (int s2 = 0; s2 < 2; ++s2) n2 = __builtin_amdgcn_mfma_f32_32x32x16_bf16(Z10[s2], PT11[s2], n2, 0, 0, 0);
                    pack_op(n0, nPT00); pack_op(n1, nPT11); pack_op(n2, nPT01);
                }
                __builtin_amdgcn_sched_barrier(0);
                {
                    f32x16 n3 = zero16(), n4 = zero16(), n5 = zero16();
#pragma unroll
                    for (int s2 = 0; s2 < 2; ++s2) {
                        n3 = __builtin_amdgcn_mfma_f32_32x32x16_bf16(PT00[s2], Z00[s2], n3, 0, 0, 0);
                        n4 = __builtin_amdgcn_mfma_f32_32x32x16_bf16(PT11[s2], Z11[s2], n4, 0, 0, 0);
                        n5 = __builtin_amdgcn_mfma_f32_32x32x16_bf16(PT01[s2], Z00[s2], n5, 0, 0, 0);
                    }
#pragma unroll
                    for (int s2 = 0; s2 < 2; ++s2) n5 = __builtin_amdgcn_mfma_f32_32x32x16_bf16(PT11[s2], Z10[s2], n5, 0, 0, 0);
                    pack_op(n3, Z00); pack_op(n4, Z11); pack_op(n5, Z10);
                }
#pragma unroll
                for (int s2 = 0; s2 < 2; ++s2) { PT00[s2] = nPT00[s2]; PT11[s2] = nPT11[s2]; PT01[s2] = nPT01[s2]; }
            }
        }
        stt(SO, G_X0 + 4096 * cb, 0, X0); stt(SO, G_X0 + 4096 * cb, 1, X1);
    }
    {
        STAGE_IDS
        const int jb = wg >> 1, ib = wg & 1;
        f32x16 c1 = zero16(), c2 = zero16();
        if (jb <= ib) {
            bf16x8 fR[4], fB[4], fK[4]; ldf(FO, G_RT + 4096 * ib, fR); ldf(FO, G_BT + 4096 * jb, fB); ldf(FO, G_KT + 4096 * jb, fK);
#pragma unroll
            for (int t = 0; t < 4; ++t) { c1 = __builtin_amdgcn_mfma_f32_32x32x16_bf16(fB[t], fR[t], c1, 0, 0, 0); c2 = __builtin_amdgcn_mfma_f32_32x32x16_bf16(fK[t], fR[t], c2, 0, 0, 0); }
            if (jb == ib) { mask_lt(c1, 32 * jb, 32 * ib + r, hh, true); mask_lt(c2, 32 * jb, 32 * ib + r, hh, true); }
        }
        stt(SO, G_P0 + 4096 * ib, jb, c1); stt(SO, G_PT0 + 4096 * ib, jb, c2);
    }
    gbar(cnt, bt, lane_in);
    {
        STAGE_IDS
#pragma unroll
        for (int q = 0; q < 2; ++q) { *(LDSP u32x4*)(lg + G_BT + sw64(lane, wg * 16 + 8 * q)) = keep_bh[q]; *(LDSP u32x4*)(lg + G_KT + sw64(lane, wg * 16 + 8 * q)) = keep_kh[q]; }
    }
    gbar(cnt, bt, lane_in);
    {
        STAGE_IDS
        const int mi = wg;
        const int L_BH = G_BT, L_KH = G_KT, L_RB = G_P0, L_RK = G_PT0;
        const size_t inst = (size_t)inst_index(b, h, d, chunk_id) * 4096;
        bf16_t* dst = (bf16_t*)(p.ws + (mi == 0 ? OFF_CM : mi == 1 ? OFF_CN : mi == 2 ? OFF_CP : OFF_CQ)) + inst;
        if (isx || mi < 2) {
            const int Ax = (mi == 1) ? L_BH : G_X0, Ax0 = (mi == 3) ? 64 : 0;
            const int By = (mi == 0) ? L_BH : (mi == 1) ? G_X0 : L_RB, By0 = (mi == 1) ? 64 : 0;
            const int A2 = (mi == 1) ? L_KH : G_VT, B2 = (mi == 1) ? G_VT : L_RK;
#pragma unroll 1
            for (int half = 0; half < 2; ++half) {
                bf16x8 a0[4], a1[4], b1[4];
                ldf(FO, Ax + 128 * Ax0, a0); ldf(FO, Ax + 128 * (Ax0 + 32), a1); ldf(FO, By + 128 * (By0 + 32 * half), b1);
                f32x16 c0 = zero16(), c1 = zero16();
#pragma unroll
                for (int t = 0; t < 4; ++t) { c0 = __builtin_amdgcn_mfma_f32_32x32x16_bf16(a0[t], b1[t], c0, 0, 0, 0); c1 = __builtin_amdgcn_mfma_f32_32x32x16_bf16(a1[t], b1[t], c1, 0, 0, 0); }
                if (mi & 1) {
                    ldf(FO, A2, a0); ldf(FO, A2 + 4096, a1); ldf(FO, B2 + 4096 * half, b1);
#pragma unroll
                    for (int t = 0; t < 4; ++t) { c0 = __builtin_amdgcn_mfma_f32_32x32x16_bf16(a0[t], b1[t], c0, 0, 0, 0); c1 = __builtin_amdgcn_mfma_f32_32x32x16_bf16(a1[t], b1[t], c1, 0, 0, 0); }
                }
                const int y = 32 * half + r;
                const float dg = (mi == 0) ? __expf(((const LDSP float*)(lg + G_GL))[y]) : 0.f;
#pragma unroll
                for (int xb = 0; xb < 2; ++xb) {
#pragma unroll
                    for (int gq = 0; gq < 4; ++gq) {
                        const int x0 = 32 * xb + 8 * gq + 4 * hh;
                        float v0 = xb ? c1[4 * gq] : c0[4 * gq], v1 = xb ? c1[4 * gq + 1] : c0[4 * gq + 1], v2 = xb ? c1[4 * gq + 2] : c0[4 * gq + 2], v3 = xb ? c1[4 * gq + 3] : c0[4 * gq + 3];
                        if (mi == 0) { if (x0 == y) v0 += dg; if (x0 + 1 == y) v1 += dg; if (x0 + 2 == y) v2 += dg; if (x0 + 3 == y) v3 += dg; }
                        if (mi == 2) { const u32x2 w = ld8(SO, gq, G_RT + 4096 * half, xb); v0 += bf2f(w.x & 0xffff); v1 += bf2f(w.x >> 16); v2 += bf2f(w.y & 0xffff); v3 += bf2f(w.y >> 16); }
                        *(u32x2*)(dst + ((half * 4 + 2 * xb + (gq >> 1)) * 64 + hh * 32 + r) * 8 + 4 * (gq & 1)) = mk2u(pk2(v0, v1), pk2(v2, v3));
                    }
                }
            }
        }
    }
    gbar(cnt, bt, lane_in);
#undef STAGE_IDS
}

__device__ __forceinline__ void conv_group_load(const float* src, int N, int k0, int n0, int tg, f32x4 (&v)[8][2]) {
    const int kr = tg >> 3, nc = (tg & 7) * 8;
#pragma unroll
    for (int s = 0; s < 8; ++s) { const float* q = src + (size_t)(k0 + s * 32 + kr) * N + n0 + nc; v[s][0] = *(const f32x4*)q; v[s][1] = *(const f32x4*)(q + 4); }
}
__device__ __forceinline__ void conv_group_finish(LDSP unsigned char* lg, LDSP unsigned* cnt, unsigned& bt, bf16_t* dst, int ld, int mode, int k0, int n0, const f32x4 (&v)[8][2], int tg, int lane) {
    LDSP float* Tm = (LDSP float*)lg;
    {
        const int kr = tg >> 3, nc = (tg & 7) * 8;
#pragma unroll
        for (int s = 0; s < 8; ++s) { LDSP float* q = Tm + (s * 32 + kr) * 65 + nc;
            q[0] = v[s][0].x; q[1] = v[s][0].y; q[2] = v[s][0].z; q[3] = v[s][0].w; q[4] = v[s][1].x; q[5] = v[s][1].y; q[6] = v[s][1].z; q[7] = v[s][1].w; }
    }
    gbar(cnt, bt, lane);
    {
        const int n = tg >> 2; unsigned char* drow = (unsigned char*)dst + (size_t)conv_row(n0 + n, mode & 3) * ld;
        if (mode & 4) {
            const float sc = (mode & 3) ? W1_SCALE : W2_SCALE;
#pragma unroll
            for (int s = 0; s < 4; ++s) { const int kc = ((tg & 3) + 4 * s) * 16; float f[16];
#pragma unroll
                for (int j = 0; j < 16; ++j) f[j] = Tm[(kc + j) * 65 + n] * sc;
                *(u32x4*)(drow + k0 + kc) = mk4u(pk4_fp8(f[0], f[1], f[2], f[3]), pk4_fp8(f[4], f[5], f[6], f[7]), pk4_fp8(f[8], f[9], f[10], f[11]), pk4_fp8(f[12], f[13], f[14], f[15])); }
        } else {
#pragma unroll
            for (int s = 0; s < 8; ++s) { const int kc = ((tg & 3) + 4 * s) * 8; float f[8];
#pragma unroll
                for (int j = 0; j < 8; ++j) f[j] = Tm[(kc + j) * 65 + n];
                *(u32x4*)(drow + 2 * (k0 + kc)) = mk4u(pk2(f[0], f[1]), pk2(f[2], f[3]), pk2(f[4], f[5]), pk2(f[6], f[7])); }
        }
    }
    gbar(cnt, bt, lane);
}
__device__ __forceinline__ void conv_group_range(LDSP unsigned char* lg, LDSP unsigned* cnt, unsigned& bt, const Params& p, int g0, int g1, int tg, int lane) {
    int g = g0 + blockIdx.x;
    const float* csrc = nullptr; bf16_t* cdst = nullptr; int cN = 0, cld = 0, cmode = 0, ck0 = 0, cn0 = 0;
    const float* nsrc = nullptr; bf16_t* ndst = nullptr; int nN = 0, nld = 0, nmode = 0, nk0 = 0, nn0 = 0;
    f32x4 va[8][2], vb[8][2];
    if (g < g1) { conv_decode(p, g, csrc, cdst, cN, cld, cmode, ck0, cn0); conv_group_load(csrc, cN, ck0, cn0, tg, va); }
    __builtin_amdgcn_s_waitcnt(0);
#pragma unroll 1
    while (g < g1) {
        const int gn = g + gridDim.x;
        if (gn < g1) { conv_decode(p, gn, nsrc, ndst, nN, nld, nmode, nk0, nn0); conv_group_load(nsrc, nN, nk0, nn0, tg, vb); }
        conv_group_finish(lg, cnt, bt, cdst, cld, cmode, ck0, cn0, va, tg, lane);
        cdst = ndst; cld = nld; cmode = nmode; ck0 = nk0; cn0 = nn0; g = gn;
#pragma unroll
        for (int s = 0; s < 8; ++s) { va[s][0] = vb[s][0]; va[s][1] = vb[s][1]; }
    }
}

__device__ __forceinline__ void phaseR3(LDSP unsigned char* lds, const Params& p) {
    const int tid = TIDX(), wid = tid >> 6, lane = tid & 63, gp = wid >> 2, wg = wid & 3;
    LDSP unsigned char* lg = lds + gp * G_BYTES;
    LDSP unsigned* cnt = (LDSP unsigned*)(lg + G_CNT);
    LDSP unsigned* uq = (LDSP unsigned*)(lds + SMEM_BYTES - 48);
    LDSP unsigned* pick = (LDSP unsigned*)(lg + G_CNT + 8);
    if ((tid & 255) == 0) *cnt = 0u;
    if (tid == 0) *uq = 0u;
    __syncthreads();
    unsigned bt = 0u;
    if (!(p.flags & 1) && gp == 1) conv_group_range(lg, cnt, bt, p, p2_conv_end((int)gridDim.x), CT8, tid & 255, lane);
    unsigned FO[4], SO[4];
    { const unsigned base = LDS_ADDR(lg), r = lane & 31, hh = lane >> 5;
#pragma unroll
      for (int q = 0; q < 4; ++q) { FO[q] = base + r * 128u + ((((2u * q + hh) ^ (r >> 1)) & 7u) << 4); SO[q] = base + r * 128u + ((((unsigned)q ^ (r >> 1)) & 7u) << 4) + 8u * hh; } }
    for (;;) {
        if ((tid & 255) == 0) *pick = __hip_atomic_fetch_add(uq, 1u, __ATOMIC_RELAXED, __HIP_MEMORY_SCOPE_WORKGROUP);
        gbar(cnt, bt, lane);
        const int u = blockIdx.x + (int)(*pick) * gridDim.x;
        gbar(cnt, bt, lane);
        if ((p.flags & 2) || u >= 4096 + 256) break;
        rwkv_prep_group(lg, cnt, bt, p, u, wg, lane, FO, SO);
    }
    __syncthreads();
}

constexpr size_t OFF_HT = OFF_YD;
__device__ __forceinline__ void scan_wave(const Params& p, int item, int lane) {
    const int chain = item >> 1, vb = item & 1, b = chain >> 5, h = (chain >> 1) & 15, d = chain & 1;
    const bf16_t* CM = (const bf16_t*)(p.ws + OFF_CM); const bf16_t* CN = (const bf16_t*)(p.ws + OFF_CN); bf16_t* HT = (bf16_t*)(p.ws + OFF_HT);
    u32x4 na[2][4], nn[2][2];
    auto chunk_of = [&](int step) { return (step < 4) ? (d ? 3 - step : step) : (d ? 4 + (67 - step) : step); };
    auto prefetch = [&](int step) {
        const size_t inst = (size_t)inst_index(b, h, d, chunk_of(step)) * 4096;
#pragma unroll
        for (int rt = 0; rt < 2; ++rt) {
#pragma unroll
            for (int s = 0; s < 4; ++s) na[rt][s] = *(const u32x4*)(CM + inst + ((rt * 4 + s) * 64 + lane) * 8);
#pragma unroll
            for (int g2 = 0; g2 < 2; ++g2) nn[rt][g2] = *(const u32x4*)(CN + inst + (((vb * 2 + rt) * 2 + g2) * 64 + lane) * 8);
        }
    };
    f32x16 hacc[2]; hacc[0] = zero16(); hacc[1] = zero16();
    prefetch(0);
#pragma unroll 1
    for (int step = 0; step < NCHUNK; ++step) {
        const int chunk_id = chunk_of(step);
        u32x4 a[2][4], n[2][2];
#pragma unroll
        for (int rt = 0; rt < 2; ++rt) {
#pragma unroll
            for (int s = 0; s < 4; ++s) a[rt][s] = na[rt][s];
            n[rt][0] = nn[rt][0]; n[rt][1] = nn[rt][1];
        }
        if (step + 1 < NCHUNK) prefetch(step + 1);
        bf16x8 bfr[4];
#pragma unroll
        for (int s = 0; s < 4; ++s) { const f32x16& t = hacc[s >> 1]; const int o = 8 * (s & 1);
            bfr[s] = __builtin_bit_cast(bf16x8, mk4u(pk2(t[o], t[o + 1]), pk2(t[o + 2], t[o + 3]), pk2(t[o + 4], t[o + 5]), pk2(t[o + 6], t[o + 7]))); }
        if (chunk_id >= 4) {
            bf16_t* hp = HT + (size_t)inst_index(b, h, d, chunk_id) * 4096 + (vb * 4 * 64 + lane) * 8;
#pragma unroll
            for (int s = 0; s < 4; ++s) *(bf16x8*)(hp + s * 512) = bfr[s];
        }
#pragma unroll
        for (int rt = 0; rt < 2; ++rt) {
            f32x16 acc;
#pragma unroll
            for (int g2 = 0; g2 < 2; ++g2) { const u32x4 w = n[rt][g2];
                acc[8 * g2] = bf2f(w.x & 0xffff); acc[8 * g2 + 1] = bf2f(w.x >> 16); acc[8 * g2 + 2] = bf2f(w.y & 0xffff); acc[8 * g2 + 3] = bf2f(w.y >> 16);
                acc[8 * g2 + 4] = bf2f(w.z & 0xffff); acc[8 * g2 + 5] = bf2f(w.z >> 16); acc[8 * g2 + 6] = bf2f(w.w & 0xffff); acc[8 * g2 + 7] = bf2f(w.w >> 16); }
#pragma unroll
            for (int s = 0; s < 4; ++s) acc = __builtin_amdgcn_mfma_f32_32x32x16_bf16(__builtin_bit_cast(bf16x8, a[rt][s]), bfr[s], acc, 0, 0, 0);
            hacc[rt] = acc;
        }
    }
}
__device__ __forceinline__ void phaseR4(LDSP unsigned char* lds, const Params& p) {
    const int tid = TIDX(), wid = tid >> 6, lane = tid & 63;
    LDSP int* nxt = (LDSP int*)(lds + SMEM_BYTES - 32);
    unsigned* qctr = (unsigned*)(p.ws + OFF_CTL + 16384 + 512);
    if ((int)blockIdx.x < 64 && gridDim.x >= 128) { if (wid < 2) scan_wave(p, blockIdx.x * 2 + wid, lane); }
    else if (gridDim.x < 128) { if (wid == 0) for (int it = blockIdx.x; it < 128; it += gridDim.x) scan_wave(p, it, lane); }
    for (;;) {
        __syncthreads();
        if (tid == 0) *nxt = (int)atomicAdd(qctr, 1u);
        __syncthreads();
        const int u = *nxt;
        if (u >= 512) break;
        attn_unit(lds, p, u);
    }
}

__device__ __forceinline__ void phaseR5(LDSP unsigned char* lds, const Params& p) {
    const int tid = TIDX(), wid = tid >> 6, lane = tid & 63, r = lane & 31, hh = lane >> 5;
    const bf16_t* CP = (const bf16_t*)(p.ws + OFF_CP); const bf16_t* CQ = (const bf16_t*)(p.ws + OFF_CQ); const bf16_t* HT = (const bf16_t*)(p.ws + OFF_HT);
    for (int wu = blockIdx.x * 8 + wid; wu < 2 * 64 * 16 * 2; wu += gridDim.x * 8) {
        const int half = wu & 1, u = wu >> 1, b = u >> 10, c = (u >> 4) & 63, h = u & 15;
        f32x16 y0 = zero16(), y1 = zero16();
#pragma unroll
        for (int d = 0; d < 2; ++d) {
            const size_t inst = (size_t)inst_index(b, h, d, 4 + c) * 4096;
            const int ii = d ? 63 - (32 * half + r) : (32 * half + r);
            const int it = ii >> 5, lp = hh * 32 + (ii & 31);
            f32x16 a0, a1;
#pragma unroll
            for (int g2 = 0; g2 < 2; ++g2) {
                const u32x4 w0 = *(const u32x4*)(CQ + inst + (((it * 2 + 0) * 2 + g2) * 64 + lp) * 8), w1 = *(const u32x4*)(CQ + inst + (((it * 2 + 1) * 2 + g2) * 64 + lp) * 8);
                a0[8 * g2] = bf2f(w0.x & 0xffff); a0[8 * g2 + 1] = bf2f(w0.x >> 16); a0[8 * g2 + 2] = bf2f(w0.y & 0xffff); a0[8 * g2 + 3] = bf2f(w0.y >> 16);
                a0[8 * g2 + 4] = bf2f(w0.z & 0xffff); a0[8 * g2 + 5] = bf2f(w0.z >> 16); a0[8 * g2 + 6] = bf2f(w0.w & 0xffff); a0[8 * g2 + 7] = bf2f(w0.w >> 16);
                a1[8 * g2] = bf2f(w1.x & 0xffff); a1[8 * g2 + 1] = bf2f(w1.x >> 16); a1[8 * g2 + 2] = bf2f(w1.y & 0xffff); a1[8 * g2 + 3] = bf2f(w1.y >> 16);
                a1[8 * g2 + 4] = bf2f(w1.z & 0xffff); a1[8 * g2 + 5] = bf2f(w1.z >> 16); a1[8 * g2 + 6] = bf2f(w1.w & 0xffff); a1[8 * g2 + 7] = bf2f(w1.w >> 16);
            }
#pragma unroll
            for (int s = 0; s < 4; ++s) {
                const bf16x8 pf = *(const bf16x8*)(CP + inst + ((it * 4 + s) * 64 + lp) * 8);
                const bf16x8 h0 = *(const bf16x8*)(HT + inst + ((0 * 4 + s) * 64 + lane) * 8), h1 = *(const bf16x8*)(HT + inst + ((1 * 4 + s) * 64 + lane) * 8);
                a0 = __builtin_amdgcn_mfma_f32_32x32x16_bf16(h0, pf, a0, 0, 0, 0);
                a1 = __builtin_amdgcn_mfma_f32_32x32x16_bf16(h1, pf, a1, 0, 0, 0);
            }
#pragma unroll
            for (int g = 0; g < 16; ++g) { y0[g] += a0[g]; y1[g] += a1[g]; }
        }
        const int tau = 32 * half + r; const size_t row = (size_t)b * T + c * 64 + tau;
        float sm = 0.f;
#pragma unroll
        for (int g = 0; g < 16; ++g) sm += y0[g] + y1[g];
        sm += shx(sm, 32);
        const float mean = sm * (1.f / 64.f);
        float q2 = 0.f;
#pragma unroll
        for (int g = 0; g < 16; ++g) { y0[g] -= mean; y1[g] -= mean; q2 += y0[g] * y0[g] + y1[g] * y1[g]; }
        q2 += shx(q2, 32);
        const float rstd = rsqrtf(q2 * (1.f / 64.f) + 64e-5f);
        const bf16_t* rs = (const bf16_t*)(p.ws + OFF_RS) + row * 1024 + h * 64; const bf16_t* ks = (const bf16_t*)(p.ws + OFF_KS) + row * 1024 + h * 64;
        const bf16_t* ai0 = (const bf16_t*)(p.ws + OFF_AIG) + row * 2048 + h * 64; const bf16_t* ai1 = ai0 + 1024;
        const bf16_t* vs = (const bf16_t*)(p.ws + OFF_VS) + row * 1024 + h * 64; const bf16_t* gg = (const bf16_t*)(p.ws + OFF_GG) + row * 1024 + h * 64;
        float bon = 0.f;
#pragma unroll
        for (int q = 0; q < 8; ++q) {
            const int ch = 32 * (q >> 2) + 8 * (q & 3) + 4 * hh;
            const u32x2 r2 = *(const u32x2*)(rs + ch), k2 = *(const u32x2*)(ks + ch), x2 = *(const u32x2*)(ai0 + ch), z2 = *(const u32x2*)(ai1 + ch);
            const f32x4 ka = *(const f32x4*)(p.k_a + h * 64 + ch), rk = *(const f32x4*)(p.r_k + h * 64 + ch);
            const float rr[4] = {bf2f(r2.x & 0xffff), bf2f(r2.x >> 16), bf2f(r2.y & 0xffff), bf2f(r2.y >> 16)}, kk[4] = {bf2f(k2.x & 0xffff), bf2f(k2.x >> 16), bf2f(k2.y & 0xffff), bf2f(k2.y >> 16)};
            const float xa[4] = {bf2f(x2.x & 0xffff), bf2f(x2.x >> 16), bf2f(x2.y & 0xffff), bf2f(x2.y >> 16)}, za[4] = {bf2f(z2.x & 0xffff), bf2f(z2.x >> 16), bf2f(z2.y & 0xffff), bf2f(z2.y >> 16)};
#pragma unroll
            for (int e = 0; e < 4; ++e) bon += rr[e] * (kk[e] * ((1.f + (xa[e] - 1.f) * ka[e]) + (1.f + (za[e] - 1.f) * ka[e]))) * rk[e];
        }
        bon += shx(bon, 32);
        unsigned char* dst = p.ws + OFF_MIX + (size_t)row * D + h * 64;
#pragma unroll
        for (int q = 0; q < 8; ++q) {
            const int ch = 32 * (q >> 2) + 8 * (q & 3) + 4 * hh, g0 = 4 * (q & 3);
            const f32x4 lg = *(const f32x4*)(p.lnx_g + h * 64 + ch), lb = *(const f32x4*)(p.lnx_b + h * 64 + ch);
            const u32x2 v2 = *(const u32x2*)(vs + ch), g2 = *(const u32x2*)(gg + ch);
            const float vv[4] = {bf2f(v2.x & 0xffff), bf2f(v2.x >> 16), bf2f(v2.y & 0xffff), bf2f(v2.y >> 16)}, gv[4] = {bf2f(g2.x & 0xffff), bf2f(g2.x >> 16), bf2f(g2.y & 0xffff), bf2f(g2.y >> 16)};
            float o[4];
#pragma unroll
            for (int e = 0; e < 4; ++e) { const float yv = (q < 4) ? y0[g0 + e] : y1[g0 + e]; o[e] = (yv * rstd * lg[e] + lb[e] + bon * vv[e]) * gv[e]; }
            *(unsigned*)(dst + ch) = pk4_fp8(o[0], o[1], o[2], o[3]);
        }
    }
}

__device__ __forceinline__ void phase6(LDSP unsigned char* lds, const Params& p) {
    pg8::Epi<FX1> epi{FX1{p.x, (const float*)(p.ws + OFF_MOD), (float*)(p.ws + OFF_X1), 1.f / W2_SCALE}};
    pg8::DenseSched S{(const char*)(p.ws + OFF_MIX), (const char*)(p.ws + OFF_WTOUT), NX / 256, D / 256, D / 2, (int)gridDim.x, (int)blockIdx.x};
    pg8::gemm_phase<false, true, 2>(lds, D / 2, S, epi);
}

__device__ __forceinline__ void phase7(LDSP unsigned char* lds, const Params& p) {
    const int tid = TIDX(), wid = tid >> 6, lane = tid & 63;
    LDSP float* GS = (LDSP float*)lds;
    LDSP float* RSTD = (LDSP float*)(lds + 16384);
    LDSP float* PART = (LDSP float*)(lds + 16896);
    LDSP float* CB = (LDSP float*)(lds + 16896 + 65536);
    const float* MOD = (const float*)(p.ws + OFF_MOD);
    const float* X1 = (const float*)(p.ws + OFF_X1);
    unsigned char* H2 = p.ws + OFF_H2;
    LDSP unsigned* MASK = (LDSP unsigned*)(lds + 16896 + 65536 + 2048);
    LDSP unsigned char* SELE = (LDSP unsigned char*)(lds + 16896 + 65536 + 2048 + 256);
    for (int u = blockIdx.x; u < NX / 32; u += gridDim.x) {
        const float* md = MOD + (size_t)((u * 32) >> 12) * 12288;
        for (int idx = tid; idx < D / 4; idx += 512) { const f32x4 g = *(const f32x4*)(p.norm2_g + 4 * idx), sh = *(const f32x4*)(md + 3 * D + 4 * idx), sc = *(const f32x4*)(md + 4 * D + 4 * idx);
            *(LDSP f32x4*)(GS + 4 * idx) = g * (sc + 1.f); *(LDSP f32x4*)(GS + D + 4 * idx) = sh; }
        __syncthreads();
        {
            f32x4 xv[8], xn[8];
            { const float* src = X1 + (size_t)(u * 32 + 4 * wid) * D;
#pragma unroll
              for (int i = 0; i < 8; ++i) xv[i] = ((const f32x4*)src)[lane + 64 * i]; }
#pragma unroll
            for (int rr = 0; rr < 4; ++rr) {
                const int t = 4 * wid + rr, row = u * 32 + t;
                if (rr < 3) { const float* src = X1 + (size_t)(row + 1) * D;
#pragma unroll
                    for (int i = 0; i < 8; ++i) xn[i] = ((const f32x4*)src)[lane + 64 * i]; }
                float ss = 0.f;
#pragma unroll
                for (int i = 0; i < 8; ++i) ss += xv[i].x * xv[i].x + xv[i].y * xv[i].y + xv[i].z * xv[i].z + xv[i].w * xv[i].w;
                ss = wave_sum(ss); const float rs = rsqrtf(ss * (1.f / D) + 1e-6f);
                if (lane == 0) RSTD[t] = rs;
#pragma unroll
                for (int i = 0; i < 8; ++i) { const int col = 4 * (lane + 64 * i);
                    const f32x4 g = *(const LDSP f32x4*)(GS + col), sh = *(const LDSP f32x4*)(GS + D + col);
                    const f32x4 hv = xv[i] * rs * g + sh;
                    *(unsigned*)(H2 + (size_t)row * D + col) = pk4_fp8(hv.x, hv.y, hv.z, hv.w); }
#pragma unroll
                for (int i = 0; i < 8; ++i) xv[i] = xn[i];
            }
        }
        {
            const int j = lane & 31, kk = lane >> 5, k0 = wid * 256;
            unsigned xoff = (unsigned)((u * 32 + j) * D + k0 + 4 * kk) * 4u;
            unsigned woff = (unsigned)(j * D + k0 + 4 * kk) * 4u;
            unsigned goff = (unsigned)(k0 + 4 * kk) * 4u;
            const char* WRT = (const char*)(p.ws + OFF_WRT);
            f32x16 acc0 = zero16(), acc1 = zero16(); float c0 = 0.f, c1 = 0.f;
#pragma unroll 4
            for (int q = 0; q < 32; ++q) {
                const f32x4 xa = *(const f32x4*)((const char*)X1 + xoff);
                const f32x4 b0 = *(const f32x4*)(WRT + woff), b1 = *(const f32x4*)(WRT + woff + 32 * D * 4);
                const f32x4 gv = *(const LDSP f32x4*)((const LDSP char*)GS + goff), sv = *(const LDSP f32x4*)((const LDSP char*)GS + D * 4 + goff);
#pragma unroll
                for (int e = 0; e < 4; ++e) {
                    acc0 = __builtin_amdgcn_mfma_f32_32x32x2f32(xa[e], b0[e] * gv[e], acc0, 0, 0, 0);
                    acc1 = __builtin_amdgcn_mfma_f32_32x32x2f32(xa[e], b1[e] * gv[e], acc1, 0, 0, 0);
                    c0 += sv[e] * b0[e]; c1 += sv[e] * b1[e];
                }
                xoff += 32u; woff += 32u; goff += 32u;
            }
            c0 += shx(c0, 32); c1 += shx(c1, 32);
#pragma unroll
            for (int g = 0; g < 16; ++g) { const int t = crow(g, kk); PART[(wid * 32 + t) * 64 + j] = acc0[g]; PART[(wid * 32 + t) * 64 + 32 + j] = acc1[g]; }
            if (kk == 0) { CB[wid * 64 + j] = c0; CB[wid * 64 + 32 + j] = c1; }
        }
        __syncthreads();
        float cb = 0.f;
#pragma unroll
        for (int w = 0; w < 8; ++w) cb += CB[w * 64 + lane];
        const float eb = p.expert_bias[lane];
#pragma unroll 1
        for (int rr = 0; rr < 4; ++rr) {
            const int t = 4 * wid + rr, token = u * 32 + t;
            float sum = 0.f;
#pragma unroll
            for (int w = 0; w < 8; ++w) sum += PART[(w * 32 + t) * 64 + lane];
            const float logit = RSTD[t] * sum + cb;
            const float score = 1.f / (1.f + expf(-logit));
            const float v = score + eb;
            const int gi = lane >> 3;
            float m1 = v;
            m1 = fmaxf(m1, shx(m1, 1)); m1 = fmaxf(m1, shx(m1, 2)); m1 = fmaxf(m1, shx(m1, 4));
            const unsigned long long eq = __ballot(v == m1);
            const unsigned gbits = (unsigned)((eq >> (gi * 8)) & 0xffull);
            const bool first = (lane & 7) == (__ffs((int)gbits) - 1);
            float v2 = first ? -INFINITY : v;
            v2 = fmaxf(v2, shx(v2, 1)); v2 = fmaxf(v2, shx(v2, 2)); v2 = fmaxf(v2, shx(v2, 4));
            const float gs = m1 + v2;
            int gr = 0;
#pragma unroll
            for (int jj = 0; jj < 8; ++jj) { const float gj = __builtin_bit_cast(float, __builtin_amdgcn_readlane(__builtin_bit_cast(int, gs), jj * 8)); gr += (gj > gs || (gj == gs && jj < gi)) ? 1 : 0; }
            const float mv = (gr < 4) ? v : -INFINITY;
            int rk = 0;
#pragma unroll
            for (int j8 = 0; j8 < 8; ++j8) {
#pragma unroll
                for (int j1 = 0; j1 < 8; ++j1) { const int jj = 8 * j8 + j1; const float vj = __builtin_bit_cast(float, __builtin_amdgcn_readlane(__builtin_bit_cast(int, mv), jj)); rk += (vj > mv || (vj == mv && jj < lane)) ? 1 : 0; }
                __builtin_amdgcn_sched_barrier(0);
            }
            const bool sel = (rk < 8) && (gr < 4);
            const float gsum = wave_sum(sel ? score : 0.f);
            const unsigned long long smask = __ballot(sel);
            if (lane == 0) { MASK[2 * t] = (unsigned)smask; MASK[2 * t + 1] = (unsigned)(smask >> 32); }
            if (sel) {
                SELE[t * 8 + rk] = (unsigned char)lane;
                ((int*)(p.ws + OFF_EIDX))[token * 8 + rk] = lane;
                ((float*)(p.ws + OFF_GATE))[token * 8 + rk] = score / gsum * 2.5f;
            }
        }
        __syncthreads();
        if (tid < 256) {
            const int t = tid >> 3, e = SELE[tid], w = e >> 5, sh = e & 31; int lr = 0;
            for (int t2 = 0; t2 < t; ++t2) lr += (MASK[2 * t2 + w] >> sh) & 1u;
            ((int*)(p.ws + OFF_ESLOT))[(u * 32 + t) * 8 + (tid & 7)] = lr;
        } else if (tid < 320) {
            const int e = tid - 256, w = e >> 5, sh = e & 31; int tot = 0;
#pragma unroll 8
            for (int t2 = 0; t2 < 32; ++t2) tot += (MASK[2 * t2 + w] >> sh) & 1u;
            ((int*)(p.ws + OFF_CNTB))[u * 64 + e] = tot;
        }
        __syncthreads();
    }
}

__device__ __forceinline__ void phase7b(LDSP unsigned char* lds, const Params& p) {
    const int tid = TIDX(), wid = tid >> 6, lane = tid & 63;
    LDSP int* PB = (LDSP int*)lds;
    LDSP int* PT = PB + 512;
    LDSP int* BASE = PT + 512;
    const int* CNTB = (const int*)(p.ws + OFF_CNTB);
    for (int u = blockIdx.x; u < NX / 32; u += gridDim.x) {
        int before = 0, all = 0;
#pragma unroll 8
        for (int i = 0; i < 32; ++i) { const int u2 = wid * 32 + i; const int c = CNTB[u2 * 64 + lane]; all += c; before += (u2 < u) ? c : 0; }
        PB[wid * 64 + lane] = before; PT[wid * 64 + lane] = all;
        __syncthreads();
        if (wid == 0) { int b = 0, tsum = 0;
#pragma unroll
            for (int w = 0; w < 8; ++w) { b += PB[w * 64 + lane]; tsum += PT[w * 64 + lane]; }
            BASE[lane] = b;
            if (u == 0) ((int*)(p.ws + OFF_CTL + 16384))[lane] = tsum; }
        __syncthreads();
        if (tid < 256) {
            const int token = u * 32 + (tid >> 3), idx = token * 8 + (tid & 7);
            const int e = ((const int*)(p.ws + OFF_EIDX))[idx], slot = BASE[e] + ((const int*)(p.ws + OFF_ESLOT))[idx];
            ((int*)(p.ws + OFF_ESLOT))[idx] = slot;
            ((int*)(p.ws + OFF_TOKL))[(size_t)e * NX + slot] = token;
        }
        __syncthreads();
    }
}

constexpr int LE_TAB = 131072;
__device__ __forceinline__ void build_expert_tables(LDSP unsigned char* lds, const Params& p) {
    LDSP int* TP = (LDSP int*)(lds + LE_TAB); LDSP int* ST = TP + 72; LDSP int* CN = ST + 72;
    const int tid = TIDX();
    if (tid < NEX) CN[tid] = (tid < NE) ? ((const int*)(p.ws + OFF_CTL + 16384))[tid] : NX;
    __syncthreads();
    if (tid == 0) {
        int tp = 0, st = 0;
        for (int e = 0; e < NEX; ++e) { const int cn = CN[e]; TP[e] = tp; ST[e] = st; tp += (cn + 255) >> 8; st += cn; }
        TP[NEX] = tp; ST[NEX] = st;
    }
    __syncthreads();
}

struct GroupSched {
    const LDSP int* TP; const LDSP int* ST; const LDSP int* CN;
    const char* A; const char* B; const int* tokl; int ntn, K, G, c; size_t bstride; bool gather; int bn;
    __device__ __forceinline__ bool next(int i, pg8::Unit& u) const {
        const int total = __builtin_amdgcn_readfirstlane(TP[NEX]) * ntn; const long L = (long)i * G + c; if (L >= total) return false;
        const int w = pg8::xcd_remap((int)L, total);
        const int nt = w % ntn, mtg = w / ntn;
        int e = u.e;
        if (__builtin_amdgcn_readfirstlane(TP[e]) > mtg) e = 0;
        while (__builtin_amdgcn_readfirstlane(TP[e + 1]) <= mtg) ++e;
        const int tpe = __builtin_amdgcn_readfirstlane(TP[e]), ste = __builtin_amdgcn_readfirstlane(ST[e]), cne = __builtin_amdgcn_readfirstlane(CN[e]);
        const int mt = mtg - tpe;
        u.B = B + (size_t)e * bstride + (size_t)nt * bn * K * 2;
        u.nvalid = cne; u.m0 = mt * 256; u.pos0 = ste; u.row0 = 0; u.col0 = nt * bn; u.e = e;
        if (gather) { u.A = A; u.rowmap = (e < NE) ? tokl + (size_t)e * NX : nullptr; }
        else { u.A = A + (size_t)(ste + mt * 256) * K * 2; u.rowmap = nullptr; }
        return true;
    }
};
#ifndef P8MODE
#define P8MODE 2
#endif
#ifndef P9MODE
#define P9MODE 2
#endif
__device__ __forceinline__ void phase8(LDSP unsigned char* lds, const Params& p) {
    build_expert_tables(lds, p);
    const LDSP int* TP = (const LDSP int*)(lds + LE_TAB);
    pg8::Epi<FH1, P8MODE> epi{FH1{p.ws + OFF_H1}};
    GroupSched S{TP, TP + 72, TP + 144, (const char*)(p.ws + OFF_H2), (const char*)(p.ws + OFF_WTE1), (const int*)(p.ws + OFF_TOKL), 8 / P8MODE, D / 2, (int)gridDim.x, (int)blockIdx.x,
                 (size_t)1024 * 2048, true, 128 * P8MODE};
    pg8::gemm_phase<true, true, P8MODE>(lds, D / 2, S, epi);
}
__device__ __forceinline__ void phase9(LDSP unsigned char* lds, const Params& p) {
    build_expert_tables(lds, p);
    const LDSP int* TP = (const LDSP int*)(lds + LE_TAB);
    pg8::Epi<FEO, P9MODE> epi{FEO{p.ws + OFF_EO}};
    GroupSched S{TP, TP + 72, TP + 144, (const char*)(p.ws + OFF_H1), (const char*)(p.ws + OFF_WTE2), nullptr, 16 / P9MODE, EFF / 2, (int)gridDim.x, (int)blockIdx.x,
                 (size_t)2048 * 512, false, 128 * P9MODE};
    pg8::gemm_phase<false, false, P9MODE>(lds, EFF / 2, S, epi);
}
typedef float f32x2v __attribute__((ext_vector_type(2)));
__device__ __forceinline__ void phase10(LDSP unsigned char* lds, const Params& p) {
    build_expert_tables(lds, p);
    const LDSP int* ST = (const LDSP int*)(lds + LE_TAB) + 72;
    const int tid = TIDX(), wid = tid >> 6, lane = tid & 63;
    const float* MOD = (const float*)(p.ws + OFF_MOD);
    const float* X1 = (const float*)(p.ws + OFF_X1);
    const unsigned char* EO = p.ws + OFF_EO;
    for (int row = blockIdx.x * 8 + wid; row < NX; row += gridDim.x * 8) {
        unsigned er[9]; float gw[9];
#pragma unroll
        for (int k = 0; k < 8; ++k) { const int e = ((const int*)(p.ws + OFF_EIDX))[row * 8 + k], sl = ((const int*)(p.ws + OFF_ESLOT))[row * 8 + k];
            er[k] = (unsigned)(ST[e] + sl) * (unsigned)D; gw[k] = ((const float*)(p.ws + OFF_GATE))[row * 8 + k]; }
        er[8] = (unsigned)(ST[NE] + row) * (unsigned)D; gw[8] = 1.f;
        const float* md = MOD + (size_t)(row >> 12) * 12288 + 5 * D;
        LDSP float* RB = (LDSP float*)lds + wid * 2048;
        float ss = 0.f;
#pragma unroll 2
        for (int i = 0; i < 4; ++i) { const int col = 8 * (lane + 64 * i);
            float a[8];
#pragma unroll
            for (int j = 0; j < 8; ++j) a[j] = 0.f;
#pragma unroll
            for (int k = 0; k < 9; ++k) { const u32x2 w = *(const u32x2*)(EO + er[k] + col);
                const f32x2v f0 = __builtin_amdgcn_cvt_pk_f32_fp8((int)w.x, false), f1 = __builtin_amdgcn_cvt_pk_f32_fp8((int)w.x, true), f2 = __builtin_amdgcn_cvt_pk_f32_fp8((int)w.y, false), f3 = __builtin_amdgcn_cvt_pk_f32_fp8((int)w.y, true);
                a[0] += gw[k] * f0.x; a[1] += gw[k] * f0.y; a[2] += gw[k] * f1.x; a[3] += gw[k] * f1.y; a[4] += gw[k] * f2.x; a[5] += gw[k] * f2.y; a[6] += gw[k] * f3.x; a[7] += gw[k] * f3.y; }
            const f32x4 xa = *(const f32x4*)(X1 + (size_t)row * D + col), xb = *(const f32x4*)(X1 + (size_t)row * D + col + 4), ga = *(const f32x4*)(md + col), gb = *(const f32x4*)(md + col + 4);
            f32x4 va, vb; va.x = xa.x + ga.x * a[0]; va.y = xa.y + ga.y * a[1]; va.z = xa.z + ga.z * a[2]; va.w = xa.w + ga.w * a[3];
            vb.x = xb.x + gb.x * a[4]; vb.y = xb.y + gb.y * a[5]; vb.z = xb.z + gb.z * a[6]; vb.w = xb.w + gb.w * a[7];
            ss += va.x * va.x + va.y * va.y + va.z * va.z + va.w * va.w + vb.x * vb.x + vb.y * vb.y + vb.z * vb.z + vb.w * vb.w;
            *(LDSP f32x4*)(RB + col) = va; *(LDSP f32x4*)(RB + col + 4) = vb; }
        ss = wave_sum(ss); const float rs = rsqrtf(ss * (1.f / D) + 1e-6f);
#pragma unroll 4
        for (int i = 0; i < 8; ++i) { const int col = 4 * (lane + 64 * i); const f32x4 g = *(const f32x4*)(p.final_g + col);
            const f32x4 xv = *(const LDSP f32x4*)(RB + col);
            f32x4 o; o.x = xv.x * rs * g.x; o.y = xv.y * rs * g.y; o.z = xv.z * rs * g.z; o.w = xv.w * rs * g.w;
            *(f32x4*)(p.out + (size_t)row * D + col) = o; }
    }
}

#define XB_TMO      128
#define XB_XCNT(j)  (256  + 64 * (j))
#define XB_XSUB(j)  (1280 + 64 * (j))
#define XB_XGEN(j)  (2304 + 64 * (j))
#define XB_TOP      3328
#define XB_TOPGEN   3392
#define XB_SPIN_CAP (1u << 20)
__device__ __forceinline__ unsigned xb_ld(unsigned* p)              { return __hip_atomic_load(p, __ATOMIC_RELAXED, __HIP_MEMORY_SCOPE_AGENT); }
__device__ __forceinline__ unsigned xb_add(unsigned* p, unsigned v) { return __hip_atomic_fetch_add(p, v, __ATOMIC_RELAXED, __HIP_MEMORY_SCOPE_AGENT); }
__device__ __forceinline__ unsigned xb_xcc_id() { return (unsigned)__builtin_amdgcn_s_getreg((3 << 11) | 20) & 0xFu; }
#define XB_SPIN(cond, bar) do { unsigned _sp = 0; while (cond) { __builtin_amdgcn_s_sleep(1); \
    if ((++_sp & 255u) == 0u) { if (xb_ld(&(bar)[XB_TMO])) break; if (_sp > XB_SPIN_CAP) { atomicAdd(&(bar)[XB_TMO], 1u); break; } } } } while (0)
__device__ __forceinline__ unsigned xcd_barrier_complete(unsigned* bar, unsigned x) {
    const unsigned G = gridDim.x * gridDim.y * gridDim.z;
    unsigned sum, cnt, mine, sp = 0u;
    for (;;) {
        sum = 0u; cnt = 0u; mine = 0u;
#pragma unroll
        for (unsigned j = 0; j < 16; ++j) { const unsigned c = xb_ld(&bar[XB_XCNT(j)]); sum += c; cnt += (c > 0u) ? 1u : 0u; mine = (j == x) ? c : mine; }
        if (sum == G) break;
        __builtin_amdgcn_s_sleep(1);
        if ((++sp & 255u) == 0u) { if (xb_ld(&bar[XB_TMO])) break; if (sp > XB_SPIN_CAP) { atomicAdd(&bar[XB_TMO], 1u); break; } }
    }
    return (mine > 0u ? mine : 1u) | ((cnt > 0u ? cnt : 1u) << 16);
}
__device__ __forceinline__ void xcd_barrier(unsigned* bar, unsigned x, volatile LDSP unsigned* st) {
    x = (unsigned)opaque_s((int)x);
    asm volatile("s_waitcnt vmcnt(0)" ::: "memory");
    __syncthreads();
    if (TIDX() == 0) {
        __builtin_amdgcn_s_waitcnt(0);
        unsigned pk = st[0];
        if (pk == 0u) { pk = xcd_barrier_complete(bar, x); st[0] = pk; }
        const unsigned nloc = pk & 0xffffu, nx = pk >> 16;
        const unsigned old = xb_add(&bar[XB_XSUB(x)], 1u);
        const unsigned gen = old / nloc;
        if (old + 1u == (gen + 1u) * nloc) {
            __builtin_amdgcn_fence(__ATOMIC_RELEASE, "agent");
            asm volatile("s_waitcnt vmcnt(0)" ::: "memory");
            const unsigned og = xb_add(&bar[XB_TOP], 1u);
            const unsigned tg = og / nx;
            if (og + 1u == (tg + 1u) * nx) xb_add(&bar[XB_TOPGEN], 1u);
            else XB_SPIN(xb_ld(&bar[XB_TOPGEN]) == tg, bar);
            __builtin_amdgcn_fence(__ATOMIC_ACQUIRE, "agent");
            xb_add(&bar[XB_XGEN(x)], 1u);
            asm volatile("s_waitcnt vmcnt(0)" ::: "memory");
        } else {
            XB_SPIN(xb_ld(&bar[XB_XGEN(x)]) == gen, bar);
            __builtin_amdgcn_fence(__ATOMIC_ACQUIRE, "agent");
            asm volatile("s_waitcnt vmcnt(0)" ::: "memory");
        }
    }
    __syncthreads();
}

__global__ void __launch_bounds__(512, 2) fwd_megakernel(Params p) {
    __shared__ __attribute__((aligned(16))) unsigned char smem_raw[SMEM_BYTES];
    LDSP unsigned char* lds = (LDSP unsigned char*)smem_raw;
    volatile LDSP unsigned* xst = (volatile LDSP unsigned*)(lds + SMEM_BYTES - 16);
    if ((threadIdx.x & 63u) == 0u) *LDS_AT(int, TID_TAB + 4u * ((unsigned)__builtin_amdgcn_s_getreg(0x2804) & 63u)) = (int)(threadIdx.x >> 6);
    if (threadIdx.x == 0) { xst[0] = 0u; xst[1] = 0u; }
    __syncthreads();
    const unsigned xcc = xb_xcc_id();
    if (threadIdx.x == 0) (void)xb_add(&((unsigned*)p.ws)[XB_XCNT(xcc)], 1u);
#define GSYNC xcd_barrier((unsigned*)p.ws, xcc, xst)
#ifndef PH_TWICE
#define PH_TWICE 0
#endif
#ifndef PROBE_FLAGS
#define PROBE_FLAGS 0
#endif
#ifndef PH_MASK
#define PH_MASK 0xffff
#endif
#define RUN_PHASE(bit, fn) _Pragma("unroll 1") for (int rep = 0; rep < ((PH_TWICE & (bit)) ? 2 : 1); ++rep) { if (rep) GSYNC; if (PH_MASK & (bit)) { Params q = p; q.ws = opq(p.ws); q.flags = rep ? PROBE_FLAGS : 0; fn(lds, q); } }
    RUN_PHASE(1, phase0)      GSYNC;
    RUN_PHASE(2, phase1)      GSYNC;
    RUN_PHASE(4, phase2)      GSYNC;
    RUN_PHASE(8, phaseR1)     GSYNC;
    RUN_PHASE(16, phaseR2)    GSYNC;
    RUN_PHASE(32, phaseR3)    GSYNC;
    RUN_PHASE(64, phaseR4)    GSYNC;
    RUN_PHASE(128, phaseR5)   GSYNC;
    RUN_PHASE(256, phase6)    GSYNC;
    RUN_PHASE(512, phase7)    GSYNC;
    RUN_PHASE(8192, phase7b)  GSYNC;
    RUN_PHASE(1024, phase8)   GSYNC;
    RUN_PHASE(2048, phase9)   GSYNC;
    RUN_PHASE(4096, phase10)
}

extern "C" void kernel_launch(void* const* d_in, const int* in_sizes, int n_in, void* d_out, int out_size, void* d_ws, size_t ws_size, hipStream_t stream) {
    static int grid_blocks = 0;
    if (!grid_blocks) {
        int dev = 0, cus = 0, per_cu = 0;
        (void)hipGetDevice(&dev);
        (void)hipDeviceGetAttribute(&cus, hipDeviceAttributeMultiprocessorCount, dev);
        (void)hipOccupancyMaxActiveBlocksPerMultiprocessor(&per_cu, fwd_megakernel, 512, 0);
        if (per_cu > 1) per_cu = 1;
        grid_blocks = cus * per_cu;
        if (ws_size < WS_END) fprintf(stderr, "workspace too small: %zu < %zu\n", ws_size, (size_t)WS_END);
    }
    Params p{};
    const float** f = (const float**)&p;
    for (int i = 0; i < 31; ++i) f[i] = (const float*)d_in[i];
    p.out = (float*)d_out; p.ws = (unsigned char*)d_ws;
    (void)hipMemsetAsync(d_ws, 0, 32768, stream);
    void* args[] = {&p};
    hipError_t e = hipLaunchCooperativeKernel((void*)fwd_megakernel, dim3(grid_blocks), dim3(512), args, 0, stream);
    if (e != hipSuccess) fprintf(stderr, "cooperative launch failed: %s (grid %d)\n", hipGetErrorString(e), grid_blocks);
}
```

```cpp
#include <hip/hip_runtime.h>
#include <hip/hip_cooperative_groups.h>
#include <cstdio>
#include <cstdint>
namespace cg = cooperative_groups;

#define LDSP __attribute__((address_space(3)))
typedef unsigned short bf16_t;
typedef short bf16x8 __attribute__((ext_vector_type(8)));
typedef float f32x4 __attribute__((ext_vector_type(4)));
typedef float f32x16 __attribute__((ext_vector_type(16)));
typedef unsigned u32x4 __attribute__((ext_vector_type(4)));
typedef unsigned u32x2 __attribute__((ext_vector_type(2)));
typedef int v4i __attribute__((ext_vector_type(4)));
typedef int v8i __attribute__((ext_vector_type(8)));
__device__ __forceinline__ u32x4 mk4u(unsigned a, unsigned b, unsigned c, unsigned d) { u32x4 r; r.x = a; r.y = b; r.z = c; r.w = d; return r; }
__device__ __forceinline__ u32x2 mk2u(unsigned a, unsigned b) { u32x2 r; r.x = a; r.y = b; return r; }
__device__ __forceinline__ f32x4 mk4f(float a, float b, float c, float d) { f32x4 r; r.x = a; r.y = b; r.z = c; r.w = d; return r; }

constexpr int D = 2048, NB = 2, T = 4096, CL = 256, NX = NB * T, NCX = NB * CL, NR = NX + NCX;
constexpr int INC = 5056, INP = 5120;
constexpr int C_R = 0, C_K = 1024, C_V = 2048, C_XW = 3072, C_XA = 3168, C_XG = 3264, C_Q = 3520, C_AK = 4544, C_AV = 4800;
constexpr int NE = 64, NEX = 65, EFF = 512;
constexpr int NCHUNK = 68;
constexpr int NINST = NB * 16 * 2 * NCHUNK;
constexpr int EROWS = NX * 8 + NX;

constexpr size_t al4k(size_t x) { return (x + 4095) & ~(size_t)4095; }
constexpr size_t OFF_CTL = 0;
constexpr size_t OFF_ROPE = 65536;
constexpr size_t OFF_MODP = OFF_ROPE + 8192;
constexpr size_t OFF_MOD = al4k(OFF_MODP + (size_t)16 * 3 * 12288 * 4);
constexpr size_t OFF_WTDU = al4k(OFF_MOD + (size_t)3 * 12288 * 4);
constexpr size_t OFF_WTIU = OFF_WTDU + (size_t)2 * 1024 * 128 * 2;
constexpr size_t OFF_WTGU = OFF_WTIU + (size_t)2 * 1024 * 128 * 2;
constexpr size_t OFF_WTE2 = OFF_WTGU + (size_t)1024 * 256 * 2;
constexpr size_t OFF_X1 = OFF_WTE2 + (size_t)NEX * 2048 * 512 * 2;
constexpr size_t OFF_H2 = OFF_X1 + (size_t)NX * D * 4;
constexpr size_t OFF_TOKL = OFF_H2 + (size_t)NX * D * 2;
constexpr size_t OFF_EIDX = OFF_TOKL + (size_t)NE * NX * 4;
constexpr size_t OFF_ESLOT = OFF_EIDX + (size_t)NX * 8 * 4;
constexpr size_t OFF_GATE = OFF_ESLOT + (size_t)NX * 8 * 4;
constexpr size_t OFF_H1 = OFF_GATE + (size_t)NX * 8 * 4;
constexpr size_t OFF_WTE1 = al4k(OFF_H1 + (size_t)(EROWS + 256) * EFF * 2);
constexpr size_t OFF_EO = OFF_WTE1;
constexpr size_t OFF_WTIN = OFF_WTE1 + (size_t)NEX * 1024 * 2048 * 2;
constexpr size_t OFF_WTOUT = OFF_WTIN + (size_t)INP * D * 2;
constexpr size_t OFF_HX = OFF_WTOUT + (size_t)D * D * 2;
constexpr size_t OFF_PX = OFF_HX + (size_t)NR * D * 2;
constexpr size_t OFF_CM = OFF_PX + (size_t)NR * INP * 2;
constexpr size_t OFF_CN = OFF_CM + (size_t)NINST * 4096 * 2;
constexpr size_t OFF_CP = OFF_CN + (size_t)NINST * 4096 * 2;
constexpr size_t OFF_CQ = OFF_CP + (size_t)NINST * 4096 * 2;
constexpr size_t OFF_YD = OFF_CQ + (size_t)NINST * 4096 * 2;
constexpr size_t OFF_BON = OFF_YD + (size_t)2 * NX * 1024 * 4;
constexpr size_t OFF_MIX = OFF_BON + (size_t)2 * NX * 16 * 4;
constexpr size_t OFF_WRT = OFF_MIX + (size_t)NX * D * 2;
constexpr size_t WS_END = OFF_WRT + (size_t)NE * D * 4;
constexpr size_t OFF_CNTB = OFF_MODP;
constexpr size_t OFF_RS = OFF_X1;
constexpr size_t OFF_KS = OFF_RS + (size_t)NR * 1024 * 2;
constexpr size_t OFF_KK = OFF_KS + (size_t)NR * 1024 * 2;
constexpr size_t OFF_VS = OFF_KK + (size_t)NR * 1024 * 2;
constexpr size_t OFF_TW = OFF_VS + (size_t)NR * 1024 * 2;
constexpr size_t OFF_XA = OFF_TW + (size_t)NR * 128 * 2;
constexpr size_t OFF_SG = OFF_XA + (size_t)NR * 128 * 2;
constexpr size_t OFF_LWG = OFF_SG + (size_t)NX * 256 * 2;
constexpr size_t OFF_AIG = OFF_LWG + (size_t)NR * 2048 * 2;
constexpr size_t OFF_GG = OFF_AIG + (size_t)NR * 2048 * 2;
static_assert(OFF_GG + (size_t)NX * 1024 * 2 <= OFF_WTE1, "RWKV token buffers fit the overlay region");
static_assert(OFF_EO + (size_t)EROWS * D * 2 <= OFF_HX, "EO overlays only WT_E1/WT_IN/WT_OUT");
static_assert(WS_END <= (size_t)1073741824, "workspace map must fit 1 GiB");

constexpr int SMEM_BYTES = 157 * 1024;

struct Params {
    const float *x, *c, *ctx, *c_ctx, *w_mod, *b_mod, *norm1_g, *norm2_g, *w_in, *shift_mu, *k_k, *k_a, *r_k, *decay_bias, *decay_up, *iclr_bias, *iclr_up,
        *gate_up, *lnx_g, *lnx_b, *attn_sink, *w_out, *w_router, *expert_bias, *e_gate, *e_up, *e_down, *s_gate, *s_up, *s_down, *final_g;
    float* out;
    unsigned char* ws;
    int flags;
};

#if defined(__HIP_DEVICE_COMPILE__)
#define LDS_AT(T, addr) (__builtin_bit_cast(LDSP T*, (unsigned)(addr)))
#define LDS_ADDR(ptr) (__builtin_bit_cast(unsigned, (ptr)))
#else
#define LDS_AT(T, addr) ((LDSP T*)(size_t)(addr))
#define LDS_ADDR(ptr) ((unsigned)(size_t)(ptr))
#endif
constexpr int TID_TAB = SMEM_BYTES - 320;
__device__ __forceinline__ int TIDX() {
    const unsigned hw = (unsigned)__builtin_amdgcn_s_getreg(0x2804) & 63u;
    unsigned z = 0u; asm volatile("" : "+v"(z));
    const int wv = __builtin_amdgcn_readfirstlane(*LDS_AT(const int, TID_TAB + 4u * hw));
    return (wv << 6) | (int)__builtin_amdgcn_mbcnt_hi(~0u, __builtin_amdgcn_mbcnt_lo(~0u, z));
}
__device__ __forceinline__ unsigned f2bf(float f) { unsigned u = __float_as_uint(f); return (u + 0x7fffu + ((u >> 16) & 1u)) >> 16; }
__device__ __forceinline__ float bf2f(unsigned h) { return __uint_as_float(h << 16); }
typedef float f32x2_t __attribute__((ext_vector_type(2)));
typedef __bf16 bf16x2_t __attribute__((ext_vector_type(2)));
__device__ __forceinline__ unsigned pk2(float lo, float hi) { f32x2_t v = {lo, hi}; bf16x2_t b = __builtin_convertvector(v, bf16x2_t); return __builtin_bit_cast(unsigned, b); }
__device__ __forceinline__ unsigned pk4_fp8(float a, float b, float c, float d) { int w = 0; w = __builtin_amdgcn_cvt_pk_fp8_f32(a, b, w, false); w = __builtin_amdgcn_cvt_pk_fp8_f32(c, d, w, true); return (unsigned)w; }
__device__ __forceinline__ int opaque(int x);
__device__ __forceinline__ float shx(float v, int o) {
    const int l = TIDX() & 63;
    return __builtin_bit_cast(float, __builtin_amdgcn_ds_bpermute((l ^ o) << 2, __builtin_bit_cast(int, v))); }
__device__ __forceinline__ u32x4 widen32(unsigned d0, unsigned d1, unsigned d2, unsigned d3) {
    const auto s01 = __builtin_amdgcn_permlane32_swap(d0, d1, false, false), s23 = __builtin_amdgcn_permlane32_swap(d2, d3, false, false);
    const auto t0 = __builtin_amdgcn_permlane32_swap(s01[0], s23[0], false, false), t1 = __builtin_amdgcn_permlane32_swap(s01[1], s23[1], false, false);
    return mk4u(t0[0], t1[0], t0[1], t1[1]);
}
__device__ __forceinline__ float wave_sum(float v) {
#pragma unroll
    for (int o = 32; o > 0; o >>= 1) v += shx(v, o);
    return v;
}
__device__ __forceinline__ int opaque(int x) { asm volatile("" : "+v"(x)); return x; }
__device__ __forceinline__ int opaque_s(int x) { asm volatile("" : "+s"(x)); return x; }
__device__ __forceinline__ unsigned char* opq(unsigned char* x) {
    unsigned long long v = (unsigned long long)x; asm volatile("" : "+s"(v));
    return (unsigned char*)(__attribute__((address_space(1))) unsigned char*)v; }
__device__ __forceinline__ float sigmoidf_(float x) { return __builtin_amdgcn_rcpf(1.f + __expf(-x)); }
__device__ __forceinline__ int lds_byte(int r, int c) { const int st = (r >> 4) * 2 + (c >> 5), rr = r & 15, cc = c & 31, ob = rr * 64 + cc * 2; return st * 1024 + (ob ^ (((ob >> 9) & 1) << 5)); }
__device__ __forceinline__ int sw64(int r, int k) { return r * 128 + ((((k >> 3) ^ (r >> 1)) & 7) << 4) + (k & 7) * 2; }

__device__ __forceinline__ f32x16 zero16() { f32x16 z;
#pragma unroll
    for (int i = 0; i < 16; ++i) z[i] = 0.f; return z; }
__device__ __forceinline__ int crow(int reg, int hi) { return (reg & 3) + 8 * (reg >> 2) + 4 * hi; }

namespace pg8 {
constexpr int BM = 256, BK = 64, HALF = 128, HTB = HALF * BK * 2, NXCD = 8;
__device__ __forceinline__ void stage_rc(int b, int& R, int& C) { const int st = b / 1024, sb = b % 1024, swz = sb ^ (((sb >> 9) & 1) << 5); R = (st >> 1) * 16 + swz / 64; C = (st & 1) * 32 + (swz % 64) / 2; }
struct Unit { const char* A; const char* B; const int* rowmap; int nvalid, m0, row0, col0, pos0, e; };
__device__ __forceinline__ int xcd_remap(int L, int nwg) { const int q = nwg / NXCD, r = nwg % NXCD, xcd = L % NXCD, off = L / NXCD; return (xcd < r ? xcd * (q + 1) : r * (q + 1) + (xcd - r) * q) + off; }

__device__ __forceinline__ int perm32(int rho) { const int n = rho >> 4, i = rho & 15; return 8 * (i >> 2) + 4 * n + (i & 3); }
template <class F, int NBJ = 2> struct Epi {
    F f;
    __device__ __forceinline__ void operator()(const f32x4 (&acc)[2][2][4][2], const Unit& u, int wr, int wc, int fr, int fq) const {
        { const int lane = TIDX() & 63; fr = lane & 15; fq = lane >> 4; }
#pragma unroll
        for (int ai = 0; ai < 2; ++ai)
#pragma unroll
            for (int m = 0; m < 4; ++m)
#pragma unroll
                for (int bj = 0; bj < NBJ; ++bj) { f(u, 128 * ai + 64 * wr + 16 * m + fr, 128 * bj + 32 * wc + 8 * fq, acc[ai][bj][m][0], acc[ai][bj][m][1]); __builtin_amdgcn_sched_barrier(0); }
    }
};

template <bool GATHER, bool ALIGN_EPI = true, int FP8M = 0, class EpiT, class Sched>
__device__ __forceinline__ void gemm_phase(LDSP unsigned char* lds, const int K, const Sched& S, const EpiT& E) {
    const int tid = TIDX(), wid = __builtin_amdgcn_readfirstlane(tid >> 6), lane = tid & 63, wr = wid >> 2, wc = wid & 3, fr = lane & 15, fq = lane >> 4;
    constexpr bool FP8 = (FP8M != 0), NARROW = (FP8M == 1);
    const int nt = K / BK;
    unsigned voffA[2], voffB[2];
#pragma unroll
    for (int i = 0; i < 2; ++i) { int R, C; stage_rc(tid * 16 + i * 8192, R, C); const int Rb = (R & ~31) + perm32(R & 31); voffA[i] = (unsigned)(R * K + C) * 2u; voffB[i] = (unsigned)(Rb * K + C) * 2u; }
    const size_t kstep = (size_t)(BK * 2);
    const size_t hstep = (size_t)HALF * K * 2;
    const size_t hstepB = hstep;
    const unsigned ldsw = (unsigned)wid * 1024u;
    const int aoff = lds_byte(wr * 64 + fr, fq * 8), boff = lds_byte(wc * 32 + fr, fq * 8);
    const unsigned abase = LDS_ADDR(lds) + (unsigned)aoff, bbase = LDS_ADDR(lds) + 65536u + (unsigned)boff;
#define PG8_SA(b, h) (((b) * 2 + (h)) * HTB)
#define PG8_SB(b, h) ((4 + (b) * 2 + (h)) * HTB)
#define PG8_STAGE(bufoff, gbase, voff) do { _Pragma("unroll") for (int _i = 0; _i < 2; ++_i) \
        { unsigned _o = (voff)[_i]; asm volatile("" : "+v"(_o)); __builtin_amdgcn_global_load_lds((const unsigned*)((const char*)(gbase) + _o), (LDSP unsigned*)(lds + (bufoff) + ldsw + _i * 8192), 16, 0, 0); } } while (0)
#define PG8_STAGE_B1(bufoff, gbase) do { if constexpr (!NARROW) { PG8_STAGE(bufoff, gbase, voffB); } } while (0)
#define PG8_STAGE_A(bufoff, nx, h, ubase, koff) do { if constexpr (GATHER) { unsigned _v[2]; const LDSP unsigned* _ro = rowoff + ((((nx) ? (ui + 1) : ui) & 1) * 4 + (h) * 2) * 512; _v[0] = _ro[0]; _v[1] = _ro[512]; PG8_STAGE(bufoff, (ubase) + (koff), _v); } \
        else { PG8_STAGE(bufoff, (ubase) + (h) * hstep + (koff), voffA); } } while (0)
#define PG8_LD16(off) (*(const LDSP bf16x8*)(lds + (off)))
#define PG8_DSR(base, off) ({ v4i _r; asm volatile("ds_read_b128 %0, %1 offset:%2" : "=v"(_r) : "v"(base), "n"(off)); _r; })
#define PG8_LDA(dst, b, h) do { _Pragma("unroll") for (int m = 0; m < 4; ++m) { if constexpr (FP8) dst##8[m] = __builtin_shufflevector(PG8_DSR(abase, PG8_SA(b, h) + m * 2048), PG8_DSR(abase, PG8_SA(b, h) + m * 2048 + 1024), 0, 1, 2, 3, 4, 5, 6, 7); \
        else { _Pragma("unroll") for (int k = 0; k < 2; ++k) dst[m][k] = PG8_LD16(PG8_SA(b, h) + aoff + m * 2048 + k * 1024); } } } while (0)
#define PG8_LDB(dst, b, h) do { if constexpr (!NARROW || (h) == 0) { _Pragma("unroll") for (int n = 0; n < 2; ++n) { if constexpr (FP8) dst##8[n] = __builtin_shufflevector(PG8_DSR(bbase, PG8_SB(b, h) - 65536 + n * 2048), PG8_DSR(bbase, PG8_SB(b, h) - 65536 + n * 2048 + 1024), 0, 1, 2, 3, 4, 5, 6, 7); \
        else { _Pragma("unroll") for (int k = 0; k < 2; ++k) dst[n][k] = PG8_LD16(PG8_SB(b, h) + boff + n * 2048 + k * 1024); } } } } while (0)
#define PG8_MMA(ai, bj, At, Bt) do { if constexpr (!NARROW || (bj) == 0) { if constexpr (FP8) __builtin_amdgcn_sched_barrier(0); __builtin_amdgcn_s_setprio(1); if constexpr (FP8) { _Pragma("unroll") for (int m = 0; m < 4; ++m) _Pragma("unroll") for (int n = 0; n < 2; ++n) \
            acc[ai][bj][m][n] = __builtin_amdgcn_mfma_scale_f32_16x16x128_f8f6f4(Bt##8[n], At##8[m], acc[ai][bj][m][n], 0, 0, 0, 0x7f7f7f7f, 0, 0x7f7f7f7f); } \
        else { _Pragma("unroll") for (int m = 0; m < 4; ++m) _Pragma("unroll") for (int n = 0; n < 2; ++n) _Pragma("unroll") for (int k = 0; k < 2; ++k) \
            acc[ai][bj][m][n] = __builtin_amdgcn_mfma_f32_16x16x32_bf16(Bt[n][k], At[m][k], acc[ai][bj][m][n], 0, 0, 0); } __builtin_amdgcn_s_setprio(0); } } while (0)
#define PG8_WAIT_V(n) asm volatile("s_waitcnt vmcnt(" #n ")" ::: "memory")
#define PG8_WAIT_L(n) asm volatile("s_waitcnt lgkmcnt(" #n ")" ::: "memory")
#define PG8_BAR __builtin_amdgcn_s_barrier()
#define PG8_SCHED __builtin_amdgcn_sched_barrier(0)
    Unit cur, nxt; int ui = 0;
    cur.e = 0; nxt.e = 0;
    if (!S.next(0, cur)) return;
    LDSP unsigned* rowoff = (LDSP unsigned*)(lds + 132096) + tid;
    auto rows_of = [&](const Unit& u, int slot) {
        if constexpr (GATHER) {
#pragma unroll
            for (int h = 0; h < 2; ++h)
#pragma unroll
                for (int i = 0; i < 2; ++i) { int R, C; stage_rc(TIDX() * 16 + i * 8192, R, C); const int idx = u.m0 + h * HALF + R; int gr = idx; if (u.rowmap) gr = (idx < u.nvalid) ? u.rowmap[idx] : 0;
                    rowoff[((slot & 1) * 4 + h * 2 + i) * 512] = (unsigned)(gr * K + C) * 2u; }
        }
    };
    rows_of(cur, 0);
    f32x4 acc[2][2][4][2];
#pragma unroll
    for (int a = 0; a < 2; ++a)
#pragma unroll
        for (int b = 0; b < 2; ++b)
#pragma unroll
            for (int m = 0; m < 4; ++m)
#pragma unroll
                for (int n = 0; n < 2; ++n) acc[a][b][m][n] = (f32x4){0.f, 0.f, 0.f, 0.f};
    bf16x8 At[4][2], B0[2][2], B1[2][2];
    v8i At8[4], B08[2], B18[2];
    const char* cA = cur.A; const char* cB = cur.B;
    PG8_STAGE(PG8_SB(0, 0), cB, voffB); PG8_STAGE_B1(PG8_SB(0, 1), cB + hstepB); PG8_STAGE_A(PG8_SA(0, 0), false, 0, cA, 0); PG8_STAGE_A(PG8_SA(0, 1), false, 1, cA, 0);
    if (wr == 1) PG8_BAR;
    PG8_WAIT_V(2); PG8_BAR;
    PG8_STAGE(PG8_SB(1, 0), cB + kstep, voffB); PG8_STAGE_A(PG8_SA(1, 0), false, 0, cA, kstep); PG8_STAGE_B1(PG8_SB(1, 1), cB + hstepB + kstep);
    if constexpr (NARROW) PG8_WAIT_V(4); else PG8_WAIT_V(6);
    PG8_BAR;
    for (;;) {
        nxt.e = cur.e;
        const bool has_next = S.next(ui + 1, nxt);
        rows_of(has_next ? nxt : cur, ui + 1);
        const char* nA = has_next ? nxt.A : cA; const char* nB = has_next ? nxt.B : cB;
#pragma unroll 1
        for (int t = 0; t < nt; t += 2) {
            const bool last = (t == nt - 2);
            const size_t k1 = (size_t)(t + 1) * kstep;
            const char* a2 = last ? nA : cA; const size_t k2 = last ? 0 : (size_t)(t + 2) * kstep;
            const char* b2 = last ? nB : cB + (size_t)(t + 2) * kstep;
            const char* b3 = b2 + kstep;
            PG8_LDB(B0, 0, 0); PG8_LDB(B1, 0, 1); PG8_SCHED; PG8_LDA(At, 0, 0); PG8_STAGE_A(PG8_SA(1, 1), false, 1, cA, k1);
            if constexpr (NARROW) PG8_WAIT_V(6); else PG8_WAIT_V(8);
            PG8_WAIT_L(0); PG8_BAR; PG8_MMA(0, 0, At, B0); PG8_MMA(0, 1, At, B1); PG8_BAR; PG8_SCHED;
            PG8_LDA(At, 0, 1); PG8_STAGE(PG8_SB(0, 0), b2, voffB); PG8_STAGE_B1(PG8_SB(0, 1), b2 + hstepB); PG8_STAGE_A(PG8_SA(0, 0), last, 0, a2, k2);
            if constexpr (NARROW) PG8_WAIT_V(6); else PG8_WAIT_V(8);
            PG8_WAIT_L(0); PG8_BAR; PG8_MMA(1, 0, At, B0); PG8_MMA(1, 1, At, B1); PG8_BAR; PG8_SCHED;
            PG8_LDB(B0, 1, 0); PG8_LDB(B1, 1, 1); PG8_SCHED; PG8_LDA(At, 1, 0); PG8_STAGE_A(PG8_SA(0, 1), last, 1, a2, k2);
            if constexpr (NARROW) PG8_WAIT_V(6); else PG8_WAIT_V(8);
            PG8_WAIT_L(0); PG8_BAR; PG8_MMA(0, 0, At, B0); PG8_MMA(0, 1, At, B1); PG8_BAR; PG8_SCHED;
            PG8_LDA(At, 1, 1); PG8_STAGE(PG8_SB(1, 0), b3, voffB); PG8_STAGE_B1(PG8_SB(1, 1), b3 + hstepB); PG8_STAGE_A(PG8_SA(1, 0), last, 0, a2, k2 + kstep);
            if constexpr (NARROW) PG8_WAIT_V(6); else PG8_WAIT_V(8);
            PG8_WAIT_L(0); PG8_BAR; PG8_MMA(1, 0, At, B0); PG8_MMA(1, 1, At, B1); PG8_BAR; PG8_SCHED;
        }
        if constexpr (ALIGN_EPI) { if (wr == 0) PG8_BAR; }
        E(acc, cur, wr, wc, fr, fq);
        if (!has_next) break;
#pragma unroll
        for (int a = 0; a < 2; ++a)
#pragma unroll
            for (int b = 0; b < 2; ++b)
#pragma unroll
                for (int m = 0; m < 4; ++m)
#pragma unroll
                    for (int n = 0; n < 2; ++n) acc[a][b][m][n] = (f32x4){0.f, 0.f, 0.f, 0.f};
        cur = nxt; cA = nA; cB = nB; ++ui;
        if constexpr (ALIGN_EPI) { if (wr == 1) PG8_BAR; }
    }
    PG8_WAIT_V(0);
    if constexpr (!ALIGN_EPI) { if (wr == 0) PG8_BAR; }
    PG8_BAR;
#undef PG8_SA
#undef PG8_SB
#undef PG8_STAGE
#undef PG8_STAGE_A
#undef PG8_STAGE_B1
#undef PG8_LDA
#undef PG8_LD16
#undef PG8_DSR
#undef PG8_LDB
#undef PG8_MMA
#undef PG8_WAIT_V
#undef PG8_WAIT_L
#undef PG8_BAR
#undef PG8_SCHED
}

struct DenseSched {
    const char* A; const char* B; int nM, nN, K, G, c;
    __device__ __forceinline__ bool next(int i, Unit& u) const {
        const int nwg = nM * nN; const long L = (long)i * G + c; if (L >= nwg) return false;
        const int wgid = xcd_remap((int)L, nwg);
        const int nig = 8 * nN, gid = wgid / nig, fm = gid * 8, gsz = (nM - fm) < 8 ? (nM - fm) : 8;
        const int pm = fm + ((wgid % nig) % gsz), pn = (wgid % nig) / gsz;
        u.A = A + (size_t)pm * 256 * K * 2; u.B = B + (size_t)pn * 256 * K * 2; u.rowmap = nullptr; u.nvalid = 0; u.m0 = 0; u.row0 = pm * 256; u.col0 = pn * 256; u.pos0 = 0;
        return true;
    }
};
}

struct FPX { bf16_t* PX; __device__ __forceinline__ void operator()(const pg8::Unit& u, int lr, int lc, f32x4 v0, f32x4 v1) const {
    *(u32x4*)(PX + (size_t)(u.row0 + lr) * INP + u.col0 + lc) = mk4u(pk2(v0[0], v0[1]), pk2(v0[2], v0[3]), pk2(v1[0], v1[1]), pk2(v1[2], v1[3])); } };
struct FX1 { const float* x; const float* mod; float* X1; float sc; __device__ __forceinline__ void operator()(const pg8::Unit& u, int lr, int lc, f32x4 v0, f32x4 v1) const {
    const int row = u.row0 + lr, col = u.col0 + lc; const float* xp = x + (size_t)row * D + col; const float* gp = mod + (size_t)(row >> 12) * 12288 + 2 * D + col; float* op = X1 + (size_t)row * D + col;
    *(f32x4*)op = *(const f32x4*)xp + *(const f32x4*)gp * (v0 * sc); *(f32x4*)(op + 4) = *(const f32x4*)(xp + 4) + *(const f32x4*)(gp + 4) * (v1 * sc); } };
constexpr float W1_SCALE = 64.f, W2_SCALE = 32.f;
struct FH1 { unsigned char* H1; __device__ __forceinline__ void operator()(const pg8::Unit& u, int lr, int lc, f32x4 v0, f32x4 v1) const {
    if (u.m0 + lr < u.nvalid) { float h[4];
#pragma unroll
        for (int e = 0; e < 4; ++e) { const float g = v0[e] * (1.f / W1_SCALE); h[e] = g * sigmoidf_(g) * (v1[e] * (1.f / W1_SCALE)); }
        *(unsigned*)(H1 + (unsigned)((u.pos0 + u.m0 + lr) * EFF + ((u.col0 + lc) >> 1))) = pk4_fp8(h[0], h[1], h[2], h[3]); } } };
struct FEO { unsigned char* EO; __device__ __forceinline__ void operator()(const pg8::Unit& u, int lr, int lc, f32x4 v0, f32x4 v1) const {
    if (u.m0 + lr < u.nvalid) { v0 *= (1.f / W2_SCALE); v1 *= (1.f / W2_SCALE);
        *(u32x2*)(EO + (unsigned)((u.pos0 + u.m0 + lr) * D + u.col0 + lc)) = mk2u(pk4_fp8(v0[0], v0[1], v0[2], v0[3]), pk4_fp8(v1[0], v1[1], v1[2], v1[3])); } } };

struct ConvJob { const float* src; bf16_t* dst; int K, N, ld, mode, ntk, ntn; size_t sbs, dbs; };
__device__ __forceinline__ int conv_row(int n, int mode) { return mode == 0 ? n : (8 * (n >> 2) + (n & 3) + (mode == 2 ? 4 : 0)); }

struct TileCtx { const float* src; bf16_t* dst; int N, ld, mode, k0, n0; };
constexpr int CT0 = 0, CT1 = CT0 + 8 * (INC / 64), CT2 = CT1 + 8 * 32, CT3 = CT2 + 64 * 64, CT4 = CT3 + 64 * 64, CT5 = CT4 + 64 * 64, CT6 = CT5 + 64, CT7 = CT6 + 64, CT8 = CT7 + 64, CT_END = CT8 + 16;
__device__ __forceinline__ void conv_decode(const Params& p, int g, const float*& src, bf16_t*& dst, int& N, int& ld, int& mode, int& k0, int& n0) {
    unsigned char* WTE1 = p.ws + OFF_WTE1; unsigned char* WTE2 = p.ws + OFF_WTE2;
    unsigned char* d8; int t, ntk, ntn; size_t sbs = 0, dbs = 0;
    if (g < CT1)      { t = g - CT0; src = p.w_in; d8 = p.ws + OFF_WTIN; N = INC; ld = 4096; mode = 0; ntk = 8; ntn = INC / 64; }
    else if (g < CT2) { t = g - CT1; src = p.w_out; d8 = p.ws + OFF_WTOUT; N = 2048; ld = 2048; mode = 4; ntk = 8; ntn = 32; }
    else if (g < CT3) { t = g - CT2; src = p.e_gate; d8 = WTE1; N = 512; ld = 2048; mode = 5; ntk = 8; ntn = 8; sbs = (size_t)2048 * 512; dbs = (size_t)1024 * 2048; }
    else if (g < CT4) { t = g - CT3; src = p.e_up; d8 = WTE1; N = 512; ld = 2048; mode = 6; ntk = 8; ntn = 8; sbs = (size_t)2048 * 512; dbs = (size_t)1024 * 2048; }
    else if (g < CT5) { t = g - CT4; src = p.e_down; d8 = WTE2; N = 2048; ld = 512; mode = 4; ntk = 2; ntn = 32; sbs = (size_t)512 * 2048; dbs = (size_t)2048 * 512; }
    else if (g < CT6) { t = g - CT5; src = p.s_gate; d8 = WTE1 + (size_t)64 * 1024 * 2048; N = 512; ld = 2048; mode = 5; ntk = 8; ntn = 8; }
    else if (g < CT7) { t = g - CT6; src = p.s_up; d8 = WTE1 + (size_t)64 * 1024 * 2048; N = 512; ld = 2048; mode = 6; ntk = 8; ntn = 8; }
    else if (g < CT8) { t = g - CT7; src = p.s_down; d8 = WTE2 + (size_t)64 * 2048 * 512; N = 2048; ld = 512; mode = 4; ntk = 2; ntn = 32; }
    else              { t = g - CT8; src = p.gate_up; d8 = p.ws + OFF_WTGU; N = 1024; ld = 512; mode = 0; ntk = 1; ntn = 16; }
    const int per = ntk * ntn, bi = t / per, rem = t - bi * per, kt = rem / ntn, ntile = rem - kt * ntn;
    src += (size_t)bi * sbs; dst = (bf16_t*)(d8 + (size_t)bi * dbs); k0 = kt * 256; n0 = ntile * 64;
}
__device__ __forceinline__ void conv_load(const float* src, int N, int k0, int n0, f32x4 (&v)[4][2], int tid) {
    const int kr = tid >> 3, nc = (tid & 7) * 8;
#pragma unroll
    for (int s = 0; s < 4; ++s) { const float* q = src + (size_t)(k0 + s * 64 + kr) * N + n0 + nc; v[s][0] = *(const f32x4*)q; v[s][1] = *(const f32x4*)(q + 4); }
}
__device__ __forceinline__ void conv_finish(LDSP unsigned char* lds, bf16_t* dst, int ld, int mode, int k0, int n0, const f32x4 (&v)[4][2], int tid) {
    LDSP float* Tm = (LDSP float*)lds;
    {
        const int kr = tid >> 3, nc = (tid & 7) * 8;
#pragma unroll
        for (int s = 0; s < 4; ++s) { LDSP float* q = Tm + (s * 64 + kr) * 65 + nc;
            q[0] = v[s][0].x; q[1] = v[s][0].y; q[2] = v[s][0].z; q[3] = v[s][0].w; q[4] = v[s][1].x; q[5] = v[s][1].y; q[6] = v[s][1].z; q[7] = v[s][1].w; }
    }
    __syncthreads();
    {
        const int n = tid >> 3; unsigned char* drow8 = (unsigned char*)dst + (size_t)conv_row(n0 + n, mode & 3) * ld;
        if (mode & 4) {
            const float sc = (mode & 3) ? W1_SCALE : W2_SCALE;
#pragma unroll
            for (int s = 0; s < 2; ++s) { const int kc = ((tid & 7) + 8 * s) * 16; float f[16];
#pragma unroll
                for (int j = 0; j < 16; ++j) f[j] = Tm[(kc + j) * 65 + n] * sc;
                __builtin_nontemporal_store(mk4u(pk4_fp8(f[0], f[1], f[2], f[3]), pk4_fp8(f[4], f[5], f[6], f[7]), pk4_fp8(f[8], f[9], f[10], f[11]), pk4_fp8(f[12], f[13], f[14], f[15])), (u32x4*)(drow8 + k0 + kc)); }
        } else {
            bf16_t* drow = (bf16_t*)drow8 + k0;
#pragma unroll
            for (int s = 0; s < 4; ++s) { const int kc = ((tid & 7) + 8 * s) * 8; float f[8];
#pragma unroll
                for (int j = 0; j < 8; ++j) f[j] = Tm[(kc + j) * 65 + n];
                u32x4 w; w.x = pk2(f[0], f[1]); w.y = pk2(f[2], f[3]); w.z = pk2(f[4], f[5]); w.w = pk2(f[6], f[7]); *(u32x4*)(drow + kc) = w; }
        }
    }
    __syncthreads();
}

__device__ __forceinline__ void mod_item(LDSP unsigned char* lds, const Params& p, int item) {
    const int kb = item >> 6, nb = item & 63, tid = TIDX(), wid = tid >> 6, lane = tid & 63;
    f32x4 acc[3];
#pragma unroll
    for (int v = 0; v < 3; ++v) acc[v] = mk4f(0.f, 0.f, 0.f, 0.f);
    if (lane < 48) {
#pragma unroll 8
        for (int i = 0; i < 64; ++i) {
            const int k = kb * 512 + wid * 64 + i;
            const float c0 = p.c[k], c1 = p.c[D + k], c2 = p.c_ctx[k];
            const float s0 = c0 * sigmoidf_(c0), s1 = c1 * sigmoidf_(c1), s2 = c2 * sigmoidf_(c2);
            const f32x4 w = __builtin_nontemporal_load((const f32x4*)(p.w_mod + (size_t)k * 12288 + nb * 192 + 4 * lane));
            acc[0] += s0 * w; acc[1] += s1 * w; acc[2] += s2 * w;
        }
    }
    LDSP float* R = (LDSP float*)lds;
    if (lane < 48) {
#pragma unroll
        for (int v = 0; v < 3; ++v) *(LDSP f32x4*)(R + (wid * 3 + v) * 192 + 4 * lane) = acc[v];
    }
    __syncthreads();
    float* MODP = (float*)(p.ws + OFF_MODP);
    for (int o = tid; o < 3 * 192; o += 512) { const int v = o / 192, cidx = o - v * 192; float sum = 0.f;
#pragma unroll
        for (int w = 0; w < 8; ++w) sum += R[(w * 3 + v) * 192 + cidx];
        MODP[((size_t)kb * 3 + v) * 12288 + nb * 192 + cidx] = sum; }
    __syncthreads();
}

__device__ __forceinline__ void conv_range(LDSP unsigned char* lds, const Params& p, int g0, int g1, int rank, int nblk) {
    const int tid = TIDX();
    int g = g0 + rank;
    const float* csrc = nullptr; bf16_t* cdst = nullptr; int cN = 0, cld = 0, cmode = 0, ck0 = 0, cn0 = 0;
    const float* nsrc = nullptr; bf16_t* ndst = nullptr; int nN = 0, nld = 0, nmode = 0, nk0 = 0, nn0 = 0;
    f32x4 va[4][2], vb[4][2];
    if (g < g1) { conv_decode(p, g, csrc, cdst, cN, cld, cmode, ck0, cn0); conv_load(csrc, cN, ck0, cn0, va, tid); }
    __builtin_amdgcn_s_waitcnt(0);
#pragma unroll 1
    while (g < g1) {
        const int gn = g + nblk;
        if (gn < g1) { conv_decode(p, gn, nsrc, ndst, nN, nld, nmode, nk0, nn0); conv_load(nsrc, nN, nk0, nn0, vb, tid); }
        conv_finish(lds, cdst, cld, cmode, ck0, cn0, va, tid);
        cdst = ndst; cld = nld; cmode = nmode; ck0 = nk0; cn0 = nn0; g = gn;
#pragma unroll
        for (int s = 0; s < 4; ++s) { va[s][0] = vb[s][0]; va[s][1] = vb[s][1]; }
    }
}

__device__ __forceinline__ void phase0(LDSP unsigned char* lds, const Params& p) {
    const int tid = TIDX();
    for (int it = blockIdx.x; it < 256; it += gridDim.x) mod_item(lds, p, it);
    conv_range(lds, p, 0, CT1, blockIdx.x, gridDim.x);
    conv_range(lds, p, CT8, CT_END, blockIdx.x, gridDim.x);
    {
        const int total = 4 * 1024 * 128;
        for (int idx = blockIdx.x * 512 + tid; idx < total; idx += gridDim.x * 512) {
            const int mtx = idx >> 17, rem = idx & 131071, n = rem >> 7, k = rem & 127;
            const float* src = (mtx < 2 ? p.decay_up : p.iclr_up) + (size_t)(mtx & 1) * 96 * 1024;
            bf16_t* dst = (bf16_t*)(p.ws + (mtx < 2 ? OFF_WTDU : OFF_WTIU)) + (size_t)(mtx & 1) * 1024 * 128;
            dst[n * 128 + k] = (bf16_t)f2bf(k < 96 ? src[(size_t)k * 1024 + n] : 0.f);
        }
    }
    {
        float* WRT = (float*)(p.ws + OFF_WRT);
        for (int idx = blockIdx.x * 512 + tid; idx < D * NE; idx += gridDim.x * 512) WRT[(size_t)(idx & 63) * D + (idx >> 6)] = p.w_router[idx];
    }
    {
        u32x4* z = (u32x4*)((bf16_t*)(p.ws + OFF_WTIN) + (size_t)INC * D);
        const int total = (INP - INC) * D * 2 / 16;
        for (int idx = blockIdx.x * 512 + tid; idx < total; idx += gridDim.x * 512) z[idx] = mk4u(0, 0, 0, 0);
    }
    if (blockIdx.x == gridDim.x - 1) {
        float2* R = (float2*)(p.ws + OFF_ROPE);
        for (int idx = tid; idx < 1024; idx += 512) { const int pos = idx >> 4, f = idx & 15;
            const float freq = powf(10000.f, -(float)f / 16.f); const float ang = (float)pos * freq; R[idx] = make_float2(cosf(ang), sinf(ang)); }
    }
}

__device__ __forceinline__ void phase1(LDSP unsigned char* lds, const Params& p) {
    const int tid = TIDX(), wid = tid >> 6, lane = tid & 63;
    const float* MODP = (const float*)(p.ws + OFF_MODP);
    float* MOD = (float*)(p.ws + OFF_MOD);
    LDSP float* MV = (LDSP float*)lds;
#pragma unroll 8
    for (int idx = tid; idx < 3 * 4096; idx += 512) { const int v = idx >> 12, col = idx & 4095; float s = p.b_mod[col];
#pragma unroll
        for (int kb = 0; kb < 4; ++kb) s += MODP[((size_t)kb * 3 + v) * 12288 + col];
        MV[idx] = s; }
    for (int idx = blockIdx.x * 512 + tid; idx < 3 * 12288; idx += gridDim.x * 512) { const int v = idx / 12288, col = idx - v * 12288; float s = p.b_mod[col];
#pragma unroll
        for (int kb = 0; kb < 4; ++kb) s += MODP[((size_t)kb * 3 + v) * 12288 + col];
        MOD[idx] = s; }
    __syncthreads();
    bf16_t* HX = (bf16_t*)(p.ws + OFF_HX);
    {
        int row = blockIdx.x * 8 + wid;
        f32x4 xv[8], xn[8];
#pragma unroll
        for (int i = 0; i < 8; ++i) xv[i] = mk4f(0.f, 0.f, 0.f, 0.f);
        if (row < NR) { const float* src = row < NX ? p.x + (size_t)row * D : p.ctx + (size_t)(row - NX) * D;
#pragma unroll
            for (int i = 0; i < 8; ++i) xv[i] = ((const f32x4*)src)[lane + 64 * i]; }
#pragma unroll 1
        for (; row < NR; row += gridDim.x * 8) {
            const int nrow = row + gridDim.x * 8, lrow = nrow < NR ? nrow : row;
            { const float* src = lrow < NX ? p.x + (size_t)lrow * D : p.ctx + (size_t)(lrow - NX) * D;
#pragma unroll
              for (int i = 0; i < 8; ++i) xn[i] = __builtin_nontemporal_load((const f32x4*)src + lane + 64 * i); }
            const int v = row < NX ? (row >> 12) : 2;
            float ss = 0.f;
#pragma unroll
            for (int i = 0; i < 8; ++i) ss += xv[i].x * xv[i].x + xv[i].y * xv[i].y + xv[i].z * xv[i].z + xv[i].w * xv[i].w;
            ss = wave_sum(ss);
            const float rs = rsqrtf(ss * (1.f / D) + 1e-6f);
#pragma unroll
            for (int i = 0; i < 8; ++i) { const int col = 4 * (lane + 64 * i);
                const f32x4 g = *(const f32x4*)(p.norm1_g + col); const LDSP float* sh = MV + v * 4096 + col; const LDSP float* sc = sh + 2048;
                const float h0 = xv[i].x * rs * g.x * (1.f + sc[0]) + sh[0], h1 = xv[i].y * rs * g.y * (1.f + sc[1]) + sh[1];
                const float h2 = xv[i].z * rs * g.z * (1.f + sc[2]) + sh[2], h3 = xv[i].w * rs * g.w * (1.f + sc[3]) + sh[3];
                u32x2 w; w.x = pk2(h0, h1); w.y = pk2(h2, h3); *(u32x2*)(HX + (size_t)row * D + col) = w; }
#pragma unroll
            for (int i = 0; i < 8; ++i) xv[i] = xn[i];
        }
    }
}

#ifndef P2_CONV_TILES
#define P2_CONV_TILES (24 * 24)
#endif
__device__ __forceinline__ int p2_gemm_blocks(int grid) { return grid == 256 ? 232 : grid; }
__device__ __forceinline__ int p2_conv_end(int grid) { return grid == 256 ? CT1 + P2_CONV_TILES : CT1; }
__device__ __forceinline__ void phase2(LDSP unsigned char* lds, const Params& p) {
    pg8::Epi<FPX> epi{FPX{(bf16_t*)(p.ws + OFF_PX)}};
    const int ng = p2_gemm_blocks((int)gridDim.x);
    if ((int)blockIdx.x >= ng) { conv_range(lds, p, CT1, p2_conv_end((int)gridDim.x), (int)blockIdx.x - ng, (int)gridDim.x - ng); return; }
    pg8::DenseSched S{(const char*)(p.ws + OFF_HX), (const char*)(p.ws + OFF_WTIN), NR / 256, INP / 256, D, ng, (int)blockIdx.x};
    pg8::gemm_phase<false>(lds, D, S, epi);
}

__device__ __forceinline__ void phaseR1(LDSP unsigned char* lds, const Params& p) {
    const int tid = TIDX(), wid = tid >> 6, lane = tid & 63;
    const bf16_t* PX = (const bf16_t*)(p.ws + OFF_PX);
    for (int row = blockIdx.x * 8 + wid; row < NR; row += gridDim.x * 8) {
        const bool isx = row < NX;
        const int s0 = isx ? (row & ~(T - 1)) : NX + ((row - NX) & ~(CL - 1)), len = isx ? T : CL;
        const bool hp = row > s0, hn = row + 1 < s0 + len;
        const bf16_t* pc = PX + (size_t)row * INP;
        u32x4 cA[7], pA[7], nA[7];
        {
            const bf16_t* pp = hp ? pc - INP : pc; const bf16_t* pn = hn ? pc + INP : pc;
#pragma unroll
            for (int it = 0; it < 7; ++it) { const int chl = (lane + 64 * it < 440) ? lane + 64 * it : 439; cA[it] = *(const u32x4*)(pc + chl * 8); pA[it] = *(const u32x4*)(pp + chl * 8); nA[it] = *(const u32x4*)(pn + chl * 8); }
        }
        const unsigned pmask = hp ? 0xffffffffu : 0u, nmask = hn ? 0xffffffffu : 0u;
#pragma unroll
        for (int it = 0; it < 7; ++it) {
            const int ch = lane + 64 * it;
            if (ch < 440) {
                const int col = ch * 8;
                const u32x4 c4 = cA[it];
                const u32x4 p4 = mk4u(pA[it].x & pmask, pA[it].y & pmask, pA[it].z & pmask, pA[it].w & pmask), n4 = mk4u(nA[it].x & nmask, nA[it].y & nmask, nA[it].z & nmask, nA[it].w & nmask);
                const f32x4 m0 = *(const f32x4*)(p.shift_mu + col), m1 = *(const f32x4*)(p.shift_mu + col + 4);
                const float mu[8] = {m0.x, m0.y, m0.z, m0.w, m1.x, m1.y, m1.z, m1.w};
                const unsigned cw[4] = {c4.x, c4.y, c4.z, c4.w}, pw[4] = {p4.x, p4.y, p4.z, p4.w}, nw[4] = {n4.x, n4.y, n4.z, n4.w};
                float v[8];
#pragma unroll
                for (int j = 0; j < 4; ++j) {
                    const float c0 = bf2f(cw[j] & 0xffff), c1 = bf2f(cw[j] >> 16);
                    v[2 * j] = c0 + mu[2 * j] * (0.5f * (bf2f(pw[j] & 0xffff) + bf2f(nw[j] & 0xffff)) - c0);
                    v[2 * j + 1] = c1 + mu[2 * j + 1] * (0.5f * (bf2f(pw[j] >> 16) + bf2f(nw[j] >> 16)) - c1);
                }
                if (it < 2) {
                    *(u32x4*)((bf16_t*)(p.ws + OFF_RS) + (size_t)row * 1024 + col) = mk4u(pk2(v[0], v[1]), pk2(v[2], v[3]), pk2(v[4], v[5]), pk2(v[6], v[7]));
                } else if (it < 4) {
                    const int kc = col - C_K;
                    *(u32x4*)((bf16_t*)(p.ws + OFF_KS) + (size_t)row * 1024 + kc) = mk4u(pk2(v[0], v[1]), pk2(v[2], v[3]), pk2(v[4], v[5]), pk2(v[6], v[7]));
                    const f32x4 k0 = *(const f32x4*)(p.k_k + kc), k1 = *(const f32x4*)(p.k_k + kc + 4);
                    const float kq[8] = {k0.x, k0.y, k0.z, k0.w, k1.x, k1.y, k1.z, k1.w};
                    float ss = 0.f;
#pragma unroll
                    for (int j = 0; j < 8; ++j) { v[j] *= kq[j]; ss += v[j] * v[j]; }
                    ss += shx(ss, 1); ss += shx(ss, 2); ss += shx(ss, 4);
                    const float sc = rsqrtf(ss + 1e-12f);
                    *(u32x4*)((bf16_t*)(p.ws + OFF_KK) + (size_t)row * 1024 + kc) = mk4u(pk2(v[0] * sc, v[1] * sc), pk2(v[2] * sc, v[3] * sc), pk2(v[4] * sc, v[5] * sc), pk2(v[6] * sc, v[7] * sc));
                } else if (it < 6) {
                    *(u32x4*)((bf16_t*)(p.ws + OFF_VS) + (size_t)row * 1024 + col - C_V) = mk4u(pk2(v[0], v[1]), pk2(v[2], v[3]), pk2(v[4], v[5]), pk2(v[6], v[7]));
                } else if (ch < 396) {
#pragma unroll
                    for (int j = 0; j < 8; ++j) v[j] = tanhf(v[j]);
                    *(u32x4*)((bf16_t*)(p.ws + OFF_TW) + (size_t)row * 128 + col - C_XW) = mk4u(pk2(v[0], v[1]), pk2(v[2], v[3]), pk2(v[4], v[5]), pk2(v[6], v[7]));
                } else if (ch < 408) {
                    *(u32x4*)((bf16_t*)(p.ws + OFF_XA) + (size_t)row * 128 + col - C_XA) = mk4u(pk2(v[0], v[1]), pk2(v[2], v[3]), pk2(v[4], v[5]), pk2(v[6], v[7]));
                } else if (isx) {
#pragma unroll
                    for (int j = 0; j < 8; ++j) v[j] = sigmoidf_(v[j]);
                    *(u32x4*)((bf16_t*)(p.ws + OFF_SG) + (size_t)row * 256 + col - C_XG) = mk4u(pk2(v[0], v[1]), pk2(v[2], v[3]), pk2(v[4], v[5]), pk2(v[6], v[7]));
                }
            }
        }
        if (lane < 4) { *(u32x4*)((bf16_t*)(p.ws + OFF_TW) + (size_t)row * 128 + 96 + lane * 8) = mk4u(0, 0, 0, 0); *(u32x4*)((bf16_t*)(p.ws + OFF_XA) + (size_t)row * 128 + 96 + lane * 8) = mk4u(0, 0, 0, 0); }
    }
}

struct LoraSched {
    const char *A0, *B0, *A1, *B1; int G, c;
    __device__ __forceinline__ bool next(int i, pg8::Unit& u) const {
        const int per = (NR / 256) * 8; const long L = (long)i * G + c; if (L >= 2 * per) return false;
        const int job = (int)L / per, w = (int)L % per, pm = w >> 3, pn = w & 7;
        u.A = (job ? A1 : A0) + (size_t)pm * 256 * 128 * 2; u.B = (job ? B1 : B0) + (size_t)pn * 256 * 128 * 2; u.rowmap = nullptr; u.nvalid = 0; u.m0 = 0; u.row0 = pm * 256; u.col0 = pn * 256; u.pos0 = job;
        return true;
    }
};
struct FLORA { const float* dbias; const float* ibias; bf16_t* LWG; bf16_t* AIG; __device__ __forceinline__ void operator()(const pg8::Unit& u, int lr, int lc, f32x4 v0, f32x4 v1) const {
    const int row = u.row0 + lr, col = u.col0 + lc;
    const float* bp = (u.pos0 == 0 ? dbias : ibias) + col; const f32x4 b0 = *(const f32x4*)bp, b1 = *(const f32x4*)(bp + 4);
    const float sc = (u.pos0 == 0) ? -0.60653065971f : 1.f;
    float o[8];
#pragma unroll
    for (int e = 0; e < 4; ++e) { o[e] = sc * sigmoidf_(b0[e] + v0[e]); o[4 + e] = sc * sigmoidf_(b1[e] + v1[e]); }
    *(u32x4*)((u.pos0 == 0 ? LWG : AIG) + (size_t)row * 2048 + col) = mk4u(pk2(o[0], o[1]), pk2(o[2], o[3]), pk2(o[4], o[5]), pk2(o[6], o[7]));
} };
struct FGG { bf16_t* GG; __device__ __forceinline__ void operator()(const pg8::Unit& u, int lr, int lc, f32x4 v0, f32x4 v1) const {
    __builtin_nontemporal_store(mk4u(pk2(v0[0], v0[1]), pk2(v0[2], v0[3]), pk2(v1[0], v1[1]), pk2(v1[2], v1[3])), (u32x4*)(GG + (size_t)(u.row0 + lr) * 1024 + u.col0 + lc)); } };

struct EpiLORA {
    const float* dbias; const float* ibias; bf16_t* LWG; bf16_t* AIG;
    __device__ __forceinline__ void operator()(const f32x4 (&acc)[2][2][4][2], const pg8::Unit& u, int wr, int wc, int fr, int fq) const {
        { const int lane = TIDX() & 63; fr = lane & 15; fq = lane >> 4; }
        const bool job0 = (u.pos0 == 0);
        const float sc = job0 ? -0.60653065971f : 1.f;
        const float* bias = job0 ? dbias : ibias; bf16_t* out = job0 ? LWG : AIG;
        f32x4 bb[2][2];
#pragma unroll
        for (int bj = 0; bj < 2; ++bj) { const float* bp = bias + u.col0 + 128 * bj + 32 * wc + 8 * fq; bb[bj][0] = *(const f32x4*)bp; bb[bj][1] = *(const f32x4*)(bp + 4); }
#pragma unroll
        for (int ai = 0; ai < 2; ++ai)
#pragma unroll
            for (int m = 0; m < 4; ++m)
#pragma unroll
                for (int bj = 0; bj < 2; ++bj) {
                    const int row = u.row0 + 128 * ai + 64 * wr + 16 * m + fr, col = u.col0 + 128 * bj + 32 * wc + 8 * fq;
                    const f32x4 v0 = acc[ai][bj][m][0], v1 = acc[ai][bj][m][1];
                    float o[8];
#pragma unroll
                    for (int e = 0; e < 4; ++e) { o[e] = sc * sigmoidf_(bb[bj][0][e] + v0[e]); o[4 + e] = sc * sigmoidf_(bb[bj][1][e] + v1[e]); }
                    *(u32x4*)(out + (size_t)row * 2048 + col) = mk4u(pk2(o[0], o[1]), pk2(o[2], o[3]), pk2(o[4], o[5]), pk2(o[6], o[7]));
                    __builtin_amdgcn_sched_barrier(0);
                }
    }
};
struct EpiX1 {
    const float* x; const float* mod; float* X1; float sc;
    __device__ __forceinline__ void operator()(const f32x4 (&acc)[2][2][4][2], const pg8::Unit& u, int wr, int wc, int fr, int fq) const {
        { const int lane = TIDX() & 63; fr = lane & 15; fq = lane >> 4; }
        f32x4 gt[2][2];
#pragma unroll
        for (int bj = 0; bj < 2; ++bj) { const float* gp = mod + (size_t)(u.row0 >> 12) * 12288 + 2 * D + u.col0 + 128 * bj + 32 * wc + 8 * fq; gt[bj][0] = *(const f32x4*)gp * sc; gt[bj][1] = *(const f32x4*)(gp + 4) * sc; }
#pragma unroll
        for (int ai = 0; ai < 2; ++ai) {
            f32x4 xs[4][2][2];
#pragma unroll
            for (int m = 0; m < 4; ++m)
#pragma unroll
                for (int bj = 0; bj < 2; ++bj) { const float* xp = x + (size_t)(u.row0 + 128 * ai + 64 * wr + 16 * m + fr) * D + u.col0 + 128 * bj + 32 * wc + 8 * fq; xs[m][bj][0] = *(const f32x4*)xp; xs[m][bj][1] = *(const f32x4*)(xp + 4); }
            __builtin_amdgcn_sched_barrier(0);
#pragma unroll
            for (int m = 0; m < 4; ++m)
#pragma unroll
                for (int bj = 0; bj < 2; ++bj) { float* op = X1 + (size_t)(u.row0 + 128 * ai + 64 * wr + 16 * m + fr) * D + u.col0 + 128 * bj + 32 * wc + 8 * fq;
                    *(f32x4*)op = xs[m][bj][0] + gt[bj][0] * acc[ai][bj][m][0]; *(f32x4*)(op + 4) = xs[m][bj][1] + gt[bj][1] * acc[ai][bj][m][1]; }
            __builtin_amdgcn_sched_barrier(0);
        }
    }
};

__device__ __forceinline__ int inst_index(int b, int h, int d, int chunk) { return ((b * 16 + h) * 2 + d) * NCHUNK + chunk; }

constexpr int LA_K = 0  , LA_VT = 73728  , LA_END = LA_VT + 18 * 4608;
static_assert(LA_END <= SMEM_BYTES, "attention LDS map");

__device__ __forceinline__ void attn_unit(LDSP unsigned char* lds, const Params& p, int unit) {
    const int tid = TIDX(), wid = tid >> 6, lane = tid & 63;
    const int b = unit >> 8, kvh = (unit >> 6) & 3, qb = unit & 63, q0 = qb * 64;
    const bf16_t* PX = (const bf16_t*)(p.ws + OFF_PX);
    const float2* ROPE = (const float2*)(p.ws + OFF_ROPE);
    {
        u32x4 kx1[5], kx2[5];
#pragma unroll
        for (int it = 0; it < 5; ++it) {
            const int task = tid + 512 * it; kx1[it] = mk4u(0, 0, 0, 0); kx2[it] = mk4u(0, 0, 0, 0);
            if (task < 576 * 4) {
                const int key = task >> 2, pr = task & 3, c0 = (pr & 1) + 4 * (pr >> 1);
                const int pos = q0 - 128 + key;
                const bool lat = key < 320;
                if (!lat || (pos >= 0 && pos < T)) {
                    const bf16_t* src = PX + (size_t)(lat ? (b * T + pos) : (NX + b * CL + (key - 320))) * INP + C_AK + kvh * 64 + c0 * 8;
                    kx1[it] = *(const u32x4*)src; kx2[it] = *(const u32x4*)(src + 16);
                }
            }
        }
#pragma unroll
        for (int it = 0; it < 5; ++it) {
            const int task = tid + 512 * it;
            if (task < 576 * 4) {
                const int key = task >> 2, pr = task & 3, c0 = (pr & 1) + 4 * (pr >> 1);
                u32x4 w0 = kx1[it], w1 = kx2[it];
                if (key < 320) {
                    const int pos = q0 - 128 + key;
                    if (pos >= 0 && pos < T) {
                        const int ppos = (pr < 2) ? (pos >> 6) : (pos & 63);
                        const float2* tb = ROPE + ppos * 16 + (pr & 1) * 8;
                        const unsigned a1[4] = {w0.x, w0.y, w0.z, w0.w}, a2[4] = {w1.x, w1.y, w1.z, w1.w};
                        unsigned o1[4], o2[4];
#pragma unroll
                        for (int j = 0; j < 4; ++j) {
                            const float2 cs0 = tb[2 * j], cs1 = tb[2 * j + 1];
                            const float u0 = bf2f(a1[j] & 0xffff), u1 = bf2f(a1[j] >> 16), v0 = bf2f(a2[j] & 0xffff), v1 = bf2f(a2[j] >> 16);
                            o1[j] = pk2(u0 * cs0.x - v0 * cs0.y, u1 * cs1.x - v1 * cs1.y);
                            o2[j] = pk2(v0 * cs0.x + u0 * cs0.y, v1 * cs1.x + u1 * cs1.y);
                        }
                        w0 = mk4u(o1[0], o1[1], o1[2], o1[3]); w1 = mk4u(o2[0], o2[1], o2[2], o2[3]);
                    }
                }
                *(LDSP u32x4*)(lds + LA_K + sw64(key, c0 * 8)) = w0;
                *(LDSP u32x4*)(lds + LA_K + sw64(key, c0 * 8 + 16)) = w1;
            }
        }
    }
    {
        u32x4 vx[3][4];
#pragma unroll
        for (int it = 0; it < 3; ++it) {
            const int task = tid + 512 * it;
#pragma unroll
            for (int q = 0; q < 4; ++q) {
                vx[it][q] = mk4u(0, 0, 0, 0);
                if (task < 144 * 8) {
                    const int kg = task >> 3, dc = task & 7, key = kg * 4 + q;
                    if (key < 320) { const int pos = q0 - 128 + key; if (pos >= 0 && pos < T) vx[it][q] = *(const u32x4*)(PX + (size_t)(b * T + pos) * INP + C_AV + kvh * 64 + dc * 8); }
                    else vx[it][q] = *(const u32x4*)(PX + (size_t)(NX + b * CL + (key - 320)) * INP + C_AV + kvh * 64 + dc * 8);
                }
            }
        }
#pragma unroll
        for (int it = 0; it < 3; ++it) {
            const int task = tid + 512 * it;
            if (task < 144 * 8) {
                const int kg = task >> 3, dc = task & 7;
                unsigned short e[4][8];
#pragma unroll
                for (int q = 0; q < 4; ++q) { const u32x4 w = vx[it][q];
                    e[q][0] = w.x & 0xffff; e[q][1] = w.x >> 16; e[q][2] = w.y & 0xffff; e[q][3] = w.y >> 16; e[q][4] = w.z & 0xffff; e[q][5] = w.z >> 16; e[q][6] = w.w & 0xffff; e[q][7] = w.w >> 16; }
                const int tile = kg >> 3, kin = (kg & 7) * 4;
#pragma unroll
                for (int j = 0; j < 8; ++j) { u32x2 w; w.x = (unsigned)e[0][j] | ((unsigned)e[1][j] << 16); w.y = (unsigned)e[2][j] | ((unsigned)e[3][j] << 16);
                    *(LDSP u32x2*)(lds + LA_VT + tile * 4608 + (dc * 8 + j) * 72 + kin * 2) = w; }
            }
        }
    }
    const int hq = kvh * 4 + (wid >> 1), qs = (wid & 1) * 32, r = lane & 31, hh = lane >> 5;
    const int qpos = q0 + qs + r;
    bf16x8 qf[4];
    {
        const bf16_t* src = PX + (size_t)(b * T + qpos) * INP + C_Q + hq * 64 + 8 * hh;
        u32x4 raw[4];
#pragma unroll
        for (int s = 0; s < 4; ++s) raw[s] = *(const u32x4*)(src + 16 * s);
#pragma unroll
        for (int pr = 0; pr < 2; ++pr) {
            const int ppos = pr == 0 ? (qpos >> 6) : (qpos & 63);
            const float2* tb = ROPE + ppos * 16 + 8 * hh;
            const unsigned a1[4] = {raw[2 * pr].x, raw[2 * pr].y, raw[2 * pr].z, raw[2 * pr].w}, a2[4] = {raw[2 * pr + 1].x, raw[2 * pr + 1].y, raw[2 * pr + 1].z, raw[2 * pr + 1].w};
            unsigned o1[4], o2[4];
#pragma unroll
            for (int j = 0; j < 4; ++j) {
                const float2 cs0 = tb[2 * j], cs1 = tb[2 * j + 1];
                const float u0 = bf2f(a1[j] & 0xffff), u1 = bf2f(a1[j] >> 16), v0 = bf2f(a2[j] & 0xffff), v1 = bf2f(a2[j] >> 16);
                o1[j] = pk2(0.18033688f * (u0 * cs0.x - v0 * cs0.y), 0.18033688f * (u1 * cs1.x - v1 * cs1.y));
                o2[j] = pk2(0.18033688f * (v0 * cs0.x + u0 * cs0.y), 0.18033688f * (v1 * cs1.x + u1 * cs1.y));
            }
            const u32x4 w1 = mk4u(o1[0], o1[1], o1[2], o1[3]), w2 = mk4u(o2[0], o2[1], o2[2], o2[3]);
            qf[2 * pr] = __builtin_bit_cast(bf16x8, w1); qf[2 * pr + 1] = __builtin_bit_cast(bf16x8, w2);
        }
    }
    __syncthreads();
    float m = p.attn_sink[hq] * 1.44269504f, l = 1.f;
    f32x16 o0 = zero16(), o1 = zero16();
    f32x16 st = zero16();
#pragma unroll
    for (int s = 0; s < 4; ++s) st = __builtin_amdgcn_mfma_f32_32x32x16_bf16(*(const LDSP bf16x8*)(lds + LA_K + sw64(r, 16 * s + 8 * hh)), qf[s], st, 0, 0, 0);
#pragma unroll 1
    for (int tl = 0; tl < 18; ++tl) {
        f32x16 stn = zero16();
        { const int tn = (tl + 1 < 18) ? tl + 1 : 17;
#pragma unroll
          for (int s = 0; s < 4; ++s) stn = __builtin_amdgcn_mfma_f32_32x32x16_bf16(*(const LDSP bf16x8*)(lds + LA_K + sw64(32 * tn + r, 16 * s + 8 * hh)), qf[s], stn, 0, 0, 0); }
        bf16x8 vfr[2][2];
#pragma unroll
        for (int s2 = 0; s2 < 2; ++s2)
#pragma unroll
            for (int dm = 0; dm < 2; ++dm) {
                const LDSP unsigned char* vp = lds + LA_VT + tl * 4608 + (32 * dm + r) * 72 + (16 * s2 + 4 * hh) * 2;
                const u32x2 v0 = *(const LDSP u32x2*)vp, v1 = *(const LDSP u32x2*)(vp + 16);
                vfr[s2][dm] = __builtin_bit_cast(bf16x8, mk4u(v0.x, v0.y, v1.x, v1.y)); }
        const int kp0 = q0 - 128 + 32 * tl, qlo = q0 + qs;
        if (tl < 10 && (qlo + 31 - kp0 > 128 || qlo - (kp0 + 31) < -128 || kp0 < 0 || kp0 + 31 >= T)) {
#pragma unroll
            for (int g = 0; g < 16; ++g) { const int kp = q0 - 128 + 32 * tl + crow(g, hh); const int dlt = qpos - kp;
                const bool ok = (dlt <= 128) && (dlt >= -128) && (kp >= 0) && (kp < T); st[g] = ok ? st[g] : -1e30f; }
        }
        float t8[8];
#pragma unroll
        for (int g = 0; g < 8; ++g) t8[g] = fmaxf(st[g], st[g + 8]);
        float mt = fmaxf(fmaxf(fmaxf(t8[0], t8[4]), fmaxf(t8[1], t8[5])), fmaxf(fmaxf(t8[2], t8[6]), fmaxf(t8[3], t8[7])));
        mt = fmaxf(mt, shx(mt, 32));
        float alpha = 1.f;
        if (__any(mt > m + 8.f)) { const float mn = fmaxf(m, mt); alpha = __builtin_amdgcn_exp2f(m - mn); m = mn; }
        const float mn = m;
#pragma unroll
        for (int g = 0; g < 16; ++g) st[g] = __builtin_amdgcn_exp2f(st[g] - mn);
#pragma unroll
        for (int g = 0; g < 8; ++g) t8[g] = st[g] + st[g + 8];
        float ps = ((t8[0] + t8[4]) + (t8[1] + t8[5])) + ((t8[2] + t8[6]) + (t8[3] + t8[7]));
        ps += shx(ps, 32);
        l = l * alpha + ps;
        if (__any(alpha != 1.f)) {
#pragma unroll
            for (int g = 0; g < 16; ++g) { o0[g] *= alpha; o1[g] *= alpha; }
        }
#pragma unroll
        for (int s2 = 0; s2 < 2; ++s2) {
            const u32x4 pw = mk4u(pk2(st[8 * s2], st[8 * s2 + 1]), pk2(st[8 * s2 + 2], st[8 * s2 + 3]), pk2(st[8 * s2 + 4], st[8 * s2 + 5]), pk2(st[8 * s2 + 6], st[8 * s2 + 7]));
            const bf16x8 pf = __builtin_bit_cast(bf16x8, pw);
            o0 = __builtin_amdgcn_mfma_f32_32x32x16_bf16(vfr[s2][0], pf, o0, 0, 0, 0);
            o1 = __builtin_amdgcn_mfma_f32_32x32x16_bf16(vfr[s2][1], pf, o1, 0, 0, 0);
        }
        st = stn;
    }
    {
        const float inv = 1.f / l;
        unsigned char* dst = p.ws + OFF_MIX + (size_t)(b * T + qpos) * D + 1024 + hq * 64;
        unsigned da[4], db[4];
#pragma unroll
        for (int gq = 0; gq < 4; ++gq) {
            da[gq] = pk4_fp8(o0[4 * gq] * inv, o0[4 * gq + 1] * inv, o0[4 * gq + 2] * inv, o0[4 * gq + 3] * inv);
            db[gq] = pk4_fp8(o1[4 * gq] * inv, o1[4 * gq + 1] * inv, o1[4 * gq + 2] * inv, o1[4 * gq + 3] * inv);
        }
        *(u32x4*)(dst + 16 * hh) = widen32(da[0], da[1], da[2], da[3]);
        *(u32x4*)(dst + 32 + 16 * hh) = widen32(db[0], db[1], db[2], db[3]);
    }
    __syncthreads();
}

__device__ __forceinline__ unsigned ho_xcc_id() { return (unsigned)__builtin_amdgcn_s_getreg((3 << 11) | 20) & 0xFu; }
__device__ __forceinline__ unsigned* ho_slot(const Params& p, int slot) { return (unsigned*)(p.ws + OFF_CTL + 16384 + 1280 + slot * 1152); }
__device__ __forceinline__ void ho_arrive(LDSP unsigned char* lds, const Params& p, int slot) {
    const unsigned pk = *(volatile LDSP unsigned*)(lds + SMEM_BYTES - 16), nloc = pk & 0xffffu;
    unsigned* hc = ho_slot(p, slot);
    const unsigned old = __hip_atomic_fetch_add(hc + 16 + 16 * ho_xcc_id(), 1u, __ATOMIC_RELAXED, __HIP_MEMORY_SCOPE_AGENT);
    if (old + 1u == nloc) {
        __builtin_amdgcn_fence(__ATOMIC_RELEASE, "agent"); asm volatile("s_waitcnt vmcnt(0)" ::: "memory");
        __hip_atomic_fetch_add(hc, 1u, __ATOMIC_RELAXED, __HIP_MEMORY_SCOPE_AGENT);
    }
}
__device__ __forceinline__ void ho_wait(LDSP unsigned char* lds, const Params& p, int slot) {
    unsigned* hc = ho_slot(p, slot);
    const unsigned nx = (unsigned)__builtin_amdgcn_readfirstlane((int)(*(volatile LDSP unsigned*)(lds + SMEM_BYTES - 16) >> 16));
    unsigned sp = 0;
    while ((unsigned)__builtin_amdgcn_readfirstlane((int)__hip_atomic_load(hc, __ATOMIC_RELAXED, __HIP_MEMORY_SCOPE_AGENT)) < nx && ++sp < (1u << 22)) __builtin_amdgcn_s_sleep(2);
    __builtin_amdgcn_fence(__ATOMIC_ACQUIRE, "agent");
    asm volatile("s_waitcnt vmcnt(0)" ::: "memory");
}
__device__ __forceinline__ void phaseR2(LDSP unsigned char* lds, const Params& p) {
    {
        EpiLORA epi{p.decay_bias, p.iclr_bias, (bf16_t*)(p.ws + OFF_LWG), (bf16_t*)(p.ws + OFF_AIG)};
        LoraSched S{(const char*)(p.ws + OFF_TW), (const char*)(p.ws + OFF_WTDU), (const char*)(p.ws + OFF_XA), (const char*)(p.ws + OFF_WTIU), (int)gridDim.x, (int)blockIdx.x};
        pg8::gemm_phase<false>(lds, opaque_s(128), S, epi);
    }
    {
        pg8::Epi<FGG> epi{FGG{(bf16_t*)(p.ws + OFF_GG)}};
        pg8::DenseSched S{(const char*)(p.ws + OFF_SG), (const char*)(p.ws + OFF_WTGU), NX / 256, 1024 / 256, 256, (int)gridDim.x, (int)(gridDim.x - 1 - blockIdx.x)};
        pg8::gemm_phase<false>(lds, opaque_s(256), S, epi);
    }
    asm volatile("s_waitcnt vmcnt(0)" ::: "memory");
    __syncthreads();
    if (TIDX() == 0) ho_arrive(lds, p, 1);
}

constexpr int G_RT = 0, G_VT = 8192, G_X0 = 16384, G_AT = 32768, G_BT = 40960, G_KT = 49152, G_P0 = 57344, G_PT0 = 65536, G_SEG = 73728, G_GL = 74752, G_CNT = 75008, G_BYTES = 79872;
static_assert(2 * G_BYTES <= SMEM_BYTES - 16, "two R3 groups fit the LDS");

__device__ __forceinline__ void gbar(LDSP unsigned* cnt, unsigned& target, int lane) {
    target += 4u;
    asm volatile("s_waitcnt lgkmcnt(0)" ::: "memory");
    if (lane == 0) {
        __hip_atomic_fetch_add(cnt, 1u, __ATOMIC_RELAXED, __HIP_MEMORY_SCOPE_WORKGROUP);
        while (__hip_atomic_load(cnt, __ATOMIC_RELAXED, __HIP_MEMORY_SCOPE_WORKGROUP) < target) __builtin_amdgcn_s_sleep(1);
    }
    asm volatile("" ::: "memory");
}
__device__ __forceinline__ void mask_lt(f32x16& c, int x0, int y, int hh, bool incl) {
#pragma unroll
    for (int g = 0; g < 16; ++g) { const int x = x0 + crow(g, hh); c[g] = (incl ? (x <= y) : (x < y)) ? c[g] : 0.f; }
}

__device__ __forceinline__ void ldf(const unsigned (&FO)[4], unsigned off, bf16x8 (&f)[4]) {
#pragma unroll
    for (int s = 0; s < 4; ++s) f[s] = *LDS_AT(const bf16x8, FO[s] + off);
}
__device__ __forceinline__ void stt(const unsigned (&SO)[4], unsigned off, int xh, const f32x16& acc) {
#pragma unroll
    for (int gq = 0; gq < 4; ++gq) *LDS_AT(u32x2, (SO[gq] ^ ((unsigned)xh << 6)) + off) = mk2u(pk2(acc[4 * gq], acc[4 * gq + 1]), pk2(acc[4 * gq + 2], acc[4 * gq + 3]));
}
__device__ __forceinline__ u32x2 ld8(const unsigned (&SO)[4], int gq, unsigned off, int xh) { return *LDS_AT(const u32x2, (SO[gq] ^ ((unsigned)xh << 6)) + off); }

__device__ __forceinline__ void pack_op(const f32x16& t, bf16x8 (&o)[2]) {
#pragma unroll
    for (int s2 = 0; s2 < 2; ++s2) o[s2] = __builtin_bit_cast(bf16x8, mk4u(pk2(t[8 * s2], t[8 * s2 + 1]), pk2(t[8 * s2 + 2], t[8 * s2 + 3]), pk2(t[8 * s2 + 4], t[8 * s2 + 5]), pk2(t[8 * s2 + 6], t[8 * s2 + 7])));
}
__device__ __forceinline__ void rwkv_prep_group(LDSP unsigned char* lg, LDSP unsigned* cnt, unsigned& bt, const Params& p, int unit, int wg_in, int lane_in, const unsigned (&FO)[4], const unsigned (&SO)[4]) {
    int seq, c, h, d;
    if (unit < 4096) { seq = unit >> 11; c = (unit >> 5) & 63; h = (unit >> 1) & 15; d = unit & 1; } else { const int u = unit - 4096; seq = 2 + (u >> 7); c = (u >> 5) & 3; h = (u >> 1) & 15; d = u & 1; }
    const bool isx = seq < 2;
    const int b = seq & 1;
    const int s0 = isx ? b * T : NX + b * CL, t0 = c * 64;
    const int chunk_id = isx ? 4 + c : c;
    u32x4 keep_bh[2], keep_kh[2];
#define STAGE_IDS const int lane = opaque(lane_in), wg = opaque(wg_in), r = lane & 31, hh = lane >> 5; (void)r; (void)hh; (void)wg;
    {
        STAGE_IDS
        const int k = lane, seg = wg, hk = h * 64 + k;
        const float kac = p.k_a[hk];
        const bf16_t* RS = (const bf16_t*)(p.ws + OFF_RS); const bf16_t* KS = (const bf16_t*)(p.ws + OFF_KS); const bf16_t* KKp = (const bf16_t*)(p.ws + OFF_KK); const bf16_t* VS = (const bf16_t*)(p.ws + OFF_VS);
        const bf16_t* LWG = (const bf16_t*)(p.ws + OFF_LWG); const bf16_t* AIG = (const bf16_t*)(p.ws + OFF_AIG);
        const int ibase = seg * 16;
        const int rowA = (s0 + t0) + (d ? 63 - ibase : ibase);
        const int sgn = d ? -1 : 1;
        const unsigned o1 = ((unsigned)rowA * 1024u + (unsigned)hk) * 2u, o2 = ((unsigned)rowA * 2048u + (unsigned)(d * 1024 + hk)) * 2u;
        const int st1 = sgn * 2048, st2 = sgn * 4096;
#define LD16(base, off) bf2f(*(const bf16_t*)((const char*)(base) + (unsigned)(off)))
        unsigned short rlw[16], rrr[16], rkr[16], rkk[16], rvv[16], rai[16];
#pragma unroll
        for (int tt = 0; tt < 16; ++tt) rlw[tt] = *(const bf16_t*)((const char*)LWG + (unsigned)(o2 + tt * st2));
#pragma unroll
        for (int tt = 0; tt < 16; ++tt) { rrr[tt] = *(const bf16_t*)((const char*)RS + (unsigned)(o1 + tt * st1)); rkr[tt] = *(const bf16_t*)((const char*)KS + (unsigned)(o1 + tt * st1));
            rkk[tt] = *(const bf16_t*)((const char*)KKp + (unsigned)(o1 + tt * st1)); rvv[tt] = *(const bf16_t*)((const char*)VS + (unsigned)(o1 + tt * st1)); rai[tt] = *(const bf16_t*)((const char*)AIG + (unsigned)(o2 + tt * st2)); }
        float lw[16];
        float run = 0.f;
#pragma unroll
        for (int tt = 0; tt < 16; ++tt) { run += bf2f(rlw[tt]); lw[tt] = run; }
        LDSP float* SEG = (LDSP float*)(lg + G_SEG);
        SEG[seg * 64 + k] = run;
        gbar(cnt, bt, lane);
        float off = 0.f, gL = 0.f;
#pragma unroll
        for (int s = 0; s < 4; ++s) { const float sv = SEG[s * 64 + k]; if (s < seg) off += sv; gL += sv; }
        if (seg == 0) ((LDSP float*)(lg + G_GL))[k] = gL;
        const float egL = __expf(gL);
#pragma unroll
        for (int q = 0; q < 2; ++q) {
            float rr[8], kr[8], kk[8], vv[8], ai[8];
#pragma unroll
            for (int e = 0; e < 8; ++e) { const int tt = 8 * q + e;
                rr[e] = bf2f(rrr[tt]); kr[e] = bf2f(rkr[tt]); kk[e] = bf2f(rkk[tt]); vv[e] = bf2f(rvv[tt]); ai[e] = bf2f(rai[tt]); }
            unsigned wat[4], wbh[4], wkh[4], wv[4];
#pragma unroll
            for (int t2 = 0; t2 < 4; ++t2) {
                const int i0 = ibase + 8 * q + 2 * t2;
                float fat[2], frt[2], fbt[2], fkt[2], fbh[2], fkh[2];
#pragma unroll
                for (int e2 = 0; e2 < 2; ++e2) { const int e = 2 * t2 + e2, tt = 8 * q + e;
                    const float kd = kr[e] * (1.f + (ai[e] - 1.f) * kac), bbv = kk[e] * ai[e];
                    const float g = off + lw[tt], ge = (tt == 0) ? off : off + lw[tt - 1];
                    const float eg = __expf(g), ege = __expf(ge), eng = __builtin_amdgcn_rcpf(eg), egl = egL * eng;
                    fat[e2] = -kk[e] * ege; frt[e2] = rr[e] * eg; fbt[e2] = bbv * eng; fkt[e2] = kd * eng; fbh[e2] = bbv * egl; fkh[e2] = kd * egl; }
                wat[t2] = pk2(fat[0], fat[1]); wbh[t2] = pk2(fbh[0], fbh[1]); wkh[t2] = pk2(fkh[0], fkh[1]); wv[t2] = pk2(vv[2 * t2], vv[2 * t2 + 1]);
                const unsigned wr = pk2(frt[0], frt[1]), wb = pk2(fbt[0], fbt[1]), wk = pk2(fkt[0], fkt[1]);
                *(LDSP bf16_t*)(lg + G_AT + sw64(i0, k)) = (bf16_t)(wat[t2] & 0xffffu); *(LDSP bf16_t*)(lg + G_AT + sw64(i0 + 1, k)) = (bf16_t)(wat[t2] >> 16);
                *(LDSP bf16_t*)(lg + G_RT + sw64(i0, k)) = (bf16_t)(wr & 0xffffu);      *(LDSP bf16_t*)(lg + G_RT + sw64(i0 + 1, k)) = (bf16_t)(wr >> 16);
                *(LDSP bf16_t*)(lg + G_BT + sw64(i0, k)) = (bf16_t)(wb & 0xffffu);      *(LDSP bf16_t*)(lg + G_BT + sw64(i0 + 1, k)) = (bf16_t)(wb >> 16);
                *(LDSP bf16_t*)(lg + G_KT + sw64(i0, k)) = (bf16_t)(wk & 0xffffu);      *(LDSP bf16_t*)(lg + G_KT + sw64(i0 + 1, k)) = (bf16_t)(wk >> 16);
            }
            *(LDSP u32x4*)(lg + G_X0 + sw64(k, ibase + 8 * q)) = mk4u(wat[0], wat[1], wat[2], wat[3]);
            *(LDSP u32x4*)(lg + G_VT + sw64(k, ibase + 8 * q)) = mk4u(wv[0], wv[1], wv[2], wv[3]);
            keep_bh[q] = mk4u(wbh[0], wbh[1], wbh[2], wbh[3]); keep_kh[q] = mk4u(wkh[0], wkh[1], wkh[2], wkh[3]);
            __builtin_amdgcn_sched_barrier(0);
        }
#undef LD16
    }
    gbar(cnt, bt, lane_in);
    {
        STAGE_IDS
        const int cb = wg;
        bf16x8 PT00[2], PT01[2], PT11[2], Z00[2], Z10[2], Z11[2];
        f32x16 X0 = zero16(), X1 = zero16();
        {
            bf16x8 fA0[4], fA1[4];
            ldf(FO, G_AT, fA0); ldf(FO, G_AT + 4096, fA1);
            if (cb >= 2) {
                const int vb = cb - 2;
                bf16x8 fK[4];
                ldf(FO, G_KT, fK);
#pragma unroll
                for (int q = 0; q < 3; ++q) {
                    const int jb = (q == 2) ? 1 : 0, ib = (q == 0) ? 0 : 1;
                    if (q == 2) { __builtin_amdgcn_sched_barrier(0); ldf(FO, G_KT + 4096, fK); }
                    f32x16 t = zero16();
#pragma unroll
                    for (int s4 = 0; s4 < 4; ++s4) t = __builtin_amdgcn_mfma_f32_32x32x16_bf16(fK[s4], ib ? fA1[s4] : fA0[s4], t, 0, 0, 0);
                    if (jb == ib) mask_lt(t, 0, r, hh, false);
                    bf16x8 af[2]; pack_op(t, af);
#pragma unroll
                    for (int s2 = 0; s2 < 2; ++s2) {
                        const u32x2 v0 = ld8(SO, 2 * s2, G_VT + 4096 * vb, jb), v1 = ld8(SO, 2 * s2 + 1, G_VT + 4096 * vb, jb);
                        const bf16x8 bv = __builtin_bit_cast(bf16x8, mk4u(v0.x, v0.y, v1.x, v1.y));
                        if (ib) X1 = __builtin_amdgcn_mfma_f32_32x32x16_bf16(af[s2], bv, X1, 0, 0, 0); else X0 = __builtin_amdgcn_mfma_f32_32x32x16_bf16(af[s2], bv, X0, 0, 0, 0);
                    }
                }
            } else {
#pragma unroll
                for (int gq = 0; gq < 4; ++gq) { const u32x2 w0 = ld8(SO, gq, G_X0 + 4096 * cb, 0), w1 = ld8(SO, gq, G_X0 + 4096 * cb, 1);
                    X0[4 * gq] = bf2f(w0.x & 0xffff); X0[4 * gq + 1] = bf2f(w0.x >> 16); X0[4 * gq + 2] = bf2f(w0.y & 0xffff); X0[4 * gq + 3] = bf2f(w0.y >> 16);
                    X1[4 * gq] = bf2f(w1.x & 0xffff); X1[4 * gq + 1] = bf2f(w1.x >> 16); X1[4 * gq + 2] = bf2f(w1.y & 0xffff); X1[4 * gq + 3] = bf2f(w1.y >> 16); }
            }
            __builtin_amdgcn_sched_barrier(0);
            {
                bf16x8 fB[4];
                ldf(FO, G_BT, fB);
                f32x16 c1 = zero16(), c2 = zero16();
#pragma unroll
                for (int t = 0; t < 4; ++t) { c1 = __builtin_amdgcn_mfma_f32_32x32x16_bf16(fB[t], fA0[t], c1, 0, 0, 0); c2 = __builtin_amdgcn_mfma_f32_32x32x16_bf16(fA0[t], fB[t], c2, 0, 0, 0); }
                mask_lt(c1, 0, r, hh, false);
#pragma unroll
                for (int g = 0; g < 16; ++g) c2[g] = (r < crow(g, hh)) ? c2[g] : 0.f;
                pack_op(c1, PT00); pack_op(c2, Z00);
                c1 = zero16(); c2 = zero16();
#pragma unroll
                for (int t = 0; t < 4; ++t) { c1 = __builtin_amdgcn_mfma_f32_32x32x16_bf16(fB[t], fA1[t], c1, 0, 0, 0); c2 = __builtin_amdgcn_mfma_f32_32x32x16_bf16(fA1[t], fB[t], c2, 0, 0, 0); }
                pack_op(c1, PT01); pack_op(c2, Z10);
                __builtin_amdgcn_sched_barrier(0);
                ldf(FO, G_BT + 4096, fB);
                c1 = zero16(); c2 = zero16();
#pragma unroll
                for (int t = 0; t < 4; ++t) { c1 = __builtin_amdgcn_mfma_f32_32x32x16_bf16(fB[t], fA1[t], c1, 0, 0, 0); c2 = __builtin_amdgcn_mfma_f32_32x32x16_bf16(fA1[t], fB[t], c2, 0, 0, 0); }
                mask_lt(c1, 0, r, hh, false);
#pragma unroll
                for (int g = 0; g < 16; ++g) c2[g] = (r < crow(g, hh)) ? c2[g] : 0.f;
                pack_op(c1, PT11); pack_op(c2, Z11);
            }
        }
        __builtin_amdgcn_sched_barrier(0);
#pragma unroll 1
        for (int s = 0; s < 6; ++s) {
            bf16x8 x0[2], x1[2]; pack_op(X0, x0); pack_op(X1, x1);
#pragma unroll
            for (int s2 = 0; s2 < 2; ++s2) { X0 = __builtin_amdgcn_mfma_f32_32x32x16_bf16(PT00[s2], x0[s2], X0, 0, 0, 0); X1 = __builtin_amdgcn_mfma_f32_32x32x16_bf16(PT01[s2], x0[s2], X1, 0, 0, 0); }
#pragma unroll
            for (int s2 = 0; s2 < 2; ++s2) X1 = __builtin_amdgcn_mfma_f32_32x32x16_bf16(PT11[s2], x1[s2], X1, 0, 0, 0);
            if (s < 5) {
                bf16x8 nPT00[2], nPT11[2], nPT01[2];
                {
                    f32x16 n0 = zero16(), n1 = zero16(), n2 = zero16();
#pragma unroll
                    for (int s2 = 0; s2 < 2; ++s2) {
                        n0 = __builtin_amdgcn_mfma_f32_32x32x16_bf16(Z00[s2], PT00[s2], n0, 0, 0, 0);
                        n1 = __builtin_amdgcn_mfma_f32_32x32x16_bf16(Z11[s2], PT11[s2], n1, 0, 0, 0);
                        n2 = __builtin_amdgcn_mfma_f32_32x32x16_bf16(Z00[s2], PT01[s2], n2, 0, 0, 0);
                    }
#pragma unroll
                    for (int s2 = 0; s2 < 2; ++s2) n2 = __builtin_amdgcn_mfma_f32_32x32x16_bf16(Z10[s2], PT11[s2], n2, 0, 0, 0);
                    pack_op(n0, nPT00); pack_op(n1, nPT11); pack_op(n2, nPT01);
                }
                __builtin_amdgcn_sched_barrier(0);
                {
                    f32x16 n3 = zero16(), n4 = zero16(), n5 = zero16();
#pragma unroll
                    for (int s2 = 0; s2 < 2; ++s2) {
                        n3 = __builtin_amdgcn_mfma_f32_32x32x16_bf16(PT00[s2], Z00[s2], n3, 0, 0, 0);
                        n4 = __builtin_amdgcn_mfma_f32_32x32x16_bf16(PT11[s2], Z11[s2], n4, 0, 0, 0);
                        n5 = __builtin_amdgcn_mfma_f32_32x32x16_bf16(PT01[s2], Z00[s2], n5, 0, 0, 0);
                    }
#pragma unroll
                    for (int s2 = 0; s2 < 2; ++s2) n5 = __builtin_amdgcn_mfma_f32_32x32x16_bf16(PT11[s2], Z10[s2], n5, 0, 0, 0);
                    pack_op(n3, Z00); pack_op(n4, Z11); pack_op(n5, Z10);
                }
#pragma unroll
                for (int s2 = 0; s2 < 2; ++s2) { PT00[s2] = nPT00[s2]; PT11[s2] = nPT11[s2]; PT01[s2] = nPT01[s2]; }
            }
        }
        stt(SO, G_X0 + 4096 * cb, 0, X0); stt(SO, G_X0 + 4096 * cb, 1, X1);
    }
    {
        STAGE_IDS
        const int jb = wg >> 1, ib = wg & 1;
        f32x16 c1 = zero16(), c2 = zero16();
        if (jb <= ib) {
            bf16x8 fR[4], fB[4], fK[4]; ldf(FO, G_RT + 4096 * ib, fR); ldf(FO, G_BT + 4096 * jb, fB); ldf(FO, G_KT + 4096 * jb, fK);
#pragma unroll
            for (int t = 0; t < 4; ++t) { c1 = __builtin_amdgcn_mfma_f32_32x32x16_bf16(fB[t], fR[t], c1, 0, 0, 0); c2 = __builtin_amdgcn_mfma_f32_32x32x16_bf16(fK[t], fR[t], c2, 0, 0, 0); }
            if (jb == ib) { mask_lt(c1, 32 * jb, 32 * ib + r, hh, true); mask_lt(c2, 32 * jb, 32 * ib + r, hh, true); }
        }
        stt(SO, G_P0 + 4096 * ib, jb, c1); stt(SO, G_PT0 + 4096 * ib, jb, c2);
    }
    gbar(cnt, bt, lane_in);
    {
        STAGE_IDS
#pragma unroll
        for (int q = 0; q < 2; ++q) { *(LDSP u32x4*)(lg + G_BT + sw64(lane, wg * 16 + 8 * q)) = keep_bh[q]; *(LDSP u32x4*)(lg + G_KT + sw64(lane, wg * 16 + 8 * q)) = keep_kh[q]; }
    }
    gbar(cnt, bt, lane_in);
    {
        STAGE_IDS
        const int mi = wg;
        const int L_BH = G_BT, L_KH = G_KT, L_RB = G_P0, L_RK = G_PT0;
        const size_t inst = (size_t)inst_index(b, h, d, chunk_id) * 4096;
        bf16_t* dst = (bf16_t*)(p.ws + (mi == 0 ? OFF_CM : mi == 1 ? OFF_CN : mi == 2 ? OFF_CP : OFF_CQ)) + inst;
        if (isx || mi < 2) {
            const int Ax = (mi == 1) ? L_BH : G_X0, Ax0 = (mi == 3) ? 64 : 0;
            const int By = (mi == 0) ? L_BH : (mi == 1) ? G_X0 : L_RB, By0 = (mi == 1) ? 64 : 0;
            const int A2 = (mi == 1) ? L_KH : G_VT, B2 = (mi == 1) ? G_VT : L_RK;
#pragma unroll 1
            for (int half = 0; half < 2; ++half) {
                bf16x8 a0[4], a1[4], b1[4];
                ldf(FO, Ax + 128 * Ax0, a0); ldf(FO, Ax + 128 * (Ax0 + 32), a1); ldf(FO, By + 128 * (By0 + 32 * half), b1);
                f32x16 c0 = zero16(), c1 = zero16();
#pragma unroll
                for (int t = 0; t < 4; ++t) { c0 = __builtin_amdgcn_mfma_f32_32x32x16_bf16(a0[t], b1[t], c0, 0, 0, 0); c1 = __builtin_amdgcn_mfma_f32_32x32x16_bf16(a1[t], b1[t], c1, 0, 0, 0); }
                if (mi & 1) {
                    ldf(FO, A2, a0); ldf(FO, A2 + 4096, a1); ldf(FO, B2 + 4096 * half, b1);
#pragma unroll
                    for (int t = 0; t < 4; ++t) { c0 = __builtin_amdgcn_mfma_f32_32x32x16_bf16(a0[t], b1[t], c0, 0, 0, 0); c1 = __builtin_amdgcn_mfma_f32_32x32x16_bf16(a1[t], b1[t], c1, 0, 0, 0); }
                }
                const int y = 32 * half + r;
                const float dg = (mi == 0) ? __expf(((const LDSP float*)(lg + G_GL))[y]) : 0.f;
#pragma unroll
                for (int xb = 0; xb < 2; ++xb) {
#pragma unroll
                    for (int gp2 = 0; gp2 < 2; ++gp2) {
                        unsigned pw[4];
#pragma unroll
                        for (int g1 = 0; g1 < 2; ++g1) { const int gq = 2 * gp2 + g1;
                            const int x0 = 32 * xb + 8 * gq + 4 * hh;
                            float v0 = xb ? c1[4 * gq] : c0[4 * gq], v1 = xb ? c1[4 * gq + 1] : c0[4 * gq + 1], v2 = xb ? c1[4 * gq + 2] : c0[4 * gq + 2], v3 = xb ? c1[4 * gq + 3] : c0[4 * gq + 3];
                            if (mi == 0) { if (x0 == y) v0 += dg; if (x0 + 1 == y) v1 += dg; if (x0 + 2 == y) v2 += dg; if (x0 + 3 == y) v3 += dg; }
                            if (mi == 2) { const u32x2 w = ld8(SO, gq, G_RT + 4096 * half, xb); v0 += bf2f(w.x & 0xffff); v1 += bf2f(w.x >> 16); v2 += bf2f(w.y & 0xffff); v3 += bf2f(w.y >> 16); }
                            pw[2 * g1] = pk2(v0, v1); pw[2 * g1 + 1] = pk2(v2, v3); }
                        *(u32x4*)(dst + ((half * 4 + 2 * xb + gp2) * 64 + hh * 32 + r) * 8) = mk4u(pw[0], pw[1], pw[2], pw[3]);
                    }
                }
            }
        }
    }
    gbar(cnt, bt, lane_in);
#undef STAGE_IDS
}

__device__ __forceinline__ void conv_group_load(const float* src, int N, int k0, int n0, int tg, f32x4 (&v)[8][2]) {
    const int kr = tg >> 4, nc = (tg & 15) * 4;
#pragma unroll
    for (int s = 0; s < 8; ++s)
#pragma unroll
        for (int h = 0; h < 2; ++h) v[s][h] = __builtin_nontemporal_load((const f32x4*)(src + (size_t)(k0 + (2 * s + h) * 16 + kr) * N + n0 + nc));
}
__device__ __forceinline__ void conv_group_finish(LDSP unsigned char* lg, LDSP unsigned* cnt, unsigned& bt, bf16_t* dst, int ld, int mode, int k0, int n0, const f32x4 (&v)[8][2], int tg, int lane) {
    LDSP float* Tm = (LDSP float*)lg;
    {
        const int kr = tg >> 4, nc = (tg & 15) * 4;
#pragma unroll
        for (int s = 0; s < 8; ++s)
#pragma unroll
            for (int h = 0; h < 2; ++h) { LDSP float* q = Tm + ((2 * s + h) * 16 + kr) * 65 + nc;
                q[0] = v[s][h].x; q[1] = v[s][h].y; q[2] = v[s][h].z; q[3] = v[s][h].w; }
    }
    gbar(cnt, bt, lane);
    {
        const int n = tg >> 2; unsigned char* drow = (unsigned char*)dst + (size_t)conv_row(n0 + n, mode & 3) * ld;
        if (mode & 4) {
            const float sc = (mode & 3) ? W1_SCALE : W2_SCALE;
#pragma unroll
            for (int s = 0; s < 4; ++s) { const int kc = ((tg & 3) + 4 * s) * 16; float f[16];
#pragma unroll
                for (int j = 0; j < 16; ++j) f[j] = Tm[(kc + j) * 65 + n] * sc;
                __builtin_nontemporal_store(mk4u(pk4_fp8(f[0], f[1], f[2], f[3]), pk4_fp8(f[4], f[5], f[6], f[7]), pk4_fp8(f[8], f[9], f[10], f[11]), pk4_fp8(f[12], f[13], f[14], f[15])), (u32x4*)(drow + k0 + kc)); }
        } else {
#pragma unroll
            for (int s = 0; s < 8; ++s) { const int kc = ((tg & 3) + 4 * s) * 8; float f[8];
#pragma unroll
                for (int j = 0; j < 8; ++j) f[j] = Tm[(kc + j) * 65 + n];
                *(u32x4*)(drow + 2 * (k0 + kc)) = mk4u(pk2(f[0], f[1]), pk2(f[2], f[3]), pk2(f[4], f[5]), pk2(f[6], f[7])); }
        }
    }
    gbar(cnt, bt, lane);
}
__device__ __forceinline__ void conv_group_range(LDSP unsigned char* lg, LDSP unsigned* cnt, unsigned& bt, const Params& p, int g0, int g1, int tg, int lane) {
    int g = g0 + blockIdx.x;
    const float* csrc = nullptr; bf16_t* cdst = nullptr; int cN = 0, cld = 0, cmode = 0, ck0 = 0, cn0 = 0;
    const float* nsrc = nullptr; bf16_t* ndst = nullptr; int nN = 0, nld = 0, nmode = 0, nk0 = 0, nn0 = 0;
    f32x4 va[8][2], vb[8][2];
    if (g < g1) { conv_decode(p, g, csrc, cdst, cN, cld, cmode, ck0, cn0); conv_group_load(csrc, cN, ck0, cn0, tg, va); }
    __builtin_amdgcn_s_waitcnt(0);
#pragma unroll 1
    while (g < g1) {
        const int gn = g + gridDim.x;
        if (gn < g1) { conv_decode(p, gn, nsrc, ndst, nN, nld, nmode, nk0, nn0); conv_group_load(nsrc, nN, nk0, nn0, tg, vb); }
        conv_group_finish(lg, cnt, bt, cdst, cld, cmode, ck0, cn0, va, tg, lane);
        cdst = ndst; cld = nld; cmode = nmode; ck0 = nk0; cn0 = nn0; g = gn;
#pragma unroll
        for (int s = 0; s < 8; ++s) { va[s][0] = vb[s][0]; va[s][1] = vb[s][1]; }
    }
}

__device__ __forceinline__ void phaseR3(LDSP unsigned char* lds, const Params& p) {
    const int tid = TIDX(), wid = tid >> 6, lane = tid & 63, gp = wid >> 2, wg = wid & 3;
    LDSP unsigned char* lg = lds + gp * G_BYTES;
    LDSP unsigned* cnt = (LDSP unsigned*)(lg + G_CNT);
    LDSP unsigned* uq = (LDSP unsigned*)(lds + SMEM_BYTES - 48);
    LDSP unsigned* pick = (LDSP unsigned*)(lg + G_CNT + 8);
    if ((tid & 255) == 0) *cnt = 0u;
    if (tid == 0) *uq = 0u;
    __syncthreads();
    unsigned bt = 0u;
    if (!(p.flags & 1) && gp == 1) conv_group_range(lg, cnt, bt, p, p2_conv_end((int)gridDim.x), CT8, tid & 255, lane);
    unsigned FO[4], SO[4];
    { const unsigned base = LDS_ADDR(lg), r = lane & 31, hh = lane >> 5;
#pragma unroll
      for (int q = 0; q < 4; ++q) { FO[q] = base + r * 128u + ((((2u * q + hh) ^ (r >> 1)) & 7u) << 4); SO[q] = base + r * 128u + ((((unsigned)q ^ (r >> 1)) & 7u) << 4) + 8u * hh; } }
    if (wg == 0) ho_wait(lds, p, 1);
    gbar(cnt, bt, lane);
    for (;;) {
        if ((tid & 255) == 0) *pick = __hip_atomic_fetch_add(uq, 1u, __ATOMIC_RELAXED, __HIP_MEMORY_SCOPE_WORKGROUP);
        gbar(cnt, bt, lane);
        const int u = blockIdx.x + (int)(*pick) * gridDim.x;
        gbar(cnt, bt, lane);
        if ((p.flags & 2) || u >= 4096 + 256) break;
        rwkv_prep_group(lg, cnt, bt, p, u, wg, lane, FO, SO);
    }
    asm volatile("s_waitcnt vmcnt(0)" ::: "memory");
    __syncthreads();
    if (tid == 0) ho_arrive(lds, p, 0);
}

constexpr size_t OFF_HT = OFF_YD;
__device__ __forceinline__ void scan_wave(const Params& p, int item, int lane) {
    const int chain = item >> 1, vb = item & 1, b = chain >> 5, h = (chain >> 1) & 15, d = chain & 1;
    const bf16_t* CM = (const bf16_t*)(p.ws + OFF_CM); const bf16_t* CN = (const bf16_t*)(p.ws + OFF_CN); bf16_t* HT = (bf16_t*)(p.ws + OFF_HT);
    auto chunk_of = [&](int step) { return (step < 4) ? (d ? 3 - step : step) : (d ? 4 + (67 - step) : step); };
    auto load_set = [&](int step, u32x4 (&na)[2][4], u32x4 (&nn)[2][2]) {
        const size_t inst = (size_t)inst_index(b, h, d, chunk_of(step < NCHUNK ? step : NCHUNK - 1)) * 4096;
#pragma unroll
        for (int rt = 0; rt < 2; ++rt) {
#pragma unroll
            for (int s = 0; s < 4; ++s) na[rt][s] = __builtin_nontemporal_load((const u32x4*)(CM + inst + ((rt * 4 + s) * 64 + lane) * 8));
#pragma unroll
            for (int g2 = 0; g2 < 2; ++g2) nn[rt][g2] = __builtin_nontemporal_load((const u32x4*)(CN + inst + (((vb * 2 + rt) * 2 + g2) * 64 + lane) * 8));
        }
    };
    f32x16 hacc[2]; hacc[0] = zero16(); hacc[1] = zero16();
    auto do_step = [&](int step, const u32x4 (&a)[2][4], const u32x4 (&n)[2][2]) {
        bf16x8 bfr[4];
#pragma unroll
        for (int s = 0; s < 4; ++s) { const f32x16& t = hacc[s >> 1]; const int o = 8 * (s & 1);
            bfr[s] = __builtin_bit_cast(bf16x8, mk4u(pk2(t[o], t[o + 1]), pk2(t[o + 2], t[o + 3]), pk2(t[o + 4], t[o + 5]), pk2(t[o + 6], t[o + 7]))); }
        {
            bf16_t* hp = HT + (size_t)inst_index(b, h, d, chunk_of(step)) * 4096 + (vb * 4 * 64 + lane) * 8;
#pragma unroll
            for (int s = 0; s < 4; ++s) *(bf16x8*)(hp + s * 512) = bfr[s];
        }
#pragma unroll
        for (int rt = 0; rt < 2; ++rt) {
            f32x16 acc;
#pragma unroll
            for (int g2 = 0; g2 < 2; ++g2) { const u32x4 w = n[rt][g2];
                acc[8 * g2] = bf2f(w.x & 0xffff); acc[8 * g2 + 1] = bf2f(w.x >> 16); acc[8 * g2 + 2] = bf2f(w.y & 0xffff); acc[8 * g2 + 3] = bf2f(w.y >> 16);
                acc[8 * g2 + 4] = bf2f(w.z & 0xffff); acc[8 * g2 + 5] = bf2f(w.z >> 16); acc[8 * g2 + 6] = bf2f(w.w & 0xffff); acc[8 * g2 + 7] = bf2f(w.w >> 16); }
#pragma unroll
            for (int s = 0; s < 4; ++s) acc = __builtin_amdgcn_mfma_f32_32x32x16_bf16(__builtin_bit_cast(bf16x8, a[rt][s]), bfr[s], acc, 0, 0, 0);
            hacc[rt] = acc;
        }
    };
    u32x4 A0[2][4], N0[2][2], A1[2][4], N1[2][2], A2[2][4], N2[2][2];
    load_set(0, A0, N0); load_set(1, A1, N1); load_set(2, A2, N2);
    __builtin_amdgcn_s_waitcnt(0);
    static_assert(NCHUNK == 68, "the scan loop is unrolled for 68 chunks");
#define SCAN_SB __builtin_amdgcn_sched_barrier(0)
#pragma unroll 1
    for (int step = 0; step < 66; step += 3) {
        do_step(step, A0, N0);     SCAN_SB; load_set(step + 3, A0, N0); SCAN_SB;
        do_step(step + 1, A1, N1); SCAN_SB; load_set(step + 4, A1, N1); SCAN_SB;
        do_step(step + 2, A2, N2); SCAN_SB; load_set(step + 5, A2, N2); SCAN_SB;
    }
#undef SCAN_SB
    do_step(66, A0, N0); do_step(67, A1, N1);
}
__device__ __forceinline__ void scan_wait(LDSP unsigned char* lds, const Params& p, int lane) { ho_wait(lds, p, 0); }
__device__ __forceinline__ void phaseR4(LDSP unsigned char* lds, const Params& p) {
    const int tid = TIDX(), wid = tid >> 6, lane = tid & 63;
    LDSP int* nxt = (LDSP int*)(lds + SMEM_BYTES - 32);
    unsigned* qctr = (unsigned*)(p.ws + OFF_CTL + 16384 + 512);
    unsigned* sdone = (unsigned*)(p.ws + OFF_CTL + 16384 + 1024);
    if ((int)blockIdx.x < 64 && gridDim.x >= 128) {
        if (wid < 2) { scan_wait(lds, p, lane); scan_wave(p, blockIdx.x * 2 + wid, lane);
            __builtin_amdgcn_fence(__ATOMIC_RELEASE, "agent"); asm volatile("s_waitcnt vmcnt(0)" ::: "memory");
            if (lane == 0) __hip_atomic_fetch_add(sdone, 1u, __ATOMIC_RELAXED, __HIP_MEMORY_SCOPE_AGENT); }
    } else if (gridDim.x < 128) {
        if (wid == 0) for (int it = blockIdx.x; it < 128; it += gridDim.x) { scan_wait(lds, p, lane); scan_wave(p, it, lane);
            __builtin_amdgcn_fence(__ATOMIC_RELEASE, "agent"); asm volatile("s_waitcnt vmcnt(0)" ::: "memory");
            if (lane == 0) __hip_atomic_fetch_add(sdone, 1u, __ATOMIC_RELAXED, __HIP_MEMORY_SCOPE_AGENT); }
    }
    for (;;) {
        __syncthreads();
        if (tid == 0) *nxt = (int)atomicAdd(qctr, 1u);
        __syncthreads();
        const int u = *nxt;
        if (u >= 512) break;
        attn_unit(lds, p, u);
    }
}

__device__ __forceinline__ void phaseR5(LDSP unsigned char* lds, const Params& p) {
    const int tid = TIDX(), wid = tid >> 6, lane = tid & 63, r = lane & 31, hh = lane >> 5;
    {
        asm volatile("s_waitcnt vmcnt(0)" ::: "memory");
        if (tid == 0) {
            unsigned* sdone = (unsigned*)(p.ws + OFF_CTL + 16384 + 1024);
            unsigned sp = 0;
            while (__hip_atomic_load(sdone, __ATOMIC_RELAXED, __HIP_MEMORY_SCOPE_AGENT) < 128u && ++sp < (1u << 22)) __builtin_amdgcn_s_sleep(2);
            __builtin_amdgcn_fence(__ATOMIC_ACQUIRE, "agent");
            asm volatile("s_waitcnt vmcnt(0)" ::: "memory");
        }
        __syncthreads();
    }
    const bf16_t* CP = (const bf16_t*)(p.ws + OFF_CP); const bf16_t* CQ = (const bf16_t*)(p.ws + OFF_CQ); const bf16_t* HT = (const bf16_t*)(p.ws + OFF_HT);
    for (int wu = blockIdx.x * 8 + wid; wu < 2 * 64 * 16 * 2; wu += gridDim.x * 8) {
        const int half = wu & 1, u = wu >> 1, b = u >> 10, c = (u >> 4) & 63, h = u & 15;
        const int tau = 32 * half + r; const size_t row = (size_t)b * T + c * 64 + tau;
        const bf16_t* rs = (const bf16_t*)(p.ws + OFF_RS) + row * 1024 + h * 64; const bf16_t* ks = (const bf16_t*)(p.ws + OFF_KS) + row * 1024 + h * 64;
        const bf16_t* ai0 = (const bf16_t*)(p.ws + OFF_AIG) + row * 2048 + h * 64; const bf16_t* ai1 = ai0 + 1024;
        const bf16_t* vs = (const bf16_t*)(p.ws + OFF_VS) + row * 1024 + h * 64; const bf16_t* gg = (const bf16_t*)(p.ws + OFF_GG) + row * 1024 + h * 64;
        u32x2 tr2[8], tk2[8], tx2[8], tz2[8], tv2[8], tg2[8];
#pragma unroll
        for (int q = 0; q < 8; ++q) { const int ch = 32 * (q >> 2) + 8 * (q & 3) + 4 * hh;
            tr2[q] = *(const u32x2*)(rs + ch); tk2[q] = *(const u32x2*)(ks + ch); tx2[q] = *(const u32x2*)(ai0 + ch); tz2[q] = *(const u32x2*)(ai1 + ch); tv2[q] = *(const u32x2*)(vs + ch); tg2[q] = *(const u32x2*)(gg + ch); }
        f32x16 y0 = zero16(), y1 = zero16();
#pragma unroll
        for (int d = 0; d < 2; ++d) {
            const size_t inst = (size_t)inst_index(b, h, d, 4 + c) * 4096;
            const int ii = d ? 63 - (32 * half + r) : (32 * half + r);
            const int it = ii >> 5, lp = hh * 32 + (ii & 31);
            f32x16 a0, a1;
#pragma unroll
            for (int g2 = 0; g2 < 2; ++g2) {
                const u32x4 w0 = __builtin_nontemporal_load((const u32x4*)(CQ + inst + (((it * 2 + 0) * 2 + g2) * 64 + lp) * 8)), w1 = __builtin_nontemporal_load((const u32x4*)(CQ + inst + (((it * 2 + 1) * 2 + g2) * 64 + lp) * 8));
                a0[8 * g2] = bf2f(w0.x & 0xffff); a0[8 * g2 + 1] = bf2f(w0.x >> 16); a0[8 * g2 + 2] = bf2f(w0.y & 0xffff); a0[8 * g2 + 3] = bf2f(w0.y >> 16);
                a0[8 * g2 + 4] = bf2f(w0.z & 0xffff); a0[8 * g2 + 5] = bf2f(w0.z >> 16); a0[8 * g2 + 6] = bf2f(w0.w & 0xffff); a0[8 * g2 + 7] = bf2f(w0.w >> 16);
                a1[8 * g2] = bf2f(w1.x & 0xffff); a1[8 * g2 + 1] = bf2f(w1.x >> 16); a1[8 * g2 + 2] = bf2f(w1.y & 0xffff); a1[8 * g2 + 3] = bf2f(w1.y >> 16);
                a1[8 * g2 + 4] = bf2f(w1.z & 0xffff); a1[8 * g2 + 5] = bf2f(w1.z >> 16); a1[8 * g2 + 6] = bf2f(w1.w & 0xffff); a1[8 * g2 + 7] = bf2f(w1.w >> 16);
            }
#pragma unroll
            for (int s = 0; s < 4; ++s) {
                const bf16x8 pf = __builtin_nontemporal_load((const bf16x8*)(CP + inst + ((it * 4 + s) * 64 + lp) * 8));
                const bf16x8 h0 = *(const bf16x8*)(HT + inst + ((0 * 4 + s) * 64 + lane) * 8), h1 = *(const bf16x8*)(HT + inst + ((1 * 4 + s) * 64 + lane) * 8);
                a0 = __builtin_amdgcn_mfma_f32_32x32x16_bf16(h0, pf, a0, 0, 0, 0);
                a1 = __builtin_amdgcn_mfma_f32_32x32x16_bf16(h1, pf, a1, 0, 0, 0);
            }
#pragma unroll
            for (int g = 0; g < 16; ++g) { y0[g] += a0[g]; y1[g] += a1[g]; }
        }
        float sm = 0.f;
#pragma unroll
        for (int g = 0; g < 16; ++g) sm += y0[g] + y1[g];
        sm += shx(sm, 32);
        const float mean = sm * (1.f / 64.f);
        float q2 = 0.f;
#pragma unroll
        for (int g = 0; g < 16; ++g) { y0[g] -= mean; y1[g] -= mean; q2 += y0[g] * y0[g] + y1[g] * y1[g]; }
        q2 += shx(q2, 32);
        const float rstd = rsqrtf(q2 * (1.f / 64.f) + 64e-5f);
        float bon = 0.f;
#pragma unroll
        for (int q = 0; q < 8; ++q) {
            const int ch = 32 * (q >> 2) + 8 * (q & 3) + 4 * hh;
            const u32x2 r2 = tr2[q], k2 = tk2[q], x2 = tx2[q], z2 = tz2[q];
            const f32x4 ka = *(const f32x4*)(p.k_a + h * 64 + ch), rk = *(const f32x4*)(p.r_k + h * 64 + ch);
            const float rr[4] = {bf2f(r2.x & 0xffff), bf2f(r2.x >> 16), bf2f(r2.y & 0xffff), bf2f(r2.y >> 16)}, kk[4] = {bf2f(k2.x & 0xffff), bf2f(k2.x >> 16), bf2f(k2.y & 0xffff), bf2f(k2.y >> 16)};
            const float xa[4] = {bf2f(x2.x & 0xffff), bf2f(x2.x >> 16), bf2f(x2.y & 0xffff), bf2f(x2.y >> 16)}, za[4] = {bf2f(z2.x & 0xffff), bf2f(z2.x >> 16), bf2f(z2.y & 0xffff), bf2f(z2.y >> 16)};
#pragma unroll
            for (int e = 0; e < 4; ++e) bon += rr[e] * (kk[e] * ((1.f + (xa[e] - 1.f) * ka[e]) + (1.f + (za[e] - 1.f) * ka[e]))) * rk[e];
        }
        bon += shx(bon, 32);
        unsigned char* dst = p.ws + OFF_MIX + (size_t)row * D + h * 64;
#pragma unroll
        for (int q = 0; q < 8; ++q) {
            const int ch = 32 * (q >> 2) + 8 * (q & 3) + 4 * hh, g0 = 4 * (q & 3);
            const f32x4 lg = *(const f32x4*)(p.lnx_g + h * 64 + ch), lb = *(const f32x4*)(p.lnx_b + h * 64 + ch);
            const u32x2 v2 = tv2[q], g2 = tg2[q];
            const float vv[4] = {bf2f(v2.x & 0xffff), bf2f(v2.x >> 16), bf2f(v2.y & 0xffff), bf2f(v2.y >> 16)}, gv[4] = {bf2f(g2.x & 0xffff), bf2f(g2.x >> 16), bf2f(g2.y & 0xffff), bf2f(g2.y >> 16)};
            float o[4];
#pragma unroll
            for (int e = 0; e < 4; ++e) { const float yv = (q < 4) ? y0[g0 + e] : y1[g0 + e]; o[e] = (yv * rstd * lg[e] + lb[e] + bon * vv[e]) * gv[e]; }
            *(unsigned*)(dst + ch) = pk4_fp8(o[0], o[1], o[2], o[3]);
        }
    }
}

__device__ __forceinline__ void phase6(LDSP unsigned char* lds, const Params& p) {
    EpiX1 epi{p.x, (const float*)(p.ws + OFF_MOD), (float*)(p.ws + OFF_X1), 1.f / W2_SCALE};
    pg8::DenseSched S{(const char*)(p.ws + OFF_MIX), (const char*)(p.ws + OFF_WTOUT), NX / 256, D / 256, D / 2, (int)gridDim.x, (int)blockIdx.x};
    pg8::gemm_phase<false, true, 2>(lds, D / 2, S, epi);
}

__device__ __forceinline__ void phase7(LDSP unsigned char* lds, const Params& p) {
    const int tid = TIDX(), wid = tid >> 6, lane = tid & 63;
    LDSP float* GS = (LDSP float*)lds;
    LDSP float* RSTD = (LDSP float*)(lds + 16384);
    LDSP float* PART = (LDSP float*)(lds + 16896);
    LDSP float* CB = (LDSP float*)(lds + 16896 + 65536);
    const float* MOD = (const float*)(p.ws + OFF_MOD);
    const float* X1 = (const float*)(p.ws + OFF_X1);
    unsigned char* H2 = p.ws + OFF_H2;
    LDSP unsigned* MASK = (LDSP unsigned*)(lds + 16896 + 65536 + 2048);
    LDSP unsigned char* SELE = (LDSP unsigned char*)(lds + 16896 + 65536 + 2048 + 256);
    for (int u = blockIdx.x; u < NX / 32; u += gridDim.x) {
        const float* md = MOD + (size_t)((u * 32) >> 12) * 12288;
        for (int idx = tid; idx < D / 4; idx += 512) { const f32x4 g = *(const f32x4*)(p.norm2_g + 4 * idx), sh = *(const f32x4*)(md + 3 * D + 4 * idx), sc = *(const f32x4*)(md + 4 * D + 4 * idx);
            *(LDSP f32x4*)(GS + 4 * idx) = g * (sc + 1.f); *(LDSP f32x4*)(GS + D + 4 * idx) = sh; }
        __syncthreads();
        {
            f32x4 xv[8], xn[8];
            { const float* src = X1 + (size_t)(u * 32 + 4 * wid) * D;
#pragma unroll
              for (int i = 0; i < 8; ++i) xv[i] = ((const f32x4*)src)[lane + 64 * i]; }
#pragma unroll
            for (int rr = 0; rr < 4; ++rr) {
                const int t = 4 * wid + rr, row = u * 32 + t;
                if (rr < 3) { const float* src = X1 + (size_t)(row + 1) * D;
#pragma unroll
                    for (int i = 0; i < 8; ++i) xn[i] = ((const f32x4*)src)[lane + 64 * i]; }
                float ss = 0.f;
#pragma unroll
                for (int i = 0; i < 8; ++i) ss += xv[i].x * xv[i].x + xv[i].y * xv[i].y + xv[i].z * xv[i].z + xv[i].w * xv[i].w;
                ss = wave_sum(ss); const float rs = rsqrtf(ss * (1.f / D) + 1e-6f);
                if (lane == 0) RSTD[t] = rs;
#pragma unroll
                for (int i = 0; i < 8; ++i) { const int col = 4 * (lane + 64 * i);
                    const f32x4 g = *(const LDSP f32x4*)(GS + col), sh = *(const LDSP f32x4*)(GS + D + col);
                    const f32x4 hv = xv[i] * rs * g + sh;
                    *(unsigned*)(H2 + (size_t)row * D + col) = pk4_fp8(hv.x, hv.y, hv.z, hv.w); }
#pragma unroll
                for (int i = 0; i < 8; ++i) xv[i] = xn[i];
            }
        }
        {
            const int j = lane & 31, kk = lane >> 5, k0 = wid * 256;
            unsigned xoff = (unsigned)((u * 32 + j) * D + k0 + 4 * kk) * 4u;
            unsigned woff = (unsigned)(j * D + k0 + 4 * kk) * 4u;
            unsigned goff = (unsigned)(k0 + 4 * kk) * 4u;
            const char* WRT = (const char*)(p.ws + OFF_WRT);
            f32x16 acc0 = zero16(), acc1 = zero16(); float c0 = 0.f, c1 = 0.f;
#pragma unroll 8
            for (int q = 0; q < 32; ++q) {
                const f32x4 xa = *(const f32x4*)((const char*)X1 + xoff);
                const f32x4 b0 = *(const f32x4*)(WRT + woff), b1 = *(const f32x4*)(WRT + woff + 32 * D * 4);
                const f32x4 gv = *(const LDSP f32x4*)((const LDSP char*)GS + goff), sv = *(const LDSP f32x4*)((const LDSP char*)GS + D * 4 + goff);
#pragma unroll
                for (int e = 0; e < 4; ++e) {
                    acc0 = __builtin_amdgcn_mfma_f32_32x32x2f32(xa[e], b0[e] * gv[e], acc0, 0, 0, 0);
                    acc1 = __builtin_amdgcn_mfma_f32_32x32x2f32(xa[e], b1[e] * gv[e], acc1, 0, 0, 0);
                    c0 += sv[e] * b0[e]; c1 += sv[e] * b1[e];
                }
                xoff += 32u; woff += 32u; goff += 32u;
            }
            c0 += shx(c0, 32); c1 += shx(c1, 32);
#pragma unroll
            for (int g = 0; g < 16; ++g) { const int t = crow(g, kk); PART[(wid * 32 + t) * 64 + j] = acc0[g]; PART[(wid * 32 + t) * 64 + 32 + j] = acc1[g]; }
            if (kk == 0) { CB[wid * 64 + j] = c0; CB[wid * 64 + 32 + j] = c1; }
        }
        __syncthreads();
        float cb = 0.f;
#pragma unroll
        for (int w = 0; w < 8; ++w) cb += CB[w * 64 + lane];
        const float eb = p.expert_bias[lane];
#pragma unroll
        for (int rr = 0; rr < 4; ++rr) {
            const int t = 4 * wid + rr, token = u * 32 + t;
            float sum = 0.f;
#pragma unroll
            for (int w = 0; w < 8; ++w) sum += PART[(w * 32 + t) * 64 + lane];
            const float logit = RSTD[t] * sum + cb;
            const float score = 1.f / (1.f + expf(-logit));
            const float v = score + eb;
            const int gi = lane >> 3;
            float m1 = v;
            m1 = fmaxf(m1, shx(m1, 1)); m1 = fmaxf(m1, shx(m1, 2)); m1 = fmaxf(m1, shx(m1, 4));
            const unsigned long long eq = __ballot(v == m1);
            const unsigned gbits = (unsigned)((eq >> (gi * 8)) & 0xffull);
            const bool first = (lane & 7) == (__ffs((int)gbits) - 1);
            float v2 = first ? -INFINITY : v;
            v2 = fmaxf(v2, shx(v2, 1)); v2 = fmaxf(v2, shx(v2, 2)); v2 = fmaxf(v2, shx(v2, 4));
            const float gs = m1 + v2;
            int gr = 0;
#pragma unroll
            for (int jj = 0; jj < 8; ++jj) { const float gj = __builtin_bit_cast(float, __builtin_amdgcn_readlane(__builtin_bit_cast(int, gs), jj * 8)); gr += (gj > gs || (gj == gs && jj < gi)) ? 1 : 0; }
            const float mv = (gr < 4) ? v : -INFINITY;
            int rk = 0;
#pragma unroll
            for (int j8 = 0; j8 < 8; ++j8) {
#pragma unroll
                for (int j1 = 0; j1 < 8; ++j1) { const int jj = 8 * j8 + j1; const float vj = __builtin_bit_cast(float, __builtin_amdgcn_readlane(__builtin_bit_cast(int, mv), jj)); rk += (vj > mv || (vj == mv && jj < lane)) ? 1 : 0; }
            }
            const bool sel = (rk < 8) && (gr < 4);
            const float gsum = wave_sum(sel ? score : 0.f);
            const unsigned long long smask = __ballot(sel);
            if (lane == 0) { MASK[2 * t] = (unsigned)smask; MASK[2 * t + 1] = (unsigned)(smask >> 32); }
            if (sel) {
                SELE[t * 8 + rk] = (unsigned char)lane;
                ((int*)(p.ws + OFF_EIDX))[token * 8 + rk] = lane;
                ((float*)(p.ws + OFF_GATE))[token * 8 + rk] = score / gsum * 2.5f;
            }
        }
        __syncthreads();
        if (tid < 256) {
            const int t = tid >> 3, e = SELE[tid], w = e >> 5, sh = e & 31; int lr = 0;
            for (int t2 = 0; t2 < t; ++t2) lr += (MASK[2 * t2 + w] >> sh) & 1u;
            ((int*)(p.ws + OFF_ESLOT))[(u * 32 + t) * 8 + (tid & 7)] = lr;
        } else if (tid < 320) {
            const int e = tid - 256, w = e >> 5, sh = e & 31; int tot = 0;
#pragma unroll 8
            for (int t2 = 0; t2 < 32; ++t2) tot += (MASK[2 * t2 + w] >> sh) & 1u;
            ((int*)(p.ws + OFF_CNTB))[u * 64 + e] = tot;
        }
        __syncthreads();
    }
}

__device__ __forceinline__ void phase7b(LDSP unsigned char* lds, const Params& p) {
    const int tid = TIDX(), wid = tid >> 6, lane = tid & 63;
    LDSP int* PB = (LDSP int*)lds;
    LDSP int* PT = PB + 512;
    LDSP int* BASE = PT + 512;
    const int* CNTB = (const int*)(p.ws + OFF_CNTB);
    for (int u = blockIdx.x; u < NX / 32; u += gridDim.x) {
        int before = 0, all = 0;
#pragma unroll 8
        for (int i = 0; i < 32; ++i) { const int u2 = wid * 32 + i; const int c = CNTB[u2 * 64 + lane]; all += c; before += (u2 < u) ? c : 0; }
        PB[wid * 64 + lane] = before; PT[wid * 64 + lane] = all;
        __syncthreads();
        if (wid == 0) { int b = 0, tsum = 0;
#pragma unroll
            for (int w = 0; w < 8; ++w) { b += PB[w * 64 + lane]; tsum += PT[w * 64 + lane]; }
            BASE[lane] = b;
            if (u == 0) ((int*)(p.ws + OFF_CTL + 16384))[lane] = tsum; }
        __syncthreads();
        if (tid < 256) {
            const int token = u * 32 + (tid >> 3), idx = token * 8 + (tid & 7);
            const int e = ((const int*)(p.ws + OFF_EIDX))[idx], slot = BASE[e] + ((const int*)(p.ws + OFF_ESLOT))[idx];
            ((int*)(p.ws + OFF_ESLOT))[idx] = slot;
            ((int*)(p.ws + OFF_TOKL))[(size_t)e * NX + slot] = token;
        }
        __syncthreads();
    }
}

constexpr int LE_TAB = 131072;
__device__ __forceinline__ void build_expert_tables(LDSP unsigned char* lds, const Params& p) {
    LDSP int* TP = (LDSP int*)(lds + LE_TAB); LDSP int* ST = TP + 72; LDSP int* CN = ST + 72;
    const int tid = TIDX();
    if (tid < NEX) CN[tid] = (tid < NE) ? ((const int*)(p.ws + OFF_CTL + 16384))[tid] : NX;
    __syncthreads();
    if (tid == 0) {
        int tp = 0, st = 0;
        for (int e = 0; e < NEX; ++e) { const int cn = CN[e]; TP[e] = tp; ST[e] = st; tp += (cn + 255) >> 8; st += cn; }
        TP[NEX] = tp; ST[NEX] = st;
    }
    __syncthreads();
}

struct GroupSched {
    const LDSP int* TP; const LDSP int* ST; const LDSP int* CN;
    const char* A; const char* B; const int* tokl; int ntn, K, G, c; size_t bstride; bool gather; int bn;
    __device__ __forceinline__ bool next(int i, pg8::Unit& u) const {
        const int total = __builtin_amdgcn_readfirstlane(TP[NEX]) * ntn; const long L = (long)i * G + c; if (L >= total) return false;
        const int w = pg8::xcd_remap((int)L, total);
        const int nt = w % ntn, mtg = w / ntn;
        int e = u.e;
        if (__builtin_amdgcn_readfirstlane(TP[e]) > mtg) e = 0;
        while (__builtin_amdgcn_readfirstlane(TP[e + 1]) <= mtg) ++e;
        const int tpe = __builtin_amdgcn_readfirstlane(TP[e]), ste = __builtin_amdgcn_readfirstlane(ST[e]), cne = __builtin_amdgcn_readfirstlane(CN[e]);
        const int mt = mtg - tpe;
        u.B = B + (size_t)e * bstride + (size_t)nt * bn * K * 2;
        u.nvalid = cne; u.m0 = mt * 256; u.pos0 = ste; u.row0 = 0; u.col0 = nt * bn; u.e = e;
        if (gather) { u.A = A; u.rowmap = (e < NE) ? tokl + (size_t)e * NX : nullptr; }
        else { u.A = A + (size_t)(ste + mt * 256) * K * 2; u.rowmap = nullptr; }
        return true;
    }
};
#ifndef P8MODE
#define P8MODE 2
#endif
#ifndef P9MODE
#define P9MODE 2
#endif
struct EpiEO {
    unsigned char* EO;
    __device__ __forceinline__ void operator()(const f32x4 (&acc)[2][2][4][2], const pg8::Unit& u, int wr, int wc, int fr, int fq) const {
        { const int lane = TIDX() & 63; fr = lane & 15; fq = lane >> 4; }
        const int odd = fq & 1;
#pragma unroll
        for (int ai = 0; ai < 2; ++ai)
#pragma unroll
            for (int bj = 0; bj < 2; ++bj)
#pragma unroll
                for (int mp = 0; mp < 4; mp += 2) {
                    const f32x4 a0 = acc[ai][bj][mp][0] * (1.f / W2_SCALE), a1 = acc[ai][bj][mp][1] * (1.f / W2_SCALE);
                    const f32x4 b0 = acc[ai][bj][mp + 1][0] * (1.f / W2_SCALE), b1 = acc[ai][bj][mp + 1][1] * (1.f / W2_SCALE);
                    const unsigned ax = pk4_fp8(a0[0], a0[1], a0[2], a0[3]), ay = pk4_fp8(a1[0], a1[1], a1[2], a1[3]);
                    const unsigned bx = pk4_fp8(b0[0], b0[1], b0[2], b0[3]), by = pk4_fp8(b1[0], b1[1], b1[2], b1[3]);
                    const auto r0 = __builtin_amdgcn_permlane16_swap(ax, bx, false, false), r1 = __builtin_amdgcn_permlane16_swap(ay, by, false, false);
                    const int lr = 128 * ai + 64 * wr + 16 * (mp + odd) + fr, lc = 128 * bj + 32 * wc + 8 * (fq - odd);
                    if (u.m0 + lr < u.nvalid) *(u32x4*)(EO + (unsigned)((u.pos0 + u.m0 + lr) * D + u.col0 + lc)) = mk4u(r0[0], r1[0], r0[1], r1[1]);
                }
    }
};
struct EpiH1 {
    unsigned char* H1;
    __device__ __forceinline__ void operator()(const f32x4 (&acc)[2][2][4][2], const pg8::Unit& u, int wr, int wc, int fr, int fq) const {
        { const int lane = TIDX() & 63; fr = lane & 15; fq = lane >> 4; }
#pragma unroll
        for (int ai = 0; ai < 2; ++ai)
#pragma unroll
            for (int bj = 0; bj < 2; ++bj) {
                unsigned hm[4];
#pragma unroll
                for (int m = 0; m < 4; ++m) { const f32x4 v0 = acc[ai][bj][m][0], v1 = acc[ai][bj][m][1]; float h[4];
#pragma unroll
                    for (int e = 0; e < 4; ++e) { const float g = v0[e] * (1.f / W1_SCALE); h[e] = g * sigmoidf_(g) * (v1[e] * (1.f / W1_SCALE)); }
                    hm[m] = pk4_fp8(h[0], h[1], h[2], h[3]); }
                const auto r01 = __builtin_amdgcn_permlane16_swap(hm[0], hm[1], false, false), r23 = __builtin_amdgcn_permlane16_swap(hm[2], hm[3], false, false);
                const auto t0 = __builtin_amdgcn_permlane32_swap(r01[0], r23[0], false, false), t1 = __builtin_amdgcn_permlane32_swap(r01[1], r23[1], false, false);
                const int lr = 128 * ai + 64 * wr + 16 * fq + fr;
                if (u.m0 + lr < u.nvalid) *(u32x4*)(H1 + (unsigned)((u.pos0 + u.m0 + lr) * EFF + ((u.col0 + 128 * bj + 32 * wc) >> 1))) = mk4u(t0[0], t1[0], t0[1], t1[1]);
            }
    }
};
__device__ __forceinline__ void phase8(LDSP unsigned char* lds, const Params& p) {
    build_expert_tables(lds, p);
    const LDSP int* TP = (const LDSP int*)(lds + LE_TAB);
    EpiH1 epi{p.ws + OFF_H1};
    GroupSched S{TP, TP + 72, TP + 144, (const char*)(p.ws + OFF_H2), (const char*)(p.ws + OFF_WTE1), (const int*)(p.ws + OFF_TOKL), 8 / P8MODE, D / 2, (int)gridDim.x, (int)blockIdx.x,
                 (size_t)1024 * 2048, true, 128 * P8MODE};
    pg8::gemm_phase<true, true, P8MODE>(lds, D / 2, S, epi);
}
__device__ __forceinline__ void phase9(LDSP unsigned char* lds, const Params& p) {
    build_expert_tables(lds, p);
    const LDSP int* TP = (const LDSP int*)(lds + LE_TAB);
    EpiEO epi{p.ws + OFF_EO};
    GroupSched S{TP, TP + 72, TP + 144, (const char*)(p.ws + OFF_H1), (const char*)(p.ws + OFF_WTE2), nullptr, 16 / P9MODE, EFF / 2, (int)gridDim.x, (int)blockIdx.x,
                 (size_t)2048 * 512, false, 128 * P9MODE};
    pg8::gemm_phase<false, true, P9MODE>(lds, EFF / 2, S, epi);
}
typedef float f32x2v __attribute__((ext_vector_type(2)));
__device__ __forceinline__ void phase10(LDSP unsigned char* lds, const Params& p) {
    build_expert_tables(lds, p);
    const LDSP int* ST = (const LDSP int*)(lds + LE_TAB) + 72;
    const int tid = TIDX(), wid = tid >> 6, lane = tid & 63;
    const float* MOD = (const float*)(p.ws + OFF_MOD);
    const float* X1 = (const float*)(p.ws + OFF_X1);
    const unsigned char* EO = p.ws + OFF_EO;
    for (int row = blockIdx.x * 8 + wid; row < NX; row += gridDim.x * 8) {
        unsigned er[9]; float gw[9];
#pragma unroll
        for (int k = 0; k < 8; ++k) { const int e = ((const int*)(p.ws + OFF_EIDX))[row * 8 + k], sl = ((const int*)(p.ws + OFF_ESLOT))[row * 8 + k];
            er[k] = (unsigned)(ST[e] + sl) * (unsigned)D; gw[k] = ((const float*)(p.ws + OFF_GATE))[row * 8 + k]; }
        er[8] = (unsigned)(ST[NE] + row) * (unsigned)D; gw[8] = 1.f;
        const float* md = MOD + (size_t)(row >> 12) * 12288 + 5 * D;
        LDSP float* RB = (LDSP float*)lds + wid * 2048;
        float ss = 0.f;
#pragma unroll 4
        for (int i = 0; i < 4; ++i) { const int col = 8 * (lane + 64 * i);
            float a[8];
#pragma unroll
            for (int j = 0; j < 8; ++j) a[j] = 0.f;
#pragma unroll
            for (int k = 0; k < 9; ++k) { const u32x2 w = *(const u32x2*)(EO + er[k] + col);
                const f32x2v f0 = __builtin_amdgcn_cvt_pk_f32_fp8((int)w.x, false), f1 = __builtin_amdgcn_cvt_pk_f32_fp8((int)w.x, true), f2 = __builtin_amdgcn_cvt_pk_f32_fp8((int)w.y, false), f3 = __builtin_amdgcn_cvt_pk_f32_fp8((int)w.y, true);
                a[0] += gw[k] * f0.x; a[1] += gw[k] * f0.y; a[2] += gw[k] * f1.x; a[3] += gw[k] * f1.y; a[4] += gw[k] * f2.x; a[5] += gw[k] * f2.y; a[6] += gw[k] * f3.x; a[7] += gw[k] * f3.y; }
            const f32x4 xa = *(const f32x4*)(X1 + (size_t)row * D + col), xb = *(const f32x4*)(X1 + (size_t)row * D + col + 4), ga = *(const f32x4*)(md + col), gb = *(const f32x4*)(md + col + 4);
            f32x4 va, vb; va.x = xa.x + ga.x * a[0]; va.y = xa.y + ga.y * a[1]; va.z = xa.z + ga.z * a[2]; va.w = xa.w + ga.w * a[3];
            vb.x = xb.x + gb.x * a[4]; vb.y = xb.y + gb.y * a[5]; vb.z = xb.z + gb.z * a[6]; vb.w = xb.w + gb.w * a[7];
            ss += va.x * va.x + va.y * va.y + va.z * va.z + va.w * va.w + vb.x * vb.x + vb.y * vb.y + vb.z * vb.z + vb.w * vb.w;
            *(LDSP f32x4*)(RB + col) = va; *(LDSP f32x4*)(RB + col + 4) = vb; }
        ss = wave_sum(ss); const float rs = rsqrtf(ss * (1.f / D) + 1e-6f);
#pragma unroll 4
        for (int i = 0; i < 8; ++i) { const int col = 4 * (lane + 64 * i); const f32x4 g = *(const f32x4*)(p.final_g + col);
            const f32x4 xv = *(const LDSP f32x4*)(RB + col);
            f32x4 o; o.x = xv.x * rs * g.x; o.y = xv.y * rs * g.y; o.z = xv.z * rs * g.z; o.w = xv.w * rs * g.w;
            __builtin_nontemporal_store(o, (f32x4*)(p.out + (size_t)row * D + col)); }
    }
}

#define XB_TMO      128
#define XB_XCNT(j)  (256  + 64 * (j))
#define XB_XSUB(j)  (1280 + 64 * (j))
#define XB_XGEN(j)  (2304 + 64 * (j))
#define XB_TOP      3328
#define XB_TOPGEN   3392
#define XB_SPIN_CAP (1u << 20)
__device__ __forceinline__ unsigned xb_ld(unsigned* p)              { return __hip_atomic_load(p, __ATOMIC_RELAXED, __HIP_MEMORY_SCOPE_AGENT); }
__device__ __forceinline__ unsigned xb_add(unsigned* p, unsigned v) { return __hip_atomic_fetch_add(p, v, __ATOMIC_RELAXED, __HIP_MEMORY_SCOPE_AGENT); }
__device__ __forceinline__ unsigned xb_xcc_id() { return (unsigned)__builtin_amdgcn_s_getreg((3 << 11) | 20) & 0xFu; }
#define XB_SPIN(cond, bar) do { unsigned _sp = 0; while (cond) { __builtin_amdgcn_s_sleep(1); \
    if ((++_sp & 255u) == 0u) { if (xb_ld(&(bar)[XB_TMO])) break; if (_sp > XB_SPIN_CAP) { atomicAdd(&(bar)[XB_TMO], 1u); break; } } } } while (0)
__device__ __forceinline__ unsigned xcd_barrier_complete(unsigned* bar, unsigned x) {
    const unsigned G = gridDim.x * gridDim.y * gridDim.z;
    unsigned sum, cnt, mine, sp = 0u;
    for (;;) {
        sum = 0u; cnt = 0u; mine = 0u;
#pragma unroll
        for (unsigned j = 0; j < 16; ++j) { const unsigned c = xb_ld(&bar[XB_XCNT(j)]); sum += c; cnt += (c > 0u) ? 1u : 0u; mine = (j == x) ? c : mine; }
        if (sum == G) break;
        __builtin_amdgcn_s_sleep(1);
        if ((++sp & 255u) == 0u) { if (xb_ld(&bar[XB_TMO])) break; if (sp > XB_SPIN_CAP) { atomicAdd(&bar[XB_TMO], 1u); break; } }
    }
    return (mine > 0u ? mine : 1u) | ((cnt > 0u ? cnt : 1u) << 16);
}
__device__ __forceinline__ void xcd_barrier(unsigned* bar, unsigned x, volatile LDSP unsigned* st) {
    x = (unsigned)opaque_s((int)x);
    asm volatile("s_waitcnt vmcnt(0)" ::: "memory");
    __syncthreads();
    if (TIDX() == 0) {
        __builtin_amdgcn_s_waitcnt(0);
        unsigned pk = st[0];
        if (pk == 0u) { pk = xcd_barrier_complete(bar, x); st[0] = pk; }
        const unsigned nloc = pk & 0xffffu, nx = pk >> 16;
        const unsigned old = xb_add(&bar[XB_XSUB(x)], 1u);
        const unsigned gen = old / nloc;
        if (old + 1u == (gen + 1u) * nloc) {
            __builtin_amdgcn_fence(__ATOMIC_RELEASE, "agent");
            asm volatile("s_waitcnt vmcnt(0)" ::: "memory");
            const unsigned og = xb_add(&bar[XB_TOP], 1u);
            const unsigned tg = og / nx;
            if (og + 1u == (tg + 1u) * nx) xb_add(&bar[XB_TOPGEN], 1u);
            else XB_SPIN(xb_ld(&bar[XB_TOPGEN]) == tg, bar);
            __builtin_amdgcn_fence(__ATOMIC_ACQUIRE, "agent");
            xb_add(&bar[XB_XGEN(x)], 1u);
            asm volatile("s_waitcnt vmcnt(0)" ::: "memory");
        } else {
            XB_SPIN(xb_ld(&bar[XB_XGEN(x)]) == gen, bar);
            __builtin_amdgcn_fence(__ATOMIC_ACQUIRE, "agent");
            asm volatile("s_waitcnt vmcnt(0)" ::: "memory");
        }
    }
    __syncthreads();
}

__global__ void __launch_bounds__(512, 2) fwd_megakernel(Params p) {
    __shared__ __attribute__((aligned(16))) unsigned char smem_raw[SMEM_BYTES];
    LDSP unsigned char* lds = (LDSP unsigned char*)smem_raw;
    volatile LDSP unsigned* xst = (volatile LDSP unsigned*)(lds + SMEM_BYTES - 16);
    if ((threadIdx.x & 63u) == 0u) *LDS_AT(int, TID_TAB + 4u * ((unsigned)__builtin_amdgcn_s_getreg(0x2804) & 63u)) = (int)(threadIdx.x >> 6);
    if (threadIdx.x == 0) { xst[0] = 0u; xst[1] = 0u; }
    __syncthreads();
    const unsigned xcc = xb_xcc_id();
    if (threadIdx.x == 0) (void)xb_add(&((unsigned*)p.ws)[XB_XCNT(xcc)], 1u);
#define GSYNC xcd_barrier((unsigned*)p.ws, xcc, xst)
#ifndef PH_TWICE
#define PH_TWICE 0
#endif
#ifndef PROBE_FLAGS
#define PROBE_FLAGS 0
#endif
#ifndef PH_MASK
#define PH_MASK 0xffff
#endif
#define RUN_PHASE(bit, fn) _Pragma("unroll 1") for (int rep = 0; rep < ((PH_TWICE & (bit)) ? 2 : 1); ++rep) { if (rep) GSYNC; if (PH_MASK & (bit)) { Params q = p; q.ws = opq(p.ws); q.flags = rep ? PROBE_FLAGS : 0; fn(lds, q); } }
    RUN_PHASE(1, phase0)      GSYNC;
    RUN_PHASE(2, phase1)      GSYNC;
    RUN_PHASE(4, phase2)      GSYNC;
    RUN_PHASE(8, phaseR1)     GSYNC;
    RUN_PHASE(16, phaseR2)
    RUN_PHASE(32, phaseR3)
    RUN_PHASE(64, phaseR4)
    RUN_PHASE(128, phaseR5)   GSYNC;
    RUN_PHASE(256, phase6)    GSYNC;
    RUN_PHASE(512, phase7)    GSYNC;
    RUN_PHASE(8192, phase7b)  GSYNC;
    RUN_PHASE(1024, phase8)   GSYNC;
    RUN_PHASE(2048, phase9)   GSYNC;
    RUN_PHASE(4096, phase10)
}

extern "C" void kernel_launch(void* const* d_in, const int* in_sizes, int n_in, void* d_out, int out_size, void* d_ws, size_t ws_size, hipStream_t stream) {
    static int grid_blocks = 0;
    if (!grid_blocks) {
        int dev = 0, cus = 0, per_cu = 0;
        (void)hipGetDevice(&dev);
        (void)hipDeviceGetAttribute(&cus, hipDeviceAttributeMultiprocessorCount, dev);
        (void)hipOccupancyMaxActiveBlocksPerMultiprocessor(&per_cu, fwd_megakernel, 512, 0);
        if (per_cu > 1) per_cu = 1;
        grid_blocks = cus * per_cu;
        if (ws_size < WS_END) fprintf(stderr, "workspace too small: %zu < %zu\n", ws_size, (size_t)WS_END);
    }
    Params p{};
    const float** f = (const float**)&p;
    for (int i = 0; i < 31; ++i) f[i] = (const float*)d_in[i];
    p.out = (float*)d_out; p.ws = (unsigned char*)d_ws;
    (void)hipMemsetAsync(d_ws, 0, 32768, stream);
    void* args[] = {&p};
    hipError_t e = hipLaunchCooperativeKernel((void*)fwd_megakernel, dim3(grid_blocks), dim3(512), args, 0, stream);
    if (e != hipSuccess) fprintf(stderr, "cooperative launch failed: %s (grid %d)\n", hipGetErrorString(e), grid_blocks);
}
```
